# Optimizing an MI355X kernel written in HIP

```python
import math
import jax, jax.numpy as jnp
from jax import lax
import numpy as np

D_MODEL = 1024
BATCH = 8
SEQ = 2048
DEPTH = 2

ATTN_HEADS = 4
ATTN_HEAD_DIM = 64
ATTN_WIDTH = ATTN_HEADS * ATTN_HEAD_DIM
DILATED_CONFIGS = ((128, 1), (512, 4), (2048, 16))
ATTN_BLOCK = 128
REL_BUCKETS = 32
REL_MAX_DIST = 1024

RWKV_HEADS = 6
RWKV_HEAD_DIM = 64
RWKV_WIDTH = RWKV_HEADS * RWKV_HEAD_DIM
RWKV_DECAY_RANK = 64
RWKV_ICL_RANK = 64
RWKV_GATE_RANK = 128
RWKV_GN_EPS = 64e-5
RWKV_DIR_WIDTH = 3 * RWKV_WIDTH + RWKV_DECAY_RANK + RWKV_ICL_RANK

MLSTM_HEADS = 4
MLSTM_HEAD_DIM = 96
MLSTM_WIDTH = MLSTM_HEADS * MLSTM_HEAD_DIM
MLSTM_CONV = 5
MLSTM_CHUNK = 64
MLSTM_GN_EPS = 1e-6
MLSTM_M_INIT = -1e30

MIX_WIDTH = ATTN_WIDTH + RWKV_WIDTH + MLSTM_WIDTH

IN_SPLITS = (3 * ATTN_WIDTH,
             3 * RWKV_WIDTH,
             RWKV_DECAY_RANK, RWKV_DECAY_RANK,
             RWKV_ICL_RANK, RWKV_ICL_RANK,
             RWKV_GATE_RANK,
             2 * MLSTM_WIDTH,
             MLSTM_WIDTH,
             MLSTM_WIDTH,
             4 * MLSTM_HEADS)
IN_WIDTH = sum(IN_SPLITS)

N_EXPERTS = 16
EC_FACTOR = 2
D_FF_EXPERT = 2816
RMS_EPS = 1e-6

kernel_name = "hybrid_dilated_rwkv7_mlstm_ec_moe_encoder"


def split_cols(z, sizes):
    offs = np.cumsum(sizes)[:-1].tolist()
    return jnp.split(z, offs, axis=-1)


def rmsnorm(x, g):
    xf = x.astype(jnp.float32)
    y = xf * lax.rsqrt(jnp.mean(xf * xf, axis=-1, keepdims=True) + RMS_EPS) * g.astype(jnp.float32)
    return y.astype(x.dtype)


def head_norm(y, eps):
    mu = jnp.mean(y, axis=-1, keepdims=True)
    var = jnp.mean(jnp.square(y - mu), axis=-1, keepdims=True)
    return (y - mu) * lax.rsqrt(var + eps)


def t5_bucket(rel):
    nb = REL_BUCKETS // 2
    ret = jnp.where(rel > 0, nb, 0)
    n = jnp.abs(rel)
    max_exact = nb // 2
    nf = jnp.maximum(n, 1).astype(jnp.float32)
    large = max_exact + (jnp.log(nf / max_exact) / math.log(REL_MAX_DIST / max_exact)
                         * (nb - max_exact)).astype(jnp.int32)
    large = jnp.minimum(large, nb - 1)
    return ret + jnp.where(n < max_exact, n, large)


def dilated_branch(q, k, v, rel_bias, radius, dil):
    Bsz, S, H, hd = q.shape
    L = S // dil
    bq = math.gcd(L, ATTN_BLOCK)
    nb = L // bq
    kw = bq + 2 * radius

    def to_sub(t):
        return t.reshape(Bsz, L, dil, H, hd).transpose(0, 2, 3, 1, 4)

    qs, ks, vs = to_sub(q), to_sub(k), to_sub(v)
    pad = ((0, 0), (0, 0), (0, 0), (radius, radius), (0, 0))
    kp, vp = jnp.pad(ks, pad), jnp.pad(vs, pad)
    idx = jnp.arange(nb)[:, None] * bq + jnp.arange(kw)[None, :]
    kb = jnp.take(kp, idx, axis=3)
    vb = jnp.take(vp, idx, axis=3).astype(jnp.float32)
    qb = qs.reshape(Bsz, dil, H, nb, bq, hd)
    s = jnp.einsum('brhnqc,brhnkc->brhnqk', qb, kb).astype(jnp.float32) * (hd ** -0.5)
    rel = jnp.arange(kw)[None, :] - radius - jnp.arange(bq)[:, None]
    kpos = idx[:, None, :] - radius
    valid = (jnp.abs(rel) <= radius)[None] & (kpos >= 0) & (kpos < L)
    bias = rel_bias[t5_bucket(rel * dil)].astype(jnp.float32).transpose(2, 0, 1)
    s = jnp.where(valid, s + bias[:, None], -jnp.inf)
    lse = jax.nn.logsumexp(s, axis=-1)
    p = jnp.exp(s - lse[..., None])
    o = jnp.einsum('brhnqk,brhnkc->brhnqc', p, vb)
    o = o.reshape(Bsz, dil, H, L, hd).transpose(0, 3, 1, 2, 4).reshape(Bsz, S, H, hd)
    lse = lse.reshape(Bsz, dil, H, L).transpose(0, 3, 1, 2).reshape(Bsz, S, H)
    return o, lse


def dilated_attention(za, rel_bias):
    Bsz, S, _ = za.shape
    q, k, v = [t.reshape(Bsz, S, ATTN_HEADS, ATTN_HEAD_DIM) for t in jnp.split(za, 3, axis=-1)]
    outs, lses = [], []
    for window, dil in DILATED_CONFIGS:
        o, l = dilated_branch(q, k, v, rel_bias, window // (2 * dil), dil)
        outs.append(o)
        lses.append(l)
    wts = jax.nn.softmax(jnp.stack(lses), axis=0)
    out = jnp.sum(wts[..., None] * jnp.stack(outs), axis=0)
    return out.reshape(Bsz, S, ATTN_WIDTH)


def token_shift(x):
    return jnp.pad(x, ((0, 0), (1, 0), (0, 0)))[:, :-1]


def rwkv7_scan(r, w, k, v, kk, a):
    Bsz, _, H, N = r.shape

    def step(state, inp):
        r_t, w_t, k_t, v_t, kk_t, a_t = inp
        sa = jnp.einsum('bhvk,bhk->bhv', state, -kk_t)
        state = (state * w_t[:, :, None, :] + sa[..., None] * (kk_t * a_t)[:, :, None, :]
                 + v_t[..., None] * k_t[:, :, None, :])
        y = jnp.einsum('bhvk,bhk->bhv', state, r_t)
        return state, y

    xs = tuple(jnp.moveaxis(t, 1, 0) for t in (r, w, k, v, kk, a))
    s0 = jnp.zeros((Bsz, H, N, N), jnp.float32)
    _, ys = lax.scan(step, s0, xs)
    return jnp.moveaxis(ys, 0, 1)


def rwkv7_direction(xd, mu, w0, w2, a0, a2, k_k, k_a, r_k):
    Bsz, S, _ = xd.shape
    xd = xd + mu * (token_shift(xd) - xd)
    r, k, v, wd, ad = split_cols(xd, (RWKV_WIDTH, RWKV_WIDTH, RWKV_WIDTH, RWKV_DECAY_RANK, RWKV_ICL_RANK))
    w_log = -jax.nn.softplus(-(w0 + jnp.tanh(wd) @ w2)) - 0.5
    decay = jnp.exp(-jnp.exp(w_log))
    a = jax.nn.sigmoid(a0 + ad @ a2)
    kk = k * k_k
    k = k * (1.0 + (a - 1.0) * k_a)
    heads = lambda t: t.reshape(Bsz, S, RWKV_HEADS, RWKV_HEAD_DIM)
    r, k, v, decay, a, kk = map(heads, (r, k, v, decay, a, kk))
    kk = kk / jnp.maximum(jnp.sqrt(jnp.sum(kk * kk, axis=-1, keepdims=True)), 1e-12)
    y = rwkv7_scan(r, decay, k, v, kk, a)
    bonus = jnp.sum(r * k * r_k, axis=-1, keepdims=True) * v
    return y, bonus


def rwkv7_mixer(rkv, wd_f, wd_b, ad_f, ad_b, gd, mu, w0, w2, a0, a2, k_k, k_a, r_k, g2, ln_g, ln_b):
    f32 = lambda t: t.astype(jnp.float32)
    Bsz, S, _ = rkv.shape
    rkv, wd_f, wd_b, ad_f, ad_b, gd = map(f32, (rkv, wd_f, wd_b, ad_f, ad_b, gd))
    mu, w0, w2, a0, a2, k_k, k_a, r_k, g2, ln_g, ln_b = map(f32, (mu, w0, w2, a0, a2, k_k, k_a, r_k, g2, ln_g, ln_b))
    x_f = jnp.concatenate([rkv, wd_f, ad_f], axis=-1)
    x_b = jnp.concatenate([rkv, wd_b, ad_b], axis=-1)[:, ::-1]
    y_f, bon_f = rwkv7_direction(x_f, mu[0], w0[0], w2[0], a0[0], a2[0], k_k, k_a, r_k)
    y_b, bon_b = rwkv7_direction(x_b, mu[1], w0[1], w2[1], a0[1], a2[1], k_k, k_a, r_k)
    y_b, bon_b = y_b[:, ::-1], bon_b[:, ::-1]
    y = head_norm(y_f + y_b, RWKV_GN_EPS).reshape(Bsz, S, RWKV_WIDTH) * ln_g + ln_b
    y = y + (bon_f + bon_b).reshape(Bsz, S, RWKV_WIDTH)
    g = jax.nn.sigmoid(gd) @ g2
    return y * g


def depthwise_conv(x, w, b):
    K, C = w.shape
    y = lax.conv_general_dilated(x, w[:, None, :].astype(x.dtype), window_strides=(1,),
                                 padding=[(K // 2, K // 2)],
                                 dimension_numbers=('NWC', 'WIO', 'NWC'),
                                 feature_group_count=C)
    return y + b.astype(x.dtype)


def mlstm_chunkwise(q, k, v, ig, lf):
    Bsz, H, S, D = q.shape
    L = MLSTM_CHUNK
    nc = S // L
    chunk = lambda t: jnp.moveaxis(t.reshape(Bsz, H, nc, L, *t.shape[3:]), 2, 0)
    xs = tuple(chunk(t) for t in (q, k, v, ig, lf))
    tril = jnp.tril(jnp.ones((L, L), dtype=bool))

    def step(carry, inp):
        C, n, m = carry
        qc, kc, vc, ic, fc = inp
        b = jnp.cumsum(fc, axis=-1)
        dmat = jnp.where(tril, b[..., :, None] - b[..., None, :] + ic[..., None, :], -jnp.inf)
        m_inter = b + m[..., None]
        m_t = jnp.maximum(jnp.max(dmat, axis=-1), m_inter)
        w = jnp.exp(dmat - m_t[..., None]) * jnp.einsum('bhtd,bhsd->bhts', qc, kc)
        inter = jnp.exp(m_inter - m_t)
        num = jnp.einsum('bhts,bhsd->bhtd', w, vc) + inter[..., None] * jnp.einsum('bhtk,bhkv->bhtv', qc, C)
        den = jnp.sum(w, axis=-1) + inter * jnp.einsum('bhtk,bhk->bht', qc, n)
        h = num / jnp.maximum(jnp.abs(den), jnp.exp(-m_t))[..., None]
        b_end = b[..., -1]
        g_end = b_end[..., None] - b + ic
        m_new = jnp.maximum(b_end + m, jnp.max(g_end, axis=-1))
        sk = jnp.exp(g_end - m_new[..., None])
        carry_decay = jnp.exp(b_end + m - m_new)
        C = carry_decay[..., None, None] * C + jnp.einsum('bhs,bhsk,bhsv->bhkv', sk, kc, vc)
        n = carry_decay[..., None] * n + jnp.einsum('bhs,bhsk->bhk', sk, kc)
        return (C, n, m_new), h

    init = (jnp.zeros((Bsz, H, D, D), jnp.float32), jnp.zeros((Bsz, H, D), jnp.float32),
            jnp.full((Bsz, H), MLSTM_M_INIT, jnp.float32))
    _, hs = lax.scan(step, init, xs)
    return jnp.moveaxis(hs, 0, 2).reshape(Bsz, H, S, D)


def mlstm_mixer(qk, v, o, gates, conv_w, conv_b, ib, fb, ln_g):
    Bsz, S, _ = v.shape
    qk = jax.nn.silu(depthwise_conv(qk.astype(jnp.float32), conv_w.astype(jnp.float32), conv_b))
    q, k = jnp.split(qk, 2, axis=-1)
    k = k * (MLSTM_HEAD_DIM ** -0.5)
    heads = lambda t: t.astype(jnp.float32).reshape(Bsz, S, MLSTM_HEADS, MLSTM_HEAD_DIM).transpose(0, 2, 1, 3)
    q, k, v = heads(q), heads(k), heads(v)
    g = gates.astype(jnp.float32).reshape(Bsz, S, 4, MLSTM_HEADS).transpose(2, 0, 3, 1)
    ib = ib.astype(jnp.float32)
    fb = fb.astype(jnp.float32)
    ig_f = g[0] + ib[0][:, None]
    lf_f = jax.nn.log_sigmoid(g[1] + fb[0][:, None])
    ig_b = g[2] + ib[1][:, None]
    lf_b = jax.nn.log_sigmoid(g[3] + fb[1][:, None])
    flip = lambda t: jnp.flip(t, axis=2)
    h_f = mlstm_chunkwise(q, k, v, ig_f, lf_f)
    h_b = flip(mlstm_chunkwise(flip(q), flip(k), flip(v), flip(ig_b), flip(lf_b)))
    h = (h_f + h_b).transpose(0, 2, 1, 3)
    h = head_norm(h, MLSTM_GN_EPS).reshape(Bsz, S, MLSTM_WIDTH) * ln_g.astype(jnp.float32)
    return h * jax.nn.sigmoid(o.astype(jnp.float32))


def expert_choice_ffn(h, router, w1, w3, w2):
    Bsz, S, D = h.shape
    cap = EC_FACTOR * S // N_EXPERTS
    aff = jax.nn.softmax(jnp.einsum('bsd,de->bse', h, router).astype(jnp.float32), axis=-1)
    gate, idx = lax.top_k(jnp.swapaxes(aff, 1, 2), cap)
    flat = idx + (jnp.arange(Bsz) * S)[:, None, None]
    xg = h.reshape(Bsz * S, D)[flat]
    a1 = jnp.einsum('becd,edf->becf', xg, w1)
    a3 = jnp.einsum('becd,edf->becf', xg, w3)
    y = jnp.einsum('becf,efd->becd', jax.nn.silu(a1) * a3, w2)
    y = (y.astype(jnp.float32) * gate[..., None]).astype(h.dtype)
    out = jax.ops.segment_sum(y.reshape(-1, D), flat.reshape(-1), num_segments=Bsz * S)
    return out.reshape(Bsz, S, D)


def setup_inputs(seed: int = 0) -> dict:
    key = jax.random.key(seed)
    ks = iter(jax.random.split(key, 40))
    f32 = jnp.float32
    nrm = lambda shape, scale: scale * jax.random.normal(next(ks), shape, f32)
    L = DEPTH
    inp = {}
    inp["x"] = nrm((BATCH, SEQ, D_MODEL), 1.0)
    inp["rel_bias"] = nrm((REL_BUCKETS, ATTN_HEADS), 0.5)
    inp["ln1_g"] = 1.0 + nrm((L, D_MODEL), 0.02)
    inp["w_in"] = nrm((L, D_MODEL, IN_WIDTH), D_MODEL ** -0.5)
    inp["w_out"] = nrm((L, MIX_WIDTH, D_MODEL), MIX_WIDTH ** -0.5)
    inp["rk_mu"] = jax.random.uniform(next(ks), (L, 2, RWKV_DIR_WIDTH), f32, 0.2, 0.8)
    inp["rk_w0"] = jax.random.uniform(next(ks), (L, 2, RWKV_WIDTH), f32, -5.0, -0.5)
    inp["rk_w2"] = nrm((L, 2, RWKV_DECAY_RANK, RWKV_WIDTH), 0.1)
    inp["rk_a0"] = nrm((L, 2, RWKV_WIDTH), 0.1)
    inp["rk_a2"] = nrm((L, 2, RWKV_ICL_RANK, RWKV_WIDTH), 0.1)
    inp["rk_kk"] = 0.85 + nrm((L, RWKV_WIDTH), 0.05)
    inp["rk_ka"] = 1.0 + nrm((L, RWKV_WIDTH), 0.05)
    inp["rk_rk"] = nrm((L, RWKV_HEADS, RWKV_HEAD_DIM), 0.1)
    inp["rk_g2"] = nrm((L, RWKV_GATE_RANK, RWKV_WIDTH), RWKV_GATE_RANK ** -0.5)
    inp["rk_ln_g"] = 1.0 + nrm((L, RWKV_WIDTH), 0.02)
    inp["rk_ln_b"] = nrm((L, RWKV_WIDTH), 0.02)
    inp["ml_conv_w"] = nrm((L, MLSTM_CONV, 2 * MLSTM_WIDTH), MLSTM_CONV ** -0.5)
    inp["ml_conv_b"] = nrm((L, 2 * MLSTM_WIDTH), 0.02)
    inp["ml_ib"] = nrm((L, 2, MLSTM_HEADS), 0.1)
    inp["ml_fb"] = jnp.linspace(3.0, 6.0, MLSTM_HEADS, dtype=f32) + nrm((L, 2, MLSTM_HEADS), 0.1)
    inp["ml_ln_g"] = 1.0 + nrm((L, MLSTM_WIDTH), 0.02)
    inp["ln2_g"] = 1.0 + nrm((L, D_MODEL), 0.02)
    inp["router"] = nrm((L, D_MODEL, N_EXPERTS), D_MODEL ** -0.5)
    inp["e_w1"] = nrm((L, N_EXPERTS, D_MODEL, D_FF_EXPERT), D_MODEL ** -0.5)
    inp["e_w3"] = nrm((L, N_EXPERTS, D_MODEL, D_FF_EXPERT), D_MODEL ** -0.5)
    inp["e_w2"] = nrm((L, N_EXPERTS, D_FF_EXPERT, D_MODEL), D_FF_EXPERT ** -0.5)
    inp["final_g"] = 1.0 + nrm((D_MODEL,), 0.02)
    return inp


def reference(x, rel_bias, ln1_g, w_in, w_out, rk_mu, rk_w0, rk_w2, rk_a0, rk_a2, rk_kk, rk_ka,
              rk_rk, rk_g2, rk_ln_g, rk_ln_b, ml_conv_w, ml_conv_b, ml_ib, ml_fb, ml_ln_g,
              ln2_g, router, e_w1, e_w3, e_w2, final_g):
    for l in range(DEPTH):
        h = rmsnorm(x, ln1_g[l])
        z = h @ w_in[l]
        (za, rkv, wd_f, wd_b, ad_f, ad_b, gd, mqk, mv, mo, mg) = split_cols(z, IN_SPLITS)
        ya = dilated_attention(za, rel_bias)
        yb = rwkv7_mixer(rkv, wd_f, wd_b, ad_f, ad_b, gd, rk_mu[l], rk_w0[l], rk_w2[l], rk_a0[l],
                         rk_a2[l], rk_kk[l], rk_ka[l], rk_rk[l], rk_g2[l], rk_ln_g[l], rk_ln_b[l])
        yc = mlstm_mixer(mqk, mv, mo, mg, ml_conv_w[l], ml_conv_b[l], ml_ib[l], ml_fb[l], ml_ln_g[l])
        y = jnp.concatenate([ya.astype(x.dtype), yb.astype(x.dtype), yc.astype(x.dtype)], axis=-1)
        x = x + y @ w_out[l]
        x = x + expert_choice_ffn(rmsnorm(x, ln2_g[l]), router[l], e_w1[l], e_w3[l], e_w2[l])
    return rmsnorm(x, final_g)
```

```cpp
#include <hip/hip_runtime.h>
#include <cstdio>
#include <cstdint>
namespace pg8 {
#define PG8_LAS __attribute__((address_space(3)))
typedef unsigned short bf16_t;
typedef short bf16x8 __attribute__((ext_vector_type(8)));
typedef float f32x4 __attribute__((ext_vector_type(4)));
typedef unsigned u32x4 __attribute__((ext_vector_type(4)));
constexpr int BM = 256, BK = 64, HALF = 128, HTB = HALF * BK * 2  , STAGE_BYTES = 8 * HTB, NXCD = 8, WGM = 8;

__host__ __device__ __forceinline__ int lds_byte(int r, int c) { const int st = (r >> 4) * 2 + (c >> 5), rr = r & 15, cc = c & 31, ob = rr * 64 + cc * 2; return st * 1024 + (ob ^ (((ob >> 9) & 1) << 5)); }
__host__ __device__ __forceinline__ void stage_rc(int b, int& R, int& C) { const int st = b / 1024, sb = b % 1024, swz = sb ^ (((sb >> 9) & 1) << 5); R = (st >> 1) * 16 + swz / 64; C = (st & 1) * 32 + (swz % 64) / 2; }
__host__ __device__ __forceinline__ int perm32(int rho) { const int n = rho >> 4, i = rho & 15; return 8 * (i >> 2) + 4 * n + (i & 3); }

struct Unit { int pm, pn; };
struct Gemm { const bf16_t* A; const bf16_t* Bt; int M, N, K; };

struct StaticOrder {
    int nM, nN, nwg, G, c;
    __host__ __device__ void init(int M, int N, int G_, int c_) { nM = M / BM; nN = N / BM; nwg = nM * nN; G = G_; c = c_; }
    __host__ __device__ bool next(int i, Unit& u) const {
        const long L = (long)i * G + c; if (L >= nwg) return false;
        int wgid = (int)L; { const int q = nwg / NXCD, r = nwg % NXCD, xcd = wgid % NXCD, off = wgid / NXCD; wgid = (xcd < r ? xcd * (q + 1) : r * (q + 1) + (xcd - r) * q) + off; }
        const int nig = WGM * nN, gid = wgid / nig, fm = gid * WGM, gsz = (nM - fm) < WGM ? (nM - fm) : WGM;
        u.pm = fm + ((wgid % nig) % gsz); u.pn = (wgid % nig) / gsz; return true;
    }
    __device__ __forceinline__ void a_ready(const Unit&) const {}
    __device__ __forceinline__ void done(const Unit&) const {}
};

__device__ __forceinline__ unsigned cvt_pk_bf16(float lo, float hi) { unsigned r; asm volatile("v_cvt_pk_bf16_f32 %0, %1, %2" : "=v"(r) : "v"(lo), "v"(hi)); return r; }
typedef float f32x2 __attribute__((ext_vector_type(2)));
__device__ __forceinline__ f32x2 gelu_pk(f32x2 v) {
    const f32x2 av = __builtin_elementwise_abs(v), d = av * 0.2316418882f + 1.0f;
    f32x2 t; t.x = __builtin_amdgcn_rcpf(d.x); t.y = __builtin_amdgcn_rcpf(d.y);
    f32x2 q = t * 0.5307027145f + (-0.7265760135f); q = q * t + 0.7107068705f; q = q * t + (-0.142248368f); q = q * t + 0.127414796f; q = q * t;
    const f32x2 s = (v * v) * (-0.72134752044f);
    f32x2 e; e.x = __builtin_amdgcn_exp2f(s.x); e.y = __builtin_amdgcn_exp2f(s.y);
    const f32x2 m = v * (q * e), r = v - m;
    f32x2 o; o.x = v.x < 0.f ? m.x : r.x; o.y = v.y < 0.f ? m.y : r.y; return o;
}

template <int ACT  > struct EpiBf16 {
    static constexpr bool PERM = true, AFTER_DRAIN = false; static_assert(ACT == 0 || ACT == 1, "EpiBf16: ACT is 0 (none) or 1 (gelu_pk)");
    bf16_t* O; int ldc; const float* bias; int split_cols; size_t split_stride; float scale0;
    __device__ __forceinline__ void operator()(const f32x4 (&acc)[2][2][4][2], const Unit& u, int wr, int wc, int fr, int fq) const {
        const int row0 = u.pm * BM + wr * 64 + fr; int colt = u.pn * BM; bf16_t* base = O;
        float sc = 1.f; if (split_cols) { const int t = colt / split_cols; base += (size_t)t * split_stride; colt -= t * split_cols; if (t == 0) sc = scale0; }
        const int col0 = colt + wc * 32 + 8 * fq, bcol0 = u.pn * BM + wc * 32 + 8 * fq;
        f32x4 bv[2][2];
#pragma unroll
        for (int bj = 0; bj < 2; ++bj)
#pragma unroll
            for (int n = 0; n < 2; ++n) bv[bj][n] = bias ? *(const f32x4*)(bias + bcol0 + bj * HALF + 4 * n) : (f32x4){0.f, 0.f, 0.f, 0.f};
#pragma unroll
        for (int ai = 0; ai < 2; ++ai)
#pragma unroll
            for (int m = 0; m < 4; ++m) { bf16_t* rowp = base + (size_t)(row0 + ai * HALF + m * 16) * ldc + col0;
#pragma unroll
                for (int bj = 0; bj < 2; ++bj) { f32x4 v0 = acc[ai][bj][m][0] + bv[bj][0], v1 = acc[ai][bj][m][1] + bv[bj][1];
                    if (ACT == 1) { f32x2 a = gelu_pk((f32x2){v0[0], v0[1]}), b = gelu_pk((f32x2){v0[2], v0[3]}), c = gelu_pk((f32x2){v1[0], v1[1]}), d = gelu_pk((f32x2){v1[2], v1[3]});
                        v0 = (f32x4){a.x, a.y, b.x, b.y}; v1 = (f32x4){c.x, c.y, d.x, d.y}; }
                    v0 = v0 * sc; v1 = v1 * sc; u32x4 w; w.x = cvt_pk_bf16(v0[0], v0[1]); w.y = cvt_pk_bf16(v0[2], v0[3]); w.z = cvt_pk_bf16(v1[0], v1[1]); w.w = cvt_pk_bf16(v1[2], v1[3]);
                    *(u32x4*)(rowp + bj * HALF) = w; } }
    }
};
template <class Epi, class Sched, bool ALIGN_EPI = false, bool SP2 = false>
__device__ __forceinline__ void gemm_phase(PG8_LAS unsigned char* lds, const Gemm g, const Sched& S, const Epi& E) {
    const int tid = threadIdx.x, wid = __builtin_amdgcn_readfirstlane(tid >> 6), lane = tid & 63, wr = wid >> 2, wc = wid & 3, fr = lane & 15, fq = lane >> 4;
    const int K = g.K, nt = K / BK;
    unsigned voffA[2], voffB[2];
#pragma unroll
    for (int i = 0; i < 2; ++i) { int R, C; stage_rc(tid * 16 + i * 8192, R, C); const int Rb = Epi::PERM ? ((R & ~31) + perm32(R & 31)) : R;
        voffA[i] = (unsigned)(R * K + C) * 2u; voffB[i] = (unsigned)(Rb * K + C) * 2u; }
    const size_t kstep = (size_t)(BK * 2);
    const size_t hstep = (size_t)HALF * K * 2;
    const size_t tstep = 2 * hstep;
    const unsigned ldsw = (unsigned)wid * 1024u;
    const int aoff = lds_byte(wr * 64 + fr, fq * 8), boff = lds_byte(wc * 32 + fr, fq * 8);
#define PG8_SA(b, h) (((b) * 2 + (h)) * HTB)
#define PG8_SB(b, h) ((4 + (b) * 2 + (h)) * HTB)
#define PG8_STAGE(bufoff, gbase, voff) do { _Pragma("unroll") for (int _i = 0; _i < 2; ++_i) \
        __builtin_amdgcn_global_load_lds((const unsigned*)((const char*)(gbase) + (voff)[_i]), (PG8_LAS unsigned*)(lds + (bufoff) + ldsw + _i * 8192), 16, 0, 0); } while (0)
#define PG8_LDA(dst, b, h) do { _Pragma("unroll") for (int m = 0; m < 4; ++m) _Pragma("unroll") for (int k = 0; k < 2; ++k) dst[m][k] = *(const PG8_LAS bf16x8*)(lds + PG8_SA(b, h) + aoff + m * 2048 + k * 1024); } while (0)
#define PG8_LDB(dst, b, h) do { _Pragma("unroll") for (int n = 0; n < 2; ++n) _Pragma("unroll") for (int k = 0; k < 2; ++k) dst[n][k] = *(const PG8_LAS bf16x8*)(lds + PG8_SB(b, h) + boff + n * 2048 + k * 1024); } while (0)
#define PG8_MMA(ai, bj, At, Bt) do { __builtin_amdgcn_s_setprio(1); _Pragma("unroll") for (int m = 0; m < 4; ++m) _Pragma("unroll") for (int n = 0; n < 2; ++n) _Pragma("unroll") for (int k = 0; k < 2; ++k) \
        acc[ai][bj][m][n] = __builtin_amdgcn_mfma_f32_16x16x32_bf16(Bt[n][k], At[m][k], acc[ai][bj][m][n], 0, 0, 0); __builtin_amdgcn_s_setprio(0); } while (0)
#define PG8_WAIT_V(n) asm volatile("s_waitcnt vmcnt(" #n ")" ::: "memory")
#define PG8_WAIT_L(n) asm volatile("s_waitcnt lgkmcnt(" #n ")" ::: "memory")
#define PG8_BAR __builtin_amdgcn_s_barrier()
#define PG8_SCHED __builtin_amdgcn_sched_barrier(0)
    Unit cur, nxt; int ui = 0;
    if (!S.next(0, cur)) return;
    f32x4 acc[2][2][4][2];
#pragma unroll
    for (int a = 0; a < 2; ++a)
#pragma unroll
        for (int b = 0; b < 2; ++b)
#pragma unroll
            for (int m = 0; m < 4; ++m)
#pragma unroll
                for (int n = 0; n < 2; ++n) acc[a][b][m][n] = (f32x4){0.f, 0.f, 0.f, 0.f};
    bf16x8 At[4][2], B0[2][2], B1[2][2];
    const char* cA = (const char*)g.A + (size_t)cur.pm * tstep; const char* cB = (const char*)g.Bt + (size_t)cur.pn * tstep;
    S.a_ready(cur);
    if constexpr (SP2) {
        PG8_STAGE(PG8_SB(0, 0), cB, voffB); PG8_STAGE(PG8_SB(0, 1), cB + hstep, voffB); PG8_STAGE(PG8_SA(0, 0), cA, voffA); PG8_STAGE(PG8_SA(0, 1), cA + hstep, voffA);
        if (wr == 1) PG8_BAR;
        PG8_WAIT_V(2); PG8_BAR;
        PG8_STAGE(PG8_SB(1, 0), cB + kstep, voffB); PG8_STAGE(PG8_SA(1, 0), cA + kstep, voffA); PG8_STAGE(PG8_SB(1, 1), cB + hstep + kstep, voffB);
        PG8_WAIT_V(6); PG8_BAR;
    } else {
        PG8_STAGE(PG8_SB(0, 0), cB, voffB); PG8_STAGE(PG8_SA(0, 0), cA, voffA); PG8_STAGE(PG8_SB(0, 1), cB + hstep, voffB); PG8_STAGE(PG8_SA(0, 1), cA + hstep, voffA);
        if (wr == 1) PG8_BAR;
        PG8_WAIT_V(4); PG8_BAR;
        PG8_STAGE(PG8_SB(1, 0), cB + kstep, voffB); PG8_STAGE(PG8_SA(1, 0), cA + kstep, voffA); PG8_STAGE(PG8_SB(1, 1), cB + hstep + kstep, voffB);
        PG8_WAIT_V(6); PG8_BAR;
    }
    for (;;) {
        const bool has_next = S.next(ui + 1, nxt);
        const char* nA = has_next ? (const char*)g.A + (size_t)nxt.pm * tstep : cA; const char* nB = has_next ? (const char*)g.Bt + (size_t)nxt.pn * tstep : cB;
        for (int t = 0; t < nt; t += 2) {
            const bool last = (t == nt - 2);
            const char* a1 = cA + (size_t)(t + 1) * kstep;
            const char* a2 = last ? nA : cA + (size_t)(t + 2) * kstep; const char* b2 = last ? nB : cB + (size_t)(t + 2) * kstep;
            const char* a3 = a2 + kstep; const char* b3 = b2 + kstep;
            if (last && has_next) S.a_ready(nxt);
            if constexpr (SP2) {
            PG8_LDB(B0, 0, 0); PG8_LDB(B1, 0, 1); PG8_SCHED; PG8_LDA(At, 0, 0); PG8_STAGE(PG8_SA(1, 1), a1 + hstep, voffA);
            PG8_WAIT_V(8); PG8_WAIT_L(0); PG8_BAR; PG8_MMA(0, 0, At, B0); PG8_MMA(0, 1, At, B1); PG8_BAR; PG8_SCHED;
            PG8_LDA(At, 0, 1); PG8_STAGE(PG8_SB(0, 0), b2, voffB); PG8_STAGE(PG8_SB(0, 1), b2 + hstep, voffB); PG8_STAGE(PG8_SA(0, 0), a2, voffA);
            PG8_WAIT_V(8); PG8_WAIT_L(0); PG8_BAR; PG8_MMA(1, 0, At, B0); PG8_MMA(1, 1, At, B1); PG8_BAR; PG8_SCHED;
            PG8_LDB(B0, 1, 0); PG8_LDB(B1, 1, 1); PG8_SCHED; PG8_LDA(At, 1, 0); PG8_STAGE(PG8_SA(0, 1), a2 + hstep, voffA);
            PG8_WAIT_V(8); PG8_WAIT_L(0); PG8_BAR; PG8_MMA(0, 0, At, B0); PG8_MMA(0, 1, At, B1); PG8_BAR; PG8_SCHED;
            PG8_LDA(At, 1, 1); PG8_STAGE(PG8_SB(1, 0), b3, voffB); PG8_STAGE(PG8_SB(1, 1), b3 + hstep, voffB); PG8_STAGE(PG8_SA(1, 0), a3, voffA);
            PG8_WAIT_V(8); PG8_WAIT_L(0); PG8_BAR; PG8_MMA(1, 0, At, B0); PG8_MMA(1, 1, At, B1); PG8_BAR; PG8_SCHED;
            } else {
            PG8_LDB(B0, 0, 0); PG8_SCHED; PG8_LDA(At, 0, 0); PG8_STAGE(PG8_SA(1, 1), a1 + hstep, voffA);
            PG8_WAIT_L(8); PG8_BAR; PG8_WAIT_L(0); PG8_MMA(0, 0, At, B0); PG8_BAR; PG8_SCHED;
            PG8_LDB(B1, 0, 1); PG8_STAGE(PG8_SB(0, 0), b2, voffB);
            PG8_BAR; PG8_WAIT_L(0); PG8_MMA(0, 1, At, B1); PG8_BAR;
            PG8_LDA(At, 0, 1); PG8_STAGE(PG8_SA(0, 0), a2, voffA);
            PG8_BAR; PG8_WAIT_L(0); PG8_MMA(1, 0, At, B0); PG8_BAR; PG8_SCHED;
            PG8_STAGE(PG8_SB(0, 1), b2 + hstep, voffB);
            PG8_WAIT_V(6); PG8_BAR; PG8_MMA(1, 1, At, B1); PG8_BAR;
            PG8_LDB(B0, 1, 0); PG8_SCHED; PG8_LDA(At, 1, 0); PG8_STAGE(PG8_SA(0, 1), a2 + hstep, voffA);
            PG8_WAIT_L(8); PG8_BAR; PG8_WAIT_L(0); PG8_MMA(0, 0, At, B0); PG8_BAR; PG8_SCHED;
            PG8_LDB(B1, 1, 1); PG8_STAGE(PG8_SB(1, 0), b3, voffB);
            PG8_BAR; PG8_WAIT_L(0); PG8_MMA(0, 1, At, B1); PG8_BAR;
            PG8_LDA(At, 1, 1); PG8_STAGE(PG8_SA(1, 0), a3, voffA);
            PG8_BAR; PG8_WAIT_L(0); PG8_MMA(1, 0, At, B0); PG8_BAR; PG8_SCHED;
            PG8_STAGE(PG8_SB(1, 1), b3 + hstep, voffB);
            PG8_WAIT_V(6); PG8_BAR; PG8_MMA(1, 1, At, B1); PG8_BAR;
            }
        }
        if constexpr (ALIGN_EPI) { if (wr == 0) PG8_BAR; }
        if constexpr (!Epi::AFTER_DRAIN) { E(acc, cur, wr, wc, fr, fq); S.done(cur); }
        if (!has_next) break;
#pragma unroll
        for (int a = 0; a < 2; ++a)
#pragma unroll
            for (int b = 0; b < 2; ++b)
#pragma unroll
                for (int m = 0; m < 4; ++m)
#pragma unroll
                    for (int n = 0; n < 2; ++n) acc[a][b][m][n] = (f32x4){0.f, 0.f, 0.f, 0.f};
        cur = nxt; cA = nA; cB = nB; ++ui;
        if constexpr (ALIGN_EPI) { if (wr == 1) PG8_BAR; }
    }
    PG8_WAIT_V(0);
    if constexpr (!ALIGN_EPI) { if (wr == 0) PG8_BAR; }
    PG8_BAR;
    if constexpr (Epi::AFTER_DRAIN) { E.fused(acc, cur, wr, wc, fr, fq, lds, wid, lane); S.done(cur); }
#undef PG8_SA
#undef PG8_SB
#undef PG8_STAGE
#undef PG8_LDA
#undef PG8_LDB
#undef PG8_MMA
#undef PG8_WAIT_V
#undef PG8_WAIT_L
#undef PG8_BAR
#undef PG8_SCHED
}
}
#define LAS __attribute__((address_space(3)))
#define XB_TMO      128
#define XB_XCNT(j)  (256  + 64 * (j))
#define XB_XSUB(j)  (1280 + 64 * (j))
#define XB_XGEN(j)  (2304 + 64 * (j))
#define XB_TOP      3328
#define XB_TOPGEN   3392
#define XCD_BAR_WORDS 3456
#define XB_SPIN_CAP (1u << 18)

__device__ __forceinline__ unsigned xb_ld(unsigned* p)              { return __hip_atomic_load(p, __ATOMIC_RELAXED, __HIP_MEMORY_SCOPE_AGENT); }
__device__ __forceinline__ unsigned xb_add(unsigned* p, unsigned v) { return __hip_atomic_fetch_add(p, v, __ATOMIC_RELAXED, __HIP_MEMORY_SCOPE_AGENT); }
__device__ __forceinline__ unsigned xb_xcc_id() { return (unsigned)__builtin_amdgcn_s_getreg((3 << 11) | 20) & 0xFu; }
#define XB_SPIN(cond, bar) do { unsigned _sp = 0; while (cond) { __builtin_amdgcn_s_sleep(1); \
    if ((++_sp & 255u) == 0u) { if (xb_ld(&(bar)[XB_TMO])) break; if (_sp > XB_SPIN_CAP) { atomicAdd(&(bar)[XB_TMO], 1u); break; } } } } while (0)

struct XcdBarrier {
    unsigned* bar; unsigned x;
    volatile LAS unsigned* st;
};

__device__ __forceinline__ XcdBarrier xcd_barrier_post(unsigned* bar, volatile LAS unsigned* st) {
    XcdBarrier b; b.bar = bar; b.x = xb_xcc_id(); b.st = st;
    if (threadIdx.x == 0) (void)xb_add(&bar[XB_XCNT(b.x)], 1u);
    return b;
}
__device__ __forceinline__ void xcd_barrier_complete(unsigned* bar, unsigned x, unsigned& nloc, unsigned& nx) {
    const unsigned G = gridDim.x * gridDim.y * gridDim.z;
    unsigned sum, cnt, mine, sp = 0u;
    for (;;) {
        sum = 0u; cnt = 0u; mine = 0u;
#pragma unroll
        for (unsigned j = 0; j < 16; ++j) { const unsigned c = xb_ld(&bar[XB_XCNT(j)]); sum += c; cnt += (c > 0u) ? 1u : 0u; mine = (j == x) ? c : mine; }
        if (sum == G) break;
        __builtin_amdgcn_s_sleep(1);
        if ((++sp & 255u) == 0u) { if (xb_ld(&bar[XB_TMO])) break; if (sp > XB_SPIN_CAP) { atomicAdd(&bar[XB_TMO], 1u); break; } }
    }
    nloc = mine > 0u ? mine : 1u; nx = cnt > 0u ? cnt : 1u;
}

__device__ __forceinline__ void xcd_barrier(const XcdBarrier& b) {
    asm volatile("s_waitcnt vmcnt(0)" ::: "memory");
    __syncthreads();
    if (threadIdx.x == 0) {
        unsigned* bar = b.bar;
        __builtin_amdgcn_s_waitcnt(0);
        unsigned nloc = b.st[0], nx = b.st[1];
        if (nloc == 0u) { xcd_barrier_complete(bar, b.x, nloc, nx); b.st[0] = nloc; b.st[1] = nx; }
        const unsigned old = xb_add(&bar[XB_XSUB(b.x)], 1u);
        const unsigned gen = old / nloc;
        if (old + 1u == (gen + 1u) * nloc) {
            __builtin_amdgcn_fence(__ATOMIC_RELEASE, "agent");
            asm volatile("s_waitcnt vmcnt(0)" ::: "memory");
            const unsigned og = xb_add(&bar[XB_TOP], 1u);
            const unsigned tg = og / nx;
            if (og + 1u == (tg + 1u) * nx) xb_add(&bar[XB_TOPGEN], 1u);
            else XB_SPIN(xb_ld(&bar[XB_TOPGEN]) == tg, bar);
            __builtin_amdgcn_fence(__ATOMIC_ACQUIRE, "agent");
            xb_add(&bar[XB_XGEN(b.x)], 1u);
            asm volatile("s_waitcnt vmcnt(0)" ::: "memory");
        } else {
            XB_SPIN(xb_ld(&bar[XB_XGEN(b.x)]) == gen, bar);
            __builtin_amdgcn_fence(__ATOMIC_ACQUIRE, "agent");
            asm volatile("s_waitcnt vmcnt(0)" ::: "memory");
        }
    }
    __syncthreads();
}

#define DI __device__ __forceinline__
#define LDS_WAIT() asm volatile("s_waitcnt lgkmcnt(0)" ::: "memory")
typedef unsigned short bf16;
typedef float f32x4 __attribute__((ext_vector_type(4)));

namespace mk {
constexpr int NB = 8, SEQ = 2048, DM = 1024, NT = NB * SEQ, NL = 2;
constexpr int INW = 3856, ZLD = 4096;
constexpr int ZA = 0, ZRKV = 768, ZWDF = 1920, ZWDB = 1984, ZADF = 2048, ZADB = 2112, ZGD = 2176, ZMQK = 2304, ZMV = 3072, ZMO = 3456, ZMG = 3840;
constexpr int RW = 384, MW = 384, AW = 256;
constexpr int NE = 16, CAP = 256, FF = 2816, NSLOT = NB * NE * CAP;
constexpr int NWAVES = 8, NTHR = 512;
constexpr float RMS_EPS = 1e-6f;

enum { I_X = 0, I_RELB, I_LN1G, I_WIN, I_WOUT, I_MU, I_W0, I_W2, I_A0, I_A2, I_KK, I_KA, I_RK, I_G2, I_RLNG, I_RLNB,
       I_CW, I_CB, I_IB, I_FB, I_MLNG, I_LN2G, I_ROUTER, I_EW1, I_EW3, I_EW2, I_FG, N_IN };

constexpr size_t MiB = 1u << 20;
constexpr size_t WS_CTL = 0, CTL_ZERO_BYTES = 1 * MiB;
constexpr size_t WS_WTIN = 2 * MiB;
constexpr size_t WS_WTOUT = 18 * MiB;
constexpr size_t WS_W13T = 22 * MiB;
constexpr size_t WS_W2T = 374 * MiB;
constexpr size_t WS_X1 = 550 * MiB;
constexpr size_t WS_X2 = 614 * MiB;
constexpr size_t WS_HB = 678 * MiB;
constexpr size_t WS_AFF = 710 * MiB;
constexpr size_t WS_SEL = 711 * MiB;
constexpr size_t WS_GATE = 712 * MiB;
constexpr size_t WS_R = 714 * MiB;
constexpr size_t WS_Z = WS_R;
constexpr size_t WS_ATTO = WS_R + 128 * MiB;
constexpr size_t WS_ATTL = WS_R + 152 * MiB;
constexpr size_t WS_PR = WS_R + 154 * MiB;
constexpr size_t WS_RKY = WS_R + 442 * MiB;
constexpr size_t WS_RKB = WS_R + 490 * MiB;
constexpr size_t WS_MLQK = WS_R + 538 * MiB;
constexpr size_t WS_MLNUM = WS_R + 586 * MiB;
constexpr size_t WS_MLDEN = WS_R + 634 * MiB;
constexpr size_t WS_XG = WS_R;
constexpr size_t WS_ACT = WS_R + 64 * MiB;
constexpr size_t WS_YS = WS_R + 240 * MiB;
constexpr size_t WS_END = WS_R + 636 * MiB;

constexpr int CW_BAR = 4096;
constexpr int LDS_BYTES = 147456;
constexpr int MISC_OFF = LDS_BYTES - 256;

struct Args { const float* in[N_IN]; float* out; unsigned char* ws; int ph_lo, ph_hi; };

DI float bf2f(unsigned v) { return __uint_as_float(v << 16); }
DI unsigned f2bf(float f) { unsigned u = __float_as_uint(f); return (u + 0x7fffu + ((u >> 16) & 1u)) >> 16; }
DI unsigned pk2(float lo, float hi) { return f2bf(lo) | (f2bf(hi) << 16); }
DI float wave_sum(float v) {
#pragma unroll
    for (int o = 1; o < 64; o <<= 1) v += __shfl_xor(v, o);
    return v;
}
DI float sigm(float x) { return 1.f / (1.f + __expf(-x)); }
DI void unpack8(const uint4 w, float (&f)[8]) {
    f[0] = __uint_as_float(w.x << 16); f[1] = __uint_as_float(w.x & 0xffff0000u); f[2] = __uint_as_float(w.y << 16); f[3] = __uint_as_float(w.y & 0xffff0000u);
    f[4] = __uint_as_float(w.z << 16); f[5] = __uint_as_float(w.z & 0xffff0000u); f[6] = __uint_as_float(w.w << 16); f[7] = __uint_as_float(w.w & 0xffff0000u);
}

struct GroupOrder {
    int G, c2, nunits, per_e, nN;
    DI void init(int nN_, int G_, int bid) { nN = nN_; per_e = 8 * nN_; nunits = NE * per_e; G = G_; c2 = (G_ % 8 == 0) ? (bid % 8) * (G_ / 8) + bid / 8 : bid; }
    DI bool next(int i, pg8::Unit& u) const {
        const long L = (long)i * G + c2; if (L >= nunits) return false;
        const int e = (int)L / per_e, r = (int)L % per_e; u.pm = e * 8 + (r & 7); u.pn = e * nN + (r >> 3); return true;
    }
    DI void a_ready(const pg8::Unit&) const {}
    DI void done(const pg8::Unit&) const {}
};
struct EpiResF32 {
    static constexpr bool PERM = false, AFTER_DRAIN = false;
    const float* base; float* out; int ldc;
    DI void operator()(const pg8::f32x4 (&acc)[2][2][4][2], const pg8::Unit& u, int wr, int wc, int fr, int fq) const {
        const int row0 = u.pm * 256 + wr * 64 + fr, col0 = u.pn * 256 + wc * 32 + 4 * fq;
#pragma unroll
        for (int ai = 0; ai < 2; ++ai)
#pragma unroll
            for (int m = 0; m < 4; ++m) { const size_t off = (size_t)(row0 + ai * 128 + m * 16) * ldc + col0;
#pragma unroll
                for (int bj = 0; bj < 2; ++bj)
#pragma unroll
                    for (int n = 0; n < 2; ++n) { const pg8::f32x4 b = *(const pg8::f32x4*)(base + off + bj * 128 + n * 16); *(pg8::f32x4*)(out + off + bj * 128 + n * 16) = b + acc[ai][bj][m][n]; } }
    }
};
DI float silu_f(float x) { return x * __builtin_amdgcn_rcpf(1.f + __expf(-x)); }
struct EpiSwiGLU {
    static constexpr bool PERM = true, AFTER_DRAIN = false;
    bf16* act; int nN;
    DI void operator()(const pg8::f32x4 (&acc)[2][2][4][2], const pg8::Unit& u, int wr, int wc, int fr, int fq) const {
        const int lpn = u.pn % nN; const int row0 = u.pm * 256 + wr * 64 + fr, col0 = lpn * 128 + wc * 32 + 8 * fq;
#pragma unroll
        for (int ai = 0; ai < 2; ++ai)
#pragma unroll
            for (int m = 0; m < 4; ++m) { bf16* p = act + (size_t)(row0 + ai * 128 + m * 16) * FF + col0;
                const pg8::f32x4 a0 = acc[ai][0][m][0], a1 = acc[ai][0][m][1], g0 = acc[ai][1][m][0], g1 = acc[ai][1][m][1];
                pg8::u32x4 w;
                w.x = pg8::cvt_pk_bf16(silu_f(a0[0]) * g0[0], silu_f(a0[1]) * g0[1]); w.y = pg8::cvt_pk_bf16(silu_f(a0[2]) * g0[2], silu_f(a0[3]) * g0[3]);
                w.z = pg8::cvt_pk_bf16(silu_f(a1[0]) * g1[0], silu_f(a1[1]) * g1[1]); w.w = pg8::cvt_pk_bf16(silu_f(a1[2]) * g1[2], silu_f(a1[3]) * g1[3]);
                *(pg8::u32x4*)p = w; }
    }
};
struct EpiGate {
    static constexpr bool PERM = true, AFTER_DRAIN = false;
    bf16* ys; const float* gate;
    DI void operator()(const pg8::f32x4 (&acc)[2][2][4][2], const pg8::Unit& u, int wr, int wc, int fr, int fq) const {
        const int row0 = u.pm * 256 + wr * 64 + fr, col0 = (u.pn & 3) * 256 + wc * 32 + 8 * fq;
#pragma unroll
        for (int ai = 0; ai < 2; ++ai)
#pragma unroll
            for (int m = 0; m < 4; ++m) { const int row = row0 + ai * 128 + m * 16; const float g = gate[row]; bf16* p = ys + (size_t)row * DM + col0;
#pragma unroll
                for (int bj = 0; bj < 2; ++bj) { const pg8::f32x4 v0 = acc[ai][bj][m][0] * g, v1 = acc[ai][bj][m][1] * g; pg8::u32x4 w;
                    w.x = pg8::cvt_pk_bf16(v0[0], v0[1]); w.y = pg8::cvt_pk_bf16(v0[2], v0[3]); w.z = pg8::cvt_pk_bf16(v1[0], v1[1]); w.w = pg8::cvt_pk_bf16(v1[2], v1[3]);
                    *(pg8::u32x4*)(p + bj * 128) = w; } }
    }
};

DI void cvt_tile(const float* W, int N, int nvalid, int k0, int n0, bf16* dst, int Kd, size_t drow0, LAS float* scr, int lane) {
    const int c4 = (lane & 15) * 4, kr = lane >> 4;
#pragma unroll
    for (int it = 0; it < 16; ++it) { const int k = it * 4 + kr; float4 v = make_float4(0.f, 0.f, 0.f, 0.f);
        if (n0 + c4 < nvalid) v = *(const float4*)(W + (size_t)(k0 + k) * N + n0 + c4);
        LAS float* s = scr + k * 65 + c4; s[0] = v.x; s[1] = v.y; s[2] = v.z; s[3] = v.w; }
    LDS_WAIT(); asm volatile("" ::: "memory");
    const int c = lane & 7;
#pragma unroll
    for (int it = 0; it < 8; ++it) { const int n = it * 8 + (lane >> 3); const LAS float* s = scr + (8 * c) * 65 + n;
        uint4 o; o.x = pk2(s[0], s[65]); o.y = pk2(s[130], s[195]); o.z = pk2(s[260], s[325]); o.w = pk2(s[390], s[455]);
        *(uint4*)(dst + (drow0 + n) * (size_t)Kd + k0 + 8 * c) = o; }
    LDS_WAIT(); asm volatile("" ::: "memory");
}
DI void phase_p0(const Args& A, LAS unsigned char* lds, int gw, int ngw, int wave, int lane) {
    LAS float* scr = (LAS float*)(lds + wave * 16640);
    bf16* wtin = (bf16*)(A.ws + WS_WTIN); bf16* wtout = (bf16*)(A.ws + WS_WTOUT); bf16* w13 = (bf16*)(A.ws + WS_W13T); bf16* w2t = (bf16*)(A.ws + WS_W2T);
    constexpr int I_IN = NL * 16 * 64, I_OUT = NL * 16 * 16, I_E = 16 * 44, I_MOE = NL * NE * 3 * I_E;
    for (int it = gw; it < I_IN + I_OUT + I_MOE; it += ngw) {
        int r = it;
        if (r < I_IN) { const int l = r / 1024, t = r % 1024, kb = t / 64, nb = t % 64;
            cvt_tile(A.in[I_WIN] + (size_t)l * DM * INW, INW, INW, kb * 64, nb * 64, wtin + (size_t)l * ZLD * DM, DM, (size_t)nb * 64, scr, lane); continue; }
        r -= I_IN;
        if (r < I_OUT) { const int l = r / 256, t = r % 256, kb = t / 16, nb = t % 16;
            cvt_tile(A.in[I_WOUT] + (size_t)l * DM * DM, DM, DM, kb * 64, nb * 64, wtout + (size_t)l * DM * DM, DM, (size_t)nb * 64, scr, lane); continue; }
        r -= I_OUT;
        const int le = r / (3 * I_E), q = r % (3 * I_E), which = q / I_E, t = q % I_E;
        if (which < 2) { const int kb = t / 44, nb = t % 44, n0 = nb * 64;
            cvt_tile(A.in[which == 0 ? I_EW1 : I_EW3] + (size_t)le * DM * FF, FF, FF, kb * 64, n0, w13 + (size_t)le * 5632 * DM, DM, (size_t)((n0 >> 7) * 256 + which * 128 + (n0 & 127)), scr, lane); }
        else { const int kb = t / 16, nb = t % 16;
            cvt_tile(A.in[I_EW2] + (size_t)le * FF * DM, DM, DM, kb * 64, nb * 64, w2t + (size_t)le * DM * FF, FF, (size_t)nb * 64, scr, lane); }
    }
}

DI void load_row(const float* xrow, int lane, f32x4 (&v)[4]) {
    const f32x4* xr = (const f32x4*)xrow + lane;
#pragma unroll
    for (int j = 0; j < 4; ++j) v[j] = xr[64 * j];
}
DI void add_slots(const Args& A, int tok, int lane, f32x4 (&v)[4]) {
    const int* sel = (const int*)(A.ws + WS_SEL); const bf16* ys = (const bf16*)(A.ws + WS_YS);
    const int b = tok / SEQ; const int mys = (lane < NE) ? sel[(size_t)tok * NE + lane] : -1;
    for (int e = 0; e < NE; ++e) { const int r = __shfl(mys, e);
        if (r >= 0) { const uint2* p = (const uint2*)(ys + (size_t)((e * NB + b) * CAP + r) * DM) + lane;
#pragma unroll
            for (int j = 0; j < 4; ++j) { const uint2 w = p[64 * j]; v[j][0] += __uint_as_float(w.x << 16); v[j][1] += __uint_as_float(w.x & 0xffff0000u); v[j][2] += __uint_as_float(w.y << 16); v[j][3] += __uint_as_float(w.y & 0xffff0000u); } } }
}
DI float row_rstd(const f32x4 (&v)[4]) {
    float s = 0.f;
#pragma unroll
    for (int j = 0; j < 4; ++j) s += (v[j][0] * v[j][0] + v[j][1] * v[j][1]) + (v[j][2] * v[j][2] + v[j][3] * v[j][3]);
    return rsqrtf(wave_sum(s) * (1.f / DM) + RMS_EPS);
}
DI void phase_ln1(const Args& A, int l, int gw, int ngw, int lane) {
    const float* xin = (l == 0) ? A.in[I_X] : (const float*)(A.ws + WS_X1); float* x2 = (float*)(A.ws + WS_X2); bf16* hb = (bf16*)(A.ws + WS_HB);
    const f32x4* g = (const f32x4*)(A.in[I_LN1G] + (size_t)l * DM) + lane;
    for (int tok = gw; tok < NT; tok += ngw) {
        f32x4 v[4]; load_row(xin + (size_t)tok * DM, lane, v);
        if (l > 0) { add_slots(A, tok, lane, v); f32x4* o = (f32x4*)(x2 + (size_t)tok * DM) + lane;
#pragma unroll
            for (int j = 0; j < 4; ++j) o[64 * j] = v[j]; }
        const float rs = row_rstd(v); uint2* o8 = (uint2*)(hb + (size_t)tok * DM) + lane;
#pragma unroll
        for (int j = 0; j < 4; ++j) { const f32x4 gg = g[64 * j]; uint2 w; w.x = pk2(v[j][0] * rs * gg[0], v[j][1] * rs * gg[1]); w.y = pk2(v[j][2] * rs * gg[2], v[j][3] * rs * gg[3]); o8[64 * j] = w; }
    }
}
DI void phase_final(const Args& A, int gw, int ngw, int lane) {
    const float* xin = (const float*)(A.ws + WS_X1); const f32x4* g = (const f32x4*)A.in[I_FG] + lane;
    for (int tok = gw; tok < NT; tok += ngw) {
        f32x4 v[4]; load_row(xin + (size_t)tok * DM, lane, v); add_slots(A, tok, lane, v);
        const float rs = row_rstd(v); f32x4* o = (f32x4*)(A.out + (size_t)tok * DM) + lane;
#pragma unroll
        for (int j = 0; j < 4; ++j) o[64 * j] = v[j] * rs * g[64 * j];
    }
}
DI void phase_ln2(const Args& A, int l, int gw, int ngw, int lane) {
    const float* xin = (const float*)(A.ws + WS_X1); bf16* hb = (bf16*)(A.ws + WS_HB); float* aff = (float*)(A.ws + WS_AFF);
    const f32x4* g = (const f32x4*)(A.in[I_LN2G] + (size_t)l * DM) + lane; const float* router = A.in[I_ROUTER] + (size_t)l * DM * NE;
    for (int tok = gw; tok < NT; tok += ngw) {
        f32x4 v[4]; load_row(xin + (size_t)tok * DM, lane, v);
        const float rs = row_rstd(v); uint2* o8 = (uint2*)(hb + (size_t)tok * DM) + lane;
        float lg[NE];
#pragma unroll
        for (int e = 0; e < NE; ++e) lg[e] = 0.f;
#pragma unroll
        for (int j = 0; j < 4; ++j) { const f32x4 gg = g[64 * j]; f32x4 h; h[0] = v[j][0] * rs * gg[0]; h[1] = v[j][1] * rs * gg[1]; h[2] = v[j][2] * rs * gg[2]; h[3] = v[j][3] * rs * gg[3];
            uint2 w; w.x = pk2(h[0], h[1]); w.y = pk2(h[2], h[3]); o8[64 * j] = w;
#pragma unroll
            for (int i = 0; i < 4; ++i) { const f32x4* R = (const f32x4*)(router + (size_t)(256 * j + 4 * lane + i) * NE);
#pragma unroll
                for (int q = 0; q < 4; ++q) { const f32x4 rr = R[q]; lg[4 * q + 0] += h[i] * rr[0]; lg[4 * q + 1] += h[i] * rr[1]; lg[4 * q + 2] += h[i] * rr[2]; lg[4 * q + 3] += h[i] * rr[3]; } } }
        float mx = -3.0e38f;
#pragma unroll
        for (int e = 0; e < NE; ++e) { lg[e] = wave_sum(lg[e]); mx = fmaxf(mx, lg[e]); }
        float sum = 0.f;
#pragma unroll
        for (int e = 0; e < NE; ++e) { lg[e] = expf(lg[e] - mx); sum += lg[e]; }
        const float inv = 1.f / sum;
#pragma unroll
        for (int e = 0; e < NE; ++e) if (lane == e) aff[(size_t)tok * NE + e] = lg[e] * inv;
    }
}
DI void phase_topk(const Args& A, LAS unsigned char* lds, int bid, int G, int tid, int wave, int lane) {
    const float* aff = (const float*)(A.ws + WS_AFF); int* sel = (int*)(A.ws + WS_SEL); float* gate = (float*)(A.ws + WS_GATE);
    const bf16* hb = (const bf16*)(A.ws + WS_HB); bf16* xg = (bf16*)(A.ws + WS_XG);
    LAS float* vals = (LAS float*)lds; LAS int* list = (LAS int*)(lds + 8192);
    for (int u = bid; u < NB * NE * 2; u += G) {
        const int half = u & 1, e = (u >> 1) % NE, b = u / (2 * NE);
        __syncthreads();
        for (int s = tid; s < SEQ; s += NTHR) vals[s] = aff[(size_t)(b * SEQ + s) * NE + e];
        if (tid < CAP) list[tid] = -1;
        __syncthreads();
        const int s0 = half * 1024 + tid * 2; const float v0 = vals[s0], v1 = vals[s0 + 1]; int c0 = 0, c1 = 0;
        for (int sp = 0; sp < SEQ; sp += 4) { const f32x4 q = *(const LAS f32x4*)(vals + sp);
#pragma unroll
            for (int i = 0; i < 4; ++i) { const float vp = q[i]; const int s = sp + i;
                c0 += (vp > v0 || (vp == v0 && s < s0)) ? 1 : 0; c1 += (vp > v1 || (vp == v1 && s < s0 + 1)) ? 1 : 0; } }
        const int slot0 = (e * NB + b) * CAP;
        if (c0 < CAP) { list[c0] = s0; gate[slot0 + c0] = v0; }
        if (c1 < CAP) { list[c1] = s0 + 1; gate[slot0 + c1] = v1; }
        sel[(size_t)(b * SEQ + s0) * NE + e] = c0 < CAP ? c0 : -1;
        sel[(size_t)(b * SEQ + s0 + 1) * NE + e] = c1 < CAP ? c1 : -1;
        __syncthreads();
        for (int r = wave; r < CAP; r += NWAVES) { const int s = list[r];
            if (s >= 0) { const uint4* src = (const uint4*)(hb + (size_t)(b * SEQ + s) * DM) + lane; uint4* dstp = (uint4*)(xg + (size_t)(slot0 + r) * DM) + lane; dstp[0] = src[0]; dstp[64] = src[64]; } }
    }
}

DI int t5_bucket(int rel) {
    const int ret = rel > 0 ? 16 : 0; const int n = rel < 0 ? -rel : rel;
    if (n < 8) return ret + n;
    int large = 8 + (int)(logf((float)n / 8.0f) / 4.852030263919617f * 8.0f);
    large = large < 15 ? large : 15;
    return ret + large;
}
DI void phase_attn_naive(const Args& A, LAS unsigned char* lds, int gtid, int nthr, int tid) {
    const bf16* Z = (const bf16*)(A.ws + WS_Z); bf16* ao = (bf16*)(A.ws + WS_ATTO); float* al = (float*)(A.ws + WS_ATTL);
    LAS float* btab = (LAS float*)lds;
    __syncthreads();
    for (int i = tid; i < 3 * 129 * 4; i += NTHR) { const int hh = i & 3, mi = (i >> 2) % 129, br = i / (4 * 129); const int dil = br == 0 ? 1 : (br == 1 ? 4 : 16);
        btab[i] = A.in[I_RELB][t5_bucket((mi - 64) * dil) * 4 + hh]; }
    __syncthreads();
    for (int item = gtid; item < 3 * NB * 4 * SEQ; item += nthr) {
        const int t = item % SEQ; int r = item / SEQ; const int hh = r & 3; r >>= 2; const int b = r % NB, br = r / NB; const int dil = br == 0 ? 1 : (br == 1 ? 4 : 16);
        const int tok = b * SEQ + t;
        float q[64];
        { const uint4* qp = (const uint4*)(Z + (size_t)tok * ZLD + ZA + hh * 64);
#pragma unroll
          for (int c = 0; c < 8; ++c) { float f[8]; unpack8(qp[c], f);
#pragma unroll
              for (int j = 0; j < 8; ++j) q[c * 8 + j] = f[j] * 0.125f; } }
        float o[64];
#pragma unroll
        for (int c = 0; c < 64; ++c) o[c] = 0.f;
        float mrun = -1.0e30f, lrun = 0.f;
        for (int mi = 0; mi < 129; ++mi) { const int tk = t + (mi - 64) * dil; if (tk < 0 || tk >= SEQ) continue;
            const uint4* kp = (const uint4*)(Z + (size_t)(b * SEQ + tk) * ZLD + ZA + 256 + hh * 64);
            float s = 0.f;
#pragma unroll
            for (int c = 0; c < 8; ++c) { float f[8]; unpack8(kp[c], f);
#pragma unroll
                for (int j = 0; j < 8; ++j) s += q[c * 8 + j] * f[j]; }
            s += btab[(br * 129 + mi) * 4 + hh];
            const float mn = fmaxf(mrun, s), alpha = __expf(mrun - mn), p = __expf(s - mn);
            lrun = lrun * alpha + p; mrun = mn;
            const uint4* vp = kp + 32;
#pragma unroll
            for (int c = 0; c < 8; ++c) { float f[8]; unpack8(vp[c], f);
#pragma unroll
                for (int j = 0; j < 8; ++j) o[c * 8 + j] = o[c * 8 + j] * alpha + p * f[j]; } }
        const float inv = 1.f / lrun;
        uint4* op = (uint4*)(ao + ((size_t)br * NT + tok) * AW + hh * 64);
#pragma unroll
        for (int c = 0; c < 8; ++c) { uint4 w; w.x = pk2(o[c * 8 + 0] * inv, o[c * 8 + 1] * inv); w.y = pk2(o[c * 8 + 2] * inv, o[c * 8 + 3] * inv); w.z = pk2(o[c * 8 + 4] * inv, o[c * 8 + 5] * inv); w.w = pk2(o[c * 8 + 6] * inv, o[c * 8 + 7] * inv); op[c] = w; }
        al[((size_t)br * NT + tok) * 4 + hh] = mrun + logf(lrun);
    }
}
DI void phase_rwkv_prep(const Args& A, int l, int gw, int ngw, int lane) {
    const bf16* Z = (const bf16*)(A.ws + WS_Z); float* PR = (float*)(A.ws + WS_PR); float* bonb = (float*)(A.ws + WS_RKB);
    for (int item = gw; item < 2 * NT * 6; item += ngw) {
        const int hh = item % 6; const int r0 = item / 6; const int tok = r0 % NT, dir = r0 / NT; const int t = tok % SEQ;
        const int tp = dir ? t + 1 : t - 1; const bool valid = (tp >= 0 && tp < SEQ);
        const bf16* zr = Z + (size_t)tok * ZLD; const bf16* zp = Z + (size_t)(valid ? (tok + (dir ? 1 : -1)) : tok) * ZLD;
        const float* mu = A.in[I_MU] + (size_t)(l * 2 + dir) * 1280; const int col = hh * 64 + lane;
#define MK_LERP(zc, xc) ({ const float x_ = bf2f(zr[(zc)]); const float xp_ = valid ? bf2f(zp[(zc)]) : 0.f; x_ + mu[(xc)] * (xp_ - x_); })
        const float r_ = MK_LERP(ZRKV + col, col), k_ = MK_LERP(ZRKV + 384 + col, 384 + col), v_ = MK_LERP(ZRKV + 768 + col, 768 + col);
        const float wd_ = MK_LERP((dir ? ZWDB : ZWDF) + lane, 1152 + lane), ad_ = MK_LERP((dir ? ZADB : ZADF) + lane, 1216 + lane);
#undef MK_LERP
        const float th = tanhf(wd_);
        const float* w2 = A.in[I_W2] + (size_t)(l * 2 + dir) * 64 * RW + col; const float* a2 = A.in[I_A2] + (size_t)(l * 2 + dir) * 64 * RW + col;
        float wsum = 0.f, asum = 0.f;
        for (int i = 0; i < 64; ++i) { wsum += __shfl(th, i) * w2[(size_t)i * RW]; asum += __shfl(ad_, i) * a2[(size_t)i * RW]; }
        const float x = A.in[I_W0][(size_t)(l * 2 + dir) * RW + col] + wsum;
        const float nx = -x; const float sp = fmaxf(nx, 0.f) + log1pf(expf(-fabsf(nx)));
        const float wlog = -sp - 0.5f; const float decay = expf(-expf(wlog));
        const float a = 1.f / (1.f + expf(-(A.in[I_A0][(size_t)(l * 2 + dir) * RW + col] + asum)));
        const float kk = k_ * A.in[I_KK][(size_t)l * RW + col]; const float k2 = k_ * (1.f + (a - 1.f) * A.in[I_KA][(size_t)l * RW + col]);
        const float nrm = sqrtf(wave_sum(kk * kk)); const float kkn = kk / fmaxf(nrm, 1e-12f);
        const float bs = wave_sum(r_ * k2 * A.in[I_RK][(size_t)(l * 6 + hh) * 64 + lane]);
        float* p = PR + ((size_t)(dir * NT + tok) * 6) * RW + col;
        p[0] = r_; p[RW] = decay; p[2 * RW] = k2; p[3 * RW] = v_; p[4 * RW] = kkn; p[5 * RW] = a;
        bonb[(size_t)(dir * NT + tok) * RW + col] = bs * v_;
    }
}
DI void phase_mlstm_conv(const Args& A, int l, int gtid, int nthr) {
    const bf16* Z = (const bf16*)(A.ws + WS_Z); float* qk = (float*)(A.ws + WS_MLQK);
    const float* cw = A.in[I_CW] + (size_t)l * 5 * 768; const float* cb = A.in[I_CB] + (size_t)l * 768;
    for (int idx = gtid; idx < NT * 768; idx += nthr) { const int c = idx % 768, tok = idx / 768, t = tok % SEQ;
        float acc = cb[c];
#pragma unroll
        for (int j = 0; j < 5; ++j) { const int tt = t + j - 2; if (tt >= 0 && tt < SEQ) acc += cw[j * 768 + c] * bf2f(Z[(size_t)(tok + j - 2) * ZLD + ZMQK + c]); }
        float y = acc / (1.f + expf(-acc)); if (c >= 384) y *= 0.10206207261596575f;
        qk[idx] = y; }
}
DI void rwkv_scan_unit(const Args& A, int u, int wave, int lane) {
    const float* PR = (const float*)(A.ws + WS_PR); float* yb = (float*)(A.ws + WS_RKY);
    const int dir = u / 48, rem = u % 48, b = rem / 6, hh = rem % 6; const int row = wave * 8 + (lane >> 3), kq = lane & 7;
    float s[8];
#pragma unroll
    for (int j = 0; j < 8; ++j) s[j] = 0.f;
    const float* base = PR + ((size_t)dir * NT * 6) * RW + hh * 64;
    f32x4 n_r[2], n_w[2], n_k[2], n_kk[2], n_a[2]; float n_v;
#define MK_LOADSTEP(i_) do { const int t_ = dir ? SEQ - 1 - (i_) : (i_); const float* p_ = base + (size_t)(b * SEQ + t_) * 6 * RW; const f32x4* q_ = (const f32x4*)(p_ + kq * 8); \
        n_r[0] = q_[0]; n_r[1] = q_[1]; n_w[0] = q_[RW / 4]; n_w[1] = q_[RW / 4 + 1]; n_k[0] = q_[2 * RW / 4]; n_k[1] = q_[2 * RW / 4 + 1]; n_v = p_[3 * RW + row]; \
        n_kk[0] = q_[4 * RW / 4]; n_kk[1] = q_[4 * RW / 4 + 1]; n_a[0] = q_[5 * RW / 4]; n_a[1] = q_[5 * RW / 4 + 1]; } while (0)
    MK_LOADSTEP(0);
    for (int i = 0; i < SEQ; ++i) {
        const f32x4 c_r0 = n_r[0], c_r1 = n_r[1], c_w0 = n_w[0], c_w1 = n_w[1], c_k0 = n_k[0], c_k1 = n_k[1], c_kk0 = n_kk[0], c_kk1 = n_kk[1], c_a0 = n_a[0], c_a1 = n_a[1]; const float c_v = n_v;
        if (i + 1 < SEQ) MK_LOADSTEP(i + 1);
        float sa = 0.f;
#pragma unroll
        for (int j = 0; j < 4; ++j) { sa -= s[j] * c_kk0[j]; sa -= s[4 + j] * c_kk1[j]; }
        sa += __shfl_xor(sa, 1); sa += __shfl_xor(sa, 2); sa += __shfl_xor(sa, 4);
        float y = 0.f;
#pragma unroll
        for (int j = 0; j < 4; ++j) { s[j] = s[j] * c_w0[j] + sa * (c_kk0[j] * c_a0[j]) + c_v * c_k0[j]; s[4 + j] = s[4 + j] * c_w1[j] + sa * (c_kk1[j] * c_a1[j]) + c_v * c_k1[j];
            y += s[j] * c_r0[j]; y += s[4 + j] * c_r1[j]; }
        y += __shfl_xor(y, 1); y += __shfl_xor(y, 2); y += __shfl_xor(y, 4);
        const int t = dir ? SEQ - 1 - i : i;
        if (kq == 0) yb[((size_t)dir * NT + b * SEQ + t) * RW + hh * 64 + row] = y;
    }
#undef MK_LOADSTEP
}
DI void mlstm_scan_unit(const Args& A, int l, int u, int tid) {
    const bf16* Z = (const bf16*)(A.ws + WS_Z); const float* qk = (const float*)(A.ws + WS_MLQK); float* num = (float*)(A.ws + WS_MLNUM); float* den = (float*)(A.ws + WS_MLDEN);
    const int dir = u / 32, b = (u % 32) / 4, hh = u % 4;
    if (tid >= 97 * 4) return;
    const int vcol = tid >> 2, kq = tid & 3;
    float c[24];
#pragma unroll
    for (int j = 0; j < 24; ++j) c[j] = 0.f;
    const float ibv = A.in[I_IB][(l * 2 + dir) * 4 + hh], fbv = A.in[I_FB][(l * 2 + dir) * 4 + hh];
    for (int i = 0; i < SEQ; ++i) { const int t = dir ? SEQ - 1 - i : i; const size_t tok = (size_t)b * SEQ + t;
        const float gi = bf2f(Z[tok * ZLD + ZMG + (dir * 2 + 0) * 4 + hh]) + ibv, gf = bf2f(Z[tok * ZLD + ZMG + (dir * 2 + 1) * 4 + hh]) + fbv;
        const float f = 1.f / (1.f + expf(-gf)), ii = expf(gi);
        const f32x4* qp = (const f32x4*)(qk + tok * 768 + hh * 96 + kq * 24); const f32x4* kp = (const f32x4*)(qk + tok * 768 + 384 + hh * 96 + kq * 24);
        const float vv = vcol < 96 ? bf2f(Z[tok * ZLD + ZMV + hh * 96 + vcol]) : 1.f; const float iv = ii * vv;
        float p = 0.f;
#pragma unroll
        for (int j4 = 0; j4 < 6; ++j4) { const f32x4 q4 = qp[j4], k4 = kp[j4];
#pragma unroll
            for (int j = 0; j < 4; ++j) { c[j4 * 4 + j] = f * c[j4 * 4 + j] + k4[j] * iv; p += q4[j] * c[j4 * 4 + j]; } }
        p += __shfl_xor(p, 1); p += __shfl_xor(p, 2);
        if (kq == 0) { if (vcol < 96) num[((size_t)dir * NT + tok) * MW + hh * 96 + vcol] = p; else den[((size_t)dir * NT + tok) * 4 + hh] = p; }
    }
}
DI void phase_yasm(const Args& A, int l, int gw, int ngw, int lane) {
    const bf16* Z = (const bf16*)(A.ws + WS_Z); const bf16* ao = (const bf16*)(A.ws + WS_ATTO); const float* al = (const float*)(A.ws + WS_ATTL);
    const float* rky = (const float*)(A.ws + WS_RKY); const float* rkb = (const float*)(A.ws + WS_RKB);
    const float* num = (const float*)(A.ws + WS_MLNUM); const float* den = (const float*)(A.ws + WS_MLDEN); bf16* y = (bf16*)(A.ws + WS_HB);
    const float* g2 = A.in[I_G2] + (size_t)l * 128 * RW; const float* lng = A.in[I_RLNG] + (size_t)l * RW; const float* lnb = A.in[I_RLNB] + (size_t)l * RW; const float* mlg = A.in[I_MLNG] + (size_t)l * MW;
    for (int tok = gw; tok < NT; tok += ngw) {
        const bf16* zr = Z + (size_t)tok * ZLD; bf16* yr = y + (size_t)tok * DM;
#pragma unroll
        for (int hh = 0; hh < 4; ++hh) { const int col = hh * 64 + lane;
            const float l0 = al[((size_t)0 * NT + tok) * 4 + hh], l1 = al[((size_t)1 * NT + tok) * 4 + hh], l2 = al[((size_t)2 * NT + tok) * 4 + hh];
            const float mx = fmaxf(l0, fmaxf(l1, l2)); const float w0 = __expf(l0 - mx), w1 = __expf(l1 - mx), w2 = __expf(l2 - mx);
            const float o = (w0 * bf2f(ao[((size_t)0 * NT + tok) * AW + col]) + w1 * bf2f(ao[((size_t)1 * NT + tok) * AW + col]) + w2 * bf2f(ao[((size_t)2 * NT + tok) * AW + col])) / (w0 + w1 + w2);
            yr[col] = (bf16)f2bf(o); }
        const float sg0 = sigm(bf2f(zr[ZGD + lane])), sg1 = sigm(bf2f(zr[ZGD + 64 + lane]));
        float g[6];
#pragma unroll
        for (int i = 0; i < 6; ++i) g[i] = 0.f;
        for (int j = 0; j < 128; ++j) { const float sj = (j < 64) ? __shfl(sg0, j) : __shfl(sg1, j - 64); const float* gr = g2 + (size_t)j * RW + lane;
#pragma unroll
            for (int i = 0; i < 6; ++i) g[i] += sj * gr[i * 64]; }
#pragma unroll
        for (int hh = 0; hh < 6; ++hh) { const int col = hh * 64 + lane;
            const float s = rky[((size_t)0 * NT + tok) * RW + col] + rky[((size_t)1 * NT + tok) * RW + col];
            const float mean = wave_sum(s) * (1.f / 64.f); const float d = s - mean; const float var = wave_sum(d * d) * (1.f / 64.f);
            const float yn = d * rsqrtf(var + 64e-5f) * lng[col] + lnb[col] + rkb[((size_t)0 * NT + tok) * RW + col] + rkb[((size_t)1 * NT + tok) * RW + col];
            yr[AW + col] = (bf16)f2bf(yn * g[hh]); }
#pragma unroll
        for (int hh = 0; hh < 4; ++hh) { const int c0 = hh * 96 + lane, c1 = hh * 96 + 64 + (lane & 31); const bool hi = lane < 32;
            const float df = den[((size_t)0 * NT + tok) * 4 + hh], db = den[((size_t)1 * NT + tok) * 4 + hh];
            const float invf = 1.f / fmaxf(fabsf(df), 1.f), invb = 1.f / fmaxf(fabsf(db), 1.f);
            const float a = num[((size_t)0 * NT + tok) * MW + c0] * invf + num[((size_t)1 * NT + tok) * MW + c0] * invb;
            const float bb = hi ? (num[((size_t)0 * NT + tok) * MW + c1] * invf + num[((size_t)1 * NT + tok) * MW + c1] * invb) : 0.f;
            const float mean = (wave_sum(a) + wave_sum(bb)) * (1.f / 96.f); const float da = a - mean, dbb = hi ? bb - mean : 0.f;
            const float var = (wave_sum(da * da) + wave_sum(dbb * dbb)) * (1.f / 96.f); const float rs = rsqrtf(var + 1e-6f);
            yr[AW + RW + c0] = (bf16)f2bf(da * rs * mlg[c0] * sigm(bf2f(zr[ZMO + c0])));
            if (hi) yr[AW + RW + c1] = (bf16)f2bf(dbb * rs * mlg[c1] * sigm(bf2f(zr[ZMO + c1]))); }
    }
}

constexpr int PH_PER_LAYER = 10, NPH = 1 + NL * PH_PER_LAYER + 1;
#ifndef MK_ONE_LAUNCH
#define MK_ONE_LAUNCH 1
#endif

template <int l> DI void run_layer(const Args& A, LAS unsigned char* lds, const XcdBarrier& bar, int lo, int hi, int G, int bid, int tid, int lane, int wave, int gw, int ngw, int gtid, int nthr) {
#define IN(k) (lo <= (k) && (k) < hi)
#define SEAM(k) do { if (IN(k) && IN((k) + 1)) xcd_barrier(bar); } while (0)
        const int pb = 1 + l * PH_PER_LAYER;
        if (IN(pb + 0)) { phase_ln1(A, l, gw, ngw, lane); } SEAM(pb + 0);
        if (IN(pb + 1)) {
            pg8::Gemm g{(const bf16*)(A.ws + WS_HB), (const bf16*)(A.ws + WS_WTIN) + (size_t)l * ZLD * DM, NT, ZLD, DM};
            pg8::StaticOrder S; S.init(NT, ZLD, G, bid);
            pg8::EpiBf16<0> E{(bf16*)(A.ws + WS_Z), ZLD, nullptr, 0, 0, 1.f};
            pg8::gemm_phase<pg8::EpiBf16<0>, pg8::StaticOrder, true, true>(lds, g, S, E);
        } SEAM(pb + 1);
        if (IN(pb + 2)) { phase_attn_naive(A, lds, gtid, nthr, tid); phase_rwkv_prep(A, l, gw, ngw, lane); phase_mlstm_conv(A, l, gtid, nthr); } SEAM(pb + 2);
        if (IN(pb + 3)) { for (int u = bid; u < 96 + 64; u += G) { if (u < 96) rwkv_scan_unit(A, u, wave, lane); else mlstm_scan_unit(A, l, u - 96, tid); } } SEAM(pb + 3);
        if (IN(pb + 4)) { phase_yasm(A, l, gw, ngw, lane); } SEAM(pb + 4);
        if (IN(pb + 5)) {
            pg8::Gemm g{(const bf16*)(A.ws + WS_HB), (const bf16*)(A.ws + WS_WTOUT) + (size_t)l * DM * DM, NT, DM, DM};
            pg8::StaticOrder S; S.init(NT, DM, G, bid);
            EpiResF32 E{(l == 0) ? A.in[I_X] : (const float*)(A.ws + WS_X2), (float*)(A.ws + WS_X1), DM};
            pg8::gemm_phase<EpiResF32, pg8::StaticOrder, false, true>(lds, g, S, E);
        } SEAM(pb + 5);
        if (IN(pb + 6)) { phase_ln2(A, l, gw, ngw, lane); } SEAM(pb + 6);
        if (IN(pb + 7)) { phase_topk(A, lds, bid, G, tid, wave, lane); } SEAM(pb + 7);
        if (IN(pb + 8)) {
            pg8::Gemm g{(const bf16*)(A.ws + WS_XG), (const bf16*)(A.ws + WS_W13T) + (size_t)l * NE * 5632 * DM, NSLOT, NE * 5632, DM};
            GroupOrder S; S.init(22, G, bid);
            EpiSwiGLU E{(bf16*)(A.ws + WS_ACT), 22};
            pg8::gemm_phase<EpiSwiGLU, GroupOrder, true, true>(lds, g, S, E);
        } SEAM(pb + 8);
        if (IN(pb + 9)) {
            pg8::Gemm g{(const bf16*)(A.ws + WS_ACT), (const bf16*)(A.ws + WS_W2T) + (size_t)l * NE * DM * FF, NSLOT, NE * DM, FF};
            GroupOrder S; S.init(4, G, bid);
            EpiGate E{(bf16*)(A.ws + WS_YS), (const float*)(A.ws + WS_GATE)};
            pg8::gemm_phase<EpiGate, GroupOrder, true, true>(lds, g, S, E);
        } SEAM(pb + 9);
#undef IN
#undef SEAM
}

__global__ void __launch_bounds__(NTHR, 2) mk_fwd(Args A) {
    extern __shared__ __attribute__((aligned(16))) unsigned char lds_raw[];
    LAS unsigned char* lds = (LAS unsigned char*)lds_raw;
    const int tid = threadIdx.x, lane = tid & 63, wave = __builtin_amdgcn_readfirstlane(tid >> 6);
    const int G = gridDim.x, bid = blockIdx.x;
    const int gw = bid * NWAVES + wave, ngw = G * NWAVES, gtid = bid * NTHR + tid, nthr = G * NTHR;
    volatile LAS unsigned* MISC = (volatile LAS unsigned*)(lds + MISC_OFF);
    if (tid < 64) MISC[tid] = 0u;
    __syncthreads();
    const int lo = A.ph_lo, hi = A.ph_hi;
    const bool use_bar = (hi - lo) > 1;
    XcdBarrier bar; bar.bar = (unsigned*)(A.ws + WS_CTL) + CW_BAR; bar.x = 0; bar.st = MISC + 8;
    if (use_bar) bar = xcd_barrier_post((unsigned*)(A.ws + WS_CTL) + CW_BAR, MISC + 8);
#define IN(k) (lo <= (k) && (k) < hi)
#define SEAM(k) do { if (IN(k) && IN((k) + 1)) xcd_barrier(bar); } while (0)

    if (IN(0)) { phase_p0(A, lds, gw, ngw, wave, lane); } SEAM(0);

    run_layer<0>(A, lds, bar, lo, hi, G, bid, tid, lane, wave, gw, ngw, gtid, nthr);
    run_layer<1>(A, lds, bar, lo, hi, G, bid, tid, lane, wave, gw, ngw, gtid, nthr);
    if (IN(NPH - 1)) { phase_final(A, gw, ngw, lane); }
#undef IN
#undef SEAM
}
}

extern "C" void kernel_launch(void* const* d_in, const int* in_sizes, int n_in, void* d_out, int out_size, void* d_ws, size_t ws_size, hipStream_t stream) {
    using namespace mk;
    static int grid = 0;
    if (grid == 0) {
        if (n_in != N_IN || out_size != NT * DM || ws_size < WS_END) { fprintf(stderr, "kernel_launch: unexpected shapes (n_in %d, out %d, ws %zu < %zu)\n", n_in, out_size, ws_size, (size_t)WS_END); grid = -1; return; }
        int dev = 0, cus = 0, per_cu = 0;
        if (hipGetDevice(&dev) != hipSuccess || hipDeviceGetAttribute(&cus, hipDeviceAttributeMultiprocessorCount, dev) != hipSuccess) { grid = -1; return; }
        if (hipFuncSetAttribute((const void*)mk_fwd, hipFuncAttributeMaxDynamicSharedMemorySize, LDS_BYTES) != hipSuccess) { fprintf(stderr, "kernel_launch: hipFuncSetAttribute failed\n"); grid = -1; return; }
        if (hipOccupancyMaxActiveBlocksPerMultiprocessor(&per_cu, (const void*)mk_fwd, NTHR, LDS_BYTES) != hipSuccess || per_cu < 1) fprintf(stderr, "kernel_launch: occupancy query reports %d\n", per_cu);
        (void)hipGetLastError();
        grid = cus;
    }
    if (grid < 0) return;
    hipMemsetAsync((char*)d_ws + WS_CTL, 0, CTL_ZERO_BYTES, stream);
    Args a{};
    for (int i = 0; i < N_IN; ++i) a.in[i] = (const float*)d_in[i];
    a.out = (float*)d_out; a.ws = (unsigned char*)d_ws;
#if MK_ONE_LAUNCH
    a.ph_lo = 0; a.ph_hi = NPH;
    hipLaunchKernelGGL(mk_fwd, dim3(grid), dim3(NTHR), LDS_BYTES, stream, a);
#else
    for (int p = 0; p < NPH; ++p) { a.ph_lo = p; a.ph_hi = p + 1; hipLaunchKernelGGL(mk_fwd, dim3(grid), dim3(NTHR), LDS_BYTES, stream, a); }
#endif
}
```

```cpp
#include <hip/hip_runtime.h>
#include <cstdio>
#include <cstdint>
namespace pg8 {
#define PG8_LAS __attribute__((address_space(3)))
typedef unsigned short bf16_t;
typedef short bf16x8 __attribute__((ext_vector_type(8)));
typedef float f32x4 __attribute__((ext_vector_type(4)));
typedef unsigned u32x4 __attribute__((ext_vector_type(4)));
constexpr int BM = 256, BK = 64, HALF = 128, HTB = HALF * BK * 2  , STAGE_BYTES = 8 * HTB, NXCD = 8, WGM = 8;

__host__ __device__ __forceinline__ int lds_byte(int r, int c) { const int st = (r >> 4) * 2 + (c >> 5), rr = r & 15, cc = c & 31, ob = rr * 64 + cc * 2; return st * 1024 + (ob ^ (((ob >> 9) & 1) << 5)); }
__host__ __device__ __forceinline__ void stage_rc(int b, int& R, int& C) { const int st = b / 1024, sb = b % 1024, swz = sb ^ (((sb >> 9) & 1) << 5); R = (st >> 1) * 16 + swz / 64; C = (st & 1) * 32 + (swz % 64) / 2; }
__host__ __device__ __forceinline__ int perm32(int rho) { const int n = rho >> 4, i = rho & 15; return 8 * (i >> 2) + 4 * n + (i & 3); }

struct Unit { int pm, pn; };
struct Gemm { const bf16_t* A; const bf16_t* Bt; int M, N, K; };

struct StaticOrder {
    int nM, nN, nwg, G, c;
    __host__ __device__ void init(int M, int N, int G_, int c_) { nM = M / BM; nN = N / BM; nwg = nM * nN; G = G_; c = c_; }
    __host__ __device__ bool next(int i, Unit& u) const {
        const long L = (long)i * G + c; if (L >= nwg) return false;
        int wgid = (int)L; { const int q = nwg / NXCD, r = nwg % NXCD, xcd = wgid % NXCD, off = wgid / NXCD; wgid = (xcd < r ? xcd * (q + 1) : r * (q + 1) + (xcd - r) * q) + off; }
        const int nig = WGM * nN, gid = wgid / nig, fm = gid * WGM, gsz = (nM - fm) < WGM ? (nM - fm) : WGM;
        u.pm = fm + ((wgid % nig) % gsz); u.pn = (wgid % nig) / gsz; return true;
    }
    __device__ __forceinline__ void a_ready(const Unit&) const {}
    __device__ __forceinline__ void done(const Unit&) const {}
};

__device__ __forceinline__ unsigned cvt_pk_bf16(float lo, float hi) { unsigned r; asm volatile("v_cvt_pk_bf16_f32 %0, %1, %2" : "=v"(r) : "v"(lo), "v"(hi)); return r; }
typedef float f32x2 __attribute__((ext_vector_type(2)));
__device__ __forceinline__ f32x2 gelu_pk(f32x2 v) {
    const f32x2 av = __builtin_elementwise_abs(v), d = av * 0.2316418882f + 1.0f;
    f32x2 t; t.x = __builtin_amdgcn_rcpf(d.x); t.y = __builtin_amdgcn_rcpf(d.y);
    f32x2 q = t * 0.5307027145f + (-0.7265760135f); q = q * t + 0.7107068705f; q = q * t + (-0.142248368f); q = q * t + 0.127414796f; q = q * t;
    const f32x2 s = (v * v) * (-0.72134752044f);
    f32x2 e; e.x = __builtin_amdgcn_exp2f(s.x); e.y = __builtin_amdgcn_exp2f(s.y);
    const f32x2 m = v * (q * e), r = v - m;
    f32x2 o; o.x = v.x < 0.f ? m.x : r.x; o.y = v.y < 0.f ? m.y : r.y; return o;
}

template <int ACT  > struct EpiBf16 {
    static constexpr bool PERM = true, AFTER_DRAIN = false; static_assert(ACT == 0 || ACT == 1, "EpiBf16: ACT is 0 (none) or 1 (gelu_pk)");
    bf16_t* O; int ldc; const float* bias; int split_cols; size_t split_stride; float scale0;
    __device__ __forceinline__ void operator()(const f32x4 (&acc)[2][2][4][2], const Unit& u, int wr, int wc, int fr, int fq) const {
        const int row0 = u.pm * BM + wr * 64 + fr; int colt = u.pn * BM; bf16_t* base = O;
        float sc = 1.f; if (split_cols) { const int t = colt / split_cols; base += (size_t)t * split_stride; colt -= t * split_cols; if (t == 0) sc = scale0; }
        const int col0 = colt + wc * 32 + 8 * fq, bcol0 = u.pn * BM + wc * 32 + 8 * fq;
        f32x4 bv[2][2];
#pragma unroll
        for (int bj = 0; bj < 2; ++bj)
#pragma unroll
            for (int n = 0; n < 2; ++n) bv[bj][n] = bias ? *(const f32x4*)(bias + bcol0 + bj * HALF + 4 * n) : (f32x4){0.f, 0.f, 0.f, 0.f};
#pragma unroll
        for (int ai = 0; ai < 2; ++ai)
#pragma unroll
            for (int m = 0; m < 4; ++m) { bf16_t* rowp = base + (size_t)(row0 + ai * HALF + m * 16) * ldc + col0;
#pragma unroll
                for (int bj = 0; bj < 2; ++bj) { f32x4 v0 = acc[ai][bj][m][0] + bv[bj][0], v1 = acc[ai][bj][m][1] + bv[bj][1];
                    if (ACT == 1) { f32x2 a = gelu_pk((f32x2){v0[0], v0[1]}), b = gelu_pk((f32x2){v0[2], v0[3]}), c = gelu_pk((f32x2){v1[0], v1[1]}), d = gelu_pk((f32x2){v1[2], v1[3]});
                        v0 = (f32x4){a.x, a.y, b.x, b.y}; v1 = (f32x4){c.x, c.y, d.x, d.y}; }
                    v0 = v0 * sc; v1 = v1 * sc; u32x4 w; w.x = cvt_pk_bf16(v0[0], v0[1]); w.y = cvt_pk_bf16(v0[2], v0[3]); w.z = cvt_pk_bf16(v1[0], v1[1]); w.w = cvt_pk_bf16(v1[2], v1[3]);
                    *(u32x4*)(rowp + bj * HALF) = w; } }
    }
};
template <class Epi, class Sched, bool ALIGN_EPI = false, bool SP2 = false>
__device__ __forceinline__ void gemm_phase(PG8_LAS unsigned char* lds, const Gemm g, const Sched& S, const Epi& E) {
    const int tid = threadIdx.x, wid = __builtin_amdgcn_readfirstlane(tid >> 6), lane = tid & 63, wr = wid >> 2, wc = wid & 3, fr = lane & 15, fq = lane >> 4;
    const int K = g.K, nt = K / BK;
    unsigned voffA[2], voffB[2];
#pragma unroll
    for (int i = 0; i < 2; ++i) { int R, C; stage_rc(tid * 16 + i * 8192, R, C); const int Rb = Epi::PERM ? ((R & ~31) + perm32(R & 31)) : R;
        voffA[i] = (unsigned)(R * K + C) * 2u; voffB[i] = (unsigned)(Rb * K + C) * 2u; }
    const size_t kstep = (size_t)(BK * 2);
    const size_t hstep = (size_t)HALF * K * 2;
    const size_t tstep = 2 * hstep;
    const unsigned ldsw = (unsigned)wid * 1024u;
    const int aoff = lds_byte(wr * 64 + fr, fq * 8), boff = lds_byte(wc * 32 + fr, fq * 8);
#define PG8_SA(b, h) (((b) * 2 + (h)) * HTB)
#define PG8_SB(b, h) ((4 + (b) * 2 + (h)) * HTB)
#define PG8_STAGE(bufoff, gbase, voff) do { _Pragma("unroll") for (int _i = 0; _i < 2; ++_i) \
        __builtin_amdgcn_global_load_lds((const unsigned*)((const char*)(gbase) + (voff)[_i]), (PG8_LAS unsigned*)(lds + (bufoff) + ldsw + _i * 8192), 16, 0, 0); } while (0)
#define PG8_LDA(dst, b, h) do { _Pragma("unroll") for (int m = 0; m < 4; ++m) _Pragma("unroll") for (int k = 0; k < 2; ++k) dst[m][k] = *(const PG8_LAS bf16x8*)(lds + PG8_SA(b, h) + aoff + m * 2048 + k * 1024); } while (0)
#define PG8_LDB(dst, b, h) do { _Pragma("unroll") for (int n = 0; n < 2; ++n) _Pragma("unroll") for (int k = 0; k < 2; ++k) dst[n][k] = *(const PG8_LAS bf16x8*)(lds + PG8_SB(b, h) + boff + n * 2048 + k * 1024); } while (0)
#define PG8_MMA(ai, bj, At, Bt) do { __builtin_amdgcn_s_setprio(1); _Pragma("unroll") for (int m = 0; m < 4; ++m) _Pragma("unroll") for (int n = 0; n < 2; ++n) _Pragma("unroll") for (int k = 0; k < 2; ++k) \
        acc[ai][bj][m][n] = __builtin_amdgcn_mfma_f32_16x16x32_bf16(Bt[n][k], At[m][k], acc[ai][bj][m][n], 0, 0, 0); __builtin_amdgcn_s_setprio(0); } while (0)
#define PG8_WAIT_V(n) asm volatile("s_waitcnt vmcnt(" #n ")" ::: "memory")
#define PG8_WAIT_L(n) asm volatile("s_waitcnt lgkmcnt(" #n ")" ::: "memory")
#define PG8_BAR __builtin_amdgcn_s_barrier()
#define PG8_SCHED __builtin_amdgcn_sched_barrier(0)
    Unit cur, nxt; int ui = 0;
    if (!S.next(0, cur)) return;
    f32x4 acc[2][2][4][2];
#pragma unroll
    for (int a = 0; a < 2; ++a)
#pragma unroll
        for (int b = 0; b < 2; ++b)
#pragma unroll
            for (int m = 0; m < 4; ++m)
#pragma unroll
                for (int n = 0; n < 2; ++n) acc[a][b][m][n] = (f32x4){0.f, 0.f, 0.f, 0.f};
    bf16x8 At[4][2], B0[2][2], B1[2][2];
    const char* cA = (const char*)g.A + (size_t)cur.pm * tstep; const char* cB = (const char*)g.Bt + (size_t)cur.pn * tstep;
    S.a_ready(cur);
    if constexpr (SP2) {
        PG8_STAGE(PG8_SB(0, 0), cB, voffB); PG8_STAGE(PG8_SB(0, 1), cB + hstep, voffB); PG8_STAGE(PG8_SA(0, 0), cA, voffA); PG8_STAGE(PG8_SA(0, 1), cA + hstep, voffA);
        if (wr == 1) PG8_BAR;
        PG8_WAIT_V(2); PG8_BAR;
        PG8_STAGE(PG8_SB(1, 0), cB + kstep, voffB); PG8_STAGE(PG8_SA(1, 0), cA + kstep, voffA); PG8_STAGE(PG8_SB(1, 1), cB + hstep + kstep, voffB);
        PG8_WAIT_V(6); PG8_BAR;
    } else {
        PG8_STAGE(PG8_SB(0, 0), cB, voffB); PG8_STAGE(PG8_SA(0, 0), cA, voffA); PG8_STAGE(PG8_SB(0, 1), cB + hstep, voffB); PG8_STAGE(PG8_SA(0, 1), cA + hstep, voffA);
        if (wr == 1) PG8_BAR;
        PG8_WAIT_V(4); PG8_BAR;
        PG8_STAGE(PG8_SB(1, 0), cB + kstep, voffB); PG8_STAGE(PG8_SA(1, 0), cA + kstep, voffA); PG8_STAGE(PG8_SB(1, 1), cB + hstep + kstep, voffB);
        PG8_WAIT_V(6); PG8_BAR;
    }
    for (;;) {
        const bool has_next = S.next(ui + 1, nxt);
        const char* nA = has_next ? (const char*)g.A + (size_t)nxt.pm * tstep : cA; const char* nB = has_next ? (const char*)g.Bt + (size_t)nxt.pn * tstep : cB;
        for (int t = 0; t < nt; t += 2) {
            const bool last = (t == nt - 2);
            const char* a1 = cA + (size_t)(t + 1) * kstep;
            const char* a2 = last ? nA : cA + (size_t)(t + 2) * kstep; const char* b2 = last ? nB : cB + (size_t)(t + 2) * kstep;
            const char* a3 = a2 + kstep; const char* b3 = b2 + kstep;
            if (last && has_next) S.a_ready(nxt);
            if constexpr (SP2) {
            PG8_LDB(B0, 0, 0); PG8_LDB(B1, 0, 1); PG8_SCHED; PG8_LDA(At, 0, 0); PG8_STAGE(PG8_SA(1, 1), a1 + hstep, voffA);
            PG8_WAIT_V(8); PG8_WAIT_L(0); PG8_BAR; PG8_MMA(0, 0, At, B0); PG8_MMA(0, 1, At, B1); PG8_BAR; PG8_SCHED;
            PG8_LDA(At, 0, 1); PG8_STAGE(PG8_SB(0, 0), b2, voffB); PG8_STAGE(PG8_SB(0, 1), b2 + hstep, voffB); PG8_STAGE(PG8_SA(0, 0), a2, voffA);
            PG8_WAIT_V(8); PG8_WAIT_L(0); PG8_BAR; PG8_MMA(1, 0, At, B0); PG8_MMA(1, 1, At, B1); PG8_BAR; PG8_SCHED;
            PG8_LDB(B0, 1, 0); PG8_LDB(B1, 1, 1); PG8_SCHED; PG8_LDA(At, 1, 0); PG8_STAGE(PG8_SA(0, 1), a2 + hstep, voffA);
            PG8_WAIT_V(8); PG8_WAIT_L(0); PG8_BAR; PG8_MMA(0, 0, At, B0); PG8_MMA(0, 1, At, B1); PG8_BAR; PG8_SCHED;
            PG8_LDA(At, 1, 1); PG8_STAGE(PG8_SB(1, 0), b3, voffB); PG8_STAGE(PG8_SB(1, 1), b3 + hstep, voffB); PG8_STAGE(PG8_SA(1, 0), a3, voffA);
            PG8_WAIT_V(8); PG8_WAIT_L(0); PG8_BAR; PG8_MMA(1, 0, At, B0); PG8_MMA(1, 1, At, B1); PG8_BAR; PG8_SCHED;
            } else {
            PG8_LDB(B0, 0, 0); PG8_SCHED; PG8_LDA(At, 0, 0); PG8_STAGE(PG8_SA(1, 1), a1 + hstep, voffA);
            PG8_WAIT_L(8); PG8_BAR; PG8_WAIT_L(0); PG8_MMA(0, 0, At, B0); PG8_BAR; PG8_SCHED;
            PG8_LDB(B1, 0, 1); PG8_STAGE(PG8_SB(0, 0), b2, voffB);
            PG8_BAR; PG8_WAIT_L(0); PG8_MMA(0, 1, At, B1); PG8_BAR;
            PG8_LDA(At, 0, 1); PG8_STAGE(PG8_SA(0, 0), a2, voffA);
            PG8_BAR; PG8_WAIT_L(0); PG8_MMA(1, 0, At, B0); PG8_BAR; PG8_SCHED;
            PG8_STAGE(PG8_SB(0, 1), b2 + hstep, voffB);
            PG8_WAIT_V(6); PG8_BAR; PG8_MMA(1, 1, At, B1); PG8_BAR;
            PG8_LDB(B0, 1, 0); PG8_SCHED; PG8_LDA(At, 1, 0); PG8_STAGE(PG8_SA(0, 1), a2 + hstep, voffA);
            PG8_WAIT_L(8); PG8_BAR; PG8_WAIT_L(0); PG8_MMA(0, 0, At, B0); PG8_BAR; PG8_SCHED;
            PG8_LDB(B1, 1, 1); PG8_STAGE(PG8_SB(1, 0), b3, voffB);
            PG8_BAR; PG8_WAIT_L(0); PG8_MMA(0, 1, At, B1); PG8_BAR;
            PG8_LDA(At, 1, 1); PG8_STAGE(PG8_SA(1, 0), a3, voffA);
            PG8_BAR; PG8_WAIT_L(0); PG8_MMA(1, 0, At, B0); PG8_BAR; PG8_SCHED;
            PG8_STAGE(PG8_SB(1, 1), b3 + hstep, voffB);
            PG8_WAIT_V(6); PG8_BAR; PG8_MMA(1, 1, At, B1); PG8_BAR;
            }
        }
        if constexpr (ALIGN_EPI) { if (wr == 0) PG8_BAR; }
        if constexpr (!Epi::AFTER_DRAIN) { E(acc, cur, wr, wc, fr, fq); S.done(cur); }
        if (!has_next) break;
#pragma unroll
        for (int a = 0; a < 2; ++a)
#pragma unroll
            for (int b = 0; b < 2; ++b)
#pragma unroll
                for (int m = 0; m < 4; ++m)
#pragma unroll
                    for (int n = 0; n < 2; ++n) acc[a][b][m][n] = (f32x4){0.f, 0.f, 0.f, 0.f};
        cur = nxt; cA = nA; cB = nB; ++ui;
        if constexpr (ALIGN_EPI) { if (wr == 1) PG8_BAR; }
    }
    PG8_WAIT_V(0);
    if constexpr (!ALIGN_EPI) { if (wr == 0) PG8_BAR; }
    PG8_BAR;
    if constexpr (Epi::AFTER_DRAIN) { E.fused(acc, cur, wr, wc, fr, fq, lds, wid, lane); S.done(cur); }
#undef PG8_SA
#undef PG8_SB
#undef PG8_STAGE
#undef PG8_LDA
#undef PG8_LDB
#undef PG8_MMA
#undef PG8_WAIT_V
#undef PG8_WAIT_L
#undef PG8_BAR
#undef PG8_SCHED
}
}
#define LAS __attribute__((address_space(3)))
#define XB_TMO      128
#define XB_XCNT(j)  (256  + 64 * (j))
#define XB_XSUB(j)  (1280 + 64 * (j))
#define XB_XGEN(j)  (2304 + 64 * (j))
#define XB_TOP      3328
#define XB_TOPGEN   3392
#define XCD_BAR_WORDS 3456
#define XB_SPIN_CAP (1u << 18)

__device__ __forceinline__ unsigned xb_ld(unsigned* p)              { return __hip_atomic_load(p, __ATOMIC_RELAXED, __HIP_MEMORY_SCOPE_AGENT); }
__device__ __forceinline__ unsigned xb_add(unsigned* p, unsigned v) { return __hip_atomic_fetch_add(p, v, __ATOMIC_RELAXED, __HIP_MEMORY_SCOPE_AGENT); }
__device__ __forceinline__ unsigned xb_xcc_id() { return (unsigned)__builtin_amdgcn_s_getreg((3 << 11) | 20) & 0xFu; }
#define XB_SPIN(cond, bar) do { unsigned _sp = 0; while (cond) { __builtin_amdgcn_s_sleep(1); \
    if ((++_sp & 255u) == 0u) { if (xb_ld(&(bar)[XB_TMO])) break; if (_sp > XB_SPIN_CAP) { atomicAdd(&(bar)[XB_TMO], 1u); break; } } } } while (0)

struct XcdBarrier {
    unsigned* bar; unsigned x;
    volatile LAS unsigned* st;
};

__device__ __forceinline__ XcdBarrier xcd_barrier_post(unsigned* bar, volatile LAS unsigned* st) {
    XcdBarrier b; b.bar = bar; b.x = xb_xcc_id(); b.st = st;
    if (threadIdx.x == 0) (void)xb_add(&bar[XB_XCNT(b.x)], 1u);
    return b;
}
__device__ __forceinline__ void xcd_barrier_complete(unsigned* bar, unsigned x, unsigned& nloc, unsigned& nx) {
    const unsigned G = gridDim.x * gridDim.y * gridDim.z;
    unsigned sum, cnt, mine, sp = 0u;
    for (;;) {
        sum = 0u; cnt = 0u; mine = 0u;
#pragma unroll
        for (unsigned j = 0; j < 16; ++j) { const unsigned c = xb_ld(&bar[XB_XCNT(j)]); sum += c; cnt += (c > 0u) ? 1u : 0u; mine = (j == x) ? c : mine; }
        if (sum == G) break;
        __builtin_amdgcn_s_sleep(1);
        if ((++sp & 255u) == 0u) { if (xb_ld(&bar[XB_TMO])) break; if (sp > XB_SPIN_CAP) { atomicAdd(&bar[XB_TMO], 1u); break; } }
    }
    nloc = mine > 0u ? mine : 1u; nx = cnt > 0u ? cnt : 1u;
}

__device__ __forceinline__ void xcd_barrier(const XcdBarrier& b) {
    asm volatile("s_waitcnt vmcnt(0)" ::: "memory");
    __syncthreads();
    if (threadIdx.x == 0) {
        unsigned* bar = b.bar;
        __builtin_amdgcn_s_waitcnt(0);
        unsigned nloc = b.st[0], nx = b.st[1];
        if (nloc == 0u) { xcd_barrier_complete(bar, b.x, nloc, nx); b.st[0] = nloc; b.st[1] = nx; }
        const unsigned old = xb_add(&bar[XB_XSUB(b.x)], 1u);
        const unsigned gen = old / nloc;
        if (old + 1u == (gen + 1u) * nloc) {
            __builtin_amdgcn_fence(__ATOMIC_RELEASE, "agent");
            asm volatile("s_waitcnt vmcnt(0)" ::: "memory");
            const unsigned og = xb_add(&bar[XB_TOP], 1u);
            const unsigned tg = og / nx;
            if (og + 1u == (tg + 1u) * nx) xb_add(&bar[XB_TOPGEN], 1u);
            else XB_SPIN(xb_ld(&bar[XB_TOPGEN]) == tg, bar);
            __builtin_amdgcn_fence(__ATOMIC_ACQUIRE, "agent");
            xb_add(&bar[XB_XGEN(b.x)], 1u);
            asm volatile("s_waitcnt vmcnt(0)" ::: "memory");
        } else {
            XB_SPIN(xb_ld(&bar[XB_XGEN(b.x)]) == gen, bar);
            __builtin_amdgcn_fence(__ATOMIC_ACQUIRE, "agent");
            asm volatile("s_waitcnt vmcnt(0)" ::: "memory");
        }
    }
    __syncthreads();
}

#define DI __device__ __forceinline__
#define LDS_WAIT() asm volatile("s_waitcnt lgkmcnt(0)" ::: "memory")
typedef unsigned short bf16;
typedef float f32x4 __attribute__((ext_vector_type(4)));

namespace mk {
constexpr int NB = 8, SEQ = 2048, DM = 1024, NT = NB * SEQ, NL = 2;
constexpr int INW = 3856, ZLD = 4096;
constexpr int ZA = 0, ZRKV = 768, ZWDF = 1920, ZWDB = 1984, ZADF = 2048, ZADB = 2112, ZGD = 2176, ZMQK = 2304, ZMV = 3072, ZMO = 3456, ZMG = 3840;
constexpr int RW = 384, MW = 384, AW = 256;
constexpr int NE = 16, CAP = 256, FF = 2816, NSLOT = NB * NE * CAP;
constexpr int NWAVES = 8, NTHR = 512;
constexpr float RMS_EPS = 1e-6f;

enum { I_X = 0, I_RELB, I_LN1G, I_WIN, I_WOUT, I_MU, I_W0, I_W2, I_A0, I_A2, I_KK, I_KA, I_RK, I_G2, I_RLNG, I_RLNB,
       I_CW, I_CB, I_IB, I_FB, I_MLNG, I_LN2G, I_ROUTER, I_EW1, I_EW3, I_EW2, I_FG, N_IN };

constexpr size_t MiB = 1u << 20;
constexpr size_t WS_CTL = 0, CTL_ZERO_BYTES = 1 * MiB;
constexpr size_t WS_WTIN = 2 * MiB;
constexpr size_t WS_WTOUT = 18 * MiB;
constexpr size_t WS_W13T = 22 * MiB;
constexpr size_t WS_W2T = 374 * MiB;
constexpr size_t WS_X1 = 550 * MiB;
constexpr size_t WS_X2 = 614 * MiB;
constexpr size_t WS_HB = 678 * MiB;
constexpr size_t WS_AFF = 710 * MiB;
constexpr size_t WS_SEL = 711 * MiB;
constexpr size_t WS_GATE = 712 * MiB;
constexpr size_t WS_R = 714 * MiB;
constexpr size_t WS_Z = WS_R;
constexpr size_t WS_ATTO = WS_R + 128 * MiB;
constexpr size_t WS_ATTL = WS_R + 152 * MiB;
constexpr size_t WS_PR = WS_R + 154 * MiB;
constexpr size_t WS_RKY = WS_R + 442 * MiB;
constexpr size_t WS_RKB = WS_R + 490 * MiB;
constexpr size_t WS_MLQK = WS_R + 538 * MiB;
constexpr size_t WS_MLNUM = WS_R + 586 * MiB;
constexpr size_t WS_MLDEN = WS_R + 634 * MiB;
constexpr size_t WS_XG = WS_R;
constexpr size_t WS_ACT = WS_R + 64 * MiB;
constexpr size_t WS_YS = WS_R + 240 * MiB;
constexpr size_t WS_END = WS_R + 636 * MiB;

constexpr int CW_BAR = 4096;
constexpr int LDS_BYTES = 147456;
constexpr int MISC_OFF = LDS_BYTES - 256;

struct Args { const float* in[N_IN]; float* out; unsigned char* ws; int ph_lo, ph_hi; };

DI float bf2f(unsigned v) { return __uint_as_float(v << 16); }
DI unsigned f2bf(float f) { unsigned u = __float_as_uint(f); return (u + 0x7fffu + ((u >> 16) & 1u)) >> 16; }
DI unsigned pk2(float lo, float hi) { return f2bf(lo) | (f2bf(hi) << 16); }
DI float wave_sum(float v) {
#pragma unroll
    for (int o = 1; o < 64; o <<= 1) v += __shfl_xor(v, o);
    return v;
}
DI float sigm(float x) { return 1.f / (1.f + __expf(-x)); }
DI void unpack8(const uint4 w, float (&f)[8]) {
    f[0] = __uint_as_float(w.x << 16); f[1] = __uint_as_float(w.x & 0xffff0000u); f[2] = __uint_as_float(w.y << 16); f[3] = __uint_as_float(w.y & 0xffff0000u);
    f[4] = __uint_as_float(w.z << 16); f[5] = __uint_as_float(w.z & 0xffff0000u); f[6] = __uint_as_float(w.w << 16); f[7] = __uint_as_float(w.w & 0xffff0000u);
}

struct GroupOrder {
    int G, c2, nunits, per_e, nN;
    DI void init(int nN_, int G_, int bid) { nN = nN_; per_e = 8 * nN_; nunits = NE * per_e; G = G_; c2 = (G_ % 8 == 0) ? (bid % 8) * (G_ / 8) + bid / 8 : bid; }
    DI bool next(int i, pg8::Unit& u) const {
        const long L = (long)i * G + c2; if (L >= nunits) return false;
        const int e = (int)L / per_e, r = (int)L % per_e; u.pm = e * 8 + (r & 7); u.pn = e * nN + (r >> 3); return true;
    }
    DI void a_ready(const pg8::Unit&) const {}
    DI void done(const pg8::Unit&) const {}
};
struct EpiResF32 {
    static constexpr bool PERM = false, AFTER_DRAIN = false;
    const float* base; float* out; int ldc;
    DI void operator()(const pg8::f32x4 (&acc)[2][2][4][2], const pg8::Unit& u, int wr, int wc, int fr, int fq) const {
        const int row0 = u.pm * 256 + wr * 64 + fr, col0 = u.pn * 256 + wc * 32 + 4 * fq;
#pragma unroll
        for (int ai = 0; ai < 2; ++ai)
#pragma unroll
            for (int m = 0; m < 4; ++m) { const size_t off = (size_t)(row0 + ai * 128 + m * 16) * ldc + col0;
#pragma unroll
                for (int bj = 0; bj < 2; ++bj)
#pragma unroll
                    for (int n = 0; n < 2; ++n) { const pg8::f32x4 b = *(const pg8::f32x4*)(base + off + bj * 128 + n * 16); *(pg8::f32x4*)(out + off + bj * 128 + n * 16) = b + acc[ai][bj][m][n]; } }
    }
};
DI float silu_f(float x) { return x * __builtin_amdgcn_rcpf(1.f + __expf(-x)); }
struct EpiSwiGLU {
    static constexpr bool PERM = true, AFTER_DRAIN = false;
    bf16* act; int nN;
    DI void operator()(const pg8::f32x4 (&acc)[2][2][4][2], const pg8::Unit& u, int wr, int wc, int fr, int fq) const {
        const int lpn = u.pn % nN; const int row0 = u.pm * 256 + wr * 64 + fr, col0 = lpn * 128 + wc * 32 + 8 * fq;
#pragma unroll
        for (int ai = 0; ai < 2; ++ai)
#pragma unroll
            for (int m = 0; m < 4; ++m) { bf16* p = act + (size_t)(row0 + ai * 128 + m * 16) * FF + col0;
                const pg8::f32x4 a0 = acc[ai][0][m][0], a1 = acc[ai][0][m][1], g0 = acc[ai][1][m][0], g1 = acc[ai][1][m][1];
                pg8::u32x4 w;
                w.x = pg8::cvt_pk_bf16(silu_f(a0[0]) * g0[0], silu_f(a0[1]) * g0[1]); w.y = pg8::cvt_pk_bf16(silu_f(a0[2]) * g0[2], silu_f(a0[3]) * g0[3]);
                w.z = pg8::cvt_pk_bf16(silu_f(a1[0]) * g1[0], silu_f(a1[1]) * g1[1]); w.w = pg8::cvt_pk_bf16(silu_f(a1[2]) * g1[2], silu_f(a1[3]) * g1[3]);
                *(pg8::u32x4*)p = w; }
    }
};
struct EpiGate {
    static constexpr bool PERM = true, AFTER_DRAIN = false;
    bf16* ys; const float* gate;
    DI void operator()(const pg8::f32x4 (&acc)[2][2][4][2], const pg8::Unit& u, int wr, int wc, int fr, int fq) const {
        const int row0 = u.pm * 256 + wr * 64 + fr, col0 = (u.pn & 3) * 256 + wc * 32 + 8 * fq;
#pragma unroll
        for (int ai = 0; ai < 2; ++ai)
#pragma unroll
            for (int m = 0; m < 4; ++m) { const int row = row0 + ai * 128 + m * 16; const float g = gate[row]; bf16* p = ys + (size_t)row * DM + col0;
#pragma unroll
                for (int bj = 0; bj < 2; ++bj) { const pg8::f32x4 v0 = acc[ai][bj][m][0] * g, v1 = acc[ai][bj][m][1] * g; pg8::u32x4 w;
                    w.x = pg8::cvt_pk_bf16(v0[0], v0[1]); w.y = pg8::cvt_pk_bf16(v0[2], v0[3]); w.z = pg8::cvt_pk_bf16(v1[0], v1[1]); w.w = pg8::cvt_pk_bf16(v1[2], v1[3]);
                    *(pg8::u32x4*)(p + bj * 128) = w; } }
    }
};

DI void cvt_tile(const float* W, int N, int nvalid, int k0, int n0, bf16* dst, int Kd, size_t drow0, LAS float* scr, int lane) {
    const int c4 = (lane & 15) * 4, kr = lane >> 4;
#pragma unroll
    for (int it = 0; it < 16; ++it) { const int k = it * 4 + kr; float4 v = make_float4(0.f, 0.f, 0.f, 0.f);
        if (n0 + c4 < nvalid) v = *(const float4*)(W + (size_t)(k0 + k) * N + n0 + c4);
        LAS float* s = scr + k * 65 + c4; s[0] = v.x; s[1] = v.y; s[2] = v.z; s[3] = v.w; }
    LDS_WAIT(); asm volatile("" ::: "memory");
    const int c = lane & 7;
#pragma unroll
    for (int it = 0; it < 8; ++it) { const int n = it * 8 + (lane >> 3); const LAS float* s = scr + (8 * c) * 65 + n;
        uint4 o; o.x = pk2(s[0], s[65]); o.y = pk2(s[130], s[195]); o.z = pk2(s[260], s[325]); o.w = pk2(s[390], s[455]);
        *(uint4*)(dst + (drow0 + n) * (size_t)Kd + k0 + 8 * c) = o; }
    LDS_WAIT(); asm volatile("" ::: "memory");
}
DI void phase_p0(const Args& A, LAS unsigned char* lds, int gw, int ngw, int wave, int lane) {
    LAS float* scr = (LAS float*)(lds + wave * 16640);
    bf16* wtin = (bf16*)(A.ws + WS_WTIN); bf16* wtout = (bf16*)(A.ws + WS_WTOUT); bf16* w13 = (bf16*)(A.ws + WS_W13T); bf16* w2t = (bf16*)(A.ws + WS_W2T);
    constexpr int I_IN = NL * 16 * 64, I_OUT = NL * 16 * 16, I_E = 16 * 44, I_MOE = NL * NE * 3 * I_E;
    for (int it = gw; it < I_IN + I_OUT + I_MOE; it += ngw) {
        int r = it;
        if (r < I_IN) { const int l = r / 1024, t = r % 1024, kb = t / 64, nb = t % 64;
            cvt_tile(A.in[I_WIN] + (size_t)l * DM * INW, INW, INW, kb * 64, nb * 64, wtin + (size_t)l * ZLD * DM, DM, (size_t)nb * 64, scr, lane); continue; }
        r -= I_IN;
        if (r < I_OUT) { const int l = r / 256, t = r % 256, kb = t / 16, nb = t % 16;
            cvt_tile(A.in[I_WOUT] + (size_t)l * DM * DM, DM, DM, kb * 64, nb * 64, wtout + (size_t)l * DM * DM, DM, (size_t)nb * 64, scr, lane); continue; }
        r -= I_OUT;
        const int le = r / (3 * I_E), q = r % (3 * I_E), which = q / I_E, t = q % I_E;
        if (which < 2) { const int kb = t / 44, nb = t % 44, n0 = nb * 64;
            cvt_tile(A.in[which == 0 ? I_EW1 : I_EW3] + (size_t)le * DM * FF, FF, FF, kb * 64, n0, w13 + (size_t)le * 5632 * DM, DM, (size_t)((n0 >> 7) * 256 + which * 128 + (n0 & 127)), scr, lane); }
        else { const int kb = t / 16, nb = t % 16;
            cvt_tile(A.in[I_EW2] + (size_t)le * FF * DM, DM, DM, kb * 64, nb * 64, w2t + (size_t)le * DM * FF, FF, (size_t)nb * 64, scr, lane); }
    }
}

DI void load_row(const float* xrow, int lane, f32x4 (&v)[4]) {
    const f32x4* xr = (const f32x4*)xrow + lane;
#pragma unroll
    for (int j = 0; j < 4; ++j) v[j] = xr[64 * j];
}
DI void add_slots(const Args& A, int tok, int lane, f32x4 (&v)[4]) {
    const int* sel = (const int*)(A.ws + WS_SEL); const bf16* ys = (const bf16*)(A.ws + WS_YS);
    const int b = tok / SEQ; const int mys = (lane < NE) ? sel[(size_t)tok * NE + lane] : -1;
    for (int e = 0; e < NE; ++e) { const int r = __shfl(mys, e);
        if (r >= 0) { const uint2* p = (const uint2*)(ys + (size_t)((e * NB + b) * CAP + r) * DM) + lane;
#pragma unroll
            for (int j = 0; j < 4; ++j) { const uint2 w = p[64 * j]; v[j][0] += __uint_as_float(w.x << 16); v[j][1] += __uint_as_float(w.x & 0xffff0000u); v[j][2] += __uint_as_float(w.y << 16); v[j][3] += __uint_as_float(w.y & 0xffff0000u); } } }
}
DI float row_rstd(const f32x4 (&v)[4]) {
    float s = 0.f;
#pragma unroll
    for (int j = 0; j < 4; ++j) s += (v[j][0] * v[j][0] + v[j][1] * v[j][1]) + (v[j][2] * v[j][2] + v[j][3] * v[j][3]);
    return rsqrtf(wave_sum(s) * (1.f / DM) + RMS_EPS);
}
DI void phase_ln1(const Args& A, int l, int gw, int ngw, int lane) {
    const float* xin = (l == 0) ? A.in[I_X] : (const float*)(A.ws + WS_X1); float* x2 = (float*)(A.ws + WS_X2); bf16* hb = (bf16*)(A.ws + WS_HB);
    const f32x4* g = (const f32x4*)(A.in[I_LN1G] + (size_t)l * DM) + lane;
    for (int tok = gw; tok < NT; tok += ngw) {
        f32x4 v[4]; load_row(xin + (size_t)tok * DM, lane, v);
        if (l > 0) { add_slots(A, tok, lane, v); f32x4* o = (f32x4*)(x2 + (size_t)tok * DM) + lane;
#pragma unroll
            for (int j = 0; j < 4; ++j) o[64 * j] = v[j]; }
        const float rs = row_rstd(v); uint2* o8 = (uint2*)(hb + (size_t)tok * DM) + lane;
#pragma unroll
        for (int j = 0; j < 4; ++j) { const f32x4 gg = g[64 * j]; uint2 w; w.x = pk2(v[j][0] * rs * gg[0], v[j][1] * rs * gg[1]); w.y = pk2(v[j][2] * rs * gg[2], v[j][3] * rs * gg[3]); o8[64 * j] = w; }
    }
}
DI void phase_final(const Args& A, int gw, int ngw, int lane) {
    const float* xin = (const float*)(A.ws + WS_X1); const f32x4* g = (const f32x4*)A.in[I_FG] + lane;
    for (int tok = gw; tok < NT; tok += ngw) {
        f32x4 v[4]; load_row(xin + (size_t)tok * DM, lane, v); add_slots(A, tok, lane, v);
        const float rs = row_rstd(v); f32x4* o = (f32x4*)(A.out + (size_t)tok * DM) + lane;
#pragma unroll
        for (int j = 0; j < 4; ++j) o[64 * j] = v[j] * rs * g[64 * j];
    }
}
DI void phase_ln2(const Args& A, int l, int gw, int ngw, int lane) {
    const float* xin = (const float*)(A.ws + WS_X1); bf16* hb = (bf16*)(A.ws + WS_HB); float* aff = (float*)(A.ws + WS_AFF);
    const f32x4* g = (const f32x4*)(A.in[I_LN2G] + (size_t)l * DM) + lane; const float* router = A.in[I_ROUTER] + (size_t)l * DM * NE;
    for (int tok = gw; tok < NT; tok += ngw) {
        f32x4 v[4]; load_row(xin + (size_t)tok * DM, lane, v);
        const float rs = row_rstd(v); uint2* o8 = (uint2*)(hb + (size_t)tok * DM) + lane;
        float lg[NE];
#pragma unroll
        for (int e = 0; e < NE; ++e) lg[e] = 0.f;
#pragma unroll
        for (int j = 0; j < 4; ++j) { const f32x4 gg = g[64 * j]; f32x4 h; h[0] = v[j][0] * rs * gg[0]; h[1] = v[j][1] * rs * gg[1]; h[2] = v[j][2] * rs * gg[2]; h[3] = v[j][3] * rs * gg[3];
            uint2 w; w.x = pk2(h[0], h[1]); w.y = pk2(h[2], h[3]); o8[64 * j] = w;
#pragma unroll
            for (int i = 0; i < 4; ++i) { const f32x4* R = (const f32x4*)(router + (size_t)(256 * j + 4 * lane + i) * NE);
#pragma unroll
                for (int q = 0; q < 4; ++q) { const f32x4 rr = R[q]; lg[4 * q + 0] += h[i] * rr[0]; lg[4 * q + 1] += h[i] * rr[1]; lg[4 * q + 2] += h[i] * rr[2]; lg[4 * q + 3] += h[i] * rr[3]; } } }
        float mx = -3.0e38f;
#pragma unroll
        for (int e = 0; e < NE; ++e) { lg[e] = wave_sum(lg[e]); mx = fmaxf(mx, lg[e]); }
        float sum = 0.f;
#pragma unroll
        for (int e = 0; e < NE; ++e) { lg[e] = expf(lg[e] - mx); sum += lg[e]; }
        const float inv = 1.f / sum;
#pragma unroll
        for (int e = 0; e < NE; ++e) if (lane == e) aff[(size_t)tok * NE + e] = lg[e] * inv;
    }
}
DI void phase_topk(const Args& A, LAS unsigned char* lds, int bid, int G, int tid, int wave, int lane) {
    const float* aff = (const float*)(A.ws + WS_AFF); int* sel = (int*)(A.ws + WS_SEL); float* gate = (float*)(A.ws + WS_GATE);
    const bf16* hb = (const bf16*)(A.ws + WS_HB); bf16* xg = (bf16*)(A.ws + WS_XG);
    LAS float* vals = (LAS float*)lds; LAS int* list = (LAS int*)(lds + 8192);
    for (int u = bid; u < NB * NE * 2; u += G) {
        const int half = u & 1, e = (u >> 1) % NE, b = u / (2 * NE);
        __syncthreads();
        for (int s = tid; s < SEQ; s += NTHR) vals[s] = aff[(size_t)(b * SEQ + s) * NE + e];
        if (tid < CAP) list[tid] = -1;
        __syncthreads();
        const int s0 = half * 1024 + tid * 2; const float v0 = vals[s0], v1 = vals[s0 + 1]; int c0 = 0, c1 = 0;
        for (int sp = 0; sp < SEQ; sp += 4) { const f32x4 q = *(const LAS f32x4*)(vals + sp);
#pragma unroll
            for (int i = 0; i < 4; ++i) { const float vp = q[i]; const int s = sp + i;
                c0 += (vp > v0 || (vp == v0 && s < s0)) ? 1 : 0; c1 += (vp > v1 || (vp == v1 && s < s0 + 1)) ? 1 : 0; } }
        const int slot0 = (e * NB + b) * CAP;
        if (c0 < CAP) { list[c0] = s0; gate[slot0 + c0] = v0; }
        if (c1 < CAP) { list[c1] = s0 + 1; gate[slot0 + c1] = v1; }
        sel[(size_t)(b * SEQ + s0) * NE + e] = c0 < CAP ? c0 : -1;
        sel[(size_t)(b * SEQ + s0 + 1) * NE + e] = c1 < CAP ? c1 : -1;
        __syncthreads();
        for (int r = wave; r < CAP; r += NWAVES) { const int s = list[r];
            if (s >= 0) { const uint4* src = (const uint4*)(hb + (size_t)(b * SEQ + s) * DM) + lane; uint4* dstp = (uint4*)(xg + (size_t)(slot0 + r) * DM) + lane; dstp[0] = src[0]; dstp[64] = src[64]; } }
    }
}

DI int t5_bucket(int rel) {
    const int ret = rel > 0 ? 16 : 0; const int n = rel < 0 ? -rel : rel;
    if (n < 8) return ret + n;
    int large = 8 + (int)(logf((float)n / 8.0f) / 4.852030263919617f * 8.0f);
    large = large < 15 ? large : 15;
    return ret + large;
}
DI void phase_attn_naive(const Args& A, LAS unsigned char* lds, int gtid, int nthr, int tid) {
    const bf16* Z = (const bf16*)(A.ws + WS_Z); bf16* ao = (bf16*)(A.ws + WS_ATTO); float* al = (float*)(A.ws + WS_ATTL);
    LAS float* btab = (LAS float*)lds;
    __syncthreads();
    for (int i = tid; i < 3 * 129 * 4; i += NTHR) { const int hh = i & 3, mi = (i >> 2) % 129, br = i / (4 * 129); const int dil = br == 0 ? 1 : (br == 1 ? 4 : 16);
        btab[i] = A.in[I_RELB][t5_bucket((mi - 64) * dil) * 4 + hh]; }
    __syncthreads();
    for (int item = gtid; item < 3 * NB * 4 * SEQ; item += nthr) {
        const int t = item % SEQ; int r = item / SEQ; const int hh = r & 3; r >>= 2; const int b = r % NB, br = r / NB; const int dil = br == 0 ? 1 : (br == 1 ? 4 : 16);
        const int tok = b * SEQ + t;
        float q[64];
        { const uint4* qp = (const uint4*)(Z + (size_t)tok * ZLD + ZA + hh * 64);
#pragma unroll
          for (int c = 0; c < 8; ++c) { float f[8]; unpack8(qp[c], f);
#pragma unroll
              for (int j = 0; j < 8; ++j) q[c * 8 + j] = f[j] * 0.125f; } }
        float o[64];
#pragma unroll
        for (int c = 0; c < 64; ++c) o[c] = 0.f;
        float mrun = -1.0e30f, lrun = 0.f;
        for (int mi = 0; mi < 129; ++mi) { const int tk = t + (mi - 64) * dil; if (tk < 0 || tk >= SEQ) continue;
            const uint4* kp = (const uint4*)(Z + (size_t)(b * SEQ + tk) * ZLD + ZA + 256 + hh * 64);
            float s = 0.f;
#pragma unroll
            for (int c = 0; c < 8; ++c) { float f[8]; unpack8(kp[c], f);
#pragma unroll
                for (int j = 0; j < 8; ++j) s += q[c * 8 + j] * f[j]; }
            s += btab[(br * 129 + mi) * 4 + hh];
            const float mn = fmaxf(mrun, s), alpha = __expf(mrun - mn), p = __expf(s - mn);
            lrun = lrun * alpha + p; mrun = mn;
            const uint4* vp = kp + 32;
#pragma unroll
            for (int c = 0; c < 8; ++c) { float f[8]; unpack8(vp[c], f);
#pragma unroll
                for (int j = 0; j < 8; ++j) o[c * 8 + j] = o[c * 8 + j] * alpha + p * f[j]; } }
        const float inv = 1.f / lrun;
        uint4* op = (uint4*)(ao + ((size_t)br * NT + tok) * AW + hh * 64);
#pragma unroll
        for (int c = 0; c < 8; ++c) { uint4 w; w.x = pk2(o[c * 8 + 0] * inv, o[c * 8 + 1] * inv); w.y = pk2(o[c * 8 + 2] * inv, o[c * 8 + 3] * inv); w.z = pk2(o[c * 8 + 4] * inv, o[c * 8 + 5] * inv); w.w = pk2(o[c * 8 + 6] * inv, o[c * 8 + 7] * inv); op[c] = w; }
        al[((size_t)br * NT + tok) * 4 + hh] = mrun + logf(lrun);
    }
}
DI void phase_rwkv_prep(const Args& A, int l, int gw, int ngw, int lane) {
    const bf16* Z = (const bf16*)(A.ws + WS_Z); float* PR = (float*)(A.ws + WS_PR); float* bonb = (float*)(A.ws + WS_RKB);
    for (int item = gw; item < 2 * NT * 6; item += ngw) {
        const int hh = item % 6; const int r0 = item / 6; const int tok = r0 % NT, dir = r0 / NT; const int t = tok % SEQ;
        const int tp = dir ? t + 1 : t - 1; const bool valid = (tp >= 0 && tp < SEQ);
        const bf16* zr = Z + (size_t)tok * ZLD; const bf16* zp = Z + (size_t)(valid ? (tok + (dir ? 1 : -1)) : tok) * ZLD;
        const float* mu = A.in[I_MU] + (size_t)(l * 2 + dir) * 1280; const int col = hh * 64 + lane;
#define MK_LERP(zc, xc) ({ const float x_ = bf2f(zr[(zc)]); const float xp_ = valid ? bf2f(zp[(zc)]) : 0.f; x_ + mu[(xc)] * (xp_ - x_); })
        const float r_ = MK_LERP(ZRKV + col, col), k_ = MK_LERP(ZRKV + 384 + col, 384 + col), v_ = MK_LERP(ZRKV + 768 + col, 768 + col);
        const float wd_ = MK_LERP((dir ? ZWDB : ZWDF) + lane, 1152 + lane), ad_ = MK_LERP((dir ? ZADB : ZADF) + lane, 1216 + lane);
#undef MK_LERP
        const float th = tanhf(wd_);
        const float* w2 = A.in[I_W2] + (size_t)(l * 2 + dir) * 64 * RW + col; const float* a2 = A.in[I_A2] + (size_t)(l * 2 + dir) * 64 * RW + col;
        float wsum = 0.f, asum = 0.f;
        for (int i = 0; i < 64; ++i) { wsum += __shfl(th, i) * w2[(size_t)i * RW]; asum += __shfl(ad_, i) * a2[(size_t)i * RW]; }
        const float x = A.in[I_W0][(size_t)(l * 2 + dir) * RW + col] + wsum;
        const float nx = -x; const float sp = fmaxf(nx, 0.f) + log1pf(expf(-fabsf(nx)));
        const float wlog = -sp - 0.5f; const float decay = expf(-expf(wlog));
        const float a = 1.f / (1.f + expf(-(A.in[I_A0][(size_t)(l * 2 + dir) * RW + col] + asum)));
        const float kk = k_ * A.in[I_KK][(size_t)l * RW + col]; const float k2 = k_ * (1.f + (a - 1.f) * A.in[I_KA][(size_t)l * RW + col]);
        const float nrm = sqrtf(wave_sum(kk * kk)); const float kkn = kk / fmaxf(nrm, 1e-12f);
        const float bs = wave_sum(r_ * k2 * A.in[I_RK][(size_t)(l * 6 + hh) * 64 + lane]);
        float* p = PR + ((size_t)(dir * NT + tok) * 6) * RW + col;
        p[0] = r_; p[RW] = decay; p[2 * RW] = k2; p[3 * RW] = v_; p[4 * RW] = kkn; p[5 * RW] = a;
        bonb[(size_t)(dir * NT + tok) * RW + col] = bs * v_;
    }
}
DI void phase_mlstm_conv(const Args& A, int l, int gtid, int nthr) {
    const bf16* Z = (const bf16*)(A.ws + WS_Z); float* qk = (float*)(A.ws + WS_MLQK);
    const float* cw = A.in[I_CW] + (size_t)l * 5 * 768; const float* cb = A.in[I_CB] + (size_t)l * 768;
    for (int idx = gtid; idx < NT * 768; idx += nthr) { const int c = idx % 768, tok = idx / 768, t = tok % SEQ;
        float acc = cb[c];
#pragma unroll
        for (int j = 0; j < 5; ++j) { const int tt = t + j - 2; if (tt >= 0 && tt < SEQ) acc += cw[j * 768 + c] * bf2f(Z[(size_t)(tok + j - 2) * ZLD + ZMQK + c]); }
        float y = acc / (1.f + expf(-acc)); if (c >= 384) y *= 0.10206207261596575f;
        qk[idx] = y; }
}
DI void rwkv_scan_unit(const Args& A, int u, int wave, int lane) {
    const float* PR = (const float*)(A.ws + WS_PR); float* yb = (float*)(A.ws + WS_RKY);
    const int dir = u / 48, rem = u % 48, b = rem / 6, hh = rem % 6; const int row = wave * 8 + (lane >> 3), kq = lane & 7;
    float s[8];
#pragma unroll
    for (int j = 0; j < 8; ++j) s[j] = 0.f;
    const float* base = PR + ((size_t)dir * NT * 6) * RW + hh * 64;
    f32x4 n_r[2], n_w[2], n_k[2], n_kk[2], n_a[2]; float n_v;
#define MK_LOADSTEP(i_) do { const int t_ = dir ? SEQ - 1 - (i_) : (i_); const float* p_ = base + (size_t)(b * SEQ + t_) * 6 * RW; const f32x4* q_ = (const f32x4*)(p_ + kq * 8); \
        n_r[0] = q_[0]; n_r[1] = q_[1]; n_w[0] = q_[RW / 4]; n_w[1] = q_[RW / 4 + 1]; n_k[0] = q_[2 * RW / 4]; n_k[1] = q_[2 * RW / 4 + 1]; n_v = p_[3 * RW + row]; \
        n_kk[0] = q_[4 * RW / 4]; n_kk[1] = q_[4 * RW / 4 + 1]; n_a[0] = q_[5 * RW / 4]; n_a[1] = q_[5 * RW / 4 + 1]; } while (0)
    MK_LOADSTEP(0);
    for (int i = 0; i < SEQ; ++i) {
        const f32x4 c_r0 = n_r[0], c_r1 = n_r[1], c_w0 = n_w[0], c_w1 = n_w[1], c_k0 = n_k[0], c_k1 = n_k[1], c_kk0 = n_kk[0], c_kk1 = n_kk[1], c_a0 = n_a[0], c_a1 = n_a[1]; const float c_v = n_v;
        if (i + 1 < SEQ) MK_LOADSTEP(i + 1);
        float sa = 0.f;
#pragma unroll
        for (int j = 0; j < 4; ++j) { sa -= s[j] * c_kk0[j]; sa -= s[4 + j] * c_kk1[j]; }
        sa += __shfl_xor(sa, 1); sa += __shfl_xor(sa, 2); sa += __shfl_xor(sa, 4);
        float y = 0.f;
#pragma unroll
        for (int j = 0; j < 4; ++j) { s[j] = s[j] * c_w0[j] + sa * (c_kk0[j] * c_a0[j]) + c_v * c_k0[j]; s[4 + j] = s[4 + j] * c_w1[j] + sa * (c_kk1[j] * c_a1[j]) + c_v * c_k1[j];
            y += s[j] * c_r0[j]; y += s[4 + j] * c_r1[j]; }
        y += __shfl_xor(y, 1); y += __shfl_xor(y, 2); y += __shfl_xor(y, 4);
        const int t = dir ? SEQ - 1 - i : i;
        if (kq == 0) yb[((size_t)dir * NT + b * SEQ + t) * RW + hh * 64 + row] = y;
    }
#undef MK_LOADSTEP
}
DI void mlstm_scan_unit(const Args& A, int l, int u, int tid) {
    const bf16* Z = (const bf16*)(A.ws + WS_Z); const float* qk = (const float*)(A.ws + WS_MLQK); float* num = (float*)(A.ws + WS_MLNUM); float* den = (float*)(A.ws + WS_MLDEN);
    const int dir = u / 32, b = (u % 32) / 4, hh = u % 4;
    if (tid >= 97 * 4) return;
    const int vcol = tid >> 2, kq = tid & 3;
    float c[24];
#pragma unroll
    for (int j = 0; j < 24; ++j) c[j] = 0.f;
    const float ibv = A.in[I_IB][(l * 2 + dir) * 4 + hh], fbv = A.in[I_FB][(l * 2 + dir) * 4 + hh];
    for (int i = 0; i < SEQ; ++i) { const int t = dir ? SEQ - 1 - i : i; const size_t tok = (size_t)b * SEQ + t;
        const float gi = bf2f(Z[tok * ZLD + ZMG + (dir * 2 + 0) * 4 + hh]) + ibv, gf = bf2f(Z[tok * ZLD + ZMG + (dir * 2 + 1) * 4 + hh]) + fbv;
        const float f = 1.f / (1.f + expf(-gf)), ii = expf(gi);
        const f32x4* qp = (const f32x4*)(qk + tok * 768 + hh * 96 + kq * 24); const f32x4* kp = (const f32x4*)(qk + tok * 768 + 384 + hh * 96 + kq * 24);
        const float vv = vcol < 96 ? bf2f(Z[tok * ZLD + ZMV + hh * 96 + vcol]) : 1.f; const float iv = ii * vv;
        float p = 0.f;
#pragma unroll
        for (int j4 = 0; j4 < 6; ++j4) { const f32x4 q4 = qp[j4], k4 = kp[j4];
#pragma unroll
            for (int j = 0; j < 4; ++j) { c[j4 * 4 + j] = f * c[j4 * 4 + j] + k4[j] * iv; p += q4[j] * c[j4 * 4 + j]; } }
        p += __shfl_xor(p, 1); p += __shfl_xor(p, 2);
        if (kq == 0) { if (vcol < 96) num[((size_t)dir * NT + tok) * MW + hh * 96 + vcol] = p; else den[((size_t)dir * NT + tok) * 4 + hh] = p; }
    }
}
DI void phase_yasm(const Args& A, int l, int gw, int ngw, int lane) {
    const bf16* Z = (const bf16*)(A.ws + WS_Z); const bf16* ao = (const bf16*)(A.ws + WS_ATTO); const float* al = (const float*)(A.ws + WS_ATTL);
    const float* rky = (const float*)(A.ws + WS_RKY); const float* rkb = (const float*)(A.ws + WS_RKB);
    const float* num = (const float*)(A.ws + WS_MLNUM); const float* den = (const float*)(A.ws + WS_MLDEN); bf16* y = (bf16*)(A.ws + WS_HB);
    const float* g2 = A.in[I_G2] + (size_t)l * 128 * RW; const float* lng = A.in[I_RLNG] + (size_t)l * RW; const float* lnb = A.in[I_RLNB] + (size_t)l * RW; const float* mlg = A.in[I_MLNG] + (size_t)l * MW;
    for (int tok = gw; tok < NT; tok += ngw) {
        const bf16* zr = Z + (size_t)tok * ZLD; bf16* yr = y + (size_t)tok * DM;
        const float lsev = al[((size_t)((lane >> 2) % 3) * NT + tok) * 4 + (lane & 3)];
        const float denv = den[((size_t)((lane >> 2) & 1) * NT + tok) * 4 + (lane & 3)];
#pragma unroll
        for (int hh = 0; hh < 4; ++hh) { const int col = hh * 64 + lane;
            const float l0 = __shfl(lsev, hh), l1 = __shfl(lsev, 4 + hh), l2 = __shfl(lsev, 8 + hh);
            const float mx = fmaxf(l0, fmaxf(l1, l2)); const float w0 = __expf(l0 - mx), w1 = __expf(l1 - mx), w2 = __expf(l2 - mx);
            const float o = (w0 * bf2f(ao[((size_t)0 * NT + tok) * AW + col]) + w1 * bf2f(ao[((size_t)1 * NT + tok) * AW + col]) + w2 * bf2f(ao[((size_t)2 * NT + tok) * AW + col])) / (w0 + w1 + w2);
            yr[col] = (bf16)f2bf(o); }
        const float sg0 = sigm(bf2f(zr[ZGD + lane])), sg1 = sigm(bf2f(zr[ZGD + 64 + lane]));
        float g[6];
#pragma unroll
        for (int i = 0; i < 6; ++i) g[i] = 0.f;
        for (int j = 0; j < 128; ++j) { const float sj = (j < 64) ? __shfl(sg0, j) : __shfl(sg1, j - 64); const float* gr = g2 + (size_t)j * RW + lane;
#pragma unroll
            for (int i = 0; i < 6; ++i) g[i] += sj * gr[i * 64]; }
#pragma unroll
        for (int hh = 0; hh < 6; ++hh) { const int col = hh * 64 + lane;
            const float s = rky[((size_t)0 * NT + tok) * RW + col] + rky[((size_t)1 * NT + tok) * RW + col];
            const float mean = wave_sum(s) * (1.f / 64.f); const float d = s - mean; const float var = wave_sum(d * d) * (1.f / 64.f);
            const float yn = d * rsqrtf(var + 64e-5f) * lng[col] + lnb[col] + rkb[((size_t)0 * NT + tok) * RW + col] + rkb[((size_t)1 * NT + tok) * RW + col];
            yr[AW + col] = (bf16)f2bf(yn * g[hh]); }
#pragma unroll
        for (int hh = 0; hh < 4; ++hh) { const int c0 = hh * 96 + lane, c1 = hh * 96 + 64 + (lane & 31); const bool hi = lane < 32;
            const float df = __shfl(denv, hh), db = __shfl(denv, 4 + hh);
            const float invf = 1.f / fmaxf(fabsf(df), 1.f), invb = 1.f / fmaxf(fabsf(db), 1.f);
            const float a = num[((size_t)0 * NT + tok) * MW + c0] * invf + num[((size_t)1 * NT + tok) * MW + c0] * invb;
            const float bb = hi ? (num[((size_t)0 * NT + tok) * MW + c1] * invf + num[((size_t)1 * NT + tok) * MW + c1] * invb) : 0.f;
            const float mean = (wave_sum(a) + wave_sum(bb)) * (1.f / 96.f); const float da = a - mean, dbb = hi ? bb - mean : 0.f;
            const float var = (wave_sum(da * da) + wave_sum(dbb * dbb)) * (1.f / 96.f); const float rs = rsqrtf(var + 1e-6f);
            yr[AW + RW + c0] = (bf16)f2bf(da * rs * mlg[c0] * sigm(bf2f(zr[ZMO + c0])));
            if (hi) yr[AW + RW + c1] = (bf16)f2bf(dbb * rs * mlg[c1] * sigm(bf2f(zr[ZMO + c1]))); }
    }
}

typedef short bf16x8_t __attribute__((ext_vector_type(8)));
typedef short bf16x4_t __attribute__((ext_vector_type(4)));
typedef unsigned u32x4_t __attribute__((ext_vector_type(4)));
typedef unsigned u32x2_t __attribute__((ext_vector_type(2)));
typedef __bf16 bf2_t __attribute__((ext_vector_type(2)));
typedef float f2_t __attribute__((ext_vector_type(2)));
DI unsigned cvtpk(float lo, float hi) { const f2_t v = {lo, hi}; return __builtin_bit_cast(unsigned, __builtin_convertvector(v, bf2_t)); }
#define MFMA16(a, b, c) __builtin_amdgcn_mfma_f32_16x16x32_bf16((a), (b), (c), 0, 0, 0)

constexpr int AT_QS = 0, AT_QLD = 72;
constexpr int AT_KS = AT_QS + 128 * AT_QLD * 2;
constexpr int AT_VT = AT_KS + 272 * AT_QLD * 2, AT_VLD = 280;
constexpr int AT_BT = AT_VT + 64 * AT_VLD * 2;
constexpr int AT_END = AT_BT + 132 * 4;
static_assert(AT_END <= MISC_OFF, "attention LDS");

DI void attn_unit(const Args& A, LAS unsigned char* lds, int unit, int tid, int wave, int lane) {
    const bf16* Z = (const bf16*)(A.ws + WS_Z); bf16* ao = (bf16*)(A.ws + WS_ATTO); float* al = (float*)(A.ws + WS_ATTL);
    const int x = unit & 15; int r0 = unit >> 4; const int hh = r0 & 3; r0 >>= 2; const int b = r0 % NB, br = r0 / NB;
    const int dil = br == 0 ? 1 : (br == 1 ? 4 : 16), lsub = SEQ / dil, nblk = lsub / 128;
    const int res = x / nblk, nbk = x % nblk, l0 = nbk * 128, wbase = l0 - 64;
    LAS bf16* Qs = (LAS bf16*)(lds + AT_QS); LAS bf16* Ks = (LAS bf16*)(lds + AT_KS); LAS bf16* Vt = (LAS bf16*)(lds + AT_VT); LAS float* btab = (LAS float*)(lds + AT_BT);
    __syncthreads();
#pragma unroll
    for (int i = 0; i < 2; ++i) { const int id = tid + 512 * i, row = id >> 3, ch = id & 7; const int tok = b * SEQ + (l0 + row) * dil + res;
        *(LAS u32x4_t*)(Qs + row * AT_QLD + ch * 8) = *(const u32x4_t*)(Z + (size_t)tok * ZLD + ZA + hh * 64 + ch * 8); }
    for (int id = tid; id < 272 * 8; id += NTHR) { const int row = id >> 3, ch = id & 7; const int pos = wbase + row; u32x4_t v = (u32x4_t){0u, 0u, 0u, 0u};
        if (row < 256 && pos >= 0 && pos < lsub) v = *(const u32x4_t*)(Z + (size_t)(b * SEQ + pos * dil + res) * ZLD + ZA + 256 + hh * 64 + ch * 8);
        *(LAS u32x4_t*)(Ks + row * AT_QLD + ch * 8) = v; }
    for (int id = tid; id < 272 * 8; id += NTHR) { const int key = id % 272, ch = id / 272; const int pos = wbase + key; u32x4_t v = (u32x4_t){0u, 0u, 0u, 0u};
        if (key < 256 && pos >= 0 && pos < lsub) v = *(const u32x4_t*)(Z + (size_t)(b * SEQ + pos * dil + res) * ZLD + ZA + 512 + hh * 64 + ch * 8);
        LAS bf16* d = Vt + (ch * 8) * AT_VLD + key;
        d[0] = (bf16)(v.x & 0xffffu); d[AT_VLD] = (bf16)(v.x >> 16); d[2 * AT_VLD] = (bf16)(v.y & 0xffffu); d[3 * AT_VLD] = (bf16)(v.y >> 16);
        d[4 * AT_VLD] = (bf16)(v.z & 0xffffu); d[5 * AT_VLD] = (bf16)(v.z >> 16); d[6 * AT_VLD] = (bf16)(v.w & 0xffffu); d[7 * AT_VLD] = (bf16)(v.w >> 16); }
    if (tid < 129) btab[tid] = A.in[I_RELB][t5_bucket((tid - 64) * dil) * 4 + hh];
    __syncthreads();
    const int fr = lane & 15, qd = lane >> 4;
    f32x4 acc[10];
    { bf16x8_t qb[2];
#pragma unroll
      for (int ks = 0; ks < 2; ++ks) qb[ks] = *(const LAS bf16x8_t*)(Qs + (16 * wave + fr) * AT_QLD + ks * 32 + 8 * qd);
#pragma unroll
      for (int j = 0; j < 10; ++j) { acc[j] = (f32x4){0.f, 0.f, 0.f, 0.f};
#pragma unroll
          for (int ks = 0; ks < 2; ++ks) { const bf16x8_t ka = *(const LAS bf16x8_t*)(Ks + (16 * (wave + j) + fr) * AT_QLD + ks * 32 + 8 * qd); acc[j] = MFMA16(ka, qb[ks], acc[j]); } } }
    const int iq = 16 * wave + fr; float mx = -1.0e30f;
#pragma unroll
    for (int j = 0; j < 10; ++j)
#pragma unroll
        for (int r = 0; r < 4; ++r) { const int kw = 16 * (wave + j) + 4 * qd + r; const int m = kw - 64 - iq; const int pos = wbase + kw;
            const bool valid = (m >= -64) && (m <= 64) && (pos >= 0) && (pos < lsub);
            const float s = valid ? acc[j][r] * 0.125f + btab[valid ? m + 64 : 0] : -1.0e30f; acc[j][r] = s; mx = fmaxf(mx, s); }
    mx = fmaxf(mx, __shfl_xor(mx, 16)); mx = fmaxf(mx, __shfl_xor(mx, 32));
    float lsum = 0.f;
#pragma unroll
    for (int j = 0; j < 10; ++j)
#pragma unroll
        for (int r = 0; r < 4; ++r) { const float p = __expf(acc[j][r] - mx); acc[j][r] = p; lsum += p; }
    lsum += __shfl_xor(lsum, 16); lsum += __shfl_xor(lsum, 32);
    f32x4 oacc[4];
#pragma unroll
    for (int d = 0; d < 4; ++d) oacc[d] = (f32x4){0.f, 0.f, 0.f, 0.f};
#pragma unroll
    for (int pp = 0; pp < 5; ++pp) {
        union { unsigned u[4]; bf16x8_t v; } pb;
        pb.u[0] = cvtpk(acc[2 * pp][0], acc[2 * pp][1]); pb.u[1] = cvtpk(acc[2 * pp][2], acc[2 * pp][3]); pb.u[2] = cvtpk(acc[2 * pp + 1][0], acc[2 * pp + 1][1]); pb.u[3] = cvtpk(acc[2 * pp + 1][2], acc[2 * pp + 1][3]);
#pragma unroll
        for (int d = 0; d < 4; ++d) { const LAS bf16* vp = Vt + (16 * d + fr) * AT_VLD + 16 * (wave + 2 * pp) + 4 * qd;
            union { bf16x4_t h[2]; bf16x8_t v; } va; va.h[0] = *(const LAS bf16x4_t*)vp; va.h[1] = *(const LAS bf16x4_t*)(vp + 16);
            oacc[d] = MFMA16(va.v, pb.v, oacc[d]); } }
    const float inv = 1.f / lsum; const int tok = b * SEQ + (l0 + iq) * dil + res;
    bf16* op = ao + ((size_t)br * NT + tok) * AW + hh * 64 + 4 * qd;
#pragma unroll
    for (int d = 0; d < 4; ++d) { uint2 w; w.x = cvtpk(oacc[d][0] * inv, oacc[d][1] * inv); w.y = cvtpk(oacc[d][2] * inv, oacc[d][3] * inv); *(uint2*)(op + 16 * d) = w; }
    if (qd == 0) al[((size_t)br * NT + tok) * 4 + hh] = mx + logf(lsum);
}
DI void phase_attn(const Args& A, LAS unsigned char* lds, int bid, int G, int tid, int wave, int lane) {
    for (int u = bid; u < 3 * NB * 4 * 16; u += G) attn_unit(A, lds, u, tid, wave, lane);
    __syncthreads();
}

constexpr int ML_QLD = 104, ML_SLD = 72;
constexpr int ML_QS = 0;
constexpr int ML_QT = ML_QS + 64 * ML_QLD * 2;
constexpr int ML_KS = ML_QT + 64 * ML_QLD * 2;
constexpr int ML_KT = ML_KS + 64 * ML_QLD * 2;
constexpr int ML_VT = ML_KT + 96 * ML_SLD * 2;
constexpr int ML_WS = ML_VT + 112 * ML_SLD * 2;
constexpr int ML_CT = ML_WS + 64 * ML_SLD * 2;
constexpr int ML_CW = ML_CT + 112 * ML_QLD * 2;
constexpr int ML_END = ML_CW + 6 * 192 * 4;
static_assert(ML_END <= MISC_OFF, "mlstm LDS");

DI void mlstm_unit(const Args& A, int l, LAS unsigned char* lds, int u, int tid, int wave, int lane) {
    const bf16* Z = (const bf16*)(A.ws + WS_Z); float* num = (float*)(A.ws + WS_MLNUM); float* den = (float*)(A.ws + WS_MLDEN);
    const int dir = u / 32, b = (u % 32) / 4, hh = u % 4;
    LAS bf16* Qs = (LAS bf16*)(lds + ML_QS); LAS bf16* Qt = (LAS bf16*)(lds + ML_QT); LAS bf16* Ks = (LAS bf16*)(lds + ML_KS); LAS bf16* KtT = (LAS bf16*)(lds + ML_KT);
    LAS bf16* VtT = (LAS bf16*)(lds + ML_VT); LAS bf16* Ws = (LAS bf16*)(lds + ML_WS); LAS bf16* Ct = (LAS bf16*)(lds + ML_CT); LAS float* cwl = (LAS float*)(lds + ML_CW); LAS float* cbl = cwl + 5 * 192;
    const int fr = lane & 15, qd = lane >> 4;
    __syncthreads();
    for (int i = tid; i < 5 * 192; i += NTHR) { const int tap = i / 192, ch = i % 192; cwl[i] = A.in[I_CW][(size_t)(l * 5 + tap) * 768 + (ch < 96 ? 0 : 384) + hh * 96 + (ch % 96)]; }
    for (int i = tid; i < 192; i += NTHR) cbl[i] = A.in[I_CB][(size_t)l * 768 + (i < 96 ? 0 : 384) + hh * 96 + (i % 96)];
    for (int i = tid; i < 16 * ML_SLD; i += NTHR) VtT[96 * ML_SLD + i] = (i < ML_SLD) ? (bf16)0x3F80u : (bf16)0u;
    const float ibv = A.in[I_IB][(l * 2 + dir) * 4 + hh], fbv = A.in[I_FB][(l * 2 + dir) * 4 + hh];
    f32x4 cacc[6];
#pragma unroll
    for (int i = 0; i < 6; ++i) cacc[i] = (f32x4){0.f, 0.f, 0.f, 0.f};
    const int j = tid >> 3, sub = tid & 7;
    for (int c = 0; c < SEQ / 64; ++c) {
        const int tl = dir ? SEQ - 1 - (c * 64 + lane) : c * 64 + lane; const size_t tokl = (size_t)b * SEQ + tl;
        const float gi = bf2f(Z[tokl * ZLD + ZMG + dir * 8 + hh]) + ibv, gf = bf2f(Z[tokl * ZLD + ZMG + dir * 8 + 4 + hh]) + fbv;
        float bsum = fminf(gf, 0.f) - log1pf(expf(-fabsf(gf)));
#pragma unroll
        for (int o = 1; o < 64; o <<= 1) { const float t = __shfl_up(bsum, o); if (lane >= o) bsum += t; }
        const float bend = __shfl(bsum, 63);
        const int tj = dir ? SEQ - 1 - (c * 64 + j) : c * 64 + j; const size_t tokj = (size_t)b * SEQ + tj;
        const float bj = __shfl(bsum, j), igj = __shfl(gi, j);
        __syncthreads();
#pragma unroll
        for (int i = 0; i < 6; ++i) { const int id = wave + 8 * i; if (id < 42) { const int kt = id / 7, nt = id % 7;
            u32x2_t w; w.x = cvtpk(cacc[i][0], cacc[i][1]); w.y = cvtpk(cacc[i][2], cacc[i][3]); *(LAS u32x2_t*)(Ct + (16 * nt + fr) * ML_QLD + 16 * kt + 4 * qd) = w; } }
        { const bool isk = sub >= 4; const int c0 = (sub & 3) * 24, cl = (isk ? 96 : 0) + c0; const int zcol = ZMQK + (isk ? 384 : 0) + hh * 96 + c0;
          float acc[24];
#pragma unroll
          for (int e = 0; e < 24; ++e) acc[e] = cbl[cl + e];
#pragma unroll
          for (int tap = 0; tap < 5; ++tap) { const int tt = tj + tap - 2;
              if (tt >= 0 && tt < SEQ) { const u32x4_t* zp = (const u32x4_t*)(Z + ((size_t)b * SEQ + tt) * ZLD + zcol);
#pragma unroll
                  for (int q4 = 0; q4 < 3; ++q4) { const u32x4_t w = zp[q4]; const LAS float* cwp = cwl + tap * 192 + cl + q4 * 8;
                      acc[q4 * 8 + 0] += cwp[0] * __uint_as_float(w.x << 16); acc[q4 * 8 + 1] += cwp[1] * __uint_as_float(w.x & 0xffff0000u);
                      acc[q4 * 8 + 2] += cwp[2] * __uint_as_float(w.y << 16); acc[q4 * 8 + 3] += cwp[3] * __uint_as_float(w.y & 0xffff0000u);
                      acc[q4 * 8 + 4] += cwp[4] * __uint_as_float(w.z << 16); acc[q4 * 8 + 5] += cwp[5] * __uint_as_float(w.z & 0xffff0000u);
                      acc[q4 * 8 + 6] += cwp[6] * __uint_as_float(w.w << 16); acc[q4 * 8 + 7] += cwp[7] * __uint_as_float(w.w & 0xffff0000u); } } }
          const float sc1 = isk ? 0.10206207261596575f : 1.f; const float sc2 = isk ? __expf(bend - bj + igj) : __expf(bj);
#pragma unroll
          for (int e = 0; e < 24; ++e) acc[e] = acc[e] * sigm(acc[e]) * sc1;
          LAS bf16* d1 = (isk ? Ks : Qs) + j * ML_QLD + c0;
#pragma unroll
          for (int q4 = 0; q4 < 3; ++q4) { u32x4_t w; w.x = cvtpk(acc[q4 * 8 + 0], acc[q4 * 8 + 1]); w.y = cvtpk(acc[q4 * 8 + 2], acc[q4 * 8 + 3]); w.z = cvtpk(acc[q4 * 8 + 4], acc[q4 * 8 + 5]); w.w = cvtpk(acc[q4 * 8 + 6], acc[q4 * 8 + 7]);
              *(LAS u32x4_t*)(d1 + q4 * 8) = w; }
          if (!isk) { LAS bf16* d2 = Qt + j * ML_QLD + c0;
#pragma unroll
              for (int q4 = 0; q4 < 3; ++q4) { u32x4_t w; w.x = cvtpk(acc[q4 * 8 + 0] * sc2, acc[q4 * 8 + 1] * sc2); w.y = cvtpk(acc[q4 * 8 + 2] * sc2, acc[q4 * 8 + 3] * sc2); w.z = cvtpk(acc[q4 * 8 + 4] * sc2, acc[q4 * 8 + 5] * sc2); w.w = cvtpk(acc[q4 * 8 + 6] * sc2, acc[q4 * 8 + 7] * sc2);
                  *(LAS u32x4_t*)(d2 + q4 * 8) = w; } }
          else {
#pragma unroll
              for (int e = 0; e < 24; ++e) KtT[(c0 + e) * ML_SLD + j] = (bf16)f2bf(acc[e] * sc2); } }
        { const int n0 = sub * 12; const u32x2_t* vp = (const u32x2_t*)(Z + tokj * ZLD + ZMV + hh * 96 + n0);
#pragma unroll
          for (int q2 = 0; q2 < 3; ++q2) { const u32x2_t w = vp[q2]; LAS bf16* d = VtT + (n0 + q2 * 4) * ML_SLD + j;
              d[0] = (bf16)(w.x & 0xffffu); d[ML_SLD] = (bf16)(w.x >> 16); d[2 * ML_SLD] = (bf16)(w.y & 0xffffu); d[3 * ML_SLD] = (bf16)(w.y >> 16); } }
        __syncthreads();
#pragma unroll
        for (int i = 0; i < 2; ++i) { const int tile = 2 * wave + i, jt = tile >> 2, st = tile & 3; const int jq = 16 * jt + fr;
            u32x2_t w = (u32x2_t){0u, 0u};
            if (st <= jt) { f32x4 acc = (f32x4){0.f, 0.f, 0.f, 0.f};
#pragma unroll
                for (int ks = 0; ks < 3; ++ks) { const bf16x8_t a = *(const LAS bf16x8_t*)(Ks + (16 * st + fr) * ML_QLD + 32 * ks + 8 * qd); const bf16x8_t bq = *(const LAS bf16x8_t*)(Qs + jq * ML_QLD + 32 * ks + 8 * qd); acc = MFMA16(a, bq, acc); }
                const float bjq = __shfl(bsum, jq); float wv[4];
#pragma unroll
                for (int r = 0; r < 4; ++r) { const int s = 16 * st + 4 * qd + r; const float bs = __shfl(bsum, s), igs = __shfl(gi, s); wv[r] = (s <= jq) ? acc[r] * __expf(bjq - bs + igs) : 0.f; }
                w.x = cvtpk(wv[0], wv[1]); w.y = cvtpk(wv[2], wv[3]); }
            *(LAS u32x2_t*)(Ws + jq * ML_SLD + 16 * st + 4 * qd) = w; }
        __syncthreads();
#pragma unroll
        for (int i = 0; i < 4; ++i) { const int id = wave + 8 * i; if (id < 28) { const int jt = id / 7, nt = id % 7; f32x4 acc = (f32x4){0.f, 0.f, 0.f, 0.f};
#pragma unroll
            for (int ks = 0; ks < 2; ++ks) { const bf16x8_t a = *(const LAS bf16x8_t*)(Ws + (16 * jt + fr) * ML_SLD + 32 * ks + 8 * qd); const bf16x8_t bv = *(const LAS bf16x8_t*)(VtT + (16 * nt + fr) * ML_SLD + 32 * ks + 8 * qd); acc = MFMA16(a, bv, acc); }
#pragma unroll
            for (int ks = 0; ks < 3; ++ks) { const bf16x8_t a = *(const LAS bf16x8_t*)(Qt + (16 * jt + fr) * ML_QLD + 32 * ks + 8 * qd); const bf16x8_t bc = *(const LAS bf16x8_t*)(Ct + (16 * nt + fr) * ML_QLD + 32 * ks + 8 * qd); acc = MFMA16(a, bc, acc); }
            const int n = 16 * nt + fr;
#pragma unroll
            for (int r = 0; r < 4; ++r) { const int jj = 16 * jt + 4 * qd + r; const int tt = dir ? SEQ - 1 - (c * 64 + jj) : c * 64 + jj; const size_t tok = (size_t)b * SEQ + tt;
                if (n < 96) num[((size_t)dir * NT + tok) * MW + hh * 96 + n] = acc[r]; else if (n == 96) den[((size_t)dir * NT + tok) * 4 + hh] = acc[r]; } } }
        const float dec = __expf(bend);
#pragma unroll
        for (int i = 0; i < 6; ++i) { const int id = wave + 8 * i; if (id < 42) { const int kt = id / 7, nt = id % 7; f32x4 t = cacc[i] * dec;
#pragma unroll
            for (int ks = 0; ks < 2; ++ks) { const bf16x8_t a = *(const LAS bf16x8_t*)(KtT + (16 * kt + fr) * ML_SLD + 32 * ks + 8 * qd); const bf16x8_t bv = *(const LAS bf16x8_t*)(VtT + (16 * nt + fr) * ML_SLD + 32 * ks + 8 * qd); t = MFMA16(a, bv, t); }
            cacc[i] = t; } }
    }
    __syncthreads();
}

DI bf16x8_t widen4(const bf16x4_t a) { return __builtin_shufflevector(a, (bf16x4_t){0, 0, 0, 0}, 0, 1, 2, 3, 4, 5, 6, 7); }
constexpr int PKG_BYTES = 12544;
constexpr int PK_AH = 0, PK_RH = 2048, PK_BT = 4096, PK_KT = 6144, PK_VV = 8192, PK_TM = 10240, PK_MRB = 10752, PK_LAK = 11264, PK_MRK = 11776, PK_GE = 12288;
constexpr size_t WS_PKG = WS_PR;
static_assert((size_t)2 * NB * 6 * 128 * PKG_BYTES <= 288 * MiB, "package region");
constexpr int R1_W2T = 0, R1_A2T = 9216, R1_WV = 18432, R1_WV_BYTES = 12928;
constexpr int R1_IMG = 0, R1_LF = 9216, R1_MT = 10368;
static_assert(R1_WV + 8 * R1_WV_BYTES <= MISC_OFF, "rwkv r1 LDS");
#ifndef RK_DEBUG_PR
#define RK_DEBUG_PR 0
#endif

DI bf16x4_t pack4(const f32x4 v) { union { unsigned u[2]; bf16x4_t h; } x; x.u[0] = cvtpk(v[0], v[1]); x.u[1] = cvtpk(v[2], v[3]); return x.h; }

DI void rwkv_r1_item(const Args& A, int l, LAS unsigned char* lds, int item, int tid, int wave, int lane) {
    const bf16* Z = (const bf16*)(A.ws + WS_Z);
    const int g = item & 15; int r0 = item >> 4; const int hh = r0 % 6; r0 /= 6; const int b = r0 % NB, dir = r0 / NB;
    const int cc = 8 * g + wave, fr = lane & 15, qd = lane >> 4;
    LAS bf16* W2T = (LAS bf16*)(lds + R1_W2T); LAS bf16* A2T = (LAS bf16*)(lds + R1_A2T);
    LAS unsigned char* wv = lds + R1_WV + wave * R1_WV_BYTES;
    LAS bf16* IMG = (LAS bf16*)(wv + R1_IMG); LAS float* Lf = (LAS float*)(wv + R1_LF); LAS bf16* MT = (LAS bf16*)(wv + R1_MT);
    __syncthreads();
    { const int ch = tid & 63, i0 = (tid >> 6) * 8; const float* w2 = A.in[I_W2] + ((size_t)(l * 2 + dir) * 64 + i0) * RW + hh * 64 + ch; const float* a2 = A.in[I_A2] + ((size_t)(l * 2 + dir) * 64 + i0) * RW + hh * 64 + ch;
      u32x4_t pw, pa; pw.x = cvtpk(w2[0], w2[RW]); pw.y = cvtpk(w2[2 * RW], w2[3 * RW]); pw.z = cvtpk(w2[4 * RW], w2[5 * RW]); pw.w = cvtpk(w2[6 * RW], w2[7 * RW]);
      pa.x = cvtpk(a2[0], a2[RW]); pa.y = cvtpk(a2[2 * RW], a2[3 * RW]); pa.z = cvtpk(a2[4 * RW], a2[5 * RW]); pa.w = cvtpk(a2[6 * RW], a2[7 * RW]);
      *(LAS u32x4_t*)(W2T + ch * 72 + i0) = pw; *(LAS u32x4_t*)(A2T + ch * 72 + i0) = pa; }
    __syncthreads();
    const int sgn = dir ? -1 : 1; const int tok0 = b * SEQ + (dir ? SEQ - 1 - 16 * cc : 16 * cc);
    const float* mu = A.in[I_MU] + (size_t)(l * 2 + dir) * 1280;
    float er[4][4], ek[4][4], ev[4][4];
#pragma unroll
    for (int nt = 0; nt < 4; ++nt) {
#pragma unroll
        for (int r = 0; r < 4; ++r) { const bf16* zp = Z + (size_t)(tok0 + sgn * (4 * qd + r)) * ZLD + ZRKV + hh * 64 + 16 * nt + fr; er[nt][r] = bf2f(zp[0]); ek[nt][r] = bf2f(zp[RW]); ev[nt][r] = bf2f(zp[2 * RW]); }
        float pr = __shfl(er[nt][3], lane - 16), pk = __shfl(ek[nt][3], lane - 16), pv = __shfl(ev[nt][3], lane - 16);
        if (qd == 0) { pr = 0.f; pk = 0.f; pv = 0.f; if (cc > 0) { const bf16* zp = Z + (size_t)(tok0 - sgn) * ZLD + ZRKV + hh * 64 + 16 * nt + fr; pr = bf2f(zp[0]); pk = bf2f(zp[RW]); pv = bf2f(zp[2 * RW]); } }
        const float mr = mu[hh * 64 + 16 * nt + fr], mk = mu[RW + hh * 64 + 16 * nt + fr], mv = mu[2 * RW + hh * 64 + 16 * nt + fr];
#pragma unroll
        for (int r = 3; r >= 0; --r) { const float qr = r ? er[nt][r - 1] : pr, qk = r ? ek[nt][r - 1] : pk, qv = r ? ev[nt][r - 1] : pv;
            er[nt][r] += mr * (qr - er[nt][r]); ek[nt][r] += mk * (qk - ek[nt][r]); ev[nt][r] += mv * (qv - ev[nt][r]); }
    }
    bf16x8_t thA[2], adA[2];
    { const int zwd = dir ? ZWDB : ZWDF, zad = dir ? ZADB : ZADF; const bool hasp = !(cc == 0 && fr == 0);
      const bf16* zc = Z + (size_t)(tok0 + sgn * fr) * ZLD; const bf16* zq = Z + (size_t)(tok0 + sgn * (fr - 1)) * ZLD;
#pragma unroll
      for (int ks = 0; ks < 2; ++ks) { float cw[8], pw[8], ca[8], pa[8];
          unpack8(*(const uint4*)(zc + zwd + 32 * ks + 8 * qd), cw); unpack8(*(const uint4*)(zc + zad + 32 * ks + 8 * qd), ca);
          if (hasp) { unpack8(*(const uint4*)(zq + zwd + 32 * ks + 8 * qd), pw); unpack8(*(const uint4*)(zq + zad + 32 * ks + 8 * qd), pa); }
          else {
#pragma unroll
              for (int e = 0; e < 8; ++e) { pw[e] = 0.f; pa[e] = 0.f; } }
          const float* muw = mu + 1152 + 32 * ks + 8 * qd; const float* mua = mu + 1216 + 32 * ks + 8 * qd;
#pragma unroll
          for (int e = 0; e < 8; ++e) { cw[e] = tanhf(cw[e] + muw[e] * (pw[e] - cw[e])); ca[e] = ca[e] + mua[e] * (pa[e] - ca[e]); }
          union { unsigned u[4]; bf16x8_t v; } x, y;
#pragma unroll
          for (int e = 0; e < 4; ++e) { x.u[e] = cvtpk(cw[2 * e], cw[2 * e + 1]); y.u[e] = cvtpk(ca[2 * e], ca[2 * e + 1]); }
          thA[ks] = x.v; adA[ks] = y.v; } }
    f32x4 wl[4], al[4];
#pragma unroll
    for (int nt = 0; nt < 4; ++nt) { wl[nt] = (f32x4){0.f, 0.f, 0.f, 0.f}; al[nt] = (f32x4){0.f, 0.f, 0.f, 0.f};
#pragma unroll
        for (int ks = 0; ks < 2; ++ks) { const bf16x8_t bw = *(const LAS bf16x8_t*)(W2T + (16 * nt + fr) * 72 + 32 * ks + 8 * qd); const bf16x8_t ba = *(const LAS bf16x8_t*)(A2T + (16 * nt + fr) * 72 + 32 * ks + 8 * qd);
            wl[nt] = MFMA16(thA[ks], bw, wl[nt]); al[nt] = MFMA16(adA[ks], ba, al[nt]); } }
    float lw[4][4], alp[4][4], kap[4][4]; float ssq[4] = {0.f, 0.f, 0.f, 0.f}, bsm[4] = {0.f, 0.f, 0.f, 0.f};
#pragma unroll
    for (int nt = 0; nt < 4; ++nt) { const int ch = hh * 64 + 16 * nt + fr;
        const float w0v = A.in[I_W0][(size_t)(l * 2 + dir) * RW + ch], a0v = A.in[I_A0][(size_t)(l * 2 + dir) * RW + ch], kkw = A.in[I_KK][(size_t)l * RW + ch], kaw = A.in[I_KA][(size_t)l * RW + ch], rkw = A.in[I_RK][(size_t)l * RW + ch];
#pragma unroll
        for (int r = 0; r < 4; ++r) { const float x = w0v + wl[nt][r]; const float nx = -x; const float sp = fmaxf(nx, 0.f) + log1pf(expf(-fabsf(nx)));
            lw[nt][r] = -expf(-sp - 0.5f);
            const float a = 1.f / (1.f + expf(-(a0v + al[nt][r]))); alp[nt][r] = a;
            const float k0 = ek[nt][r]; kap[nt][r] = k0 * kkw; ek[nt][r] = k0 * (1.f + (a - 1.f) * kaw);
            ssq[r] += kap[nt][r] * kap[nt][r]; bsm[r] += er[nt][r] * ek[nt][r] * rkw; } }
#pragma unroll
    for (int r = 0; r < 4; ++r) {
#pragma unroll
        for (int o = 1; o < 16; o <<= 1) { ssq[r] += __shfl_xor(ssq[r], o); bsm[r] += __shfl_xor(bsm[r], o); }
        ssq[r] = 1.f / fmaxf(sqrtf(ssq[r]), 1e-12f); }
    { float* bon = (float*)(A.ws + WS_RKB);
#pragma unroll
      for (int nt = 0; nt < 4; ++nt)
#pragma unroll
          for (int r = 0; r < 4; ++r) { kap[nt][r] *= ssq[r]; bon[((size_t)dir * NT + tok0 + sgn * (4 * qd + r)) * RW + hh * 64 + 16 * nt + fr] = bsm[r] * ev[nt][r]; } }
#if RK_DEBUG_PR
    { float* PR = (float*)(A.ws + WS_PR);
#pragma unroll
      for (int nt = 0; nt < 4; ++nt)
#pragma unroll
          for (int r = 0; r < 4; ++r) { float* p = PR + ((size_t)(dir * NT + tok0 + sgn * (4 * qd + r)) * 6) * RW + hh * 64 + 16 * nt + fr;
              p[0] = er[nt][r]; p[RW] = expf(lw[nt][r]); p[2 * RW] = ek[nt][r]; p[3 * RW] = ev[nt][r]; p[4 * RW] = kap[nt][r]; p[5 * RW] = alp[nt][r]; } }
#else
    unsigned char* pkg = A.ws + WS_PKG + ((size_t)((dir * NB + b) * 6 + hh) * 128 + cc) * PKG_BYTES;
    float lend[4];
    u32x2_t btf[4], ktf[4];
#pragma unroll
    for (int nt = 0; nt < 4; ++nt) { float lam[4]; lam[0] = lw[nt][0]; lam[1] = lam[0] + lw[nt][1]; lam[2] = lam[1] + lw[nt][2]; lam[3] = lam[2] + lw[nt][3];
        const float t1 = __shfl(lam[3], lane - 16), t2 = __shfl(lam[3], lane - 32), t3 = __shfl(lam[3], lane - 48);
        const float off = (qd >= 1 ? t1 : 0.f) + (qd >= 2 ? t2 : 0.f) + (qd >= 3 ? t3 : 0.f);
#pragma unroll
        for (int r = 0; r < 4; ++r) lam[r] += off;
        lend[nt] = __shfl(lam[3], 48 + fr);
        float bt4[4], kt4[4];
#pragma unroll
        for (int r = 0; r < 4; ++r) { const float ep = __expf(lam[r]), epm = __expf(lam[r] - lw[nt][r]), einv = 1.f / ep, eend = __expf(lend[nt] - lam[r]);
            const float bb = kap[nt][r] * alp[nt][r]; const int o = (4 * qd + r) * 72 + 16 * nt + fr;
            IMG[o] = (bf16)f2bf(-kap[nt][r] * epm); IMG[1152 + o] = (bf16)f2bf(er[nt][r] * ep); IMG[2304 + o] = (bf16)f2bf(bb * einv); IMG[3456 + o] = (bf16)f2bf(ek[nt][r] * einv);
            bt4[r] = bb * eend; kt4[r] = ek[nt][r] * eend; }
        btf[nt].x = cvtpk(bt4[0], bt4[1]); btf[nt].y = cvtpk(bt4[2], bt4[3]); ktf[nt].x = cvtpk(kt4[0], kt4[1]); ktf[nt].y = cvtpk(kt4[2], kt4[3]); }
    asm volatile("s_waitcnt lgkmcnt(0)" ::: "memory");
    f32x4 Lab = (f32x4){0.f, 0.f, 0.f, 0.f}, Lak = Lab, Mrb = Lab, Mrk = Lab;
#pragma unroll
    for (int ks = 0; ks < 2; ++ks) { const int o = fr * 72 + 32 * ks + 8 * qd;
        const bf16x8_t aA = *(const LAS bf16x8_t*)(IMG + o), aR = *(const LAS bf16x8_t*)(IMG + 1152 + o), bB = *(const LAS bf16x8_t*)(IMG + 2304 + o), bK = *(const LAS bf16x8_t*)(IMG + 3456 + o);
        Lab = MFMA16(aA, bB, Lab); Lak = MFMA16(aA, bK, Lak); Mrb = MFMA16(aR, bB, Mrb); Mrk = MFMA16(aR, bK, Mrk); }
#pragma unroll
    for (int r = 0; r < 4; ++r) { const int t = 4 * qd + r; if (!(fr < t)) { Lab[r] = 0.f; Lak[r] = 0.f; } if (!(fr <= t)) { Mrb[r] = 0.f; Mrk[r] = 0.f; } Lf[t * 17 + fr] = Lab[r]; }
    asm volatile("s_waitcnt lgkmcnt(0)" ::: "memory");
    float Tc[16];
#pragma unroll
    for (int t = 0; t < 16; ++t) { float acc = (t == fr) ? 1.f : 0.f;
#pragma unroll
        for (int s = 0; s < t; ++s) acc += Lf[t * 17 + s] * Tc[s];
        Tc[t] = acc; }
    f32x4 Tm;
#pragma unroll
    for (int r = 0; r < 4; ++r) Tm[r] = qd == 0 ? Tc[r] : (qd == 1 ? Tc[4 + r] : (qd == 2 ? Tc[8 + r] : Tc[12 + r]));
#pragma unroll
    for (int r = 0; r < 4; ++r) { const int o = (4 * qd + r) * 20 + fr; MT[o] = (bf16)f2bf(Tm[r]); MT[320 + o] = (bf16)f2bf(Mrb[r]); MT[640 + o] = (bf16)f2bf(Lak[r]); MT[960 + o] = (bf16)f2bf(Mrk[r]); }
    asm volatile("s_waitcnt lgkmcnt(0)" ::: "memory");
    { const int o = fr * 20 + 4 * qd;
      *(u32x2_t*)(pkg + PK_TM + lane * 8) = *(const LAS u32x2_t*)(MT + o); *(u32x2_t*)(pkg + PK_MRB + lane * 8) = *(const LAS u32x2_t*)(MT + 320 + o);
      *(u32x2_t*)(pkg + PK_LAK + lane * 8) = *(const LAS u32x2_t*)(MT + 640 + o); *(u32x2_t*)(pkg + PK_MRK + lane * 8) = *(const LAS u32x2_t*)(MT + 960 + o); }
#pragma unroll
    for (int ks = 0; ks < 2; ++ks) { const int o = fr * 72 + 32 * ks + 4 * qd;
        const u32x2_t alo = *(const LAS u32x2_t*)(IMG + o), ahi = *(const LAS u32x2_t*)(IMG + o + 16), rlo = *(const LAS u32x2_t*)(IMG + 1152 + o), rhi = *(const LAS u32x2_t*)(IMG + 1152 + o + 16);
        *(u32x4_t*)(pkg + PK_AH + ks * 1024 + lane * 16) = (u32x4_t){alo.x, alo.y, ahi.x, ahi.y}; *(u32x4_t*)(pkg + PK_RH + ks * 1024 + lane * 16) = (u32x4_t){rlo.x, rlo.y, rhi.x, rhi.y}; }
#pragma unroll
    for (int nt = 0; nt < 4; ++nt) { *(u32x2_t*)(pkg + PK_BT + nt * 512 + lane * 8) = btf[nt]; *(u32x2_t*)(pkg + PK_KT + nt * 512 + lane * 8) = ktf[nt];
        u32x2_t vf; vf.x = cvtpk(ev[nt][0], ev[nt][1]); vf.y = cvtpk(ev[nt][2], ev[nt][3]); *(u32x2_t*)(pkg + PK_VV + nt * 512 + lane * 8) = vf;
        if (qd == 0) ((float*)(pkg + PK_GE))[16 * nt + fr] = __expf(lend[nt]); }
    asm volatile("s_waitcnt lgkmcnt(0)" ::: "memory");
#endif
}
DI void phase_rwkv_r1(const Args& A, int l, LAS unsigned char* lds, int bid, int G, int tid, int wave, int lane) {
    for (int it = bid; it < 2 * NB * 6 * 16; it += G) rwkv_r1_item(A, l, lds, it, tid, wave, lane);
    __syncthreads();
}

struct RkOps { bf16x8_t ah[2], rh[2]; bf16x4_t bt[4], kt[4], vv, tm, mrb, lak, mrk; f32x4 ge[4]; };
DI void rk_load(RkOps& o, const unsigned char* pkg, int vb, int lane, int qd) {
#pragma unroll
    for (int ks = 0; ks < 2; ++ks) { o.ah[ks] = *(const bf16x8_t*)(pkg + PK_AH + ks * 1024 + lane * 16); o.rh[ks] = *(const bf16x8_t*)(pkg + PK_RH + ks * 1024 + lane * 16); }
#pragma unroll
    for (int kt = 0; kt < 4; ++kt) { o.bt[kt] = *(const bf16x4_t*)(pkg + PK_BT + kt * 512 + lane * 8); o.kt[kt] = *(const bf16x4_t*)(pkg + PK_KT + kt * 512 + lane * 8); o.ge[kt] = *(const f32x4*)(pkg + PK_GE + (16 * kt + 4 * qd) * 4); }
    o.vv = *(const bf16x4_t*)(pkg + PK_VV + vb * 512 + lane * 8); o.tm = *(const bf16x4_t*)(pkg + PK_TM + lane * 8); o.mrb = *(const bf16x4_t*)(pkg + PK_MRB + lane * 8);
    o.lak = *(const bf16x4_t*)(pkg + PK_LAK + lane * 8); o.mrk = *(const bf16x4_t*)(pkg + PK_MRK + lane * 8);
}
DI void rk_step(const RkOps& c, f32x4 (&sT)[4], float* yb, int dir, int b, int hh, int vb, int cc, int fr, int qd) {
    const f32x4 zero4 = (f32x4){0.f, 0.f, 0.f, 0.f};
    union { unsigned u[4]; bf16x8_t v; } s0, s1;
    s0.u[0] = cvtpk(sT[0][0], sT[0][1]); s0.u[1] = cvtpk(sT[0][2], sT[0][3]); s0.u[2] = cvtpk(sT[1][0], sT[1][1]); s0.u[3] = cvtpk(sT[1][2], sT[1][3]);
    s1.u[0] = cvtpk(sT[2][0], sT[2][1]); s1.u[1] = cvtpk(sT[2][2], sT[2][3]); s1.u[2] = cvtpk(sT[3][0], sT[3][1]); s1.u[3] = cvtpk(sT[3][2], sT[3][3]);
    const bf16x8_t vv8 = widen4(c.vv);
    f32x4 ax = MFMA16(widen4(c.lak), vv8, zero4); ax = MFMA16(c.ah[0], s0.v, ax); ax = MFMA16(c.ah[1], s1.v, ax);
    f32x4 ay = MFMA16(widen4(c.mrk), vv8, zero4); ay = MFMA16(c.rh[0], s0.v, ay); ay = MFMA16(c.rh[1], s1.v, ay);
    const bf16x8_t xb = widen4(pack4(ax));
    const f32x4 au = MFMA16(widen4(c.tm), xb, zero4);
    const bf16x8_t ub = widen4(pack4(au));
    ay = MFMA16(widen4(c.mrb), ub, ay);
#pragma unroll
    for (int kt = 0; kt < 4; ++kt) { f32x4 t = sT[kt] * c.ge[kt]; t = MFMA16(widen4(c.kt[kt]), vv8, t); t = MFMA16(widen4(c.bt[kt]), ub, t); sT[kt] = t; }
    const int sgn = dir ? -1 : 1; const int tok0 = b * SEQ + (dir ? SEQ - 1 - 16 * cc : 16 * cc);
#pragma unroll
    for (int r = 0; r < 4; ++r) yb[((size_t)dir * NT + tok0 + sgn * (4 * qd + r)) * RW + hh * 64 + 16 * vb + fr] = ay[r];
}
DI void rwkv_r2_wave(const Args& A, int u, int vb, int lane) {
    float* yb = (float*)(A.ws + WS_RKY);
    const int dir = u / 48, rem = u % 48, b = rem / 6, hh = rem % 6; const int fr = lane & 15, qd = lane >> 4;
    const unsigned char* pkg0 = A.ws + WS_PKG + ((size_t)((dir * NB + b) * 6 + hh) * 128) * PKG_BYTES;
    f32x4 sT[4];
#pragma unroll
    for (int kt = 0; kt < 4; ++kt) sT[kt] = (f32x4){0.f, 0.f, 0.f, 0.f};
    RkOps pa, pb; rk_load(pa, pkg0, vb, lane, qd);
    for (int cc = 0; cc < 128; cc += 2) {
        rk_load(pb, pkg0 + (size_t)(cc + 1) * PKG_BYTES, vb, lane, qd);
        rk_step(pa, sT, yb, dir, b, hh, vb, cc, fr, qd);
        if (cc + 2 < 128) rk_load(pa, pkg0 + (size_t)(cc + 2) * PKG_BYTES, vb, lane, qd);
        rk_step(pb, sT, yb, dir, b, hh, vb, cc + 1, fr, qd);
    }
}

constexpr int PH_PER_LAYER = 10, NPH = 1 + NL * PH_PER_LAYER + 1;
#ifndef MK_ONE_LAUNCH
#define MK_ONE_LAUNCH 1
#endif

template <int l> DI void run_layer(const Args& A, LAS unsigned char* lds, const XcdBarrier& bar, int lo, int hi, int G, int bid, int tid, int lane, int wave, int gw, int ngw, int gtid, int nthr) {
#define IN(k) (lo <= (k) && (k) < hi)
#define SEAM(k) do { if (IN(k) && IN((k) + 1)) xcd_barrier(bar); } while (0)
        const int pb = 1 + l * PH_PER_LAYER;
        if (IN(pb + 0)) { phase_ln1(A, l, gw, ngw, lane); } SEAM(pb + 0);
        if (IN(pb + 1)) {
            pg8::Gemm g{(const bf16*)(A.ws + WS_HB), (const bf16*)(A.ws + WS_WTIN) + (size_t)l * ZLD * DM, NT, ZLD, DM};
            pg8::StaticOrder S; S.init(NT, ZLD, G, bid);
            pg8::EpiBf16<0> E{(bf16*)(A.ws + WS_Z), ZLD, nullptr, 0, 0, 1.f};
            pg8::gemm_phase<pg8::EpiBf16<0>, pg8::StaticOrder, true, true>(lds, g, S, E);
        } SEAM(pb + 1);
        if (IN(pb + 2)) { phase_attn(A, lds, bid, G, tid, wave, lane); phase_rwkv_r1(A, l, lds, bid, G, tid, wave, lane); } SEAM(pb + 2);
        if (IN(pb + 3)) { for (int u = bid; u < 96; u += G) { if (wave < 4) rwkv_r2_wave(A, u, wave, lane); }
            for (int u = bid; u < 96 + 64; u += G) { if (u >= 96) mlstm_unit(A, l, lds, u - 96, tid, wave, lane); } } SEAM(pb + 3);
        if (IN(pb + 4)) { phase_yasm(A, l, gw, ngw, lane); } SEAM(pb + 4);
        if (IN(pb + 5)) {
            pg8::Gemm g{(const bf16*)(A.ws + WS_HB), (const bf16*)(A.ws + WS_WTOUT) + (size_t)l * DM * DM, NT, DM, DM};
            pg8::StaticOrder S; S.init(NT, DM, G, bid);
            EpiResF32 E{(l == 0) ? A.in[I_X] : (const float*)(A.ws + WS_X2), (float*)(A.ws + WS_X1), DM};
            pg8::gemm_phase<EpiResF32, pg8::StaticOrder, false, true>(lds, g, S, E);
        } SEAM(pb + 5);
        if (IN(pb + 6)) { phase_ln2(A, l, gw, ngw, lane); } SEAM(pb + 6);
        if (IN(pb + 7)) { phase_topk(A, lds, bid, G, tid, wave, lane); } SEAM(pb + 7);
        if (IN(pb + 8)) {
            pg8::Gemm g{(const bf16*)(A.ws + WS_XG), (const bf16*)(A.ws + WS_W13T) + (size_t)l * NE * 5632 * DM, NSLOT, NE * 5632, DM};
            GroupOrder S; S.init(22, G, bid);
            EpiSwiGLU E{(bf16*)(A.ws + WS_ACT), 22};
            pg8::gemm_phase<EpiSwiGLU, GroupOrder, true, true>(lds, g, S, E);
        } SEAM(pb + 8);
        if (IN(pb + 9)) {
            pg8::Gemm g{(const bf16*)(A.ws + WS_ACT), (const bf16*)(A.ws + WS_W2T) + (size_t)l * NE * DM * FF, NSLOT, NE * DM, FF};
            GroupOrder S; S.init(4, G, bid);
            EpiGate E{(bf16*)(A.ws + WS_YS), (const float*)(A.ws + WS_GATE)};
            pg8::gemm_phase<EpiGate, GroupOrder, true, true>(lds, g, S, E);
        } SEAM(pb + 9);
#undef IN
#undef SEAM
}

__global__ void __launch_bounds__(NTHR, 2) mk_fwd(Args A) {
    extern __shared__ __attribute__((aligned(16))) unsigned char lds_raw[];
    LAS unsigned char* lds = (LAS unsigned char*)lds_raw;
    const int tid = threadIdx.x, lane = tid & 63, wave = __builtin_amdgcn_readfirstlane(tid >> 6);
    const int G = gridDim.x, bid = blockIdx.x;
    const int gw = bid * NWAVES + wave, ngw = G * NWAVES, gtid = bid * NTHR + tid, nthr = G * NTHR;
    volatile LAS unsigned* MISC = (volatile LAS unsigned*)(lds + MISC_OFF);
    if (tid < 64) MISC[tid] = 0u;
    __syncthreads();
    const int lo = A.ph_lo, hi = A.ph_hi;
    const bool use_bar = (hi - lo) > 1;
    XcdBarrier bar; bar.bar = (unsigned*)(A.ws + WS_CTL) + CW_BAR; bar.x = 0; bar.st = MISC + 8;
    if (use_bar) bar = xcd_barrier_post((unsigned*)(A.ws + WS_CTL) + CW_BAR, MISC + 8);
#define IN(k) (lo <= (k) && (k) < hi)
#define SEAM(k) do { if (IN(k) && IN((k) + 1)) xcd_barrier(bar); } while (0)

    if (IN(0)) { phase_p0(A, lds, gw, ngw, wave, lane); } SEAM(0);

    run_layer<0>(A, lds, bar, lo, hi, G, bid, tid, lane, wave, gw, ngw, gtid, nthr);
    run_layer<1>(A, lds, bar, lo, hi, G, bid, tid, lane, wave, gw, ngw, gtid, nthr);
    if (IN(NPH - 1)) { phase_final(A, gw, ngw, lane); }
#undef IN
#undef SEAM
}
}

extern "C" void kernel_launch(void* const* d_in, const int* in_sizes, int n_in, void* d_out, int out_size, void* d_ws, size_t ws_size, hipStream_t stream) {
    using namespace mk;
    static int grid = 0;
    if (grid == 0) {
        if (n_in != N_IN || out_size != NT * DM || ws_size < WS_END) { fprintf(stderr, "kernel_launch: unexpected shapes (n_in %d, out %d, ws %zu < %zu)\n", n_in, out_size, ws_size, (size_t)WS_END); grid = -1; return; }
        int dev = 0, cus = 0, per_cu = 0;
        if (hipGetDevice(&dev) != hipSuccess || hipDeviceGetAttribute(&cus, hipDeviceAttributeMultiprocessorCount, dev) != hipSuccess) { grid = -1; return; }
        if (hipFuncSetAttribute((const void*)mk_fwd, hipFuncAttributeMaxDynamicSharedMemorySize, LDS_BYTES) != hipSuccess) { fprintf(stderr, "kernel_launch: hipFuncSetAttribute failed\n"); grid = -1; return; }
        if (hipOccupancyMaxActiveBlocksPerMultiprocessor(&per_cu, (const void*)mk_fwd, NTHR, LDS_BYTES) != hipSuccess || per_cu < 1) fprintf(stderr, "kernel_launch: occupancy query reports %d\n", per_cu);
        (void)hipGetLastError();
        grid = cus;
    }
    if (grid < 0) return;
    hipMemsetAsync((char*)d_ws + WS_CTL, 0, CTL_ZERO_BYTES, stream);
    Args a{};
    for (int i = 0; i < N_IN; ++i) a.in[i] = (const float*)d_in[i];
    a.out = (float*)d_out; a.ws = (unsigned char*)d_ws;
#if MK_ONE_LAUNCH
    a.ph_lo = 0; a.ph_hi = NPH;
    hipLaunchKernelGGL(mk_fwd, dim3(grid), dim3(NTHR), LDS_BYTES, stream, a);
#else
    for (int p = 0; p < NPH; ++p) { a.ph_lo = p; a.ph_hi = p + 1; hipLaunchKernelGGL(mk_fwd, dim3(grid), dim3(NTHR), LDS_BYTES, stream, a); }
#endif
}
```

```cpp
#include <hip/hip_runtime.h>
#include <cstdio>
#include <cstdint>
namespace pg8 {
#define PG8_LAS __attribute__((address_space(3)))
typedef unsigned short bf16_t;
typedef short bf16x8 __attribute__((ext_vector_type(8)));
typedef float f32x4 __attribute__((ext_vector_type(4)));
typedef unsigned u32x4 __attribute__((ext_vector_type(4)));
constexpr int BM = 256, BK = 64, HALF = 128, HTB = HALF * BK * 2  , STAGE_BYTES = 8 * HTB, NXCD = 8, WGM = 8;

__host__ __device__ __forceinline__ int lds_byte(int r, int c) { const int st = (r >> 4) * 2 + (c >> 5), rr = r & 15, cc = c & 31, ob = rr * 64 + cc * 2; return st * 1024 + (ob ^ (((ob >> 9) & 1) << 5)); }
__host__ __device__ __forceinline__ void stage_rc(int b, int& R, int& C) { const int st = b / 1024, sb = b % 1024, swz = sb ^ (((sb >> 9) & 1) << 5); R = (st >> 1) * 16 + swz / 64; C = (st & 1) * 32 + (swz % 64) / 2; }
__host__ __device__ __forceinline__ int perm32(int rho) { const int n = rho >> 4, i = rho & 15; return 8 * (i >> 2) + 4 * n + (i & 3); }

struct Unit { int pm, pn; };
struct Gemm { const bf16_t* A; const bf16_t* Bt; int M, N, K; };

struct StaticOrder {
    int nM, nN, nwg, G, c;
    __host__ __device__ void init(int M, int N, int G_, int c_) { nM = M / BM; nN = N / BM; nwg = nM * nN; G = G_; c = c_; }
    __host__ __device__ bool next(int i, Unit& u) const {
        const long L = (long)i * G + c; if (L >= nwg) return false;
        int wgid = (int)L; { const int q = nwg / NXCD, r = nwg % NXCD, xcd = wgid % NXCD, off = wgid / NXCD; wgid = (xcd < r ? xcd * (q + 1) : r * (q + 1) + (xcd - r) * q) + off; }
        const int nig = WGM * nN, gid = wgid / nig, fm = gid * WGM, gsz = (nM - fm) < WGM ? (nM - fm) : WGM;
        u.pm = fm + ((wgid % nig) % gsz); u.pn = (wgid % nig) / gsz; return true;
    }
    __device__ __forceinline__ void a_ready(const Unit&) const {}
    __device__ __forceinline__ void done(const Unit&) const {}
};

__device__ __forceinline__ unsigned cvt_pk_bf16(float lo, float hi) { unsigned r; asm volatile("v_cvt_pk_bf16_f32 %0, %1, %2" : "=v"(r) : "v"(lo), "v"(hi)); return r; }
typedef float f32x2 __attribute__((ext_vector_type(2)));
__device__ __forceinline__ f32x2 gelu_pk(f32x2 v) {
    const f32x2 av = __builtin_elementwise_abs(v), d = av * 0.2316418882f + 1.0f;
    f32x2 t; t.x = __builtin_amdgcn_rcpf(d.x); t.y = __builtin_amdgcn_rcpf(d.y);
    f32x2 q = t * 0.5307027145f + (-0.7265760135f); q = q * t + 0.7107068705f; q = q * t + (-0.142248368f); q = q * t + 0.127414796f; q = q * t;
    const f32x2 s = (v * v) * (-0.72134752044f);
    f32x2 e; e.x = __builtin_amdgcn_exp2f(s.x); e.y = __builtin_amdgcn_exp2f(s.y);
    const f32x2 m = v * (q * e), r = v - m;
    f32x2 o; o.x = v.x < 0.f ? m.x : r.x; o.y = v.y < 0.f ? m.y : r.y; return o;
}

template <int ACT  > struct EpiBf16 {
    static constexpr bool PERM = true, AFTER_DRAIN = false; static_assert(ACT == 0 || ACT == 1, "EpiBf16: ACT is 0 (none) or 1 (gelu_pk)");
    bf16_t* O; int ldc; const float* bias; int split_cols; size_t split_stride; float scale0;
    __device__ __forceinline__ void operator()(const f32x4 (&acc)[2][2][4][2], const Unit& u, int wr, int wc, int fr, int fq) const {
        const int row0 = u.pm * BM + wr * 64 + fr; int colt = u.pn * BM; bf16_t* base = O;
        float sc = 1.f; if (split_cols) { const int t = colt / split_cols; base += (size_t)t * split_stride; colt -= t * split_cols; if (t == 0) sc = scale0; }
        const int col0 = colt + wc * 32 + 8 * fq, bcol0 = u.pn * BM + wc * 32 + 8 * fq;
        f32x4 bv[2][2];
#pragma unroll
        for (int bj = 0; bj < 2; ++bj)
#pragma unroll
            for (int n = 0; n < 2; ++n) bv[bj][n] = bias ? *(const f32x4*)(bias + bcol0 + bj * HALF + 4 * n) : (f32x4){0.f, 0.f, 0.f, 0.f};
#pragma unroll
        for (int ai = 0; ai < 2; ++ai)
#pragma unroll
            for (int m = 0; m < 4; ++m) { bf16_t* rowp = base + (size_t)(row0 + ai * HALF + m * 16) * ldc + col0;
#pragma unroll
                for (int bj = 0; bj < 2; ++bj) { f32x4 v0 = acc[ai][bj][m][0] + bv[bj][0], v1 = acc[ai][bj][m][1] + bv[bj][1];
                    if (ACT == 1) { f32x2 a = gelu_pk((f32x2){v0[0], v0[1]}), b = gelu_pk((f32x2){v0[2], v0[3]}), c = gelu_pk((f32x2){v1[0], v1[1]}), d = gelu_pk((f32x2){v1[2], v1[3]});
                        v0 = (f32x4){a.x, a.y, b.x, b.y}; v1 = (f32x4){c.x, c.y, d.x, d.y}; }
                    v0 = v0 * sc; v1 = v1 * sc; u32x4 w; w.x = cvt_pk_bf16(v0[0], v0[1]); w.y = cvt_pk_bf16(v0[2], v0[3]); w.z = cvt_pk_bf16(v1[0], v1[1]); w.w = cvt_pk_bf16(v1[2], v1[3]);
                    *(u32x4*)(rowp + bj * HALF) = w; } }
    }
};
template <class Epi, class Sched, bool ALIGN_EPI = false, bool SP2 = false, bool F8 = false>
__device__ __forceinline__ void gemm_phase(PG8_LAS unsigned char* lds, const Gemm g, const Sched& S, const Epi& E) {
    const int tid = threadIdx.x, wid = __builtin_amdgcn_readfirstlane(tid >> 6), lane = tid & 63, wr = wid >> 2, wc = wid & 3, fr = lane & 15, fq = lane >> 4;
    int Kq = g.K; if constexpr (F8) asm volatile("" : "+s"(Kq));
    const int K = Kq, nt = K / BK;
    unsigned voffA[2], voffB[2];
#pragma unroll
    for (int i = 0; i < 2; ++i) { int R, C; stage_rc(tid * 16 + i * 8192, R, C); const int Rb = Epi::PERM ? ((R & ~31) + perm32(R & 31)) : R;
        voffA[i] = (unsigned)(R * K + C) * 2u; voffB[i] = (unsigned)(Rb * K + C) * 2u; }
    const size_t kstep = (size_t)(BK * 2);
    const size_t hstep = (size_t)HALF * K * 2;
    const size_t tstep = 2 * hstep;
    const unsigned ldsw = (unsigned)wid * 1024u;
    const int aoff = lds_byte(wr * 64 + fr, fq * 8), boff = lds_byte(wc * 32 + fr, fq * 8);
#define PG8_SA(b, h) (((b) * 2 + (h)) * HTB)
#define PG8_SB(b, h) ((4 + (b) * 2 + (h)) * HTB)
#define PG8_STAGE(bufoff, gbase, voff) do { _Pragma("unroll") for (int _i = 0; _i < 2; ++_i) \
        __builtin_amdgcn_global_load_lds((const unsigned*)((const char*)(gbase) + (voff)[_i]), (PG8_LAS unsigned*)(lds + (bufoff) + ldsw + _i * 8192), 16, 0, 0); } while (0)
#define PG8_LDA(dst, b, h) do { _Pragma("unroll") for (int m = 0; m < 4; ++m) { if constexpr (F8) { const i32x4_ lo_ = *(const PG8_LAS i32x4_*)(lds + PG8_SA(b, h) + aoff + m * 2048), hi_ = *(const PG8_LAS i32x4_*)(lds + PG8_SA(b, h) + aoff + m * 2048 + 1024); dst##8[m] = __builtin_shufflevector(lo_, hi_, 0, 1, 2, 3, 4, 5, 6, 7); } \
        else { _Pragma("unroll") for (int k = 0; k < 2; ++k) dst[m][k] = *(const PG8_LAS bf16x8*)(lds + PG8_SA(b, h) + aoff + m * 2048 + k * 1024); } } } while (0)
#define PG8_LDB(dst, b, h) do { _Pragma("unroll") for (int n = 0; n < 2; ++n) { if constexpr (F8) { const i32x4_ lo_ = *(const PG8_LAS i32x4_*)(lds + PG8_SB(b, h) + boff + n * 2048), hi_ = *(const PG8_LAS i32x4_*)(lds + PG8_SB(b, h) + boff + n * 2048 + 1024); dst##8[n] = __builtin_shufflevector(lo_, hi_, 0, 1, 2, 3, 4, 5, 6, 7); } \
        else { _Pragma("unroll") for (int k = 0; k < 2; ++k) dst[n][k] = *(const PG8_LAS bf16x8*)(lds + PG8_SB(b, h) + boff + n * 2048 + k * 1024); } } } while (0)
#define PG8_MMA(ai, bj, At, Bt) do { __builtin_amdgcn_s_setprio(1); _Pragma("unroll") for (int m = 0; m < 4; ++m) _Pragma("unroll") for (int n = 0; n < 2; ++n) { \
        if constexpr (F8) asm volatile("v_mfma_scale_f32_16x16x128_f8f6f4 %0, %1, %2, %0, %3, %3 op_sel_hi:[0,0,0]" : "+v"(acc[ai][bj][m][n]) : "v"(Bt##8[n]), "v"(At##8[m]), "v"(f8scale)); \
        else { _Pragma("unroll") for (int k = 0; k < 2; ++k) acc[ai][bj][m][n] = __builtin_amdgcn_mfma_f32_16x16x32_bf16(Bt[n][k], At[m][k], acc[ai][bj][m][n], 0, 0, 0); } } \
        __builtin_amdgcn_s_setprio(0); } while (0)
#define PG8_WAIT_V(n) asm volatile("s_waitcnt vmcnt(" #n ")" ::: "memory")
#define PG8_WAIT_L(n) asm volatile("s_waitcnt lgkmcnt(" #n ")" ::: "memory")
#define PG8_BAR __builtin_amdgcn_s_barrier()
#define PG8_SCHED __builtin_amdgcn_sched_barrier(0)
    Unit cur, nxt; int ui = 0;
    if (!S.next(0, cur)) return;
    f32x4 acc[2][2][4][2];
#pragma unroll
    for (int a = 0; a < 2; ++a)
#pragma unroll
        for (int b = 0; b < 2; ++b)
#pragma unroll
            for (int m = 0; m < 4; ++m)
#pragma unroll
                for (int n = 0; n < 2; ++n) { acc[a][b][m][n] = (f32x4){0.f, 0.f, 0.f, 0.f}; if constexpr (F8) asm volatile("" : "+v"(acc[a][b][m][n])); }
    bf16x8 At[4][2], B0[2][2], B1[2][2];
    typedef int i32x4_ __attribute__((ext_vector_type(4))); typedef int i32x8_ __attribute__((ext_vector_type(8)));
    i32x8_ At8[4], B08[2], B18[2];
    const int f8scale = 0x7f7f7f7f;
    const char* cA = (const char*)g.A + (size_t)cur.pm * tstep; const char* cB = (const char*)g.Bt + (size_t)cur.pn * tstep;
    S.a_ready(cur);
    if constexpr (SP2) {
        PG8_STAGE(PG8_SB(0, 0), cB, voffB); PG8_STAGE(PG8_SB(0, 1), cB + hstep, voffB); PG8_STAGE(PG8_SA(0, 0), cA, voffA); PG8_STAGE(PG8_SA(0, 1), cA + hstep, voffA);
        if (wr == 1) PG8_BAR;
        PG8_WAIT_V(2); PG8_BAR;
        PG8_STAGE(PG8_SB(1, 0), cB + kstep, voffB); PG8_STAGE(PG8_SA(1, 0), cA + kstep, voffA); PG8_STAGE(PG8_SB(1, 1), cB + hstep + kstep, voffB);
        PG8_WAIT_V(6); PG8_BAR;
    } else {
        PG8_STAGE(PG8_SB(0, 0), cB, voffB); PG8_STAGE(PG8_SA(0, 0), cA, voffA); PG8_STAGE(PG8_SB(0, 1), cB + hstep, voffB); PG8_STAGE(PG8_SA(0, 1), cA + hstep, voffA);
        if (wr == 1) PG8_BAR;
        PG8_WAIT_V(4); PG8_BAR;
        PG8_STAGE(PG8_SB(1, 0), cB + kstep, voffB); PG8_STAGE(PG8_SA(1, 0), cA + kstep, voffA); PG8_STAGE(PG8_SB(1, 1), cB + hstep + kstep, voffB);
        PG8_WAIT_V(6); PG8_BAR;
    }
    for (;;) {
        const bool has_next = S.next(ui + 1, nxt);
        const char* nA = has_next ? (const char*)g.A + (size_t)nxt.pm * tstep : cA; const char* nB = has_next ? (const char*)g.Bt + (size_t)nxt.pn * tstep : cB;
        for (int t = 0; t < nt; t += 2) {
            const bool last = (t == nt - 2);
            const char* a1 = cA + (size_t)(t + 1) * kstep;
            const char* a2 = last ? nA : cA + (size_t)(t + 2) * kstep; const char* b2 = last ? nB : cB + (size_t)(t + 2) * kstep;
            const char* a3 = a2 + kstep; const char* b3 = b2 + kstep;
            if (last && has_next) S.a_ready(nxt);
            if constexpr (SP2) {
            PG8_LDB(B0, 0, 0); PG8_LDB(B1, 0, 1); PG8_SCHED; PG8_LDA(At, 0, 0); PG8_STAGE(PG8_SA(1, 1), a1 + hstep, voffA);
            PG8_WAIT_V(8); PG8_WAIT_L(0); PG8_BAR; PG8_MMA(0, 0, At, B0); PG8_MMA(0, 1, At, B1); PG8_BAR; PG8_SCHED;
            PG8_LDA(At, 0, 1); PG8_STAGE(PG8_SB(0, 0), b2, voffB); PG8_STAGE(PG8_SB(0, 1), b2 + hstep, voffB); PG8_STAGE(PG8_SA(0, 0), a2, voffA);
            PG8_WAIT_V(8); PG8_WAIT_L(0); PG8_BAR; PG8_MMA(1, 0, At, B0); PG8_MMA(1, 1, At, B1); PG8_BAR; PG8_SCHED;
            PG8_LDB(B0, 1, 0); PG8_LDB(B1, 1, 1); PG8_SCHED; PG8_LDA(At, 1, 0); PG8_STAGE(PG8_SA(0, 1), a2 + hstep, voffA);
            PG8_WAIT_V(8); PG8_WAIT_L(0); PG8_BAR; PG8_MMA(0, 0, At, B0); PG8_MMA(0, 1, At, B1); PG8_BAR; PG8_SCHED;
            PG8_LDA(At, 1, 1); PG8_STAGE(PG8_SB(1, 0), b3, voffB); PG8_STAGE(PG8_SB(1, 1), b3 + hstep, voffB); PG8_STAGE(PG8_SA(1, 0), a3, voffA);
            PG8_WAIT_V(8); PG8_WAIT_L(0); PG8_BAR; PG8_MMA(1, 0, At, B0); PG8_MMA(1, 1, At, B1); PG8_BAR; PG8_SCHED;
            } else {
            PG8_LDB(B0, 0, 0); PG8_SCHED; PG8_LDA(At, 0, 0); PG8_STAGE(PG8_SA(1, 1), a1 + hstep, voffA);
            PG8_WAIT_L(8); PG8_BAR; PG8_WAIT_L(0); PG8_MMA(0, 0, At, B0); PG8_BAR; PG8_SCHED;
            PG8_LDB(B1, 0, 1); PG8_STAGE(PG8_SB(0, 0), b2, voffB);
            PG8_BAR; PG8_WAIT_L(0); PG8_MMA(0, 1, At, B1); PG8_BAR;
            PG8_LDA(At, 0, 1); PG8_STAGE(PG8_SA(0, 0), a2, voffA);
            PG8_BAR; PG8_WAIT_L(0); PG8_MMA(1, 0, At, B0); PG8_BAR; PG8_SCHED;
            PG8_STAGE(PG8_SB(0, 1), b2 + hstep, voffB);
            PG8_WAIT_V(6); PG8_BAR; PG8_MMA(1, 1, At, B1); PG8_BAR;
            PG8_LDB(B0, 1, 0); PG8_SCHED; PG8_LDA(At, 1, 0); PG8_STAGE(PG8_SA(0, 1), a2 + hstep, voffA);
            PG8_WAIT_L(8); PG8_BAR; PG8_WAIT_L(0); PG8_MMA(0, 0, At, B0); PG8_BAR; PG8_SCHED;
            PG8_LDB(B1, 1, 1); PG8_STAGE(PG8_SB(1, 0), b3, voffB);
            PG8_BAR; PG8_WAIT_L(0); PG8_MMA(0, 1, At, B1); PG8_BAR;
            PG8_LDA(At, 1, 1); PG8_STAGE(PG8_SA(1, 0), a3, voffA);
            PG8_BAR; PG8_WAIT_L(0); PG8_MMA(1, 0, At, B0); PG8_BAR; PG8_SCHED;
            PG8_STAGE(PG8_SB(1, 1), b3 + hstep, voffB);
            PG8_WAIT_V(6); PG8_BAR; PG8_MMA(1, 1, At, B1); PG8_BAR;
            }
        }
        if constexpr (F8) asm volatile("s_nop 15\n\ts_nop 15" ::: "memory");
        if constexpr (ALIGN_EPI) { if (wr == 0) PG8_BAR; }
        if constexpr (!Epi::AFTER_DRAIN) { E(acc, cur, wr, wc, fr, fq); S.done(cur); }
        if (!has_next) break;
#pragma unroll
        for (int a = 0; a < 2; ++a)
#pragma unroll
            for (int b = 0; b < 2; ++b)
#pragma unroll
                for (int m = 0; m < 4; ++m)
#pragma unroll
                    for (int n = 0; n < 2; ++n) { acc[a][b][m][n] = (f32x4){0.f, 0.f, 0.f, 0.f}; if constexpr (F8) asm volatile("" : "+v"(acc[a][b][m][n])); }
        cur = nxt; cA = nA; cB = nB; ++ui;
        if constexpr (ALIGN_EPI) { if (wr == 1) PG8_BAR; }
    }
    PG8_WAIT_V(0);
    if constexpr (!ALIGN_EPI) { if (wr == 0) PG8_BAR; }
    PG8_BAR;
    if constexpr (Epi::AFTER_DRAIN) { E.fused(acc, cur, wr, wc, fr, fq, lds, wid, lane); S.done(cur); }
#undef PG8_SA
#undef PG8_SB
#undef PG8_STAGE
#undef PG8_LDA
#undef PG8_LDB
#undef PG8_MMA
#undef PG8_WAIT_V
#undef PG8_WAIT_L
#undef PG8_BAR
#undef PG8_SCHED
}
}
#define LAS __attribute__((address_space(3)))
#define XB_TMO      128
#define XB_XCNT(j)  (256  + 64 * (j))
#define XB_XSUB(j)  (1280 + 64 * (j))
#define XB_XGEN(j)  (2304 + 64 * (j))
#define XB_TOP      3328
#define XB_TOPGEN   3392
#define XCD_BAR_WORDS 3456
#define XB_SPIN_CAP (1u << 18)

__device__ __forceinline__ unsigned xb_ld(unsigned* p)              { return __hip_atomic_load(p, __ATOMIC_RELAXED, __HIP_MEMORY_SCOPE_AGENT); }
__device__ __forceinline__ unsigned xb_add(unsigned* p, unsigned v) { return __hip_atomic_fetch_add(p, v, __ATOMIC_RELAXED, __HIP_MEMORY_SCOPE_AGENT); }
__device__ __forceinline__ unsigned xb_xcc_id() { return (unsigned)__builtin_amdgcn_s_getreg((3 << 11) | 20) & 0xFu; }
#define XB_SPIN(cond, bar) do { unsigned _sp = 0; while (cond) { __builtin_amdgcn_s_sleep(1); \
    if ((++_sp & 255u) == 0u) { if (xb_ld(&(bar)[XB_TMO])) break; if (_sp > XB_SPIN_CAP) { atomicAdd(&(bar)[XB_TMO], 1u); break; } } } } while (0)

struct XcdBarrier {
    unsigned* bar; unsigned x;
    volatile LAS unsigned* st;
};

__device__ __forceinline__ XcdBarrier xcd_barrier_post(unsigned* bar, volatile LAS unsigned* st) {
    XcdBarrier b; b.bar = bar; b.x = xb_xcc_id(); b.st = st;
    if (threadIdx.x == 0) (void)xb_add(&bar[XB_XCNT(b.x)], 1u);
    return b;
}
__device__ __forceinline__ void xcd_barrier_complete(unsigned* bar, unsigned x, unsigned& nloc, unsigned& nx) {
    const unsigned G = gridDim.x * gridDim.y * gridDim.z;
    unsigned sum, cnt, mine, sp = 0u;
    for (;;) {
        sum = 0u; cnt = 0u; mine = 0u;
#pragma unroll
        for (unsigned j = 0; j < 16; ++j) { const unsigned c = xb_ld(&bar[XB_XCNT(j)]); sum += c; cnt += (c > 0u) ? 1u : 0u; mine = (j == x) ? c : mine; }
        if (sum == G) break;
        __builtin_amdgcn_s_sleep(1);
        if ((++sp & 255u) == 0u) { if (xb_ld(&bar[XB_TMO])) break; if (sp > XB_SPIN_CAP) { atomicAdd(&bar[XB_TMO], 1u); break; } }
    }
    nloc = mine > 0u ? mine : 1u; nx = cnt > 0u ? cnt : 1u;
}

__device__ __forceinline__ void xcd_barrier(const XcdBarrier& b) {
    asm volatile("s_waitcnt vmcnt(0)" ::: "memory");
    __syncthreads();
    if (threadIdx.x == 0) {
        unsigned* bar = b.bar;
        __builtin_amdgcn_s_waitcnt(0);
        unsigned nloc = b.st[0], nx = b.st[1];
        if (nloc == 0u) { xcd_barrier_complete(bar, b.x, nloc, nx); b.st[0] = nloc; b.st[1] = nx; }
        const unsigned old = xb_add(&bar[XB_XSUB(b.x)], 1u);
        const unsigned gen = old / nloc;
        if (old + 1u == (gen + 1u) * nloc) {
            __builtin_amdgcn_fence(__ATOMIC_RELEASE, "agent");
            asm volatile("s_waitcnt vmcnt(0)" ::: "memory");
            const unsigned og = xb_add(&bar[XB_TOP], 1u);
            const unsigned tg = og / nx;
            if (og + 1u == (tg + 1u) * nx) xb_add(&bar[XB_TOPGEN], 1u);
            else XB_SPIN(xb_ld(&bar[XB_TOPGEN]) == tg, bar);
            __builtin_amdgcn_fence(__ATOMIC_ACQUIRE, "agent");
            xb_add(&bar[XB_XGEN(b.x)], 1u);
            asm volatile("s_waitcnt vmcnt(0)" ::: "memory");
        } else {
            XB_SPIN(xb_ld(&bar[XB_XGEN(b.x)]) == gen, bar);
            __builtin_amdgcn_fence(__ATOMIC_ACQUIRE, "agent");
            asm volatile("s_waitcnt vmcnt(0)" ::: "memory");
        }
    }
    __syncthreads();
}

#define DI __device__ __forceinline__
#define LDS_WAIT() asm volatile("s_waitcnt lgkmcnt(0)" ::: "memory")
typedef unsigned short bf16;
typedef float f32x4 __attribute__((ext_vector_type(4)));

namespace mk {
constexpr int NB = 8, SEQ = 2048, DM = 1024, NT = NB * SEQ, NL = 2;
constexpr int INW = 3856, ZLD = 4096;
constexpr int ZA = 0, ZRKV = 768, ZWDF = 1920, ZWDB = 1984, ZADF = 2048, ZADB = 2112, ZGD = 2176, ZMQK = 2304, ZMV = 3072, ZMO = 3456, ZMG = 3840;
constexpr int RW = 384, MW = 384, AW = 256;
constexpr int NE = 16, CAP = 256, FF = 2816, NSLOT = NB * NE * CAP;
constexpr int NWAVES = 8, NTHR = 512;
constexpr float RMS_EPS = 1e-6f;

enum { I_X = 0, I_RELB, I_LN1G, I_WIN, I_WOUT, I_MU, I_W0, I_W2, I_A0, I_A2, I_KK, I_KA, I_RK, I_G2, I_RLNG, I_RLNB,
       I_CW, I_CB, I_IB, I_FB, I_MLNG, I_LN2G, I_ROUTER, I_EW1, I_EW3, I_EW2, I_FG, N_IN };

constexpr size_t MiB = 1u << 20;
constexpr size_t WS_CTL = 0, CTL_ZERO_BYTES = 1 * MiB;
constexpr size_t WS_WTIN = 2 * MiB;
constexpr size_t WS_WTOUT = 18 * MiB;
constexpr size_t WS_W13T = 22 * MiB;
constexpr size_t WS_W2T = 374 * MiB;
constexpr size_t WS_X1 = 550 * MiB;
constexpr size_t WS_X2 = 614 * MiB;
constexpr size_t WS_HB = 678 * MiB;
constexpr size_t WS_AFF = 710 * MiB;
constexpr size_t WS_SEL = 711 * MiB;
constexpr size_t WS_GATE = 712 * MiB;
constexpr size_t WS_R = 714 * MiB;
constexpr size_t WS_Z = WS_R;
constexpr size_t WS_ATTO = WS_R + 128 * MiB;
constexpr size_t WS_ATTL = WS_R + 152 * MiB;
constexpr size_t WS_PR = WS_R + 154 * MiB;
constexpr size_t WS_RKY = WS_R + 442 * MiB;
constexpr size_t WS_RKB = WS_R + 490 * MiB;
constexpr size_t WS_MLQK = WS_R + 538 * MiB;
constexpr size_t WS_MLNUM = WS_R + 586 * MiB;
constexpr size_t WS_MLDEN = WS_R + 634 * MiB;
constexpr size_t WS_XG = WS_R;
constexpr size_t WS_ACT = WS_R + 64 * MiB;
constexpr size_t WS_YS = WS_R + 240 * MiB;
constexpr size_t WS_END = WS_R + 636 * MiB;

constexpr int CW_BAR = 4096;
constexpr int LDS_BYTES = 147456;
constexpr int MISC_OFF = LDS_BYTES - 256;

struct Args { const float* in[N_IN]; float* out; unsigned char* ws; int ph_lo, ph_hi; };

DI float bf2f(unsigned v) { return __uint_as_float(v << 16); }
DI unsigned f2bf(float f) { unsigned u = __float_as_uint(f); return (u + 0x7fffu + ((u >> 16) & 1u)) >> 16; }
DI unsigned pk2(float lo, float hi) { return f2bf(lo) | (f2bf(hi) << 16); }
DI float wave_sum(float v) {
#pragma unroll
    for (int o = 1; o < 64; o <<= 1) v += __shfl_xor(v, o);
    return v;
}
DI float sigm(float x) { return 1.f / (1.f + __expf(-x)); }
DI void unpack8(const uint4 w, float (&f)[8]) {
    f[0] = __uint_as_float(w.x << 16); f[1] = __uint_as_float(w.x & 0xffff0000u); f[2] = __uint_as_float(w.y << 16); f[3] = __uint_as_float(w.y & 0xffff0000u);
    f[4] = __uint_as_float(w.z << 16); f[5] = __uint_as_float(w.z & 0xffff0000u); f[6] = __uint_as_float(w.w << 16); f[7] = __uint_as_float(w.w & 0xffff0000u);
}

struct GroupOrder {
    int G, c2, nunits, per_e, nN;
    DI void init(int nN_, int G_, int bid) { nN = nN_; per_e = 8 * nN_; nunits = NE * per_e; G = G_; c2 = (G_ % 8 == 0) ? (bid % 8) * (G_ / 8) + bid / 8 : bid; }
    DI bool next(int i, pg8::Unit& u) const {
        const long L = (long)i * G + c2; if (L >= nunits) return false;
        const int e = (int)L / per_e, r = (int)L % per_e; u.pm = e * 8 + (r & 7); u.pn = e * nN + (r >> 3); return true;
    }
    DI void a_ready(const pg8::Unit&) const {}
    DI void done(const pg8::Unit&) const {}
};
struct EpiResF32 {
    static constexpr bool PERM = false, AFTER_DRAIN = false;
    const float* base; float* out; int ldc;
    DI void operator()(const pg8::f32x4 (&acc)[2][2][4][2], const pg8::Unit& u, int wr, int wc, int fr, int fq) const {
        const int row0 = u.pm * 256 + wr * 64 + fr, col0 = u.pn * 256 + wc * 32 + 4 * fq;
#pragma unroll
        for (int ai = 0; ai < 2; ++ai)
#pragma unroll
            for (int m = 0; m < 4; ++m) { const size_t off = (size_t)(row0 + ai * 128 + m * 16) * ldc + col0;
#pragma unroll
                for (int bj = 0; bj < 2; ++bj)
#pragma unroll
                    for (int n = 0; n < 2; ++n) { const pg8::f32x4 b = *(const pg8::f32x4*)(base + off + bj * 128 + n * 16); *(pg8::f32x4*)(out + off + bj * 128 + n * 16) = b + acc[ai][bj][m][n]; } }
    }
};
DI float silu_f(float x) { return x * __builtin_amdgcn_rcpf(1.f + __expf(-x)); }
DI unsigned pk4_fp8(float a, float b, float c, float d) { unsigned p = 0u; p = __builtin_amdgcn_cvt_pk_fp8_f32(a, b, p, false); p = __builtin_amdgcn_cvt_pk_fp8_f32(c, d, p, true); return p; }
constexpr float F8_WSC = 64.f, F8_HSC = 8.f, F8_ASC = 16.f;
struct EpiSwiGLU {
    static constexpr bool PERM = true, AFTER_DRAIN = false;
    unsigned char* act; int nN;
    DI void operator()(const pg8::f32x4 (&acc)[2][2][4][2], const pg8::Unit& u, int wr, int wc, int fr, int fq) const {
        const int lpn = u.pn % nN; const int row0 = u.pm * 256 + wr * 64 + fr, col0 = lpn * 128 + wc * 32 + 8 * fq; constexpr float is = 1.f / (F8_HSC * F8_WSC);
#pragma unroll
        for (int ai = 0; ai < 2; ++ai)
#pragma unroll
            for (int m = 0; m < 4; ++m) { unsigned char* p = act + (size_t)(row0 + ai * 128 + m * 16) * FF + col0;
                const pg8::f32x4 a0 = acc[ai][0][m][0] * is, a1 = acc[ai][0][m][1] * is, g0 = acc[ai][1][m][0] * (is * F8_ASC), g1 = acc[ai][1][m][1] * (is * F8_ASC);
                uint2 w; w.x = pk4_fp8(silu_f(a0[0]) * g0[0], silu_f(a0[1]) * g0[1], silu_f(a0[2]) * g0[2], silu_f(a0[3]) * g0[3]);
                w.y = pk4_fp8(silu_f(a1[0]) * g1[0], silu_f(a1[1]) * g1[1], silu_f(a1[2]) * g1[2], silu_f(a1[3]) * g1[3]);
                *(uint2*)p = w; }
    }
};
struct EpiGate {
    static constexpr bool PERM = true, AFTER_DRAIN = false;
    bf16* ys; const float* gate;
    DI void operator()(const pg8::f32x4 (&acc)[2][2][4][2], const pg8::Unit& u, int wr, int wc, int fr, int fq) const {
        const int row0 = u.pm * 256 + wr * 64 + fr, col0 = (u.pn & 3) * 256 + wc * 32 + 8 * fq;
#pragma unroll
        for (int ai = 0; ai < 2; ++ai)
#pragma unroll
            for (int m = 0; m < 4; ++m) { const int row = row0 + ai * 128 + m * 16; const float g = gate[row] * (1.f / (F8_ASC * F8_WSC)); bf16* p = ys + (size_t)row * DM + col0;
#pragma unroll
                for (int bj = 0; bj < 2; ++bj) { const pg8::f32x4 v0 = acc[ai][bj][m][0] * g, v1 = acc[ai][bj][m][1] * g; pg8::u32x4 w;
                    w.x = pg8::cvt_pk_bf16(v0[0], v0[1]); w.y = pg8::cvt_pk_bf16(v0[2], v0[3]); w.z = pg8::cvt_pk_bf16(v1[0], v1[1]); w.w = pg8::cvt_pk_bf16(v1[2], v1[3]);
                    *(pg8::u32x4*)(p + bj * 128) = w; } }
    }
};

DI void cvt_tile(const float* W, int N, int nvalid, int k0, int n0, bf16* dst, int Kd, size_t drow0, LAS float* scr, int lane) {
    const int c4 = (lane & 15) * 4, kr = lane >> 4;
#pragma unroll
    for (int it = 0; it < 16; ++it) { const int k = it * 4 + kr; float4 v = make_float4(0.f, 0.f, 0.f, 0.f);
        if (n0 + c4 < nvalid) v = *(const float4*)(W + (size_t)(k0 + k) * N + n0 + c4);
        LAS float* s = scr + k * 65 + c4; s[0] = v.x; s[1] = v.y; s[2] = v.z; s[3] = v.w; }
    LDS_WAIT(); asm volatile("" ::: "memory");
    const int c = lane & 7;
#pragma unroll
    for (int it = 0; it < 8; ++it) { const int n = it * 8 + (lane >> 3); const LAS float* s = scr + (8 * c) * 65 + n;
        uint4 o; o.x = pk2(s[0], s[65]); o.y = pk2(s[130], s[195]); o.z = pk2(s[260], s[325]); o.w = pk2(s[390], s[455]);
        *(uint4*)(dst + (drow0 + n) * (size_t)Kd + k0 + 8 * c) = o; }
    LDS_WAIT(); asm volatile("" ::: "memory");
}
DI void cvt_tile_fp8(const float* W, int N, int k0, int n0, unsigned char* dst, int Kd, size_t drow0, float sc, LAS float* scr, int lane) {
    const int c4 = (lane & 15) * 4, kr = lane >> 4;
#pragma unroll
    for (int it = 0; it < 16; ++it) { const int k = it * 4 + kr; const float4 v = *(const float4*)(W + (size_t)(k0 + k) * N + n0 + c4);
        LAS float* s = scr + k * 65 + c4; s[0] = v.x * sc; s[1] = v.y * sc; s[2] = v.z * sc; s[3] = v.w * sc; }
    LDS_WAIT(); asm volatile("" ::: "memory");
    const int c = lane & 3;
#pragma unroll
    for (int it = 0; it < 4; ++it) { const int n = it * 16 + (lane >> 2); const LAS float* s = scr + (16 * c) * 65 + n;
        uint4 o; o.x = pk4_fp8(s[0], s[65], s[130], s[195]); o.y = pk4_fp8(s[260], s[325], s[390], s[455]); o.z = pk4_fp8(s[520], s[585], s[650], s[715]); o.w = pk4_fp8(s[780], s[845], s[910], s[975]);
        *(uint4*)(dst + (drow0 + n) * (size_t)Kd + k0 + 16 * c) = o; }
    LDS_WAIT(); asm volatile("" ::: "memory");
}
DI void phase_p0(const Args& A, LAS unsigned char* lds, int gw, int ngw, int wave, int lane) {
    LAS float* scr = (LAS float*)(lds + wave * 16640);
    bf16* wtin = (bf16*)(A.ws + WS_WTIN); bf16* wtout = (bf16*)(A.ws + WS_WTOUT); unsigned char* w13 = A.ws + WS_W13T; unsigned char* w2t = A.ws + WS_W2T;
    constexpr int I_IN = NL * 16 * 64, I_OUT = NL * 16 * 16, I_E = 16 * 44, I_MOE = NL * NE * 3 * I_E;
    for (int it = gw; it < I_IN + I_OUT + I_MOE; it += ngw) {
        int r = it;
        if (r < I_IN) { const int l = r / 1024, t = r % 1024, kb = t / 64, nb = t % 64;
            cvt_tile(A.in[I_WIN] + (size_t)l * DM * INW, INW, INW, kb * 64, nb * 64, wtin + (size_t)l * ZLD * DM, DM, (size_t)nb * 64, scr, lane); continue; }
        r -= I_IN;
        if (r < I_OUT) { const int l = r / 256, t = r % 256, kb = t / 16, nb = t % 16;
            cvt_tile(A.in[I_WOUT] + (size_t)l * DM * DM, DM, DM, kb * 64, nb * 64, wtout + (size_t)l * DM * DM, DM, (size_t)nb * 64, scr, lane); continue; }
        r -= I_OUT;
        const int le = r / (3 * I_E), q = r % (3 * I_E), which = q / I_E, t = q % I_E;
        if (which < 2) { const int kb = t / 44, nb = t % 44, n0 = nb * 64;
            cvt_tile_fp8(A.in[which == 0 ? I_EW1 : I_EW3] + (size_t)le * DM * FF, FF, kb * 64, n0, w13 + (size_t)le * 5632 * DM, DM, (size_t)((n0 >> 7) * 256 + which * 128 + (n0 & 127)), F8_WSC, scr, lane); }
        else { const int kb = t / 16, nb = t % 16;
            cvt_tile_fp8(A.in[I_EW2] + (size_t)le * FF * DM, DM, kb * 64, nb * 64, w2t + (size_t)le * DM * FF, FF, (size_t)nb * 64, F8_WSC, scr, lane); }
    }
}

DI void load_row(const float* xrow, int lane, f32x4 (&v)[4]) {
    const f32x4* xr = (const f32x4*)xrow + lane;
#pragma unroll
    for (int j = 0; j < 4; ++j) v[j] = xr[64 * j];
}
DI void add_slots(const Args& A, int tok, int lane, f32x4 (&v)[4]) {
    const int* sel = (const int*)(A.ws + WS_SEL); const bf16* ys = (const bf16*)(A.ws + WS_YS);
    const int b = tok / SEQ; const int mys = (lane < NE) ? sel[(size_t)tok * NE + lane] : -1;
    for (int e = 0; e < NE; ++e) { const int r = __shfl(mys, e);
        if (r >= 0) { const uint2* p = (const uint2*)(ys + (size_t)((e * NB + b) * CAP + r) * DM) + lane;
#pragma unroll
            for (int j = 0; j < 4; ++j) { const uint2 w = p[64 * j]; v[j][0] += __uint_as_float(w.x << 16); v[j][1] += __uint_as_float(w.x & 0xffff0000u); v[j][2] += __uint_as_float(w.y << 16); v[j][3] += __uint_as_float(w.y & 0xffff0000u); } } }
}
DI float row_rstd(const f32x4 (&v)[4]) {
    float s = 0.f;
#pragma unroll
    for (int j = 0; j < 4; ++j) s += (v[j][0] * v[j][0] + v[j][1] * v[j][1]) + (v[j][2] * v[j][2] + v[j][3] * v[j][3]);
    return rsqrtf(wave_sum(s) * (1.f / DM) + RMS_EPS);
}
DI unsigned pkbf(float lo, float hi) { typedef __bf16 b2 __attribute__((ext_vector_type(2))); typedef float f2 __attribute__((ext_vector_type(2))); const f2 v = {lo, hi}; return __builtin_bit_cast(unsigned, __builtin_convertvector(v, b2)); }
DI void phase_ln1(const Args& A, int l, int gw, int ngw, int lane) {
    const float* xin = (l == 0) ? A.in[I_X] : (const float*)(A.ws + WS_X1); float* x2 = (float*)(A.ws + WS_X2); bf16* hb = (bf16*)(A.ws + WS_HB);
    f32x4 gg[4];
#pragma unroll
    for (int j = 0; j < 4; ++j) gg[j] = ((const f32x4*)(A.in[I_LN1G] + (size_t)l * DM) + lane)[64 * j];
    for (int tok = gw; tok < NT; tok += 2 * ngw) {
        const int tokb = tok + ngw; const bool hb2 = tokb < NT;
        f32x4 va[4], vb[4]; load_row(xin + (size_t)tok * DM, lane, va); load_row(xin + (size_t)(hb2 ? tokb : tok) * DM, lane, vb);
        if (l > 0) { add_slots(A, tok, lane, va); add_slots(A, hb2 ? tokb : tok, lane, vb);
            f32x4* oa = (f32x4*)(x2 + (size_t)tok * DM) + lane; f32x4* ob = (f32x4*)(x2 + (size_t)tokb * DM) + lane;
#pragma unroll
            for (int j = 0; j < 4; ++j) { oa[64 * j] = va[j]; if (hb2) ob[64 * j] = vb[j]; } }
        const float ra = row_rstd(va), rb = row_rstd(vb); uint2* o8a = (uint2*)(hb + (size_t)tok * DM) + lane; uint2* o8b = (uint2*)(hb + (size_t)tokb * DM) + lane;
#pragma unroll
        for (int j = 0; j < 4; ++j) { uint2 w; w.x = pkbf(va[j][0] * ra * gg[j][0], va[j][1] * ra * gg[j][1]); w.y = pkbf(va[j][2] * ra * gg[j][2], va[j][3] * ra * gg[j][3]); o8a[64 * j] = w;
            if (hb2) { uint2 u; u.x = pkbf(vb[j][0] * rb * gg[j][0], vb[j][1] * rb * gg[j][1]); u.y = pkbf(vb[j][2] * rb * gg[j][2], vb[j][3] * rb * gg[j][3]); o8b[64 * j] = u; } }
    }
}
DI void phase_final(const Args& A, int gw, int ngw, int lane) {
    const float* xin = (const float*)(A.ws + WS_X1);
    f32x4 gg[4];
#pragma unroll
    for (int j = 0; j < 4; ++j) gg[j] = ((const f32x4*)A.in[I_FG] + lane)[64 * j];
    for (int tok = gw; tok < NT; tok += 2 * ngw) {
        const int tokb = tok + ngw; const bool hb2 = tokb < NT;
        f32x4 va[4], vb[4]; load_row(xin + (size_t)tok * DM, lane, va); load_row(xin + (size_t)(hb2 ? tokb : tok) * DM, lane, vb);
        add_slots(A, tok, lane, va); add_slots(A, hb2 ? tokb : tok, lane, vb);
        const float ra = row_rstd(va), rb = row_rstd(vb); f32x4* oa = (f32x4*)(A.out + (size_t)tok * DM) + lane; f32x4* ob = (f32x4*)(A.out + (size_t)tokb * DM) + lane;
#pragma unroll
        for (int j = 0; j < 4; ++j) { oa[64 * j] = va[j] * ra * gg[j]; if (hb2) ob[64 * j] = vb[j] * rb * gg[j]; }
    }
}
DI void ln2_row(const f32x4 (&v)[4], const f32x4 (&gg)[4], const LAS float* rt, unsigned char* hrow, float* affrow, int lane) {
    const float rs = row_rstd(v); unsigned* o8 = (unsigned*)hrow + lane;
    float lg[NE];
#pragma unroll
    for (int e = 0; e < NE; ++e) lg[e] = 0.f;
#pragma unroll
    for (int j = 0; j < 4; ++j) { f32x4 h; h[0] = v[j][0] * rs * gg[j][0]; h[1] = v[j][1] * rs * gg[j][1]; h[2] = v[j][2] * rs * gg[j][2]; h[3] = v[j][3] * rs * gg[j][3];
        o8[64 * j] = pk4_fp8(h[0] * F8_HSC, h[1] * F8_HSC, h[2] * F8_HSC, h[3] * F8_HSC);
#pragma unroll
        for (int e = 0; e < NE; ++e) { const f32x4 rr = *(const LAS f32x4*)(rt + e * DM + 256 * j + 4 * lane); lg[e] += (h[0] * rr[0] + h[1] * rr[1]) + (h[2] * rr[2] + h[3] * rr[3]); }
        asm volatile("" ::: "memory"); }
    float mx = -3.0e38f;
#pragma unroll
    for (int e = 0; e < NE; ++e) { lg[e] = wave_sum(lg[e]); mx = fmaxf(mx, lg[e]); }
    float sum = 0.f;
#pragma unroll
    for (int e = 0; e < NE; ++e) { lg[e] = expf(lg[e] - mx); sum += lg[e]; }
    const float inv = 1.f / sum;
#pragma unroll
    for (int e = 0; e < NE; ++e) if (lane == e) affrow[(size_t)e * SEQ] = lg[e] * inv;
}
DI void phase_ln2(const Args& A, int l, LAS unsigned char* lds, int gw, int ngw, int tid, int lane) {
    const float* xin = (const float*)(A.ws + WS_X1); unsigned char* hb = A.ws + WS_HB; float* aff = (float*)(A.ws + WS_AFF);
    const float* router = A.in[I_ROUTER] + (size_t)l * DM * NE; LAS float* rt = (LAS float*)lds;
    __syncthreads();
    for (int i = tid; i < DM * NE; i += NTHR) rt[(i & 15) * DM + (i >> 4)] = router[i];
    __syncthreads();
    f32x4 gg[4];
#pragma unroll
    for (int j = 0; j < 4; ++j) gg[j] = ((const f32x4*)(A.in[I_LN2G] + (size_t)l * DM) + lane)[64 * j];
    for (int tok = gw; tok < NT; tok += 2 * ngw) {
        const int tokb = tok + ngw; const bool hb2 = tokb < NT;
        f32x4 va[4], vb[4]; load_row(xin + (size_t)tok * DM, lane, va); load_row(xin + (size_t)(hb2 ? tokb : tok) * DM, lane, vb);
        ln2_row(va, gg, rt, hb + (size_t)tok * DM, aff + (size_t)(tok / SEQ) * NE * SEQ + (tok % SEQ), lane);
        if (hb2) ln2_row(vb, gg, rt, hb + (size_t)tokb * DM, aff + (size_t)(tokb / SEQ) * NE * SEQ + (tokb % SEQ), lane);
    }
    __syncthreads();
}
DI void phase_topk(const Args& A, LAS unsigned char* lds, int bid, int G, int tid, int wave, int lane) {
    const unsigned* affk = (const unsigned*)(A.ws + WS_AFF); int* sel = (int*)(A.ws + WS_SEL); float* gate = (float*)(A.ws + WS_GATE);
    const unsigned char* hb = A.ws + WS_HB; unsigned char* xg = A.ws + WS_XG;
    LAS unsigned* hist = (LAS unsigned*)lds;
    LAS unsigned* wsum = hist + 32;
    LAS int* list = (LAS int*)(lds + 256);
    for (int u = bid; u < NB * NE * 2; u += G) {
        const int half = u & 1, e = (u >> 1) % NE, b = u / (2 * NE);
        __syncthreads();
        if (tid < 32) hist[tid] = 0u;
        const uint4 kv = *(const uint4*)(affk + (size_t)(b * NE + e) * SEQ + tid * 4);
        const unsigned key[4] = {kv.x, kv.y, kv.z, kv.w};
        __syncthreads();
        unsigned prefix = 0u, krem = CAP;
#pragma unroll 1
        for (int pass = 0; pass < 8; ++pass) { const int shift = 28 - 4 * pass; LAS unsigned* h = hist + (pass & 1) * 16;
            unsigned cnt = 0u;
#pragma unroll
            for (int i = 0; i < 4; ++i) { const bool cand = (pass == 0) || ((key[i] >> (shift + 4)) == prefix); const unsigned bin = (key[i] >> shift) & 15u;
#pragma unroll
                for (int v = 0; v < 16; ++v) { const unsigned long long m = __ballot(cand && bin == (unsigned)v); if (lane == v) cnt += (unsigned)__popcll(m); } }
            if (lane < 16 && cnt) atomicAdd((unsigned*)(h + lane), cnt);
            __syncthreads();
            unsigned acc = 0u, pick = 0u, before = 0u;
#pragma unroll
            for (int v = 15; v >= 0; --v) { const unsigned c = h[v]; if (acc < krem && acc + c >= krem) { pick = (unsigned)v; before = acc; } acc += c; }
            prefix = (prefix << 4) | pick; krem -= before;
            if (tid < 16) hist[((pass + 1) & 1) * 16 + tid] = 0u;
            __syncthreads();
        }
        const unsigned tau = prefix;
        unsigned gt[4], eq[4]; unsigned ngt = 0u, neq = 0u;
#pragma unroll
        for (int i = 0; i < 4; ++i) { gt[i] = key[i] > tau ? 1u : 0u; eq[i] = key[i] == tau ? 1u : 0u; ngt += gt[i]; neq += eq[i]; }
        unsigned sg = ngt, se = neq;
#pragma unroll
        for (int o = 1; o < 64; o <<= 1) { const unsigned tg = __shfl_up(sg, o), te = __shfl_up(se, o); if (lane >= o) { sg += tg; se += te; } }
        if (lane == 63) { wsum[wave] = sg; wsum[8 + wave] = se; }
        __syncthreads();
        unsigned offg = 0u, offe = 0u;
        for (int w = 0; w < wave; ++w) { offg += wsum[w]; offe += wsum[8 + w]; }
        unsigned eqbefore = offe + se - neq;
        unsigned gtbefore = offg + sg - ngt;
        const int slot0 = (e * NB + b) * CAP;
#pragma unroll
        for (int i = 0; i < 4; ++i) { const int s = tid * 4 + i; const bool selq = gt[i] || (eq[i] && eqbefore < krem);
            const unsigned pos = gtbefore + (eqbefore < krem ? eqbefore : krem);
            if ((s >> 10) == half) { sel[(size_t)(b * SEQ + s) * NE + e] = selq ? (int)pos : -1;
                if (selq) { gate[slot0 + pos] = __uint_as_float(key[i]); } }
            if (selq && pos < CAP) list[pos] = s;
            gtbefore += gt[i]; eqbefore += eq[i]; }
        __syncthreads();
        for (int r = wave; r < CAP; r += NWAVES) { const int s = list[r];
            if ((s >> 10) == half) { const uint4* src = (const uint4*)(hb + (size_t)(b * SEQ + s) * DM) + lane; uint4* dstp = (uint4*)(xg + (size_t)(slot0 + r) * DM) + lane; dstp[0] = src[0]; } }
    }
    __syncthreads();
}

DI int t5_bucket(int rel) {
    const int ret = rel > 0 ? 16 : 0; const int n = rel < 0 ? -rel : rel;
    if (n < 8) return ret + n;
    int large = 8 + (int)(logf((float)n / 8.0f) / 4.852030263919617f * 8.0f);
    large = large < 15 ? large : 15;
    return ret + large;
}
DI void phase_attn_naive(const Args& A, LAS unsigned char* lds, int gtid, int nthr, int tid) {
    const bf16* Z = (const bf16*)(A.ws + WS_Z); bf16* ao = (bf16*)(A.ws + WS_ATTO); float* al = (float*)(A.ws + WS_ATTL);
    LAS float* btab = (LAS float*)lds;
    __syncthreads();
    for (int i = tid; i < 3 * 129 * 4; i += NTHR) { const int hh = i & 3, mi = (i >> 2) % 129, br = i / (4 * 129); const int dil = br == 0 ? 1 : (br == 1 ? 4 : 16);
        btab[i] = A.in[I_RELB][t5_bucket((mi - 64) * dil) * 4 + hh]; }
    __syncthreads();
    for (int item = gtid; item < 3 * NB * 4 * SEQ; item += nthr) {
        const int t = item % SEQ; int r = item / SEQ; const int hh = r & 3; r >>= 2; const int b = r % NB, br = r / NB; const int dil = br == 0 ? 1 : (br == 1 ? 4 : 16);
        const int tok = b * SEQ + t;
        float q[64];
        { const uint4* qp = (const uint4*)(Z + (size_t)tok * ZLD + ZA + hh * 64);
#pragma unroll
          for (int c = 0; c < 8; ++c) { float f[8]; unpack8(qp[c], f);
#pragma unroll
              for (int j = 0; j < 8; ++j) q[c * 8 + j] = f[j] * 0.125f; } }
        float o[64];
#pragma unroll
        for (int c = 0; c < 64; ++c) o[c] = 0.f;
        float mrun = -1.0e30f, lrun = 0.f;
        for (int mi = 0; mi < 129; ++mi) { const int tk = t + (mi - 64) * dil; if (tk < 0 || tk >= SEQ) continue;
            const uint4* kp = (const uint4*)(Z + (size_t)(b * SEQ + tk) * ZLD + ZA + 256 + hh * 64);
            float s = 0.f;
#pragma unroll
            for (int c = 0; c < 8; ++c) { float f[8]; unpack8(kp[c], f);
#pragma unroll
                for (int j = 0; j < 8; ++j) s += q[c * 8 + j] * f[j]; }
            s += btab[(br * 129 + mi) * 4 + hh];
            const float mn = fmaxf(mrun, s), alpha = __expf(mrun - mn), p = __expf(s - mn);
            lrun = lrun * alpha + p; mrun = mn;
            const uint4* vp = kp + 32;
#pragma unroll
            for (int c = 0; c < 8; ++c) { float f[8]; unpack8(vp[c], f);
#pragma unroll
                for (int j = 0; j < 8; ++j) o[c * 8 + j] = o[c * 8 + j] * alpha + p * f[j]; } }
        const float inv = 1.f / lrun;
        uint4* op = (uint4*)(ao + ((size_t)br * NT + tok) * AW + hh * 64);
#pragma unroll
        for (int c = 0; c < 8; ++c) { uint4 w; w.x = pk2(o[c * 8 + 0] * inv, o[c * 8 + 1] * inv); w.y = pk2(o[c * 8 + 2] * inv, o[c * 8 + 3] * inv); w.z = pk2(o[c * 8 + 4] * inv, o[c * 8 + 5] * inv); w.w = pk2(o[c * 8 + 6] * inv, o[c * 8 + 7] * inv); op[c] = w; }
        al[((size_t)br * NT + tok) * 4 + hh] = mrun + logf(lrun);
    }
}
DI void phase_rwkv_prep(const Args& A, int l, int gw, int ngw, int lane) {
    const bf16* Z = (const bf16*)(A.ws + WS_Z); float* PR = (float*)(A.ws + WS_PR); float* bonb = (float*)(A.ws + WS_RKB);
    for (int item = gw; item < 2 * NT * 6; item += ngw) {
        const int hh = item % 6; const int r0 = item / 6; const int tok = r0 % NT, dir = r0 / NT; const int t = tok % SEQ;
        const int tp = dir ? t + 1 : t - 1; const bool valid = (tp >= 0 && tp < SEQ);
        const bf16* zr = Z + (size_t)tok * ZLD; const bf16* zp = Z + (size_t)(valid ? (tok + (dir ? 1 : -1)) : tok) * ZLD;
        const float* mu = A.in[I_MU] + (size_t)(l * 2 + dir) * 1280; const int col = hh * 64 + lane;
#define MK_LERP(zc, xc) ({ const float x_ = bf2f(zr[(zc)]); const float xp_ = valid ? bf2f(zp[(zc)]) : 0.f; x_ + mu[(xc)] * (xp_ - x_); })
        const float r_ = MK_LERP(ZRKV + col, col), k_ = MK_LERP(ZRKV + 384 + col, 384 + col), v_ = MK_LERP(ZRKV + 768 + col, 768 + col);
        const float wd_ = MK_LERP((dir ? ZWDB : ZWDF) + lane, 1152 + lane), ad_ = MK_LERP((dir ? ZADB : ZADF) + lane, 1216 + lane);
#undef MK_LERP
        const float th = tanhf(wd_);
        const float* w2 = A.in[I_W2] + (size_t)(l * 2 + dir) * 64 * RW + col; const float* a2 = A.in[I_A2] + (size_t)(l * 2 + dir) * 64 * RW + col;
        float wsum = 0.f, asum = 0.f;
        for (int i = 0; i < 64; ++i) { wsum += __shfl(th, i) * w2[(size_t)i * RW]; asum += __shfl(ad_, i) * a2[(size_t)i * RW]; }
        const float x = A.in[I_W0][(size_t)(l * 2 + dir) * RW + col] + wsum;
        const float nx = -x; const float sp = fmaxf(nx, 0.f) + log1pf(expf(-fabsf(nx)));
        const float wlog = -sp - 0.5f; const float decay = expf(-expf(wlog));
        const float a = 1.f / (1.f + expf(-(A.in[I_A0][(size_t)(l * 2 + dir) * RW + col] + asum)));
        const float kk = k_ * A.in[I_KK][(size_t)l * RW + col]; const float k2 = k_ * (1.f + (a - 1.f) * A.in[I_KA][(size_t)l * RW + col]);
        const float nrm = sqrtf(wave_sum(kk * kk)); const float kkn = kk / fmaxf(nrm, 1e-12f);
        const float bs = wave_sum(r_ * k2 * A.in[I_RK][(size_t)(l * 6 + hh) * 64 + lane]);
        float* p = PR + ((size_t)(dir * NT + tok) * 6) * RW + col;
        p[0] = r_; p[RW] = decay; p[2 * RW] = k2; p[3 * RW] = v_; p[4 * RW] = kkn; p[5 * RW] = a;
        bonb[(size_t)(dir * NT + tok) * RW + col] = bs * v_;
    }
}
DI void phase_mlstm_conv(const Args& A, int l, int gtid, int nthr) {
    const bf16* Z = (const bf16*)(A.ws + WS_Z); float* qk = (float*)(A.ws + WS_MLQK);
    const float* cw = A.in[I_CW] + (size_t)l * 5 * 768; const float* cb = A.in[I_CB] + (size_t)l * 768;
    for (int idx = gtid; idx < NT * 768; idx += nthr) { const int c = idx % 768, tok = idx / 768, t = tok % SEQ;
        float acc = cb[c];
#pragma unroll
        for (int j = 0; j < 5; ++j) { const int tt = t + j - 2; if (tt >= 0 && tt < SEQ) acc += cw[j * 768 + c] * bf2f(Z[(size_t)(tok + j - 2) * ZLD + ZMQK + c]); }
        float y = acc / (1.f + expf(-acc)); if (c >= 384) y *= 0.10206207261596575f;
        qk[idx] = y; }
}
DI void rwkv_scan_unit(const Args& A, int u, int wave, int lane) {
    const float* PR = (const float*)(A.ws + WS_PR); float* yb = (float*)(A.ws + WS_RKY);
    const int dir = u / 48, rem = u % 48, b = rem / 6, hh = rem % 6; const int row = wave * 8 + (lane >> 3), kq = lane & 7;
    float s[8];
#pragma unroll
    for (int j = 0; j < 8; ++j) s[j] = 0.f;
    const float* base = PR + ((size_t)dir * NT * 6) * RW + hh * 64;
    f32x4 n_r[2], n_w[2], n_k[2], n_kk[2], n_a[2]; float n_v;
#define MK_LOADSTEP(i_) do { const int t_ = dir ? SEQ - 1 - (i_) : (i_); const float* p_ = base + (size_t)(b * SEQ + t_) * 6 * RW; const f32x4* q_ = (const f32x4*)(p_ + kq * 8); \
        n_r[0] = q_[0]; n_r[1] = q_[1]; n_w[0] = q_[RW / 4]; n_w[1] = q_[RW / 4 + 1]; n_k[0] = q_[2 * RW / 4]; n_k[1] = q_[2 * RW / 4 + 1]; n_v = p_[3 * RW + row]; \
        n_kk[0] = q_[4 * RW / 4]; n_kk[1] = q_[4 * RW / 4 + 1]; n_a[0] = q_[5 * RW / 4]; n_a[1] = q_[5 * RW / 4 + 1]; } while (0)
    MK_LOADSTEP(0);
    for (int i = 0; i < SEQ; ++i) {
        const f32x4 c_r0 = n_r[0], c_r1 = n_r[1], c_w0 = n_w[0], c_w1 = n_w[1], c_k0 = n_k[0], c_k1 = n_k[1], c_kk0 = n_kk[0], c_kk1 = n_kk[1], c_a0 = n_a[0], c_a1 = n_a[1]; const float c_v = n_v;
        if (i + 1 < SEQ) MK_LOADSTEP(i + 1);
        float sa = 0.f;
#pragma unroll
        for (int j = 0; j < 4; ++j) { sa -= s[j] * c_kk0[j]; sa -= s[4 + j] * c_kk1[j]; }
        sa += __shfl_xor(sa, 1); sa += __shfl_xor(sa, 2); sa += __shfl_xor(sa, 4);
        float y = 0.f;
#pragma unroll
        for (int j = 0; j < 4; ++j) { s[j] = s[j] * c_w0[j] + sa * (c_kk0[j] * c_a0[j]) + c_v * c_k0[j]; s[4 + j] = s[4 + j] * c_w1[j] + sa * (c_kk1[j] * c_a1[j]) + c_v * c_k1[j];
            y += s[j] * c_r0[j]; y += s[4 + j] * c_r1[j]; }
        y += __shfl_xor(y, 1); y += __shfl_xor(y, 2); y += __shfl_xor(y, 4);
        const int t = dir ? SEQ - 1 - i : i;
        if (kq == 0) yb[((size_t)dir * NT + b * SEQ + t) * RW + hh * 64 + row] = y;
    }
#undef MK_LOADSTEP
}
DI void mlstm_scan_unit(const Args& A, int l, int u, int tid) {
    const bf16* Z = (const bf16*)(A.ws + WS_Z); const float* qk = (const float*)(A.ws + WS_MLQK); float* num = (float*)(A.ws + WS_MLNUM); float* den = (float*)(A.ws + WS_MLDEN);
    const int dir = u / 32, b = (u % 32) / 4, hh = u % 4;
    if (tid >= 97 * 4) return;
    const int vcol = tid >> 2, kq = tid & 3;
    float c[24];
#pragma unroll
    for (int j = 0; j < 24; ++j) c[j] = 0.f;
    const float ibv = A.in[I_IB][(l * 2 + dir) * 4 + hh], fbv = A.in[I_FB][(l * 2 + dir) * 4 + hh];
    for (int i = 0; i < SEQ; ++i) { const int t = dir ? SEQ - 1 - i : i; const size_t tok = (size_t)b * SEQ + t;
        const float gi = bf2f(Z[tok * ZLD + ZMG + (dir * 2 + 0) * 4 + hh]) + ibv, gf = bf2f(Z[tok * ZLD + ZMG + (dir * 2 + 1) * 4 + hh]) + fbv;
        const float f = 1.f / (1.f + expf(-gf)), ii = expf(gi);
        const f32x4* qp = (const f32x4*)(qk + tok * 768 + hh * 96 + kq * 24); const f32x4* kp = (const f32x4*)(qk + tok * 768 + 384 + hh * 96 + kq * 24);
        const float vv = vcol < 96 ? bf2f(Z[tok * ZLD + ZMV + hh * 96 + vcol]) : 1.f; const float iv = ii * vv;
        float p = 0.f;
#pragma unroll
        for (int j4 = 0; j4 < 6; ++j4) { const f32x4 q4 = qp[j4], k4 = kp[j4];
#pragma unroll
            for (int j = 0; j < 4; ++j) { c[j4 * 4 + j] = f * c[j4 * 4 + j] + k4[j] * iv; p += q4[j] * c[j4 * 4 + j]; } }
        p += __shfl_xor(p, 1); p += __shfl_xor(p, 2);
        if (kq == 0) { if (vcol < 96) num[((size_t)dir * NT + tok) * MW + hh * 96 + vcol] = p; else den[((size_t)dir * NT + tok) * 4 + hh] = p; }
    }
}

typedef short bf16x8_t __attribute__((ext_vector_type(8)));
typedef short bf16x4_t __attribute__((ext_vector_type(4)));
typedef unsigned u32x4_t __attribute__((ext_vector_type(4)));
typedef unsigned u32x2_t __attribute__((ext_vector_type(2)));
typedef __bf16 bf2_t __attribute__((ext_vector_type(2)));
typedef float f2_t __attribute__((ext_vector_type(2)));
DI unsigned cvtpk(float lo, float hi) { const f2_t v = {lo, hi}; return __builtin_bit_cast(unsigned, __builtin_convertvector(v, bf2_t)); }
#define MFMA16(a, b, c) __builtin_amdgcn_mfma_f32_16x16x32_bf16((a), (b), (c), 0, 0, 0)

constexpr int AT_QS = 0, AT_QLD = 72;
constexpr int AT_KS = AT_QS + 128 * AT_QLD * 2;
constexpr int AT_VT = AT_KS + 272 * AT_QLD * 2, AT_VLD = 280;
constexpr int AT_BT = AT_VT + 64 * AT_VLD * 2;
constexpr int AT_END = AT_BT + 132 * 4;
static_assert(AT_END <= MISC_OFF, "attention LDS");

DI void attn_unit(const Args& A, LAS unsigned char* lds, int unit, int tid, int wave, int lane) {
    const bf16* Z = (const bf16*)(A.ws + WS_Z); bf16* ao = (bf16*)(A.ws + WS_ATTO); float* al = (float*)(A.ws + WS_ATTL);
    const int x = unit & 15; int r0 = unit >> 4; const int hh = r0 & 3; r0 >>= 2; const int b = r0 % NB, br = r0 / NB;
    const int dil = br == 0 ? 1 : (br == 1 ? 4 : 16), lsub = SEQ / dil, nblk = lsub / 128;
    const int res = x / nblk, nbk = x % nblk, l0 = nbk * 128, wbase = l0 - 64;
    LAS bf16* Qs = (LAS bf16*)(lds + AT_QS); LAS bf16* Ks = (LAS bf16*)(lds + AT_KS); LAS bf16* Vt = (LAS bf16*)(lds + AT_VT); LAS float* btab = (LAS float*)(lds + AT_BT);
    __syncthreads();
#pragma unroll
    for (int i = 0; i < 2; ++i) { const int id = tid + 512 * i, row = id >> 3, ch = id & 7; const int tok = b * SEQ + (l0 + row) * dil + res;
        *(LAS u32x4_t*)(Qs + row * AT_QLD + ch * 8) = *(const u32x4_t*)(Z + (size_t)tok * ZLD + ZA + hh * 64 + ch * 8); }
    for (int id = tid; id < 272 * 8; id += NTHR) { const int row = id >> 3, ch = id & 7; const int pos = wbase + row; u32x4_t v = (u32x4_t){0u, 0u, 0u, 0u};
        if (row < 256 && pos >= 0 && pos < lsub) v = *(const u32x4_t*)(Z + (size_t)(b * SEQ + pos * dil + res) * ZLD + ZA + 256 + hh * 64 + ch * 8);
        *(LAS u32x4_t*)(Ks + row * AT_QLD + ch * 8) = v; }
    for (int id = tid; id < 272 * 8; id += NTHR) { const int key = id % 272, ch = id / 272; const int pos = wbase + key; u32x4_t v = (u32x4_t){0u, 0u, 0u, 0u};
        if (key < 256 && pos >= 0 && pos < lsub) v = *(const u32x4_t*)(Z + (size_t)(b * SEQ + pos * dil + res) * ZLD + ZA + 512 + hh * 64 + ch * 8);
        LAS bf16* d = Vt + (ch * 8) * AT_VLD + key;
        d[0] = (bf16)(v.x & 0xffffu); d[AT_VLD] = (bf16)(v.x >> 16); d[2 * AT_VLD] = (bf16)(v.y & 0xffffu); d[3 * AT_VLD] = (bf16)(v.y >> 16);
        d[4 * AT_VLD] = (bf16)(v.z & 0xffffu); d[5 * AT_VLD] = (bf16)(v.z >> 16); d[6 * AT_VLD] = (bf16)(v.w & 0xffffu); d[7 * AT_VLD] = (bf16)(v.w >> 16); }
    if (tid < 129) btab[tid] = A.in[I_RELB][t5_bucket((tid - 64) * dil) * 4 + hh];
    __syncthreads();
    const int fr = lane & 15, qd = lane >> 4;
    f32x4 acc[10];
    { bf16x8_t qb[2];
#pragma unroll
      for (int ks = 0; ks < 2; ++ks) qb[ks] = *(const LAS bf16x8_t*)(Qs + (16 * wave + fr) * AT_QLD + ks * 32 + 8 * qd);
#pragma unroll
      for (int j = 0; j < 10; ++j) { acc[j] = (f32x4){0.f, 0.f, 0.f, 0.f};
#pragma unroll
          for (int ks = 0; ks < 2; ++ks) { const bf16x8_t ka = *(const LAS bf16x8_t*)(Ks + (16 * (wave + j) + fr) * AT_QLD + ks * 32 + 8 * qd); acc[j] = MFMA16(ka, qb[ks], acc[j]); } } }
    const int iq = 16 * wave + fr; float mx = -1.0e30f;
#pragma unroll
    for (int j = 0; j < 10; ++j)
#pragma unroll
        for (int r = 0; r < 4; ++r) { const int kw = 16 * (wave + j) + 4 * qd + r; const int m = kw - 64 - iq; const int pos = wbase + kw;
            const bool valid = (m >= -64) && (m <= 64) && (pos >= 0) && (pos < lsub);
            const float s = valid ? acc[j][r] * 0.125f + btab[valid ? m + 64 : 0] : -1.0e30f; acc[j][r] = s; mx = fmaxf(mx, s); }
    mx = fmaxf(mx, __shfl_xor(mx, 16)); mx = fmaxf(mx, __shfl_xor(mx, 32));
    float lsum = 0.f;
#pragma unroll
    for (int j = 0; j < 10; ++j)
#pragma unroll
        for (int r = 0; r < 4; ++r) { const float p = __expf(acc[j][r] - mx); acc[j][r] = p; lsum += p; }
    lsum += __shfl_xor(lsum, 16); lsum += __shfl_xor(lsum, 32);
    f32x4 oacc[4];
#pragma unroll
    for (int d = 0; d < 4; ++d) oacc[d] = (f32x4){0.f, 0.f, 0.f, 0.f};
#pragma unroll
    for (int pp = 0; pp < 5; ++pp) {
        union { unsigned u[4]; bf16x8_t v; } pb;
        pb.u[0] = cvtpk(acc[2 * pp][0], acc[2 * pp][1]); pb.u[1] = cvtpk(acc[2 * pp][2], acc[2 * pp][3]); pb.u[2] = cvtpk(acc[2 * pp + 1][0], acc[2 * pp + 1][1]); pb.u[3] = cvtpk(acc[2 * pp + 1][2], acc[2 * pp + 1][3]);
#pragma unroll
        for (int d = 0; d < 4; ++d) { const LAS bf16* vp = Vt + (16 * d + fr) * AT_VLD + 16 * (wave + 2 * pp) + 4 * qd;
            union { bf16x4_t h[2]; bf16x8_t v; } va; va.h[0] = *(const LAS bf16x4_t*)vp; va.h[1] = *(const LAS bf16x4_t*)(vp + 16);
            oacc[d] = MFMA16(va.v, pb.v, oacc[d]); } }
    const float inv = 1.f / lsum; const int tok = b * SEQ + (l0 + iq) * dil + res;
    bf16* op = ao + ((size_t)br * NT + tok) * AW + hh * 64 + 4 * qd;
#pragma unroll
    for (int d = 0; d < 4; ++d) { uint2 w; w.x = cvtpk(oacc[d][0] * inv, oacc[d][1] * inv); w.y = cvtpk(oacc[d][2] * inv, oacc[d][3] * inv); *(uint2*)(op + 16 * d) = w; }
    if (qd == 0) al[((size_t)br * NT + tok) * 4 + hh] = mx + logf(lsum);
}
DI void phase_attn(const Args& A, LAS unsigned char* lds, int bid, int G, int tid, int wave, int lane) {
    for (int u = bid; u < 3 * NB * 4 * 16; u += G) attn_unit(A, lds, u, tid, wave, lane);
    __syncthreads();
}

constexpr int ML_QLD = 104, ML_SLD = 72;
constexpr int ML_QS = 0;
constexpr int ML_QT = ML_QS + 64 * ML_QLD * 2;
constexpr int ML_KS = ML_QT + 64 * ML_QLD * 2;
constexpr int ML_KT = ML_KS + 64 * ML_QLD * 2;
constexpr int ML_VT = ML_KT + 96 * ML_SLD * 2;
constexpr int ML_WS = ML_VT + 112 * ML_SLD * 2;
constexpr int ML_CT = ML_WS + 64 * ML_SLD * 2;
constexpr int ML_CW = ML_CT + 112 * ML_QLD * 2;
constexpr int ML_END = ML_CW + 6 * 192 * 4;
static_assert(ML_END <= MISC_OFF, "mlstm LDS");

constexpr int MLP_QF = 0, MLP_WF = 12288, MLP_KF = 20480, MLP_VF = 32768, MLP_DEC = 47104, MLP_BYTES = 47360;
constexpr size_t WS_MLPKG = WS_R + 304 * MiB;
static_assert(WS_MLPKG + (size_t)2 * NB * 4 * 32 * MLP_BYTES <= WS_RKY, "mlstm package region");

DI void mlstm_m1_item(const Args& A, int l, LAS unsigned char* lds, int item, int& hh_staged, int tid, int wave, int lane) {
    const bf16* Z = (const bf16*)(A.ws + WS_Z);
    const int c = item & 31, u = item >> 5; const int dir = u / 32, b = (u % 32) / 4, hh = u % 4;
    LAS bf16* Qs = (LAS bf16*)(lds + ML_QS); LAS bf16* Qt = (LAS bf16*)(lds + ML_QT); LAS bf16* Ks = (LAS bf16*)(lds + ML_KS); LAS bf16* KtT = (LAS bf16*)(lds + ML_KT);
    LAS bf16* VtT = (LAS bf16*)(lds + ML_VT); LAS bf16* Ws = (LAS bf16*)(lds + ML_WS); LAS float* cwl = (LAS float*)(lds + ML_CW); LAS float* cbl = cwl + 5 * 192;
    const int fr = lane & 15, qd = lane >> 4;
    unsigned char* pkg = A.ws + WS_MLPKG + (size_t)item * MLP_BYTES;
    __syncthreads();
    if (hh != hh_staged) { hh_staged = hh;
        for (int i = tid; i < 5 * 192; i += NTHR) { const int tap = i / 192, ch = i % 192; cwl[i] = A.in[I_CW][(size_t)(l * 5 + tap) * 768 + (ch < 96 ? 0 : 384) + hh * 96 + (ch % 96)]; }
        for (int i = tid; i < 192; i += NTHR) cbl[i] = A.in[I_CB][(size_t)l * 768 + (i < 96 ? 0 : 384) + hh * 96 + (i % 96)];
        for (int i = tid; i < 16 * ML_SLD; i += NTHR) VtT[96 * ML_SLD + i] = (i < ML_SLD) ? (bf16)0x3F80u : (bf16)0u;
        __syncthreads(); }
    const float ibv = A.in[I_IB][(l * 2 + dir) * 4 + hh], fbv = A.in[I_FB][(l * 2 + dir) * 4 + hh];
    const int j = tid >> 3, sub = tid & 7;
    const int tl = dir ? SEQ - 1 - (c * 64 + lane) : c * 64 + lane; const size_t tokl = (size_t)b * SEQ + tl;
    const float gi = bf2f(Z[tokl * ZLD + ZMG + dir * 8 + hh]) + ibv, gf = bf2f(Z[tokl * ZLD + ZMG + dir * 8 + 4 + hh]) + fbv;
    float bsum = fminf(gf, 0.f) - __logf(1.f + __expf(-fabsf(gf)));
#pragma unroll
    for (int o = 1; o < 64; o <<= 1) { const float t = __shfl_up(bsum, o); if (lane >= o) bsum += t; }
    const float bend = __shfl(bsum, 63);
    const int tj = dir ? SEQ - 1 - (c * 64 + j) : c * 64 + j; const size_t tokj = (size_t)b * SEQ + tj;
    const float bj = __shfl(bsum, j), igj = __shfl(gi, j);
    { const bool isk = sub >= 4; const int c0 = (sub & 3) * 24, cl = (isk ? 96 : 0) + c0; const int zcol = ZMQK + (isk ? 384 : 0) + hh * 96 + c0;
      float acc[24];
#pragma unroll
      for (int e = 0; e < 24; ++e) acc[e] = cbl[cl + e];
#pragma unroll
      for (int tap = 0; tap < 5; ++tap) { const int tt = tj + tap - 2;
          if (tt >= 0 && tt < SEQ) { const u32x4_t* zp = (const u32x4_t*)(Z + ((size_t)b * SEQ + tt) * ZLD + zcol);
#pragma unroll
              for (int q4 = 0; q4 < 3; ++q4) { const u32x4_t w = zp[q4]; const LAS float* cwp = cwl + tap * 192 + cl + q4 * 8;
                  acc[q4 * 8 + 0] += cwp[0] * __uint_as_float(w.x << 16); acc[q4 * 8 + 1] += cwp[1] * __uint_as_float(w.x & 0xffff0000u);
                  acc[q4 * 8 + 2] += cwp[2] * __uint_as_float(w.y << 16); acc[q4 * 8 + 3] += cwp[3] * __uint_as_float(w.y & 0xffff0000u);
                  acc[q4 * 8 + 4] += cwp[4] * __uint_as_float(w.z << 16); acc[q4 * 8 + 5] += cwp[5] * __uint_as_float(w.z & 0xffff0000u);
                  acc[q4 * 8 + 6] += cwp[6] * __uint_as_float(w.w << 16); acc[q4 * 8 + 7] += cwp[7] * __uint_as_float(w.w & 0xffff0000u); } } }
      const float sc1 = isk ? 0.10206207261596575f : 1.f; const float sc2 = isk ? __expf(bend - bj + igj) : __expf(bj);
#pragma unroll
      for (int e = 0; e < 24; ++e) acc[e] = acc[e] * sigm(acc[e]) * sc1;
      if (!isk) { LAS bf16* d1 = Qs + j * ML_QLD + c0; LAS bf16* d2 = Qt + j * ML_QLD + c0;
#pragma unroll
          for (int q4 = 0; q4 < 3; ++q4) { u32x4_t w; w.x = cvtpk(acc[q4 * 8 + 0], acc[q4 * 8 + 1]); w.y = cvtpk(acc[q4 * 8 + 2], acc[q4 * 8 + 3]); w.z = cvtpk(acc[q4 * 8 + 4], acc[q4 * 8 + 5]); w.w = cvtpk(acc[q4 * 8 + 6], acc[q4 * 8 + 7]);
              *(LAS u32x4_t*)(d1 + q4 * 8) = w;
              u32x4_t x; x.x = cvtpk(acc[q4 * 8 + 0] * sc2, acc[q4 * 8 + 1] * sc2); x.y = cvtpk(acc[q4 * 8 + 2] * sc2, acc[q4 * 8 + 3] * sc2); x.z = cvtpk(acc[q4 * 8 + 4] * sc2, acc[q4 * 8 + 5] * sc2); x.w = cvtpk(acc[q4 * 8 + 6] * sc2, acc[q4 * 8 + 7] * sc2);
              *(LAS u32x4_t*)(d2 + q4 * 8) = x; } }
      else { LAS bf16* d1 = Ks + j * ML_QLD + c0;
#pragma unroll
          for (int q4 = 0; q4 < 3; ++q4) { u32x4_t w; w.x = cvtpk(acc[q4 * 8 + 0], acc[q4 * 8 + 1]); w.y = cvtpk(acc[q4 * 8 + 2], acc[q4 * 8 + 3]); w.z = cvtpk(acc[q4 * 8 + 4], acc[q4 * 8 + 5]); w.w = cvtpk(acc[q4 * 8 + 6], acc[q4 * 8 + 7]);
              *(LAS u32x4_t*)(d1 + q4 * 8) = w; }
#pragma unroll
          for (int e = 0; e < 24; ++e) KtT[(c0 + e) * ML_SLD + j] = (bf16)f2bf(acc[e] * sc2); } }
    { const int n0 = sub * 12; const u32x2_t* vp = (const u32x2_t*)(Z + tokj * ZLD + ZMV + hh * 96 + n0);
#pragma unroll
      for (int q2 = 0; q2 < 3; ++q2) { const u32x2_t w = vp[q2]; LAS bf16* d = VtT + (n0 + q2 * 4) * ML_SLD + j;
          d[0] = (bf16)(w.x & 0xffffu); d[ML_SLD] = (bf16)(w.x >> 16); d[2 * ML_SLD] = (bf16)(w.y & 0xffffu); d[3 * ML_SLD] = (bf16)(w.y >> 16); } }
    __syncthreads();
#pragma unroll
    for (int i = 0; i < 2; ++i) { const int tile = 2 * wave + i, jt = tile >> 2, st = tile & 3; const int jq = 16 * jt + fr;
        u32x2_t w = (u32x2_t){0u, 0u};
        if (st <= jt) { f32x4 acc = (f32x4){0.f, 0.f, 0.f, 0.f};
#pragma unroll
            for (int ks = 0; ks < 3; ++ks) { const bf16x8_t a = *(const LAS bf16x8_t*)(Ks + (16 * st + fr) * ML_QLD + 32 * ks + 8 * qd); const bf16x8_t bq = *(const LAS bf16x8_t*)(Qs + jq * ML_QLD + 32 * ks + 8 * qd); acc = MFMA16(a, bq, acc); }
            const float bjq = __shfl(bsum, jq); float wv[4];
#pragma unroll
            for (int r = 0; r < 4; ++r) { const int s = 16 * st + 4 * qd + r; const float bs = __shfl(bsum, s), igs = __shfl(gi, s); wv[r] = (s <= jq) ? acc[r] * __expf(bjq - bs + igs) : 0.f; }
            w.x = cvtpk(wv[0], wv[1]); w.y = cvtpk(wv[2], wv[3]); }
        *(LAS u32x2_t*)(Ws + jq * ML_SLD + 16 * st + 4 * qd) = w; }
    __syncthreads();
    for (int id = wave; id < 46; id += NWAVES) { u32x4_t v;
        if (id < 12) { const int jt = id / 3, i3 = id % 3; const LAS bf16* p = Qt + (16 * jt + fr) * ML_QLD + 32 * i3 + 4 * qd; const u32x2_t lo = *(const LAS u32x2_t*)p, hi = *(const LAS u32x2_t*)(p + 16); v = (u32x4_t){lo.x, lo.y, hi.x, hi.y}; }
        else if (id < 20) { const int q = id - 12; v = *(const LAS u32x4_t*)(Ws + (16 * (q >> 1) + fr) * ML_SLD + 32 * (q & 1) + 8 * qd); }
        else if (id < 32) { const int q = id - 20; v = *(const LAS u32x4_t*)(KtT + (16 * (q >> 1) + fr) * ML_SLD + 32 * (q & 1) + 8 * qd); }
        else { const int q = id - 32; v = *(const LAS u32x4_t*)(VtT + (16 * (q >> 1) + fr) * ML_SLD + 32 * (q & 1) + 8 * qd); }
        *(u32x4_t*)(pkg + (size_t)id * 1024 + lane * 16) = v; }
    if (tid < 64) ((float*)(pkg + MLP_DEC))[tid] = __expf(bend);
}
DI void phase_mlstm_m1(const Args& A, int l, LAS unsigned char* lds, int bid, int G, int tid, int wave, int lane) {
    int hh_staged = -1;
    for (int it = bid; it < 2 * NB * 4 * 32; it += G) mlstm_m1_item(A, l, lds, it, hh_staged, tid, wave, lane);
    __syncthreads();
}
DI void mlstm_m2_wave(const Args& A, int u, int nt, int lane) {
    float* num = (float*)(A.ws + WS_MLNUM); float* den = (float*)(A.ws + WS_MLDEN);
    const int dir = u / 32, b = (u % 32) / 4, hh = u % 4; const int fr = lane & 15, qd = lane >> 4;
    const unsigned char* pkg0 = A.ws + WS_MLPKG + (size_t)u * 32 * MLP_BYTES;
    f32x4 C[6];
#pragma unroll
    for (int kt = 0; kt < 6; ++kt) C[kt] = (f32x4){0.f, 0.f, 0.f, 0.f};
    for (int c = 0; c < 32; ++c) {
        const unsigned char* pkg = pkg0 + (size_t)c * MLP_BYTES + lane * 16;
        bf16x8_t vf[2], wf[8], qf[12], kf[12];
#pragma unroll
        for (int i = 0; i < 2; ++i) vf[i] = *(const bf16x8_t*)(pkg + MLP_VF + (2 * nt + i) * 1024);
#pragma unroll
        for (int i = 0; i < 8; ++i) wf[i] = *(const bf16x8_t*)(pkg + MLP_WF + i * 1024);
#pragma unroll
        for (int i = 0; i < 12; ++i) qf[i] = *(const bf16x8_t*)(pkg + MLP_QF + i * 1024);
#pragma unroll
        for (int i = 0; i < 12; ++i) kf[i] = *(const bf16x8_t*)(pkg + MLP_KF + i * 1024);
        const float dec = ((const float*)(pkg0 + (size_t)c * MLP_BYTES + MLP_DEC))[lane];
        union { unsigned u[4]; bf16x8_t v; } sB[3];
#pragma unroll
        for (int i = 0; i < 3; ++i) { sB[i].u[0] = cvtpk(C[2 * i][0], C[2 * i][1]); sB[i].u[1] = cvtpk(C[2 * i][2], C[2 * i][3]); sB[i].u[2] = cvtpk(C[2 * i + 1][0], C[2 * i + 1][1]); sB[i].u[3] = cvtpk(C[2 * i + 1][2], C[2 * i + 1][3]); }
#pragma unroll
        for (int jt = 0; jt < 4; ++jt) { f32x4 acc = (f32x4){0.f, 0.f, 0.f, 0.f};
            acc = MFMA16(wf[2 * jt], vf[0], acc); acc = MFMA16(wf[2 * jt + 1], vf[1], acc);
#pragma unroll
            for (int i = 0; i < 3; ++i) acc = MFMA16(qf[3 * jt + i], sB[i].v, acc);
#pragma unroll
            for (int r = 0; r < 4; ++r) { const int jj = 16 * jt + 4 * qd + r; const int tt = dir ? SEQ - 1 - (c * 64 + jj) : c * 64 + jj; const size_t tok = (size_t)b * SEQ + tt;
                if (nt < 6) num[((size_t)dir * NT + tok) * MW + hh * 96 + 16 * nt + fr] = acc[r]; else if (fr == 0) den[((size_t)dir * NT + tok) * 4 + hh] = acc[r]; } }
#pragma unroll
        for (int kt = 0; kt < 6; ++kt) { f32x4 t = C[kt] * dec; t = MFMA16(kf[2 * kt], vf[0], t); t = MFMA16(kf[2 * kt + 1], vf[1], t); C[kt] = t; }
    }
}

DI bf16x8_t widen4(const bf16x4_t a) { return __builtin_shufflevector(a, (bf16x4_t){0, 0, 0, 0}, 0, 1, 2, 3, 4, 5, 6, 7); }
constexpr int PKG_BYTES = 12544;
constexpr int PK_AH = 0, PK_RH = 2048, PK_BT = 4096, PK_KT = 6144, PK_VV = 8192, PK_TM = 10240, PK_MRB = 10752, PK_LAK = 11264, PK_MRK = 11776, PK_GE = 12288;
constexpr size_t WS_PKG = WS_PR;
static_assert((size_t)2 * NB * 6 * 128 * PKG_BYTES <= 288 * MiB, "package region");
constexpr int R1_W2T = 0, R1_A2T = 9216, R1_WV = 18432, R1_WV_BYTES = 12928;
constexpr int R1_IMG = 0, R1_LF = 9216, R1_MT = 10368;
static_assert(R1_WV + 8 * R1_WV_BYTES <= MISC_OFF, "rwkv r1 LDS");
#ifndef RK_DEBUG_PR
#define RK_DEBUG_PR 0
#endif

DI bf16x4_t pack4(const f32x4 v) { union { unsigned u[2]; bf16x4_t h; } x; x.u[0] = cvtpk(v[0], v[1]); x.u[1] = cvtpk(v[2], v[3]); return x.h; }

DI void rwkv_r1_item(const Args& A, int l, LAS unsigned char* lds, int item, int tid, int wave, int lane) {
    const bf16* Z = (const bf16*)(A.ws + WS_Z);
    const int g = item & 15; int r0 = item >> 4; const int hh = r0 % 6; r0 /= 6; const int b = r0 % NB, dir = r0 / NB;
    const int cc = 8 * g + wave, fr = lane & 15, qd = lane >> 4;
    LAS bf16* W2T = (LAS bf16*)(lds + R1_W2T); LAS bf16* A2T = (LAS bf16*)(lds + R1_A2T);
    LAS unsigned char* wv = lds + R1_WV + wave * R1_WV_BYTES;
    LAS bf16* IMG = (LAS bf16*)(wv + R1_IMG); LAS float* Lf = (LAS float*)(wv + R1_LF); LAS bf16* MT = (LAS bf16*)(wv + R1_MT);
    __syncthreads();
    { const int ch = tid & 63, i0 = (tid >> 6) * 8; const float* w2 = A.in[I_W2] + ((size_t)(l * 2 + dir) * 64 + i0) * RW + hh * 64 + ch; const float* a2 = A.in[I_A2] + ((size_t)(l * 2 + dir) * 64 + i0) * RW + hh * 64 + ch;
      u32x4_t pw, pa; pw.x = cvtpk(w2[0], w2[RW]); pw.y = cvtpk(w2[2 * RW], w2[3 * RW]); pw.z = cvtpk(w2[4 * RW], w2[5 * RW]); pw.w = cvtpk(w2[6 * RW], w2[7 * RW]);
      pa.x = cvtpk(a2[0], a2[RW]); pa.y = cvtpk(a2[2 * RW], a2[3 * RW]); pa.z = cvtpk(a2[4 * RW], a2[5 * RW]); pa.w = cvtpk(a2[6 * RW], a2[7 * RW]);
      *(LAS u32x4_t*)(W2T + ch * 72 + i0) = pw; *(LAS u32x4_t*)(A2T + ch * 72 + i0) = pa; }
    __syncthreads();
    const int sgn = dir ? -1 : 1; const int tok0 = b * SEQ + (dir ? SEQ - 1 - 16 * cc : 16 * cc);
    const float* mu = A.in[I_MU] + (size_t)(l * 2 + dir) * 1280;
    float er[4][4], ek[4][4], ev[4][4];
#pragma unroll
    for (int nt = 0; nt < 4; ++nt) {
#pragma unroll
        for (int r = 0; r < 4; ++r) { const bf16* zp = Z + (size_t)(tok0 + sgn * (4 * qd + r)) * ZLD + ZRKV + hh * 64 + 16 * nt + fr; er[nt][r] = bf2f(zp[0]); ek[nt][r] = bf2f(zp[RW]); ev[nt][r] = bf2f(zp[2 * RW]); }
        float pr = __shfl(er[nt][3], lane - 16), pk = __shfl(ek[nt][3], lane - 16), pv = __shfl(ev[nt][3], lane - 16);
        if (qd == 0) { pr = 0.f; pk = 0.f; pv = 0.f; if (cc > 0) { const bf16* zp = Z + (size_t)(tok0 - sgn) * ZLD + ZRKV + hh * 64 + 16 * nt + fr; pr = bf2f(zp[0]); pk = bf2f(zp[RW]); pv = bf2f(zp[2 * RW]); } }
        const float mr = mu[hh * 64 + 16 * nt + fr], mk = mu[RW + hh * 64 + 16 * nt + fr], mv = mu[2 * RW + hh * 64 + 16 * nt + fr];
#pragma unroll
        for (int r = 3; r >= 0; --r) { const float qr = r ? er[nt][r - 1] : pr, qk = r ? ek[nt][r - 1] : pk, qv = r ? ev[nt][r - 1] : pv;
            er[nt][r] += mr * (qr - er[nt][r]); ek[nt][r] += mk * (qk - ek[nt][r]); ev[nt][r] += mv * (qv - ev[nt][r]); }
    }
    bf16x8_t thA[2], adA[2];
    { const int zwd = dir ? ZWDB : ZWDF, zad = dir ? ZADB : ZADF; const bool hasp = !(cc == 0 && fr == 0);
      const bf16* zc = Z + (size_t)(tok0 + sgn * fr) * ZLD; const bf16* zq = Z + (size_t)(tok0 + sgn * (fr - 1)) * ZLD;
#pragma unroll
      for (int ks = 0; ks < 2; ++ks) { float cw[8], pw[8], ca[8], pa[8];
          unpack8(*(const uint4*)(zc + zwd + 32 * ks + 8 * qd), cw); unpack8(*(const uint4*)(zc + zad + 32 * ks + 8 * qd), ca);
          if (hasp) { unpack8(*(const uint4*)(zq + zwd + 32 * ks + 8 * qd), pw); unpack8(*(const uint4*)(zq + zad + 32 * ks + 8 * qd), pa); }
          else {
#pragma unroll
              for (int e = 0; e < 8; ++e) { pw[e] = 0.f; pa[e] = 0.f; } }
          const float* muw = mu + 1152 + 32 * ks + 8 * qd; const float* mua = mu + 1216 + 32 * ks + 8 * qd;
#pragma unroll
          for (int e = 0; e < 8; ++e) { const float xw = cw[e] + muw[e] * (pw[e] - cw[e]); cw[e] = 1.f - 2.f * __builtin_amdgcn_rcpf(1.f + __expf(2.f * xw)); ca[e] = ca[e] + mua[e] * (pa[e] - ca[e]); }
          union { unsigned u[4]; bf16x8_t v; } x, y;
#pragma unroll
          for (int e = 0; e < 4; ++e) { x.u[e] = cvtpk(cw[2 * e], cw[2 * e + 1]); y.u[e] = cvtpk(ca[2 * e], ca[2 * e + 1]); }
          thA[ks] = x.v; adA[ks] = y.v; } }
    f32x4 wl[4], al[4];
#pragma unroll
    for (int nt = 0; nt < 4; ++nt) { wl[nt] = (f32x4){0.f, 0.f, 0.f, 0.f}; al[nt] = (f32x4){0.f, 0.f, 0.f, 0.f};
#pragma unroll
        for (int ks = 0; ks < 2; ++ks) { const bf16x8_t bw = *(const LAS bf16x8_t*)(W2T + (16 * nt + fr) * 72 + 32 * ks + 8 * qd); const bf16x8_t ba = *(const LAS bf16x8_t*)(A2T + (16 * nt + fr) * 72 + 32 * ks + 8 * qd);
            wl[nt] = MFMA16(thA[ks], bw, wl[nt]); al[nt] = MFMA16(adA[ks], ba, al[nt]); } }
    float lw[4][4], alp[4][4], kap[4][4]; float ssq[4] = {0.f, 0.f, 0.f, 0.f}, bsm[4] = {0.f, 0.f, 0.f, 0.f};
#pragma unroll
    for (int nt = 0; nt < 4; ++nt) { const int ch = hh * 64 + 16 * nt + fr;
        const float w0v = A.in[I_W0][(size_t)(l * 2 + dir) * RW + ch], a0v = A.in[I_A0][(size_t)(l * 2 + dir) * RW + ch], kkw = A.in[I_KK][(size_t)l * RW + ch], kaw = A.in[I_KA][(size_t)l * RW + ch], rkw = A.in[I_RK][(size_t)l * RW + ch];
#pragma unroll
        for (int r = 0; r < 4; ++r) { const float x = w0v + wl[nt][r]; const float nx = -x; const float sp = fmaxf(nx, 0.f) + __logf(1.f + __expf(-fabsf(nx)));
            lw[nt][r] = -__expf(-sp - 0.5f);
            const float a = __builtin_amdgcn_rcpf(1.f + __expf(-(a0v + al[nt][r]))); alp[nt][r] = a;
            const float k0 = ek[nt][r]; kap[nt][r] = k0 * kkw; ek[nt][r] = k0 * (1.f + (a - 1.f) * kaw);
            ssq[r] += kap[nt][r] * kap[nt][r]; bsm[r] += er[nt][r] * ek[nt][r] * rkw; } }
#pragma unroll
    for (int r = 0; r < 4; ++r) {
#pragma unroll
        for (int o = 1; o < 16; o <<= 1) { ssq[r] += __shfl_xor(ssq[r], o); bsm[r] += __shfl_xor(bsm[r], o); }
        ssq[r] = __builtin_amdgcn_rsqf(fmaxf(ssq[r], 1e-24f)); }
    { float* bon = (float*)(A.ws + WS_RKB);
#pragma unroll
      for (int nt = 0; nt < 4; ++nt)
#pragma unroll
          for (int r = 0; r < 4; ++r) { kap[nt][r] *= ssq[r]; bon[((size_t)dir * NT + tok0 + sgn * (4 * qd + r)) * RW + hh * 64 + 16 * nt + fr] = bsm[r] * ev[nt][r]; } }
#if RK_DEBUG_PR
    { float* PR = (float*)(A.ws + WS_PR);
#pragma unroll
      for (int nt = 0; nt < 4; ++nt)
#pragma unroll
          for (int r = 0; r < 4; ++r) { float* p = PR + ((size_t)(dir * NT + tok0 + sgn * (4 * qd + r)) * 6) * RW + hh * 64 + 16 * nt + fr;
              p[0] = er[nt][r]; p[RW] = expf(lw[nt][r]); p[2 * RW] = ek[nt][r]; p[3 * RW] = ev[nt][r]; p[4 * RW] = kap[nt][r]; p[5 * RW] = alp[nt][r]; } }
#else
    unsigned char* pkg = A.ws + WS_PKG + ((size_t)((dir * NB + b) * 6 + hh) * 128 + cc) * PKG_BYTES;
    float lend[4];
    u32x2_t btf[4], ktf[4];
#pragma unroll
    for (int nt = 0; nt < 4; ++nt) { float lam[4]; lam[0] = lw[nt][0]; lam[1] = lam[0] + lw[nt][1]; lam[2] = lam[1] + lw[nt][2]; lam[3] = lam[2] + lw[nt][3];
        const float t1 = __shfl(lam[3], lane - 16), t2 = __shfl(lam[3], lane - 32), t3 = __shfl(lam[3], lane - 48);
        const float off = (qd >= 1 ? t1 : 0.f) + (qd >= 2 ? t2 : 0.f) + (qd >= 3 ? t3 : 0.f);
#pragma unroll
        for (int r = 0; r < 4; ++r) lam[r] += off;
        lend[nt] = __shfl(lam[3], 48 + fr);
        float bt4[4], kt4[4];
#pragma unroll
        for (int r = 0; r < 4; ++r) { const float ep = __expf(lam[r]), epm = __expf(lam[r] - lw[nt][r]), einv = __expf(-lam[r]), eend = __expf(lend[nt] - lam[r]);
            const float bb = kap[nt][r] * alp[nt][r]; const int o = (4 * qd + r) * 72 + 16 * nt + fr;
            IMG[o] = (bf16)f2bf(-kap[nt][r] * epm); IMG[1152 + o] = (bf16)f2bf(er[nt][r] * ep); IMG[2304 + o] = (bf16)f2bf(bb * einv); IMG[3456 + o] = (bf16)f2bf(ek[nt][r] * einv);
            bt4[r] = bb * eend; kt4[r] = ek[nt][r] * eend; }
        btf[nt].x = cvtpk(bt4[0], bt4[1]); btf[nt].y = cvtpk(bt4[2], bt4[3]); ktf[nt].x = cvtpk(kt4[0], kt4[1]); ktf[nt].y = cvtpk(kt4[2], kt4[3]); }
    asm volatile("s_waitcnt lgkmcnt(0)" ::: "memory");
    f32x4 Lab = (f32x4){0.f, 0.f, 0.f, 0.f}, Lak = Lab, Mrb = Lab, Mrk = Lab;
#pragma unroll
    for (int ks = 0; ks < 2; ++ks) { const int o = fr * 72 + 32 * ks + 8 * qd;
        const bf16x8_t aA = *(const LAS bf16x8_t*)(IMG + o), aR = *(const LAS bf16x8_t*)(IMG + 1152 + o), bB = *(const LAS bf16x8_t*)(IMG + 2304 + o), bK = *(const LAS bf16x8_t*)(IMG + 3456 + o);
        Lab = MFMA16(aA, bB, Lab); Lak = MFMA16(aA, bK, Lak); Mrb = MFMA16(aR, bB, Mrb); Mrk = MFMA16(aR, bK, Mrk); }
#pragma unroll
    for (int r = 0; r < 4; ++r) { const int t = 4 * qd + r; if (!(fr < t)) { Lab[r] = 0.f; Lak[r] = 0.f; } if (!(fr <= t)) { Mrb[r] = 0.f; Mrk[r] = 0.f; } Lf[t * 17 + fr] = Lab[r]; }
    asm volatile("s_waitcnt lgkmcnt(0)" ::: "memory");
    float Tc[16];
#pragma unroll
    for (int t = 0; t < 16; ++t) { float acc = (t == fr) ? 1.f : 0.f;
#pragma unroll
        for (int s = 0; s < t; ++s) acc += Lf[t * 17 + s] * Tc[s];
        Tc[t] = acc; }
    f32x4 Tm;
#pragma unroll
    for (int r = 0; r < 4; ++r) Tm[r] = qd == 0 ? Tc[r] : (qd == 1 ? Tc[4 + r] : (qd == 2 ? Tc[8 + r] : Tc[12 + r]));
#pragma unroll
    for (int r = 0; r < 4; ++r) { const int o = (4 * qd + r) * 20 + fr; MT[o] = (bf16)f2bf(Tm[r]); MT[320 + o] = (bf16)f2bf(Mrb[r]); MT[640 + o] = (bf16)f2bf(Lak[r]); MT[960 + o] = (bf16)f2bf(Mrk[r]); }
    asm volatile("s_waitcnt lgkmcnt(0)" ::: "memory");
    { const int o = fr * 20 + 4 * qd;
      *(u32x2_t*)(pkg + PK_TM + lane * 8) = *(const LAS u32x2_t*)(MT + o); *(u32x2_t*)(pkg + PK_MRB + lane * 8) = *(const LAS u32x2_t*)(MT + 320 + o);
      *(u32x2_t*)(pkg + PK_LAK + lane * 8) = *(const LAS u32x2_t*)(MT + 640 + o); *(u32x2_t*)(pkg + PK_MRK + lane * 8) = *(const LAS u32x2_t*)(MT + 960 + o); }
#pragma unroll
    for (int ks = 0; ks < 2; ++ks) { const int o = fr * 72 + 32 * ks + 4 * qd;
        const u32x2_t alo = *(const LAS u32x2_t*)(IMG + o), ahi = *(const LAS u32x2_t*)(IMG + o + 16), rlo = *(const LAS u32x2_t*)(IMG + 1152 + o), rhi = *(const LAS u32x2_t*)(IMG + 1152 + o + 16);
        *(u32x4_t*)(pkg + PK_AH + ks * 1024 + lane * 16) = (u32x4_t){alo.x, alo.y, ahi.x, ahi.y}; *(u32x4_t*)(pkg + PK_RH + ks * 1024 + lane * 16) = (u32x4_t){rlo.x, rlo.y, rhi.x, rhi.y}; }
#pragma unroll
    for (int nt = 0; nt < 4; ++nt) { *(u32x2_t*)(pkg + PK_BT + nt * 512 + lane * 8) = btf[nt]; *(u32x2_t*)(pkg + PK_KT + nt * 512 + lane * 8) = ktf[nt];
        u32x2_t vf; vf.x = cvtpk(ev[nt][0], ev[nt][1]); vf.y = cvtpk(ev[nt][2], ev[nt][3]); *(u32x2_t*)(pkg + PK_VV + nt * 512 + lane * 8) = vf;
        if (qd == 0) ((float*)(pkg + PK_GE))[16 * nt + fr] = __expf(lend[nt]); }
    asm volatile("s_waitcnt lgkmcnt(0)" ::: "memory");
#endif
}
DI void phase_rwkv_r1(const Args& A, int l, LAS unsigned char* lds, int bid, int G, int tid, int wave, int lane) {
    for (int it = bid; it < 2 * NB * 6 * 16; it += G) rwkv_r1_item(A, l, lds, it, tid, wave, lane);
    __syncthreads();
}

struct RkOps { bf16x8_t ah[2], rh[2]; bf16x4_t bt[4], kt[4], vv, tm, mrb, lak, mrk; f32x4 ge[4]; };
DI void rk_load(RkOps& o, const unsigned char* pkg, int vb, int lane, int qd) {
#pragma unroll
    for (int ks = 0; ks < 2; ++ks) { o.ah[ks] = *(const bf16x8_t*)(pkg + PK_AH + ks * 1024 + lane * 16); o.rh[ks] = *(const bf16x8_t*)(pkg + PK_RH + ks * 1024 + lane * 16); }
#pragma unroll
    for (int kt = 0; kt < 4; ++kt) { o.bt[kt] = *(const bf16x4_t*)(pkg + PK_BT + kt * 512 + lane * 8); o.kt[kt] = *(const bf16x4_t*)(pkg + PK_KT + kt * 512 + lane * 8); o.ge[kt] = *(const f32x4*)(pkg + PK_GE + (16 * kt + 4 * qd) * 4); }
    o.vv = *(const bf16x4_t*)(pkg + PK_VV + vb * 512 + lane * 8); o.tm = *(const bf16x4_t*)(pkg + PK_TM + lane * 8); o.mrb = *(const bf16x4_t*)(pkg + PK_MRB + lane * 8);
    o.lak = *(const bf16x4_t*)(pkg + PK_LAK + lane * 8); o.mrk = *(const bf16x4_t*)(pkg + PK_MRK + lane * 8);
}
DI void rk_step(const RkOps& c, f32x4 (&sT)[4], float* yb, int dir, int b, int hh, int vb, int cc, int fr, int qd) {
    const f32x4 zero4 = (f32x4){0.f, 0.f, 0.f, 0.f};
    union { unsigned u[4]; bf16x8_t v; } s0, s1;
    s0.u[0] = cvtpk(sT[0][0], sT[0][1]); s0.u[1] = cvtpk(sT[0][2], sT[0][3]); s0.u[2] = cvtpk(sT[1][0], sT[1][1]); s0.u[3] = cvtpk(sT[1][2], sT[1][3]);
    s1.u[0] = cvtpk(sT[2][0], sT[2][1]); s1.u[1] = cvtpk(sT[2][2], sT[2][3]); s1.u[2] = cvtpk(sT[3][0], sT[3][1]); s1.u[3] = cvtpk(sT[3][2], sT[3][3]);
    const bf16x8_t vv8 = widen4(c.vv);
    f32x4 ax = MFMA16(widen4(c.lak), vv8, zero4); ax = MFMA16(c.ah[0], s0.v, ax); ax = MFMA16(c.ah[1], s1.v, ax);
    f32x4 ay = MFMA16(widen4(c.mrk), vv8, zero4); ay = MFMA16(c.rh[0], s0.v, ay); ay = MFMA16(c.rh[1], s1.v, ay);
    const bf16x8_t xb = widen4(pack4(ax));
    const f32x4 au = MFMA16(widen4(c.tm), xb, zero4);
    const bf16x8_t ub = widen4(pack4(au));
    ay = MFMA16(widen4(c.mrb), ub, ay);
#pragma unroll
    for (int kt = 0; kt < 4; ++kt) { f32x4 t = sT[kt] * c.ge[kt]; t = MFMA16(widen4(c.kt[kt]), vv8, t); t = MFMA16(widen4(c.bt[kt]), ub, t); sT[kt] = t; }
    const int sgn = dir ? -1 : 1; const int tok0 = b * SEQ + (dir ? SEQ - 1 - 16 * cc : 16 * cc);
#pragma unroll
    for (int r = 0; r < 4; ++r) yb[((size_t)dir * NT + tok0 + sgn * (4 * qd + r)) * RW + hh * 64 + 16 * vb + fr] = ay[r];
}
constexpr int R2_SLOTS = 8, R2_CTL = R2_SLOTS * PKG_BYTES;
static_assert(R2_CTL + 64 <= MISC_OFF, "rwkv r2 LDS");
DI void rk_load_lds(RkOps& o, const LAS unsigned char* pkg, int vb, int lane, int qd) {
#pragma unroll
    for (int ks = 0; ks < 2; ++ks) { o.ah[ks] = *(const LAS bf16x8_t*)(pkg + PK_AH + ks * 1024 + lane * 16); o.rh[ks] = *(const LAS bf16x8_t*)(pkg + PK_RH + ks * 1024 + lane * 16); }
#pragma unroll
    for (int kt = 0; kt < 4; ++kt) { o.bt[kt] = *(const LAS bf16x4_t*)(pkg + PK_BT + kt * 512 + lane * 8); o.kt[kt] = *(const LAS bf16x4_t*)(pkg + PK_KT + kt * 512 + lane * 8); o.ge[kt] = *(const LAS f32x4*)(pkg + PK_GE + (16 * kt + 4 * qd) * 4); }
    o.vv = *(const LAS bf16x4_t*)(pkg + PK_VV + vb * 512 + lane * 8); o.tm = *(const LAS bf16x4_t*)(pkg + PK_TM + lane * 8); o.mrb = *(const LAS bf16x4_t*)(pkg + PK_MRB + lane * 8);
    o.lak = *(const LAS bf16x4_t*)(pkg + PK_LAK + lane * 8); o.mrk = *(const LAS bf16x4_t*)(pkg + PK_MRK + lane * 8);
}
DI void rk_pkg_fetch(u32x4_t (&buf)[13], const unsigned char* pkg, int lane) {
#pragma unroll
    for (int i = 0; i < 12; ++i) buf[i] = *(const u32x4_t*)(pkg + i * 1024 + lane * 16);
    buf[12] = (lane < 16) ? *(const u32x4_t*)(pkg + 12288 + lane * 16) : (u32x4_t){0u, 0u, 0u, 0u};
}
DI void rwkv_r2_unit(const Args& A, LAS unsigned char* lds, int u, int tid, int wave, int lane) {
    float* yb = (float*)(A.ws + WS_RKY);
    const int dir = u / 48, rem = u % 48, b = rem / 6, hh = rem % 6; const int fr = lane & 15, qd = lane >> 4;
    const unsigned char* pkg0 = A.ws + WS_PKG + ((size_t)((dir * NB + b) * 6 + hh) * 128) * PKG_BYTES;
    volatile LAS unsigned* ready = (volatile LAS unsigned*)(lds + R2_CTL); volatile LAS unsigned* consumed = ready + 8;
    __syncthreads();
    if (tid < 16) ready[tid] = 0u;
    __syncthreads();
    if (wave >= 4) {
        const int j = wave - 4; u32x4_t cur[13], nxt[13];
        rk_pkg_fetch(cur, pkg0 + (size_t)j * PKG_BYTES, lane);
        for (int cc = j; cc < 128; cc += 4) {
            if (cc + 4 < 128) rk_pkg_fetch(nxt, pkg0 + (size_t)(cc + 4) * PKG_BYTES, lane);
            if (cc >= R2_SLOTS) { const unsigned need = (unsigned)(cc - R2_SLOTS + 1); unsigned spins = 0;
                for (;;) { const unsigned c0 = consumed[0], c1 = consumed[1], c2 = consumed[2], c3 = consumed[3];
                    if (c0 >= need && c1 >= need && c2 >= need && c3 >= need) break; if (++spins > (1u << 22)) break; __builtin_amdgcn_s_sleep(1); } }
            LAS unsigned char* slot = lds + (cc & (R2_SLOTS - 1)) * PKG_BYTES;
#pragma unroll
            for (int i = 0; i < 12; ++i) *(LAS u32x4_t*)(slot + i * 1024 + lane * 16) = cur[i];
            if (lane < 16) *(LAS u32x4_t*)(slot + 12288 + lane * 16) = cur[12];
            asm volatile("s_waitcnt lgkmcnt(0)" ::: "memory");
            if (lane == 0) ready[cc & (R2_SLOTS - 1)] = (unsigned)(cc + 1);
            asm volatile("" ::: "memory");
#pragma unroll
            for (int i = 0; i < 13; ++i) cur[i] = nxt[i];
        }
    } else {
        const int vb = wave; f32x4 sT[4];
#pragma unroll
        for (int kt = 0; kt < 4; ++kt) sT[kt] = (f32x4){0.f, 0.f, 0.f, 0.f};
        for (int cc = 0; cc < 128; ++cc) { unsigned spins = 0;
            while (ready[cc & (R2_SLOTS - 1)] != (unsigned)(cc + 1)) { if (++spins > (1u << 22)) break; __builtin_amdgcn_s_sleep(1); }
            asm volatile("" ::: "memory");
            RkOps c; rk_load_lds(c, lds + (cc & (R2_SLOTS - 1)) * PKG_BYTES, vb, lane, qd);
            asm volatile("s_waitcnt lgkmcnt(0)" ::: "memory");
            if (lane == 0) consumed[vb] = (unsigned)(cc + 1);
            asm volatile("" ::: "memory");
            rk_step(c, sT, yb, dir, b, hh, vb, cc, fr, qd);
        }
    }
    __syncthreads();
}

constexpr int YA_G2LD = 136;
static_assert(384 * YA_G2LD * 2 <= MISC_OFF, "yasm LDS");
DI void phase_yasm(const Args& A, int l, LAS unsigned char* lds, int gw, int ngw, int tid, int lane) {
    const bf16* Z = (const bf16*)(A.ws + WS_Z); const bf16* ao = (const bf16*)(A.ws + WS_ATTO); const float* al = (const float*)(A.ws + WS_ATTL);
    const float* rky = (const float*)(A.ws + WS_RKY); const float* rkb = (const float*)(A.ws + WS_RKB);
    const float* num = (const float*)(A.ws + WS_MLNUM); const float* den = (const float*)(A.ws + WS_MLDEN); bf16* y = (bf16*)(A.ws + WS_HB);
    const float* g2 = A.in[I_G2] + (size_t)l * 128 * RW; const float* lng = A.in[I_RLNG] + (size_t)l * RW; const float* lnb = A.in[I_RLNB] + (size_t)l * RW; const float* mlg = A.in[I_MLNG] + (size_t)l * MW;
    LAS bf16* G2T = (LAS bf16*)lds;
    __syncthreads();
    for (int idx = tid; idx < 128 * RW; idx += NTHR) { const int j = idx / RW, col = idx % RW; G2T[col * YA_G2LD + j] = (bf16)f2bf(g2[idx]); }
    __syncthreads();
    const int fr = lane & 15, qd = lane >> 4;
    for (int item = gw; item < (NT / 16) * 6; item += ngw) {
        const int hh = item % 6, tg = item / 6; const int tokA = tg * 16 + fr;
        f32x4 gacc[4];
#pragma unroll
        for (int nt = 0; nt < 4; ++nt) gacc[nt] = (f32x4){0.f, 0.f, 0.f, 0.f};
#pragma unroll
        for (int ks = 0; ks < 4; ++ks) { float f[8]; unpack8(*(const uint4*)(Z + (size_t)tokA * ZLD + ZGD + 32 * ks + 8 * qd), f);
            union { unsigned u[4]; bf16x8_t v; } a;
#pragma unroll
            for (int e = 0; e < 4; ++e) a.u[e] = cvtpk(sigm(f[2 * e]), sigm(f[2 * e + 1]));
#pragma unroll
            for (int nt = 0; nt < 4; ++nt) { const bf16x8_t bg = *(const LAS bf16x8_t*)(G2T + (hh * 64 + 16 * nt + fr) * YA_G2LD + 32 * ks + 8 * qd); gacc[nt] = MFMA16(a.v, bg, gacc[nt]); } }
        float sv[4][4], bv[4][4]; float sm[4] = {0.f, 0.f, 0.f, 0.f};
#pragma unroll
        for (int nt = 0; nt < 4; ++nt)
#pragma unroll
            for (int r = 0; r < 4; ++r) { const size_t o = (size_t)(tg * 16 + 4 * qd + r) * RW + hh * 64 + 16 * nt + fr;
                sv[nt][r] = rky[o] + rky[(size_t)NT * RW + o]; bv[nt][r] = rkb[o] + rkb[(size_t)NT * RW + o]; sm[r] += sv[nt][r]; }
        float vr[4] = {0.f, 0.f, 0.f, 0.f};
#pragma unroll
        for (int r = 0; r < 4; ++r) {
#pragma unroll
            for (int o = 1; o < 16; o <<= 1) sm[r] += __shfl_xor(sm[r], o);
            sm[r] *= (1.f / 64.f);
#pragma unroll
            for (int nt = 0; nt < 4; ++nt) { sv[nt][r] -= sm[r]; vr[r] += sv[nt][r] * sv[nt][r]; }
#pragma unroll
            for (int o = 1; o < 16; o <<= 1) vr[r] += __shfl_xor(vr[r], o);
            vr[r] = rsqrtf(vr[r] * (1.f / 64.f) + 64e-5f); }
#pragma unroll
        for (int nt = 0; nt < 4; ++nt) { const int col = hh * 64 + 16 * nt + fr; const float lg_ = lng[col], lb_ = lnb[col];
#pragma unroll
            for (int r = 0; r < 4; ++r) y[(size_t)(tg * 16 + 4 * qd + r) * DM + AW + col] = (bf16)f2bf((sv[nt][r] * vr[r] * lg_ + lb_ + bv[nt][r]) * gacc[nt][r]); }
    }
    for (int tok = gw; tok < NT; tok += ngw) {
        const bf16* zr = Z + (size_t)tok * ZLD; bf16* yr = y + (size_t)tok * DM;
        const float lsev = al[((size_t)((lane >> 2) % 3) * NT + tok) * 4 + (lane & 3)];
        const float denv = den[((size_t)((lane >> 2) & 1) * NT + tok) * 4 + (lane & 3)];
#pragma unroll
        for (int hh = 0; hh < 4; ++hh) { const int col = hh * 64 + lane;
            const float l0 = __shfl(lsev, hh), l1 = __shfl(lsev, 4 + hh), l2 = __shfl(lsev, 8 + hh);
            const float mx = fmaxf(l0, fmaxf(l1, l2)); const float w0 = __expf(l0 - mx), w1 = __expf(l1 - mx), w2 = __expf(l2 - mx);
            const float o = (w0 * bf2f(ao[((size_t)0 * NT + tok) * AW + col]) + w1 * bf2f(ao[((size_t)1 * NT + tok) * AW + col]) + w2 * bf2f(ao[((size_t)2 * NT + tok) * AW + col])) / (w0 + w1 + w2);
            yr[col] = (bf16)f2bf(o); }
#pragma unroll
        for (int hh = 0; hh < 4; ++hh) { const int c0 = hh * 96 + lane, c1 = hh * 96 + 64 + (lane & 31); const bool hi = lane < 32;
            const float df = __shfl(denv, hh), db = __shfl(denv, 4 + hh);
            const float invf = 1.f / fmaxf(fabsf(df), 1.f), invb = 1.f / fmaxf(fabsf(db), 1.f);
            const float a = num[((size_t)0 * NT + tok) * MW + c0] * invf + num[((size_t)1 * NT + tok) * MW + c0] * invb;
            const float bb = hi ? (num[((size_t)0 * NT + tok) * MW + c1] * invf + num[((size_t)1 * NT + tok) * MW + c1] * invb) : 0.f;
            const float mean = (wave_sum(a) + wave_sum(bb)) * (1.f / 96.f); const float da = a - mean, dbb = hi ? bb - mean : 0.f;
            const float var = (wave_sum(da * da) + wave_sum(dbb * dbb)) * (1.f / 96.f); const float rs = rsqrtf(var + 1e-6f);
            yr[AW + RW + c0] = (bf16)f2bf(da * rs * mlg[c0] * sigm(bf2f(zr[ZMO + c0])));
            if (hi) yr[AW + RW + c1] = (bf16)f2bf(dbb * rs * mlg[c1] * sigm(bf2f(zr[ZMO + c1]))); }
    }
    __syncthreads();
}

constexpr int PH_PER_LAYER = 10, NPH = 1 + NL * PH_PER_LAYER + 1;
#ifndef MK_ONE_LAUNCH
#define MK_ONE_LAUNCH 1
#endif

#ifndef MK_DUP
#define MK_DUP 0
#endif
template <int l> DI void run_layer(const Args& A, LAS unsigned char* lds, const XcdBarrier& bar, int lo, int hi, int G, int bid, int tid, int lane, int wave, int gw, int ngw, int gtid, int nthr) {
#define IN(k) (lo <= (k) && (k) < hi)
#define SEAM(k) do { if (IN(k) && IN((k) + 1)) xcd_barrier(bar); } while (0)
#define PH(k, ...) do { if (IN(pb + (k))) { { __VA_ARGS__ } if ((MK_DUP >> (k)) & 1) { xcd_barrier(bar); { __VA_ARGS__ } } } SEAM(pb + (k)); } while (0)
    const int pb = 1 + l * PH_PER_LAYER;
    PH(0, phase_ln1(A, l, gw, ngw, lane););
    PH(1,
        pg8::Gemm g{(const bf16*)(A.ws + WS_HB), (const bf16*)(A.ws + WS_WTIN) + (size_t)l * ZLD * DM, NT, ZLD, DM};
        pg8::StaticOrder S; S.init(NT, ZLD, G, bid);
        pg8::EpiBf16<0> E{(bf16*)(A.ws + WS_Z), ZLD, nullptr, 0, 0, 1.f};
        pg8::gemm_phase<pg8::EpiBf16<0>, pg8::StaticOrder, true, true>(lds, g, S, E););
    PH(2, phase_attn(A, lds, bid, G, tid, wave, lane); if ((MK_DUP >> 12) & 1) phase_attn(A, lds, bid, G, tid, wave, lane); phase_rwkv_r1(A, l, lds, bid, G, tid, wave, lane); if ((MK_DUP >> 13) & 1) phase_rwkv_r1(A, l, lds, bid, G, tid, wave, lane);
          phase_mlstm_m1(A, l, lds, bid, G, tid, wave, lane); if ((MK_DUP >> 16) & 1) phase_mlstm_m1(A, l, lds, bid, G, tid, wave, lane););
    PH(3, for (int rep = 0; rep < 1 + ((MK_DUP >> 14) & 1); ++rep) for (int u = bid; u < 96; u += G) rwkv_r2_unit(A, lds, u, tid, wave, lane);
          for (int rep = 0; rep < 1 + ((MK_DUP >> 15) & 1); ++rep) for (int u = bid; u < 96 + 64; u += G) { if (u >= 96 && wave < 7) mlstm_m2_wave(A, u - 96, wave, lane); });
    PH(4, phase_yasm(A, l, lds, gw, ngw, tid, lane););
    PH(5,
        pg8::Gemm g{(const bf16*)(A.ws + WS_HB), (const bf16*)(A.ws + WS_WTOUT) + (size_t)l * DM * DM, NT, DM, DM};
        pg8::StaticOrder S; S.init(NT, DM, G, bid);
        EpiResF32 E{(l == 0) ? A.in[I_X] : (const float*)(A.ws + WS_X2), (float*)(A.ws + WS_X1), DM};
        pg8::gemm_phase<EpiResF32, pg8::StaticOrder, false, true>(lds, g, S, E););
    PH(6, phase_ln2(A, l, lds, gw, ngw, tid, lane););
    PH(7, phase_topk(A, lds, bid, G, tid, wave, lane););
    PH(8,
        pg8::Gemm g{(const bf16*)(A.ws + WS_XG), (const bf16*)(A.ws + WS_W13T + (size_t)l * NE * 5632 * DM), NSLOT, NE * 5632, DM / 2};
        GroupOrder S; S.init(22, G, bid);
        EpiSwiGLU E{A.ws + WS_ACT, 22};
        pg8::gemm_phase<EpiSwiGLU, GroupOrder, true, true, true>(lds, g, S, E););
    PH(9,
        pg8::Gemm g{(const bf16*)(A.ws + WS_ACT), (const bf16*)(A.ws + WS_W2T + (size_t)l * NE * DM * FF), NSLOT, NE * DM, FF / 2};
        GroupOrder S; S.init(4, G, bid);
        EpiGate E{(bf16*)(A.ws + WS_YS), (const float*)(A.ws + WS_GATE)};
        pg8::gemm_phase<EpiGate, GroupOrder, true, true, true>(lds, g, S, E););
#undef PH
#undef IN
#undef SEAM
}

__global__ void __launch_bounds__(NTHR, 2) mk_fwd(Args A) {
    extern __shared__ __attribute__((aligned(16))) unsigned char lds_raw[];
    LAS unsigned char* lds = (LAS unsigned char*)lds_raw;
    const int tid = threadIdx.x, lane = tid & 63, wave = __builtin_amdgcn_readfirstlane(tid >> 6);
    const int G = gridDim.x, bid = blockIdx.x;
    const int gw = bid * NWAVES + wave, ngw = G * NWAVES, gtid = bid * NTHR + tid, nthr = G * NTHR;
    volatile LAS unsigned* MISC = (volatile LAS unsigned*)(lds + MISC_OFF);
    if (tid < 64) MISC[tid] = 0u;
    __syncthreads();
    const int lo = A.ph_lo, hi = A.ph_hi;
    const bool use_bar = (hi - lo) > 1;
    XcdBarrier bar; bar.bar = (unsigned*)(A.ws + WS_CTL) + CW_BAR; bar.x = 0; bar.st = MISC + 8;
    if (use_bar) bar = xcd_barrier_post((unsigned*)(A.ws + WS_CTL) + CW_BAR, MISC + 8);
#define IN(k) (lo <= (k) && (k) < hi)
#define SEAM(k) do { if (IN(k) && IN((k) + 1)) xcd_barrier(bar); } while (0)

    if (IN(0)) { phase_p0(A, lds, gw, ngw, wave, lane); if ((MK_DUP >> 10) & 1) { xcd_barrier(bar); phase_p0(A, lds, gw, ngw, wave, lane); } } SEAM(0);

    run_layer<0>(A, lds, bar, lo, hi, G, bid, tid, lane, wave, gw, ngw, gtid, nthr);
    run_layer<1>(A, lds, bar, lo, hi, G, bid, tid, lane, wave, gw, ngw, gtid, nthr);
    if (IN(NPH - 1)) { phase_final(A, gw, ngw, lane); if ((MK_DUP >> 11) & 1) { xcd_barrier(bar); phase_final(A, gw, ngw, lane); } }
#undef IN
#undef SEAM
}
}

extern "C" void kernel_launch(void* const* d_in, const int* in_sizes, int n_in, void* d_out, int out_size, void* d_ws, size_t ws_size, hipStream_t stream) {
    using namespace mk;
    static int grid = 0;
    if (grid == 0) {
        if (n_in != N_IN || out_size != NT * DM || ws_size < WS_END) { fprintf(stderr, "kernel_launch: unexpected shapes (n_in %d, out %d, ws %zu < %zu)\n", n_in, out_size, ws_size, (size_t)WS_END); grid = -1; return; }
        int dev = 0, cus = 0, per_cu = 0;
        if (hipGetDevice(&dev) != hipSuccess || hipDeviceGetAttribute(&cus, hipDeviceAttributeMultiprocessorCount, dev) != hipSuccess) { grid = -1; return; }
        if (hipFuncSetAttribute((const void*)mk_fwd, hipFuncAttributeMaxDynamicSharedMemorySize, LDS_BYTES) != hipSuccess) { fprintf(stderr, "kernel_launch: hipFuncSetAttribute failed\n"); grid = -1; return; }
        if (hipOccupancyMaxActiveBlocksPerMultiprocessor(&per_cu, (const void*)mk_fwd, NTHR, LDS_BYTES) != hipSuccess || per_cu < 1) fprintf(stderr, "kernel_launch: occupancy query reports %d\n", per_cu);
        (void)hipGetLastError();
        grid = cus;
    }
    if (grid < 0) return;
    hipMemsetAsync((char*)d_ws + WS_CTL, 0, CTL_ZERO_BYTES, stream);
    Args a{};
    for (int i = 0; i < N_IN; ++i) a.in[i] = (const float*)d_in[i];
    a.out = (float*)d_out; a.ws = (unsigned char*)d_ws;
#if MK_ONE_LAUNCH
    a.ph_lo = 0; a.ph_hi = NPH;
    hipLaunchKernelGGL(mk_fwd, dim3(grid), dim3(NTHR), LDS_BYTES, stream, a);
#else
    for (int p = 0; p < NPH; ++p) { a.ph_lo = p; a.ph_hi = p + 1; hipLaunchKernelGGL(mk_fwd, dim3(grid), dim3(NTHR), LDS_BYTES, stream, a); }
#endif
}
```

```cpp
#include <hip/hip_runtime.h>
#include <cstdio>
#include <cstdint>
namespace pg8 {
#define PG8_LAS __attribute__((address_space(3)))
typedef unsigned short bf16_t;
typedef short bf16x8 __attribute__((ext_vector_type(8)));
typedef float f32x4 __attribute__((ext_vector_type(4)));
typedef unsigned u32x4 __attribute__((ext_vector_type(4)));
constexpr int BM = 256, BK = 64, HALF = 128, HTB = HALF * BK * 2  , STAGE_BYTES = 8 * HTB, NXCD = 8, WGM = 8;

__host__ __device__ __forceinline__ int lds_byte(int r, int c) { const int st = (r >> 4) * 2 + (c >> 5), rr = r & 15, cc = c & 31, ob = rr * 64 + cc * 2; return st * 1024 + (ob ^ (((ob >> 9) & 1) << 5)); }
__host__ __device__ __forceinline__ void stage_rc(int b, int& R, int& C) { const int st = b / 1024, sb = b % 1024, swz = sb ^ (((sb >> 9) & 1) << 5); R = (st >> 1) * 16 + swz / 64; C = (st & 1) * 32 + (swz % 64) / 2; }
__host__ __device__ __forceinline__ int perm32(int rho) { const int n = rho >> 4, i = rho & 15; return 8 * (i >> 2) + 4 * n + (i & 3); }

struct Unit { int pm, pn; };
struct Gemm { const bf16_t* A; const bf16_t* Bt; int M, N, K; };

struct StaticOrder {
    int nM, nN, nwg, G, c;
    __host__ __device__ void init(int M, int N, int G_, int c_) { nM = M / BM; nN = N / BM; nwg = nM * nN; G = G_; c = c_; }
    __host__ __device__ bool next(int i, Unit& u) const {
        const long L = (long)i * G + c; if (L >= nwg) return false;
        int wgid = (int)L; { const int q = nwg / NXCD, r = nwg % NXCD, xcd = wgid % NXCD, off = wgid / NXCD; wgid = (xcd < r ? xcd * (q + 1) : r * (q + 1) + (xcd - r) * q) + off; }
        const int nig = WGM * nN, gid = wgid / nig, fm = gid * WGM, gsz = (nM - fm) < WGM ? (nM - fm) : WGM;
        u.pm = fm + ((wgid % nig) % gsz); u.pn = (wgid % nig) / gsz; return true;
    }
    __device__ __forceinline__ void a_ready(const Unit&) const {}
    __device__ __forceinline__ void done(const Unit&) const {}
};

__device__ __forceinline__ unsigned cvt_pk_bf16(float lo, float hi) { unsigned r; asm volatile("v_cvt_pk_bf16_f32 %0, %1, %2" : "=v"(r) : "v"(lo), "v"(hi)); return r; }
typedef float f32x2 __attribute__((ext_vector_type(2)));
__device__ __forceinline__ f32x2 gelu_pk(f32x2 v) {
    const f32x2 av = __builtin_elementwise_abs(v), d = av * 0.2316418882f + 1.0f;
    f32x2 t; t.x = __builtin_amdgcn_rcpf(d.x); t.y = __builtin_amdgcn_rcpf(d.y);
    f32x2 q = t * 0.5307027145f + (-0.7265760135f); q = q * t + 0.7107068705f; q = q * t + (-0.142248368f); q = q * t + 0.127414796f; q = q * t;
    const f32x2 s = (v * v) * (-0.72134752044f);
    f32x2 e; e.x = __builtin_amdgcn_exp2f(s.x); e.y = __builtin_amdgcn_exp2f(s.y);
    const f32x2 m = v * (q * e), r = v - m;
    f32x2 o; o.x = v.x < 0.f ? m.x : r.x; o.y = v.y < 0.f ? m.y : r.y; return o;
}

template <int ACT  > struct EpiBf16 {
    static constexpr bool PERM = true, AFTER_DRAIN = false; static_assert(ACT == 0 || ACT == 1, "EpiBf16: ACT is 0 (none) or 1 (gelu_pk)");
    bf16_t* O; int ldc; const float* bias; int split_cols; size_t split_stride; float scale0;
    __device__ __forceinline__ void operator()(const f32x4 (&acc)[2][2][4][2], const Unit& u, int wr, int wc, int fr, int fq) const {
        const int row0 = u.pm * BM + wr * 64 + fr; int colt = u.pn * BM; bf16_t* base = O;
        float sc = 1.f; if (split_cols) { const int t = colt / split_cols; base += (size_t)t * split_stride; colt -= t * split_cols; if (t == 0) sc = scale0; }
        const int col0 = colt + wc * 32 + 8 * fq, bcol0 = u.pn * BM + wc * 32 + 8 * fq;
        f32x4 bv[2][2];
#pragma unroll
        for (int bj = 0; bj < 2; ++bj)
#pragma unroll
            for (int n = 0; n < 2; ++n) bv[bj][n] = bias ? *(const f32x4*)(bias + bcol0 + bj * HALF + 4 * n) : (f32x4){0.f, 0.f, 0.f, 0.f};
#pragma unroll
        for (int ai = 0; ai < 2; ++ai)
#pragma unroll
            for (int m = 0; m < 4; ++m) { bf16_t* rowp = base + (size_t)(row0 + ai * HALF + m * 16) * ldc + col0;
#pragma unroll
                for (int bj = 0; bj < 2; ++bj) { f32x4 v0 = acc[ai][bj][m][0] + bv[bj][0], v1 = acc[ai][bj][m][1] + bv[bj][1];
                    if (ACT == 1) { f32x2 a = gelu_pk((f32x2){v0[0], v0[1]}), b = gelu_pk((f32x2){v0[2], v0[3]}), c = gelu_pk((f32x2){v1[0], v1[1]}), d = gelu_pk((f32x2){v1[2], v1[3]});
                        v0 = (f32x4){a.x, a.y, b.x, b.y}; v1 = (f32x4){c.x, c.y, d.x, d.y}; }
                    v0 = v0 * sc; v1 = v1 * sc; u32x4 w; w.x = cvt_pk_bf16(v0[0], v0[1]); w.y = cvt_pk_bf16(v0[2], v0[3]); w.z = cvt_pk_bf16(v1[0], v1[1]); w.w = cvt_pk_bf16(v1[2], v1[3]);
                    *(u32x4*)(rowp + bj * HALF) = w; } }
    }
};
template <class Epi, class Sched, bool ALIGN_EPI = false, bool SP2 = false, bool F8 = false>
__device__ __forceinline__ void gemm_phase(PG8_LAS unsigned char* lds, const Gemm g, const Sched& S, const Epi& E) {
    const int tid = threadIdx.x, wid = __builtin_amdgcn_readfirstlane(tid >> 6), lane = tid & 63, wr = wid >> 2, wc = wid & 3, fr = lane & 15, fq = lane >> 4;
    int Kq = g.K; if constexpr (F8) asm volatile("" : "+s"(Kq));
    const int K = Kq, nt = K / BK;
    unsigned voffA[2], voffB[2];
#pragma unroll
    for (int i = 0; i < 2; ++i) { int R, C; stage_rc(tid * 16 + i * 8192, R, C); const int Rb = Epi::PERM ? ((R & ~31) + perm32(R & 31)) : R;
        voffA[i] = (unsigned)(R * K + C) * 2u; voffB[i] = (unsigned)(Rb * K + C) * 2u; }
    const size_t kstep = (size_t)(BK * 2);
    const size_t hstep = (size_t)HALF * K * 2;
    const size_t tstep = 2 * hstep;
    const unsigned ldsw = (unsigned)wid * 1024u;
    const int aoff = lds_byte(wr * 64 + fr, fq * 8), boff = lds_byte(wc * 32 + fr, fq * 8);
#define PG8_SA(b, h) (((b) * 2 + (h)) * HTB)
#define PG8_SB(b, h) ((4 + (b) * 2 + (h)) * HTB)
#define PG8_STAGE(bufoff, gbase, voff) do { _Pragma("unroll") for (int _i = 0; _i < 2; ++_i) \
        __builtin_amdgcn_global_load_lds((const unsigned*)((const char*)(gbase) + (voff)[_i]), (PG8_LAS unsigned*)(lds + (bufoff) + ldsw + _i * 8192), 16, 0, 0); } while (0)
#define PG8_LDA(dst, b, h) do { _Pragma("unroll") for (int m = 0; m < 4; ++m) { if constexpr (F8) { const i32x4_ lo_ = *(const PG8_LAS i32x4_*)(lds + PG8_SA(b, h) + aoff + m * 2048), hi_ = *(const PG8_LAS i32x4_*)(lds + PG8_SA(b, h) + aoff + m * 2048 + 1024); dst##8[m] = __builtin_shufflevector(lo_, hi_, 0, 1, 2, 3, 4, 5, 6, 7); } \
        else { _Pragma("unroll") for (int k = 0; k < 2; ++k) dst[m][k] = *(const PG8_LAS bf16x8*)(lds + PG8_SA(b, h) + aoff + m * 2048 + k * 1024); } } } while (0)
#define PG8_LDB(dst, b, h) do { _Pragma("unroll") for (int n = 0; n < 2; ++n) { if constexpr (F8) { const i32x4_ lo_ = *(const PG8_LAS i32x4_*)(lds + PG8_SB(b, h) + boff + n * 2048), hi_ = *(const PG8_LAS i32x4_*)(lds + PG8_SB(b, h) + boff + n * 2048 + 1024); dst##8[n] = __builtin_shufflevector(lo_, hi_, 0, 1, 2, 3, 4, 5, 6, 7); } \
        else { _Pragma("unroll") for (int k = 0; k < 2; ++k) dst[n][k] = *(const PG8_LAS bf16x8*)(lds + PG8_SB(b, h) + boff + n * 2048 + k * 1024); } } } while (0)
#define PG8_MMA(ai, bj, At, Bt) do { __builtin_amdgcn_s_setprio(1); _Pragma("unroll") for (int m = 0; m < 4; ++m) _Pragma("unroll") for (int n = 0; n < 2; ++n) { \
        if constexpr (F8) asm volatile("v_mfma_scale_f32_16x16x128_f8f6f4 %0, %1, %2, %0, %3, %3 op_sel_hi:[0,0,0]" : "+v"(acc[ai][bj][m][n]) : "v"(Bt##8[n]), "v"(At##8[m]), "v"(f8scale)); \
        else { _Pragma("unroll") for (int k = 0; k < 2; ++k) acc[ai][bj][m][n] = __builtin_amdgcn_mfma_f32_16x16x32_bf16(Bt[n][k], At[m][k], acc[ai][bj][m][n], 0, 0, 0); } } \
        __builtin_amdgcn_s_setprio(0); } while (0)
#define PG8_WAIT_V(n) asm volatile("s_waitcnt vmcnt(" #n ")" ::: "memory")
#define PG8_WAIT_L(n) asm volatile("s_waitcnt lgkmcnt(" #n ")" ::: "memory")
#define PG8_BAR __builtin_amdgcn_s_barrier()
#define PG8_SCHED __builtin_amdgcn_sched_barrier(0)
    Unit cur, nxt; int ui = 0;
    if (!S.next(0, cur)) return;
    f32x4 acc[2][2][4][2];
#pragma unroll
    for (int a = 0; a < 2; ++a)
#pragma unroll
        for (int b = 0; b < 2; ++b)
#pragma unroll
            for (int m = 0; m < 4; ++m)
#pragma unroll
                for (int n = 0; n < 2; ++n) { acc[a][b][m][n] = (f32x4){0.f, 0.f, 0.f, 0.f}; if constexpr (F8) asm volatile("" : "+v"(acc[a][b][m][n])); }
    bf16x8 At[4][2], B0[2][2], B1[2][2];
    typedef int i32x4_ __attribute__((ext_vector_type(4))); typedef int i32x8_ __attribute__((ext_vector_type(8)));
    i32x8_ At8[4], B08[2], B18[2];
    int f8scale = 0x7f7f7f7f; asm volatile("" : "+v"(f8scale));
    const char* cA = (const char*)g.A + (size_t)cur.pm * tstep; const char* cB = (const char*)g.Bt + (size_t)cur.pn * tstep;
    S.a_ready(cur);
    if constexpr (SP2) {
        PG8_STAGE(PG8_SB(0, 0), cB, voffB); PG8_STAGE(PG8_SB(0, 1), cB + hstep, voffB); PG8_STAGE(PG8_SA(0, 0), cA, voffA); PG8_STAGE(PG8_SA(0, 1), cA + hstep, voffA);
        if (wr == 1) PG8_BAR;
        PG8_WAIT_V(2); PG8_BAR;
        PG8_STAGE(PG8_SB(1, 0), cB + kstep, voffB); PG8_STAGE(PG8_SA(1, 0), cA + kstep, voffA); PG8_STAGE(PG8_SB(1, 1), cB + hstep + kstep, voffB);
        PG8_WAIT_V(6); PG8_BAR;
    } else {
        PG8_STAGE(PG8_SB(0, 0), cB, voffB); PG8_STAGE(PG8_SA(0, 0), cA, voffA); PG8_STAGE(PG8_SB(0, 1), cB + hstep, voffB); PG8_STAGE(PG8_SA(0, 1), cA + hstep, voffA);
        if (wr == 1) PG8_BAR;
        PG8_WAIT_V(4); PG8_BAR;
        PG8_STAGE(PG8_SB(1, 0), cB + kstep, voffB); PG8_STAGE(PG8_SA(1, 0), cA + kstep, voffA); PG8_STAGE(PG8_SB(1, 1), cB + hstep + kstep, voffB);
        PG8_WAIT_V(6); PG8_BAR;
    }
    for (;;) {
        const bool has_next = S.next(ui + 1, nxt);
        const char* nA = has_next ? (const char*)g.A + (size_t)nxt.pm * tstep : cA; const char* nB = has_next ? (const char*)g.Bt + (size_t)nxt.pn * tstep : cB;
        for (int t = 0; t < nt; t += 2) {
            const bool last = (t == nt - 2);
            const char* a1 = cA + (size_t)(t + 1) * kstep;
            const char* a2 = last ? nA : cA + (size_t)(t + 2) * kstep; const char* b2 = last ? nB : cB + (size_t)(t + 2) * kstep;
            const char* a3 = a2 + kstep; const char* b3 = b2 + kstep;
            if (last && has_next) S.a_ready(nxt);
            if constexpr (SP2) {
            PG8_LDB(B0, 0, 0); PG8_LDB(B1, 0, 1); PG8_SCHED; PG8_LDA(At, 0, 0); PG8_STAGE(PG8_SA(1, 1), a1 + hstep, voffA);
            PG8_WAIT_V(8); PG8_WAIT_L(0); PG8_BAR; PG8_MMA(0, 0, At, B0); PG8_MMA(0, 1, At, B1); PG8_BAR; PG8_SCHED;
            PG8_LDA(At, 0, 1); PG8_STAGE(PG8_SB(0, 0), b2, voffB); PG8_STAGE(PG8_SB(0, 1), b2 + hstep, voffB); PG8_STAGE(PG8_SA(0, 0), a2, voffA);
            PG8_WAIT_V(8); PG8_WAIT_L(0); PG8_BAR; PG8_MMA(1, 0, At, B0); PG8_MMA(1, 1, At, B1); PG8_BAR; PG8_SCHED;
            PG8_LDB(B0, 1, 0); PG8_LDB(B1, 1, 1); PG8_SCHED; PG8_LDA(At, 1, 0); PG8_STAGE(PG8_SA(0, 1), a2 + hstep, voffA);
            PG8_WAIT_V(8); PG8_WAIT_L(0); PG8_BAR; PG8_MMA(0, 0, At, B0); PG8_MMA(0, 1, At, B1); PG8_BAR; PG8_SCHED;
            PG8_LDA(At, 1, 1); PG8_STAGE(PG8_SB(1, 0), b3, voffB); PG8_STAGE(PG8_SB(1, 1), b3 + hstep, voffB); PG8_STAGE(PG8_SA(1, 0), a3, voffA);
            PG8_WAIT_V(8); PG8_WAIT_L(0); PG8_BAR; PG8_MMA(1, 0, At, B0); PG8_MMA(1, 1, At, B1); PG8_BAR; PG8_SCHED;
            } else {
            PG8_LDB(B0, 0, 0); PG8_SCHED; PG8_LDA(At, 0, 0); PG8_STAGE(PG8_SA(1, 1), a1 + hstep, voffA);
            PG8_WAIT_L(8); PG8_BAR; PG8_WAIT_L(0); PG8_MMA(0, 0, At, B0); PG8_BAR; PG8_SCHED;
            PG8_LDB(B1, 0, 1); PG8_STAGE(PG8_SB(0, 0), b2, voffB);
            PG8_BAR; PG8_WAIT_L(0); PG8_MMA(0, 1, At, B1); PG8_BAR;
            PG8_LDA(At, 0, 1); PG8_STAGE(PG8_SA(0, 0), a2, voffA);
            PG8_BAR; PG8_WAIT_L(0); PG8_MMA(1, 0, At, B0); PG8_BAR; PG8_SCHED;
            PG8_STAGE(PG8_SB(0, 1), b2 + hstep, voffB);
            PG8_WAIT_V(6); PG8_BAR; PG8_MMA(1, 1, At, B1); PG8_BAR;
            PG8_LDB(B0, 1, 0); PG8_SCHED; PG8_LDA(At, 1, 0); PG8_STAGE(PG8_SA(0, 1), a2 + hstep, voffA);
            PG8_WAIT_L(8); PG8_BAR; PG8_WAIT_L(0); PG8_MMA(0, 0, At, B0); PG8_BAR; PG8_SCHED;
            PG8_LDB(B1, 1, 1); PG8_STAGE(PG8_SB(1, 0), b3, voffB);
            PG8_BAR; PG8_WAIT_L(0); PG8_MMA(0, 1, At, B1); PG8_BAR;
            PG8_LDA(At, 1, 1); PG8_STAGE(PG8_SA(1, 0), a3, voffA);
            PG8_BAR; PG8_WAIT_L(0); PG8_MMA(1, 0, At, B0); PG8_BAR; PG8_SCHED;
            PG8_STAGE(PG8_SB(1, 1), b3 + hstep, voffB);
            PG8_WAIT_V(6); PG8_BAR; PG8_MMA(1, 1, At, B1); PG8_BAR;
            }
        }
        if constexpr (F8) asm volatile("s_nop 15\n\ts_nop 15" ::: "memory");
        if constexpr (ALIGN_EPI) { if (wr == 0) PG8_BAR; }
        if constexpr (!Epi::AFTER_DRAIN) { E(acc, cur, wr, wc, fr, fq); S.done(cur); }
        if (!has_next) break;
#pragma unroll
        for (int a = 0; a < 2; ++a)
#pragma unroll
            for (int b = 0; b < 2; ++b)
#pragma unroll
                for (int m = 0; m < 4; ++m)
#pragma unroll
                    for (int n = 0; n < 2; ++n) { acc[a][b][m][n] = (f32x4){0.f, 0.f, 0.f, 0.f}; if constexpr (F8) asm volatile("" : "+v"(acc[a][b][m][n])); }
        cur = nxt; cA = nA; cB = nB; ++ui;
        if constexpr (ALIGN_EPI) { if (wr == 1) PG8_BAR; }
    }
    PG8_WAIT_V(0);
    if constexpr (!ALIGN_EPI) { if (wr == 0) PG8_BAR; }
    PG8_BAR;
    if constexpr (Epi::AFTER_DRAIN) { E.fused(acc, cur, wr, wc, fr, fq, lds, wid, lane); S.done(cur); }
#undef PG8_SA
#undef PG8_SB
#undef PG8_STAGE
#undef PG8_LDA
#undef PG8_LDB
#undef PG8_MMA
#undef PG8_WAIT_V
#undef PG8_WAIT_L
#undef PG8_BAR
#undef PG8_SCHED
}
}
#define LAS __attribute__((address_space(3)))
#define XB_TMO      128
#define XB_XCNT(j)  (256  + 64 * (j))
#define XB_XSUB(j)  (1280 + 64 * (j))
#define XB_XGEN(j)  (2304 + 64 * (j))
#define XB_TOP      3328
#define XB_TOPGEN   3392
#define XCD_BAR_WORDS 3456
#define XB_SPIN_CAP (1u << 18)

__device__ __forceinline__ unsigned xb_ld(unsigned* p)              { return __hip_atomic_load(p, __ATOMIC_RELAXED, __HIP_MEMORY_SCOPE_AGENT); }
__device__ __forceinline__ unsigned xb_add(unsigned* p, unsigned v) { return __hip_atomic_fetch_add(p, v, __ATOMIC_RELAXED, __HIP_MEMORY_SCOPE_AGENT); }
__device__ __forceinline__ unsigned xb_xcc_id() { return (unsigned)__builtin_amdgcn_s_getreg((3 << 11) | 20) & 0xFu; }
#define XB_SPIN(cond, bar) do { unsigned _sp = 0; while (cond) { __builtin_amdgcn_s_sleep(1); \
    if ((++_sp & 255u) == 0u) { if (xb_ld(&(bar)[XB_TMO])) break; if (_sp > XB_SPIN_CAP) { atomicAdd(&(bar)[XB_TMO], 1u); break; } } } } while (0)

struct XcdBarrier {
    unsigned* bar; unsigned x;
    volatile LAS unsigned* st;
};

__device__ __forceinline__ XcdBarrier xcd_barrier_post(unsigned* bar, volatile LAS unsigned* st) {
    XcdBarrier b; b.bar = bar; b.x = xb_xcc_id(); b.st = st;
    if (threadIdx.x == 0) (void)xb_add(&bar[XB_XCNT(b.x)], 1u);
    return b;
}
__device__ __forceinline__ void xcd_barrier_complete(unsigned* bar, unsigned x, unsigned& nloc, unsigned& nx) {
    const unsigned G = gridDim.x * gridDim.y * gridDim.z;
    unsigned sum, cnt, mine, sp = 0u;
    for (;;) {
        sum = 0u; cnt = 0u; mine = 0u;
#pragma unroll
        for (unsigned j = 0; j < 16; ++j) { const unsigned c = xb_ld(&bar[XB_XCNT(j)]); sum += c; cnt += (c > 0u) ? 1u : 0u; mine = (j == x) ? c : mine; }
        if (sum == G) break;
        __builtin_amdgcn_s_sleep(1);
        if ((++sp & 255u) == 0u) { if (xb_ld(&bar[XB_TMO])) break; if (sp > XB_SPIN_CAP) { atomicAdd(&bar[XB_TMO], 1u); break; } }
    }
    nloc = mine > 0u ? mine : 1u; nx = cnt > 0u ? cnt : 1u;
}

__device__ __forceinline__ void xcd_barrier(const XcdBarrier& b) {
    asm volatile("s_waitcnt vmcnt(0)" ::: "memory");
    __syncthreads();
    if (threadIdx.x == 0) {
        unsigned* bar = b.bar;
        __builtin_amdgcn_s_waitcnt(0);
        unsigned nloc = b.st[0], nx = b.st[1];
        if (nloc == 0u) { xcd_barrier_complete(bar, b.x, nloc, nx); b.st[0] = nloc; b.st[1] = nx; }
        const unsigned old = xb_add(&bar[XB_XSUB(b.x)], 1u);
        const unsigned gen = old / nloc;
        if (old + 1u == (gen + 1u) * nloc) {
            __builtin_amdgcn_fence(__ATOMIC_RELEASE, "agent");
            asm volatile("s_waitcnt vmcnt(0)" ::: "memory");
            const unsigned og = xb_add(&bar[XB_TOP], 1u);
            const unsigned tg = og / nx;
            if (og + 1u == (tg + 1u) * nx) xb_add(&bar[XB_TOPGEN], 1u);
            else XB_SPIN(xb_ld(&bar[XB_TOPGEN]) == tg, bar);
            __builtin_amdgcn_fence(__ATOMIC_ACQUIRE, "agent");
            xb_add(&bar[XB_XGEN(b.x)], 1u);
            asm volatile("s_waitcnt vmcnt(0)" ::: "memory");
        } else {
            XB_SPIN(xb_ld(&bar[XB_XGEN(b.x)]) == gen, bar);
            __builtin_amdgcn_fence(__ATOMIC_ACQUIRE, "agent");
            asm volatile("s_waitcnt vmcnt(0)" ::: "memory");
        }
    }
    __syncthreads();
}

#define DI __device__ __forceinline__
#define LDS_WAIT() asm volatile("s_waitcnt lgkmcnt(0)" ::: "memory")
typedef unsigned short bf16;
typedef float f32x4 __attribute__((ext_vector_type(4)));

namespace mk {
constexpr int NB = 8, SEQ = 2048, DM = 1024, NT = NB * SEQ, NL = 2;
constexpr int INW = 3856, ZLD = 4096;
constexpr int ZA = 0, ZRKV = 768, ZWDF = 1920, ZWDB = 1984, ZADF = 2048, ZADB = 2112, ZGD = 2176, ZMQK = 2304, ZMV = 3072, ZMO = 3456, ZMG = 3840;
constexpr int RW = 384, MW = 384, AW = 256;
constexpr int NE = 16, CAP = 256, FF = 2816, NSLOT = NB * NE * CAP;
constexpr int NWAVES = 8, NTHR = 512;
constexpr float RMS_EPS = 1e-6f;

enum { I_X = 0, I_RELB, I_LN1G, I_WIN, I_WOUT, I_MU, I_W0, I_W2, I_A0, I_A2, I_KK, I_KA, I_RK, I_G2, I_RLNG, I_RLNB,
       I_CW, I_CB, I_IB, I_FB, I_MLNG, I_LN2G, I_ROUTER, I_EW1, I_EW3, I_EW2, I_FG, N_IN };

constexpr size_t MiB = 1u << 20;
constexpr size_t WS_CTL = 0, CTL_ZERO_BYTES = 1 * MiB;
constexpr size_t WS_WTIN = 2 * MiB;
constexpr size_t WS_WTOUT = 18 * MiB;
constexpr size_t WS_W13T = 22 * MiB;
constexpr size_t WS_W2T = 374 * MiB;
constexpr size_t WS_X1 = 550 * MiB;
constexpr size_t WS_X2 = 614 * MiB;
constexpr size_t WS_HB = 678 * MiB;
constexpr size_t WS_AFF = 710 * MiB;
constexpr size_t WS_SEL = 711 * MiB;
constexpr size_t WS_GATE = 712 * MiB;
constexpr size_t WS_G2T = 713 * MiB;
constexpr size_t WS_R = 714 * MiB;
constexpr size_t WS_Z = WS_R;
constexpr size_t WS_ATTO = WS_R + 128 * MiB;
constexpr size_t WS_ATTL = WS_R + 152 * MiB;
constexpr size_t WS_PR = WS_R + 154 * MiB;
constexpr size_t WS_RKY = WS_R + 442 * MiB;
constexpr size_t WS_RKB = WS_R + 490 * MiB;
constexpr size_t WS_MLQK = WS_R + 538 * MiB;
constexpr size_t WS_MLNUM = WS_R + 586 * MiB;
constexpr size_t WS_MLDEN = WS_R + 634 * MiB;
constexpr size_t WS_XG = WS_R;
constexpr size_t WS_ACT = WS_R + 64 * MiB;
constexpr size_t WS_YS = WS_R + 240 * MiB;
constexpr size_t WS_END = WS_R + 636 * MiB;

constexpr int CW_BAR = 4096;
constexpr int LDS_BYTES = 147456;
constexpr int MISC_OFF = LDS_BYTES - 256;

struct Args { const float* in[N_IN]; float* out; unsigned char* ws; int ph_lo, ph_hi; };

DI float bf2f(unsigned v) { return __uint_as_float(v << 16); }
DI unsigned f2bf(float f) { unsigned u = __float_as_uint(f); return (u + 0x7fffu + ((u >> 16) & 1u)) >> 16; }
DI unsigned pk2(float lo, float hi) { return f2bf(lo) | (f2bf(hi) << 16); }
DI float wave_sum(float v) {
#pragma unroll
    for (int o = 1; o < 64; o <<= 1) v += __shfl_xor(v, o);
    return v;
}
DI float sigm(float x) { return 1.f / (1.f + __expf(-x)); }
DI void unpack8(const uint4 w, float (&f)[8]) {
    f[0] = __uint_as_float(w.x << 16); f[1] = __uint_as_float(w.x & 0xffff0000u); f[2] = __uint_as_float(w.y << 16); f[3] = __uint_as_float(w.y & 0xffff0000u);
    f[4] = __uint_as_float(w.z << 16); f[5] = __uint_as_float(w.z & 0xffff0000u); f[6] = __uint_as_float(w.w << 16); f[7] = __uint_as_float(w.w & 0xffff0000u);
}

struct GroupOrder {
    int G, c2, nunits, per_e, nN;
    DI void init(int nN_, int G_, int bid) { nN = nN_; per_e = 8 * nN_; nunits = NE * per_e; G = G_; c2 = (G_ % 8 == 0) ? (bid % 8) * (G_ / 8) + bid / 8 : bid; }
    DI bool next(int i, pg8::Unit& u) const {
        const long L = (long)i * G + c2; if (L >= nunits) return false;
        const int e = (int)L / per_e, r = (int)L % per_e; u.pm = e * 8 + (r & 7); u.pn = e * nN + (r >> 3); return true;
    }
    DI void a_ready(const pg8::Unit&) const {}
    DI void done(const pg8::Unit&) const {}
};
struct EpiResF32 {
    static constexpr bool PERM = false, AFTER_DRAIN = false;
    const float* base; float* out; int ldc;
    DI void operator()(const pg8::f32x4 (&acc)[2][2][4][2], const pg8::Unit& u, int wr, int wc, int fr, int fq) const {
        const int row0 = u.pm * 256 + wr * 64 + fr, col0 = u.pn * 256 + wc * 32 + 4 * fq;
#pragma unroll
        for (int ai = 0; ai < 2; ++ai)
#pragma unroll
            for (int m = 0; m < 4; ++m) { const size_t off = (size_t)(row0 + ai * 128 + m * 16) * ldc + col0;
#pragma unroll
                for (int bj = 0; bj < 2; ++bj)
#pragma unroll
                    for (int n = 0; n < 2; ++n) { const pg8::f32x4 b = *(const pg8::f32x4*)(base + off + bj * 128 + n * 16); *(pg8::f32x4*)(out + off + bj * 128 + n * 16) = b + acc[ai][bj][m][n]; } }
    }
};
DI float silu_f(float x) { return x * __builtin_amdgcn_rcpf(1.f + __expf(-x)); }
DI float f8clamp(float x) { return __builtin_amdgcn_fmed3f(x, -448.f, 448.f); }
DI unsigned pk4_fp8(float a, float b, float c, float d) { unsigned p = 0u; p = __builtin_amdgcn_cvt_pk_fp8_f32(f8clamp(a), f8clamp(b), p, false); p = __builtin_amdgcn_cvt_pk_fp8_f32(f8clamp(c), f8clamp(d), p, true); return p; }
constexpr float F8_WSC = 64.f, F8_HSC = 8.f, F8_ASC = 16.f;
struct EpiSwiGLU {
    static constexpr bool PERM = true, AFTER_DRAIN = false;
    unsigned char* act; int nN;
    DI void operator()(const pg8::f32x4 (&acc)[2][2][4][2], const pg8::Unit& u, int wr, int wc, int fr, int fq) const {
        const int lpn = u.pn % nN; const int row0 = u.pm * 256 + wr * 64 + fr, col0 = lpn * 128 + wc * 32 + 8 * fq; constexpr float is = 1.f / (F8_HSC * F8_WSC);
#pragma unroll
        for (int ai = 0; ai < 2; ++ai)
#pragma unroll
            for (int m = 0; m < 4; ++m) { unsigned char* p = act + (size_t)(row0 + ai * 128 + m * 16) * FF + col0;
                const pg8::f32x4 a0 = acc[ai][0][m][0] * is, a1 = acc[ai][0][m][1] * is, g0 = acc[ai][1][m][0] * (is * F8_ASC), g1 = acc[ai][1][m][1] * (is * F8_ASC);
                uint2 w; w.x = pk4_fp8(silu_f(a0[0]) * g0[0], silu_f(a0[1]) * g0[1], silu_f(a0[2]) * g0[2], silu_f(a0[3]) * g0[3]);
                w.y = pk4_fp8(silu_f(a1[0]) * g1[0], silu_f(a1[1]) * g1[1], silu_f(a1[2]) * g1[2], silu_f(a1[3]) * g1[3]);
                *(uint2*)p = w; }
    }
};
struct EpiGate {
    static constexpr bool PERM = true, AFTER_DRAIN = false;
    bf16* ys; const float* gate;
    DI void operator()(const pg8::f32x4 (&acc)[2][2][4][2], const pg8::Unit& u, int wr, int wc, int fr, int fq) const {
        const int row0 = u.pm * 256 + wr * 64 + fr, col0 = (u.pn & 3) * 256 + wc * 32 + 8 * fq;
#pragma unroll
        for (int ai = 0; ai < 2; ++ai)
#pragma unroll
            for (int m = 0; m < 4; ++m) { const int row = row0 + ai * 128 + m * 16; const float g = gate[row] * (1.f / (F8_ASC * F8_WSC)); bf16* p = ys + (size_t)row * DM + col0;
#pragma unroll
                for (int bj = 0; bj < 2; ++bj) { const pg8::f32x4 v0 = acc[ai][bj][m][0] * g, v1 = acc[ai][bj][m][1] * g; pg8::u32x4 w;
                    w.x = pg8::cvt_pk_bf16(v0[0], v0[1]); w.y = pg8::cvt_pk_bf16(v0[2], v0[3]); w.z = pg8::cvt_pk_bf16(v1[0], v1[1]); w.w = pg8::cvt_pk_bf16(v1[2], v1[3]);
                    *(pg8::u32x4*)(p + bj * 128) = w; } }
    }
};

DI void cvt_tile(const float* W, int N, int nvalid, int k0, int n0, bf16* dst, int Kd, size_t drow0, LAS float* scr, int lane) {
    const int c4 = (lane & 15) * 4, kr = lane >> 4;
#pragma unroll
    for (int it = 0; it < 16; ++it) { const int k = it * 4 + kr; float4 v = make_float4(0.f, 0.f, 0.f, 0.f);
        if (n0 + c4 < nvalid) v = *(const float4*)(W + (size_t)(k0 + k) * N + n0 + c4);
        LAS float* s = scr + k * 65 + c4; s[0] = v.x; s[1] = v.y; s[2] = v.z; s[3] = v.w; }
    LDS_WAIT(); asm volatile("" ::: "memory");
    const int c = lane & 7;
#pragma unroll
    for (int it = 0; it < 8; ++it) { const int n = it * 8 + (lane >> 3); const LAS float* s = scr + (8 * c) * 65 + n;
        uint4 o; o.x = pk2(s[0], s[65]); o.y = pk2(s[130], s[195]); o.z = pk2(s[260], s[325]); o.w = pk2(s[390], s[455]);
        *(uint4*)(dst + (drow0 + n) * (size_t)Kd + k0 + 8 * c) = o; }
    LDS_WAIT(); asm volatile("" ::: "memory");
}
DI void cvt_tile_fp8(const float* W, int N, int k0, int n0, unsigned char* dst, int Kd, size_t drow0, float sc, LAS float* scr, int lane) {
    const int c4 = (lane & 15) * 4, kr = lane >> 4;
#pragma unroll
    for (int it = 0; it < 16; ++it) { const int k = it * 4 + kr; const f32x4 v = __builtin_nontemporal_load((const f32x4*)(W + (size_t)(k0 + k) * N + n0 + c4));
        LAS float* s = scr + k * 65 + c4; s[0] = v.x * sc; s[1] = v.y * sc; s[2] = v.z * sc; s[3] = v.w * sc; }
    LDS_WAIT(); asm volatile("" ::: "memory");
    const int c = lane & 3;
#pragma unroll
    for (int it = 0; it < 4; ++it) { const int n = it * 16 + (lane >> 2); const LAS float* s = scr + (16 * c) * 65 + n;
        uint4 o; o.x = pk4_fp8(s[0], s[65], s[130], s[195]); o.y = pk4_fp8(s[260], s[325], s[390], s[455]); o.z = pk4_fp8(s[520], s[585], s[650], s[715]); o.w = pk4_fp8(s[780], s[845], s[910], s[975]);
        *(uint4*)(dst + (drow0 + n) * (size_t)Kd + k0 + 16 * c) = o; }
    LDS_WAIT(); asm volatile("" ::: "memory");
}
DI void phase_p0(const Args& A, LAS unsigned char* lds, int it0, int it1, int gw, int ngw, int wave, int lane) {
    LAS float* scr = (LAS float*)(lds + wave * 16640);
    bf16* wtin = (bf16*)(A.ws + WS_WTIN); bf16* wtout = (bf16*)(A.ws + WS_WTOUT); unsigned char* w13 = A.ws + WS_W13T; unsigned char* w2t = A.ws + WS_W2T;
    constexpr int I_IN = NL * 16 * 64, I_OUT = NL * 16 * 16, I_E = 16 * 44, I_MOE = NL * NE * 3 * I_E;
    for (int it = it0 + gw; it < it1; it += ngw) {
        int r = it;
        if (r < I_IN) { const int l = r / 1024, t = r % 1024, kb = t / 64, nb = t % 64;
            cvt_tile(A.in[I_WIN] + (size_t)l * DM * INW, INW, INW, kb * 64, nb * 64, wtin + (size_t)l * ZLD * DM, DM, (size_t)nb * 64, scr, lane); continue; }
        r -= I_IN;
        if (r < I_OUT) { const int l = r / 256, t = r % 256, kb = t / 16, nb = t % 16;
            cvt_tile(A.in[I_WOUT] + (size_t)l * DM * DM, DM, DM, kb * 64, nb * 64, wtout + (size_t)l * DM * DM, DM, (size_t)nb * 64, scr, lane); continue; }
        r -= I_OUT;
        const int le = r / (3 * I_E), q = r % (3 * I_E), which = q / I_E, t = q % I_E;
        if (which < 2) { const int kb = t / 44, nb = t % 44, n0 = nb * 64;
            cvt_tile_fp8(A.in[which == 0 ? I_EW1 : I_EW3] + (size_t)le * DM * FF, FF, kb * 64, n0, w13 + (size_t)le * 5632 * DM, DM, (size_t)((n0 >> 7) * 256 + which * 128 + (n0 & 127)), F8_WSC, scr, lane); }
        else { const int kb = t / 16, nb = t % 16;
            cvt_tile_fp8(A.in[I_EW2] + (size_t)le * FF * DM, DM, kb * 64, nb * 64, w2t + (size_t)le * DM * FF, FF, (size_t)nb * 64, F8_WSC, scr, lane); }
    }
    if (it0 == 0) { bf16* g2t = (bf16*)(A.ws + WS_G2T);
        for (int idx = gw * 64 + lane; idx < NL * 128 * RW; idx += ngw * 64) { const int col = idx % RW, j = (idx / RW) % 128, l = idx / (128 * RW); g2t[((size_t)l * RW + col) * 128 + j] = (bf16)f2bf(A.in[I_G2][idx]); } }
}

DI void load_row(const float* xrow, int lane, f32x4 (&v)[4]) {
    const f32x4* xr = (const f32x4*)xrow + lane;
#pragma unroll
    for (int j = 0; j < 4; ++j) v[j] = xr[64 * j];
}
DI void add_slots(const Args& A, int tok, int lane, f32x4 (&v)[4]) {
    const int* sel = (const int*)(A.ws + WS_SEL); const bf16* ys = (const bf16*)(A.ws + WS_YS);
    const int b = tok / SEQ; const int mys = (lane < NE) ? sel[(size_t)tok * NE + lane] : -1;
    for (int e = 0; e < NE; ++e) { const int r = __shfl(mys, e);
        if (r >= 0) { const uint2* p = (const uint2*)(ys + (size_t)((e * NB + b) * CAP + r) * DM) + lane;
#pragma unroll
            for (int j = 0; j < 4; ++j) { const uint2 w = p[64 * j]; v[j][0] += __uint_as_float(w.x << 16); v[j][1] += __uint_as_float(w.x & 0xffff0000u); v[j][2] += __uint_as_float(w.y << 16); v[j][3] += __uint_as_float(w.y & 0xffff0000u); } } }
}
DI float row_rstd(const f32x4 (&v)[4]) {
    float s = 0.f;
#pragma unroll
    for (int j = 0; j < 4; ++j) s += (v[j][0] * v[j][0] + v[j][1] * v[j][1]) + (v[j][2] * v[j][2] + v[j][3] * v[j][3]);
    return rsqrtf(wave_sum(s) * (1.f / DM) + RMS_EPS);
}
DI unsigned pkbf(float lo, float hi) { typedef __bf16 b2 __attribute__((ext_vector_type(2))); typedef float f2 __attribute__((ext_vector_type(2))); const f2 v = {lo, hi}; return __builtin_bit_cast(unsigned, __builtin_convertvector(v, b2)); }
DI void phase_ln1(const Args& A, int l, int gw, int ngw, int lane) {
    const float* xin = (l == 0) ? A.in[I_X] : (const float*)(A.ws + WS_X1); float* x2 = (float*)(A.ws + WS_X2); bf16* hb = (bf16*)(A.ws + WS_HB);
    f32x4 gg[4];
#pragma unroll
    for (int j = 0; j < 4; ++j) gg[j] = ((const f32x4*)(A.in[I_LN1G] + (size_t)l * DM) + lane)[64 * j];
    for (int tok = gw; tok < NT; tok += 2 * ngw) {
        const int tokb = tok + ngw; const bool hb2 = tokb < NT;
        f32x4 va[4], vb[4]; load_row(xin + (size_t)tok * DM, lane, va); load_row(xin + (size_t)(hb2 ? tokb : tok) * DM, lane, vb);
        if (l > 0) { add_slots(A, tok, lane, va); add_slots(A, hb2 ? tokb : tok, lane, vb);
            f32x4* oa = (f32x4*)(x2 + (size_t)tok * DM) + lane; f32x4* ob = (f32x4*)(x2 + (size_t)tokb * DM) + lane;
#pragma unroll
            for (int j = 0; j < 4; ++j) { oa[64 * j] = va[j]; if (hb2) ob[64 * j] = vb[j]; } }
        const float ra = row_rstd(va), rb = row_rstd(vb); uint2* o8a = (uint2*)(hb + (size_t)tok * DM) + lane; uint2* o8b = (uint2*)(hb + (size_t)tokb * DM) + lane;
#pragma unroll
        for (int j = 0; j < 4; ++j) { uint2 w; w.x = pkbf(va[j][0] * ra * gg[j][0], va[j][1] * ra * gg[j][1]); w.y = pkbf(va[j][2] * ra * gg[j][2], va[j][3] * ra * gg[j][3]); o8a[64 * j] = w;
            if (hb2) { uint2 u; u.x = pkbf(vb[j][0] * rb * gg[j][0], vb[j][1] * rb * gg[j][1]); u.y = pkbf(vb[j][2] * rb * gg[j][2], vb[j][3] * rb * gg[j][3]); o8b[64 * j] = u; } }
    }
}
DI void phase_final(const Args& A, int gw, int ngw, int lane) {
    const float* xin = (const float*)(A.ws + WS_X1);
    f32x4 gg[4];
#pragma unroll
    for (int j = 0; j < 4; ++j) gg[j] = ((const f32x4*)A.in[I_FG] + lane)[64 * j];
    for (int tok = gw; tok < NT; tok += 2 * ngw) {
        const int tokb = tok + ngw; const bool hb2 = tokb < NT;
        f32x4 va[4], vb[4]; load_row(xin + (size_t)tok * DM, lane, va); load_row(xin + (size_t)(hb2 ? tokb : tok) * DM, lane, vb);
        add_slots(A, tok, lane, va); add_slots(A, hb2 ? tokb : tok, lane, vb);
        const float ra = row_rstd(va), rb = row_rstd(vb); f32x4* oa = (f32x4*)(A.out + (size_t)tok * DM) + lane; f32x4* ob = (f32x4*)(A.out + (size_t)tokb * DM) + lane;
#pragma unroll
        for (int j = 0; j < 4; ++j) { oa[64 * j] = va[j] * ra * gg[j]; if (hb2) ob[64 * j] = vb[j] * rb * gg[j]; }
    }
}
DI void ln2_row(const f32x4 (&v)[4], const f32x4 (&gg)[4], const LAS float* rt, unsigned char* hrow, float* affrow, int lane) {
    const float rs = row_rstd(v); unsigned* o8 = (unsigned*)hrow + lane;
    float lg[NE];
#pragma unroll
    for (int e = 0; e < NE; ++e) lg[e] = 0.f;
#pragma unroll
    for (int j = 0; j < 4; ++j) { f32x4 h; h[0] = v[j][0] * rs * gg[j][0]; h[1] = v[j][1] * rs * gg[j][1]; h[2] = v[j][2] * rs * gg[j][2]; h[3] = v[j][3] * rs * gg[j][3];
        o8[64 * j] = pk4_fp8(h[0] * F8_HSC, h[1] * F8_HSC, h[2] * F8_HSC, h[3] * F8_HSC);
#pragma unroll
        for (int e = 0; e < NE; ++e) { const f32x4 rr = *(const LAS f32x4*)(rt + e * DM + 256 * j + 4 * lane); lg[e] += (h[0] * rr[0] + h[1] * rr[1]) + (h[2] * rr[2] + h[3] * rr[3]); }
        asm volatile("" ::: "memory"); }
    float mx = -3.0e38f;
#pragma unroll
    for (int e = 0; e < NE; ++e) { lg[e] = wave_sum(lg[e]); mx = fmaxf(mx, lg[e]); }
    float sum = 0.f;
#pragma unroll
    for (int e = 0; e < NE; ++e) { lg[e] = expf(lg[e] - mx); sum += lg[e]; }
    const float inv = 1.f / sum;
#pragma unroll
    for (int e = 0; e < NE; ++e) if (lane == e) affrow[(size_t)e * SEQ] = lg[e] * inv;
}
DI void phase_ln2(const Args& A, int l, LAS unsigned char* lds, int gw, int ngw, int tid, int lane) {
    const float* xin = (const float*)(A.ws + WS_X1); unsigned char* hb = A.ws + WS_HB; float* aff = (float*)(A.ws + WS_AFF);
    const float* router = A.in[I_ROUTER] + (size_t)l * DM * NE; LAS float* rt = (LAS float*)lds;
    __syncthreads();
    for (int i = tid; i < DM * NE; i += NTHR) rt[(i & 15) * DM + (i >> 4)] = router[i];
    __syncthreads();
    f32x4 gg[4];
#pragma unroll
    for (int j = 0; j < 4; ++j) gg[j] = ((const f32x4*)(A.in[I_LN2G] + (size_t)l * DM) + lane)[64 * j];
    for (int tok = gw; tok < NT; tok += 2 * ngw) {
        const int tokb = tok + ngw; const bool hb2 = tokb < NT;
        f32x4 va[4], vb[4]; load_row(xin + (size_t)tok * DM, lane, va); load_row(xin + (size_t)(hb2 ? tokb : tok) * DM, lane, vb);
        ln2_row(va, gg, rt, hb + (size_t)tok * DM, aff + (size_t)(tok / SEQ) * NE * SEQ + (tok % SEQ), lane);
        if (hb2) ln2_row(vb, gg, rt, hb + (size_t)tokb * DM, aff + (size_t)(tokb / SEQ) * NE * SEQ + (tokb % SEQ), lane);
    }
    __syncthreads();
}
DI void phase_topk(const Args& A, LAS unsigned char* lds, int bid, int G, int tid, int wave, int lane) {
    const unsigned* affk = (const unsigned*)(A.ws + WS_AFF); int* sel = (int*)(A.ws + WS_SEL); float* gate = (float*)(A.ws + WS_GATE);
    const unsigned char* hb = A.ws + WS_HB; unsigned char* xg = A.ws + WS_XG;
    LAS unsigned* hist = (LAS unsigned*)lds;
    LAS unsigned* wsum = hist + 32;
    LAS int* list = (LAS int*)(lds + 256);
    for (int u = bid; u < NB * NE * 2; u += G) {
        const int half = u & 1, e = (u >> 1) % NE, b = u / (2 * NE);
        __syncthreads();
        if (tid < 32) hist[tid] = 0u;
        const uint4 kv = *(const uint4*)(affk + (size_t)(b * NE + e) * SEQ + tid * 4);
        const unsigned key[4] = {kv.x, kv.y, kv.z, kv.w};
        __syncthreads();
        unsigned prefix = 0u, krem = CAP;
#pragma unroll 1
        for (int pass = 0; pass < 8; ++pass) { const int shift = 28 - 4 * pass; LAS unsigned* h = hist + (pass & 1) * 16;
            unsigned cnt = 0u;
#pragma unroll
            for (int i = 0; i < 4; ++i) { const bool cand = (pass == 0) || ((key[i] >> (shift + 4)) == prefix); const unsigned bin = (key[i] >> shift) & 15u;
#pragma unroll
                for (int v = 0; v < 16; ++v) { const unsigned long long m = __ballot(cand && bin == (unsigned)v); if (lane == v) cnt += (unsigned)__popcll(m); } }
            if (lane < 16 && cnt) atomicAdd((unsigned*)(h + lane), cnt);
            __syncthreads();
            unsigned acc = 0u, pick = 0u, before = 0u;
#pragma unroll
            for (int v = 15; v >= 0; --v) { const unsigned c = h[v]; if (acc < krem && acc + c >= krem) { pick = (unsigned)v; before = acc; } acc += c; }
            prefix = (prefix << 4) | pick; krem -= before;
            if (tid < 16) hist[((pass + 1) & 1) * 16 + tid] = 0u;
            __syncthreads();
        }
        const unsigned tau = prefix;
        unsigned gt[4], eq[4]; unsigned ngt = 0u, neq = 0u;
#pragma unroll
        for (int i = 0; i < 4; ++i) { gt[i] = key[i] > tau ? 1u : 0u; eq[i] = key[i] == tau ? 1u : 0u; ngt += gt[i]; neq += eq[i]; }
        unsigned sg = ngt, se = neq;
#pragma unroll
        for (int o = 1; o < 64; o <<= 1) { const unsigned tg = __shfl_up(sg, o), te = __shfl_up(se, o); if (lane >= o) { sg += tg; se += te; } }
        if (lane == 63) { wsum[wave] = sg; wsum[8 + wave] = se; }
        __syncthreads();
        unsigned offg = 0u, offe = 0u;
        for (int w = 0; w < wave; ++w) { offg += wsum[w]; offe += wsum[8 + w]; }
        unsigned eqbefore = offe + se - neq;
        unsigned gtbefore = offg + sg - ngt;
        const int slot0 = (e * NB + b) * CAP;
#pragma unroll
        for (int i = 0; i < 4; ++i) { const int s = tid * 4 + i; const bool selq = gt[i] || (eq[i] && eqbefore < krem);
            const unsigned pos = gtbefore + (eqbefore < krem ? eqbefore : krem);
            if ((s >> 10) == half) { sel[(size_t)(b * SEQ + s) * NE + e] = selq ? (int)pos : -1;
                if (selq) { gate[slot0 + pos] = __uint_as_float(key[i]); } }
            if (selq && pos < CAP) list[pos] = s;
            gtbefore += gt[i]; eqbefore += eq[i]; }
        __syncthreads();
        for (int r = wave; r < CAP; r += NWAVES) { const int s = list[r];
            if ((s >> 10) == half) { const uint4* src = (const uint4*)(hb + (size_t)(b * SEQ + s) * DM) + lane; uint4* dstp = (uint4*)(xg + (size_t)(slot0 + r) * DM) + lane; dstp[0] = src[0]; } }
    }
    __syncthreads();
}

DI int t5_bucket(int rel) {
    const int ret = rel > 0 ? 16 : 0; const int n = rel < 0 ? -rel : rel;
    if (n < 8) return ret + n;
    int large = 8 + (int)(logf((float)n / 8.0f) / 4.852030263919617f * 8.0f);
    large = large < 15 ? large : 15;
    return ret + large;
}

typedef short bf16x8_t __attribute__((ext_vector_type(8)));
typedef short bf16x4_t __attribute__((ext_vector_type(4)));
typedef unsigned u32x4_t __attribute__((ext_vector_type(4)));
typedef unsigned u32x2_t __attribute__((ext_vector_type(2)));
typedef __bf16 bf2_t __attribute__((ext_vector_type(2)));
typedef float f2_t __attribute__((ext_vector_type(2)));
DI unsigned cvtpk(float lo, float hi) { const f2_t v = {lo, hi}; return __builtin_bit_cast(unsigned, __builtin_convertvector(v, bf2_t)); }
#define MFMA16(a, b, c) __builtin_amdgcn_mfma_f32_16x16x32_bf16((a), (b), (c), 0, 0, 0)

constexpr int AT_QS = 0, AT_QLD = 72;
constexpr int AT_KS = AT_QS + 128 * AT_QLD * 2;
constexpr int AT_VT = AT_KS + 272 * AT_QLD * 2, AT_VLD = 280;
constexpr int AT_BT = AT_VT + 64 * AT_VLD * 2;
constexpr int AT_END = AT_BT + 132 * 4;
static_assert(AT_END <= MISC_OFF, "attention LDS");

DI void attn_unit(const Args& A, LAS unsigned char* lds, int unit, int tid, int wave, int lane) {
    const bf16* Z = (const bf16*)(A.ws + WS_Z); bf16* ao = (bf16*)(A.ws + WS_ATTO); float* al = (float*)(A.ws + WS_ATTL);
    const int x = unit & 15; int r0 = unit >> 4; const int hh = r0 & 3; r0 >>= 2; const int b = r0 % NB, br = r0 / NB;
    const int dil = br == 0 ? 1 : (br == 1 ? 4 : 16), lsub = SEQ / dil, nblk = lsub / 128;
    const int res = x / nblk, nbk = x % nblk, l0 = nbk * 128, wbase = l0 - 64;
    LAS bf16* Qs = (LAS bf16*)(lds + AT_QS); LAS bf16* Ks = (LAS bf16*)(lds + AT_KS); LAS bf16* Vt = (LAS bf16*)(lds + AT_VT); LAS float* btab = (LAS float*)(lds + AT_BT);
    __syncthreads();
#pragma unroll
    for (int i = 0; i < 2; ++i) { const int id = tid + 512 * i, row = id >> 3, ch = id & 7; const int tok = b * SEQ + (l0 + row) * dil + res;
        *(LAS u32x4_t*)(Qs + row * AT_QLD + ch * 8) = *(const u32x4_t*)(Z + (size_t)tok * ZLD + ZA + hh * 64 + ch * 8); }
    for (int id = tid; id < 272 * 8; id += NTHR) { const int row = id >> 3, ch = id & 7; const int pos = wbase + row; u32x4_t v = (u32x4_t){0u, 0u, 0u, 0u};
        if (row < 256 && pos >= 0 && pos < lsub) v = *(const u32x4_t*)(Z + (size_t)(b * SEQ + pos * dil + res) * ZLD + ZA + 256 + hh * 64 + ch * 8);
        *(LAS u32x4_t*)(Ks + row * AT_QLD + ch * 8) = v; }
    for (int id = tid; id < 272 * 8; id += NTHR) { const int key = id % 272, ch = id / 272; const int pos = wbase + key; u32x4_t v = (u32x4_t){0u, 0u, 0u, 0u};
        if (key < 256 && pos >= 0 && pos < lsub) v = *(const u32x4_t*)(Z + (size_t)(b * SEQ + pos * dil + res) * ZLD + ZA + 512 + hh * 64 + ch * 8);
        LAS bf16* d = Vt + (ch * 8) * AT_VLD + key;
        d[0] = (bf16)(v.x & 0xffffu); d[AT_VLD] = (bf16)(v.x >> 16); d[2 * AT_VLD] = (bf16)(v.y & 0xffffu); d[3 * AT_VLD] = (bf16)(v.y >> 16);
        d[4 * AT_VLD] = (bf16)(v.z & 0xffffu); d[5 * AT_VLD] = (bf16)(v.z >> 16); d[6 * AT_VLD] = (bf16)(v.w & 0xffffu); d[7 * AT_VLD] = (bf16)(v.w >> 16); }
    if (tid < 129) btab[tid] = A.in[I_RELB][t5_bucket((tid - 64) * dil) * 4 + hh];
    __syncthreads();
    const int fr = lane & 15, qd = lane >> 4;
    f32x4 acc[10];
    { bf16x8_t qb[2];
#pragma unroll
      for (int ks = 0; ks < 2; ++ks) qb[ks] = *(const LAS bf16x8_t*)(Qs + (16 * wave + fr) * AT_QLD + ks * 32 + 8 * qd);
#pragma unroll
      for (int j = 0; j < 10; ++j) { acc[j] = (f32x4){0.f, 0.f, 0.f, 0.f};
#pragma unroll
          for (int ks = 0; ks < 2; ++ks) { const bf16x8_t ka = *(const LAS bf16x8_t*)(Ks + (16 * (wave + j) + fr) * AT_QLD + ks * 32 + 8 * qd); acc[j] = MFMA16(ka, qb[ks], acc[j]); } } }
    const int iq = 16 * wave + fr; float mx = -1.0e30f;
#pragma unroll
    for (int j = 0; j < 10; ++j)
#pragma unroll
        for (int r = 0; r < 4; ++r) { const int kw = 16 * (wave + j) + 4 * qd + r; const int m = kw - 64 - iq; const int pos = wbase + kw;
            const bool valid = (m >= -64) && (m <= 64) && (pos >= 0) && (pos < lsub);
            const float s = valid ? acc[j][r] * 0.125f + btab[valid ? m + 64 : 0] : -1.0e30f; acc[j][r] = s; mx = fmaxf(mx, s); }
    mx = fmaxf(mx, __shfl_xor(mx, 16)); mx = fmaxf(mx, __shfl_xor(mx, 32));
    float lsum = 0.f;
#pragma unroll
    for (int j = 0; j < 10; ++j)
#pragma unroll
        for (int r = 0; r < 4; ++r) { const float p = __expf(acc[j][r] - mx); acc[j][r] = p; lsum += p; }
    lsum += __shfl_xor(lsum, 16); lsum += __shfl_xor(lsum, 32);
    f32x4 oacc[4];
#pragma unroll
    for (int d = 0; d < 4; ++d) oacc[d] = (f32x4){0.f, 0.f, 0.f, 0.f};
#pragma unroll
    for (int pp = 0; pp < 5; ++pp) {
        union { unsigned u[4]; bf16x8_t v; } pb;
        pb.u[0] = cvtpk(acc[2 * pp][0], acc[2 * pp][1]); pb.u[1] = cvtpk(acc[2 * pp][2], acc[2 * pp][3]); pb.u[2] = cvtpk(acc[2 * pp + 1][0], acc[2 * pp + 1][1]); pb.u[3] = cvtpk(acc[2 * pp + 1][2], acc[2 * pp + 1][3]);
#pragma unroll
        for (int d = 0; d < 4; ++d) { const LAS bf16* vp = Vt + (16 * d + fr) * AT_VLD + 16 * (wave + 2 * pp) + 4 * qd;
            union { bf16x4_t h[2]; bf16x8_t v; } va; va.h[0] = *(const LAS bf16x4_t*)vp; va.h[1] = *(const LAS bf16x4_t*)(vp + 16);
            oacc[d] = MFMA16(va.v, pb.v, oacc[d]); } }
    const float inv = 1.f / lsum; const int tok = b * SEQ + (l0 + iq) * dil + res;
    bf16* op = ao + ((size_t)br * NT + tok) * AW + hh * 64 + 4 * qd;
#pragma unroll
    for (int d = 0; d < 4; ++d) { uint2 w; w.x = cvtpk(oacc[d][0] * inv, oacc[d][1] * inv); w.y = cvtpk(oacc[d][2] * inv, oacc[d][3] * inv); *(uint2*)(op + 16 * d) = w; }
    if (qd == 0) al[((size_t)br * NT + tok) * 4 + hh] = mx + logf(lsum);
}
DI void phase_attn(const Args& A, LAS unsigned char* lds, int bid, int G, int tid, int wave, int lane) {
    for (int u = bid; u < 3 * NB * 4 * 16; u += G) attn_unit(A, lds, u, tid, wave, lane);
    __syncthreads();
}


constexpr int ML_QLD = 104, ML_SLD = 72;
constexpr int ML_QS = 0;
constexpr int ML_QT = ML_QS + 64 * ML_QLD * 2;
constexpr int ML_KS = ML_QT + 64 * ML_QLD * 2;
constexpr int ML_KT = ML_KS + 64 * ML_QLD * 2;
constexpr int ML_VT = ML_KT + 96 * ML_SLD * 2;
constexpr int ML_WS = ML_VT + 112 * ML_SLD * 2;
constexpr int ML_CT = ML_WS + 64 * ML_SLD * 2;
constexpr int ML_CW = ML_CT + 112 * ML_QLD * 2;
constexpr int ML_END = ML_CW + 6 * 192 * 4;
static_assert(ML_END <= MISC_OFF, "mlstm LDS");

constexpr int MLP_QF = 0, MLP_NI = 12288, MLP_U = 26624, MLP_DEC = 48128, MLP_BYTES = 48384;
constexpr size_t WS_MLPKG = WS_R + 304 * MiB;
static_assert(WS_MLPKG + (size_t)2 * NB * 4 * 32 * MLP_BYTES <= WS_RKY, "mlstm package region");

struct M1Regs { u32x4_t zc[15]; u32x2_t vv[3]; float gi, gf; };
DI void mlstm_m1_fetch(const Args& A, int item, int tid, int lane, M1Regs& R) {
    const bf16* Z = (const bf16*)(A.ws + WS_Z);
    const int c = item & 31, u = item >> 5; const int dir = u / 32, b = (u % 32) / 4, hh = u % 4; const int j = tid >> 3, sub = tid & 7;
    const int tl = dir ? SEQ - 1 - (c * 64 + lane) : c * 64 + lane; const size_t tokl = (size_t)b * SEQ + tl;
    R.gi = bf2f(Z[tokl * ZLD + ZMG + dir * 8 + hh]); R.gf = bf2f(Z[tokl * ZLD + ZMG + dir * 8 + 4 + hh]);
    const int tj = dir ? SEQ - 1 - (c * 64 + j) : c * 64 + j; const size_t tokj = (size_t)b * SEQ + tj;
    const bool isk = sub >= 4; const int zcol = ZMQK + (isk ? 384 : 0) + hh * 96 + (sub & 3) * 24;
#pragma unroll
    for (int tap = 0; tap < 5; ++tap) { const int tt = tj + tap - 2; const bool ok = tt >= 0 && tt < SEQ; const u32x4_t* zp = (const u32x4_t*)(Z + ((size_t)b * SEQ + (ok ? tt : tj)) * ZLD + zcol);
#pragma unroll
        for (int q4 = 0; q4 < 3; ++q4) { const u32x4_t w = zp[q4]; R.zc[tap * 3 + q4] = ok ? w : (u32x4_t){0u, 0u, 0u, 0u}; } }
    const u32x2_t* vp = (const u32x2_t*)(Z + tokj * ZLD + ZMV + hh * 96 + sub * 12);
#pragma unroll
    for (int q2 = 0; q2 < 3; ++q2) R.vv[q2] = vp[q2];
}
DI void mlstm_m1_item(const Args& A, int l, LAS unsigned char* lds, int item, int item_next, M1Regs& R, int& hh_staged, int tid, int wave, int lane) {
    const int c = item & 31, u = item >> 5; const int dir = u / 32, hh = u % 4;
    LAS bf16* Qs = (LAS bf16*)(lds + ML_QS); LAS bf16* Qt = (LAS bf16*)(lds + ML_QT); LAS bf16* Ks = (LAS bf16*)(lds + ML_KS); LAS bf16* KtT = (LAS bf16*)(lds + ML_KT);
    LAS bf16* VtT = (LAS bf16*)(lds + ML_VT); LAS bf16* Ws = (LAS bf16*)(lds + ML_WS); LAS float* cwl = (LAS float*)(lds + ML_CW); LAS float* cbl = cwl + 5 * 192;
    const int fr = lane & 15, qd = lane >> 4;
    unsigned char* pkg = A.ws + WS_MLPKG + (size_t)item * MLP_BYTES;
    __syncthreads();
    if (hh != hh_staged) { hh_staged = hh;
        for (int i = tid; i < 5 * 192; i += NTHR) { const int tap = i / 192, ch = i % 192; cwl[i] = A.in[I_CW][(size_t)(l * 5 + tap) * 768 + (ch < 96 ? 0 : 384) + hh * 96 + (ch % 96)]; }
        for (int i = tid; i < 192; i += NTHR) cbl[i] = A.in[I_CB][(size_t)l * 768 + (i < 96 ? 0 : 384) + hh * 96 + (i % 96)];
        for (int i = tid; i < 16 * ML_SLD; i += NTHR) VtT[96 * ML_SLD + i] = (i < ML_SLD) ? (bf16)0x3F80u : (bf16)0u;
        __syncthreads(); }
    const float ibv = A.in[I_IB][(l * 2 + dir) * 4 + hh], fbv = A.in[I_FB][(l * 2 + dir) * 4 + hh];
    const int j = tid >> 3, sub = tid & 7;
    const float gi = R.gi + ibv, gf = R.gf + fbv;
    float bsum = fminf(gf, 0.f) - __logf(1.f + __expf(-fabsf(gf)));
#pragma unroll
    for (int o = 1; o < 64; o <<= 1) { const float t = __shfl_up(bsum, o); if (lane >= o) bsum += t; }
    const float bend = __shfl(bsum, 63);
    const float bj = __shfl(bsum, j), igj = __shfl(gi, j);
    { const bool isk = sub >= 4; const int c0 = (sub & 3) * 24, cl = (isk ? 96 : 0) + c0;
      float acc[24];
#pragma unroll
      for (int e = 0; e < 24; ++e) acc[e] = cbl[cl + e];
#pragma unroll
      for (int tap = 0; tap < 5; ++tap) {
#pragma unroll
          for (int q4 = 0; q4 < 3; ++q4) { const u32x4_t w = R.zc[tap * 3 + q4]; const LAS float* cwp = cwl + tap * 192 + cl + q4 * 8;
              acc[q4 * 8 + 0] += cwp[0] * __uint_as_float(w.x << 16); acc[q4 * 8 + 1] += cwp[1] * __uint_as_float(w.x & 0xffff0000u);
              acc[q4 * 8 + 2] += cwp[2] * __uint_as_float(w.y << 16); acc[q4 * 8 + 3] += cwp[3] * __uint_as_float(w.y & 0xffff0000u);
              acc[q4 * 8 + 4] += cwp[4] * __uint_as_float(w.z << 16); acc[q4 * 8 + 5] += cwp[5] * __uint_as_float(w.z & 0xffff0000u);
              acc[q4 * 8 + 6] += cwp[6] * __uint_as_float(w.w << 16); acc[q4 * 8 + 7] += cwp[7] * __uint_as_float(w.w & 0xffff0000u); } }
      const float sc1 = isk ? 0.10206207261596575f : 1.f; const float sc2 = isk ? __expf(bend - bj + igj) : __expf(bj);
#pragma unroll
      for (int e = 0; e < 24; ++e) acc[e] = acc[e] * sigm(acc[e]) * sc1;
      if (!isk) { LAS bf16* d1 = Qs + j * ML_QLD + c0; LAS bf16* d2 = Qt + j * ML_QLD + c0;
#pragma unroll
          for (int q4 = 0; q4 < 3; ++q4) { u32x4_t w; w.x = cvtpk(acc[q4 * 8 + 0], acc[q4 * 8 + 1]); w.y = cvtpk(acc[q4 * 8 + 2], acc[q4 * 8 + 3]); w.z = cvtpk(acc[q4 * 8 + 4], acc[q4 * 8 + 5]); w.w = cvtpk(acc[q4 * 8 + 6], acc[q4 * 8 + 7]);
              *(LAS u32x4_t*)(d1 + q4 * 8) = w;
              u32x4_t x; x.x = cvtpk(acc[q4 * 8 + 0] * sc2, acc[q4 * 8 + 1] * sc2); x.y = cvtpk(acc[q4 * 8 + 2] * sc2, acc[q4 * 8 + 3] * sc2); x.z = cvtpk(acc[q4 * 8 + 4] * sc2, acc[q4 * 8 + 5] * sc2); x.w = cvtpk(acc[q4 * 8 + 6] * sc2, acc[q4 * 8 + 7] * sc2);
              *(LAS u32x4_t*)(d2 + q4 * 8) = x; } }
      else { LAS bf16* d1 = Ks + j * ML_QLD + c0;
#pragma unroll
          for (int q4 = 0; q4 < 3; ++q4) { u32x4_t w; w.x = cvtpk(acc[q4 * 8 + 0], acc[q4 * 8 + 1]); w.y = cvtpk(acc[q4 * 8 + 2], acc[q4 * 8 + 3]); w.z = cvtpk(acc[q4 * 8 + 4], acc[q4 * 8 + 5]); w.w = cvtpk(acc[q4 * 8 + 6], acc[q4 * 8 + 7]);
              *(LAS u32x4_t*)(d1 + q4 * 8) = w; }
#pragma unroll
          for (int e = 0; e < 24; ++e) KtT[(c0 + e) * ML_SLD + j] = (bf16)f2bf(acc[e] * sc2); } }
    { const int n0 = sub * 12;
#pragma unroll
      for (int q2 = 0; q2 < 3; ++q2) { const u32x2_t w = R.vv[q2]; LAS bf16* d = VtT + (n0 + q2 * 4) * ML_SLD + j;
          d[0] = (bf16)(w.x & 0xffffu); d[ML_SLD] = (bf16)(w.x >> 16); d[2 * ML_SLD] = (bf16)(w.y & 0xffffu); d[3 * ML_SLD] = (bf16)(w.y >> 16); } }
    if (item_next >= 0) mlstm_m1_fetch(A, item_next, tid, lane, R);
    __syncthreads();
#pragma unroll
    for (int i = 0; i < 2; ++i) { const int tile = 2 * wave + i, jt = tile >> 2, st = tile & 3; const int jq = 16 * jt + fr;
        u32x2_t w = (u32x2_t){0u, 0u};
        if (st <= jt) { f32x4 acc = (f32x4){0.f, 0.f, 0.f, 0.f};
#pragma unroll
            for (int ks = 0; ks < 3; ++ks) { const bf16x8_t a = *(const LAS bf16x8_t*)(Ks + (16 * st + fr) * ML_QLD + 32 * ks + 8 * qd); const bf16x8_t bq = *(const LAS bf16x8_t*)(Qs + jq * ML_QLD + 32 * ks + 8 * qd); acc = MFMA16(a, bq, acc); }
            const float bjq = __shfl(bsum, jq); float wv[4];
#pragma unroll
            for (int r = 0; r < 4; ++r) { const int s = 16 * st + 4 * qd + r; const float bs = __shfl(bsum, s), igs = __shfl(gi, s); wv[r] = (s <= jq) ? acc[r] * __expf(bjq - bs + igs) : 0.f; }
            w.x = cvtpk(wv[0], wv[1]); w.y = cvtpk(wv[2], wv[3]); }
        *(LAS u32x2_t*)(Ws + jq * ML_SLD + 16 * st + 4 * qd) = w; }
    __syncthreads();
    for (int id = wave; id < 12; id += NWAVES) { const int jt = id / 3, i3 = id % 3; const LAS bf16* p = Qt + (16 * jt + fr) * ML_QLD + 32 * i3 + 4 * qd; const u32x2_t lo = *(const LAS u32x2_t*)p, hi = *(const LAS u32x2_t*)(p + 16);
        *(u32x4_t*)(pkg + MLP_QF + (size_t)id * 1024 + lane * 16) = (u32x4_t){lo.x, lo.y, hi.x, hi.y}; }
    for (int id = wave; id < 70; id += NWAVES) { f32x4 acc = (f32x4){0.f, 0.f, 0.f, 0.f}; int nt; const LAS bf16* ap; int ald; unsigned char* dst;
        if (id < 28) { const int jt = id & 3; nt = id >> 2; ap = Ws + (16 * jt + fr) * ML_SLD; ald = 0; dst = pkg + MLP_NI + (size_t)(nt * 4 + jt) * 512; }
        else { const int q = id - 28, kt = q % 6; nt = q / 6; ap = KtT + (16 * kt + fr) * ML_SLD; ald = 0; dst = pkg + MLP_U + (size_t)(nt * 6 + kt) * 512; }
#pragma unroll
        for (int ks = 0; ks < 2; ++ks) { const bf16x8_t a = *(const LAS bf16x8_t*)(ap + 32 * ks + 8 * qd); const bf16x8_t bv = *(const LAS bf16x8_t*)(VtT + (16 * nt + fr) * ML_SLD + 32 * ks + 8 * qd); acc = MFMA16(a, bv, acc); }
        u32x2_t w; w.x = cvtpk(acc[0], acc[1]); w.y = cvtpk(acc[2], acc[3]); *(u32x2_t*)(dst + lane * 8) = w; }
    if (tid < 64) ((float*)(pkg + MLP_DEC))[tid] = __expf(bend);
}
DI void phase_mlstm_m1(const Args& A, int l, LAS unsigned char* lds, int bid, int G, int tid, int wave, int lane) {
    int hh_staged = -1; constexpr int NIT = 2 * NB * 4 * 32;
    if (bid < NIT) { M1Regs R; mlstm_m1_fetch(A, bid, tid, lane, R);
        for (int it = bid; it < NIT; it += G) mlstm_m1_item(A, l, lds, it, (it + G < NIT) ? it + G : -1, R, hh_staged, tid, wave, lane); }
    __syncthreads();
}
DI void m2_load_q(bf16x8_t (&qf)[12], const unsigned char* pkg, int lane) {
#pragma unroll
    for (int i = 0; i < 12; ++i) qf[i] = *(const bf16x8_t*)(pkg + MLP_QF + i * 1024 + lane * 16);
}
DI f32x4 unpk4(const u32x2_t w) { return (f32x4){__uint_as_float(w.x << 16), __uint_as_float(w.x & 0xffff0000u), __uint_as_float(w.y << 16), __uint_as_float(w.y & 0xffff0000u)}; }
DI void m2_step(const bf16x8_t (&qf)[12], u32x2_t (&ni)[4], u32x2_t (&uu)[6], float& dec, const unsigned char* pkg_next, f32x4 (&C)[6], bf16* num, float* den, int dir, int b, int hh, int nt, int c, int lane, int fr, int qd) {
    union { unsigned u[4]; bf16x8_t v; } sB[3];
#pragma unroll
    for (int i = 0; i < 3; ++i) { sB[i].u[0] = cvtpk(C[2 * i][0], C[2 * i][1]); sB[i].u[1] = cvtpk(C[2 * i][2], C[2 * i][3]); sB[i].u[2] = cvtpk(C[2 * i + 1][0], C[2 * i + 1][1]); sB[i].u[3] = cvtpk(C[2 * i + 1][2], C[2 * i + 1][3]); }
#pragma unroll
    for (int jt = 0; jt < 4; ++jt) { f32x4 acc = unpk4(ni[jt]);
        if (pkg_next) ni[jt] = *(const u32x2_t*)(pkg_next + MLP_NI + (nt * 4 + jt) * 512 + lane * 8);
#pragma unroll
        for (int i = 0; i < 3; ++i) acc = MFMA16(qf[3 * jt + i], sB[i].v, acc);
#pragma unroll
        for (int r = 0; r < 4; ++r) { const int jj = 16 * jt + 4 * qd + r; const int tt = dir ? SEQ - 1 - (c * 64 + jj) : c * 64 + jj; const size_t tok = (size_t)b * SEQ + tt;
            if (nt < 6) num[((size_t)dir * NT + tok) * MW + hh * 96 + 16 * nt + fr] = (bf16)f2bf(acc[r]); else if (fr == 0) den[((size_t)dir * NT + tok) * 4 + hh] = acc[r]; } }
    const float d = dec; if (pkg_next) dec = ((const float*)(pkg_next + MLP_DEC))[lane];
#pragma unroll
    for (int kt = 0; kt < 6; ++kt) { C[kt] = C[kt] * d + unpk4(uu[kt]); if (pkg_next) uu[kt] = *(const u32x2_t*)(pkg_next + MLP_U + (nt * 6 + kt) * 512 + lane * 8); }
}
DI void mlstm_m2_wave(const Args& A, int u, int nt, int lane) {
    bf16* num = (bf16*)(A.ws + WS_MLNUM); float* den = (float*)(A.ws + WS_MLDEN);
    const int dir = u / 32, b = (u % 32) / 4, hh = u % 4; const int fr = lane & 15, qd = lane >> 4;
    const unsigned char* pkg0 = A.ws + WS_MLPKG + (size_t)u * 32 * MLP_BYTES;
    f32x4 C[6];
#pragma unroll
    for (int kt = 0; kt < 6; ++kt) C[kt] = (f32x4){0.f, 0.f, 0.f, 0.f};
    bf16x8_t qa[12], qb[12]; u32x2_t ni[4], uu[6]; float dec;
    m2_load_q(qa, pkg0, lane);
#pragma unroll
    for (int jt = 0; jt < 4; ++jt) ni[jt] = *(const u32x2_t*)(pkg0 + MLP_NI + (nt * 4 + jt) * 512 + lane * 8);
#pragma unroll
    for (int kt = 0; kt < 6; ++kt) uu[kt] = *(const u32x2_t*)(pkg0 + MLP_U + (nt * 6 + kt) * 512 + lane * 8);
    dec = ((const float*)(pkg0 + MLP_DEC))[lane];
    for (int c = 0; c < 32; c += 2) {
        m2_load_q(qb, pkg0 + (size_t)(c + 1) * MLP_BYTES, lane);
        m2_step(qa, ni, uu, dec, pkg0 + (size_t)(c + 1) * MLP_BYTES, C, num, den, dir, b, hh, nt, c, lane, fr, qd);
        if (c + 2 < 32) m2_load_q(qa, pkg0 + (size_t)(c + 2) * MLP_BYTES, lane);
        m2_step(qb, ni, uu, dec, (c + 2 < 32) ? pkg0 + (size_t)(c + 2) * MLP_BYTES : nullptr, C, num, den, dir, b, hh, nt, c + 1, lane, fr, qd);
    }
}

DI bf16x8_t widen4(const bf16x4_t a) { return __builtin_shufflevector(a, (bf16x4_t){0, 0, 0, 0}, 0, 1, 2, 3, 4, 5, 6, 7); }
constexpr int PKG_BYTES = 12544;
constexpr int PK_AH = 0, PK_RH = 2048, PK_BT = 4096, PK_KT = 6144, PK_VV = 8192, PK_TM = 10240, PK_MRB = 10752, PK_LAK = 11264, PK_MRK = 11776, PK_GE = 12288;
constexpr size_t WS_PKG = WS_PR;
static_assert((size_t)2 * NB * 6 * 128 * PKG_BYTES <= 288 * MiB, "package region");
constexpr int R1_W2T = 0, R1_A2T = 9216, R1_WV = 18432, R1_WV_BYTES = 12928;
constexpr int R1_IMG = 0, R1_LF = 9216, R1_MT = 10368;
static_assert(R1_WV + 8 * R1_WV_BYTES <= MISC_OFF, "rwkv r1 LDS");

DI bf16x4_t pack4(const f32x4 v) { union { unsigned u[2]; bf16x4_t h; } x; x.u[0] = cvtpk(v[0], v[1]); x.u[1] = cvtpk(v[2], v[3]); return x.h; }

DI void rwkv_r1_item(const Args& A, int l, LAS unsigned char* lds, int item, int& dh_staged, int tid, int wave, int lane) {
    const bf16* Z = (const bf16*)(A.ws + WS_Z);
    const int g = item & 15; int r0 = item >> 4; const int hh = r0 % 6; r0 /= 6; const int b = r0 % NB, dir = r0 / NB;
    const int cc = 8 * g + wave, fr = lane & 15, qd = lane >> 4;
    LAS bf16* W2T = (LAS bf16*)(lds + R1_W2T); LAS bf16* A2T = (LAS bf16*)(lds + R1_A2T);
    LAS unsigned char* wv = lds + R1_WV + wave * R1_WV_BYTES;
    LAS bf16* IMG = (LAS bf16*)(wv + R1_IMG); LAS float* Lf = (LAS float*)(wv + R1_LF); LAS bf16* MT = (LAS bf16*)(wv + R1_MT);
    if (dh_staged != dir * 6 + hh) { dh_staged = dir * 6 + hh;
    __syncthreads();
    { const int ch = tid & 63, i0 = (tid >> 6) * 8; const float* w2 = A.in[I_W2] + ((size_t)(l * 2 + dir) * 64 + i0) * RW + hh * 64 + ch; const float* a2 = A.in[I_A2] + ((size_t)(l * 2 + dir) * 64 + i0) * RW + hh * 64 + ch;
      u32x4_t pw, pa; pw.x = cvtpk(w2[0], w2[RW]); pw.y = cvtpk(w2[2 * RW], w2[3 * RW]); pw.z = cvtpk(w2[4 * RW], w2[5 * RW]); pw.w = cvtpk(w2[6 * RW], w2[7 * RW]);
      pa.x = cvtpk(a2[0], a2[RW]); pa.y = cvtpk(a2[2 * RW], a2[3 * RW]); pa.z = cvtpk(a2[4 * RW], a2[5 * RW]); pa.w = cvtpk(a2[6 * RW], a2[7 * RW]);
      *(LAS u32x4_t*)(W2T + ch * 72 + i0) = pw; *(LAS u32x4_t*)(A2T + ch * 72 + i0) = pa; }
    __syncthreads(); }
    const int sgn = dir ? -1 : 1; const int tok0 = b * SEQ + (dir ? SEQ - 1 - 16 * cc : 16 * cc);
    const float* mu = A.in[I_MU] + (size_t)(l * 2 + dir) * 1280;
    float er[4][4], ek[4][4], ev[4][4];
#pragma unroll
    for (int nt = 0; nt < 4; ++nt) {
#pragma unroll
        for (int r = 0; r < 4; ++r) { const bf16* zp = Z + (size_t)(tok0 + sgn * (4 * qd + r)) * ZLD + ZRKV + hh * 64 + 16 * nt + fr; er[nt][r] = bf2f(zp[0]); ek[nt][r] = bf2f(zp[RW]); ev[nt][r] = bf2f(zp[2 * RW]); }
        float pr = __shfl(er[nt][3], lane - 16), pk = __shfl(ek[nt][3], lane - 16), pv = __shfl(ev[nt][3], lane - 16);
        if (qd == 0) { pr = 0.f; pk = 0.f; pv = 0.f; if (cc > 0) { const bf16* zp = Z + (size_t)(tok0 - sgn) * ZLD + ZRKV + hh * 64 + 16 * nt + fr; pr = bf2f(zp[0]); pk = bf2f(zp[RW]); pv = bf2f(zp[2 * RW]); } }
        const float mr = mu[hh * 64 + 16 * nt + fr], mk = mu[RW + hh * 64 + 16 * nt + fr], mv = mu[2 * RW + hh * 64 + 16 * nt + fr];
#pragma unroll
        for (int r = 3; r >= 0; --r) { const float qr = r ? er[nt][r - 1] : pr, qk = r ? ek[nt][r - 1] : pk, qv = r ? ev[nt][r - 1] : pv;
            er[nt][r] += mr * (qr - er[nt][r]); ek[nt][r] += mk * (qk - ek[nt][r]); ev[nt][r] += mv * (qv - ev[nt][r]); }
    }
    bf16x8_t thA[2], adA[2];
    { const int zwd = dir ? ZWDB : ZWDF, zad = dir ? ZADB : ZADF; const bool hasp = !(cc == 0 && fr == 0);
      const bf16* zc = Z + (size_t)(tok0 + sgn * fr) * ZLD; const bf16* zq = Z + (size_t)(tok0 + sgn * (fr - 1)) * ZLD;
#pragma unroll
      for (int ks = 0; ks < 2; ++ks) { float cw[8], pw[8], ca[8], pa[8];
          unpack8(*(const uint4*)(zc + zwd + 32 * ks + 8 * qd), cw); unpack8(*(const uint4*)(zc + zad + 32 * ks + 8 * qd), ca);
          if (hasp) { unpack8(*(const uint4*)(zq + zwd + 32 * ks + 8 * qd), pw); unpack8(*(const uint4*)(zq + zad + 32 * ks + 8 * qd), pa); }
          else {
#pragma unroll
              for (int e = 0; e < 8; ++e) { pw[e] = 0.f; pa[e] = 0.f; } }
          const float* muw = mu + 1152 + 32 * ks + 8 * qd; const float* mua = mu + 1216 + 32 * ks + 8 * qd;
#pragma unroll
          for (int e = 0; e < 8; ++e) { const float xw = cw[e] + muw[e] * (pw[e] - cw[e]); cw[e] = 1.f - 2.f * __builtin_amdgcn_rcpf(1.f + __expf(2.f * xw)); ca[e] = ca[e] + mua[e] * (pa[e] - ca[e]); }
          union { unsigned u[4]; bf16x8_t v; } x, y;
#pragma unroll
          for (int e = 0; e < 4; ++e) { x.u[e] = cvtpk(cw[2 * e], cw[2 * e + 1]); y.u[e] = cvtpk(ca[2 * e], ca[2 * e + 1]); }
          thA[ks] = x.v; adA[ks] = y.v; } }
    f32x4 wl[4], al[4];
#pragma unroll
    for (int nt = 0; nt < 4; ++nt) { wl[nt] = (f32x4){0.f, 0.f, 0.f, 0.f}; al[nt] = (f32x4){0.f, 0.f, 0.f, 0.f};
#pragma unroll
        for (int ks = 0; ks < 2; ++ks) { const bf16x8_t bw = *(const LAS bf16x8_t*)(W2T + (16 * nt + fr) * 72 + 32 * ks + 8 * qd); const bf16x8_t ba = *(const LAS bf16x8_t*)(A2T + (16 * nt + fr) * 72 + 32 * ks + 8 * qd);
            wl[nt] = MFMA16(thA[ks], bw, wl[nt]); al[nt] = MFMA16(adA[ks], ba, al[nt]); } }
    float lw[4][4], alp[4][4], kap[4][4]; float ssq[4] = {0.f, 0.f, 0.f, 0.f}, bsm[4] = {0.f, 0.f, 0.f, 0.f};
#pragma unroll
    for (int nt = 0; nt < 4; ++nt) { const int ch = hh * 64 + 16 * nt + fr;
        const float w0v = A.in[I_W0][(size_t)(l * 2 + dir) * RW + ch], a0v = A.in[I_A0][(size_t)(l * 2 + dir) * RW + ch], kkw = A.in[I_KK][(size_t)l * RW + ch], kaw = A.in[I_KA][(size_t)l * RW + ch], rkw = A.in[I_RK][(size_t)l * RW + ch];
#pragma unroll
        for (int r = 0; r < 4; ++r) { const float x = w0v + wl[nt][r]; const float nx = -x; const float sp = fmaxf(nx, 0.f) + __logf(1.f + __expf(-fabsf(nx)));
            lw[nt][r] = -__expf(-sp - 0.5f);
            const float a = __builtin_amdgcn_rcpf(1.f + __expf(-(a0v + al[nt][r]))); alp[nt][r] = a;
            const float k0 = ek[nt][r]; kap[nt][r] = k0 * kkw; ek[nt][r] = k0 * (1.f + (a - 1.f) * kaw);
            ssq[r] += kap[nt][r] * kap[nt][r]; bsm[r] += er[nt][r] * ek[nt][r] * rkw; } }
#pragma unroll
    for (int r = 0; r < 4; ++r) {
#pragma unroll
        for (int o = 1; o < 16; o <<= 1) { ssq[r] += __shfl_xor(ssq[r], o); bsm[r] += __shfl_xor(bsm[r], o); }
        ssq[r] = __builtin_amdgcn_rsqf(fmaxf(ssq[r], 1e-24f)); }
    { bf16* bon = (bf16*)(A.ws + WS_RKB);
#pragma unroll
      for (int nt = 0; nt < 4; ++nt)
#pragma unroll
          for (int r = 0; r < 4; ++r) { kap[nt][r] *= ssq[r]; bon[((size_t)dir * NT + tok0 + sgn * (4 * qd + r)) * RW + hh * 64 + 16 * nt + fr] = (bf16)f2bf(bsm[r] * ev[nt][r]); } }
    unsigned char* pkg = A.ws + WS_PKG + ((size_t)((dir * NB + b) * 6 + hh) * 128 + cc) * PKG_BYTES;
    float lend[4];
    u32x2_t btf[4], ktf[4];
#pragma unroll
    for (int nt = 0; nt < 4; ++nt) { float lam[4]; lam[0] = lw[nt][0]; lam[1] = lam[0] + lw[nt][1]; lam[2] = lam[1] + lw[nt][2]; lam[3] = lam[2] + lw[nt][3];
        const float t1 = __shfl(lam[3], lane - 16), t2 = __shfl(lam[3], lane - 32), t3 = __shfl(lam[3], lane - 48);
        const float off = (qd >= 1 ? t1 : 0.f) + (qd >= 2 ? t2 : 0.f) + (qd >= 3 ? t3 : 0.f);
#pragma unroll
        for (int r = 0; r < 4; ++r) lam[r] += off;
        lend[nt] = __shfl(lam[3], 48 + fr);
        float bt4[4], kt4[4];
        float epv[4];
#pragma unroll
        for (int r = 0; r < 4; ++r) epv[r] = __expf(lam[r]);
        float ep_prev = __shfl(epv[3], lane - 16); if (qd == 0) ep_prev = 1.f;
        const float eendall = __expf(lend[nt]);
#pragma unroll
        for (int r = 0; r < 4; ++r) { const float ep = epv[r], epm = r ? epv[r - 1] : ep_prev, einv = __builtin_amdgcn_rcpf(ep), eend = eendall * einv;
            const float bb = kap[nt][r] * alp[nt][r]; const int o = (4 * qd + r) * 72 + 16 * nt + fr;
            IMG[o] = (bf16)f2bf(-kap[nt][r] * epm); IMG[1152 + o] = (bf16)f2bf(er[nt][r] * ep); IMG[2304 + o] = (bf16)f2bf(bb * einv); IMG[3456 + o] = (bf16)f2bf(ek[nt][r] * einv);
            bt4[r] = bb * eend; kt4[r] = ek[nt][r] * eend; }
        btf[nt].x = cvtpk(bt4[0], bt4[1]); btf[nt].y = cvtpk(bt4[2], bt4[3]); ktf[nt].x = cvtpk(kt4[0], kt4[1]); ktf[nt].y = cvtpk(kt4[2], kt4[3]); }
    asm volatile("s_waitcnt lgkmcnt(0)" ::: "memory");
    f32x4 Lab = (f32x4){0.f, 0.f, 0.f, 0.f}, Lak = Lab, Mrb = Lab, Mrk = Lab;
#pragma unroll
    for (int ks = 0; ks < 2; ++ks) { const int o = fr * 72 + 32 * ks + 8 * qd;
        const bf16x8_t aA = *(const LAS bf16x8_t*)(IMG + o), aR = *(const LAS bf16x8_t*)(IMG + 1152 + o), bB = *(const LAS bf16x8_t*)(IMG + 2304 + o), bK = *(const LAS bf16x8_t*)(IMG + 3456 + o);
        Lab = MFMA16(aA, bB, Lab); Lak = MFMA16(aA, bK, Lak); Mrb = MFMA16(aR, bB, Mrb); Mrk = MFMA16(aR, bK, Mrk); }
#pragma unroll
    for (int r = 0; r < 4; ++r) { const int t = 4 * qd + r; if (!(fr < t)) { Lab[r] = 0.f; Lak[r] = 0.f; } if (!(fr <= t)) { Mrb[r] = 0.f; Mrk[r] = 0.f; } Lf[t * 17 + fr] = Lab[r]; }
    asm volatile("s_waitcnt lgkmcnt(0)" ::: "memory");
    float Tc[16];
#pragma unroll
    for (int t = 0; t < 16; ++t) { float acc = (t == fr) ? 1.f : 0.f;
#pragma unroll
        for (int s = 0; s < t; ++s) acc += Lf[t * 17 + s] * Tc[s];
        Tc[t] = acc; }
    f32x4 Tm;
#pragma unroll
    for (int r = 0; r < 4; ++r) Tm[r] = qd == 0 ? Tc[r] : (qd == 1 ? Tc[4 + r] : (qd == 2 ? Tc[8 + r] : Tc[12 + r]));
#pragma unroll
    for (int r = 0; r < 4; ++r) { const int o = (4 * qd + r) * 20 + fr; MT[o] = (bf16)f2bf(Tm[r]); MT[320 + o] = (bf16)f2bf(Mrb[r]); MT[640 + o] = (bf16)f2bf(Lak[r]); MT[960 + o] = (bf16)f2bf(Mrk[r]); }
    asm volatile("s_waitcnt lgkmcnt(0)" ::: "memory");
    { const int o = fr * 20 + 4 * qd;
      *(u32x2_t*)(pkg + PK_TM + lane * 8) = *(const LAS u32x2_t*)(MT + o); *(u32x2_t*)(pkg + PK_MRB + lane * 8) = *(const LAS u32x2_t*)(MT + 320 + o);
      *(u32x2_t*)(pkg + PK_LAK + lane * 8) = *(const LAS u32x2_t*)(MT + 640 + o); *(u32x2_t*)(pkg + PK_MRK + lane * 8) = *(const LAS u32x2_t*)(MT + 960 + o); }
#pragma unroll
    for (int ks = 0; ks < 2; ++ks) { const int o = fr * 72 + 32 * ks + 4 * qd;
        const u32x2_t alo = *(const LAS u32x2_t*)(IMG + o), ahi = *(const LAS u32x2_t*)(IMG + o + 16), rlo = *(const LAS u32x2_t*)(IMG + 1152 + o), rhi = *(const LAS u32x2_t*)(IMG + 1152 + o + 16);
        *(u32x4_t*)(pkg + PK_AH + ks * 1024 + lane * 16) = (u32x4_t){alo.x, alo.y, ahi.x, ahi.y}; *(u32x4_t*)(pkg + PK_RH + ks * 1024 + lane * 16) = (u32x4_t){rlo.x, rlo.y, rhi.x, rhi.y}; }
#pragma unroll
    for (int nt = 0; nt < 4; ++nt) { *(u32x2_t*)(pkg + PK_BT + nt * 512 + lane * 8) = btf[nt]; *(u32x2_t*)(pkg + PK_KT + nt * 512 + lane * 8) = ktf[nt];
        u32x2_t vf; vf.x = cvtpk(ev[nt][0], ev[nt][1]); vf.y = cvtpk(ev[nt][2], ev[nt][3]); *(u32x2_t*)(pkg + PK_VV + nt * 512 + lane * 8) = vf;
        if (qd == 0) ((float*)(pkg + PK_GE))[16 * nt + fr] = __expf(lend[nt]); }
    asm volatile("s_waitcnt lgkmcnt(0)" ::: "memory");
}
DI void phase_rwkv_r1(const Args& A, int l, LAS unsigned char* lds, int bid, int G, int tid, int wave, int lane) {
    constexpr int NIT = 2 * NB * 6 * 16; int dh_staged = -1;
    __syncthreads();
    for (int it = bid; it < NIT; it += G) rwkv_r1_item(A, l, lds, it, dh_staged, tid, wave, lane);
    __syncthreads();
}

struct RkOps { bf16x8_t ah[2], rh[2]; bf16x4_t bt[4], kt[4], vv, tm, mrb, lak, mrk; f32x4 ge[4]; };
DI void rk_load(RkOps& o, const unsigned char* pkg, int vb, int lane, int qd) {
#pragma unroll
    for (int ks = 0; ks < 2; ++ks) { o.ah[ks] = *(const bf16x8_t*)(pkg + PK_AH + ks * 1024 + lane * 16); o.rh[ks] = *(const bf16x8_t*)(pkg + PK_RH + ks * 1024 + lane * 16); }
#pragma unroll
    for (int kt = 0; kt < 4; ++kt) { o.bt[kt] = *(const bf16x4_t*)(pkg + PK_BT + kt * 512 + lane * 8); o.kt[kt] = *(const bf16x4_t*)(pkg + PK_KT + kt * 512 + lane * 8); o.ge[kt] = *(const f32x4*)(pkg + PK_GE + (16 * kt + 4 * qd) * 4); }
    o.vv = *(const bf16x4_t*)(pkg + PK_VV + vb * 512 + lane * 8); o.tm = *(const bf16x4_t*)(pkg + PK_TM + lane * 8); o.mrb = *(const bf16x4_t*)(pkg + PK_MRB + lane * 8);
    o.lak = *(const bf16x4_t*)(pkg + PK_LAK + lane * 8); o.mrk = *(const bf16x4_t*)(pkg + PK_MRK + lane * 8);
}
DI void rk_step(const RkOps& c, f32x4 (&sT)[4], bf16* yb, int dir, int b, int hh, int vb, int cc, int fr, int qd) {
    const f32x4 zero4 = (f32x4){0.f, 0.f, 0.f, 0.f};
    union { unsigned u[4]; bf16x8_t v; } s0, s1;
    s0.u[0] = cvtpk(sT[0][0], sT[0][1]); s0.u[1] = cvtpk(sT[0][2], sT[0][3]); s0.u[2] = cvtpk(sT[1][0], sT[1][1]); s0.u[3] = cvtpk(sT[1][2], sT[1][3]);
    s1.u[0] = cvtpk(sT[2][0], sT[2][1]); s1.u[1] = cvtpk(sT[2][2], sT[2][3]); s1.u[2] = cvtpk(sT[3][0], sT[3][1]); s1.u[3] = cvtpk(sT[3][2], sT[3][3]);
    const bf16x8_t vv8 = widen4(c.vv);
    f32x4 ax = MFMA16(widen4(c.lak), vv8, zero4); ax = MFMA16(c.ah[0], s0.v, ax); ax = MFMA16(c.ah[1], s1.v, ax);
    f32x4 ay = MFMA16(widen4(c.mrk), vv8, zero4); ay = MFMA16(c.rh[0], s0.v, ay); ay = MFMA16(c.rh[1], s1.v, ay);
    const bf16x8_t xb = widen4(pack4(ax));
    const f32x4 au = MFMA16(widen4(c.tm), xb, zero4);
    const bf16x8_t ub = widen4(pack4(au));
    ay = MFMA16(widen4(c.mrb), ub, ay);
#pragma unroll
    for (int kt = 0; kt < 4; ++kt) { f32x4 t = sT[kt] * c.ge[kt]; t = MFMA16(widen4(c.kt[kt]), vv8, t); t = MFMA16(widen4(c.bt[kt]), ub, t); sT[kt] = t; }
    const int sgn = dir ? -1 : 1; const int tok0 = b * SEQ + (dir ? SEQ - 1 - 16 * cc : 16 * cc);
#pragma unroll
    for (int r = 0; r < 4; ++r) yb[((size_t)dir * NT + tok0 + sgn * (4 * qd + r)) * RW + hh * 64 + 16 * vb + fr] = (bf16)f2bf(ay[r]);
}
constexpr int R2_SLOTS = 8, R2_CTL = R2_SLOTS * PKG_BYTES;
static_assert(R2_CTL + 64 <= MISC_OFF, "rwkv r2 LDS");
DI void rk_load_lds(RkOps& o, const LAS unsigned char* pkg, int vb, int lane, int qd) {
#pragma unroll
    for (int ks = 0; ks < 2; ++ks) { o.ah[ks] = *(const LAS bf16x8_t*)(pkg + PK_AH + ks * 1024 + lane * 16); o.rh[ks] = *(const LAS bf16x8_t*)(pkg + PK_RH + ks * 1024 + lane * 16); }
#pragma unroll
    for (int kt = 0; kt < 4; ++kt) { o.bt[kt] = *(const LAS bf16x4_t*)(pkg + PK_BT + kt * 512 + lane * 8); o.kt[kt] = *(const LAS bf16x4_t*)(pkg + PK_KT + kt * 512 + lane * 8); o.ge[kt] = *(const LAS f32x4*)(pkg + PK_GE + (16 * kt + 4 * qd) * 4); }
    o.vv = *(const LAS bf16x4_t*)(pkg + PK_VV + vb * 512 + lane * 8); o.tm = *(const LAS bf16x4_t*)(pkg + PK_TM + lane * 8); o.mrb = *(const LAS bf16x4_t*)(pkg + PK_MRB + lane * 8);
    o.lak = *(const LAS bf16x4_t*)(pkg + PK_LAK + lane * 8); o.mrk = *(const LAS bf16x4_t*)(pkg + PK_MRK + lane * 8);
}
DI void rk_pkg_fetch(u32x4_t (&buf)[13], const unsigned char* pkg, int lane) {
#pragma unroll
    for (int i = 0; i < 12; ++i) buf[i] = *(const u32x4_t*)(pkg + i * 1024 + lane * 16);
    buf[12] = (lane < 16) ? *(const u32x4_t*)(pkg + 12288 + lane * 16) : (u32x4_t){0u, 0u, 0u, 0u};
}
DI void rwkv_r2_unit(const Args& A, LAS unsigned char* lds, int u, int tid, int wave, int lane) {
    bf16* yb = (bf16*)(A.ws + WS_RKY);
    const int dir = u / 48, rem = u % 48, b = rem / 6, hh = rem % 6; const int fr = lane & 15, qd = lane >> 4;
    const unsigned char* pkg0 = A.ws + WS_PKG + ((size_t)((dir * NB + b) * 6 + hh) * 128) * PKG_BYTES;
    volatile LAS unsigned* ready = (volatile LAS unsigned*)(lds + R2_CTL); volatile LAS unsigned* consumed = ready + 8;
    __syncthreads();
    if (tid < 16) ready[tid] = 0u;
    __syncthreads();
    if (wave >= 4) {
        const int j = wave - 4; u32x4_t cur[13], nxt[13];
        rk_pkg_fetch(cur, pkg0 + (size_t)j * PKG_BYTES, lane);
        for (int cc = j; cc < 128; cc += 4) {
            if (cc + 4 < 128) rk_pkg_fetch(nxt, pkg0 + (size_t)(cc + 4) * PKG_BYTES, lane);
            if (cc >= R2_SLOTS) { const unsigned need = (unsigned)(cc - R2_SLOTS + 1); unsigned spins = 0;
                for (;;) { const unsigned c0 = consumed[0], c1 = consumed[1], c2 = consumed[2], c3 = consumed[3];
                    if (c0 >= need && c1 >= need && c2 >= need && c3 >= need) break; if (++spins > (1u << 22)) break; __builtin_amdgcn_s_sleep(1); } }
            LAS unsigned char* slot = lds + (cc & (R2_SLOTS - 1)) * PKG_BYTES;
#pragma unroll
            for (int i = 0; i < 12; ++i) *(LAS u32x4_t*)(slot + i * 1024 + lane * 16) = cur[i];
            if (lane < 16) *(LAS u32x4_t*)(slot + 12288 + lane * 16) = cur[12];
            asm volatile("s_waitcnt lgkmcnt(0)" ::: "memory");
            if (lane == 0) ready[cc & (R2_SLOTS - 1)] = (unsigned)(cc + 1);
            asm volatile("" ::: "memory");
#pragma unroll
            for (int i = 0; i < 13; ++i) cur[i] = nxt[i];
        }
    } else {
        const int vb = wave; f32x4 sT[4];
#pragma unroll
        for (int kt = 0; kt < 4; ++kt) sT[kt] = (f32x4){0.f, 0.f, 0.f, 0.f};
        for (int cc = 0; cc < 128; ++cc) { unsigned spins = 0;
            while (ready[cc & (R2_SLOTS - 1)] != (unsigned)(cc + 1)) { if (++spins > (1u << 22)) break; __builtin_amdgcn_s_sleep(1); }
            asm volatile("" ::: "memory");
            RkOps c; rk_load_lds(c, lds + (cc & (R2_SLOTS - 1)) * PKG_BYTES, vb, lane, qd);
            asm volatile("s_waitcnt lgkmcnt(0)" ::: "memory");
            if (lane == 0) consumed[vb] = (unsigned)(cc + 1);
            asm volatile("" ::: "memory");
            rk_step(c, sT, yb, dir, b, hh, vb, cc, fr, qd);
        }
    }
    __syncthreads();
}

constexpr int YA_G2LD = 136;
static_assert(384 * YA_G2LD * 2 <= MISC_OFF, "yasm LDS");
DI void yasm_token(const bf16* Z, const bf16* ao, const float* al, const bf16* num, const float* den, const float* mlg, bf16* y, int tok, int lane) {
    const bf16* zr = Z + (size_t)tok * ZLD; bf16* yr = y + (size_t)tok * DM;
    const float lsev = al[((size_t)((lane >> 2) % 3) * NT + tok) * 4 + (lane & 3)];
    const float denv = den[((size_t)((lane >> 2) & 1) * NT + tok) * 4 + (lane & 3)];
    float aov[3][4], nmv[2][4], nm2[2][4], zo[4], zo2[4];
#pragma unroll
    for (int hh = 0; hh < 4; ++hh) { const int col = hh * 64 + lane, c0 = hh * 96 + lane, c1 = hh * 96 + 64 + (lane & 31);
#pragma unroll
        for (int br = 0; br < 3; ++br) aov[br][hh] = bf2f(ao[((size_t)br * NT + tok) * AW + col]);
#pragma unroll
        for (int d = 0; d < 2; ++d) { nmv[d][hh] = bf2f(num[((size_t)d * NT + tok) * MW + c0]); nm2[d][hh] = bf2f(num[((size_t)d * NT + tok) * MW + c1]); }
        zo[hh] = bf2f(zr[ZMO + c0]); zo2[hh] = bf2f(zr[ZMO + c1]); }
#pragma unroll
    for (int hh = 0; hh < 4; ++hh) { const int col = hh * 64 + lane;
        const float l0 = __shfl(lsev, hh), l1 = __shfl(lsev, 4 + hh), l2 = __shfl(lsev, 8 + hh);
        const float mx = fmaxf(l0, fmaxf(l1, l2)); const float w0 = __expf(l0 - mx), w1 = __expf(l1 - mx), w2 = __expf(l2 - mx);
        yr[col] = (bf16)f2bf((w0 * aov[0][hh] + w1 * aov[1][hh] + w2 * aov[2][hh]) / (w0 + w1 + w2)); }
#pragma unroll
    for (int hh = 0; hh < 4; ++hh) { const int c0 = hh * 96 + lane, c1 = hh * 96 + 64 + (lane & 31); const bool hi = lane < 32;
        const float df = __shfl(denv, hh), db = __shfl(denv, 4 + hh);
        const float invf = 1.f / fmaxf(fabsf(df), 1.f), invb = 1.f / fmaxf(fabsf(db), 1.f);
        const float a = nmv[0][hh] * invf + nmv[1][hh] * invb; const float bb = hi ? (nm2[0][hh] * invf + nm2[1][hh] * invb) : 0.f;
        const float mean = (wave_sum(a) + wave_sum(bb)) * (1.f / 96.f); const float da = a - mean, dbb = hi ? bb - mean : 0.f;
        const float var = (wave_sum(da * da) + wave_sum(dbb * dbb)) * (1.f / 96.f); const float rs = rsqrtf(var + 1e-6f);
        yr[AW + RW + c0] = (bf16)f2bf(da * rs * mlg[c0] * sigm(zo[hh]));
        if (hi) yr[AW + RW + c1] = (bf16)f2bf(dbb * rs * mlg[c1] * sigm(zo2[hh])); }
}
DI void phase_yasm(const Args& A, int l, LAS unsigned char* lds, int gw, int ngw, int tid, int lane) {
    const bf16* Z = (const bf16*)(A.ws + WS_Z); const bf16* ao = (const bf16*)(A.ws + WS_ATTO); const float* al = (const float*)(A.ws + WS_ATTL);
    const bf16* rky = (const bf16*)(A.ws + WS_RKY); const bf16* rkb = (const bf16*)(A.ws + WS_RKB);
    const bf16* num = (const bf16*)(A.ws + WS_MLNUM); const float* den = (const float*)(A.ws + WS_MLDEN); bf16* y = (bf16*)(A.ws + WS_HB);
    const float* lng = A.in[I_RLNG] + (size_t)l * RW; const float* lnb = A.in[I_RLNB] + (size_t)l * RW; const float* mlg = A.in[I_MLNG] + (size_t)l * MW;
    LAS bf16* G2T = (LAS bf16*)lds;
    __syncthreads();
    { const u32x4_t* src = (const u32x4_t*)(A.ws + WS_G2T + (size_t)l * RW * 128 * 2);
      for (int idx = tid; idx < RW * 16; idx += NTHR) { const int col = idx >> 4, ch = idx & 15; *(LAS u32x4_t*)(G2T + col * YA_G2LD + ch * 8) = src[idx]; } }
    __syncthreads();
    const int fr = lane & 15, qd = lane >> 4;
    for (int item = gw; item < (NT / 16) * 6; item += ngw) {
        const int hh = item % 6, tg = item / 6; const int tokA = tg * 16 + fr;
        f32x4 gacc[4];
#pragma unroll
        for (int nt = 0; nt < 4; ++nt) gacc[nt] = (f32x4){0.f, 0.f, 0.f, 0.f};
#pragma unroll
        for (int ks = 0; ks < 4; ++ks) { float f[8]; unpack8(*(const uint4*)(Z + (size_t)tokA * ZLD + ZGD + 32 * ks + 8 * qd), f);
            union { unsigned u[4]; bf16x8_t v; } a;
#pragma unroll
            for (int e = 0; e < 4; ++e) a.u[e] = cvtpk(sigm(f[2 * e]), sigm(f[2 * e + 1]));
#pragma unroll
            for (int nt = 0; nt < 4; ++nt) { const bf16x8_t bg = *(const LAS bf16x8_t*)(G2T + (hh * 64 + 16 * nt + fr) * YA_G2LD + 32 * ks + 8 * qd); gacc[nt] = MFMA16(a.v, bg, gacc[nt]); } }
        float sv[4][4], bv[4][4]; float sm[4] = {0.f, 0.f, 0.f, 0.f};
#pragma unroll
        for (int nt = 0; nt < 4; ++nt)
#pragma unroll
            for (int r = 0; r < 4; ++r) { const size_t o = (size_t)(tg * 16 + 4 * qd + r) * RW + hh * 64 + 16 * nt + fr;
                sv[nt][r] = bf2f(rky[o]) + bf2f(rky[(size_t)NT * RW + o]); bv[nt][r] = bf2f(rkb[o]) + bf2f(rkb[(size_t)NT * RW + o]); sm[r] += sv[nt][r]; }
        float vr[4] = {0.f, 0.f, 0.f, 0.f};
#pragma unroll
        for (int r = 0; r < 4; ++r) {
#pragma unroll
            for (int o = 1; o < 16; o <<= 1) sm[r] += __shfl_xor(sm[r], o);
            sm[r] *= (1.f / 64.f);
#pragma unroll
            for (int nt = 0; nt < 4; ++nt) { sv[nt][r] -= sm[r]; vr[r] += sv[nt][r] * sv[nt][r]; }
#pragma unroll
            for (int o = 1; o < 16; o <<= 1) vr[r] += __shfl_xor(vr[r], o);
            vr[r] = rsqrtf(vr[r] * (1.f / 64.f) + 64e-5f); }
#pragma unroll
        for (int nt = 0; nt < 4; ++nt) { const int col = hh * 64 + 16 * nt + fr; const float lg_ = lng[col], lb_ = lnb[col];
#pragma unroll
            for (int r = 0; r < 4; ++r) y[(size_t)(tg * 16 + 4 * qd + r) * DM + AW + col] = (bf16)f2bf((sv[nt][r] * vr[r] * lg_ + lb_ + bv[nt][r]) * gacc[nt][r]); }
    }
    for (int tok = gw; tok < NT; tok += ngw) yasm_token(Z, ao, al, num, den, mlg, y, tok, lane);
    __syncthreads();
}

constexpr int PH_PER_LAYER = 10, NPH = 1 + NL * PH_PER_LAYER + 1;
#ifndef MK_ONE_LAUNCH
#define MK_ONE_LAUNCH 1
#endif

#ifndef MK_DUP
#define MK_DUP 0
#endif
constexpr int P0_END = NL * 16 * 64 + NL * 16 * 16 + NL * NE * 3 * 16 * 44, P0_SPLIT = P0_END - 0;
template <int l> DI void run_layer(const Args& A, LAS unsigned char* lds, const XcdBarrier& bar, int lo, int hi, int G, int bid, int tid, int lane, int wave, int gw, int ngw, int gtid, int nthr) {
#define IN(k) (lo <= (k) && (k) < hi)
#define SEAM(k) do { if (IN(k) && IN((k) + 1)) xcd_barrier(bar); } while (0)
#define PH(k, ...) do { if (IN(pb + (k))) { { __VA_ARGS__ } if ((MK_DUP >> (k)) & 1) { xcd_barrier(bar); { __VA_ARGS__ } } } SEAM(pb + (k)); } while (0)
    const int pb = 1 + l * PH_PER_LAYER;
    PH(0, phase_ln1(A, l, gw, ngw, lane););
    PH(1,
        pg8::Gemm g{(const bf16*)(A.ws + WS_HB), (const bf16*)(A.ws + WS_WTIN) + (size_t)l * ZLD * DM, NT, ZLD, DM};
        pg8::StaticOrder S; S.init(NT, ZLD, G, bid);
        pg8::EpiBf16<0> E{(bf16*)(A.ws + WS_Z), ZLD, nullptr, 0, 0, 1.f};
        pg8::gemm_phase<pg8::EpiBf16<0>, pg8::StaticOrder, true, true>(lds, g, S, E););
    PH(2, phase_attn(A, lds, bid, G, tid, wave, lane); phase_rwkv_r1(A, l, lds, bid, G, tid, wave, lane); if ((MK_DUP >> 13) & 1) phase_rwkv_r1(A, l, lds, bid, G, tid, wave, lane);
          phase_mlstm_m1(A, l, lds, bid, G, tid, wave, lane); if ((MK_DUP >> 16) & 1) phase_mlstm_m1(A, l, lds, bid, G, tid, wave, lane););
    PH(3, if (l == 0 && P0_SPLIT < P0_END) { const int nb = G > 160 ? G - 160 : G, b0 = G > 160 ? bid - 160 : bid; if (b0 >= 0) { __syncthreads(); phase_p0(A, lds, P0_SPLIT, P0_END, b0 * NWAVES + wave, nb * NWAVES, wave, lane); __syncthreads(); } }
          for (int rep = 0; rep < 1 + ((MK_DUP >> 14) & 1); ++rep) for (int u = bid; u < 96; u += G) rwkv_r2_unit(A, lds, u, tid, wave, lane);
          for (int rep = 0; rep < 1 + ((MK_DUP >> 15) & 1); ++rep) for (int u = bid; u < 96 + 64; u += G) { if (u >= 96 && wave < 7) mlstm_m2_wave(A, u - 96, wave, lane); });
    PH(4, phase_yasm(A, l, lds, gw, ngw, tid, lane););
    PH(5,
        pg8::Gemm g{(const bf16*)(A.ws + WS_HB), (const bf16*)(A.ws + WS_WTOUT) + (size_t)l * DM * DM, NT, DM, DM};
        pg8::StaticOrder S; S.init(NT, DM, G, bid);
        EpiResF32 E{(l == 0) ? A.in[I_X] : (const float*)(A.ws + WS_X2), (float*)(A.ws + WS_X1), DM};
        pg8::gemm_phase<EpiResF32, pg8::StaticOrder, false, true>(lds, g, S, E););
    PH(6, phase_ln2(A, l, lds, gw, ngw, tid, lane););
    PH(7, phase_topk(A, lds, bid, G, tid, wave, lane););
    PH(8,
        pg8::Gemm g{(const bf16*)(A.ws + WS_XG), (const bf16*)(A.ws + WS_W13T + (size_t)l * NE * 5632 * DM), NSLOT, NE * 5632, DM / 2};
        GroupOrder S; S.init(22, G, bid);
        EpiSwiGLU E{A.ws + WS_ACT, 22};
        pg8::gemm_phase<EpiSwiGLU, GroupOrder, true, true, true>(lds, g, S, E););
    PH(9,
        pg8::Gemm g{(const bf16*)(A.ws + WS_ACT), (const bf16*)(A.ws + WS_W2T + (size_t)l * NE * DM * FF), NSLOT, NE * DM, FF / 2};
        GroupOrder S; S.init(4, G, bid);
        EpiGate E{(bf16*)(A.ws + WS_YS), (const float*)(A.ws + WS_GATE)};
        pg8::gemm_phase<EpiGate, GroupOrder, true, true, true>(lds, g, S, E););
#undef PH
#undef IN
#undef SEAM
}

__global__ void __launch_bounds__(NTHR, 2) mk_fwd(Args A) {
    extern __shared__ __attribute__((aligned(16))) unsigned char lds_raw[];
    LAS unsigned char* lds = (LAS unsigned char*)lds_raw;
    const int tid = threadIdx.x, lane = tid & 63, wave = __builtin_amdgcn_readfirstlane(tid >> 6);
    const int G = gridDim.x, bid = blockIdx.x;
    const int gw = bid * NWAVES + wave, ngw = G * NWAVES, gtid = bid * NTHR + tid, nthr = G * NTHR;
    volatile LAS unsigned* MISC = (volatile LAS unsigned*)(lds + MISC_OFF);
    if (tid < 64) MISC[tid] = 0u;
    __syncthreads();
    const int lo = A.ph_lo, hi = A.ph_hi;
    const bool use_bar = (hi - lo) > 1;
    XcdBarrier bar; bar.bar = (unsigned*)(A.ws + WS_CTL) + CW_BAR; bar.x = 0; bar.st = MISC + 8;
    if (use_bar) bar = xcd_barrier_post((unsigned*)(A.ws + WS_CTL) + CW_BAR, MISC + 8);
#define IN(k) (lo <= (k) && (k) < hi)
#define SEAM(k) do { if (IN(k) && IN((k) + 1)) xcd_barrier(bar); } while (0)

    if (IN(0)) { phase_p0(A, lds, 0, P0_SPLIT, gw, ngw, wave, lane); if ((MK_DUP >> 10) & 1) { xcd_barrier(bar); phase_p0(A, lds, 0, P0_SPLIT, gw, ngw, wave, lane); } } SEAM(0);

    run_layer<0>(A, lds, bar, lo, hi, G, bid, tid, lane, wave, gw, ngw, gtid, nthr);
    run_layer<1>(A, lds, bar, lo, hi, G, bid, tid, lane, wave, gw, ngw, gtid, nthr);
    if (IN(NPH - 1)) { phase_final(A, gw, ngw, lane); if ((MK_DUP >> 11) & 1) { xcd_barrier(bar); phase_final(A, gw, ngw, lane); } }
#undef IN
#undef SEAM
}
}

extern "C" void kernel_launch(void* const* d_in, const int* in_sizes, int n_in, void* d_out, int out_size, void* d_ws, size_t ws_size, hipStream_t stream) {
    using namespace mk;
    static int grid = 0;
    if (grid == 0) {
        if (n_in != N_IN || out_size != NT * DM || ws_size < WS_END) { fprintf(stderr, "kernel_launch: unexpected shapes (n_in %d, out %d, ws %zu < %zu)\n", n_in, out_size, ws_size, (size_t)WS_END); grid = -1; return; }
        int dev = 0, cus = 0, per_cu = 0;
        if (hipGetDevice(&dev) != hipSuccess || hipDeviceGetAttribute(&cus, hipDeviceAttributeMultiprocessorCount, dev) != hipSuccess) { grid = -1; return; }
        if (hipFuncSetAttribute((const void*)mk_fwd, hipFuncAttributeMaxDynamicSharedMemorySize, LDS_BYTES) != hipSuccess) { fprintf(stderr, "kernel_launch: hipFuncSetAttribute failed\n"); grid = -1; return; }
        if (hipOccupancyMaxActiveBlocksPerMultiprocessor(&per_cu, (const void*)mk_fwd, NTHR, LDS_BYTES) != hipSuccess || per_cu < 1) fprintf(stderr, "kernel_launch: occupancy query reports %d\n", per_cu);
        (void)hipGetLastError();
        grid = cus;
    }
    if (grid < 0) return;
    hipMemsetAsync((char*)d_ws + WS_CTL, 0, CTL_ZERO_BYTES, stream);
    Args a{};
    for (int i = 0; i < N_IN; ++i) a.in[i] = (const float*)d_in[i];
    a.out = (float*)d_out; a.ws = (unsigned char*)d_ws;
#if MK_ONE_LAUNCH
    a.ph_lo = 0; a.ph_hi = NPH;
    hipLaunchKernelGGL(mk_fwd, dim3(grid), dim3(NTHR), LDS_BYTES, stream, a);
#else
    for (int p = 0; p < NPH; ++p) { a.ph_lo = p; a.ph_hi = p + 1; hipLaunchKernelGGL(mk_fwd, dim3(grid), dim3(NTHR), LDS_BYTES, stream, a); }
#endif
}
```

```cpp
#include <hip/hip_runtime.h>
#include <cstdio>
#include <cstdint>
namespace pg8 {
#define PG8_LAS __attribute__((address_space(3)))
typedef unsigned short bf16_t;
typedef short bf16x8 __attribute__((ext_vector_type(8)));
typedef float f32x4 __attribute__((ext_vector_type(4)));
typedef unsigned u32x4 __attribute__((ext_vector_type(4)));
constexpr int BM = 256, BK = 64, HALF = 128, HTB = HALF * BK * 2  , STAGE_BYTES = 8 * HTB, NXCD = 8, WGM = 8;

__host__ __device__ __forceinline__ int lds_byte(int r, int c) { const int st = (r >> 4) * 2 + (c >> 5), rr = r & 15, cc = c & 31, ob = rr * 64 + cc * 2; return st * 1024 + (ob ^ (((ob >> 9) & 1) << 5)); }
__host__ __device__ __forceinline__ void stage_rc(int b, int& R, int& C) { const int st = b / 1024, sb = b % 1024, swz = sb ^ (((sb >> 9) & 1) << 5); R = (st >> 1) * 16 + swz / 64; C = (st & 1) * 32 + (swz % 64) / 2; }
__host__ __device__ __forceinline__ int perm32(int rho) { const int n = rho >> 4, i = rho & 15; return 8 * (i >> 2) + 4 * n + (i & 3); }

struct Unit { int pm, pn; };
struct Gemm { const bf16_t* A; const bf16_t* Bt; int M, N, K; };

struct StaticOrder {
    int nM, nN, nwg, G, c;
    __host__ __device__ void init(int M, int N, int G_, int c_) { nM = M / BM; nN = N / BM; nwg = nM * nN; G = G_; c = c_; }
    __host__ __device__ bool next(int i, Unit& u) const {
        const long L = (long)i * G + c; if (L >= nwg) return false;
        int wgid = (int)L; { const int q = nwg / NXCD, r = nwg % NXCD, xcd = wgid % NXCD, off = wgid / NXCD; wgid = (xcd < r ? xcd * (q + 1) : r * (q + 1) + (xcd - r) * q) + off; }
        const int nig = WGM * nN, gid = wgid / nig, fm = gid * WGM, gsz = (nM - fm) < WGM ? (nM - fm) : WGM;
        u.pm = fm + ((wgid % nig) % gsz); u.pn = (wgid % nig) / gsz; return true;
    }
    __device__ __forceinline__ void a_ready(const Unit&) const {}
    __device__ __forceinline__ void done(const Unit&) const {}
};

__device__ __forceinline__ unsigned cvt_pk_bf16(float lo, float hi) { unsigned r; asm volatile("v_cvt_pk_bf16_f32 %0, %1, %2" : "=v"(r) : "v"(lo), "v"(hi)); return r; }
typedef float f32x2 __attribute__((ext_vector_type(2)));
__device__ __forceinline__ f32x2 gelu_pk(f32x2 v) {
    const f32x2 av = __builtin_elementwise_abs(v), d = av * 0.2316418882f + 1.0f;
    f32x2 t; t.x = __builtin_amdgcn_rcpf(d.x); t.y = __builtin_amdgcn_rcpf(d.y);
    f32x2 q = t * 0.5307027145f + (-0.7265760135f); q = q * t + 0.7107068705f; q = q * t + (-0.142248368f); q = q * t + 0.127414796f; q = q * t;
    const f32x2 s = (v * v) * (-0.72134752044f);
    f32x2 e; e.x = __builtin_amdgcn_exp2f(s.x); e.y = __builtin_amdgcn_exp2f(s.y);
    const f32x2 m = v * (q * e), r = v - m;
    f32x2 o; o.x = v.x < 0.f ? m.x : r.x; o.y = v.y < 0.f ? m.y : r.y; return o;
}

template <int ACT  > struct EpiBf16 {
    static constexpr bool PERM = true, AFTER_DRAIN = false; static_assert(ACT == 0 || ACT == 1, "EpiBf16: ACT is 0 (none) or 1 (gelu_pk)");
    bf16_t* O; int ldc; const float* bias; int split_cols; size_t split_stride; float scale0;
    __device__ __forceinline__ void operator()(const f32x4 (&acc)[2][2][4][2], const Unit& u, int wr, int wc, int fr, int fq) const {
        const int row0 = u.pm * BM + wr * 64 + fr; int colt = u.pn * BM; bf16_t* base = O;
        float sc = 1.f; if (split_cols) { const int t = colt / split_cols; base += (size_t)t * split_stride; colt -= t * split_cols; if (t == 0) sc = scale0; }
        const int col0 = colt + wc * 32 + 8 * fq, bcol0 = u.pn * BM + wc * 32 + 8 * fq;
        f32x4 bv[2][2];
#pragma unroll
        for (int bj = 0; bj < 2; ++bj)
#pragma unroll
            for (int n = 0; n < 2; ++n) bv[bj][n] = bias ? *(const f32x4*)(bias + bcol0 + bj * HALF + 4 * n) : (f32x4){0.f, 0.f, 0.f, 0.f};
#pragma unroll
        for (int ai = 0; ai < 2; ++ai)
#pragma unroll
            for (int m = 0; m < 4; ++m) { bf16_t* rowp = base + (size_t)(row0 + ai * HALF + m * 16) * ldc + col0;
#pragma unroll
                for (int bj = 0; bj < 2; ++bj) { f32x4 v0 = acc[ai][bj][m][0] + bv[bj][0], v1 = acc[ai][bj][m][1] + bv[bj][1];
                    if (ACT == 1) { f32x2 a = gelu_pk((f32x2){v0[0], v0[1]}), b = gelu_pk((f32x2){v0[2], v0[3]}), c = gelu_pk((f32x2){v1[0], v1[1]}), d = gelu_pk((f32x2){v1[2], v1[3]});
                        v0 = (f32x4){a.x, a.y, b.x, b.y}; v1 = (f32x4){c.x, c.y, d.x, d.y}; }
                    v0 = v0 * sc; v1 = v1 * sc; u32x4 w; w.x = cvt_pk_bf16(v0[0], v0[1]); w.y = cvt_pk_bf16(v0[2], v0[3]); w.z = cvt_pk_bf16(v1[0], v1[1]); w.w = cvt_pk_bf16(v1[2], v1[3]);
                    *(u32x4*)(rowp + bj * HALF) = w; } }
    }
};
template <class Epi, class Sched, bool ALIGN_EPI = false, bool SP2 = false, bool F8 = false>
__device__ __forceinline__ void gemm_phase(PG8_LAS unsigned char* lds, const Gemm g, const Sched& S, const Epi& E) {
    const int tid = threadIdx.x, wid = __builtin_amdgcn_readfirstlane(tid >> 6), lane = tid & 63, wr = wid >> 2, wc = wid & 3, fr = lane & 15, fq = lane >> 4;
    int Kq = g.K; if constexpr (F8) asm volatile("" : "+s"(Kq));
    const int K = Kq, nt = K / BK;
    unsigned voffA[2], voffB[2];
#pragma unroll
    for (int i = 0; i < 2; ++i) { int R, C; stage_rc(tid * 16 + i * 8192, R, C); const int Rb = Epi::PERM ? ((R & ~31) + perm32(R & 31)) : R;
        voffA[i] = (unsigned)(R * K + C) * 2u; voffB[i] = (unsigned)(Rb * K + C) * 2u; }
    const size_t kstep = (size_t)(BK * 2);
    const size_t hstep = (size_t)HALF * K * 2;
    const size_t tstep = 2 * hstep;
    const unsigned ldsw = (unsigned)wid * 1024u;
    const int aoff = lds_byte(wr * 64 + fr, fq * 8), boff = lds_byte(wc * 32 + fr, fq * 8);
#define PG8_SA(b, h) (((b) * 2 + (h)) * HTB)
#define PG8_SB(b, h) ((4 + (b) * 2 + (h)) * HTB)
#define PG8_STAGE(bufoff, gbase, voff) do { _Pragma("unroll") for (int _i = 0; _i < 2; ++_i) \
        __builtin_amdgcn_global_load_lds((const unsigned*)((const char*)(gbase) + (voff)[_i]), (PG8_LAS unsigned*)(lds + (bufoff) + ldsw + _i * 8192), 16, 0, 0); } while (0)
#define PG8_LDA(dst, b, h) do { _Pragma("unroll") for (int m = 0; m < 4; ++m) { if constexpr (F8) { const i32x4_ lo_ = *(const PG8_LAS i32x4_*)(lds + PG8_SA(b, h) + aoff + m * 2048), hi_ = *(const PG8_LAS i32x4_*)(lds + PG8_SA(b, h) + aoff + m * 2048 + 1024); dst##8[m] = __builtin_shufflevector(lo_, hi_, 0, 1, 2, 3, 4, 5, 6, 7); } \
        else { _Pragma("unroll") for (int k = 0; k < 2; ++k) dst[m][k] = *(const PG8_LAS bf16x8*)(lds + PG8_SA(b, h) + aoff + m * 2048 + k * 1024); } } } while (0)
#define PG8_LDB(dst, b, h) do { _Pragma("unroll") for (int n = 0; n < 2; ++n) { if constexpr (F8) { const i32x4_ lo_ = *(const PG8_LAS i32x4_*)(lds + PG8_SB(b, h) + boff + n * 2048), hi_ = *(const PG8_LAS i32x4_*)(lds + PG8_SB(b, h) + boff + n * 2048 + 1024); dst##8[n] = __builtin_shufflevector(lo_, hi_, 0, 1, 2, 3, 4, 5, 6, 7); } \
        else { _Pragma("unroll") for (int k = 0; k < 2; ++k) dst[n][k] = *(const PG8_LAS bf16x8*)(lds + PG8_SB(b, h) + boff + n * 2048 + k * 1024); } } } while (0)
#define PG8_MMA(ai, bj, At, Bt) do { __builtin_amdgcn_s_setprio(1); _Pragma("unroll") for (int m = 0; m < 4; ++m) _Pragma("unroll") for (int n = 0; n < 2; ++n) { \
        if constexpr (F8) asm volatile("v_mfma_scale_f32_16x16x128_f8f6f4 %0, %1, %2, %0, %3, %3 op_sel_hi:[0,0,0]" : "+v"(acc[ai][bj][m][n]) : "v"(Bt##8[n]), "v"(At##8[m]), "v"(f8scale)); \
        else { _Pragma("unroll") for (int k = 0; k < 2; ++k) acc[ai][bj][m][n] = __builtin_amdgcn_mfma_f32_16x16x32_bf16(Bt[n][k], At[m][k], acc[ai][bj][m][n], 0, 0, 0); } } \
        __builtin_amdgcn_s_setprio(0); } while (0)
#define PG8_WAIT_V(n) asm volatile("s_waitcnt vmcnt(" #n ")" ::: "memory")
#define PG8_WAIT_L(n) asm volatile("s_waitcnt lgkmcnt(" #n ")" ::: "memory")
#define PG8_BAR __builtin_amdgcn_s_barrier()
#define PG8_SCHED __builtin_amdgcn_sched_barrier(0)
    Unit cur, nxt; int ui = 0;
    if (!S.next(0, cur)) return;
    f32x4 acc[2][2][4][2];
#pragma unroll
    for (int a = 0; a < 2; ++a)
#pragma unroll
        for (int b = 0; b < 2; ++b)
#pragma unroll
            for (int m = 0; m < 4; ++m)
#pragma unroll
                for (int n = 0; n < 2; ++n) { acc[a][b][m][n] = (f32x4){0.f, 0.f, 0.f, 0.f}; if constexpr (F8) asm volatile("" : "+v"(acc[a][b][m][n])); }
    bf16x8 At[4][2], B0[2][2], B1[2][2];
    typedef int i32x4_ __attribute__((ext_vector_type(4))); typedef int i32x8_ __attribute__((ext_vector_type(8)));
    i32x8_ At8[4], B08[2], B18[2];
    int f8scale = 0x7f7f7f7f; asm volatile("" : "+v"(f8scale));
    const char* cA = (const char*)g.A + (size_t)cur.pm * tstep; const char* cB = (const char*)g.Bt + (size_t)cur.pn * tstep;
    S.a_ready(cur);
    if constexpr (SP2) {
        PG8_STAGE(PG8_SB(0, 0), cB, voffB); PG8_STAGE(PG8_SB(0, 1), cB + hstep, voffB); PG8_STAGE(PG8_SA(0, 0), cA, voffA); PG8_STAGE(PG8_SA(0, 1), cA + hstep, voffA);
        if (wr == 1) PG8_BAR;
        PG8_WAIT_V(2); PG8_BAR;
        PG8_STAGE(PG8_SB(1, 0), cB + kstep, voffB); PG8_STAGE(PG8_SA(1, 0), cA + kstep, voffA); PG8_STAGE(PG8_SB(1, 1), cB + hstep + kstep, voffB);
        PG8_WAIT_V(6); PG8_BAR;
    } else {
        PG8_STAGE(PG8_SB(0, 0), cB, voffB); PG8_STAGE(PG8_SA(0, 0), cA, voffA); PG8_STAGE(PG8_SB(0, 1), cB + hstep, voffB); PG8_STAGE(PG8_SA(0, 1), cA + hstep, voffA);
        if (wr == 1) PG8_BAR;
        PG8_WAIT_V(4); PG8_BAR;
        PG8_STAGE(PG8_SB(1, 0), cB + kstep, voffB); PG8_STAGE(PG8_SA(1, 0), cA + kstep, voffA); PG8_STAGE(PG8_SB(1, 1), cB + hstep + kstep, voffB);
        PG8_WAIT_V(6); PG8_BAR;
    }
    for (;;) {
        const bool has_next = S.next(ui + 1, nxt);
        const char* nA = has_next ? (const char*)g.A + (size_t)nxt.pm * tstep : cA; const char* nB = has_next ? (const char*)g.Bt + (size_t)nxt.pn * tstep : cB;
        for (int t = 0; t < nt; t += 2) {
            const bool last = (t == nt - 2);
            const char* a1 = cA + (size_t)(t + 1) * kstep;
            const char* a2 = last ? nA : cA + (size_t)(t + 2) * kstep; const char* b2 = last ? nB : cB + (size_t)(t + 2) * kstep;
            const char* a3 = a2 + kstep; const char* b3 = b2 + kstep;
            if (last && has_next) S.a_ready(nxt);
            if constexpr (SP2) {
            PG8_LDB(B0, 0, 0); PG8_LDB(B1, 0, 1); PG8_SCHED; PG8_LDA(At, 0, 0); PG8_STAGE(PG8_SA(1, 1), a1 + hstep, voffA);
            PG8_WAIT_V(8); PG8_WAIT_L(0); PG8_BAR; PG8_MMA(0, 0, At, B0); PG8_MMA(0, 1, At, B1); PG8_BAR; PG8_SCHED;
            PG8_LDA(At, 0, 1); PG8_STAGE(PG8_SB(0, 0), b2, voffB); PG8_STAGE(PG8_SB(0, 1), b2 + hstep, voffB); PG8_STAGE(PG8_SA(0, 0), a2, voffA);
            PG8_WAIT_V(8); PG8_WAIT_L(0); PG8_BAR; PG8_MMA(1, 0, At, B0); PG8_MMA(1, 1, At, B1); PG8_BAR; PG8_SCHED;
            PG8_LDB(B0, 1, 0); PG8_LDB(B1, 1, 1); PG8_SCHED; PG8_LDA(At, 1, 0); PG8_STAGE(PG8_SA(0, 1), a2 + hstep, voffA);
            PG8_WAIT_V(8); PG8_WAIT_L(0); PG8_BAR; PG8_MMA(0, 0, At, B0); PG8_MMA(0, 1, At, B1); PG8_BAR; PG8_SCHED;
            PG8_LDA(At, 1, 1); PG8_STAGE(PG8_SB(1, 0), b3, voffB); PG8_STAGE(PG8_SB(1, 1), b3 + hstep, voffB); PG8_STAGE(PG8_SA(1, 0), a3, voffA);
            PG8_WAIT_V(8); PG8_WAIT_L(0); PG8_BAR; PG8_MMA(1, 0, At, B0); PG8_MMA(1, 1, At, B1); PG8_BAR; PG8_SCHED;
            } else {
            PG8_LDB(B0, 0, 0); PG8_SCHED; PG8_LDA(At, 0, 0); PG8_STAGE(PG8_SA(1, 1), a1 + hstep, voffA);
            PG8_WAIT_L(8); PG8_BAR; PG8_WAIT_L(0); PG8_MMA(0, 0, At, B0); PG8_BAR; PG8_SCHED;
            PG8_LDB(B1, 0, 1); PG8_STAGE(PG8_SB(0, 0), b2, voffB);
            PG8_BAR; PG8_WAIT_L(0); PG8_MMA(0, 1, At, B1); PG8_BAR;
            PG8_LDA(At, 0, 1); PG8_STAGE(PG8_SA(0, 0), a2, voffA);
            PG8_BAR; PG8_WAIT_L(0); PG8_MMA(1, 0, At, B0); PG8_BAR; PG8_SCHED;
            PG8_STAGE(PG8_SB(0, 1), b2 + hstep, voffB);
            PG8_WAIT_V(6); PG8_BAR; PG8_MMA(1, 1, At, B1); PG8_BAR;
            PG8_LDB(B0, 1, 0); PG8_SCHED; PG8_LDA(At, 1, 0); PG8_STAGE(PG8_SA(0, 1), a2 + hstep, voffA);
            PG8_WAIT_L(8); PG8_BAR; PG8_WAIT_L(0); PG8_MMA(0, 0, At, B0); PG8_BAR; PG8_SCHED;
            PG8_LDB(B1, 1, 1); PG8_STAGE(PG8_SB(1, 0), b3, voffB);
            PG8_BAR; PG8_WAIT_L(0); PG8_MMA(0, 1, At, B1); PG8_BAR;
            PG8_LDA(At, 1, 1); PG8_STAGE(PG8_SA(1, 0), a3, voffA);
            PG8_BAR; PG8_WAIT_L(0); PG8_MMA(1, 0, At, B0); PG8_BAR; PG8_SCHED;
            PG8_STAGE(PG8_SB(1, 1), b3 + hstep, voffB);
            PG8_WAIT_V(6); PG8_BAR; PG8_MMA(1, 1, At, B1); PG8_BAR;
            }
        }
        if constexpr (F8) asm volatile("s_nop 15\n\ts_nop 15" ::: "memory");
        if constexpr (ALIGN_EPI) { if (wr == 0) PG8_BAR; }
        if constexpr (!Epi::AFTER_DRAIN) { E(acc, cur, wr, wc, fr, fq); S.done(cur); }
        if (!has_next) break;
#pragma unroll
        for (int a = 0; a < 2; ++a)
#pragma unroll
            for (int b = 0; b < 2; ++b)
#pragma unroll
                for (int m = 0; m < 4; ++m)
#pragma unroll
                    for (int n = 0; n < 2; ++n) { acc[a][b][m][n] = (f32x4){0.f, 0.f, 0.f, 0.f}; if constexpr (F8) asm volatile("" : "+v"(acc[a][b][m][n])); }
        cur = nxt; cA = nA; cB = nB; ++ui;
        if constexpr (ALIGN_EPI) { if (wr == 1) PG8_BAR; }
    }
    PG8_WAIT_V(0);
    if constexpr (!ALIGN_EPI) { if (wr == 0) PG8_BAR; }
    PG8_BAR;
    if constexpr (Epi::AFTER_DRAIN) { E.fused(acc, cur, wr, wc, fr, fq, lds, wid, lane); S.done(cur); }
#undef PG8_SA
#undef PG8_SB
#undef PG8_STAGE
#undef PG8_LDA
#undef PG8_LDB
#undef PG8_MMA
#undef PG8_WAIT_V
#undef PG8_WAIT_L
#undef PG8_BAR
#undef PG8_SCHED
}
}
#define LAS __attribute__((address_space(3)))
#define XB_TMO      128
#define XB_XCNT(j)  (256  + 64 * (j))
#define XB_XSUB(j)  (1280 + 64 * (j))
#define XB_XGEN(j)  (2304 + 64 * (j))
#define XB_TOP      3328
#define XB_TOPGEN   3392
#define XCD_BAR_WORDS 3456
#define XB_SPIN_CAP (1u << 18)

__device__ __forceinline__ unsigned xb_ld(unsigned* p)              { return __hip_atomic_load(p, __ATOMIC_RELAXED, __HIP_MEMORY_SCOPE_AGENT); }
__device__ __forceinline__ unsigned xb_add(unsigned* p, unsigned v) { return __hip_atomic_fetch_add(p, v, __ATOMIC_RELAXED, __HIP_MEMORY_SCOPE_AGENT); }
__device__ __forceinline__ unsigned xb_xcc_id() { return (unsigned)__builtin_amdgcn_s_getreg((3 << 11) | 20) & 0xFu; }
#define XB_SPIN(cond, bar) do { unsigned _sp = 0; while (cond) { __builtin_amdgcn_s_sleep(1); \
    if ((++_sp & 255u) == 0u) { if (xb_ld(&(bar)[XB_TMO])) break; if (_sp > XB_SPIN_CAP) { atomicAdd(&(bar)[XB_TMO], 1u); break; } } } } while (0)

struct XcdBarrier {
    unsigned* bar; unsigned x;
    volatile LAS unsigned* st;
};

__device__ __forceinline__ XcdBarrier xcd_barrier_post(unsigned* bar, volatile LAS unsigned* st) {
    XcdBarrier b; b.bar = bar; b.x = xb_xcc_id(); b.st = st;
    if (threadIdx.x == 0) (void)xb_add(&bar[XB_XCNT(b.x)], 1u);
    return b;
}
__device__ __forceinline__ void xcd_barrier_complete(unsigned* bar, unsigned x, unsigned& nloc, unsigned& nx) {
    const unsigned G = gridDim.x * gridDim.y * gridDim.z;
    unsigned sum, cnt, mine, sp = 0u;
    for (;;) {
        sum = 0u; cnt = 0u; mine = 0u;
#pragma unroll
        for (unsigned j = 0; j < 16; ++j) { const unsigned c = xb_ld(&bar[XB_XCNT(j)]); sum += c; cnt += (c > 0u) ? 1u : 0u; mine = (j == x) ? c : mine; }
        if (sum == G) break;
        __builtin_amdgcn_s_sleep(1);
        if ((++sp & 255u) == 0u) { if (xb_ld(&bar[XB_TMO])) break; if (sp > XB_SPIN_CAP) { atomicAdd(&bar[XB_TMO], 1u); break; } }
    }
    nloc = mine > 0u ? mine : 1u; nx = cnt > 0u ? cnt : 1u;
}

__device__ __forceinline__ void xcd_barrier(const XcdBarrier& b) {
    asm volatile("s_waitcnt vmcnt(0)" ::: "memory");
    __syncthreads();
    if (threadIdx.x == 0) {
        unsigned* bar = b.bar;
        __builtin_amdgcn_s_waitcnt(0);
        unsigned nloc = b.st[0], nx = b.st[1];
        if (nloc == 0u) { xcd_barrier_complete(bar, b.x, nloc, nx); b.st[0] = nloc; b.st[1] = nx; }
        const unsigned old = xb_add(&bar[XB_XSUB(b.x)], 1u);
        const unsigned gen = old / nloc;
        if (old + 1u == (gen + 1u) * nloc) {
            __builtin_amdgcn_fence(__ATOMIC_RELEASE, "agent");
            asm volatile("s_waitcnt vmcnt(0)" ::: "memory");
            const unsigned og = xb_add(&bar[XB_TOP], 1u);
            const unsigned tg = og / nx;
            if (og + 1u == (tg + 1u) * nx) xb_add(&bar[XB_TOPGEN], 1u);
            else XB_SPIN(xb_ld(&bar[XB_TOPGEN]) == tg, bar);
            __builtin_amdgcn_fence(__ATOMIC_ACQUIRE, "agent");
            xb_add(&bar[XB_XGEN(b.x)], 1u);
            asm volatile("s_waitcnt vmcnt(0)" ::: "memory");
        } else {
            XB_SPIN(xb_ld(&bar[XB_XGEN(b.x)]) == gen, bar);
            __builtin_amdgcn_fence(__ATOMIC_ACQUIRE, "agent");
            asm volatile("s_waitcnt vmcnt(0)" ::: "memory");
        }
    }
    __syncthreads();
}

#define DI __device__ __forceinline__
#define LDS_WAIT() asm volatile("s_waitcnt lgkmcnt(0)" ::: "memory")
typedef unsigned short bf16;
typedef float f32x4 __attribute__((ext_vector_type(4)));

namespace mk {
constexpr int NB = 8, SEQ = 2048, DM = 1024, NT = NB * SEQ, NL = 2;
constexpr int INW = 3856, ZLD = 4096;
constexpr int ZA = 0, ZRKV = 768, ZWDF = 1920, ZWDB = 1984, ZADF = 2048, ZADB = 2112, ZGD = 2176, ZMQK = 2304, ZMV = 3072, ZMO = 3456, ZMG = 3840;
constexpr int RW = 384, MW = 384, AW = 256;
constexpr int NE = 16, CAP = 256, FF = 2816, NSLOT = NB * NE * CAP;
constexpr int NWAVES = 8, NTHR = 512;
constexpr float RMS_EPS = 1e-6f;

enum { I_X = 0, I_RELB, I_LN1G, I_WIN, I_WOUT, I_MU, I_W0, I_W2, I_A0, I_A2, I_KK, I_KA, I_RK, I_G2, I_RLNG, I_RLNB,
       I_CW, I_CB, I_IB, I_FB, I_MLNG, I_LN2G, I_ROUTER, I_EW1, I_EW3, I_EW2, I_FG, N_IN };

constexpr size_t MiB = 1u << 20;
constexpr size_t WS_CTL = 0, CTL_ZERO_BYTES = 1 * MiB;
constexpr size_t WS_WTIN = 2 * MiB;
constexpr size_t WS_WTOUT = 18 * MiB;
constexpr size_t WS_W13T = 22 * MiB;
constexpr size_t WS_W2T = 374 * MiB;
constexpr size_t WS_X1 = 550 * MiB;
constexpr size_t WS_X2 = 614 * MiB;
constexpr size_t WS_HB = 678 * MiB;
constexpr size_t WS_AFF = 710 * MiB;
constexpr size_t WS_SEL = 711 * MiB;
constexpr size_t WS_GATE = 712 * MiB;
constexpr size_t WS_G2T = 713 * MiB;
constexpr size_t WS_LWT = 713 * MiB + 256 * 1024;
constexpr size_t WS_R = 714 * MiB;
constexpr size_t WS_Z = WS_R;
constexpr size_t WS_ATTO = WS_R + 128 * MiB;
constexpr size_t WS_ATTL = WS_R + 152 * MiB;
constexpr size_t WS_PR = WS_R + 154 * MiB;
constexpr size_t WS_RKY = WS_R + 442 * MiB;
constexpr size_t WS_RKB = WS_R + 490 * MiB;
constexpr size_t WS_MLQK = WS_R + 538 * MiB;
constexpr size_t WS_MLNUM = WS_R + 586 * MiB;
constexpr size_t WS_MLDEN = WS_R + 634 * MiB;
constexpr size_t WS_XG = WS_R;
constexpr size_t WS_ACT = WS_R + 64 * MiB;
constexpr size_t WS_YS = WS_R + 240 * MiB;
constexpr size_t WS_END = WS_R + 636 * MiB;

constexpr int CW_BAR = 4096;
constexpr int LDS_BYTES = 147456;
constexpr int MISC_OFF = LDS_BYTES - 256;

struct Args { const float* in[N_IN]; float* out; unsigned char* ws; int ph_lo, ph_hi; };

DI float bf2f(unsigned v) { return __uint_as_float(v << 16); }
DI unsigned f2bf(float f) { unsigned u = __float_as_uint(f); return (u + 0x7fffu + ((u >> 16) & 1u)) >> 16; }
DI unsigned pk2(float lo, float hi) { return f2bf(lo) | (f2bf(hi) << 16); }
DI float wave_sum(float v) {
#pragma unroll
    for (int o = 1; o < 64; o <<= 1) v += __shfl_xor(v, o);
    return v;
}
DI float sigm(float x) { return 1.f / (1.f + __expf(-x)); }
DI void unpack8(const uint4 w, float (&f)[8]) {
    f[0] = __uint_as_float(w.x << 16); f[1] = __uint_as_float(w.x & 0xffff0000u); f[2] = __uint_as_float(w.y << 16); f[3] = __uint_as_float(w.y & 0xffff0000u);
    f[4] = __uint_as_float(w.z << 16); f[5] = __uint_as_float(w.z & 0xffff0000u); f[6] = __uint_as_float(w.w << 16); f[7] = __uint_as_float(w.w & 0xffff0000u);
}

struct GroupOrder {
    int G, c2, nunits, per_e, nN;
    DI void init(int nN_, int G_, int bid) { nN = nN_; per_e = 8 * nN_; nunits = NE * per_e; G = G_; c2 = (G_ % 8 == 0) ? (bid % 8) * (G_ / 8) + bid / 8 : bid; }
    DI bool next(int i, pg8::Unit& u) const {
        const long L = (long)i * G + c2; if (L >= nunits) return false;
        const int e = (int)L / per_e, r = (int)L % per_e; u.pm = e * 8 + (r & 7); u.pn = e * nN + (r >> 3); return true;
    }
    DI void a_ready(const pg8::Unit&) const {}
    DI void done(const pg8::Unit&) const {}
};
struct EpiResF32 {
    static constexpr bool PERM = false, AFTER_DRAIN = false;
    const float* base; float* out; int ldc;
    DI void operator()(const pg8::f32x4 (&acc)[2][2][4][2], const pg8::Unit& u, int wr, int wc, int fr, int fq) const {
        const int row0 = u.pm * 256 + wr * 64 + fr, col0 = u.pn * 256 + wc * 32 + 4 * fq;
#pragma unroll
        for (int ai = 0; ai < 2; ++ai)
#pragma unroll
            for (int m = 0; m < 4; ++m) { const size_t off = (size_t)(row0 + ai * 128 + m * 16) * ldc + col0;
#pragma unroll
                for (int bj = 0; bj < 2; ++bj)
#pragma unroll
                    for (int n = 0; n < 2; ++n) { const pg8::f32x4 b = *(const pg8::f32x4*)(base + off + bj * 128 + n * 16); *(pg8::f32x4*)(out + off + bj * 128 + n * 16) = b + acc[ai][bj][m][n]; } }
    }
};
DI float silu_f(float x) { return x * __builtin_amdgcn_rcpf(1.f + __expf(-x)); }
DI float f8clamp(float x) { return __builtin_amdgcn_fmed3f(x, -448.f, 448.f); }
DI unsigned pk4_fp8(float a, float b, float c, float d) { unsigned p = 0u; p = __builtin_amdgcn_cvt_pk_fp8_f32(f8clamp(a), f8clamp(b), p, false); p = __builtin_amdgcn_cvt_pk_fp8_f32(f8clamp(c), f8clamp(d), p, true); return p; }
constexpr float F8_WSC = 64.f, F8_HSC = 8.f, F8_ASC = 16.f;
struct EpiSwiGLU {
    static constexpr bool PERM = true, AFTER_DRAIN = false;
    unsigned char* act; int nN;
    DI void operator()(const pg8::f32x4 (&acc)[2][2][4][2], const pg8::Unit& u, int wr, int wc, int fr, int fq) const {
        const int lpn = u.pn % nN; const int row0 = u.pm * 256 + wr * 64 + fr, col0 = lpn * 128 + wc * 32 + 8 * fq; constexpr float is = 1.f / (F8_HSC * F8_WSC);
#pragma unroll
        for (int ai = 0; ai < 2; ++ai)
#pragma unroll
            for (int m = 0; m < 4; ++m) { unsigned char* p = act + (size_t)(row0 + ai * 128 + m * 16) * FF + col0;
                const pg8::f32x4 a0 = acc[ai][0][m][0] * is, a1 = acc[ai][0][m][1] * is, g0 = acc[ai][1][m][0] * (is * F8_ASC), g1 = acc[ai][1][m][1] * (is * F8_ASC);
                uint2 w; w.x = pk4_fp8(silu_f(a0[0]) * g0[0], silu_f(a0[1]) * g0[1], silu_f(a0[2]) * g0[2], silu_f(a0[3]) * g0[3]);
                w.y = pk4_fp8(silu_f(a1[0]) * g1[0], silu_f(a1[1]) * g1[1], silu_f(a1[2]) * g1[2], silu_f(a1[3]) * g1[3]);
                *(uint2*)p = w; }
    }
};
struct EpiGate {
    static constexpr bool PERM = true, AFTER_DRAIN = false;
    bf16* ys; const float* gate;
    DI void operator()(const pg8::f32x4 (&acc)[2][2][4][2], const pg8::Unit& u, int wr, int wc, int fr, int fq) const {
        const int row0 = u.pm * 256 + wr * 64 + fr, col0 = (u.pn & 3) * 256 + wc * 32 + 8 * fq;
#pragma unroll
        for (int ai = 0; ai < 2; ++ai)
#pragma unroll
            for (int m = 0; m < 4; ++m) { const int row = row0 + ai * 128 + m * 16; const float g = gate[row] * (1.f / (F8_ASC * F8_WSC)); bf16* p = ys + (size_t)row * DM + col0;
#pragma unroll
                for (int bj = 0; bj < 2; ++bj) { const pg8::f32x4 v0 = acc[ai][bj][m][0] * g, v1 = acc[ai][bj][m][1] * g; pg8::u32x4 w;
                    w.x = pg8::cvt_pk_bf16(v0[0], v0[1]); w.y = pg8::cvt_pk_bf16(v0[2], v0[3]); w.z = pg8::cvt_pk_bf16(v1[0], v1[1]); w.w = pg8::cvt_pk_bf16(v1[2], v1[3]);
                    *(pg8::u32x4*)(p + bj * 128) = w; } }
    }
};

DI void cvt_tile(const float* W, int N, int nvalid, int k0, int n0, bf16* dst, int Kd, size_t drow0, LAS float* scr, int lane) {
    const int c4 = (lane & 15) * 4, kr = lane >> 4;
#pragma unroll
    for (int it = 0; it < 16; ++it) { const int k = it * 4 + kr; float4 v = make_float4(0.f, 0.f, 0.f, 0.f);
        if (n0 + c4 < nvalid) v = *(const float4*)(W + (size_t)(k0 + k) * N + n0 + c4);
        LAS float* s = scr + k * 65 + c4; s[0] = v.x; s[1] = v.y; s[2] = v.z; s[3] = v.w; }
    LDS_WAIT(); asm volatile("" ::: "memory");
    const int c = lane & 7;
#pragma unroll
    for (int it = 0; it < 8; ++it) { const int n = it * 8 + (lane >> 3); const LAS float* s = scr + (8 * c) * 65 + n;
        uint4 o; o.x = pk2(s[0], s[65]); o.y = pk2(s[130], s[195]); o.z = pk2(s[260], s[325]); o.w = pk2(s[390], s[455]);
        *(uint4*)(dst + (drow0 + n) * (size_t)Kd + k0 + 8 * c) = o; }
    LDS_WAIT(); asm volatile("" ::: "memory");
}
DI void cvt_tile_fp8(const float* W, int N, int k0, int n0, unsigned char* dst, int Kd, size_t drow0, float sc, LAS float* scr, int lane) {
    const int c4 = (lane & 7) * 4, kr = lane >> 3;
#pragma unroll
    for (int it = 0; it < 16; ++it) { const int k = it * 8 + kr; const f32x4 v = __builtin_nontemporal_load((const f32x4*)(W + (size_t)(k0 + k) * N + n0 + c4));
        LAS float* s = scr + k * 33 + c4; s[0] = v.x * sc; s[1] = v.y * sc; s[2] = v.z * sc; s[3] = v.w * sc; }
    LDS_WAIT(); asm volatile("" ::: "memory");
    const int c = lane & 7;
#pragma unroll
    for (int it = 0; it < 4; ++it) { const int n = it * 8 + (lane >> 3); const LAS float* s = scr + (16 * c) * 33 + n;
        uint4 o; o.x = pk4_fp8(s[0], s[33], s[66], s[99]); o.y = pk4_fp8(s[132], s[165], s[198], s[231]); o.z = pk4_fp8(s[264], s[297], s[330], s[363]); o.w = pk4_fp8(s[396], s[429], s[462], s[495]);
        *(uint4*)(dst + (drow0 + n) * (size_t)Kd + k0 + 16 * c) = o; }
    LDS_WAIT(); asm volatile("" ::: "memory");
}
DI void phase_p0(const Args& A, LAS unsigned char* lds, int it0, int it1, int gw, int ngw, int wave, int lane) {
    LAS float* scr = (LAS float*)(lds + wave * 16896);
    bf16* wtin = (bf16*)(A.ws + WS_WTIN); bf16* wtout = (bf16*)(A.ws + WS_WTOUT); unsigned char* w13 = A.ws + WS_W13T; unsigned char* w2t = A.ws + WS_W2T;
    constexpr int I_IN = NL * 16 * 64, I_OUT = NL * 16 * 16, I_E = 16 * 44, I_MOE = NL * NE * 3 * I_E;
    for (int it = it0 + gw; it < it1; it += ngw) {
        int r = it;
        if (r < I_IN) { const int l = r / 1024, t = r % 1024, kb = t / 64, nb = t % 64;
            cvt_tile(A.in[I_WIN] + (size_t)l * DM * INW, INW, INW, kb * 64, nb * 64, wtin + (size_t)l * ZLD * DM, DM, (size_t)nb * 64, scr, lane); continue; }
        r -= I_IN;
        if (r < I_OUT) { const int l = r / 256, t = r % 256, kb = t / 16, nb = t % 16;
            cvt_tile(A.in[I_WOUT] + (size_t)l * DM * DM, DM, DM, kb * 64, nb * 64, wtout + (size_t)l * DM * DM, DM, (size_t)nb * 64, scr, lane); continue; }
        r -= I_OUT;
        const int le = r / (3 * I_E), q = r % (3 * I_E), which = q / I_E, t = q % I_E;
        if (which < 2) { const int kb = t / 88, nb = t % 88, n0 = nb * 32;
            cvt_tile_fp8(A.in[which == 0 ? I_EW1 : I_EW3] + (size_t)le * DM * FF, FF, kb * 128, n0, w13 + (size_t)le * 5632 * DM, DM, (size_t)((n0 >> 7) * 256 + which * 128 + (n0 & 127)), F8_WSC, scr, lane); }
        else { const int kb = t / 32, nb = t % 32;
            cvt_tile_fp8(A.in[I_EW2] + (size_t)le * FF * DM, DM, kb * 128, nb * 32, w2t + (size_t)le * DM * FF, FF, (size_t)nb * 32, F8_WSC, scr, lane); }
    }
    if (it0 == 0) { bf16* g2t = (bf16*)(A.ws + WS_G2T);
        for (int idx = gw * 64 + lane; idx < NL * 128 * RW; idx += ngw * 64) { const int col = idx % RW, j = (idx / RW) % 128, l = idx / (128 * RW); g2t[((size_t)l * RW + col) * 128 + j] = (bf16)f2bf(A.in[I_G2][idx]); } }
}

DI void load_row(const float* xrow, int lane, f32x4 (&v)[4]) {
    const f32x4* xr = (const f32x4*)xrow + lane;
#pragma unroll
    for (int j = 0; j < 4; ++j) v[j] = xr[64 * j];
}
DI void add_slots(const Args& A, int tok, int lane, f32x4 (&v)[4]) {
    const int* sel = (const int*)(A.ws + WS_SEL); const bf16* ys = (const bf16*)(A.ws + WS_YS);
    const int b = tok / SEQ; const int mys = (lane < NE) ? sel[(size_t)tok * NE + lane] : -1;
    for (int e = 0; e < NE; ++e) { const int r = __shfl(mys, e);
        if (r >= 0) { const uint2* p = (const uint2*)(ys + (size_t)((e * NB + b) * CAP + r) * DM) + lane;
#pragma unroll
            for (int j = 0; j < 4; ++j) { const uint2 w = p[64 * j]; v[j][0] += __uint_as_float(w.x << 16); v[j][1] += __uint_as_float(w.x & 0xffff0000u); v[j][2] += __uint_as_float(w.y << 16); v[j][3] += __uint_as_float(w.y & 0xffff0000u); } } }
}
DI float row_rstd(const f32x4 (&v)[4]) {
    float s = 0.f;
#pragma unroll
    for (int j = 0; j < 4; ++j) s += (v[j][0] * v[j][0] + v[j][1] * v[j][1]) + (v[j][2] * v[j][2] + v[j][3] * v[j][3]);
    return rsqrtf(wave_sum(s) * (1.f / DM) + RMS_EPS);
}
DI unsigned pkbf(float lo, float hi) { typedef __bf16 b2 __attribute__((ext_vector_type(2))); typedef float f2 __attribute__((ext_vector_type(2))); const f2 v = {lo, hi}; return __builtin_bit_cast(unsigned, __builtin_convertvector(v, b2)); }
DI void phase_ln1(const Args& A, int l, int gw, int ngw, int lane) {
    const float* xin = (l == 0) ? A.in[I_X] : (const float*)(A.ws + WS_X1); float* x2 = (float*)(A.ws + WS_X2); bf16* hb = (bf16*)(A.ws + WS_HB);
    f32x4 gg[4];
#pragma unroll
    for (int j = 0; j < 4; ++j) gg[j] = ((const f32x4*)(A.in[I_LN1G] + (size_t)l * DM) + lane)[64 * j];
    for (int tok = gw; tok < NT; tok += 2 * ngw) {
        const int tokb = tok + ngw; const bool hb2 = tokb < NT;
        f32x4 va[4], vb[4]; load_row(xin + (size_t)tok * DM, lane, va); load_row(xin + (size_t)(hb2 ? tokb : tok) * DM, lane, vb);
        if (l > 0) { add_slots(A, tok, lane, va); add_slots(A, hb2 ? tokb : tok, lane, vb);
            f32x4* oa = (f32x4*)(x2 + (size_t)tok * DM) + lane; f32x4* ob = (f32x4*)(x2 + (size_t)tokb * DM) + lane;
#pragma unroll
            for (int j = 0; j < 4; ++j) { oa[64 * j] = va[j]; if (hb2) ob[64 * j] = vb[j]; } }
        const float ra = row_rstd(va), rb = row_rstd(vb); uint2* o8a = (uint2*)(hb + (size_t)tok * DM) + lane; uint2* o8b = (uint2*)(hb + (size_t)tokb * DM) + lane;
#pragma unroll
        for (int j = 0; j < 4; ++j) { uint2 w; w.x = pkbf(va[j][0] * ra * gg[j][0], va[j][1] * ra * gg[j][1]); w.y = pkbf(va[j][2] * ra * gg[j][2], va[j][3] * ra * gg[j][3]); o8a[64 * j] = w;
            if (hb2) { uint2 u; u.x = pkbf(vb[j][0] * rb * gg[j][0], vb[j][1] * rb * gg[j][1]); u.y = pkbf(vb[j][2] * rb * gg[j][2], vb[j][3] * rb * gg[j][3]); o8b[64 * j] = u; } }
    }
}
DI void phase_final(const Args& A, int gw, int ngw, int lane) {
    const float* xin = (const float*)(A.ws + WS_X1);
    f32x4 gg[4];
#pragma unroll
    for (int j = 0; j < 4; ++j) gg[j] = ((const f32x4*)A.in[I_FG] + lane)[64 * j];
    for (int tok = gw; tok < NT; tok += 2 * ngw) {
        const int tokb = tok + ngw; const bool hb2 = tokb < NT;
        f32x4 va[4], vb[4]; load_row(xin + (size_t)tok * DM, lane, va); load_row(xin + (size_t)(hb2 ? tokb : tok) * DM, lane, vb);
        add_slots(A, tok, lane, va); add_slots(A, hb2 ? tokb : tok, lane, vb);
        const float ra = row_rstd(va), rb = row_rstd(vb); f32x4* oa = (f32x4*)(A.out + (size_t)tok * DM) + lane; f32x4* ob = (f32x4*)(A.out + (size_t)tokb * DM) + lane;
#pragma unroll
        for (int j = 0; j < 4; ++j) { oa[64 * j] = va[j] * ra * gg[j]; if (hb2) ob[64 * j] = vb[j] * rb * gg[j]; }
    }
}
DI void ln2_row(const f32x4 (&v)[4], const f32x4 (&gg)[4], const LAS float* rt, unsigned char* hrow, float* affrow, int lane) {
    const float rs = row_rstd(v); unsigned* o8 = (unsigned*)hrow + lane;
    float lg[NE];
#pragma unroll
    for (int e = 0; e < NE; ++e) lg[e] = 0.f;
#pragma unroll
    for (int j = 0; j < 4; ++j) { f32x4 h; h[0] = v[j][0] * rs * gg[j][0]; h[1] = v[j][1] * rs * gg[j][1]; h[2] = v[j][2] * rs * gg[j][2]; h[3] = v[j][3] * rs * gg[j][3];
        o8[64 * j] = pk4_fp8(h[0] * F8_HSC, h[1] * F8_HSC, h[2] * F8_HSC, h[3] * F8_HSC);
#pragma unroll
        for (int e = 0; e < NE; ++e) { const f32x4 rr = *(const LAS f32x4*)(rt + e * DM + 256 * j + 4 * lane); lg[e] += (h[0] * rr[0] + h[1] * rr[1]) + (h[2] * rr[2] + h[3] * rr[3]); }
        asm volatile("" ::: "memory"); }
    float mx = -3.0e38f;
#pragma unroll
    for (int e = 0; e < NE; ++e) { lg[e] = wave_sum(lg[e]); mx = fmaxf(mx, lg[e]); }
    float sum = 0.f;
#pragma unroll
    for (int e = 0; e < NE; ++e) { lg[e] = expf(lg[e] - mx); sum += lg[e]; }
    const float inv = 1.f / sum;
#pragma unroll
    for (int e = 0; e < NE; ++e) if (lane == e) affrow[(size_t)e * SEQ] = lg[e] * inv;
}
DI void phase_ln2(const Args& A, int l, LAS unsigned char* lds, int gw, int ngw, int tid, int lane) {
    const float* xin = (const float*)(A.ws + WS_X1); unsigned char* hb = A.ws + WS_HB; float* aff = (float*)(A.ws + WS_AFF);
    const float* router = A.in[I_ROUTER] + (size_t)l * DM * NE; LAS float* rt = (LAS float*)lds;
    __syncthreads();
    for (int i = tid; i < DM * NE; i += NTHR) rt[(i & 15) * DM + (i >> 4)] = router[i];
    __syncthreads();
    f32x4 gg[4];
#pragma unroll
    for (int j = 0; j < 4; ++j) gg[j] = ((const f32x4*)(A.in[I_LN2G] + (size_t)l * DM) + lane)[64 * j];
    for (int tok = gw; tok < NT; tok += 2 * ngw) {
        const int tokb = tok + ngw; const bool hb2 = tokb < NT;
        f32x4 va[4], vb[4]; load_row(xin + (size_t)tok * DM, lane, va); load_row(xin + (size_t)(hb2 ? tokb : tok) * DM, lane, vb);
        ln2_row(va, gg, rt, hb + (size_t)tok * DM, aff + (size_t)(tok / SEQ) * NE * SEQ + (tok % SEQ), lane);
        if (hb2) ln2_row(vb, gg, rt, hb + (size_t)tokb * DM, aff + (size_t)(tokb / SEQ) * NE * SEQ + (tokb % SEQ), lane);
    }
    __syncthreads();
}
DI void phase_topk(const Args& A, LAS unsigned char* lds, int bid, int G, int tid, int wave, int lane) {
    const unsigned* affk = (const unsigned*)(A.ws + WS_AFF); int* sel = (int*)(A.ws + WS_SEL); float* gate = (float*)(A.ws + WS_GATE);
    const unsigned char* hb = A.ws + WS_HB; unsigned char* xg = A.ws + WS_XG;
    LAS unsigned* hist = (LAS unsigned*)lds;
    LAS unsigned* wsum = hist + 32;
    LAS int* list = (LAS int*)(lds + 256);
    for (int u = bid; u < NB * NE * 2; u += G) {
        const int half = u & 1, e = (u >> 1) % NE, b = u / (2 * NE);
        __syncthreads();
        if (tid < 32) hist[tid] = 0u;
        const uint4 kv = *(const uint4*)(affk + (size_t)(b * NE + e) * SEQ + tid * 4);
        const unsigned key[4] = {kv.x, kv.y, kv.z, kv.w};
        __syncthreads();
        unsigned prefix = 0u, krem = CAP;
#pragma unroll 1
        for (int pass = 0; pass < 8; ++pass) { const int shift = 28 - 4 * pass; LAS unsigned* h = hist + (pass & 1) * 16;
            unsigned cnt = 0u;
#pragma unroll
            for (int i = 0; i < 4; ++i) { const bool cand = (pass == 0) || ((key[i] >> (shift + 4)) == prefix); const unsigned bin = (key[i] >> shift) & 15u;
#pragma unroll
                for (int v = 0; v < 16; ++v) { const unsigned long long m = __ballot(cand && bin == (unsigned)v); if (lane == v) cnt += (unsigned)__popcll(m); } }
            if (lane < 16 && cnt) atomicAdd((unsigned*)(h + lane), cnt);
            __syncthreads();
            unsigned acc = 0u, pick = 0u, before = 0u;
#pragma unroll
            for (int v = 15; v >= 0; --v) { const unsigned c = h[v]; if (acc < krem && acc + c >= krem) { pick = (unsigned)v; before = acc; } acc += c; }
            prefix = (prefix << 4) | pick; krem -= before;
            if (tid < 16) hist[((pass + 1) & 1) * 16 + tid] = 0u;
            __syncthreads();
        }
        const unsigned tau = prefix;
        unsigned gt[4], eq[4]; unsigned ngt = 0u, neq = 0u;
#pragma unroll
        for (int i = 0; i < 4; ++i) { gt[i] = key[i] > tau ? 1u : 0u; eq[i] = key[i] == tau ? 1u : 0u; ngt += gt[i]; neq += eq[i]; }
        unsigned sg = ngt, se = neq;
#pragma unroll
        for (int o = 1; o < 64; o <<= 1) { const unsigned tg = __shfl_up(sg, o), te = __shfl_up(se, o); if (lane >= o) { sg += tg; se += te; } }
        if (lane == 63) { wsum[wave] = sg; wsum[8 + wave] = se; }
        __syncthreads();
        unsigned offg = 0u, offe = 0u;
        for (int w = 0; w < wave; ++w) { offg += wsum[w]; offe += wsum[8 + w]; }
        unsigned eqbefore = offe + se - neq;
        unsigned gtbefore = offg + sg - ngt;
        const int slot0 = (e * NB + b) * CAP;
#pragma unroll
        for (int i = 0; i < 4; ++i) { const int s = tid * 4 + i; const bool selq = gt[i] || (eq[i] && eqbefore < krem);
            const unsigned pos = gtbefore + (eqbefore < krem ? eqbefore : krem);
            if ((s >> 10) == half) { sel[(size_t)(b * SEQ + s) * NE + e] = selq ? (int)pos : -1;
                if (selq) { gate[slot0 + pos] = __uint_as_float(key[i]); } }
            if (selq && pos < CAP) list[pos] = s;
            gtbefore += gt[i]; eqbefore += eq[i]; }
        __syncthreads();
        for (int r = wave; r < CAP; r += NWAVES) { const int s = list[r];
            if ((s >> 10) == half) { const uint4* src = (const uint4*)(hb + (size_t)(b * SEQ + s) * DM) + lane; uint4* dstp = (uint4*)(xg + (size_t)(slot0 + r) * DM) + lane; dstp[0] = src[0]; } }
    }
    __syncthreads();
}

DI int t5_bucket(int rel) {
    const int ret = rel > 0 ? 16 : 0; const int n = rel < 0 ? -rel : rel;
    if (n < 8) return ret + n;
    int large = 8 + (int)(logf((float)n / 8.0f) / 4.852030263919617f * 8.0f);
    large = large < 15 ? large : 15;
    return ret + large;
}

typedef short bf16x8_t __attribute__((ext_vector_type(8)));
typedef short bf16x4_t __attribute__((ext_vector_type(4)));
typedef unsigned u32x4_t __attribute__((ext_vector_type(4)));
typedef unsigned u32x2_t __attribute__((ext_vector_type(2)));
typedef __bf16 bf2_t __attribute__((ext_vector_type(2)));
typedef float f2_t __attribute__((ext_vector_type(2)));
DI unsigned cvtpk(float lo, float hi) { const f2_t v = {lo, hi}; return __builtin_bit_cast(unsigned, __builtin_convertvector(v, bf2_t)); }
#define MFMA16(a, b, c) __builtin_amdgcn_mfma_f32_16x16x32_bf16((a), (b), (c), 0, 0, 0)

constexpr int AT_QS = 0, AT_QLD = 72;
constexpr int AT_KS = AT_QS + 128 * AT_QLD * 2;
constexpr int AT_VT = AT_KS + 272 * AT_QLD * 2, AT_VLD = 280;
constexpr int AT_BT = AT_VT + 64 * AT_VLD * 2;
constexpr int AT_END = AT_BT + 132 * 4;
static_assert(AT_END <= MISC_OFF, "attention LDS");

DI void attn_unit(const Args& A, LAS unsigned char* lds, int unit, int tid, int wave, int lane) {
    const bf16* Z = (const bf16*)(A.ws + WS_Z); bf16* ao = (bf16*)(A.ws + WS_ATTO); float* al = (float*)(A.ws + WS_ATTL);
    const int x = unit & 15; int r0 = unit >> 4; const int hh = r0 & 3; r0 >>= 2; const int b = r0 % NB, br = r0 / NB;
    const int dil = br == 0 ? 1 : (br == 1 ? 4 : 16), lsub = SEQ / dil, nblk = lsub / 128;
    const int res = x / nblk, nbk = x % nblk, l0 = nbk * 128, wbase = l0 - 64;
    LAS bf16* Qs = (LAS bf16*)(lds + AT_QS); LAS bf16* Ks = (LAS bf16*)(lds + AT_KS); LAS bf16* Vt = (LAS bf16*)(lds + AT_VT); LAS float* btab = (LAS float*)(lds + AT_BT);
    __syncthreads();
#pragma unroll
    for (int i = 0; i < 2; ++i) { const int id = tid + 512 * i, row = id >> 3, ch = id & 7; const int tok = b * SEQ + (l0 + row) * dil + res;
        *(LAS u32x4_t*)(Qs + row * AT_QLD + ch * 8) = *(const u32x4_t*)(Z + (size_t)tok * ZLD + ZA + hh * 64 + ch * 8); }
    for (int id = tid; id < 272 * 8; id += NTHR) { const int row = id >> 3, ch = id & 7; const int pos = wbase + row; u32x4_t v = (u32x4_t){0u, 0u, 0u, 0u};
        if (row < 256 && pos >= 0 && pos < lsub) v = *(const u32x4_t*)(Z + (size_t)(b * SEQ + pos * dil + res) * ZLD + ZA + 256 + hh * 64 + ch * 8);
        *(LAS u32x4_t*)(Ks + row * AT_QLD + ch * 8) = v; }
    for (int id = tid; id < 272 * 8; id += NTHR) { const int key = id % 272, ch = id / 272; const int pos = wbase + key; u32x4_t v = (u32x4_t){0u, 0u, 0u, 0u};
        if (key < 256 && pos >= 0 && pos < lsub) v = *(const u32x4_t*)(Z + (size_t)(b * SEQ + pos * dil + res) * ZLD + ZA + 512 + hh * 64 + ch * 8);
        LAS bf16* d = Vt + (ch * 8) * AT_VLD + key;
        d[0] = (bf16)(v.x & 0xffffu); d[AT_VLD] = (bf16)(v.x >> 16); d[2 * AT_VLD] = (bf16)(v.y & 0xffffu); d[3 * AT_VLD] = (bf16)(v.y >> 16);
        d[4 * AT_VLD] = (bf16)(v.z & 0xffffu); d[5 * AT_VLD] = (bf16)(v.z >> 16); d[6 * AT_VLD] = (bf16)(v.w & 0xffffu); d[7 * AT_VLD] = (bf16)(v.w >> 16); }
    if (tid < 129) btab[tid] = A.in[I_RELB][t5_bucket((tid - 64) * dil) * 4 + hh];
    __syncthreads();
    const int fr = lane & 15, qd = lane >> 4;
    f32x4 acc[10];
    { bf16x8_t qb[2];
#pragma unroll
      for (int ks = 0; ks < 2; ++ks) qb[ks] = *(const LAS bf16x8_t*)(Qs + (16 * wave + fr) * AT_QLD + ks * 32 + 8 * qd);
#pragma unroll
      for (int j = 0; j < 10; ++j) { acc[j] = (f32x4){0.f, 0.f, 0.f, 0.f};
#pragma unroll
          for (int ks = 0; ks < 2; ++ks) { const bf16x8_t ka = *(const LAS bf16x8_t*)(Ks + (16 * (wave + j) + fr) * AT_QLD + ks * 32 + 8 * qd); acc[j] = MFMA16(ka, qb[ks], acc[j]); } } }
    const int iq = 16 * wave + fr; float mx = -1.0e30f;
#pragma unroll
    for (int j = 0; j < 10; ++j)
#pragma unroll
        for (int r = 0; r < 4; ++r) { const int kw = 16 * (wave + j) + 4 * qd + r; const int m = kw - 64 - iq; const int pos = wbase + kw;
            const bool valid = (m >= -64) && (m <= 64) && (pos >= 0) && (pos < lsub);
            const float s = valid ? acc[j][r] * 0.125f + btab[valid ? m + 64 : 0] : -1.0e30f; acc[j][r] = s; mx = fmaxf(mx, s); }
    mx = fmaxf(mx, __shfl_xor(mx, 16)); mx = fmaxf(mx, __shfl_xor(mx, 32));
    float lsum = 0.f;
#pragma unroll
    for (int j = 0; j < 10; ++j)
#pragma unroll
        for (int r = 0; r < 4; ++r) { const float p = __expf(acc[j][r] - mx); acc[j][r] = p; lsum += p; }
    lsum += __shfl_xor(lsum, 16); lsum += __shfl_xor(lsum, 32);
    f32x4 oacc[4];
#pragma unroll
    for (int d = 0; d < 4; ++d) oacc[d] = (f32x4){0.f, 0.f, 0.f, 0.f};
#pragma unroll
    for (int pp = 0; pp < 5; ++pp) {
        union { unsigned u[4]; bf16x8_t v; } pb;
        pb.u[0] = cvtpk(acc[2 * pp][0], acc[2 * pp][1]); pb.u[1] = cvtpk(acc[2 * pp][2], acc[2 * pp][3]); pb.u[2] = cvtpk(acc[2 * pp + 1][0], acc[2 * pp + 1][1]); pb.u[3] = cvtpk(acc[2 * pp + 1][2], acc[2 * pp + 1][3]);
#pragma unroll
        for (int d = 0; d < 4; ++d) { const LAS bf16* vp = Vt + (16 * d + fr) * AT_VLD + 16 * (wave + 2 * pp) + 4 * qd;
            union { bf16x4_t h[2]; bf16x8_t v; } va; va.h[0] = *(const LAS bf16x4_t*)vp; va.h[1] = *(const LAS bf16x4_t*)(vp + 16);
            oacc[d] = MFMA16(va.v, pb.v, oacc[d]); } }
    const float inv = 1.f / lsum; const int tok = b * SEQ + (l0 + iq) * dil + res;
    bf16* op = ao + ((size_t)br * NT + tok) * AW + hh * 64 + 4 * qd;
#pragma unroll
    for (int d = 0; d < 4; ++d) { uint2 w; w.x = cvtpk(oacc[d][0] * inv, oacc[d][1] * inv); w.y = cvtpk(oacc[d][2] * inv, oacc[d][3] * inv); *(uint2*)(op + 16 * d) = w; }
    if (qd == 0) al[((size_t)br * NT + tok) * 4 + hh] = mx + logf(lsum);
}
DI void phase_attn(const Args& A, LAS unsigned char* lds, int bid, int G, int tid, int wave, int lane) {
    for (int u = bid; u < 3 * NB * 4 * 16; u += G) attn_unit(A, lds, u, tid, wave, lane);
    __syncthreads();
}


constexpr int ML_QLD = 104, ML_SLD = 72;
constexpr int ML_QS = 0;
constexpr int ML_QT = ML_QS + 64 * ML_QLD * 2;
constexpr int ML_KS = ML_QT + 64 * ML_QLD * 2;
constexpr int ML_KT = ML_KS + 64 * ML_QLD * 2;
constexpr int ML_VT = ML_KT + 96 * ML_SLD * 2;
constexpr int ML_WS = ML_VT + 112 * ML_SLD * 2;
constexpr int ML_CT = ML_WS + 64 * ML_SLD * 2;
constexpr int ML_CW = ML_CT + 112 * ML_QLD * 2;
constexpr int ML_END = ML_CW + 6 * 192 * 4;
static_assert(ML_END <= MISC_OFF, "mlstm LDS");

constexpr int MLP_QF = 0, MLP_NI = 12288, MLP_U = 26624, MLP_DEC = 48128, MLP_BYTES = 48384;
constexpr size_t WS_MLPKG = WS_R + 304 * MiB;
static_assert(WS_MLPKG + (size_t)2 * NB * 4 * 32 * MLP_BYTES <= WS_RKY, "mlstm package region");

struct M1Regs { u32x4_t zc[15]; u32x2_t vv[3]; float gi, gf; };
DI void mlstm_m1_fetch(const Args& A, int item, int tid, int lane, M1Regs& R) {
    const bf16* Z = (const bf16*)(A.ws + WS_Z);
    const int c = item & 31, u = item >> 5; const int dir = u / 32, b = (u % 32) / 4, hh = u % 4; const int j = tid >> 3, sub = tid & 7;
    const int tl = dir ? SEQ - 1 - (c * 64 + lane) : c * 64 + lane; const size_t tokl = (size_t)b * SEQ + tl;
    R.gi = bf2f(Z[tokl * ZLD + ZMG + dir * 8 + hh]); R.gf = bf2f(Z[tokl * ZLD + ZMG + dir * 8 + 4 + hh]);
    const int tj = dir ? SEQ - 1 - (c * 64 + j) : c * 64 + j; const size_t tokj = (size_t)b * SEQ + tj;
    const bool isk = sub >= 4; const int zcol = ZMQK + (isk ? 384 : 0) + hh * 96 + (sub & 3) * 24;
#pragma unroll
    for (int tap = 0; tap < 5; ++tap) { const int tt = tj + tap - 2; const bool ok = tt >= 0 && tt < SEQ; const u32x4_t* zp = (const u32x4_t*)(Z + ((size_t)b * SEQ + (ok ? tt : tj)) * ZLD + zcol);
#pragma unroll
        for (int q4 = 0; q4 < 3; ++q4) { const u32x4_t w = zp[q4]; R.zc[tap * 3 + q4] = ok ? w : (u32x4_t){0u, 0u, 0u, 0u}; } }
    const u32x2_t* vp = (const u32x2_t*)(Z + tokj * ZLD + ZMV + hh * 96 + sub * 12);
#pragma unroll
    for (int q2 = 0; q2 < 3; ++q2) R.vv[q2] = vp[q2];
}
DI void mlstm_m1_item(const Args& A, int l, LAS unsigned char* lds, int item, int item_next, M1Regs& R, int& hh_staged, int tid, int wave, int lane) {
    const int c = item & 31, u = item >> 5; const int dir = u / 32, hh = u % 4;
    LAS bf16* Qs = (LAS bf16*)(lds + ML_QS); LAS bf16* Qt = (LAS bf16*)(lds + ML_QT); LAS bf16* Ks = (LAS bf16*)(lds + ML_KS); LAS bf16* KtT = (LAS bf16*)(lds + ML_KT);
    LAS bf16* VtT = (LAS bf16*)(lds + ML_VT); LAS bf16* Ws = (LAS bf16*)(lds + ML_WS); LAS float* cwl = (LAS float*)(lds + ML_CW); LAS float* cbl = cwl + 5 * 192;
    const int fr = lane & 15, qd = lane >> 4;
    unsigned char* pkg = A.ws + WS_MLPKG + (size_t)item * MLP_BYTES;
    __syncthreads();
    if (hh != hh_staged) { hh_staged = hh;
        for (int i = tid; i < 5 * 192; i += NTHR) { const int tap = i / 192, ch = i % 192; cwl[i] = A.in[I_CW][(size_t)(l * 5 + tap) * 768 + (ch < 96 ? 0 : 384) + hh * 96 + (ch % 96)]; }
        for (int i = tid; i < 192; i += NTHR) cbl[i] = A.in[I_CB][(size_t)l * 768 + (i < 96 ? 0 : 384) + hh * 96 + (i % 96)];
        for (int i = tid; i < 16 * ML_SLD; i += NTHR) VtT[96 * ML_SLD + i] = (i < ML_SLD) ? (bf16)0x3F80u : (bf16)0u;
        __syncthreads(); }
    const float ibv = A.in[I_IB][(l * 2 + dir) * 4 + hh], fbv = A.in[I_FB][(l * 2 + dir) * 4 + hh];
    const int j = tid >> 3, sub = tid & 7;
    const float gi = R.gi + ibv, gf = R.gf + fbv;
    float bsum = fminf(gf, 0.f) - __logf(1.f + __expf(-fabsf(gf)));
#pragma unroll
    for (int o = 1; o < 64; o <<= 1) { const float t = __shfl_up(bsum, o); if (lane >= o) bsum += t; }
    const float bend = __shfl(bsum, 63);
    const float bj = __shfl(bsum, j), igj = __shfl(gi, j);
    { const bool isk = sub >= 4; const int c0 = (sub & 3) * 24, cl = (isk ? 96 : 0) + c0;
      float acc[24];
#pragma unroll
      for (int e = 0; e < 24; ++e) acc[e] = cbl[cl + e];
#pragma unroll
      for (int tap = 0; tap < 5; ++tap) {
#pragma unroll
          for (int q4 = 0; q4 < 3; ++q4) { const u32x4_t w = R.zc[tap * 3 + q4]; const LAS float* cwp = cwl + tap * 192 + cl + q4 * 8;
              acc[q4 * 8 + 0] += cwp[0] * __uint_as_float(w.x << 16); acc[q4 * 8 + 1] += cwp[1] * __uint_as_float(w.x & 0xffff0000u);
              acc[q4 * 8 + 2] += cwp[2] * __uint_as_float(w.y << 16); acc[q4 * 8 + 3] += cwp[3] * __uint_as_float(w.y & 0xffff0000u);
              acc[q4 * 8 + 4] += cwp[4] * __uint_as_float(w.z << 16); acc[q4 * 8 + 5] += cwp[5] * __uint_as_float(w.z & 0xffff0000u);
              acc[q4 * 8 + 6] += cwp[6] * __uint_as_float(w.w << 16); acc[q4 * 8 + 7] += cwp[7] * __uint_as_float(w.w & 0xffff0000u); } }
      const float sc1 = isk ? 0.10206207261596575f : 1.f; const float sc2 = isk ? __expf(bend - bj + igj) : __expf(bj);
#pragma unroll
      for (int e = 0; e < 24; ++e) acc[e] = acc[e] * sigm(acc[e]) * sc1;
      if (!isk) { LAS bf16* d1 = Qs + j * ML_QLD + c0; LAS bf16* d2 = Qt + j * ML_QLD + c0;
#pragma unroll
          for (int q4 = 0; q4 < 3; ++q4) { u32x4_t w; w.x = cvtpk(acc[q4 * 8 + 0], acc[q4 * 8 + 1]); w.y = cvtpk(acc[q4 * 8 + 2], acc[q4 * 8 + 3]); w.z = cvtpk(acc[q4 * 8 + 4], acc[q4 * 8 + 5]); w.w = cvtpk(acc[q4 * 8 + 6], acc[q4 * 8 + 7]);
              *(LAS u32x4_t*)(d1 + q4 * 8) = w;
              u32x4_t x; x.x = cvtpk(acc[q4 * 8 + 0] * sc2, acc[q4 * 8 + 1] * sc2); x.y = cvtpk(acc[q4 * 8 + 2] * sc2, acc[q4 * 8 + 3] * sc2); x.z = cvtpk(acc[q4 * 8 + 4] * sc2, acc[q4 * 8 + 5] * sc2); x.w = cvtpk(acc[q4 * 8 + 6] * sc2, acc[q4 * 8 + 7] * sc2);
              *(LAS u32x4_t*)(d2 + q4 * 8) = x; } }
      else { LAS bf16* d1 = Ks + j * ML_QLD + c0;
#pragma unroll
          for (int q4 = 0; q4 < 3; ++q4) { u32x4_t w; w.x = cvtpk(acc[q4 * 8 + 0], acc[q4 * 8 + 1]); w.y = cvtpk(acc[q4 * 8 + 2], acc[q4 * 8 + 3]); w.z = cvtpk(acc[q4 * 8 + 4], acc[q4 * 8 + 5]); w.w = cvtpk(acc[q4 * 8 + 6], acc[q4 * 8 + 7]);
              *(LAS u32x4_t*)(d1 + q4 * 8) = w; }
#pragma unroll
          for (int e = 0; e < 24; ++e) KtT[(c0 + e) * ML_SLD + j] = (bf16)f2bf(acc[e] * sc2); } }
    { const int n0 = sub * 12;
#pragma unroll
      for (int q2 = 0; q2 < 3; ++q2) { const u32x2_t w = R.vv[q2]; LAS bf16* d = VtT + (n0 + q2 * 4) * ML_SLD + j;
          d[0] = (bf16)(w.x & 0xffffu); d[ML_SLD] = (bf16)(w.x >> 16); d[2 * ML_SLD] = (bf16)(w.y & 0xffffu); d[3 * ML_SLD] = (bf16)(w.y >> 16); } }
    if (item_next >= 0) mlstm_m1_fetch(A, item_next, tid, lane, R);
    __syncthreads();
#pragma unroll
    for (int i = 0; i < 2; ++i) { const int tile = 2 * wave + i, jt = tile >> 2, st = tile & 3; const int jq = 16 * jt + fr;
        u32x2_t w = (u32x2_t){0u, 0u};
        if (st <= jt) { f32x4 acc = (f32x4){0.f, 0.f, 0.f, 0.f};
#pragma unroll
            for (int ks = 0; ks < 3; ++ks) { const bf16x8_t a = *(const LAS bf16x8_t*)(Ks + (16 * st + fr) * ML_QLD + 32 * ks + 8 * qd); const bf16x8_t bq = *(const LAS bf16x8_t*)(Qs + jq * ML_QLD + 32 * ks + 8 * qd); acc = MFMA16(a, bq, acc); }
            const float bjq = __shfl(bsum, jq); float wv[4];
#pragma unroll
            for (int r = 0; r < 4; ++r) { const int s = 16 * st + 4 * qd + r; const float bs = __shfl(bsum, s), igs = __shfl(gi, s); wv[r] = (s <= jq) ? acc[r] * __expf(bjq - bs + igs) : 0.f; }
            w.x = cvtpk(wv[0], wv[1]); w.y = cvtpk(wv[2], wv[3]); }
        *(LAS u32x2_t*)(Ws + jq * ML_SLD + 16 * st + 4 * qd) = w; }
    __syncthreads();
    for (int id = wave; id < 12; id += NWAVES) { const int jt = id / 3, i3 = id % 3; const LAS bf16* p = Qt + (16 * jt + fr) * ML_QLD + 32 * i3 + 4 * qd; const u32x2_t lo = *(const LAS u32x2_t*)p, hi = *(const LAS u32x2_t*)(p + 16);
        *(u32x4_t*)(pkg + MLP_QF + (size_t)id * 1024 + lane * 16) = (u32x4_t){lo.x, lo.y, hi.x, hi.y}; }
    for (int id = wave; id < 70; id += NWAVES) { f32x4 acc = (f32x4){0.f, 0.f, 0.f, 0.f}; int nt; const LAS bf16* ap; int ald; unsigned char* dst;
        if (id < 28) { const int jt = id & 3; nt = id >> 2; ap = Ws + (16 * jt + fr) * ML_SLD; ald = 0; dst = pkg + MLP_NI + (size_t)(nt * 4 + jt) * 512; }
        else { const int q = id - 28, kt = q % 6; nt = q / 6; ap = KtT + (16 * kt + fr) * ML_SLD; ald = 0; dst = pkg + MLP_U + (size_t)(nt * 6 + kt) * 512; }
#pragma unroll
        for (int ks = 0; ks < 2; ++ks) { const bf16x8_t a = *(const LAS bf16x8_t*)(ap + 32 * ks + 8 * qd); const bf16x8_t bv = *(const LAS bf16x8_t*)(VtT + (16 * nt + fr) * ML_SLD + 32 * ks + 8 * qd); acc = MFMA16(a, bv, acc); }
        u32x2_t w; w.x = cvtpk(acc[0], acc[1]); w.y = cvtpk(acc[2], acc[3]); *(u32x2_t*)(dst + lane * 8) = w; }
    if (tid < 64) ((float*)(pkg + MLP_DEC))[tid] = __expf(bend);
}
DI void phase_mlstm_m1(const Args& A, int l, LAS unsigned char* lds, int bid, int G, int tid, int wave, int lane) {
    int hh_staged = -1; constexpr int NIT = 2 * NB * 4 * 32;
    if (bid < NIT) { M1Regs R; mlstm_m1_fetch(A, bid, tid, lane, R);
        for (int it = bid; it < NIT; it += G) mlstm_m1_item(A, l, lds, it, (it + G < NIT) ? it + G : -1, R, hh_staged, tid, wave, lane); }
    __syncthreads();
}
constexpr int M2_SLOTS = 8, M2_SLOT_BYTES = 12288, M2_CTL = M2_SLOTS * M2_SLOT_BYTES;
static_assert(M2_CTL + 64 <= MISC_OFF, "mlstm m2 LDS");
DI f32x4 unpk4(const u32x2_t w) { return (f32x4){__uint_as_float(w.x << 16), __uint_as_float(w.x & 0xffff0000u), __uint_as_float(w.y << 16), __uint_as_float(w.y & 0xffff0000u)}; }
struct M2Small { u32x2_t ni[4], uu[6]; float dec; };
DI void m2_load_small(M2Small& o, const unsigned char* pkg, int nt, int lane) {
#pragma unroll
    for (int jt = 0; jt < 4; ++jt) o.ni[jt] = *(const u32x2_t*)(pkg + MLP_NI + (nt * 4 + jt) * 512 + lane * 8);
#pragma unroll
    for (int kt = 0; kt < 6; ++kt) o.uu[kt] = *(const u32x2_t*)(pkg + MLP_U + (nt * 6 + kt) * 512 + lane * 8);
    o.dec = ((const float*)(pkg + MLP_DEC))[lane];
}
DI void m2_step(const M2Small& o, const LAS unsigned char* slot, f32x4 (&C)[6], bf16* num, float* den, int dir, int b, int hh, int nt, int c, int lane, int fr, int qd) {
    union { unsigned u[4]; bf16x8_t v; } sB[3];
#pragma unroll
    for (int i = 0; i < 3; ++i) { sB[i].u[0] = cvtpk(C[2 * i][0], C[2 * i][1]); sB[i].u[1] = cvtpk(C[2 * i][2], C[2 * i][3]); sB[i].u[2] = cvtpk(C[2 * i + 1][0], C[2 * i + 1][1]); sB[i].u[3] = cvtpk(C[2 * i + 1][2], C[2 * i + 1][3]); }
#pragma unroll
    for (int jt = 0; jt < 4; ++jt) { f32x4 acc = unpk4(o.ni[jt]);
#pragma unroll
        for (int i = 0; i < 3; ++i) { const bf16x8_t qf = *(const LAS bf16x8_t*)(slot + (3 * jt + i) * 1024 + lane * 16); acc = MFMA16(qf, sB[i].v, acc); }
#pragma unroll
        for (int r = 0; r < 4; ++r) { const int jj = 16 * jt + 4 * qd + r; const int tt = dir ? SEQ - 1 - (c * 64 + jj) : c * 64 + jj; const size_t tok = (size_t)b * SEQ + tt;
            if (nt < 6) num[((size_t)dir * NT + tok) * MW + hh * 96 + 16 * nt + fr] = (bf16)f2bf(acc[r]); else if (fr == 0) den[((size_t)dir * NT + tok) * 4 + hh] = acc[r]; } }
#pragma unroll
    for (int kt = 0; kt < 6; ++kt) C[kt] = C[kt] * o.dec + unpk4(o.uu[kt]);
}
DI void mlstm_m2_unit(const Args& A, LAS unsigned char* lds, int u, int tid, int wave, int lane) {
    bf16* num = (bf16*)(A.ws + WS_MLNUM); float* den = (float*)(A.ws + WS_MLDEN);
    const int dir = u / 32, b = (u % 32) / 4, hh = u % 4; const int fr = lane & 15, qd = lane >> 4;
    const unsigned char* pkg0 = A.ws + WS_MLPKG + (size_t)u * 32 * MLP_BYTES;
    volatile LAS unsigned* ready = (volatile LAS unsigned*)(lds + M2_CTL); volatile LAS unsigned* consumed = ready + 8;
    __syncthreads();
    if (tid < 16) ready[tid] = 0u;
    __syncthreads();
    if (wave == 7) {
        u32x4_t f0[12], f1[12], f2[12];
#define M2_FETCH(dst, c_) do { _Pragma("unroll") for (int i = 0; i < 12; ++i) dst[i] = *(const u32x4_t*)(pkg0 + (size_t)(c_) * MLP_BYTES + MLP_QF + i * 1024 + lane * 16); } while (0)
#define M2_PUBLISH(src, c_) do { if ((c_) >= M2_SLOTS) { const unsigned need = (unsigned)((c_) - M2_SLOTS + 1); unsigned spins = 0; \
            for (;;) { bool ok = true; _Pragma("unroll") for (int w = 0; w < 7; ++w) ok = ok && (consumed[w] >= need); if (ok) break; if (++spins > (1u << 22)) break; __builtin_amdgcn_s_sleep(1); } } \
        LAS unsigned char* slot_ = lds + ((c_) & (M2_SLOTS - 1)) * M2_SLOT_BYTES; _Pragma("unroll") for (int i = 0; i < 12; ++i) *(LAS u32x4_t*)(slot_ + i * 1024 + lane * 16) = src[i]; \
        asm volatile("s_waitcnt lgkmcnt(0)" ::: "memory"); if (lane == 0) ready[(c_) & (M2_SLOTS - 1)] = (unsigned)((c_) + 1); asm volatile("" ::: "memory"); } while (0)
        M2_FETCH(f0, 0); M2_FETCH(f1, 1);
        for (int c = 0; c < 30; c += 3) { M2_FETCH(f2, c + 2); M2_PUBLISH(f0, c); M2_FETCH(f0, c + 3); M2_PUBLISH(f1, c + 1); M2_FETCH(f1, c + 4); M2_PUBLISH(f2, c + 2); }
        M2_PUBLISH(f0, 30); M2_PUBLISH(f1, 31);
#undef M2_FETCH
#undef M2_PUBLISH
    } else {
        const int nt = wave; f32x4 C[6];
#pragma unroll
        for (int kt = 0; kt < 6; ++kt) C[kt] = (f32x4){0.f, 0.f, 0.f, 0.f};
        M2Small s0, s1, s2, s3;
        m2_load_small(s0, pkg0, nt, lane); m2_load_small(s1, pkg0 + MLP_BYTES, nt, lane); m2_load_small(s2, pkg0 + 2 * (size_t)MLP_BYTES, nt, lane); m2_load_small(s3, pkg0 + 3 * (size_t)MLP_BYTES, nt, lane);
#define M2_CHAIN(sx, c_) do { unsigned spins = 0; while (ready[(c_) & (M2_SLOTS - 1)] != (unsigned)((c_) + 1)) { if (++spins > (1u << 22)) break; __builtin_amdgcn_s_sleep(1); } asm volatile("" ::: "memory"); \
            m2_step(sx, lds + ((c_) & (M2_SLOTS - 1)) * M2_SLOT_BYTES, C, num, den, dir, b, hh, nt, (c_), lane, fr, qd); \
            asm volatile("s_waitcnt lgkmcnt(0)" ::: "memory"); if (lane == 0) consumed[nt] = (unsigned)((c_) + 1); asm volatile("" ::: "memory"); \
            if ((c_) + 4 < 32) m2_load_small(sx, pkg0 + (size_t)((c_) + 4) * MLP_BYTES, nt, lane); } while (0)
        for (int c = 0; c < 32; c += 4) { M2_CHAIN(s0, c); M2_CHAIN(s1, c + 1); M2_CHAIN(s2, c + 2); M2_CHAIN(s3, c + 3); }
#undef M2_CHAIN
    }
    __syncthreads();
}

constexpr int PKG_BYTES = 12544;
constexpr int PK_AH = 0, PK_RH = 2048, PK_KB = 4096, PK_VV = 8192, PK_TM = 10240, PK_MM = 10752, PK_LAK = 11776, PK_GE = 12288;
constexpr size_t WS_PKG = WS_PR;
static_assert((size_t)2 * NB * 6 * 128 * PKG_BYTES <= 288 * MiB, "package region");
constexpr int R1_W2T = 0, R1_A2T = 9216, R1_WV = 18432, R1_WV_BYTES = 12928;
constexpr int R1_IMG = 0, R1_LF = 9216, R1_MT = 10368;
static_assert(R1_WV + 8 * R1_WV_BYTES <= MISC_OFF, "rwkv r1 LDS");

DI bf16x4_t pack4(const f32x4 v) { union { unsigned u[2]; bf16x4_t h; } x; x.u[0] = cvtpk(v[0], v[1]); x.u[1] = cvtpk(v[2], v[3]); return x.h; }

DI void rwkv_r1_item(const Args& A, int l, LAS unsigned char* lds, int item, int& dh_staged, int tid, int wave, int lane) {
    const bf16* Z = (const bf16*)(A.ws + WS_Z);
    const int g = item & 15; int r0 = item >> 4; const int hh = r0 % 6; r0 /= 6; const int b = r0 % NB, dir = r0 / NB;
    const int cc = 8 * g + wave, fr = lane & 15, qd = lane >> 4;
    LAS bf16* W2T = (LAS bf16*)(lds + R1_W2T); LAS bf16* A2T = (LAS bf16*)(lds + R1_A2T);
    LAS unsigned char* wv = lds + R1_WV + wave * R1_WV_BYTES;
    LAS bf16* IMG = (LAS bf16*)(wv + R1_IMG); LAS float* Lf = (LAS float*)(wv + R1_LF); LAS bf16* MT = (LAS bf16*)(wv + R1_MT);
    if (dh_staged != dir * 6 + hh) { dh_staged = dir * 6 + hh;
    __syncthreads();
    { const int ch = tid & 63, i0 = (tid >> 6) * 8; const float* w2 = A.in[I_W2] + ((size_t)(l * 2 + dir) * 64 + i0) * RW + hh * 64 + ch; const float* a2 = A.in[I_A2] + ((size_t)(l * 2 + dir) * 64 + i0) * RW + hh * 64 + ch;
      u32x4_t pw, pa; pw.x = cvtpk(w2[0], w2[RW]); pw.y = cvtpk(w2[2 * RW], w2[3 * RW]); pw.z = cvtpk(w2[4 * RW], w2[5 * RW]); pw.w = cvtpk(w2[6 * RW], w2[7 * RW]);
      pa.x = cvtpk(a2[0], a2[RW]); pa.y = cvtpk(a2[2 * RW], a2[3 * RW]); pa.z = cvtpk(a2[4 * RW], a2[5 * RW]); pa.w = cvtpk(a2[6 * RW], a2[7 * RW]);
      *(LAS u32x4_t*)(W2T + ch * 72 + i0) = pw; *(LAS u32x4_t*)(A2T + ch * 72 + i0) = pa; }
    __syncthreads(); }
    const int sgn = dir ? -1 : 1; const int tok0 = b * SEQ + (dir ? SEQ - 1 - 16 * cc : 16 * cc);
    const float* mu = A.in[I_MU] + (size_t)(l * 2 + dir) * 1280;
    float er[4][4], ek[4][4], ev[4][4], pr4[4], pk4[4], pv4[4];
    { const bool ext = (qd == 0) && (cc > 0); const size_t prow = (size_t)(ext ? tok0 - sgn : tok0 + sgn * (4 * qd)) * ZLD;
#pragma unroll
      for (int nt = 0; nt < 4; ++nt) {
#pragma unroll
          for (int r = 0; r < 4; ++r) { const bf16* zp = Z + (size_t)(tok0 + sgn * (4 * qd + r)) * ZLD + ZRKV + hh * 64 + 16 * nt + fr; er[nt][r] = bf2f(zp[0]); ek[nt][r] = bf2f(zp[RW]); ev[nt][r] = bf2f(zp[2 * RW]); }
          const bf16* zq = Z + prow + ZRKV + hh * 64 + 16 * nt + fr; pr4[nt] = bf2f(zq[0]); pk4[nt] = bf2f(zq[RW]); pv4[nt] = bf2f(zq[2 * RW]); }
      asm volatile("" : "+v"(er[0][0]), "+v"(pr4[3]));
#pragma unroll
      for (int nt = 0; nt < 4; ++nt) {
        float pr = __shfl(er[nt][3], lane - 16), pk = __shfl(ek[nt][3], lane - 16), pv = __shfl(ev[nt][3], lane - 16);
        if (qd == 0) { pr = ext ? pr4[nt] : 0.f; pk = ext ? pk4[nt] : 0.f; pv = ext ? pv4[nt] : 0.f; }
        const float mr = mu[hh * 64 + 16 * nt + fr], mk = mu[RW + hh * 64 + 16 * nt + fr], mv = mu[2 * RW + hh * 64 + 16 * nt + fr];
#pragma unroll
        for (int r = 3; r >= 0; --r) { const float qr = r ? er[nt][r - 1] : pr, qk = r ? ek[nt][r - 1] : pk, qv = r ? ev[nt][r - 1] : pv;
            er[nt][r] += mr * (qr - er[nt][r]); ek[nt][r] += mk * (qk - ek[nt][r]); ev[nt][r] += mv * (qv - ev[nt][r]); }
      } }
    bf16x8_t thA[2], adA[2];
    { const int zwd = dir ? ZWDB : ZWDF, zad = dir ? ZADB : ZADF; const bool hasp = !(cc == 0 && fr == 0);
      const bf16* zc = Z + (size_t)(tok0 + sgn * fr) * ZLD; const bf16* zq = Z + (size_t)(tok0 + sgn * (fr - 1)) * ZLD;
#pragma unroll
      for (int ks = 0; ks < 2; ++ks) { float cw[8], pw[8], ca[8], pa[8];
          unpack8(*(const uint4*)(zc + zwd + 32 * ks + 8 * qd), cw); unpack8(*(const uint4*)(zc + zad + 32 * ks + 8 * qd), ca);
          if (hasp) { unpack8(*(const uint4*)(zq + zwd + 32 * ks + 8 * qd), pw); unpack8(*(const uint4*)(zq + zad + 32 * ks + 8 * qd), pa); }
          else {
#pragma unroll
              for (int e = 0; e < 8; ++e) { pw[e] = 0.f; pa[e] = 0.f; } }
          const float* muw = mu + 1152 + 32 * ks + 8 * qd; const float* mua = mu + 1216 + 32 * ks + 8 * qd;
#pragma unroll
          for (int e = 0; e < 8; ++e) { const float xw = cw[e] + muw[e] * (pw[e] - cw[e]); cw[e] = 1.f - 2.f * __builtin_amdgcn_rcpf(1.f + __expf(2.f * xw)); ca[e] = ca[e] + mua[e] * (pa[e] - ca[e]); }
          union { unsigned u[4]; bf16x8_t v; } x, y;
#pragma unroll
          for (int e = 0; e < 4; ++e) { x.u[e] = cvtpk(cw[2 * e], cw[2 * e + 1]); y.u[e] = cvtpk(ca[2 * e], ca[2 * e + 1]); }
          thA[ks] = x.v; adA[ks] = y.v; } }
    f32x4 wl[4], al[4];
#pragma unroll
    for (int nt = 0; nt < 4; ++nt) { wl[nt] = (f32x4){0.f, 0.f, 0.f, 0.f}; al[nt] = (f32x4){0.f, 0.f, 0.f, 0.f};
#pragma unroll
        for (int ks = 0; ks < 2; ++ks) { const bf16x8_t bw = *(const LAS bf16x8_t*)(W2T + (16 * nt + fr) * 72 + 32 * ks + 8 * qd); const bf16x8_t ba = *(const LAS bf16x8_t*)(A2T + (16 * nt + fr) * 72 + 32 * ks + 8 * qd);
            wl[nt] = MFMA16(thA[ks], bw, wl[nt]); al[nt] = MFMA16(adA[ks], ba, al[nt]); } }
    float lw[4][4], alp[4][4], kap[4][4]; float ssq[4] = {0.f, 0.f, 0.f, 0.f}, bsm[4] = {0.f, 0.f, 0.f, 0.f};
#pragma unroll
    for (int nt = 0; nt < 4; ++nt) { const int ch = hh * 64 + 16 * nt + fr;
        const float w0v = A.in[I_W0][(size_t)(l * 2 + dir) * RW + ch], a0v = A.in[I_A0][(size_t)(l * 2 + dir) * RW + ch], kkw = A.in[I_KK][(size_t)l * RW + ch], kaw = A.in[I_KA][(size_t)l * RW + ch], rkw = A.in[I_RK][(size_t)l * RW + ch];
#pragma unroll
        for (int r = 0; r < 4; ++r) { const float x = w0v + wl[nt][r]; const float nx = -x; const float sp = fmaxf(nx, 0.f) + __logf(1.f + __expf(-fabsf(nx)));
            lw[nt][r] = -__expf(-sp - 0.5f);
            const float a = __builtin_amdgcn_rcpf(1.f + __expf(-(a0v + al[nt][r]))); alp[nt][r] = a;
            const float k0 = ek[nt][r]; kap[nt][r] = k0 * kkw; ek[nt][r] = k0 * (1.f + (a - 1.f) * kaw);
            ssq[r] += kap[nt][r] * kap[nt][r]; bsm[r] += er[nt][r] * ek[nt][r] * rkw; } }
#pragma unroll
    for (int r = 0; r < 4; ++r) {
#pragma unroll
        for (int o = 1; o < 16; o <<= 1) { ssq[r] += __shfl_xor(ssq[r], o); bsm[r] += __shfl_xor(bsm[r], o); }
        ssq[r] = __builtin_amdgcn_rsqf(fmaxf(ssq[r], 1e-24f)); }
    { bf16* bon = (bf16*)(A.ws + WS_RKB);
#pragma unroll
      for (int nt = 0; nt < 4; ++nt)
#pragma unroll
          for (int r = 0; r < 4; ++r) { kap[nt][r] *= ssq[r]; bon[((size_t)dir * NT + tok0 + sgn * (4 * qd + r)) * RW + hh * 64 + 16 * nt + fr] = (bf16)f2bf(bsm[r] * ev[nt][r]); } }
    unsigned char* pkg = A.ws + WS_PKG + ((size_t)((dir * NB + b) * 6 + hh) * 128 + cc) * PKG_BYTES;
    float lend[4];
    u32x2_t btf[4], ktf[4];
#pragma unroll
    for (int nt = 0; nt < 4; ++nt) { float lam[4]; lam[0] = lw[nt][0]; lam[1] = lam[0] + lw[nt][1]; lam[2] = lam[1] + lw[nt][2]; lam[3] = lam[2] + lw[nt][3];
        const float t1 = __shfl(lam[3], lane - 16), t2 = __shfl(lam[3], lane - 32), t3 = __shfl(lam[3], lane - 48);
        const float off = (qd >= 1 ? t1 : 0.f) + (qd >= 2 ? t2 : 0.f) + (qd >= 3 ? t3 : 0.f);
#pragma unroll
        for (int r = 0; r < 4; ++r) lam[r] += off;
        lend[nt] = __shfl(lam[3], 48 + fr);
        float bt4[4], kt4[4];
        float epv[4];
#pragma unroll
        for (int r = 0; r < 4; ++r) epv[r] = __expf(lam[r]);
        float ep_prev = __shfl(epv[3], lane - 16); if (qd == 0) ep_prev = 1.f;
        const float eendall = __expf(lend[nt]);
#pragma unroll
        for (int r = 0; r < 4; ++r) { const float ep = epv[r], epm = r ? epv[r - 1] : ep_prev, einv = __builtin_amdgcn_rcpf(ep), eend = eendall * einv;
            const float bb = kap[nt][r] * alp[nt][r]; const int o = (4 * qd + r) * 72 + 16 * nt + fr;
            IMG[o] = (bf16)f2bf(-kap[nt][r] * epm); IMG[1152 + o] = (bf16)f2bf(er[nt][r] * ep); IMG[2304 + o] = (bf16)f2bf(bb * einv); IMG[3456 + o] = (bf16)f2bf(ek[nt][r] * einv);
            bt4[r] = bb * eend; kt4[r] = ek[nt][r] * eend; }
        btf[nt].x = cvtpk(bt4[0], bt4[1]); btf[nt].y = cvtpk(bt4[2], bt4[3]); ktf[nt].x = cvtpk(kt4[0], kt4[1]); ktf[nt].y = cvtpk(kt4[2], kt4[3]); }
    asm volatile("s_waitcnt lgkmcnt(0)" ::: "memory");
    f32x4 Lab = (f32x4){0.f, 0.f, 0.f, 0.f}, Lak = Lab, Mrb = Lab, Mrk = Lab;
#pragma unroll
    for (int ks = 0; ks < 2; ++ks) { const int o = fr * 72 + 32 * ks + 8 * qd;
        const bf16x8_t aA = *(const LAS bf16x8_t*)(IMG + o), aR = *(const LAS bf16x8_t*)(IMG + 1152 + o), bB = *(const LAS bf16x8_t*)(IMG + 2304 + o), bK = *(const LAS bf16x8_t*)(IMG + 3456 + o);
        Lab = MFMA16(aA, bB, Lab); Lak = MFMA16(aA, bK, Lak); Mrb = MFMA16(aR, bB, Mrb); Mrk = MFMA16(aR, bK, Mrk); }
#pragma unroll
    for (int r = 0; r < 4; ++r) { const int t = 4 * qd + r; if (!(fr < t)) { Lab[r] = 0.f; Lak[r] = 0.f; } if (!(fr <= t)) { Mrb[r] = 0.f; Mrk[r] = 0.f; } Lf[t * 17 + fr] = Lab[r]; }
    asm volatile("s_waitcnt lgkmcnt(0)" ::: "memory");
    float Tc[16];
#pragma unroll
    for (int t = 0; t < 16; ++t) { float acc = (t == fr) ? 1.f : 0.f;
#pragma unroll
        for (int s = 0; s < t; ++s) acc += Lf[t * 17 + s] * Tc[s];
        Tc[t] = acc; }
    f32x4 Tm;
#pragma unroll
    for (int r = 0; r < 4; ++r) Tm[r] = qd == 0 ? Tc[r] : (qd == 1 ? Tc[4 + r] : (qd == 2 ? Tc[8 + r] : Tc[12 + r]));
#pragma unroll
    for (int r = 0; r < 4; ++r) { const int o = (4 * qd + r) * 20 + fr; MT[o] = (bf16)f2bf(Tm[r]); MT[320 + o] = (bf16)f2bf(Mrb[r]); MT[640 + o] = (bf16)f2bf(Lak[r]); MT[960 + o] = (bf16)f2bf(Mrk[r]); }
    asm volatile("s_waitcnt lgkmcnt(0)" ::: "memory");
    { const int o = fr * 20 + 4 * qd;
      const u32x2_t mrb = *(const LAS u32x2_t*)(MT + 320 + o), mrk = *(const LAS u32x2_t*)(MT + 960 + o);
      *(u32x2_t*)(pkg + PK_TM + lane * 8) = *(const LAS u32x2_t*)(MT + o); *(u32x2_t*)(pkg + PK_LAK + lane * 8) = *(const LAS u32x2_t*)(MT + 640 + o);
      *(u32x4_t*)(pkg + PK_MM + lane * 16) = (u32x4_t){mrk.x, mrk.y, mrb.x, mrb.y}; }
#pragma unroll
    for (int ks = 0; ks < 2; ++ks) { const int o = fr * 72 + 32 * ks + 4 * qd;
        const u32x2_t alo = *(const LAS u32x2_t*)(IMG + o), ahi = *(const LAS u32x2_t*)(IMG + o + 16), rlo = *(const LAS u32x2_t*)(IMG + 1152 + o), rhi = *(const LAS u32x2_t*)(IMG + 1152 + o + 16);
        *(u32x4_t*)(pkg + PK_AH + ks * 1024 + lane * 16) = (u32x4_t){alo.x, alo.y, ahi.x, ahi.y}; *(u32x4_t*)(pkg + PK_RH + ks * 1024 + lane * 16) = (u32x4_t){rlo.x, rlo.y, rhi.x, rhi.y}; }
#pragma unroll
    for (int nt = 0; nt < 4; ++nt) { *(u32x4_t*)(pkg + PK_KB + nt * 1024 + lane * 16) = (u32x4_t){ktf[nt].x, ktf[nt].y, btf[nt].x, btf[nt].y};
        u32x2_t vf; vf.x = cvtpk(ev[nt][0], ev[nt][1]); vf.y = cvtpk(ev[nt][2], ev[nt][3]); *(u32x2_t*)(pkg + PK_VV + nt * 512 + lane * 8) = vf;
        if (qd == 0) ((float*)(pkg + PK_GE))[16 * nt + fr] = __expf(lend[nt]); }
    asm volatile("s_waitcnt lgkmcnt(0)" ::: "memory");
}
DI void phase_rwkv_r1(const Args& A, int l, LAS unsigned char* lds, int bid, int G, int tid, int wave, int lane) {
    constexpr int NIT = 2 * NB * 6 * 16; int dh_staged = -1;
    __syncthreads();
    for (int it = bid; it < NIT; it += G) rwkv_r1_item(A, l, lds, it, dh_staged, tid, wave, lane);
    __syncthreads();
}

struct RkOps { bf16x8_t ah[2], rh[2], kb[4], mm; bf16x4_t vv, tm, lak; f32x4 ge[4]; };
DI bf16x8_t widen4(const bf16x4_t a) { return __builtin_shufflevector(a, (bf16x4_t){0, 0, 0, 0}, 0, 1, 2, 3, 4, 5, 6, 7); }
DI void rk_step(const RkOps& c, f32x4 (&sT)[4], bf16* yb, int dir, int b, int hh, int vb, int cc, int fr, int qd) {
    const f32x4 zero4 = (f32x4){0.f, 0.f, 0.f, 0.f};
    union { unsigned u[4]; bf16x8_t v; } s0, s1;
    s0.u[0] = cvtpk(sT[0][0], sT[0][1]); s0.u[1] = cvtpk(sT[0][2], sT[0][3]); s0.u[2] = cvtpk(sT[1][0], sT[1][1]); s0.u[3] = cvtpk(sT[1][2], sT[1][3]);
    s1.u[0] = cvtpk(sT[2][0], sT[2][1]); s1.u[1] = cvtpk(sT[2][2], sT[2][3]); s1.u[2] = cvtpk(sT[3][0], sT[3][1]); s1.u[3] = cvtpk(sT[3][2], sT[3][3]);
    f32x4 ax = MFMA16(widen4(c.lak), widen4(c.vv), zero4); ax = MFMA16(c.ah[0], s0.v, ax); ax = MFMA16(c.ah[1], s1.v, ax);
    f32x4 ay = MFMA16(c.rh[0], s0.v, zero4); ay = MFMA16(c.rh[1], s1.v, ay);
    const f32x4 au = MFMA16(widen4(c.tm), widen4(pack4(ax)), zero4);
    const bf16x8_t vu = __builtin_shufflevector(c.vv, pack4(au), 0, 1, 2, 3, 4, 5, 6, 7);
    ay = MFMA16(c.mm, vu, ay);
#pragma unroll
    for (int kt = 0; kt < 4; ++kt) sT[kt] = MFMA16(c.kb[kt], vu, sT[kt] * c.ge[kt]);
    const int sgn = dir ? -1 : 1; const int tok0 = b * SEQ + (dir ? SEQ - 1 - 16 * cc : 16 * cc);
#pragma unroll
    for (int r = 0; r < 4; ++r) yb[((size_t)dir * NT + tok0 + sgn * (4 * qd + r)) * RW + hh * 64 + 16 * vb + fr] = (bf16)f2bf(ay[r]);
}
constexpr int R2_SLOTS = 8, R2_CTL = R2_SLOTS * PKG_BYTES;
static_assert(R2_CTL + 64 <= MISC_OFF, "rwkv r2 LDS");
DI void rk_load_lds(RkOps& o, const LAS unsigned char* pkg, int vb, int lane, int qd) {
#pragma unroll
    for (int ks = 0; ks < 2; ++ks) { o.ah[ks] = *(const LAS bf16x8_t*)(pkg + PK_AH + ks * 1024 + lane * 16); o.rh[ks] = *(const LAS bf16x8_t*)(pkg + PK_RH + ks * 1024 + lane * 16); }
#pragma unroll
    for (int kt = 0; kt < 4; ++kt) { o.kb[kt] = *(const LAS bf16x8_t*)(pkg + PK_KB + kt * 1024 + lane * 16); o.ge[kt] = *(const LAS f32x4*)(pkg + PK_GE + (16 * kt + 4 * qd) * 4); }
    o.mm = *(const LAS bf16x8_t*)(pkg + PK_MM + lane * 16);
    o.vv = *(const LAS bf16x4_t*)(pkg + PK_VV + vb * 512 + lane * 8); o.tm = *(const LAS bf16x4_t*)(pkg + PK_TM + lane * 8); o.lak = *(const LAS bf16x4_t*)(pkg + PK_LAK + lane * 8);
}
DI void rk_pkg_fetch(u32x4_t (&buf)[13], const unsigned char* pkg, int lane) {
#pragma unroll
    for (int i = 0; i < 12; ++i) buf[i] = *(const u32x4_t*)(pkg + i * 1024 + lane * 16);
    buf[12] = (lane < 16) ? *(const u32x4_t*)(pkg + 12288 + lane * 16) : (u32x4_t){0u, 0u, 0u, 0u};
}
DI void rwkv_r2_unit(const Args& A, LAS unsigned char* lds, int u, int tid, int wave, int lane) {
    bf16* yb = (bf16*)(A.ws + WS_RKY);
    const int dir = u / 48, rem = u % 48, b = rem / 6, hh = rem % 6; const int fr = lane & 15, qd = lane >> 4;
    const unsigned char* pkg0 = A.ws + WS_PKG + ((size_t)((dir * NB + b) * 6 + hh) * 128) * PKG_BYTES;
    volatile LAS unsigned* ready = (volatile LAS unsigned*)(lds + R2_CTL); volatile LAS unsigned* consumed = ready + 8;
    __syncthreads();
    if (tid < 16) ready[tid] = 0u;
    __syncthreads();
    if (wave >= 4) {
        const int j = wave - 4; u32x4_t cur[13], nxt[13];
        rk_pkg_fetch(cur, pkg0 + (size_t)j * PKG_BYTES, lane);
        for (int cc = j; cc < 128; cc += 4) {
            if (cc + 4 < 128) rk_pkg_fetch(nxt, pkg0 + (size_t)(cc + 4) * PKG_BYTES, lane);
            if (cc >= R2_SLOTS) { const unsigned need = (unsigned)(cc - R2_SLOTS + 1); unsigned spins = 0;
                for (;;) { const unsigned c0 = consumed[0], c1 = consumed[1], c2 = consumed[2], c3 = consumed[3];
                    if (c0 >= need && c1 >= need && c2 >= need && c3 >= need) break; if (++spins > (1u << 22)) break; __builtin_amdgcn_s_sleep(1); } }
            LAS unsigned char* slot = lds + (cc & (R2_SLOTS - 1)) * PKG_BYTES;
#pragma unroll
            for (int i = 0; i < 12; ++i) *(LAS u32x4_t*)(slot + i * 1024 + lane * 16) = cur[i];
            if (lane < 16) *(LAS u32x4_t*)(slot + 12288 + lane * 16) = cur[12];
            asm volatile("s_waitcnt lgkmcnt(0)" ::: "memory");
            if (lane == 0) ready[cc & (R2_SLOTS - 1)] = (unsigned)(cc + 1);
            asm volatile("" ::: "memory");
#pragma unroll
            for (int i = 0; i < 13; ++i) cur[i] = nxt[i];
        }
    } else {
        const int vb = wave; f32x4 sT[4];
#pragma unroll
        for (int kt = 0; kt < 4; ++kt) sT[kt] = (f32x4){0.f, 0.f, 0.f, 0.f};
#define RK_WAIT(cc_) do { unsigned spins = 0; while (ready[(cc_) & (R2_SLOTS - 1)] != (unsigned)((cc_) + 1)) { if (++spins > (1u << 22)) break; __builtin_amdgcn_s_sleep(1); } asm volatile("" ::: "memory"); } while (0)
        RkOps pa, pb;
        RK_WAIT(0); rk_load_lds(pa, lds, vb, lane, qd);
        for (int cc = 0; cc < 128; cc += 2) {
            RK_WAIT(cc + 1); rk_load_lds(pb, lds + ((cc + 1) & (R2_SLOTS - 1)) * PKG_BYTES, vb, lane, qd);
            rk_step(pa, sT, yb, dir, b, hh, vb, cc, fr, qd);
            asm volatile("s_waitcnt lgkmcnt(0)" ::: "memory"); if (lane == 0) consumed[vb] = (unsigned)(cc + 2); asm volatile("" ::: "memory");
            if (cc + 2 < 128) { RK_WAIT(cc + 2); rk_load_lds(pa, lds + ((cc + 2) & (R2_SLOTS - 1)) * PKG_BYTES, vb, lane, qd); }
            rk_step(pb, sT, yb, dir, b, hh, vb, cc + 1, fr, qd);
            if (cc + 2 < 128) { asm volatile("s_waitcnt lgkmcnt(0)" ::: "memory"); if (lane == 0) consumed[vb] = (unsigned)(cc + 3); asm volatile("" ::: "memory"); }
        }
#undef RK_WAIT
    }
    __syncthreads();
}


constexpr int YA_G2LD = 136;
static_assert(384 * YA_G2LD * 2 <= MISC_OFF, "yasm LDS");
DI void yasm_token(const bf16* Z, const bf16* ao, const float* al, const bf16* num, const float* den, const float* mlg, bf16* y, int tok, int lane) {
    const bf16* zr = Z + (size_t)tok * ZLD; bf16* yr = y + (size_t)tok * DM;
    const float lsev = al[((size_t)((lane >> 2) % 3) * NT + tok) * 4 + (lane & 3)];
    const float denv = den[((size_t)((lane >> 2) & 1) * NT + tok) * 4 + (lane & 3)];
    float aov[3][4], nmv[2][4], nm2[2][4], zo[4], zo2[4];
#pragma unroll
    for (int hh = 0; hh < 4; ++hh) { const int col = hh * 64 + lane, c0 = hh * 96 + lane, c1 = hh * 96 + 64 + (lane & 31);
#pragma unroll
        for (int br = 0; br < 3; ++br) aov[br][hh] = bf2f(ao[((size_t)br * NT + tok) * AW + col]);
#pragma unroll
        for (int d = 0; d < 2; ++d) { nmv[d][hh] = bf2f(num[((size_t)d * NT + tok) * MW + c0]); nm2[d][hh] = bf2f(num[((size_t)d * NT + tok) * MW + c1]); }
        zo[hh] = bf2f(zr[ZMO + c0]); zo2[hh] = bf2f(zr[ZMO + c1]); }
#pragma unroll
    for (int hh = 0; hh < 4; ++hh) { const int col = hh * 64 + lane;
        const float l0 = __shfl(lsev, hh), l1 = __shfl(lsev, 4 + hh), l2 = __shfl(lsev, 8 + hh);
        const float mx = fmaxf(l0, fmaxf(l1, l2)); const float w0 = __expf(l0 - mx), w1 = __expf(l1 - mx), w2 = __expf(l2 - mx);
        yr[col] = (bf16)f2bf((w0 * aov[0][hh] + w1 * aov[1][hh] + w2 * aov[2][hh]) / (w0 + w1 + w2)); }
#pragma unroll
    for (int hh = 0; hh < 4; ++hh) { const int c0 = hh * 96 + lane, c1 = hh * 96 + 64 + (lane & 31); const bool hi = lane < 32;
        const float df = __shfl(denv, hh), db = __shfl(denv, 4 + hh);
        const float invf = 1.f / fmaxf(fabsf(df), 1.f), invb = 1.f / fmaxf(fabsf(db), 1.f);
        const float a = nmv[0][hh] * invf + nmv[1][hh] * invb; const float bb = hi ? (nm2[0][hh] * invf + nm2[1][hh] * invb) : 0.f;
        const float mean = (wave_sum(a) + wave_sum(bb)) * (1.f / 96.f); const float da = a - mean, dbb = hi ? bb - mean : 0.f;
        const float var = (wave_sum(da * da) + wave_sum(dbb * dbb)) * (1.f / 96.f); const float rs = rsqrtf(var + 1e-6f);
        yr[AW + RW + c0] = (bf16)f2bf(da * rs * mlg[c0] * sigm(zo[hh]));
        if (hi) yr[AW + RW + c1] = (bf16)f2bf(dbb * rs * mlg[c1] * sigm(zo2[hh])); }
}
DI void phase_yasm(const Args& A, int l, LAS unsigned char* lds, int gw, int ngw, int tid, int lane) {
    const bf16* Z = (const bf16*)(A.ws + WS_Z); const bf16* ao = (const bf16*)(A.ws + WS_ATTO); const float* al = (const float*)(A.ws + WS_ATTL);
    const bf16* rky = (const bf16*)(A.ws + WS_RKY); const bf16* rkb = (const bf16*)(A.ws + WS_RKB);
    const bf16* num = (const bf16*)(A.ws + WS_MLNUM); const float* den = (const float*)(A.ws + WS_MLDEN); bf16* y = (bf16*)(A.ws + WS_HB);
    const float* lng = A.in[I_RLNG] + (size_t)l * RW; const float* lnb = A.in[I_RLNB] + (size_t)l * RW; const float* mlg = A.in[I_MLNG] + (size_t)l * MW;
    LAS bf16* G2T = (LAS bf16*)lds;
    __syncthreads();
    { const u32x4_t* src = (const u32x4_t*)(A.ws + WS_G2T + (size_t)l * RW * 128 * 2);
      for (int idx = tid; idx < RW * 16; idx += NTHR) { const int col = idx >> 4, ch = idx & 15; *(LAS u32x4_t*)(G2T + col * YA_G2LD + ch * 8) = src[idx]; } }
    __syncthreads();
    const int fr = lane & 15, qd = lane >> 4;
    for (int item = gw; item < (NT / 16) * 6; item += ngw) {
        const int hh = item % 6, tg = item / 6; const int tokA = tg * 16 + fr;
        f32x4 gacc[4];
#pragma unroll
        for (int nt = 0; nt < 4; ++nt) gacc[nt] = (f32x4){0.f, 0.f, 0.f, 0.f};
#pragma unroll
        for (int ks = 0; ks < 4; ++ks) { float f[8]; unpack8(*(const uint4*)(Z + (size_t)tokA * ZLD + ZGD + 32 * ks + 8 * qd), f);
            union { unsigned u[4]; bf16x8_t v; } a;
#pragma unroll
            for (int e = 0; e < 4; ++e) a.u[e] = cvtpk(sigm(f[2 * e]), sigm(f[2 * e + 1]));
#pragma unroll
            for (int nt = 0; nt < 4; ++nt) { const bf16x8_t bg = *(const LAS bf16x8_t*)(G2T + (hh * 64 + 16 * nt + fr) * YA_G2LD + 32 * ks + 8 * qd); gacc[nt] = MFMA16(a.v, bg, gacc[nt]); } }
        float sv[4][4], bv[4][4]; float sm[4] = {0.f, 0.f, 0.f, 0.f};
#pragma unroll
        for (int nt = 0; nt < 4; ++nt)
#pragma unroll
            for (int r = 0; r < 4; ++r) { const size_t o = (size_t)(tg * 16 + 4 * qd + r) * RW + hh * 64 + 16 * nt + fr;
                sv[nt][r] = bf2f(rky[o]) + bf2f(rky[(size_t)NT * RW + o]); bv[nt][r] = bf2f(rkb[o]) + bf2f(rkb[(size_t)NT * RW + o]); sm[r] += sv[nt][r]; }
        float vr[4] = {0.f, 0.f, 0.f, 0.f};
#pragma unroll
        for (int r = 0; r < 4; ++r) {
#pragma unroll
            for (int o = 1; o < 16; o <<= 1) sm[r] += __shfl_xor(sm[r], o);
            sm[r] *= (1.f / 64.f);
#pragma unroll
            for (int nt = 0; nt < 4; ++nt) { sv[nt][r] -= sm[r]; vr[r] += sv[nt][r] * sv[nt][r]; }
#pragma unroll
            for (int o = 1; o < 16; o <<= 1) vr[r] += __shfl_xor(vr[r], o);
            vr[r] = rsqrtf(vr[r] * (1.f / 64.f) + 64e-5f); }
#pragma unroll
        for (int nt = 0; nt < 4; ++nt) { const int col = hh * 64 + 16 * nt + fr; const float lg_ = lng[col], lb_ = lnb[col];
#pragma unroll
            for (int r = 0; r < 4; ++r) y[(size_t)(tg * 16 + 4 * qd + r) * DM + AW + col] = (bf16)f2bf((sv[nt][r] * vr[r] * lg_ + lb_ + bv[nt][r]) * gacc[nt][r]); }
    }
    for (int tok = gw; tok < NT; tok += 2 * ngw) { yasm_token(Z, ao, al, num, den, mlg, y, tok, lane); if (tok + ngw < NT) yasm_token(Z, ao, al, num, den, mlg, y, tok + ngw, lane); }
    __syncthreads();
}

constexpr int PH_PER_LAYER = 10, NPH = 1 + NL * PH_PER_LAYER + 1;
#ifndef MK_ONE_LAUNCH
#define MK_ONE_LAUNCH 1
#endif

#ifndef MK_DUP
#define MK_DUP 0
#endif
constexpr int P0_END = NL * 16 * 64 + NL * 16 * 16 + NL * NE * 3 * 16 * 44, P0_SPLIT = P0_END - 0;
template <int l> DI void run_layer(const Args& A, LAS unsigned char* lds, const XcdBarrier& bar, int lo, int hi, int G, int bid, int tid, int lane, int wave, int gw, int ngw, int gtid, int nthr) {
#define IN(k) (lo <= (k) && (k) < hi)
#define SEAM(k) do { if (IN(k) && IN((k) + 1)) xcd_barrier(bar); } while (0)
#define PH(k, ...) do { if (IN(pb + (k))) { { __VA_ARGS__ } if ((MK_DUP >> (k)) & 1) { xcd_barrier(bar); { __VA_ARGS__ } } } SEAM(pb + (k)); } while (0)
    const int pb = 1 + l * PH_PER_LAYER;
    PH(0, phase_ln1(A, l, gw, ngw, lane););
    PH(1,
        pg8::Gemm g{(const bf16*)(A.ws + WS_HB), (const bf16*)(A.ws + WS_WTIN) + (size_t)l * ZLD * DM, NT, ZLD, DM};
        pg8::StaticOrder S; S.init(NT, ZLD, G, bid);
        pg8::EpiBf16<0> E{(bf16*)(A.ws + WS_Z), ZLD, nullptr, 0, 0, 1.f};
        pg8::gemm_phase<pg8::EpiBf16<0>, pg8::StaticOrder, true, true>(lds, g, S, E););
    PH(2, phase_attn(A, lds, bid, G, tid, wave, lane); phase_rwkv_r1(A, l, lds, bid, G, tid, wave, lane); if ((MK_DUP >> 13) & 1) phase_rwkv_r1(A, l, lds, bid, G, tid, wave, lane);
          phase_mlstm_m1(A, l, lds, bid, G, tid, wave, lane); if ((MK_DUP >> 16) & 1) phase_mlstm_m1(A, l, lds, bid, G, tid, wave, lane););
    PH(3, if (l == 0 && P0_SPLIT < P0_END) { const int nb = G > 160 ? G - 160 : G, b0 = G > 160 ? bid - 160 : bid; if (b0 >= 0) { __syncthreads(); phase_p0(A, lds, P0_SPLIT, P0_END, b0 * NWAVES + wave, nb * NWAVES, wave, lane); __syncthreads(); } }
          for (int rep = 0; rep < 1 + ((MK_DUP >> 14) & 1); ++rep) for (int u = bid; u < 96; u += G) rwkv_r2_unit(A, lds, u, tid, wave, lane);
          for (int rep = 0; rep < 1 + ((MK_DUP >> 15) & 1); ++rep) for (int u = bid; u < 96 + 64; u += G) { if (u >= 96) mlstm_m2_unit(A, lds, u - 96, tid, wave, lane); });
    PH(4, phase_yasm(A, l, lds, gw, ngw, tid, lane););
    PH(5,
        pg8::Gemm g{(const bf16*)(A.ws + WS_HB), (const bf16*)(A.ws + WS_WTOUT) + (size_t)l * DM * DM, NT, DM, DM};
        pg8::StaticOrder S; S.init(NT, DM, G, bid);
        EpiResF32 E{(l == 0) ? A.in[I_X] : (const float*)(A.ws + WS_X2), (float*)(A.ws + WS_X1), DM};
        pg8::gemm_phase<EpiResF32, pg8::StaticOrder, false, true>(lds, g, S, E););
    PH(6, phase_ln2(A, l, lds, gw, ngw, tid, lane););
    PH(7, phase_topk(A, lds, bid, G, tid, wave, lane););
    PH(8,
        pg8::Gemm g{(const bf16*)(A.ws + WS_XG), (const bf16*)(A.ws + WS_W13T + (size_t)l * NE * 5632 * DM), NSLOT, NE * 5632, DM / 2};
        GroupOrder S; S.init(22, G, bid);
        EpiSwiGLU E{A.ws + WS_ACT, 22};
        pg8::gemm_phase<EpiSwiGLU, GroupOrder, true, true, true>(lds, g, S, E););
    PH(9,
        pg8::Gemm g{(const bf16*)(A.ws + WS_ACT), (const bf16*)(A.ws + WS_W2T + (size_t)l * NE * DM * FF), NSLOT, NE * DM, FF / 2};
        GroupOrder S; S.init(4, G, bid);
        EpiGate E{(bf16*)(A.ws + WS_YS), (const float*)(A.ws + WS_GATE)};
        pg8::gemm_phase<EpiGate, GroupOrder, true, true, true>(lds, g, S, E););
#undef PH
#undef IN
#undef SEAM
}

__global__ void __launch_bounds__(NTHR, 2) mk_fwd(Args A) {
    extern __shared__ __attribute__((aligned(16))) unsigned char lds_raw[];
    LAS unsigned char* lds = (LAS unsigned char*)lds_raw;
    const int tid = threadIdx.x, lane = tid & 63, wave = __builtin_amdgcn_readfirstlane(tid >> 6);
    const int G = gridDim.x, bid = blockIdx.x;
    const int gw = bid * NWAVES + wave, ngw = G * NWAVES, gtid = bid * NTHR + tid, nthr = G * NTHR;
    volatile LAS unsigned* MISC = (volatile LAS unsigned*)(lds + MISC_OFF);
    if (tid < 64) MISC[tid] = 0u;
    __syncthreads();
    const int lo = A.ph_lo, hi = A.ph_hi;
    const bool use_bar = (hi - lo) > 1;
    XcdBarrier bar; bar.bar = (unsigned*)(A.ws + WS_CTL) + CW_BAR; bar.x = 0; bar.st = MISC + 8;
    if (use_bar) bar = xcd_barrier_post((unsigned*)(A.ws + WS_CTL) + CW_BAR, MISC + 8);
#define IN(k) (lo <= (k) && (k) < hi)
#define SEAM(k) do { if (IN(k) && IN((k) + 1)) xcd_barrier(bar); } while (0)

    if (IN(0)) { phase_p0(A, lds, 0, P0_SPLIT, gw, ngw, wave, lane); if ((MK_DUP >> 10) & 1) { xcd_barrier(bar); phase_p0(A, lds, 0, P0_SPLIT, gw, ngw, wave, lane); } } SEAM(0);

    run_layer<0>(A, lds, bar, lo, hi, G, bid, tid, lane, wave, gw, ngw, gtid, nthr);
    run_layer<1>(A, lds, bar, lo, hi, G, bid, tid, lane, wave, gw, ngw, gtid, nthr);
    if (IN(NPH - 1)) { phase_final(A, gw, ngw, lane); if ((MK_DUP >> 11) & 1) { xcd_barrier(bar); phase_final(A, gw, ngw, lane); } }
#undef IN
#undef SEAM
}
}

extern "C" void kernel_launch(void* const* d_in, const int* in_sizes, int n_in, void* d_out, int out_size, void* d_ws, size_t ws_size, hipStream_t stream) {
    using namespace mk;
    static int grid = 0;
    if (grid == 0) {
        if (n_in != N_IN || out_size != NT * DM || ws_size < WS_END) { fprintf(stderr, "kernel_launch: unexpected shapes (n_in %d, out %d, ws %zu < %zu)\n", n_in, out_size, ws_size, (size_t)WS_END); grid = -1; return; }
        int dev = 0, cus = 0, per_cu = 0;
        if (hipGetDevice(&dev) != hipSuccess || hipDeviceGetAttribute(&cus, hipDeviceAttributeMultiprocessorCount, dev) != hipSuccess) { grid = -1; return; }
        if (hipFuncSetAttribute((const void*)mk_fwd, hipFuncAttributeMaxDynamicSharedMemorySize, LDS_BYTES) != hipSuccess) { fprintf(stderr, "kernel_launch: hipFuncSetAttribute failed\n"); grid = -1; return; }
        if (hipOccupancyMaxActiveBlocksPerMultiprocessor(&per_cu, (const void*)mk_fwd, NTHR, LDS_BYTES) != hipSuccess || per_cu < 1) fprintf(stderr, "kernel_launch: occupancy query reports %d\n", per_cu);
        (void)hipGetLastError();
        grid = cus;
    }
    if (grid < 0) return;
    hipMemsetAsync((char*)d_ws + WS_CTL, 0, CTL_ZERO_BYTES, stream);
    Args a{};
    for (int i = 0; i < N_IN; ++i) a.in[i] = (const float*)d_in[i];
    a.out = (float*)d_out; a.ws = (unsigned char*)d_ws;
#if MK_ONE_LAUNCH
    a.ph_lo = 0; a.ph_hi = NPH;
    hipLaunchKernelGGL(mk_fwd, dim3(grid), dim3(NTHR), LDS_BYTES, stream, a);
#else
    for (int p = 0; p < NPH; ++p) { a.ph_lo = p; a.ph_hi = p + 1; hipLaunchKernelGGL(mk_fwd, dim3(grid), dim3(NTHR), LDS_BYTES, stream, a); }
#endif
}
```

```cpp
#include <hip/hip_runtime.h>
#include <cstdio>
#include <cstdint>
namespace pg8 {
#define PG8_LAS __attribute__((address_space(3)))
typedef unsigned short bf16_t;
typedef short bf16x8 __attribute__((ext_vector_type(8)));
typedef float f32x4 __attribute__((ext_vector_type(4)));
typedef unsigned u32x4 __attribute__((ext_vector_type(4)));
constexpr int BM = 256, BK = 64, HALF = 128, HTB = HALF * BK * 2  , STAGE_BYTES = 8 * HTB, NXCD = 8, WGM = 8;

__host__ __device__ __forceinline__ int lds_byte(int r, int c) { const int st = (r >> 4) * 2 + (c >> 5), rr = r & 15, cc = c & 31, ob = rr * 64 + cc * 2; return st * 1024 + (ob ^ (((ob >> 9) & 1) << 5)); }
__host__ __device__ __forceinline__ void stage_rc(int b, int& R, int& C) { const int st = b / 1024, sb = b % 1024, swz = sb ^ (((sb >> 9) & 1) << 5); R = (st >> 1) * 16 + swz / 64; C = (st & 1) * 32 + (swz % 64) / 2; }
__host__ __device__ __forceinline__ int perm32(int rho) { const int n = rho >> 4, i = rho & 15; return 8 * (i >> 2) + 4 * n + (i & 3); }

struct Unit { int pm, pn; };
struct Gemm { const bf16_t* A; const bf16_t* Bt; int M, N, K; };

struct StaticOrder {
    int nM, nN, nwg, G, c;
    __host__ __device__ void init(int M, int N, int G_, int c_) { nM = M / BM; nN = N / BM; nwg = nM * nN; G = G_; c = c_; }
    __host__ __device__ bool next(int i, Unit& u) const {
        const long L = (long)i * G + c; if (L >= nwg) return false;
        int wgid = (int)L; { const int q = nwg / NXCD, r = nwg % NXCD, xcd = wgid % NXCD, off = wgid / NXCD; wgid = (xcd < r ? xcd * (q + 1) : r * (q + 1) + (xcd - r) * q) + off; }
        const int nig = WGM * nN, gid = wgid / nig, fm = gid * WGM, gsz = (nM - fm) < WGM ? (nM - fm) : WGM;
        u.pm = fm + ((wgid % nig) % gsz); u.pn = (wgid % nig) / gsz; return true;
    }
    __device__ __forceinline__ void a_ready(const Unit&) const {}
    __device__ __forceinline__ void done(const Unit&) const {}
};

__device__ __forceinline__ unsigned cvt_pk_bf16(float lo, float hi) { unsigned r; asm volatile("v_cvt_pk_bf16_f32 %0, %1, %2" : "=v"(r) : "v"(lo), "v"(hi)); return r; }
typedef float f32x2 __attribute__((ext_vector_type(2)));
__device__ __forceinline__ f32x2 gelu_pk(f32x2 v) {
    const f32x2 av = __builtin_elementwise_abs(v), d = av * 0.2316418882f + 1.0f;
    f32x2 t; t.x = __builtin_amdgcn_rcpf(d.x); t.y = __builtin_amdgcn_rcpf(d.y);
    f32x2 q = t * 0.5307027145f + (-0.7265760135f); q = q * t + 0.7107068705f; q = q * t + (-0.142248368f); q = q * t + 0.127414796f; q = q * t;
    const f32x2 s = (v * v) * (-0.72134752044f);
    f32x2 e; e.x = __builtin_amdgcn_exp2f(s.x); e.y = __builtin_amdgcn_exp2f(s.y);
    const f32x2 m = v * (q * e), r = v - m;
    f32x2 o; o.x = v.x < 0.f ? m.x : r.x; o.y = v.y < 0.f ? m.y : r.y; return o;
}

template <int ACT  > struct EpiBf16 {
    static constexpr bool PERM = true, AFTER_DRAIN = false; static_assert(ACT == 0 || ACT == 1, "EpiBf16: ACT is 0 (none) or 1 (gelu_pk)");
    bf16_t* O; int ldc; const float* bias; int split_cols; size_t split_stride; float scale0;
    __device__ __forceinline__ void operator()(const f32x4 (&acc)[2][2][4][2], const Unit& u, int wr, int wc, int fr, int fq) const {
        const int row0 = u.pm * BM + wr * 64 + fr; int colt = u.pn * BM; bf16_t* base = O;
        float sc = 1.f; if (split_cols) { const int t = colt / split_cols; base += (size_t)t * split_stride; colt -= t * split_cols; if (t == 0) sc = scale0; }
        const int col0 = colt + wc * 32 + 8 * fq, bcol0 = u.pn * BM + wc * 32 + 8 * fq;
        f32x4 bv[2][2];
#pragma unroll
        for (int bj = 0; bj < 2; ++bj)
#pragma unroll
            for (int n = 0; n < 2; ++n) bv[bj][n] = bias ? *(const f32x4*)(bias + bcol0 + bj * HALF + 4 * n) : (f32x4){0.f, 0.f, 0.f, 0.f};
#pragma unroll
        for (int ai = 0; ai < 2; ++ai)
#pragma unroll
            for (int m = 0; m < 4; ++m) { bf16_t* rowp = base + (size_t)(row0 + ai * HALF + m * 16) * ldc + col0;
#pragma unroll
                for (int bj = 0; bj < 2; ++bj) { f32x4 v0 = acc[ai][bj][m][0] + bv[bj][0], v1 = acc[ai][bj][m][1] + bv[bj][1];
                    if (ACT == 1) { f32x2 a = gelu_pk((f32x2){v0[0], v0[1]}), b = gelu_pk((f32x2){v0[2], v0[3]}), c = gelu_pk((f32x2){v1[0], v1[1]}), d = gelu_pk((f32x2){v1[2], v1[3]});
                        v0 = (f32x4){a.x, a.y, b.x, b.y}; v1 = (f32x4){c.x, c.y, d.x, d.y}; }
                    v0 = v0 * sc; v1 = v1 * sc; u32x4 w; w.x = cvt_pk_bf16(v0[0], v0[1]); w.y = cvt_pk_bf16(v0[2], v0[3]); w.z = cvt_pk_bf16(v1[0], v1[1]); w.w = cvt_pk_bf16(v1[2], v1[3]);
                    *(u32x4*)(rowp + bj * HALF) = w; } }
    }
};
template <class Epi, class Sched, bool ALIGN_EPI = false, bool SP2 = false, bool F8 = false>
__device__ __forceinline__ void gemm_phase(PG8_LAS unsigned char* lds, const Gemm g, const Sched& S, const Epi& E) {
    const int tid = threadIdx.x, wid = __builtin_amdgcn_readfirstlane(tid >> 6), lane = tid & 63, wr = wid >> 2, wc = wid & 3, fr = lane & 15, fq = lane >> 4;
    int Kq = g.K; if constexpr (F8) asm volatile("" : "+s"(Kq));
    const int K = Kq, nt = K / BK;
    unsigned voffA[2], voffB[2];
#pragma unroll
    for (int i = 0; i < 2; ++i) { int R, C; stage_rc(tid * 16 + i * 8192, R, C); const int Rb = Epi::PERM ? ((R & ~31) + perm32(R & 31)) : R;
        voffA[i] = (unsigned)(R * K + C) * 2u; voffB[i] = (unsigned)(Rb * K + C) * 2u; }
    const size_t kstep = (size_t)(BK * 2);
    const size_t hstep = (size_t)HALF * K * 2;
    const size_t tstep = 2 * hstep;
    const unsigned ldsw = (unsigned)wid * 1024u;
    const int aoff = lds_byte(wr * 64 + fr, fq * 8), boff = lds_byte(wc * 32 + fr, fq * 8);
#define PG8_SA(b, h) (((b) * 2 + (h)) * HTB)
#define PG8_SB(b, h) ((4 + (b) * 2 + (h)) * HTB)
#define PG8_STAGE(bufoff, gbase, voff) do { _Pragma("unroll") for (int _i = 0; _i < 2; ++_i) \
        __builtin_amdgcn_global_load_lds((const unsigned*)((const char*)(gbase) + (voff)[_i]), (PG8_LAS unsigned*)(lds + (bufoff) + ldsw + _i * 8192), 16, 0, 0); } while (0)
#define PG8_LDA(dst, b, h) do { _Pragma("unroll") for (int m = 0; m < 4; ++m) { if constexpr (F8) { const i32x4_ lo_ = *(const PG8_LAS i32x4_*)(lds + PG8_SA(b, h) + aoff + m * 2048), hi_ = *(const PG8_LAS i32x4_*)(lds + PG8_SA(b, h) + aoff + m * 2048 + 1024); dst##8[m] = __builtin_shufflevector(lo_, hi_, 0, 1, 2, 3, 4, 5, 6, 7); } \
        else { _Pragma("unroll") for (int k = 0; k < 2; ++k) dst[m][k] = *(const PG8_LAS bf16x8*)(lds + PG8_SA(b, h) + aoff + m * 2048 + k * 1024); } } } while (0)
#define PG8_LDB(dst, b, h) do { _Pragma("unroll") for (int n = 0; n < 2; ++n) { if constexpr (F8) { const i32x4_ lo_ = *(const PG8_LAS i32x4_*)(lds + PG8_SB(b, h) + boff + n * 2048), hi_ = *(const PG8_LAS i32x4_*)(lds + PG8_SB(b, h) + boff + n * 2048 + 1024); dst##8[n] = __builtin_shufflevector(lo_, hi_, 0, 1, 2, 3, 4, 5, 6, 7); } \
        else { _Pragma("unroll") for (int k = 0; k < 2; ++k) dst[n][k] = *(const PG8_LAS bf16x8*)(lds + PG8_SB(b, h) + boff + n * 2048 + k * 1024); } } } while (0)
#define PG8_MMA(ai, bj, At, Bt) do { __builtin_amdgcn_s_setprio(1); _Pragma("unroll") for (int m = 0; m < 4; ++m) _Pragma("unroll") for (int n = 0; n < 2; ++n) { \
        if constexpr (F8) asm volatile("v_mfma_scale_f32_16x16x128_f8f6f4 %0, %1, %2, %0, %3, %3 op_sel_hi:[0,0,0]" : "+v"(acc[ai][bj][m][n]) : "v"(Bt##8[n]), "v"(At##8[m]), "v"(f8scale)); \
        else { _Pragma("unroll") for (int k = 0; k < 2; ++k) acc[ai][bj][m][n] = __builtin_amdgcn_mfma_f32_16x16x32_bf16(Bt[n][k], At[m][k], acc[ai][bj][m][n], 0, 0, 0); } } \
        __builtin_amdgcn_s_setprio(0); } while (0)
#define PG8_WAIT_V(n) asm volatile("s_waitcnt vmcnt(" #n ")" ::: "memory")
#define PG8_WAIT_L(n) asm volatile("s_waitcnt lgkmcnt(" #n ")" ::: "memory")
#define PG8_BAR __builtin_amdgcn_s_barrier()
#define PG8_SCHED __builtin_amdgcn_sched_barrier(0)
    Unit cur, nxt; int ui = 0;
    if (!S.next(0, cur)) return;
    f32x4 acc[2][2][4][2];
#pragma unroll
    for (int a = 0; a < 2; ++a)
#pragma unroll
        for (int b = 0; b < 2; ++b)
#pragma unroll
            for (int m = 0; m < 4; ++m)
#pragma unroll
                for (int n = 0; n < 2; ++n) { acc[a][b][m][n] = (f32x4){0.f, 0.f, 0.f, 0.f}; if constexpr (F8) asm volatile("" : "+v"(acc[a][b][m][n])); }
    bf16x8 At[4][2], B0[2][2], B1[2][2];
    typedef int i32x4_ __attribute__((ext_vector_type(4))); typedef int i32x8_ __attribute__((ext_vector_type(8)));
    i32x8_ At8[4], B08[2], B18[2];
    int f8scale = 0x7f7f7f7f; asm volatile("" : "+v"(f8scale));
    const char* cA = (const char*)g.A + (size_t)cur.pm * tstep; const char* cB = (const char*)g.Bt + (size_t)cur.pn * tstep;
    S.a_ready(cur);
    if constexpr (SP2) {
        PG8_STAGE(PG8_SB(0, 0), cB, voffB); PG8_STAGE(PG8_SB(0, 1), cB + hstep, voffB); PG8_STAGE(PG8_SA(0, 0), cA, voffA); PG8_STAGE(PG8_SA(0, 1), cA + hstep, voffA);
        if (wr == 1) PG8_BAR;
        PG8_WAIT_V(2); PG8_BAR;
        PG8_STAGE(PG8_SB(1, 0), cB + kstep, voffB); PG8_STAGE(PG8_SA(1, 0), cA + kstep, voffA); PG8_STAGE(PG8_SB(1, 1), cB + hstep + kstep, voffB);
        PG8_WAIT_V(6); PG8_BAR;
    } else {
        PG8_STAGE(PG8_SB(0, 0), cB, voffB); PG8_STAGE(PG8_SA(0, 0), cA, voffA); PG8_STAGE(PG8_SB(0, 1), cB + hstep, voffB); PG8_STAGE(PG8_SA(0, 1), cA + hstep, voffA);
        if (wr == 1) PG8_BAR;
        PG8_WAIT_V(4); PG8_BAR;
        PG8_STAGE(PG8_SB(1, 0), cB + kstep, voffB); PG8_STAGE(PG8_SA(1, 0), cA + kstep, voffA); PG8_STAGE(PG8_SB(1, 1), cB + hstep + kstep, voffB);
        PG8_WAIT_V(6); PG8_BAR;
    }
    for (;;) {
        const bool has_next = S.next(ui + 1, nxt);
        const char* nA = has_next ? (const char*)g.A + (size_t)nxt.pm * tstep : cA; const char* nB = has_next ? (const char*)g.Bt + (size_t)nxt.pn * tstep : cB;
        for (int t = 0; t < nt; t += 2) {
            const bool last = (t == nt - 2);
            const char* a1 = cA + (size_t)(t + 1) * kstep;
            const char* a2 = last ? nA : cA + (size_t)(t + 2) * kstep; const char* b2 = last ? nB : cB + (size_t)(t + 2) * kstep;
            const char* a3 = a2 + kstep; const char* b3 = b2 + kstep;
            if (last && has_next) S.a_ready(nxt);
            if constexpr (SP2) {
            PG8_LDB(B0, 0, 0); PG8_LDB(B1, 0, 1); PG8_SCHED; PG8_LDA(At, 0, 0); PG8_STAGE(PG8_SA(1, 1), a1 + hstep, voffA);
            PG8_WAIT_V(8); PG8_WAIT_L(0); PG8_BAR; PG8_MMA(0, 0, At, B0); PG8_MMA(0, 1, At, B1); PG8_BAR; PG8_SCHED;
            PG8_LDA(At, 0, 1); PG8_STAGE(PG8_SB(0, 0), b2, voffB); PG8_STAGE(PG8_SB(0, 1), b2 + hstep, voffB); PG8_STAGE(PG8_SA(0, 0), a2, voffA);
            PG8_WAIT_V(8); PG8_WAIT_L(0); PG8_BAR; PG8_MMA(1, 0, At, B0); PG8_MMA(1, 1, At, B1); PG8_BAR; PG8_SCHED;
            PG8_LDB(B0, 1, 0); PG8_LDB(B1, 1, 1); PG8_SCHED; PG8_LDA(At, 1, 0); PG8_STAGE(PG8_SA(0, 1), a2 + hstep, voffA);
            PG8_WAIT_V(8); PG8_WAIT_L(0); PG8_BAR; PG8_MMA(0, 0, At, B0); PG8_MMA(0, 1, At, B1); PG8_BAR; PG8_SCHED;
            PG8_LDA(At, 1, 1); PG8_STAGE(PG8_SB(1, 0), b3, voffB); PG8_STAGE(PG8_SB(1, 1), b3 + hstep, voffB); PG8_STAGE(PG8_SA(1, 0), a3, voffA);
            PG8_WAIT_V(8); PG8_WAIT_L(0); PG8_BAR; PG8_MMA(1, 0, At, B0); PG8_MMA(1, 1, At, B1); PG8_BAR; PG8_SCHED;
            } else {
            PG8_LDB(B0, 0, 0); PG8_SCHED; PG8_LDA(At, 0, 0); PG8_STAGE(PG8_SA(1, 1), a1 + hstep, voffA);
            PG8_WAIT_L(8); PG8_BAR; PG8_WAIT_L(0); PG8_MMA(0, 0, At, B0); PG8_BAR; PG8_SCHED;
            PG8_LDB(B1, 0, 1); PG8_STAGE(PG8_SB(0, 0), b2, voffB);
            PG8_BAR; PG8_WAIT_L(0); PG8_MMA(0, 1, At, B1); PG8_BAR;
            PG8_LDA(At, 0, 1); PG8_STAGE(PG8_SA(0, 0), a2, voffA);
            PG8_BAR; PG8_WAIT_L(0); PG8_MMA(1, 0, At, B0); PG8_BAR; PG8_SCHED;
            PG8_STAGE(PG8_SB(0, 1), b2 + hstep, voffB);
            PG8_WAIT_V(6); PG8_BAR; PG8_MMA(1, 1, At, B1); PG8_BAR;
            PG8_LDB(B0, 1, 0); PG8_SCHED; PG8_LDA(At, 1, 0); PG8_STAGE(PG8_SA(0, 1), a2 + hstep, voffA);
            PG8_WAIT_L(8); PG8_BAR; PG8_WAIT_L(0); PG8_MMA(0, 0, At, B0); PG8_BAR; PG8_SCHED;
            PG8_LDB(B1, 1, 1); PG8_STAGE(PG8_SB(1, 0), b3, voffB);
            PG8_BAR; PG8_WAIT_L(0); PG8_MMA(0, 1, At, B1); PG8_BAR;
            PG8_LDA(At, 1, 1); PG8_STAGE(PG8_SA(1, 0), a3, voffA);
            PG8_BAR; PG8_WAIT_L(0); PG8_MMA(1, 0, At, B0); PG8_BAR; PG8_SCHED;
            PG8_STAGE(PG8_SB(1, 1), b3 + hstep, voffB);
            PG8_WAIT_V(6); PG8_BAR; PG8_MMA(1, 1, At, B1); PG8_BAR;
            }
        }
        if constexpr (F8) asm volatile("s_nop 15\n\ts_nop 15" ::: "memory");
        if constexpr (ALIGN_EPI) { if (wr == 0) PG8_BAR; }
        if constexpr (!Epi::AFTER_DRAIN) { E(acc, cur, wr, wc, fr, fq); S.done(cur); }
        if (!has_next) break;
#pragma unroll
        for (int a = 0; a < 2; ++a)
#pragma unroll
            for (int b = 0; b < 2; ++b)
#pragma unroll
                for (int m = 0; m < 4; ++m)
#pragma unroll
                    for (int n = 0; n < 2; ++n) { acc[a][b][m][n] = (f32x4){0.f, 0.f, 0.f, 0.f}; if constexpr (F8) asm volatile("" : "+v"(acc[a][b][m][n])); }
        cur = nxt; cA = nA; cB = nB; ++ui;
        if constexpr (ALIGN_EPI) { if (wr == 1) PG8_BAR; }
    }
    PG8_WAIT_V(0);
    if constexpr (!ALIGN_EPI) { if (wr == 0) PG8_BAR; }
    PG8_BAR;
    if constexpr (Epi::AFTER_DRAIN) { E.fused(acc, cur, wr, wc, fr, fq, lds, wid, lane); S.done(cur); }
#undef PG8_SA
#undef PG8_SB
#undef PG8_STAGE
#undef PG8_LDA
#undef PG8_LDB
#undef PG8_MMA
#undef PG8_WAIT_V
#undef PG8_WAIT_L
#undef PG8_BAR
#undef PG8_SCHED
}
}
#define LAS __attribute__((address_space(3)))
#define XB_TMO      128
#define XB_XCNT(j)  (256  + 64 * (j))
#define XB_XSUB(j)  (1280 + 64 * (j))
#define XB_XGEN(j)  (2304 + 64 * (j))
#define XB_TOP      3328
#define XB_TOPGEN   3392
#define XCD_BAR_WORDS 3456
#define XB_SPIN_CAP (1u << 18)

__device__ __forceinline__ unsigned xb_ld(unsigned* p)              { return __hip_atomic_load(p, __ATOMIC_RELAXED, __HIP_MEMORY_SCOPE_AGENT); }
__device__ __forceinline__ unsigned xb_add(unsigned* p, unsigned v) { return __hip_atomic_fetch_add(p, v, __ATOMIC_RELAXED, __HIP_MEMORY_SCOPE_AGENT); }
__device__ __forceinline__ unsigned xb_xcc_id() { return (unsigned)__builtin_amdgcn_s_getreg((3 << 11) | 20) & 0xFu; }
#define XB_SPIN(cond, bar) do { unsigned _sp = 0; while (cond) { __builtin_amdgcn_s_sleep(1); \
    if ((++_sp & 255u) == 0u) { if (xb_ld(&(bar)[XB_TMO])) break; if (_sp > XB_SPIN_CAP) { atomicAdd(&(bar)[XB_TMO], 1u); break; } } } } while (0)

struct XcdBarrier {
    unsigned* bar; unsigned x;
    volatile LAS unsigned* st;
};

__device__ __forceinline__ XcdBarrier xcd_barrier_post(unsigned* bar, volatile LAS unsigned* st) {
    XcdBarrier b; b.bar = bar; b.x = xb_xcc_id(); b.st = st;
    if (threadIdx.x == 0) (void)xb_add(&bar[XB_XCNT(b.x)], 1u);
    return b;
}
__device__ __forceinline__ void xcd_barrier_complete(unsigned* bar, unsigned x, unsigned& nloc, unsigned& nx) {
    const unsigned G = gridDim.x * gridDim.y * gridDim.z;
    unsigned sum, cnt, mine, sp = 0u;
    for (;;) {
        sum = 0u; cnt = 0u; mine = 0u;
#pragma unroll
        for (unsigned j = 0; j < 16; ++j) { const unsigned c = xb_ld(&bar[XB_XCNT(j)]); sum += c; cnt += (c > 0u) ? 1u : 0u; mine = (j == x) ? c : mine; }
        if (sum == G) break;
        __builtin_amdgcn_s_sleep(1);
        if ((++sp & 255u) == 0u) { if (xb_ld(&bar[XB_TMO])) break; if (sp > XB_SPIN_CAP) { atomicAdd(&bar[XB_TMO], 1u); break; } }
    }
    nloc = mine > 0u ? mine : 1u; nx = cnt > 0u ? cnt : 1u;
}

__device__ __forceinline__ void xcd_barrier(const XcdBarrier& b) {
    asm volatile("s_waitcnt vmcnt(0)" ::: "memory");
    __syncthreads();
    if (threadIdx.x == 0) {
        unsigned* bar = b.bar;
        __builtin_amdgcn_s_waitcnt(0);
        unsigned nloc = b.st[0], nx = b.st[1];
        if (nloc == 0u) { xcd_barrier_complete(bar, b.x, nloc, nx); b.st[0] = nloc; b.st[1] = nx; }
        const unsigned old = xb_add(&bar[XB_XSUB(b.x)], 1u);
        const unsigned gen = old / nloc;
        if (old + 1u == (gen + 1u) * nloc) {
            __builtin_amdgcn_fence(__ATOMIC_RELEASE, "agent");
            asm volatile("s_waitcnt vmcnt(0)" ::: "memory");
            const unsigned og = xb_add(&bar[XB_TOP], 1u);
            const unsigned tg = og / nx;
            if (og + 1u == (tg + 1u) * nx) xb_add(&bar[XB_TOPGEN], 1u);
            else XB_SPIN(xb_ld(&bar[XB_TOPGEN]) == tg, bar);
            __builtin_amdgcn_fence(__ATOMIC_ACQUIRE, "agent");
            xb_add(&bar[XB_XGEN(b.x)], 1u);
            asm volatile("s_waitcnt vmcnt(0)" ::: "memory");
        } else {
            XB_SPIN(xb_ld(&bar[XB_XGEN(b.x)]) == gen, bar);
            __builtin_amdgcn_fence(__ATOMIC_ACQUIRE, "agent");
            asm volatile("s_waitcnt vmcnt(0)" ::: "memory");
        }
    }
    __syncthreads();
}

#define DI __device__ __forceinline__
#define LDS_WAIT() asm volatile("s_waitcnt lgkmcnt(0)" ::: "memory")
typedef unsigned short bf16;
typedef float f32x4 __attribute__((ext_vector_type(4)));

namespace mk {
constexpr int NB = 8, SEQ = 2048, DM = 1024, NT = NB * SEQ, NL = 2;
constexpr int INW = 3856, ZLD = 4096;
constexpr int ZA = 0, ZRKV = 768, ZWDF = 1920, ZWDB = 1984, ZADF = 2048, ZADB = 2112, ZGD = 2176, ZMQK = 2304, ZMV = 3072, ZMO = 3456, ZMG = 3840;
constexpr int RW = 384, MW = 384, AW = 256;
constexpr int NE = 16, CAP = 256, FF = 2816, NSLOT = NB * NE * CAP;
constexpr int NWAVES = 8, NTHR = 512;
constexpr float RMS_EPS = 1e-6f;

enum { I_X = 0, I_RELB, I_LN1G, I_WIN, I_WOUT, I_MU, I_W0, I_W2, I_A0, I_A2, I_KK, I_KA, I_RK, I_G2, I_RLNG, I_RLNB,
       I_CW, I_CB, I_IB, I_FB, I_MLNG, I_LN2G, I_ROUTER, I_EW1, I_EW3, I_EW2, I_FG, N_IN };

constexpr size_t MiB = 1u << 20;
constexpr size_t WS_CTL = 0, CTL_ZERO_BYTES = 1 * MiB;
constexpr size_t WS_WTIN = 2 * MiB;
constexpr size_t WS_WTOUT = 18 * MiB;
constexpr size_t WS_W13T = 22 * MiB;
constexpr size_t WS_W2T = 374 * MiB;
constexpr size_t WS_X1 = 550 * MiB;
constexpr size_t WS_X2 = 614 * MiB;
constexpr size_t WS_HB = 678 * MiB;
constexpr size_t WS_AFF = 710 * MiB;
constexpr size_t WS_SEL = 711 * MiB;
constexpr size_t WS_GATE = 712 * MiB;
constexpr size_t WS_G2T = 713 * MiB;
constexpr size_t WS_LWT = 713 * MiB + 256 * 1024;
constexpr size_t WS_R = 714 * MiB;
constexpr size_t WS_Z = WS_R;
constexpr size_t WS_ATTO = WS_R + 128 * MiB;
constexpr size_t WS_ATTL = WS_R + 152 * MiB;
constexpr size_t WS_PR = WS_R + 154 * MiB;
constexpr size_t WS_RKY = WS_R + 442 * MiB;
constexpr size_t WS_RKB = WS_R + 490 * MiB;
constexpr size_t WS_MLQK = WS_R + 538 * MiB;
constexpr size_t WS_MLNUM = WS_R + 586 * MiB;
constexpr size_t WS_MLDEN = WS_R + 634 * MiB;
constexpr size_t WS_XG = WS_R;
constexpr size_t WS_ACT = WS_R + 64 * MiB;
constexpr size_t WS_YS = WS_R + 240 * MiB;
constexpr size_t WS_END = WS_R + 636 * MiB;

constexpr int CW_BAR = 4096;
constexpr int LDS_BYTES = 147456;
constexpr int MISC_OFF = LDS_BYTES - 256;

struct Args { const float* in[N_IN]; float* out; unsigned char* ws; int ph_lo, ph_hi; };

DI float bf2f(unsigned v) { return __uint_as_float(v << 16); }
DI unsigned f2bf(float f) { unsigned u = __float_as_uint(f); return (u + 0x7fffu + ((u >> 16) & 1u)) >> 16; }
DI unsigned pk2(float lo, float hi) { return f2bf(lo) | (f2bf(hi) << 16); }
DI float wave_sum(float v) {
#pragma unroll
    for (int o = 1; o < 64; o <<= 1) v += __shfl_xor(v, o);
    return v;
}
DI float sigm(float x) { return 1.f / (1.f + __expf(-x)); }
DI void unpack8(const uint4 w, float (&f)[8]) {
    f[0] = __uint_as_float(w.x << 16); f[1] = __uint_as_float(w.x & 0xffff0000u); f[2] = __uint_as_float(w.y << 16); f[3] = __uint_as_float(w.y & 0xffff0000u);
    f[4] = __uint_as_float(w.z << 16); f[5] = __uint_as_float(w.z & 0xffff0000u); f[6] = __uint_as_float(w.w << 16); f[7] = __uint_as_float(w.w & 0xffff0000u);
}

struct GroupOrder {
    int G, c2, nunits, per_e, nN;
    DI void init(int nN_, int G_, int bid) { nN = nN_; per_e = 8 * nN_; nunits = NE * per_e; G = G_; c2 = (G_ % 8 == 0) ? (bid % 8) * (G_ / 8) + bid / 8 : bid; }
    DI bool next(int i, pg8::Unit& u) const {
        const long L = (long)i * G + c2; if (L >= nunits) return false;
        const int e = (int)L / per_e, r = (int)L % per_e; u.pm = e * 8 + (r & 7); u.pn = e * nN + (r >> 3); return true;
    }
    DI void a_ready(const pg8::Unit&) const {}
    DI void done(const pg8::Unit&) const {}
};
DI unsigned pkbf(float lo, float hi) { typedef __bf16 b2 __attribute__((ext_vector_type(2))); typedef float f2 __attribute__((ext_vector_type(2))); const f2 v = {lo, hi}; return __builtin_bit_cast(unsigned, __builtin_convertvector(v, b2)); }
template <bool BASE_BF16>
struct EpiResT {
    static constexpr bool PERM = false, AFTER_DRAIN = false;
    const void* base; bf16* out; int ldc;
    DI void operator()(const pg8::f32x4 (&acc)[2][2][4][2], const pg8::Unit& u, int wr, int wc, int fr, int fq) const {
        const int row0 = u.pm * 256 + wr * 64 + fr, col0 = u.pn * 256 + wc * 32 + 4 * fq;
#pragma unroll
        for (int ai = 0; ai < 2; ++ai)
#pragma unroll
            for (int m = 0; m < 4; ++m) { const size_t off = (size_t)(row0 + ai * 128 + m * 16) * ldc + col0;
#pragma unroll
                for (int bj = 0; bj < 2; ++bj)
#pragma unroll
                    for (int n = 0; n < 2; ++n) { pg8::f32x4 b;
                        if constexpr (BASE_BF16) { const uint2 w = *(const uint2*)((const bf16*)base + off + bj * 128 + n * 16);
                            b[0] = __uint_as_float(w.x << 16); b[1] = __uint_as_float(w.x & 0xffff0000u); b[2] = __uint_as_float(w.y << 16); b[3] = __uint_as_float(w.y & 0xffff0000u); }
                        else b = *(const pg8::f32x4*)((const float*)base + off + bj * 128 + n * 16);
                        b += acc[ai][bj][m][n]; uint2 o; o.x = pkbf(b[0], b[1]); o.y = pkbf(b[2], b[3]); *(uint2*)(out + off + bj * 128 + n * 16) = o; } }
    }
};
DI float silu_f(float x) { return x * __builtin_amdgcn_rcpf(1.f + __expf(-x)); }
DI float f8clamp(float x) { return __builtin_amdgcn_fmed3f(x, -448.f, 448.f); }
DI unsigned pk4_fp8(float a, float b, float c, float d) { unsigned p = 0u; p = __builtin_amdgcn_cvt_pk_fp8_f32(f8clamp(a), f8clamp(b), p, false); p = __builtin_amdgcn_cvt_pk_fp8_f32(f8clamp(c), f8clamp(d), p, true); return p; }
constexpr float F8_WSC = 64.f, F8_HSC = 8.f, F8_ASC = 16.f;
struct EpiSwiGLU {
    static constexpr bool PERM = true, AFTER_DRAIN = false;
    unsigned char* act; int nN;
    DI void operator()(const pg8::f32x4 (&acc)[2][2][4][2], const pg8::Unit& u, int wr, int wc, int fr, int fq) const {
        const int lpn = u.pn % nN; const int row0 = u.pm * 256 + wr * 64 + fr, col0 = lpn * 128 + wc * 32 + 8 * fq; constexpr float is = 1.f / (F8_HSC * F8_WSC);
#pragma unroll
        for (int ai = 0; ai < 2; ++ai)
#pragma unroll
            for (int m = 0; m < 4; ++m) { unsigned char* p = act + (size_t)(row0 + ai * 128 + m * 16) * FF + col0;
                const pg8::f32x4 a0 = acc[ai][0][m][0] * is, a1 = acc[ai][0][m][1] * is, g0 = acc[ai][1][m][0] * (is * F8_ASC), g1 = acc[ai][1][m][1] * (is * F8_ASC);
                uint2 w; w.x = pk4_fp8(silu_f(a0[0]) * g0[0], silu_f(a0[1]) * g0[1], silu_f(a0[2]) * g0[2], silu_f(a0[3]) * g0[3]);
                w.y = pk4_fp8(silu_f(a1[0]) * g1[0], silu_f(a1[1]) * g1[1], silu_f(a1[2]) * g1[2], silu_f(a1[3]) * g1[3]);
                *(uint2*)p = w; }
    }
};
struct EpiGate {
    static constexpr bool PERM = true, AFTER_DRAIN = false;
    bf16* ys; const float* gate;
    DI void operator()(const pg8::f32x4 (&acc)[2][2][4][2], const pg8::Unit& u, int wr, int wc, int fr, int fq) const {
        const int row0 = u.pm * 256 + wr * 64 + fr, col0 = (u.pn & 3) * 256 + wc * 32 + 8 * fq;
#pragma unroll
        for (int ai = 0; ai < 2; ++ai)
#pragma unroll
            for (int m = 0; m < 4; ++m) { const int row = row0 + ai * 128 + m * 16; const float g = gate[row] * (1.f / (F8_ASC * F8_WSC)); bf16* p = ys + (size_t)row * DM + col0;
#pragma unroll
                for (int bj = 0; bj < 2; ++bj) { const pg8::f32x4 v0 = acc[ai][bj][m][0] * g, v1 = acc[ai][bj][m][1] * g; pg8::u32x4 w;
                    w.x = pg8::cvt_pk_bf16(v0[0], v0[1]); w.y = pg8::cvt_pk_bf16(v0[2], v0[3]); w.z = pg8::cvt_pk_bf16(v1[0], v1[1]); w.w = pg8::cvt_pk_bf16(v1[2], v1[3]);
                    *(pg8::u32x4*)(p + bj * 128) = w; } }
    }
};

DI void cvt_tile(const float* W, int N, int nvalid, int k0, int n0, bf16* dst, int Kd, size_t drow0, LAS float* scr, int lane) {
    const int c4 = (lane & 15) * 4, kr = lane >> 4;
#pragma unroll
    for (int it = 0; it < 16; ++it) { const int k = it * 4 + kr; float4 v = make_float4(0.f, 0.f, 0.f, 0.f);
        if (n0 + c4 < nvalid) v = *(const float4*)(W + (size_t)(k0 + k) * N + n0 + c4);
        LAS float* s = scr + k * 65 + c4; s[0] = v.x; s[1] = v.y; s[2] = v.z; s[3] = v.w; }
    LDS_WAIT(); asm volatile("" ::: "memory");
    const int c = lane & 7;
#pragma unroll
    for (int it = 0; it < 8; ++it) { const int n = it * 8 + (lane >> 3); const LAS float* s = scr + (8 * c) * 65 + n;
        uint4 o; o.x = pk2(s[0], s[65]); o.y = pk2(s[130], s[195]); o.z = pk2(s[260], s[325]); o.w = pk2(s[390], s[455]);
        *(uint4*)(dst + (drow0 + n) * (size_t)Kd + k0 + 8 * c) = o; }
    LDS_WAIT(); asm volatile("" ::: "memory");
}
DI void cvt_tile_fp8(const float* W, int N, int k0, int n0, unsigned char* dst, int Kd, size_t drow0, float sc, LAS unsigned char* scr, int lane) {
    const int nq = lane & 15, kq = lane >> 4;
#pragma unroll
    for (int hb = 0; hb < 2; ++hb) {
        f32x4 v[4][4];
#pragma unroll
        for (int it = 0; it < 4; ++it)
#pragma unroll
            for (int j = 0; j < 4; ++j) v[it][j] = __builtin_nontemporal_load((const f32x4*)(W + (size_t)(k0 + hb * 64 + it * 16 + kq * 4 + j) * N + n0 + 4 * nq));
#pragma unroll
        for (int it = 0; it < 4; ++it)
#pragma unroll
            for (int i = 0; i < 4; ++i) *(LAS unsigned*)(scr + (4 * nq + i) * 132 + hb * 64 + it * 16 + kq * 4) = pk4_fp8(v[it][0][i] * sc, v[it][1][i] * sc, v[it][2][i] * sc, v[it][3][i] * sc);
    }
    LDS_WAIT(); asm volatile("" ::: "memory");
    const int c = lane & 7;
#pragma unroll
    for (int it = 0; it < 8; ++it) { const int n = it * 8 + (lane >> 3); const LAS unsigned* s = (const LAS unsigned*)(scr + n * 132 + 16 * c);
        uint4 o; o.x = s[0]; o.y = s[1]; o.z = s[2]; o.w = s[3];
        *(uint4*)(dst + (drow0 + n) * (size_t)Kd + k0 + 16 * c) = o; }
    LDS_WAIT(); asm volatile("" ::: "memory");
}
DI void phase_p0(const Args& A, LAS unsigned char* lds, int it0, int it1, int gw, int ngw, int wave, int lane) {
    LAS float* scr = (LAS float*)(lds + wave * 16896);
    bf16* wtin = (bf16*)(A.ws + WS_WTIN); bf16* wtout = (bf16*)(A.ws + WS_WTOUT); unsigned char* w13 = A.ws + WS_W13T; unsigned char* w2t = A.ws + WS_W2T;
    constexpr int I_IN = NL * 16 * 64, I_OUT = NL * 16 * 16, I_E = 8 * 44, I_MOE = NL * NE * 3 * I_E;
    for (int it = it0 + gw; it < it1; it += ngw) {
        int r = it;
        if (r < I_IN) { const int l = r / 1024, t = r % 1024, kb = t / 64, nb = t % 64;
            cvt_tile(A.in[I_WIN] + (size_t)l * DM * INW, INW, INW, kb * 64, nb * 64, wtin + (size_t)l * ZLD * DM, DM, (size_t)nb * 64, scr, lane); continue; }
        r -= I_IN;
        if (r < I_OUT) { const int l = r / 256, t = r % 256, kb = t / 16, nb = t % 16;
            cvt_tile(A.in[I_WOUT] + (size_t)l * DM * DM, DM, DM, kb * 64, nb * 64, wtout + (size_t)l * DM * DM, DM, (size_t)nb * 64, scr, lane); continue; }
        r -= I_OUT;
        const int le = r / (3 * I_E), q = r % (3 * I_E), which = q / I_E, t = q % I_E;
        if (which < 2) { const int kb = t / 44, nb = t % 44, n0 = nb * 64;
            cvt_tile_fp8(A.in[which == 0 ? I_EW1 : I_EW3] + (size_t)le * DM * FF, FF, kb * 128, n0, w13 + (size_t)le * 5632 * DM, DM, (size_t)((n0 >> 7) * 256 + which * 128 + (n0 & 127)), F8_WSC, (LAS unsigned char*)scr, lane); }
        else { const int kb = t / 16, nb = t % 16;
            cvt_tile_fp8(A.in[I_EW2] + (size_t)le * FF * DM, DM, kb * 128, nb * 64, w2t + (size_t)le * DM * FF, FF, (size_t)nb * 64, F8_WSC, (LAS unsigned char*)scr, lane); }
    }
    if (it0 == 0) { bf16* g2t = (bf16*)(A.ws + WS_G2T);
        for (int idx = gw * 64 + lane; idx < NL * 128 * RW; idx += ngw * 64) { const int col = idx % RW, j = (idx / RW) % 128, l = idx / (128 * RW); g2t[((size_t)l * RW + col) * 128 + j] = (bf16)f2bf(A.in[I_G2][idx]); } }
}

DI void load_row(const float* xrow, int lane, f32x4 (&v)[4]) {
    const f32x4* xr = (const f32x4*)xrow + lane;
#pragma unroll
    for (int j = 0; j < 4; ++j) v[j] = xr[64 * j];
}
DI void load_row_bf(const bf16* xrow, int lane, f32x4 (&v)[4]) {
    const uint2* xr = (const uint2*)xrow + lane;
#pragma unroll
    for (int j = 0; j < 4; ++j) { const uint2 w = xr[64 * j]; v[j][0] = __uint_as_float(w.x << 16); v[j][1] = __uint_as_float(w.x & 0xffff0000u); v[j][2] = __uint_as_float(w.y << 16); v[j][3] = __uint_as_float(w.y & 0xffff0000u); }
}
DI void add_slots(const Args& A, int tok, int lane, f32x4 (&v)[4]) {
    const int* sel = (const int*)(A.ws + WS_SEL); const bf16* ys = (const bf16*)(A.ws + WS_YS);
    const int b = tok / SEQ; const int mys = (lane < NE) ? sel[(size_t)tok * NE + lane] : -1;
    for (int e = 0; e < NE; ++e) { const int r = __shfl(mys, e);
        if (r >= 0) { const uint2* p = (const uint2*)(ys + (size_t)((e * NB + b) * CAP + r) * DM) + lane;
#pragma unroll
            for (int j = 0; j < 4; ++j) { const uint2 w = p[64 * j]; v[j][0] += __uint_as_float(w.x << 16); v[j][1] += __uint_as_float(w.x & 0xffff0000u); v[j][2] += __uint_as_float(w.y << 16); v[j][3] += __uint_as_float(w.y & 0xffff0000u); } } }
}
DI float row_rstd(const f32x4 (&v)[4]) {
    float s = 0.f;
#pragma unroll
    for (int j = 0; j < 4; ++j) s += (v[j][0] * v[j][0] + v[j][1] * v[j][1]) + (v[j][2] * v[j][2] + v[j][3] * v[j][3]);
    return rsqrtf(wave_sum(s) * (1.f / DM) + RMS_EPS);
}
DI void phase_ln1(const Args& A, int l, int gw, int ngw, int lane) {
    const float* xin = A.in[I_X]; const bf16* x1 = (const bf16*)(A.ws + WS_X1); bf16* x2 = (bf16*)(A.ws + WS_X2); bf16* hb = (bf16*)(A.ws + WS_HB);
    f32x4 gg[4];
#pragma unroll
    for (int j = 0; j < 4; ++j) gg[j] = ((const f32x4*)(A.in[I_LN1G] + (size_t)l * DM) + lane)[64 * j];
    for (int tok = gw; tok < NT; tok += 2 * ngw) {
        const int tokb = tok + ngw; const bool hb2 = tokb < NT;
        f32x4 va[4], vb[4];
        if (l == 0) { load_row(xin + (size_t)tok * DM, lane, va); load_row(xin + (size_t)(hb2 ? tokb : tok) * DM, lane, vb); }
        else { load_row_bf(x1 + (size_t)tok * DM, lane, va); load_row_bf(x1 + (size_t)(hb2 ? tokb : tok) * DM, lane, vb);
            add_slots(A, tok, lane, va); add_slots(A, hb2 ? tokb : tok, lane, vb);
            uint2* oa = (uint2*)(x2 + (size_t)tok * DM) + lane; uint2* ob = (uint2*)(x2 + (size_t)tokb * DM) + lane;
#pragma unroll
            for (int j = 0; j < 4; ++j) { uint2 w; w.x = pkbf(va[j][0], va[j][1]); w.y = pkbf(va[j][2], va[j][3]); oa[64 * j] = w;
                if (hb2) { uint2 u; u.x = pkbf(vb[j][0], vb[j][1]); u.y = pkbf(vb[j][2], vb[j][3]); ob[64 * j] = u; } } }
        const float ra = row_rstd(va), rb = row_rstd(vb); uint2* o8a = (uint2*)(hb + (size_t)tok * DM) + lane; uint2* o8b = (uint2*)(hb + (size_t)tokb * DM) + lane;
#pragma unroll
        for (int j = 0; j < 4; ++j) { uint2 w; w.x = pkbf(va[j][0] * ra * gg[j][0], va[j][1] * ra * gg[j][1]); w.y = pkbf(va[j][2] * ra * gg[j][2], va[j][3] * ra * gg[j][3]); o8a[64 * j] = w;
            if (hb2) { uint2 u; u.x = pkbf(vb[j][0] * rb * gg[j][0], vb[j][1] * rb * gg[j][1]); u.y = pkbf(vb[j][2] * rb * gg[j][2], vb[j][3] * rb * gg[j][3]); o8b[64 * j] = u; } }
    }
}
DI void phase_final(const Args& A, int gw, int ngw, int lane) {
    const bf16* xin = (const bf16*)(A.ws + WS_X1);
    f32x4 gg[4];
#pragma unroll
    for (int j = 0; j < 4; ++j) gg[j] = ((const f32x4*)A.in[I_FG] + lane)[64 * j];
    for (int tok = gw; tok < NT; tok += 2 * ngw) {
        const int tokb = tok + ngw; const bool hb2 = tokb < NT;
        f32x4 va[4], vb[4]; load_row_bf(xin + (size_t)tok * DM, lane, va); load_row_bf(xin + (size_t)(hb2 ? tokb : tok) * DM, lane, vb);
        add_slots(A, tok, lane, va); add_slots(A, hb2 ? tokb : tok, lane, vb);
        const float ra = row_rstd(va), rb = row_rstd(vb); f32x4* oa = (f32x4*)(A.out + (size_t)tok * DM) + lane; f32x4* ob = (f32x4*)(A.out + (size_t)tokb * DM) + lane;
#pragma unroll
        for (int j = 0; j < 4; ++j) { oa[64 * j] = va[j] * ra * gg[j]; if (hb2) ob[64 * j] = vb[j] * rb * gg[j]; }
    }
}
DI void ln2_row(const f32x4 (&v)[4], const f32x4 (&gg)[4], const LAS float* rt, unsigned char* hrow, float* affrow, int lane) {
    const float rs = row_rstd(v); unsigned* o8 = (unsigned*)hrow + lane;
    float lg[NE];
#pragma unroll
    for (int e = 0; e < NE; ++e) lg[e] = 0.f;
#pragma unroll
    for (int j = 0; j < 4; ++j) { f32x4 h; h[0] = v[j][0] * rs * gg[j][0]; h[1] = v[j][1] * rs * gg[j][1]; h[2] = v[j][2] * rs * gg[j][2]; h[3] = v[j][3] * rs * gg[j][3];
        o8[64 * j] = pk4_fp8(h[0] * F8_HSC, h[1] * F8_HSC, h[2] * F8_HSC, h[3] * F8_HSC);
#pragma unroll
        for (int e = 0; e < NE; ++e) { const f32x4 rr = *(const LAS f32x4*)(rt + e * DM + 256 * j + 4 * lane); lg[e] += (h[0] * rr[0] + h[1] * rr[1]) + (h[2] * rr[2] + h[3] * rr[3]); }
        asm volatile("" ::: "memory"); }
    float mx = -3.0e38f;
#pragma unroll
    for (int e = 0; e < NE; ++e) { lg[e] = wave_sum(lg[e]); mx = fmaxf(mx, lg[e]); }
    float sum = 0.f;
#pragma unroll
    for (int e = 0; e < NE; ++e) { lg[e] = expf(lg[e] - mx); sum += lg[e]; }
    const float inv = 1.f / sum;
#pragma unroll
    for (int e = 0; e < NE; ++e) if (lane == e) affrow[(size_t)e * SEQ] = lg[e] * inv;
}
DI void phase_ln2(const Args& A, int l, LAS unsigned char* lds, int gw, int ngw, int tid, int lane) {
    const bf16* xin = (const bf16*)(A.ws + WS_X1); unsigned char* hb = A.ws + WS_HB; float* aff = (float*)(A.ws + WS_AFF);
    const float* router = A.in[I_ROUTER] + (size_t)l * DM * NE; LAS float* rt = (LAS float*)lds;
    __syncthreads();
    for (int i = tid; i < DM * NE; i += NTHR) rt[(i & 15) * DM + (i >> 4)] = router[i];
    __syncthreads();
    f32x4 gg[4];
#pragma unroll
    for (int j = 0; j < 4; ++j) gg[j] = ((const f32x4*)(A.in[I_LN2G] + (size_t)l * DM) + lane)[64 * j];
    for (int tok = gw; tok < NT; tok += 2 * ngw) {
        const int tokb = tok + ngw; const bool hb2 = tokb < NT;
        f32x4 va[4], vb[4]; load_row_bf(xin + (size_t)tok * DM, lane, va); load_row_bf(xin + (size_t)(hb2 ? tokb : tok) * DM, lane, vb);
        ln2_row(va, gg, rt, hb + (size_t)tok * DM, aff + (size_t)(tok / SEQ) * NE * SEQ + (tok % SEQ), lane);
        if (hb2) ln2_row(vb, gg, rt, hb + (size_t)tokb * DM, aff + (size_t)(tokb / SEQ) * NE * SEQ + (tokb % SEQ), lane);
    }
    __syncthreads();
}
DI void phase_topk(const Args& A, LAS unsigned char* lds, int bid, int G, int tid, int wave, int lane) {
    const unsigned* affk = (const unsigned*)(A.ws + WS_AFF); int* sel = (int*)(A.ws + WS_SEL); float* gate = (float*)(A.ws + WS_GATE);
    const unsigned char* hb = A.ws + WS_HB; unsigned char* xg = A.ws + WS_XG;
    LAS unsigned* hist = (LAS unsigned*)lds;
    LAS unsigned* wsum = hist + 32;
    LAS int* list = (LAS int*)(lds + 256);
    for (int u = bid; u < NB * NE * 2; u += G) {
        const int half = u & 1, e = (u >> 1) % NE, b = u / (2 * NE);
        __syncthreads();
        if (tid < 32) hist[tid] = 0u;
        const uint4 kv = *(const uint4*)(affk + (size_t)(b * NE + e) * SEQ + tid * 4);
        const unsigned key[4] = {kv.x, kv.y, kv.z, kv.w};
        __syncthreads();
        unsigned prefix = 0u, krem = CAP;
#pragma unroll 1
        for (int pass = 0; pass < 8; ++pass) { const int shift = 28 - 4 * pass; LAS unsigned* h = hist + (pass & 1) * 16;
            unsigned cnt = 0u;
#pragma unroll
            for (int i = 0; i < 4; ++i) { const bool cand = (pass == 0) || ((key[i] >> (shift + 4)) == prefix); const unsigned bin = (key[i] >> shift) & 15u;
#pragma unroll
                for (int v = 0; v < 16; ++v) { const unsigned long long m = __ballot(cand && bin == (unsigned)v); if (lane == v) cnt += (unsigned)__popcll(m); } }
            if (lane < 16 && cnt) atomicAdd((unsigned*)(h + lane), cnt);
            __syncthreads();
            unsigned acc = 0u, pick = 0u, before = 0u;
#pragma unroll
            for (int v = 15; v >= 0; --v) { const unsigned c = h[v]; if (acc < krem && acc + c >= krem) { pick = (unsigned)v; before = acc; } acc += c; }
            prefix = (prefix << 4) | pick; krem -= before;
            if (tid < 16) hist[((pass + 1) & 1) * 16 + tid] = 0u;
            __syncthreads();
        }
        const unsigned tau = prefix;
        unsigned gt[4], eq[4]; unsigned ngt = 0u, neq = 0u;
#pragma unroll
        for (int i = 0; i < 4; ++i) { gt[i] = key[i] > tau ? 1u : 0u; eq[i] = key[i] == tau ? 1u : 0u; ngt += gt[i]; neq += eq[i]; }
        unsigned sg = ngt, se = neq;
#pragma unroll
        for (int o = 1; o < 64; o <<= 1) { const unsigned tg = __shfl_up(sg, o), te = __shfl_up(se, o); if (lane >= o) { sg += tg; se += te; } }
        if (lane == 63) { wsum[wave] = sg; wsum[8 + wave] = se; }
        __syncthreads();
        unsigned offg = 0u, offe = 0u;
        for (int w = 0; w < wave; ++w) { offg += wsum[w]; offe += wsum[8 + w]; }
        unsigned eqbefore = offe + se - neq;
        unsigned gtbefore = offg + sg - ngt;
        const int slot0 = (e * NB + b) * CAP;
#pragma unroll
        for (int i = 0; i < 4; ++i) { const int s = tid * 4 + i; const bool selq = gt[i] || (eq[i] && eqbefore < krem);
            const unsigned pos = gtbefore + (eqbefore < krem ? eqbefore : krem);
            if ((s >> 10) == half) { sel[(size_t)(b * SEQ + s) * NE + e] = selq ? (int)pos : -1;
                if (selq) { gate[slot0 + pos] = __uint_as_float(key[i]); } }
            if (selq && pos < CAP) list[pos] = s;
            gtbefore += gt[i]; eqbefore += eq[i]; }
        __syncthreads();
        for (int r = wave; r < CAP; r += NWAVES) { const int s = list[r];
            if ((s >> 10) == half) { const uint4* src = (const uint4*)(hb + (size_t)(b * SEQ + s) * DM) + lane; uint4* dstp = (uint4*)(xg + (size_t)(slot0 + r) * DM) + lane; dstp[0] = src[0]; } }
    }
    __syncthreads();
}

DI int t5_bucket(int rel) {
    const int ret = rel > 0 ? 16 : 0; const int n = rel < 0 ? -rel : rel;
    if (n < 8) return ret + n;
    int large = 8 + (int)(logf((float)n / 8.0f) / 4.852030263919617f * 8.0f);
    large = large < 15 ? large : 15;
    return ret + large;
}

typedef short bf16x8_t __attribute__((ext_vector_type(8)));
typedef short bf16x4_t __attribute__((ext_vector_type(4)));
typedef unsigned u32x4_t __attribute__((ext_vector_type(4)));
typedef unsigned u32x2_t __attribute__((ext_vector_type(2)));
typedef __bf16 bf2_t __attribute__((ext_vector_type(2)));
typedef float f2_t __attribute__((ext_vector_type(2)));
DI unsigned cvtpk(float lo, float hi) { const f2_t v = {lo, hi}; return __builtin_bit_cast(unsigned, __builtin_convertvector(v, bf2_t)); }
#define MFMA16(a, b, c) __builtin_amdgcn_mfma_f32_16x16x32_bf16((a), (b), (c), 0, 0, 0)

constexpr int AT_QS = 0, AT_QLD = 72;
constexpr int AT_KS = AT_QS + 128 * AT_QLD * 2;
constexpr int AT_VT = AT_KS + 272 * AT_QLD * 2, AT_VLD = 280;
constexpr int AT_BT = AT_VT + 64 * AT_VLD * 2;
constexpr int AT_END = AT_BT + 132 * 4;
static_assert(AT_END <= MISC_OFF, "attention LDS");

DI void attn_unit(const Args& A, LAS unsigned char* lds, int unit, int tid, int wave, int lane) {
    const bf16* Z = (const bf16*)(A.ws + WS_Z); bf16* ao = (bf16*)(A.ws + WS_ATTO); float* al = (float*)(A.ws + WS_ATTL);
    const int x = unit & 15; int r0 = unit >> 4; const int hh = r0 & 3; r0 >>= 2; const int b = r0 % NB, br = r0 / NB;
    const int dil = br == 0 ? 1 : (br == 1 ? 4 : 16), lsub = SEQ / dil, nblk = lsub / 128;
    const int res = x / nblk, nbk = x % nblk, l0 = nbk * 128, wbase = l0 - 64;
    LAS bf16* Qs = (LAS bf16*)(lds + AT_QS); LAS bf16* Ks = (LAS bf16*)(lds + AT_KS); LAS bf16* Vt = (LAS bf16*)(lds + AT_VT); LAS float* btab = (LAS float*)(lds + AT_BT);
    __syncthreads();
#pragma unroll
    for (int i = 0; i < 2; ++i) { const int id = tid + 512 * i, row = id >> 3, ch = id & 7; const int tok = b * SEQ + (l0 + row) * dil + res;
        *(LAS u32x4_t*)(Qs + row * AT_QLD + ch * 8) = *(const u32x4_t*)(Z + (size_t)tok * ZLD + ZA + hh * 64 + ch * 8); }
    for (int id = tid; id < 272 * 8; id += NTHR) { const int row = id >> 3, ch = id & 7; const int pos = wbase + row; u32x4_t v = (u32x4_t){0u, 0u, 0u, 0u};
        if (row < 256 && pos >= 0 && pos < lsub) v = *(const u32x4_t*)(Z + (size_t)(b * SEQ + pos * dil + res) * ZLD + ZA + 256 + hh * 64 + ch * 8);
        *(LAS u32x4_t*)(Ks + row * AT_QLD + ch * 8) = v; }
    for (int id = tid; id < 272 * 8; id += NTHR) { const int key = id % 272, ch = id / 272; const int pos = wbase + key; u32x4_t v = (u32x4_t){0u, 0u, 0u, 0u};
        if (key < 256 && pos >= 0 && pos < lsub) v = *(const u32x4_t*)(Z + (size_t)(b * SEQ + pos * dil + res) * ZLD + ZA + 512 + hh * 64 + ch * 8);
        LAS bf16* d = Vt + (ch * 8) * AT_VLD + key;
        d[0] = (bf16)(v.x & 0xffffu); d[AT_VLD] = (bf16)(v.x >> 16); d[2 * AT_VLD] = (bf16)(v.y & 0xffffu); d[3 * AT_VLD] = (bf16)(v.y >> 16);
        d[4 * AT_VLD] = (bf16)(v.z & 0xffffu); d[5 * AT_VLD] = (bf16)(v.z >> 16); d[6 * AT_VLD] = (bf16)(v.w & 0xffffu); d[7 * AT_VLD] = (bf16)(v.w >> 16); }
    if (tid < 129) btab[tid] = A.in[I_RELB][t5_bucket((tid - 64) * dil) * 4 + hh];
    __syncthreads();
    const int fr = lane & 15, qd = lane >> 4;
    f32x4 acc[10];
    { bf16x8_t qb[2];
#pragma unroll
      for (int ks = 0; ks < 2; ++ks) qb[ks] = *(const LAS bf16x8_t*)(Qs + (16 * wave + fr) * AT_QLD + ks * 32 + 8 * qd);
#pragma unroll
      for (int j = 0; j < 10; ++j) { acc[j] = (f32x4){0.f, 0.f, 0.f, 0.f};
#pragma unroll
          for (int ks = 0; ks < 2; ++ks) { const bf16x8_t ka = *(const LAS bf16x8_t*)(Ks + (16 * (wave + j) + fr) * AT_QLD + ks * 32 + 8 * qd); acc[j] = MFMA16(ka, qb[ks], acc[j]); } } }
    const int iq = 16 * wave + fr; float mx = -1.0e30f;
#pragma unroll
    for (int j = 0; j < 10; ++j)
#pragma unroll
        for (int r = 0; r < 4; ++r) { const int kw = 16 * (wave + j) + 4 * qd + r; const int m = kw - 64 - iq; const int pos = wbase + kw;
            const bool valid = (m >= -64) && (m <= 64) && (pos >= 0) && (pos < lsub);
            const float s = valid ? acc[j][r] * 0.125f + btab[valid ? m + 64 : 0] : -1.0e30f; acc[j][r] = s; mx = fmaxf(mx, s); }
    mx = fmaxf(mx, __shfl_xor(mx, 16)); mx = fmaxf(mx, __shfl_xor(mx, 32));
    float lsum = 0.f;
#pragma unroll
    for (int j = 0; j < 10; ++j)
#pragma unroll
        for (int r = 0; r < 4; ++r) { const float p = __expf(acc[j][r] - mx); acc[j][r] = p; lsum += p; }
    lsum += __shfl_xor(lsum, 16); lsum += __shfl_xor(lsum, 32);
    f32x4 oacc[4];
#pragma unroll
    for (int d = 0; d < 4; ++d) oacc[d] = (f32x4){0.f, 0.f, 0.f, 0.f};
#pragma unroll
    for (int pp = 0; pp < 5; ++pp) {
        union { unsigned u[4]; bf16x8_t v; } pb;
        pb.u[0] = cvtpk(acc[2 * pp][0], acc[2 * pp][1]); pb.u[1] = cvtpk(acc[2 * pp][2], acc[2 * pp][3]); pb.u[2] = cvtpk(acc[2 * pp + 1][0], acc[2 * pp + 1][1]); pb.u[3] = cvtpk(acc[2 * pp + 1][2], acc[2 * pp + 1][3]);
#pragma unroll
        for (int d = 0; d < 4; ++d) { const LAS bf16* vp = Vt + (16 * d + fr) * AT_VLD + 16 * (wave + 2 * pp) + 4 * qd;
            union { bf16x4_t h[2]; bf16x8_t v; } va; va.h[0] = *(const LAS bf16x4_t*)vp; va.h[1] = *(const LAS bf16x4_t*)(vp + 16);
            oacc[d] = MFMA16(va.v, pb.v, oacc[d]); } }
    const float inv = 1.f / lsum; const int tok = b * SEQ + (l0 + iq) * dil + res;
    bf16* op = ao + ((size_t)br * NT + tok) * AW + hh * 64 + 4 * qd;
#pragma unroll
    for (int d = 0; d < 4; ++d) { uint2 w; w.x = cvtpk(oacc[d][0] * inv, oacc[d][1] * inv); w.y = cvtpk(oacc[d][2] * inv, oacc[d][3] * inv); *(uint2*)(op + 16 * d) = w; }
    if (qd == 0) al[((size_t)br * NT + tok) * 4 + hh] = mx + logf(lsum);
}
DI void phase_attn(const Args& A, LAS unsigned char* lds, int bid, int G, int tid, int wave, int lane) {
    for (int u = bid; u < 3 * NB * 4 * 16; u += G) attn_unit(A, lds, u, tid, wave, lane);
    __syncthreads();
}


constexpr int ML_QLD = 104, ML_SLD = 72;
constexpr int ML_QS = 0;
constexpr int ML_QT = ML_QS + 64 * ML_QLD * 2;
constexpr int ML_KS = ML_QT + 64 * ML_QLD * 2;
constexpr int ML_KT = ML_KS + 64 * ML_QLD * 2;
constexpr int ML_VT = ML_KT + 96 * ML_SLD * 2;
constexpr int ML_WS = ML_VT + 112 * ML_SLD * 2;
constexpr int ML_CT = ML_WS + 64 * ML_SLD * 2;
constexpr int ML_CW = ML_CT + 112 * ML_QLD * 2;
constexpr int ML_END = ML_CW + 6 * 192 * 4;
static_assert(ML_END <= MISC_OFF, "mlstm LDS");

constexpr int MLP_QF = 0, MLP_NI = 12288, MLP_U = 26624, MLP_DEC = 48128, MLP_BYTES = 48384;
constexpr size_t WS_MLPKG = WS_R + 304 * MiB;
static_assert(WS_MLPKG + (size_t)2 * NB * 4 * 32 * MLP_BYTES <= WS_RKY, "mlstm package region");

struct M1Regs { u32x4_t zc[15]; u32x2_t vv[3]; float gi, gf; };
DI void mlstm_m1_fetch(const Args& A, int item, int tid, int lane, M1Regs& R) {
    const bf16* Z = (const bf16*)(A.ws + WS_Z);
    const int c = item & 31, u = item >> 5; const int dir = u / 32, b = (u % 32) / 4, hh = u % 4; const int j = tid >> 3, sub = tid & 7;
    const int tl = dir ? SEQ - 1 - (c * 64 + lane) : c * 64 + lane; const size_t tokl = (size_t)b * SEQ + tl;
    R.gi = bf2f(Z[tokl * ZLD + ZMG + dir * 8 + hh]); R.gf = bf2f(Z[tokl * ZLD + ZMG + dir * 8 + 4 + hh]);
    const int tj = dir ? SEQ - 1 - (c * 64 + j) : c * 64 + j; const size_t tokj = (size_t)b * SEQ + tj;
    const bool isk = sub >= 4; const int zcol = ZMQK + (isk ? 384 : 0) + hh * 96 + (sub & 3) * 24;
#pragma unroll
    for (int tap = 0; tap < 5; ++tap) { const int tt = tj + tap - 2; const bool ok = tt >= 0 && tt < SEQ; const u32x4_t* zp = (const u32x4_t*)(Z + ((size_t)b * SEQ + (ok ? tt : tj)) * ZLD + zcol);
#pragma unroll
        for (int q4 = 0; q4 < 3; ++q4) { const u32x4_t w = zp[q4]; R.zc[tap * 3 + q4] = ok ? w : (u32x4_t){0u, 0u, 0u, 0u}; } }
    const u32x2_t* vp = (const u32x2_t*)(Z + tokj * ZLD + ZMV + hh * 96 + sub * 12);
#pragma unroll
    for (int q2 = 0; q2 < 3; ++q2) R.vv[q2] = vp[q2];
}
DI void mlstm_m1_item(const Args& A, int l, LAS unsigned char* lds, int item, int item_next, M1Regs& R, int& hh_staged, int tid, int wave, int lane) {
    const int c = item & 31, u = item >> 5; const int dir = u / 32, hh = u % 4;
    LAS bf16* Qs = (LAS bf16*)(lds + ML_QS); LAS bf16* Qt = (LAS bf16*)(lds + ML_QT); LAS bf16* Ks = (LAS bf16*)(lds + ML_KS); LAS bf16* KtT = (LAS bf16*)(lds + ML_KT);
    LAS bf16* VtT = (LAS bf16*)(lds + ML_VT); LAS bf16* Ws = (LAS bf16*)(lds + ML_WS); LAS float* cwl = (LAS float*)(lds + ML_CW); LAS float* cbl = cwl + 5 * 192;
    const int fr = lane & 15, qd = lane >> 4;
    unsigned char* pkg = A.ws + WS_MLPKG + (size_t)item * MLP_BYTES;
    __syncthreads();
    if (hh != hh_staged) { hh_staged = hh;
        for (int i = tid; i < 5 * 192; i += NTHR) { const int tap = i / 192, ch = i % 192; cwl[i] = A.in[I_CW][(size_t)(l * 5 + tap) * 768 + (ch < 96 ? 0 : 384) + hh * 96 + (ch % 96)]; }
        for (int i = tid; i < 192; i += NTHR) cbl[i] = A.in[I_CB][(size_t)l * 768 + (i < 96 ? 0 : 384) + hh * 96 + (i % 96)];
        for (int i = tid; i < 16 * ML_SLD; i += NTHR) VtT[96 * ML_SLD + i] = (i < ML_SLD) ? (bf16)0x3F80u : (bf16)0u;
        __syncthreads(); }
    const float ibv = A.in[I_IB][(l * 2 + dir) * 4 + hh], fbv = A.in[I_FB][(l * 2 + dir) * 4 + hh];
    const int j = tid >> 3, sub = tid & 7;
    const float gi = R.gi + ibv, gf = R.gf + fbv;
    float bsum = fminf(gf, 0.f) - __logf(1.f + __expf(-fabsf(gf)));
#pragma unroll
    for (int o = 1; o < 64; o <<= 1) { const float t = __shfl_up(bsum, o); if (lane >= o) bsum += t; }
    const float bend = __shfl(bsum, 63);
    const float bj = __shfl(bsum, j), igj = __shfl(gi, j);
    { const bool isk = sub >= 4; const int c0 = (sub & 3) * 24, cl = (isk ? 96 : 0) + c0;
      float acc[24];
#pragma unroll
      for (int e = 0; e < 24; ++e) acc[e] = cbl[cl + e];
#pragma unroll
      for (int tap = 0; tap < 5; ++tap) {
#pragma unroll
          for (int q4 = 0; q4 < 3; ++q4) { const u32x4_t w = R.zc[tap * 3 + q4]; const LAS float* cwp = cwl + tap * 192 + cl + q4 * 8;
              acc[q4 * 8 + 0] += cwp[0] * __uint_as_float(w.x << 16); acc[q4 * 8 + 1] += cwp[1] * __uint_as_float(w.x & 0xffff0000u);
              acc[q4 * 8 + 2] += cwp[2] * __uint_as_float(w.y << 16); acc[q4 * 8 + 3] += cwp[3] * __uint_as_float(w.y & 0xffff0000u);
              acc[q4 * 8 + 4] += cwp[4] * __uint_as_float(w.z << 16); acc[q4 * 8 + 5] += cwp[5] * __uint_as_float(w.z & 0xffff0000u);
              acc[q4 * 8 + 6] += cwp[6] * __uint_as_float(w.w << 16); acc[q4 * 8 + 7] += cwp[7] * __uint_as_float(w.w & 0xffff0000u); } }
      const float sc1 = isk ? 0.10206207261596575f : 1.f; const float sc2 = isk ? __expf(bend - bj + igj) : __expf(bj);
#pragma unroll
      for (int e = 0; e < 24; ++e) acc[e] = acc[e] * sigm(acc[e]) * sc1;
      if (!isk) { LAS bf16* d1 = Qs + j * ML_QLD + c0; LAS bf16* d2 = Qt + j * ML_QLD + c0;
#pragma unroll
          for (int q4 = 0; q4 < 3; ++q4) { u32x4_t w; w.x = cvtpk(acc[q4 * 8 + 0], acc[q4 * 8 + 1]); w.y = cvtpk(acc[q4 * 8 + 2], acc[q4 * 8 + 3]); w.z = cvtpk(acc[q4 * 8 + 4], acc[q4 * 8 + 5]); w.w = cvtpk(acc[q4 * 8 + 6], acc[q4 * 8 + 7]);
              *(LAS u32x4_t*)(d1 + q4 * 8) = w;
              u32x4_t x; x.x = cvtpk(acc[q4 * 8 + 0] * sc2, acc[q4 * 8 + 1] * sc2); x.y = cvtpk(acc[q4 * 8 + 2] * sc2, acc[q4 * 8 + 3] * sc2); x.z = cvtpk(acc[q4 * 8 + 4] * sc2, acc[q4 * 8 + 5] * sc2); x.w = cvtpk(acc[q4 * 8 + 6] * sc2, acc[q4 * 8 + 7] * sc2);
              *(LAS u32x4_t*)(d2 + q4 * 8) = x; } }
      else { LAS bf16* d1 = Ks + j * ML_QLD + c0;
#pragma unroll
          for (int q4 = 0; q4 < 3; ++q4) { u32x4_t w; w.x = cvtpk(acc[q4 * 8 + 0], acc[q4 * 8 + 1]); w.y = cvtpk(acc[q4 * 8 + 2], acc[q4 * 8 + 3]); w.z = cvtpk(acc[q4 * 8 + 4], acc[q4 * 8 + 5]); w.w = cvtpk(acc[q4 * 8 + 6], acc[q4 * 8 + 7]);
              *(LAS u32x4_t*)(d1 + q4 * 8) = w; }
#pragma unroll
          for (int e = 0; e < 24; ++e) KtT[(c0 + e) * ML_SLD + j] = (bf16)f2bf(acc[e] * sc2); } }
    { const int n0 = sub * 12;
#pragma unroll
      for (int q2 = 0; q2 < 3; ++q2) { const u32x2_t w = R.vv[q2]; LAS bf16* d = VtT + (n0 + q2 * 4) * ML_SLD + j;
          d[0] = (bf16)(w.x & 0xffffu); d[ML_SLD] = (bf16)(w.x >> 16); d[2 * ML_SLD] = (bf16)(w.y & 0xffffu); d[3 * ML_SLD] = (bf16)(w.y >> 16); } }
    if (item_next >= 0) mlstm_m1_fetch(A, item_next, tid, lane, R);
    __syncthreads();
#pragma unroll
    for (int i = 0; i < 2; ++i) { const int tile = 2 * wave + i, jt = tile >> 2, st = tile & 3; const int jq = 16 * jt + fr;
        u32x2_t w = (u32x2_t){0u, 0u};
        if (st <= jt) { f32x4 acc = (f32x4){0.f, 0.f, 0.f, 0.f};
#pragma unroll
            for (int ks = 0; ks < 3; ++ks) { const bf16x8_t a = *(const LAS bf16x8_t*)(Ks + (16 * st + fr) * ML_QLD + 32 * ks + 8 * qd); const bf16x8_t bq = *(const LAS bf16x8_t*)(Qs + jq * ML_QLD + 32 * ks + 8 * qd); acc = MFMA16(a, bq, acc); }
            const float bjq = __shfl(bsum, jq); float wv[4];
#pragma unroll
            for (int r = 0; r < 4; ++r) { const int s = 16 * st + 4 * qd + r; const float bs = __shfl(bsum, s), igs = __shfl(gi, s); wv[r] = (s <= jq) ? acc[r] * __expf(bjq - bs + igs) : 0.f; }
            w.x = cvtpk(wv[0], wv[1]); w.y = cvtpk(wv[2], wv[3]); }
        *(LAS u32x2_t*)(Ws + jq * ML_SLD + 16 * st + 4 * qd) = w; }
    __syncthreads();
    for (int id = wave; id < 12; id += NWAVES) { const int jt = id / 3, i3 = id % 3; const LAS bf16* p = Qt + (16 * jt + fr) * ML_QLD + 32 * i3 + 4 * qd; const u32x2_t lo = *(const LAS u32x2_t*)p, hi = *(const LAS u32x2_t*)(p + 16);
        *(u32x4_t*)(pkg + MLP_QF + (size_t)id * 1024 + lane * 16) = (u32x4_t){lo.x, lo.y, hi.x, hi.y}; }
    for (int id = wave; id < 70; id += NWAVES) { f32x4 acc = (f32x4){0.f, 0.f, 0.f, 0.f}; int nt; const LAS bf16* ap; int ald; unsigned char* dst;
        if (id < 28) { const int jt = id & 3; nt = id >> 2; ap = Ws + (16 * jt + fr) * ML_SLD; ald = 0; dst = pkg + MLP_NI + (size_t)(nt * 4 + jt) * 512; }
        else { const int q = id - 28, kt = q % 6; nt = q / 6; ap = KtT + (16 * kt + fr) * ML_SLD; ald = 0; dst = pkg + MLP_U + (size_t)(nt * 6 + kt) * 512; }
#pragma unroll
        for (int ks = 0; ks < 2; ++ks) { const bf16x8_t a = *(const LAS bf16x8_t*)(ap + 32 * ks + 8 * qd); const bf16x8_t bv = *(const LAS bf16x8_t*)(VtT + (16 * nt + fr) * ML_SLD + 32 * ks + 8 * qd); acc = MFMA16(a, bv, acc); }
        u32x2_t w; w.x = cvtpk(acc[0], acc[1]); w.y = cvtpk(acc[2], acc[3]); *(u32x2_t*)(dst + lane * 8) = w; }
    if (tid < 64) ((float*)(pkg + MLP_DEC))[tid] = __expf(bend);
}
DI void phase_mlstm_m1(const Args& A, int l, LAS unsigned char* lds, int bid, int G, int tid, int wave, int lane) {
    int hh_staged = -1; constexpr int NIT = 2 * NB * 4 * 32;
    if (bid < NIT) { M1Regs R; mlstm_m1_fetch(A, bid, tid, lane, R);
        for (int it = bid; it < NIT; it += G) mlstm_m1_item(A, l, lds, it, (it + G < NIT) ? it + G : -1, R, hh_staged, tid, wave, lane); }
    __syncthreads();
}
constexpr int M2_SLOTS = 8, M2_SLOT_BYTES = 12288, M2_CTL = M2_SLOTS * M2_SLOT_BYTES;
static_assert(M2_CTL + 64 <= MISC_OFF, "mlstm m2 LDS");
DI f32x4 unpk4(const u32x2_t w) { return (f32x4){__uint_as_float(w.x << 16), __uint_as_float(w.x & 0xffff0000u), __uint_as_float(w.y << 16), __uint_as_float(w.y & 0xffff0000u)}; }
struct M2Small { u32x2_t ni[4], uu[6]; float dec; };
DI void m2_load_small(M2Small& o, const unsigned char* pkg, int nt, int lane) {
#pragma unroll
    for (int jt = 0; jt < 4; ++jt) o.ni[jt] = *(const u32x2_t*)(pkg + MLP_NI + (nt * 4 + jt) * 512 + lane * 8);
#pragma unroll
    for (int kt = 0; kt < 6; ++kt) o.uu[kt] = *(const u32x2_t*)(pkg + MLP_U + (nt * 6 + kt) * 512 + lane * 8);
    o.dec = ((const float*)(pkg + MLP_DEC))[lane];
}
DI void m2_step(const M2Small& o, const LAS unsigned char* slot, f32x4 (&C)[6], bf16* num, float* den, int dir, int b, int hh, int nt, int c, int lane, int fr, int qd) {
    union { unsigned u[4]; bf16x8_t v; } sB[3];
#pragma unroll
    for (int i = 0; i < 3; ++i) { sB[i].u[0] = cvtpk(C[2 * i][0], C[2 * i][1]); sB[i].u[1] = cvtpk(C[2 * i][2], C[2 * i][3]); sB[i].u[2] = cvtpk(C[2 * i + 1][0], C[2 * i + 1][1]); sB[i].u[3] = cvtpk(C[2 * i + 1][2], C[2 * i + 1][3]); }
#pragma unroll
    for (int jt = 0; jt < 4; ++jt) { f32x4 acc = unpk4(o.ni[jt]);
#pragma unroll
        for (int i = 0; i < 3; ++i) { const bf16x8_t qf = *(const LAS bf16x8_t*)(slot + (3 * jt + i) * 1024 + lane * 16); acc = MFMA16(qf, sB[i].v, acc); }
#pragma unroll
        for (int r = 0; r < 4; ++r) { const int jj = 16 * jt + 4 * qd + r; const int tt = dir ? SEQ - 1 - (c * 64 + jj) : c * 64 + jj; const size_t tok = (size_t)b * SEQ + tt;
            if (nt < 6) num[((size_t)dir * NT + tok) * MW + hh * 96 + 16 * nt + fr] = (bf16)f2bf(acc[r]); else if (fr == 0) den[((size_t)dir * NT + tok) * 4 + hh] = acc[r]; } }
#pragma unroll
    for (int kt = 0; kt < 6; ++kt) C[kt] = C[kt] * o.dec + unpk4(o.uu[kt]);
}
DI void mlstm_m2_unit(const Args& A, LAS unsigned char* lds, int u, int tid, int wave, int lane) {
    bf16* num = (bf16*)(A.ws + WS_MLNUM); float* den = (float*)(A.ws + WS_MLDEN);
    const int dir = u / 32, b = (u % 32) / 4, hh = u % 4; const int fr = lane & 15, qd = lane >> 4;
    const unsigned char* pkg0 = A.ws + WS_MLPKG + (size_t)u * 32 * MLP_BYTES;
    volatile LAS unsigned* ready = (volatile LAS unsigned*)(lds + M2_CTL); volatile LAS unsigned* consumed = ready + 8;
    __syncthreads();
    if (tid < 16) ready[tid] = 0u;
    __syncthreads();
    if (wave == 7) {
        u32x4_t f0[12], f1[12], f2[12];
#define M2_FETCH(dst, c_) do { _Pragma("unroll") for (int i = 0; i < 12; ++i) dst[i] = *(const u32x4_t*)(pkg0 + (size_t)(c_) * MLP_BYTES + MLP_QF + i * 1024 + lane * 16); } while (0)
#define M2_PUBLISH(src, c_) do { if ((c_) >= M2_SLOTS) { const unsigned need = (unsigned)((c_) - M2_SLOTS + 1); unsigned spins = 0; \
            for (;;) { bool ok = true; _Pragma("unroll") for (int w = 0; w < 7; ++w) ok = ok && (consumed[w] >= need); if (ok) break; if (++spins > (1u << 22)) break; __builtin_amdgcn_s_sleep(1); } } \
        LAS unsigned char* slot_ = lds + ((c_) & (M2_SLOTS - 1)) * M2_SLOT_BYTES; _Pragma("unroll") for (int i = 0; i < 12; ++i) *(LAS u32x4_t*)(slot_ + i * 1024 + lane * 16) = src[i]; \
        asm volatile("s_waitcnt lgkmcnt(0)" ::: "memory"); if (lane == 0) ready[(c_) & (M2_SLOTS - 1)] = (unsigned)((c_) + 1); asm volatile("" ::: "memory"); } while (0)
        M2_FETCH(f0, 0); M2_FETCH(f1, 1);
        for (int c = 0; c < 30; c += 3) { M2_FETCH(f2, c + 2); M2_PUBLISH(f0, c); M2_FETCH(f0, c + 3); M2_PUBLISH(f1, c + 1); M2_FETCH(f1, c + 4); M2_PUBLISH(f2, c + 2); }
        M2_PUBLISH(f0, 30); M2_PUBLISH(f1, 31);
#undef M2_FETCH
#undef M2_PUBLISH
    } else {
        const int nt = wave; f32x4 C[6];
#pragma unroll
        for (int kt = 0; kt < 6; ++kt) C[kt] = (f32x4){0.f, 0.f, 0.f, 0.f};
        M2Small s0, s1, s2, s3;
        m2_load_small(s0, pkg0, nt, lane); m2_load_small(s1, pkg0 + MLP_BYTES, nt, lane); m2_load_small(s2, pkg0 + 2 * (size_t)MLP_BYTES, nt, lane); m2_load_small(s3, pkg0 + 3 * (size_t)MLP_BYTES, nt, lane);
#define M2_CHAIN(sx, c_) do { unsigned spins = 0; while (ready[(c_) & (M2_SLOTS - 1)] != (unsigned)((c_) + 1)) { if (++spins > (1u << 22)) break; __builtin_amdgcn_s_sleep(1); } asm volatile("" ::: "memory"); \
            m2_step(sx, lds + ((c_) & (M2_SLOTS - 1)) * M2_SLOT_BYTES, C, num, den, dir, b, hh, nt, (c_), lane, fr, qd); \
            asm volatile("s_waitcnt lgkmcnt(0)" ::: "memory"); if (lane == 0) consumed[nt] = (unsigned)((c_) + 1); asm volatile("" ::: "memory"); \
            if ((c_) + 4 < 32) m2_load_small(sx, pkg0 + (size_t)((c_) + 4) * MLP_BYTES, nt, lane); } while (0)
        for (int c = 0; c < 32; c += 4) { M2_CHAIN(s0, c); M2_CHAIN(s1, c + 1); M2_CHAIN(s2, c + 2); M2_CHAIN(s3, c + 3); }
#undef M2_CHAIN
    }
    __syncthreads();
}

constexpr int PKG_BYTES = 12544;
constexpr int PK_AH = 0, PK_RH = 2048, PK_KB = 4096, PK_VV = 8192, PK_TM = 10240, PK_MM = 10752, PK_LAK = 11776, PK_GE = 12288;
constexpr size_t WS_PKG = WS_PR;
static_assert((size_t)2 * NB * 6 * 128 * PKG_BYTES <= 288 * MiB, "package region");
constexpr int R1_W2T = 0, R1_A2T = 9216, R1_WV = 18432, R1_WV_BYTES = 12928;
constexpr int R1_IMG = 0, R1_LF = 9216, R1_MT = 10368;
static_assert(R1_WV + 8 * R1_WV_BYTES <= MISC_OFF, "rwkv r1 LDS");

DI bf16x4_t pack4(const f32x4 v) { union { unsigned u[2]; bf16x4_t h; } x; x.u[0] = cvtpk(v[0], v[1]); x.u[1] = cvtpk(v[2], v[3]); return x.h; }

DI void rwkv_r1_item(const Args& A, int l, LAS unsigned char* lds, int item, int& dh_staged, int tid, int wave, int lane) {
    const bf16* Z = (const bf16*)(A.ws + WS_Z);
    const int g = item & 15; int r0 = item >> 4; const int hh = r0 % 6; r0 /= 6; const int b = r0 % NB, dir = r0 / NB;
    const int cc = 8 * g + wave, fr = lane & 15, qd = lane >> 4;
    LAS bf16* W2T = (LAS bf16*)(lds + R1_W2T); LAS bf16* A2T = (LAS bf16*)(lds + R1_A2T);
    LAS unsigned char* wv = lds + R1_WV + wave * R1_WV_BYTES;
    LAS bf16* IMG = (LAS bf16*)(wv + R1_IMG); LAS float* Lf = (LAS float*)(wv + R1_LF); LAS bf16* MT = (LAS bf16*)(wv + R1_MT);
    if (dh_staged != dir * 6 + hh) { dh_staged = dir * 6 + hh;
    __syncthreads();
    { const int ch = tid & 63, i0 = (tid >> 6) * 8; const float* w2 = A.in[I_W2] + ((size_t)(l * 2 + dir) * 64 + i0) * RW + hh * 64 + ch; const float* a2 = A.in[I_A2] + ((size_t)(l * 2 + dir) * 64 + i0) * RW + hh * 64 + ch;
      u32x4_t pw, pa; pw.x = cvtpk(w2[0], w2[RW]); pw.y = cvtpk(w2[2 * RW], w2[3 * RW]); pw.z = cvtpk(w2[4 * RW], w2[5 * RW]); pw.w = cvtpk(w2[6 * RW], w2[7 * RW]);
      pa.x = cvtpk(a2[0], a2[RW]); pa.y = cvtpk(a2[2 * RW], a2[3 * RW]); pa.z = cvtpk(a2[4 * RW], a2[5 * RW]); pa.w = cvtpk(a2[6 * RW], a2[7 * RW]);
      *(LAS u32x4_t*)(W2T + ch * 72 + i0) = pw; *(LAS u32x4_t*)(A2T + ch * 72 + i0) = pa; }
    __syncthreads(); }
    const int sgn = dir ? -1 : 1; const int tok0 = b * SEQ + (dir ? SEQ - 1 - 16 * cc : 16 * cc);
    const float* mu = A.in[I_MU] + (size_t)(l * 2 + dir) * 1280;
    float er[4][4], ek[4][4], ev[4][4], pr4[4], pk4[4], pv4[4];
    { const bool ext = (qd == 0) && (cc > 0); const size_t prow = (size_t)(ext ? tok0 - sgn : tok0 + sgn * (4 * qd)) * ZLD;
#pragma unroll
      for (int nt = 0; nt < 4; ++nt) {
#pragma unroll
          for (int r = 0; r < 4; ++r) { const bf16* zp = Z + (size_t)(tok0 + sgn * (4 * qd + r)) * ZLD + ZRKV + hh * 64 + 16 * nt + fr; er[nt][r] = bf2f(zp[0]); ek[nt][r] = bf2f(zp[RW]); ev[nt][r] = bf2f(zp[2 * RW]); }
          const bf16* zq = Z + prow + ZRKV + hh * 64 + 16 * nt + fr; pr4[nt] = bf2f(zq[0]); pk4[nt] = bf2f(zq[RW]); pv4[nt] = bf2f(zq[2 * RW]); }
      asm volatile("" : "+v"(er[0][0]), "+v"(pr4[3]));
#pragma unroll
      for (int nt = 0; nt < 4; ++nt) {
        float pr = __shfl(er[nt][3], lane - 16), pk = __shfl(ek[nt][3], lane - 16), pv = __shfl(ev[nt][3], lane - 16);
        if (qd == 0) { pr = ext ? pr4[nt] : 0.f; pk = ext ? pk4[nt] : 0.f; pv = ext ? pv4[nt] : 0.f; }
        const float mr = mu[hh * 64 + 16 * nt + fr], mk = mu[RW + hh * 64 + 16 * nt + fr], mv = mu[2 * RW + hh * 64 + 16 * nt + fr];
#pragma unroll
        for (int r = 3; r >= 0; --r) { const float qr = r ? er[nt][r - 1] : pr, qk = r ? ek[nt][r - 1] : pk, qv = r ? ev[nt][r - 1] : pv;
            er[nt][r] += mr * (qr - er[nt][r]); ek[nt][r] += mk * (qk - ek[nt][r]); ev[nt][r] += mv * (qv - ev[nt][r]); }
      } }
    bf16x8_t thA[2], adA[2];
    { const int zwd = dir ? ZWDB : ZWDF, zad = dir ? ZADB : ZADF; const bool hasp = !(cc == 0 && fr == 0);
      const bf16* zc = Z + (size_t)(tok0 + sgn * fr) * ZLD; const bf16* zq = Z + (size_t)(tok0 + sgn * (fr - 1)) * ZLD;
#pragma unroll
      for (int ks = 0; ks < 2; ++ks) { float cw[8], pw[8], ca[8], pa[8];
          unpack8(*(const uint4*)(zc + zwd + 32 * ks + 8 * qd), cw); unpack8(*(const uint4*)(zc + zad + 32 * ks + 8 * qd), ca);
          if (hasp) { unpack8(*(const uint4*)(zq + zwd + 32 * ks + 8 * qd), pw); unpack8(*(const uint4*)(zq + zad + 32 * ks + 8 * qd), pa); }
          else {
#pragma unroll
              for (int e = 0; e < 8; ++e) { pw[e] = 0.f; pa[e] = 0.f; } }
          const float* muw = mu + 1152 + 32 * ks + 8 * qd; const float* mua = mu + 1216 + 32 * ks + 8 * qd;
#pragma unroll
          for (int e = 0; e < 8; ++e) { const float xw = cw[e] + muw[e] * (pw[e] - cw[e]); cw[e] = 1.f - 2.f * __builtin_amdgcn_rcpf(1.f + __expf(2.f * xw)); ca[e] = ca[e] + mua[e] * (pa[e] - ca[e]); }
          union { unsigned u[4]; bf16x8_t v; } x, y;
#pragma unroll
          for (int e = 0; e < 4; ++e) { x.u[e] = cvtpk(cw[2 * e], cw[2 * e + 1]); y.u[e] = cvtpk(ca[2 * e], ca[2 * e + 1]); }
          thA[ks] = x.v; adA[ks] = y.v; } }
    f32x4 wl[4], al[4];
#pragma unroll
    for (int nt = 0; nt < 4; ++nt) { wl[nt] = (f32x4){0.f, 0.f, 0.f, 0.f}; al[nt] = (f32x4){0.f, 0.f, 0.f, 0.f};
#pragma unroll
        for (int ks = 0; ks < 2; ++ks) { const bf16x8_t bw = *(const LAS bf16x8_t*)(W2T + (16 * nt + fr) * 72 + 32 * ks + 8 * qd); const bf16x8_t ba = *(const LAS bf16x8_t*)(A2T + (16 * nt + fr) * 72 + 32 * ks + 8 * qd);
            wl[nt] = MFMA16(thA[ks], bw, wl[nt]); al[nt] = MFMA16(adA[ks], ba, al[nt]); } }
    float lw[4][4], alp[4][4], kap[4][4]; float ssq[4] = {0.f, 0.f, 0.f, 0.f}, bsm[4] = {0.f, 0.f, 0.f, 0.f};
#pragma unroll
    for (int nt = 0; nt < 4; ++nt) { const int ch = hh * 64 + 16 * nt + fr;
        const float w0v = A.in[I_W0][(size_t)(l * 2 + dir) * RW + ch], a0v = A.in[I_A0][(size_t)(l * 2 + dir) * RW + ch], kkw = A.in[I_KK][(size_t)l * RW + ch], kaw = A.in[I_KA][(size_t)l * RW + ch], rkw = A.in[I_RK][(size_t)l * RW + ch];
#pragma unroll
        for (int r = 0; r < 4; ++r) { const float x = w0v + wl[nt][r]; const float nx = -x; const float sp = fmaxf(nx, 0.f) + __logf(1.f + __expf(-fabsf(nx)));
            lw[nt][r] = -__expf(-sp - 0.5f);
            const float a = __builtin_amdgcn_rcpf(1.f + __expf(-(a0v + al[nt][r]))); alp[nt][r] = a;
            const float k0 = ek[nt][r]; kap[nt][r] = k0 * kkw; ek[nt][r] = k0 * (1.f + (a - 1.f) * kaw);
            ssq[r] += kap[nt][r] * kap[nt][r]; bsm[r] += er[nt][r] * ek[nt][r] * rkw; } }
#pragma unroll
    for (int r = 0; r < 4; ++r) {
#pragma unroll
        for (int o = 1; o < 16; o <<= 1) { ssq[r] += __shfl_xor(ssq[r], o); bsm[r] += __shfl_xor(bsm[r], o); }
        ssq[r] = __builtin_amdgcn_rsqf(fmaxf(ssq[r], 1e-24f)); }
    { bf16* bon = (bf16*)(A.ws + WS_RKB);
#pragma unroll
      for (int nt = 0; nt < 4; ++nt)
#pragma unroll
          for (int r = 0; r < 4; ++r) { kap[nt][r] *= ssq[r]; bon[((size_t)dir * NT + tok0 + sgn * (4 * qd + r)) * RW + hh * 64 + 16 * nt + fr] = (bf16)f2bf(bsm[r] * ev[nt][r]); } }
    unsigned char* pkg = A.ws + WS_PKG + ((size_t)((dir * NB + b) * 6 + hh) * 128 + cc) * PKG_BYTES;
    float lend[4];
    u32x2_t btf[4], ktf[4];
#pragma unroll
    for (int nt = 0; nt < 4; ++nt) { float lam[4]; lam[0] = lw[nt][0]; lam[1] = lam[0] + lw[nt][1]; lam[2] = lam[1] + lw[nt][2]; lam[3] = lam[2] + lw[nt][3];
        const float t1 = __shfl(lam[3], lane - 16), t2 = __shfl(lam[3], lane - 32), t3 = __shfl(lam[3], lane - 48);
        const float off = (qd >= 1 ? t1 : 0.f) + (qd >= 2 ? t2 : 0.f) + (qd >= 3 ? t3 : 0.f);
#pragma unroll
        for (int r = 0; r < 4; ++r) lam[r] += off;
        lend[nt] = __shfl(lam[3], 48 + fr);
        float bt4[4], kt4[4];
        float epv[4];
#pragma unroll
        for (int r = 0; r < 4; ++r) epv[r] = __expf(lam[r]);
        float ep_prev = __shfl(epv[3], lane - 16); if (qd == 0) ep_prev = 1.f;
        const float eendall = __expf(lend[nt]);
#pragma unroll
        for (int r = 0; r < 4; ++r) { const float ep = epv[r], epm = r ? epv[r - 1] : ep_prev, einv = __builtin_amdgcn_rcpf(ep), eend = eendall * einv;
            const float bb = kap[nt][r] * alp[nt][r]; const int o = (4 * qd + r) * 72 + 16 * nt + fr;
            IMG[o] = (bf16)f2bf(-kap[nt][r] * epm); IMG[1152 + o] = (bf16)f2bf(er[nt][r] * ep); IMG[2304 + o] = (bf16)f2bf(bb * einv); IMG[3456 + o] = (bf16)f2bf(ek[nt][r] * einv);
            bt4[r] = bb * eend; kt4[r] = ek[nt][r] * eend; }
        btf[nt].x = cvtpk(bt4[0], bt4[1]); btf[nt].y = cvtpk(bt4[2], bt4[3]); ktf[nt].x = cvtpk(kt4[0], kt4[1]); ktf[nt].y = cvtpk(kt4[2], kt4[3]); }
    asm volatile("s_waitcnt lgkmcnt(0)" ::: "memory");
    f32x4 Lab = (f32x4){0.f, 0.f, 0.f, 0.f}, Lak = Lab, Mrb = Lab, Mrk = Lab;
#pragma unroll
    for (int ks = 0; ks < 2; ++ks) { const int o = fr * 72 + 32 * ks + 8 * qd;
        const bf16x8_t aA = *(const LAS bf16x8_t*)(IMG + o), aR = *(const LAS bf16x8_t*)(IMG + 1152 + o), bB = *(const LAS bf16x8_t*)(IMG + 2304 + o), bK = *(const LAS bf16x8_t*)(IMG + 3456 + o);
        Lab = MFMA16(aA, bB, Lab); Lak = MFMA16(aA, bK, Lak); Mrb = MFMA16(aR, bB, Mrb); Mrk = MFMA16(aR, bK, Mrk); }
#pragma unroll
    for (int r = 0; r < 4; ++r) { const int t = 4 * qd + r; if (!(fr < t)) { Lab[r] = 0.f; Lak[r] = 0.f; } if (!(fr <= t)) { Mrb[r] = 0.f; Mrk[r] = 0.f; } Lf[t * 17 + fr] = Lab[r]; }
    asm volatile("s_waitcnt lgkmcnt(0)" ::: "memory");
    float Tc[16];
#pragma unroll
    for (int t = 0; t < 16; ++t) { float acc = (t == fr) ? 1.f : 0.f;
#pragma unroll
        for (int s = 0; s < t; ++s) acc += Lf[t * 17 + s] * Tc[s];
        Tc[t] = acc; }
    f32x4 Tm;
#pragma unroll
    for (int r = 0; r < 4; ++r) Tm[r] = qd == 0 ? Tc[r] : (qd == 1 ? Tc[4 + r] : (qd == 2 ? Tc[8 + r] : Tc[12 + r]));
#pragma unroll
    for (int r = 0; r < 4; ++r) { const int o = (4 * qd + r) * 20 + fr; MT[o] = (bf16)f2bf(Tm[r]); MT[320 + o] = (bf16)f2bf(Mrb[r]); MT[640 + o] = (bf16)f2bf(Lak[r]); MT[960 + o] = (bf16)f2bf(Mrk[r]); }
    asm volatile("s_waitcnt lgkmcnt(0)" ::: "memory");
    { const int o = fr * 20 + 4 * qd;
      const u32x2_t mrb = *(const LAS u32x2_t*)(MT + 320 + o), mrk = *(const LAS u32x2_t*)(MT + 960 + o);
      *(u32x2_t*)(pkg + PK_TM + lane * 8) = *(const LAS u32x2_t*)(MT + o); *(u32x2_t*)(pkg + PK_LAK + lane * 8) = *(const LAS u32x2_t*)(MT + 640 + o);
      *(u32x4_t*)(pkg + PK_MM + lane * 16) = (u32x4_t){mrk.x, mrk.y, mrb.x, mrb.y}; }
#pragma unroll
    for (int ks = 0; ks < 2; ++ks) { const int o = fr * 72 + 32 * ks + 4 * qd;
        const u32x2_t alo = *(const LAS u32x2_t*)(IMG + o), ahi = *(const LAS u32x2_t*)(IMG + o + 16), rlo = *(const LAS u32x2_t*)(IMG + 1152 + o), rhi = *(const LAS u32x2_t*)(IMG + 1152 + o + 16);
        *(u32x4_t*)(pkg + PK_AH + ks * 1024 + lane * 16) = (u32x4_t){alo.x, alo.y, ahi.x, ahi.y}; *(u32x4_t*)(pkg + PK_RH + ks * 1024 + lane * 16) = (u32x4_t){rlo.x, rlo.y, rhi.x, rhi.y}; }
#pragma unroll
    for (int nt = 0; nt < 4; ++nt) { *(u32x4_t*)(pkg + PK_KB + nt * 1024 + lane * 16) = (u32x4_t){ktf[nt].x, ktf[nt].y, btf[nt].x, btf[nt].y};
        u32x2_t vf; vf.x = cvtpk(ev[nt][0], ev[nt][1]); vf.y = cvtpk(ev[nt][2], ev[nt][3]); *(u32x2_t*)(pkg + PK_VV + nt * 512 + lane * 8) = vf;
        if (qd == 0) ((float*)(pkg + PK_GE))[16 * nt + fr] = __expf(lend[nt]); }
    asm volatile("s_waitcnt lgkmcnt(0)" ::: "memory");
}
DI void phase_rwkv_r1(const Args& A, int l, LAS unsigned char* lds, int bid, int G, int tid, int wave, int lane) {
    constexpr int NIT = 2 * NB * 6 * 16; int dh_staged = -1;
    __syncthreads();
    for (int it = bid; it < NIT; it += G) rwkv_r1_item(A, l, lds, it, dh_staged, tid, wave, lane);
    __syncthreads();
}

struct RkOps { bf16x8_t ah[2], rh[2], kb[4], mm; bf16x4_t vv, tm, lak; f32x4 ge[4]; };
DI bf16x8_t widen4(const bf16x4_t a) { return __builtin_shufflevector(a, (bf16x4_t){0, 0, 0, 0}, 0, 1, 2, 3, 4, 5, 6, 7); }
DI void rk_step(const RkOps& c, f32x4 (&sT)[4], bf16* yb, int dir, int b, int hh, int vb, int cc, int fr, int qd) {
    const f32x4 zero4 = (f32x4){0.f, 0.f, 0.f, 0.f};
    union { unsigned u[4]; bf16x8_t v; } s0, s1;
    s0.u[0] = cvtpk(sT[0][0], sT[0][1]); s0.u[1] = cvtpk(sT[0][2], sT[0][3]); s0.u[2] = cvtpk(sT[1][0], sT[1][1]); s0.u[3] = cvtpk(sT[1][2], sT[1][3]);
    s1.u[0] = cvtpk(sT[2][0], sT[2][1]); s1.u[1] = cvtpk(sT[2][2], sT[2][3]); s1.u[2] = cvtpk(sT[3][0], sT[3][1]); s1.u[3] = cvtpk(sT[3][2], sT[3][3]);
    f32x4 ax = MFMA16(widen4(c.lak), widen4(c.vv), zero4); ax = MFMA16(c.ah[0], s0.v, ax); ax = MFMA16(c.ah[1], s1.v, ax);
    f32x4 ay = MFMA16(c.rh[0], s0.v, zero4); ay = MFMA16(c.rh[1], s1.v, ay);
    const f32x4 au = MFMA16(widen4(c.tm), widen4(pack4(ax)), zero4);
    const bf16x8_t vu = __builtin_shufflevector(c.vv, pack4(au), 0, 1, 2, 3, 4, 5, 6, 7);
    ay = MFMA16(c.mm, vu, ay);
#pragma unroll
    for (int kt = 0; kt < 4; ++kt) sT[kt] = MFMA16(c.kb[kt], vu, sT[kt] * c.ge[kt]);
    const int sgn = dir ? -1 : 1; const int tok0 = b * SEQ + (dir ? SEQ - 1 - 16 * cc : 16 * cc);
#pragma unroll
    for (int r = 0; r < 4; ++r) yb[((size_t)dir * NT + tok0 + sgn * (4 * qd + r)) * RW + hh * 64 + 16 * vb + fr] = (bf16)f2bf(ay[r]);
}
constexpr int R2_SLOTS = 8, R2_CTL = R2_SLOTS * PKG_BYTES;
static_assert(R2_CTL + 64 <= MISC_OFF, "rwkv r2 LDS");
DI void rk_load_lds(RkOps& o, const LAS unsigned char* pkg, int vb, int lane, int qd) {
#pragma unroll
    for (int ks = 0; ks < 2; ++ks) { o.ah[ks] = *(const LAS bf16x8_t*)(pkg + PK_AH + ks * 1024 + lane * 16); o.rh[ks] = *(const LAS bf16x8_t*)(pkg + PK_RH + ks * 1024 + lane * 16); }
#pragma unroll
    for (int kt = 0; kt < 4; ++kt) { o.kb[kt] = *(const LAS bf16x8_t*)(pkg + PK_KB + kt * 1024 + lane * 16); o.ge[kt] = *(const LAS f32x4*)(pkg + PK_GE + (16 * kt + 4 * qd) * 4); }
    o.mm = *(const LAS bf16x8_t*)(pkg + PK_MM + lane * 16);
    o.vv = *(const LAS bf16x4_t*)(pkg + PK_VV + vb * 512 + lane * 8); o.tm = *(const LAS bf16x4_t*)(pkg + PK_TM + lane * 8); o.lak = *(const LAS bf16x4_t*)(pkg + PK_LAK + lane * 8);
}
DI void rk_pkg_fetch(u32x4_t (&buf)[13], const unsigned char* pkg, int lane) {
#pragma unroll
    for (int i = 0; i < 12; ++i) buf[i] = *(const u32x4_t*)(pkg + i * 1024 + lane * 16);
    buf[12] = (lane < 16) ? *(const u32x4_t*)(pkg + 12288 + lane * 16) : (u32x4_t){0u, 0u, 0u, 0u};
}
DI void rwkv_r2_unit(const Args& A, LAS unsigned char* lds, int u, int tid, int wave, int lane) {
    bf16* yb = (bf16*)(A.ws + WS_RKY);
    const int dir = u / 48, rem = u % 48, b = rem / 6, hh = rem % 6; const int fr = lane & 15, qd = lane >> 4;
    const unsigned char* pkg0 = A.ws + WS_PKG + ((size_t)((dir * NB + b) * 6 + hh) * 128) * PKG_BYTES;
    volatile LAS unsigned* ready = (volatile LAS unsigned*)(lds + R2_CTL); volatile LAS unsigned* consumed = ready + 8;
    __syncthreads();
    if (tid < 16) ready[tid] = 0u;
    __syncthreads();
    if (wave >= 4) {
        const int j = wave - 4; u32x4_t cur[13], nxt[13];
        rk_pkg_fetch(cur, pkg0 + (size_t)j * PKG_BYTES, lane);
        for (int cc = j; cc < 128; cc += 4) {
            if (cc + 4 < 128) rk_pkg_fetch(nxt, pkg0 + (size_t)(cc + 4) * PKG_BYTES, lane);
            if (cc >= R2_SLOTS) { const unsigned need = (unsigned)(cc - R2_SLOTS + 1); unsigned spins = 0;
                for (;;) { const unsigned c0 = consumed[0], c1 = consumed[1], c2 = consumed[2], c3 = consumed[3];
                    if (c0 >= need && c1 >= need && c2 >= need && c3 >= need) break; if (++spins > (1u << 22)) break; __builtin_amdgcn_s_sleep(1); } }
            LAS unsigned char* slot = lds + (cc & (R2_SLOTS - 1)) * PKG_BYTES;
#pragma unroll
            for (int i = 0; i < 12; ++i) *(LAS u32x4_t*)(slot + i * 1024 + lane * 16) = cur[i];
            if (lane < 16) *(LAS u32x4_t*)(slot + 12288 + lane * 16) = cur[12];
            asm volatile("s_waitcnt lgkmcnt(0)" ::: "memory");
            if (lane == 0) ready[cc & (R2_SLOTS - 1)] = (unsigned)(cc + 1);
            asm volatile("" ::: "memory");
#pragma unroll
            for (int i = 0; i < 13; ++i) cur[i] = nxt[i];
        }
    } else {
        const int vb = wave; f32x4 sT[4];
#pragma unroll
        for (int kt = 0; kt < 4; ++kt) sT[kt] = (f32x4){0.f, 0.f, 0.f, 0.f};
#define RK_WAIT(cc_) do { unsigned spins = 0; while (ready[(cc_) & (R2_SLOTS - 1)] != (unsigned)((cc_) + 1)) { if (++spins > (1u << 22)) break; __builtin_amdgcn_s_sleep(1); } asm volatile("" ::: "memory"); } while (0)
        RkOps pa, pb;
        RK_WAIT(0); rk_load_lds(pa, lds, vb, lane, qd);
        for (int cc = 0; cc < 128; cc += 2) {
            RK_WAIT(cc + 1); rk_load_lds(pb, lds + ((cc + 1) & (R2_SLOTS - 1)) * PKG_BYTES, vb, lane, qd);
            rk_step(pa, sT, yb, dir, b, hh, vb, cc, fr, qd);
            asm volatile("s_waitcnt lgkmcnt(0)" ::: "memory"); if (lane == 0) consumed[vb] = (unsigned)(cc + 2); asm volatile("" ::: "memory");
            if (cc + 2 < 128) { RK_WAIT(cc + 2); rk_load_lds(pa, lds + ((cc + 2) & (R2_SLOTS - 1)) * PKG_BYTES, vb, lane, qd); }
            rk_step(pb, sT, yb, dir, b, hh, vb, cc + 1, fr, qd);
            if (cc + 2 < 128) { asm volatile("s_waitcnt lgkmcnt(0)" ::: "memory"); if (lane == 0) consumed[vb] = (unsigned)(cc + 3); asm volatile("" ::: "memory"); }
        }
#undef RK_WAIT
    }
    __syncthreads();
}


constexpr int YA_G2LD = 136;
static_assert(384 * YA_G2LD * 2 <= MISC_OFF, "yasm LDS");
DI void yasm_token(const bf16* Z, const bf16* ao, const float* al, const bf16* num, const float* den, const float* mlg, bf16* y, int tok, int lane) {
    const bf16* zr = Z + (size_t)tok * ZLD; bf16* yr = y + (size_t)tok * DM;
    const float lsev = al[((size_t)((lane >> 2) % 3) * NT + tok) * 4 + (lane & 3)];
    const float denv = den[((size_t)((lane >> 2) & 1) * NT + tok) * 4 + (lane & 3)];
    float aov[3][4], nmv[2][4], nm2[2][4], zo[4], zo2[4];
#pragma unroll
    for (int hh = 0; hh < 4; ++hh) { const int col = hh * 64 + lane, c0 = hh * 96 + lane, c1 = hh * 96 + 64 + (lane & 31);
#pragma unroll
        for (int br = 0; br < 3; ++br) aov[br][hh] = bf2f(ao[((size_t)br * NT + tok) * AW + col]);
#pragma unroll
        for (int d = 0; d < 2; ++d) { nmv[d][hh] = bf2f(num[((size_t)d * NT + tok) * MW + c0]); nm2[d][hh] = bf2f(num[((size_t)d * NT + tok) * MW + c1]); }
        zo[hh] = bf2f(zr[ZMO + c0]); zo2[hh] = bf2f(zr[ZMO + c1]); }
#pragma unroll
    for (int hh = 0; hh < 4; ++hh) { const int col = hh * 64 + lane;
        const float l0 = __shfl(lsev, hh), l1 = __shfl(lsev, 4 + hh), l2 = __shfl(lsev, 8 + hh);
        const float mx = fmaxf(l0, fmaxf(l1, l2)); const float w0 = __expf(l0 - mx), w1 = __expf(l1 - mx), w2 = __expf(l2 - mx);
        yr[col] = (bf16)f2bf((w0 * aov[0][hh] + w1 * aov[1][hh] + w2 * aov[2][hh]) / (w0 + w1 + w2)); }
#pragma unroll
    for (int hh = 0; hh < 4; ++hh) { const int c0 = hh * 96 + lane, c1 = hh * 96 + 64 + (lane & 31); const bool hi = lane < 32;
        const float df = __shfl(denv, hh), db = __shfl(denv, 4 + hh);
        const float invf = 1.f / fmaxf(fabsf(df), 1.f), invb = 1.f / fmaxf(fabsf(db), 1.f);
        const float a = nmv[0][hh] * invf + nmv[1][hh] * invb; const float bb = hi ? (nm2[0][hh] * invf + nm2[1][hh] * invb) : 0.f;
        const float mean = (wave_sum(a) + wave_sum(bb)) * (1.f / 96.f); const float da = a - mean, dbb = hi ? bb - mean : 0.f;
        const float var = (wave_sum(da * da) + wave_sum(dbb * dbb)) * (1.f / 96.f); const float rs = rsqrtf(var + 1e-6f);
        yr[AW + RW + c0] = (bf16)f2bf(da * rs * mlg[c0] * sigm(zo[hh]));
        if (hi) yr[AW + RW + c1] = (bf16)f2bf(dbb * rs * mlg[c1] * sigm(zo2[hh])); }
}
DI void phase_yasm(const Args& A, int l, LAS unsigned char* lds, int gw, int ngw, int tid, int lane) {
    const bf16* Z = (const bf16*)(A.ws + WS_Z); const bf16* ao = (const bf16*)(A.ws + WS_ATTO); const float* al = (const float*)(A.ws + WS_ATTL);
    const bf16* rky = (const bf16*)(A.ws + WS_RKY); const bf16* rkb = (const bf16*)(A.ws + WS_RKB);
    const bf16* num = (const bf16*)(A.ws + WS_MLNUM); const float* den = (const float*)(A.ws + WS_MLDEN); bf16* y = (bf16*)(A.ws + WS_HB);
    const float* lng = A.in[I_RLNG] + (size_t)l * RW; const float* lnb = A.in[I_RLNB] + (size_t)l * RW; const float* mlg = A.in[I_MLNG] + (size_t)l * MW;
    LAS bf16* G2T = (LAS bf16*)lds;
    __syncthreads();
    { const u32x4_t* src = (const u32x4_t*)(A.ws + WS_G2T + (size_t)l * RW * 128 * 2);
      for (int idx = tid; idx < RW * 16; idx += NTHR) { const int col = idx >> 4, ch = idx & 15; *(LAS u32x4_t*)(G2T + col * YA_G2LD + ch * 8) = src[idx]; } }
    __syncthreads();
    const int fr = lane & 15, qd = lane >> 4;
    for (int item = gw; item < (NT / 16) * 6; item += ngw) {
        const int hh = item % 6, tg = item / 6; const int tokA = tg * 16 + fr;
        f32x4 gacc[4];
#pragma unroll
        for (int nt = 0; nt < 4; ++nt) gacc[nt] = (f32x4){0.f, 0.f, 0.f, 0.f};
#pragma unroll
        for (int ks = 0; ks < 4; ++ks) { float f[8]; unpack8(*(const uint4*)(Z + (size_t)tokA * ZLD + ZGD + 32 * ks + 8 * qd), f);
            union { unsigned u[4]; bf16x8_t v; } a;
#pragma unroll
            for (int e = 0; e < 4; ++e) a.u[e] = cvtpk(sigm(f[2 * e]), sigm(f[2 * e + 1]));
#pragma unroll
            for (int nt = 0; nt < 4; ++nt) { const bf16x8_t bg = *(const LAS bf16x8_t*)(G2T + (hh * 64 + 16 * nt + fr) * YA_G2LD + 32 * ks + 8 * qd); gacc[nt] = MFMA16(a.v, bg, gacc[nt]); } }
        float sv[4][4], bv[4][4]; float sm[4] = {0.f, 0.f, 0.f, 0.f};
#pragma unroll
        for (int nt = 0; nt < 4; ++nt)
#pragma unroll
            for (int r = 0; r < 4; ++r) { const size_t o = (size_t)(tg * 16 + 4 * qd + r) * RW + hh * 64 + 16 * nt + fr;
                sv[nt][r] = bf2f(rky[o]) + bf2f(rky[(size_t)NT * RW + o]); bv[nt][r] = bf2f(rkb[o]) + bf2f(rkb[(size_t)NT * RW + o]); sm[r] += sv[nt][r]; }
        float vr[4] = {0.f, 0.f, 0.f, 0.f};
#pragma unroll
        for (int r = 0; r < 4; ++r) {
#pragma unroll
            for (int o = 1; o < 16; o <<= 1) sm[r] += __shfl_xor(sm[r], o);
            sm[r] *= (1.f / 64.f);
#pragma unroll
            for (int nt = 0; nt < 4; ++nt) { sv[nt][r] -= sm[r]; vr[r] += sv[nt][r] * sv[nt][r]; }
#pragma unroll
            for (int o = 1; o < 16; o <<= 1) vr[r] += __shfl_xor(vr[r], o);
            vr[r] = rsqrtf(vr[r] * (1.f / 64.f) + 64e-5f); }
#pragma unroll
        for (int nt = 0; nt < 4; ++nt) { const int col = hh * 64 + 16 * nt + fr; const float lg_ = lng[col], lb_ = lnb[col];
#pragma unroll
            for (int r = 0; r < 4; ++r) y[(size_t)(tg * 16 + 4 * qd + r) * DM + AW + col] = (bf16)f2bf((sv[nt][r] * vr[r] * lg_ + lb_ + bv[nt][r]) * gacc[nt][r]); }
    }
    for (int tok = gw; tok < NT; tok += 2 * ngw) { yasm_token(Z, ao, al, num, den, mlg, y, tok, lane); if (tok + ngw < NT) yasm_token(Z, ao, al, num, den, mlg, y, tok + ngw, lane); }
    __syncthreads();
}

constexpr int PH_PER_LAYER = 10, NPH = 1 + NL * PH_PER_LAYER + 1;
#ifndef MK_ONE_LAUNCH
#define MK_ONE_LAUNCH 1
#endif

#ifndef MK_DUP
#define MK_DUP 0
#endif
constexpr int P0_END = NL * 16 * 64 + NL * 16 * 16 + NL * NE * 3 * 8 * 44, P0_SPLIT = P0_END - 0;
template <int l> DI void run_layer(const Args& A, LAS unsigned char* lds, const XcdBarrier& bar, int lo, int hi, int G, int bid, int tid, int lane, int wave, int gw, int ngw, int gtid, int nthr) {
#define IN(k) (lo <= (k) && (k) < hi)
#define SEAM(k) do { if (IN(k) && IN((k) + 1)) xcd_barrier(bar); } while (0)
#define PH(k, ...) do { if (IN(pb + (k))) { { __VA_ARGS__ } if ((MK_DUP >> (k)) & 1) { xcd_barrier(bar); { __VA_ARGS__ } } } SEAM(pb + (k)); } while (0)
    const int pb = 1 + l * PH_PER_LAYER;
    PH(0, phase_ln1(A, l, gw, ngw, lane););
    PH(1,
        pg8::Gemm g{(const bf16*)(A.ws + WS_HB), (const bf16*)(A.ws + WS_WTIN) + (size_t)l * ZLD * DM, NT, ZLD, DM};
        pg8::StaticOrder S; S.init(NT, ZLD, G, bid);
        pg8::EpiBf16<0> E{(bf16*)(A.ws + WS_Z), ZLD, nullptr, 0, 0, 1.f};
        pg8::gemm_phase<pg8::EpiBf16<0>, pg8::StaticOrder, true, true>(lds, g, S, E););
    PH(2, phase_attn(A, lds, bid, G, tid, wave, lane); phase_rwkv_r1(A, l, lds, bid, G, tid, wave, lane); if ((MK_DUP >> 13) & 1) phase_rwkv_r1(A, l, lds, bid, G, tid, wave, lane);
          phase_mlstm_m1(A, l, lds, bid, G, tid, wave, lane); if ((MK_DUP >> 16) & 1) phase_mlstm_m1(A, l, lds, bid, G, tid, wave, lane););
    PH(3, if (l == 0 && P0_SPLIT < P0_END) { const int nb = G > 160 ? G - 160 : G, b0 = G > 160 ? bid - 160 : bid; if (b0 >= 0) { __syncthreads(); phase_p0(A, lds, P0_SPLIT, P0_END, b0 * NWAVES + wave, nb * NWAVES, wave, lane); __syncthreads(); } }
          for (int rep = 0; rep < 1 + ((MK_DUP >> 14) & 1); ++rep) for (int u = bid; u < 96; u += G) rwkv_r2_unit(A, lds, u, tid, wave, lane);
          for (int rep = 0; rep < 1 + ((MK_DUP >> 15) & 1); ++rep) for (int u = bid; u < 96 + 64; u += G) { if (u >= 96) mlstm_m2_unit(A, lds, u - 96, tid, wave, lane); });
    PH(4, phase_yasm(A, l, lds, gw, ngw, tid, lane););
    PH(5,
        pg8::Gemm g{(const bf16*)(A.ws + WS_HB), (const bf16*)(A.ws + WS_WTOUT) + (size_t)l * DM * DM, NT, DM, DM};
        pg8::StaticOrder S; S.init(NT, DM, G, bid);
        EpiResT<(l > 0)> E{(l == 0) ? (const void*)A.in[I_X] : (const void*)(A.ws + WS_X2), (bf16*)(A.ws + WS_X1), DM};
        pg8::gemm_phase<EpiResT<(l > 0)>, pg8::StaticOrder, true, true>(lds, g, S, E););
    PH(6, phase_ln2(A, l, lds, gw, ngw, tid, lane););
    PH(7, phase_topk(A, lds, bid, G, tid, wave, lane););
    PH(8,
        pg8::Gemm g{(const bf16*)(A.ws + WS_XG), (const bf16*)(A.ws + WS_W13T + (size_t)l * NE * 5632 * DM), NSLOT, NE * 5632, DM / 2};
        GroupOrder S; S.init(22, G, bid);
        EpiSwiGLU E{A.ws + WS_ACT, 22};
        pg8::gemm_phase<EpiSwiGLU, GroupOrder, true, true, true>(lds, g, S, E););
    PH(9,
        pg8::Gemm g{(const bf16*)(A.ws + WS_ACT), (const bf16*)(A.ws + WS_W2T + (size_t)l * NE * DM * FF), NSLOT, NE * DM, FF / 2};
        GroupOrder S; S.init(4, G, bid);
        EpiGate E{(bf16*)(A.ws + WS_YS), (const float*)(A.ws + WS_GATE)};
        pg8::gemm_phase<EpiGate, GroupOrder, true, true, true>(lds, g, S, E););
#undef PH
#undef IN
#undef SEAM
}

__global__ void __launch_bounds__(NTHR, 2) mk_fwd(Args A) {
    extern __shared__ __attribute__((aligned(16))) unsigned char lds_raw[];
    LAS unsigned char* lds = (LAS unsigned char*)lds_raw;
    const int tid = threadIdx.x, lane = tid & 63, wave = __builtin_amdgcn_readfirstlane(tid >> 6);
    const int G = gridDim.x, bid = blockIdx.x;
    const int gw = bid * NWAVES + wave, ngw = G * NWAVES, gtid = bid * NTHR + tid, nthr = G * NTHR;
    volatile LAS unsigned* MISC = (volatile LAS unsigned*)(lds + MISC_OFF);
    if (tid < 64) MISC[tid] = 0u;
    __syncthreads();
    const int lo = A.ph_lo, hi = A.ph_hi;
    const bool use_bar = (hi - lo) > 1;
    XcdBarrier bar; bar.bar = (unsigned*)(A.ws + WS_CTL) + CW_BAR; bar.x = 0; bar.st = MISC + 8;
    if (use_bar) bar = xcd_barrier_post((unsigned*)(A.ws + WS_CTL) + CW_BAR, MISC + 8);
#define IN(k) (lo <= (k) && (k) < hi)
#define SEAM(k) do { if (IN(k) && IN((k) + 1)) xcd_barrier(bar); } while (0)

    if (IN(0)) { phase_p0(A, lds, 0, P0_SPLIT, gw, ngw, wave, lane); if ((MK_DUP >> 10) & 1) { xcd_barrier(bar); phase_p0(A, lds, 0, P0_SPLIT, gw, ngw, wave, lane); } } SEAM(0);

    run_layer<0>(A, lds, bar, lo, hi, G, bid, tid, lane, wave, gw, ngw, gtid, nthr);
    run_layer<1>(A, lds, bar, lo, hi, G, bid, tid, lane, wave, gw, ngw, gtid, nthr);
    if (IN(NPH - 1)) { phase_final(A, gw, ngw, lane); if ((MK_DUP >> 11) & 1) { xcd_barrier(bar); phase_final(A, gw, ngw, lane); } }
#undef IN
#undef SEAM
}
}

extern "C" void kernel_launch(void* const* d_in, const int* in_sizes, int n_in, void* d_out, int out_size, void* d_ws, size_t ws_size, hipStream_t stream) {
    using namespace mk;
    static int grid = 0;
    if (grid == 0) {
        if (n_in != N_IN || out_size != NT * DM || ws_size < WS_END) { fprintf(stderr, "kernel_launch: unexpected shapes (n_in %d, out %d, ws %zu < %zu)\n", n_in, out_size, ws_size, (size_t)WS_END); grid = -1; return; }
        int dev = 0, cus = 0, per_cu = 0;
        if (hipGetDevice(&dev) != hipSuccess || hipDeviceGetAttribute(&cus, hipDeviceAttributeMultiprocessorCount, dev) != hipSuccess) { grid = -1; return; }
        if (hipFuncSetAttribute((const void*)mk_fwd, hipFuncAttributeMaxDynamicSharedMemorySize, LDS_BYTES) != hipSuccess) { fprintf(stderr, "kernel_launch: hipFuncSetAttribute failed\n"); grid = -1; return; }
        if (hipOccupancyMaxActiveBlocksPerMultiprocessor(&per_cu, (const void*)mk_fwd, NTHR, LDS_BYTES) != hipSuccess || per_cu < 1) fprintf(stderr, "kernel_launch: occupancy query reports %d\n", per_cu);
        (void)hipGetLastError();
        grid = cus;
    }
    if (grid < 0) return;
    hipMemsetAsync((char*)d_ws + WS_CTL, 0, CTL_ZERO_BYTES, stream);
    Args a{};
    for (int i = 0; i < N_IN; ++i) a.in[i] = (const float*)d_in[i];
    a.out = (float*)d_out; a.ws = (unsigned char*)d_ws;
#if MK_ONE_LAUNCH
    a.ph_lo = 0; a.ph_hi = NPH;
    hipLaunchKernelGGL(mk_fwd, dim3(grid), dim3(NTHR), LDS_BYTES, stream, a);
#else
    for (int p = 0; p < NPH; ++p) { a.ph_lo = p; a.ph_hi = p + 1; hipLaunchKernelGGL(mk_fwd, dim3(grid), dim3(NTHR), LDS_BYTES, stream, a); }
#endif
}
```

```cpp
#include <hip/hip_runtime.h>
#include <cstdio>
#include <cstdint>
namespace pg8 {
#define PG8_LAS __attribute__((address_space(3)))
typedef unsigned short bf16_t;
typedef short bf16x8 __attribute__((ext_vector_type(8)));
typedef float f32x4 __attribute__((ext_vector_type(4)));
typedef unsigned u32x4 __attribute__((ext_vector_type(4)));
constexpr int BM = 256, BK = 64, HALF = 128, HTB = HALF * BK * 2  , STAGE_BYTES = 8 * HTB, NXCD = 8, WGM = 8;

__host__ __device__ __forceinline__ int lds_byte(int r, int c) { const int st = (r >> 4) * 2 + (c >> 5), rr = r & 15, cc = c & 31, ob = rr * 64 + cc * 2; return st * 1024 + (ob ^ (((ob >> 9) & 1) << 5)); }
__host__ __device__ __forceinline__ void stage_rc(int b, int& R, int& C) { const int st = b / 1024, sb = b % 1024, swz = sb ^ (((sb >> 9) & 1) << 5); R = (st >> 1) * 16 + swz / 64; C = (st & 1) * 32 + (swz % 64) / 2; }
__host__ __device__ __forceinline__ int perm32(int rho) { const int n = rho >> 4, i = rho & 15; return 8 * (i >> 2) + 4 * n + (i & 3); }

struct Unit { int pm, pn; };
struct Gemm { const bf16_t* A; const bf16_t* Bt; int M, N, K; };

struct StaticOrder {
    int nM, nN, nwg, G, c;
    __host__ __device__ void init(int M, int N, int G_, int c_) { nM = M / BM; nN = N / BM; nwg = nM * nN; G = G_; c = c_; }
    __host__ __device__ bool next(int i, Unit& u) const {
        const long L = (long)i * G + c; if (L >= nwg) return false;
        int wgid = (int)L; { const int q = nwg / NXCD, r = nwg % NXCD, xcd = wgid % NXCD, off = wgid / NXCD; wgid = (xcd < r ? xcd * (q + 1) : r * (q + 1) + (xcd - r) * q) + off; }
        const int nig = WGM * nN, gid = wgid / nig, fm = gid * WGM, gsz = (nM - fm) < WGM ? (nM - fm) : WGM;
        u.pm = fm + ((wgid % nig) % gsz); u.pn = (wgid % nig) / gsz; return true;
    }
    __device__ __forceinline__ void a_ready(const Unit&) const {}
    __device__ __forceinline__ void done(const Unit&) const {}
};

__device__ __forceinline__ unsigned cvt_pk_bf16(float lo, float hi) { unsigned r; asm volatile("v_cvt_pk_bf16_f32 %0, %1, %2" : "=v"(r) : "v"(lo), "v"(hi)); return r; }
typedef float f32x2 __attribute__((ext_vector_type(2)));
__device__ __forceinline__ f32x2 gelu_pk(f32x2 v) {
    const f32x2 av = __builtin_elementwise_abs(v), d = av * 0.2316418882f + 1.0f;
    f32x2 t; t.x = __builtin_amdgcn_rcpf(d.x); t.y = __builtin_amdgcn_rcpf(d.y);
    f32x2 q = t * 0.5307027145f + (-0.7265760135f); q = q * t + 0.7107068705f; q = q * t + (-0.142248368f); q = q * t + 0.127414796f; q = q * t;
    const f32x2 s = (v * v) * (-0.72134752044f);
    f32x2 e; e.x = __builtin_amdgcn_exp2f(s.x); e.y = __builtin_amdgcn_exp2f(s.y);
    const f32x2 m = v * (q * e), r = v - m;
    f32x2 o; o.x = v.x < 0.f ? m.x : r.x; o.y = v.y < 0.f ? m.y : r.y; return o;
}

template <int ACT  > struct EpiBf16 {
    static constexpr bool PERM = true, AFTER_DRAIN = false; static_assert(ACT == 0 || ACT == 1, "EpiBf16: ACT is 0 (none) or 1 (gelu_pk)");
    bf16_t* O; int ldc; const float* bias; int split_cols; size_t split_stride; float scale0;
    __device__ __forceinline__ void operator()(const f32x4 (&acc)[2][2][4][2], const Unit& u, int wr, int wc, int fr, int fq) const {
        const int row0 = u.pm * BM + wr * 64 + fr; int colt = u.pn * BM; bf16_t* base = O;
        float sc = 1.f; if (split_cols) { const int t = colt / split_cols; base += (size_t)t * split_stride; colt -= t * split_cols; if (t == 0) sc = scale0; }
        const int col0 = colt + wc * 32 + 8 * fq, bcol0 = u.pn * BM + wc * 32 + 8 * fq;
        f32x4 bv[2][2];
#pragma unroll
        for (int bj = 0; bj < 2; ++bj)
#pragma unroll
            for (int n = 0; n < 2; ++n) bv[bj][n] = bias ? *(const f32x4*)(bias + bcol0 + bj * HALF + 4 * n) : (f32x4){0.f, 0.f, 0.f, 0.f};
#pragma unroll
        for (int ai = 0; ai < 2; ++ai)
#pragma unroll
            for (int m = 0; m < 4; ++m) { bf16_t* rowp = base + (size_t)(row0 + ai * HALF + m * 16) * ldc + col0;
#pragma unroll
                for (int bj = 0; bj < 2; ++bj) { f32x4 v0 = acc[ai][bj][m][0] + bv[bj][0], v1 = acc[ai][bj][m][1] + bv[bj][1];
                    if (ACT == 1) { f32x2 a = gelu_pk((f32x2){v0[0], v0[1]}), b = gelu_pk((f32x2){v0[2], v0[3]}), c = gelu_pk((f32x2){v1[0], v1[1]}), d = gelu_pk((f32x2){v1[2], v1[3]});
                        v0 = (f32x4){a.x, a.y, b.x, b.y}; v1 = (f32x4){c.x, c.y, d.x, d.y}; }
                    v0 = v0 * sc; v1 = v1 * sc; u32x4 w; w.x = cvt_pk_bf16(v0[0], v0[1]); w.y = cvt_pk_bf16(v0[2], v0[3]); w.z = cvt_pk_bf16(v1[0], v1[1]); w.w = cvt_pk_bf16(v1[2], v1[3]);
                    *(u32x4*)(rowp + bj * HALF) = w; } }
    }
};
template <class Epi, class Sched, bool ALIGN_EPI = false, bool SP2 = false, bool F8 = false>
__device__ __forceinline__ void gemm_phase(PG8_LAS unsigned char* lds, const Gemm g, const Sched& S, const Epi& E) {
    const int tid = threadIdx.x, wid = __builtin_amdgcn_readfirstlane(tid >> 6), lane = tid & 63, wr = wid >> 2, wc = wid & 3, fr = lane & 15, fq = lane >> 4;
    int Kq = g.K; if constexpr (F8) asm volatile("" : "+s"(Kq));
    const int K = Kq, nt = K / BK;
    unsigned voffA[2], voffB[2];
#pragma unroll
    for (int i = 0; i < 2; ++i) { int R, C; stage_rc(tid * 16 + i * 8192, R, C); const int Rb = Epi::PERM ? ((R & ~31) + perm32(R & 31)) : R;
        voffA[i] = (unsigned)(R * K + C) * 2u; voffB[i] = (unsigned)(Rb * K + C) * 2u; }
    const size_t kstep = (size_t)(BK * 2);
    const size_t hstep = (size_t)HALF * K * 2;
    const size_t tstep = 2 * hstep;
    const unsigned ldsw = (unsigned)wid * 1024u;
    const int aoff = lds_byte(wr * 64 + fr, fq * 8), boff = lds_byte(wc * 32 + fr, fq * 8);
#define PG8_SA(b, h) (((b) * 2 + (h)) * HTB)
#define PG8_SB(b, h) ((4 + (b) * 2 + (h)) * HTB)
#define PG8_STAGE(bufoff, gbase, voff) do { _Pragma("unroll") for (int _i = 0; _i < 2; ++_i) \
        __builtin_amdgcn_global_load_lds((const unsigned*)((const char*)(gbase) + (voff)[_i]), (PG8_LAS unsigned*)(lds + (bufoff) + ldsw + _i * 8192), 16, 0, 0); } while (0)
#define PG8_LDA(dst, b, h) do { _Pragma("unroll") for (int m = 0; m < 4; ++m) { if constexpr (F8) { const i32x4_ lo_ = *(const PG8_LAS i32x4_*)(lds + PG8_SA(b, h) + aoff + m * 2048), hi_ = *(const PG8_LAS i32x4_*)(lds + PG8_SA(b, h) + aoff + m * 2048 + 1024); dst##8[m] = __builtin_shufflevector(lo_, hi_, 0, 1, 2, 3, 4, 5, 6, 7); } \
        else { _Pragma("unroll") for (int k = 0; k < 2; ++k) dst[m][k] = *(const PG8_LAS bf16x8*)(lds + PG8_SA(b, h) + aoff + m * 2048 + k * 1024); } } } while (0)
#define PG8_LDB(dst, b, h) do { _Pragma("unroll") for (int n = 0; n < 2; ++n) { if constexpr (F8) { const i32x4_ lo_ = *(const PG8_LAS i32x4_*)(lds + PG8_SB(b, h) + boff + n * 2048), hi_ = *(const PG8_LAS i32x4_*)(lds + PG8_SB(b, h) + boff + n * 2048 + 1024); dst##8[n] = __builtin_shufflevector(lo_, hi_, 0, 1, 2, 3, 4, 5, 6, 7); } \
        else { _Pragma("unroll") for (int k = 0; k < 2; ++k) dst[n][k] = *(const PG8_LAS bf16x8*)(lds + PG8_SB(b, h) + boff + n * 2048 + k * 1024); } } } while (0)
#define PG8_MMA(ai, bj, At, Bt) do { __builtin_amdgcn_s_setprio(1); _Pragma("unroll") for (int m = 0; m < 4; ++m) _Pragma("unroll") for (int n = 0; n < 2; ++n) { \
        if constexpr (F8) asm volatile("v_mfma_scale_f32_16x16x128_f8f6f4 %0, %1, %2, %0, %3, %3 op_sel_hi:[0,0,0]" : "+v"(acc[ai][bj][m][n]) : "v"(Bt##8[n]), "v"(At##8[m]), "v"(f8scale)); \
        else { _Pragma("unroll") for (int k = 0; k < 2; ++k) acc[ai][bj][m][n] = __builtin_amdgcn_mfma_f32_16x16x32_bf16(Bt[n][k], At[m][k], acc[ai][bj][m][n], 0, 0, 0); } } \
        __builtin_amdgcn_s_setprio(0); } while (0)
#define PG8_WAIT_V(n) asm volatile("s_waitcnt vmcnt(" #n ")" ::: "memory")
#define PG8_WAIT_L(n) asm volatile("s_waitcnt lgkmcnt(" #n ")" ::: "memory")
#define PG8_BAR __builtin_amdgcn_s_barrier()
#define PG8_SCHED __builtin_amdgcn_sched_barrier(0)
    Unit cur, nxt; int ui = 0;
    if (!S.next(0, cur)) return;
    f32x4 acc[2][2][4][2];
#pragma unroll
    for (int a = 0; a < 2; ++a)
#pragma unroll
        for (int b = 0; b < 2; ++b)
#pragma unroll
            for (int m = 0; m < 4; ++m)
#pragma unroll
                for (int n = 0; n < 2; ++n) { acc[a][b][m][n] = (f32x4){0.f, 0.f, 0.f, 0.f}; if constexpr (F8) asm volatile("" : "+v"(acc[a][b][m][n])); }
    bf16x8 At[4][2], B0[2][2], B1[2][2];
    typedef int i32x4_ __attribute__((ext_vector_type(4))); typedef int i32x8_ __attribute__((ext_vector_type(8)));
    i32x8_ At8[4], B08[2], B18[2];
    int f8scale = 0x7f7f7f7f; asm volatile("" : "+v"(f8scale));
    const char* cA = (const char*)g.A + (size_t)cur.pm * tstep; const char* cB = (const char*)g.Bt + (size_t)cur.pn * tstep;
    S.a_ready(cur);
    if constexpr (SP2) {
        PG8_STAGE(PG8_SB(0, 0), cB, voffB); PG8_STAGE(PG8_SB(0, 1), cB + hstep, voffB); PG8_STAGE(PG8_SA(0, 0), cA, voffA); PG8_STAGE(PG8_SA(0, 1), cA + hstep, voffA);
        if (wr == 1) PG8_BAR;
        PG8_WAIT_V(2); PG8_BAR;
        PG8_STAGE(PG8_SB(1, 0), cB + kstep, voffB); PG8_STAGE(PG8_SA(1, 0), cA + kstep, voffA); PG8_STAGE(PG8_SB(1, 1), cB + hstep + kstep, voffB);
        PG8_WAIT_V(6); PG8_BAR;
    } else {
        PG8_STAGE(PG8_SB(0, 0), cB, voffB); PG8_STAGE(PG8_SA(0, 0), cA, voffA); PG8_STAGE(PG8_SB(0, 1), cB + hstep, voffB); PG8_STAGE(PG8_SA(0, 1), cA + hstep, voffA);
        if (wr == 1) PG8_BAR;
        PG8_WAIT_V(4); PG8_BAR;
        PG8_STAGE(PG8_SB(1, 0), cB + kstep, voffB); PG8_STAGE(PG8_SA(1, 0), cA + kstep, voffA); PG8_STAGE(PG8_SB(1, 1), cB + hstep + kstep, voffB);
        PG8_WAIT_V(6); PG8_BAR;
    }
    for (;;) {
        const bool has_next = S.next(ui + 1, nxt);
        const char* nA = has_next ? (const char*)g.A + (size_t)nxt.pm * tstep : cA; const char* nB = has_next ? (const char*)g.Bt + (size_t)nxt.pn * tstep : cB;
        for (int t = 0; t < nt; t += 2) {
            const bool last = (t == nt - 2);
            const char* a1 = cA + (size_t)(t + 1) * kstep;
            const char* a2 = last ? nA : cA + (size_t)(t + 2) * kstep; const char* b2 = last ? nB : cB + (size_t)(t + 2) * kstep;
            const char* a3 = a2 + kstep; const char* b3 = b2 + kstep;
            if (last && has_next) S.a_ready(nxt);
            if constexpr (SP2) {
            PG8_LDB(B0, 0, 0); PG8_LDB(B1, 0, 1); PG8_SCHED; PG8_LDA(At, 0, 0); PG8_STAGE(PG8_SA(1, 1), a1 + hstep, voffA);
            PG8_WAIT_V(8); PG8_WAIT_L(0); PG8_BAR; PG8_MMA(0, 0, At, B0); PG8_MMA(0, 1, At, B1); PG8_BAR; PG8_SCHED;
            PG8_LDA(At, 0, 1); PG8_STAGE(PG8_SB(0, 0), b2, voffB); PG8_STAGE(PG8_SB(0, 1), b2 + hstep, voffB); PG8_STAGE(PG8_SA(0, 0), a2, voffA);
            PG8_WAIT_V(8); PG8_WAIT_L(0); PG8_BAR; PG8_MMA(1, 0, At, B0); PG8_MMA(1, 1, At, B1); PG8_BAR; PG8_SCHED;
            PG8_LDB(B0, 1, 0); PG8_LDB(B1, 1, 1); PG8_SCHED; PG8_LDA(At, 1, 0); PG8_STAGE(PG8_SA(0, 1), a2 + hstep, voffA);
            PG8_WAIT_V(8); PG8_WAIT_L(0); PG8_BAR; PG8_MMA(0, 0, At, B0); PG8_MMA(0, 1, At, B1); PG8_BAR; PG8_SCHED;
            PG8_LDA(At, 1, 1); PG8_STAGE(PG8_SB(1, 0), b3, voffB); PG8_STAGE(PG8_SB(1, 1), b3 + hstep, voffB); PG8_STAGE(PG8_SA(1, 0), a3, voffA);
            PG8_WAIT_V(8); PG8_WAIT_L(0); PG8_BAR; PG8_MMA(1, 0, At, B0); PG8_MMA(1, 1, At, B1); PG8_BAR; PG8_SCHED;
            } else {
            PG8_LDB(B0, 0, 0); PG8_SCHED; PG8_LDA(At, 0, 0); PG8_STAGE(PG8_SA(1, 1), a1 + hstep, voffA);
            PG8_WAIT_L(8); PG8_BAR; PG8_WAIT_L(0); PG8_MMA(0, 0, At, B0); PG8_BAR; PG8_SCHED;
            PG8_LDB(B1, 0, 1); PG8_STAGE(PG8_SB(0, 0), b2, voffB);
            PG8_BAR; PG8_WAIT_L(0); PG8_MMA(0, 1, At, B1); PG8_BAR;
            PG8_LDA(At, 0, 1); PG8_STAGE(PG8_SA(0, 0), a2, voffA);
            PG8_BAR; PG8_WAIT_L(0); PG8_MMA(1, 0, At, B0); PG8_BAR; PG8_SCHED;
            PG8_STAGE(PG8_SB(0, 1), b2 + hstep, voffB);
            PG8_WAIT_V(6); PG8_BAR; PG8_MMA(1, 1, At, B1); PG8_BAR;
            PG8_LDB(B0, 1, 0); PG8_SCHED; PG8_LDA(At, 1, 0); PG8_STAGE(PG8_SA(0, 1), a2 + hstep, voffA);
            PG8_WAIT_L(8); PG8_BAR; PG8_WAIT_L(0); PG8_MMA(0, 0, At, B0); PG8_BAR; PG8_SCHED;
            PG8_LDB(B1, 1, 1); PG8_STAGE(PG8_SB(1, 0), b3, voffB);
            PG8_BAR; PG8_WAIT_L(0); PG8_MMA(0, 1, At, B1); PG8_BAR;
            PG8_LDA(At, 1, 1); PG8_STAGE(PG8_SA(1, 0), a3, voffA);
            PG8_BAR; PG8_WAIT_L(0); PG8_MMA(1, 0, At, B0); PG8_BAR; PG8_SCHED;
            PG8_STAGE(PG8_SB(1, 1), b3 + hstep, voffB);
            PG8_WAIT_V(6); PG8_BAR; PG8_MMA(1, 1, At, B1); PG8_BAR;
            }
        }
        if constexpr (F8) asm volatile("s_nop 15\n\ts_nop 15" ::: "memory");
        if constexpr (ALIGN_EPI) { if (wr == 0) PG8_BAR; }
        if constexpr (!Epi::AFTER_DRAIN) { E(acc, cur, wr, wc, fr, fq); S.done(cur); }
        if (!has_next) break;
#pragma unroll
        for (int a = 0; a < 2; ++a)
#pragma unroll
            for (int b = 0; b < 2; ++b)
#pragma unroll
                for (int m = 0; m < 4; ++m)
#pragma unroll
                    for (int n = 0; n < 2; ++n) { acc[a][b][m][n] = (f32x4){0.f, 0.f, 0.f, 0.f}; if constexpr (F8) asm volatile("" : "+v"(acc[a][b][m][n])); }
        cur = nxt; cA = nA; cB = nB; ++ui;
        if constexpr (ALIGN_EPI) { if (wr == 1) PG8_BAR; }
    }
    PG8_WAIT_V(0);
    if constexpr (!ALIGN_EPI) { if (wr == 0) PG8_BAR; }
    PG8_BAR;
    if constexpr (Epi::AFTER_DRAIN) { E.fused(acc, cur, wr, wc, fr, fq, lds, wid, lane); S.done(cur); }
#undef PG8_SA
#undef PG8_SB
#undef PG8_STAGE
#undef PG8_LDA
#undef PG8_LDB
#undef PG8_MMA
#undef PG8_WAIT_V
#undef PG8_WAIT_L
#undef PG8_BAR
#undef PG8_SCHED
}
}
#define LAS __attribute__((address_space(3)))
#define XB_TMO      128
#define XB_XCNT(j)  (256  + 64 * (j))
#define XB_XSUB(j)  (1280 + 64 * (j))
#define XB_XGEN(j)  (2304 + 64 * (j))
#define XB_TOP      3328
#define XB_TOPGEN   3392
#define XCD_BAR_WORDS 3456
#define XB_SPIN_CAP (1u << 18)

__device__ __forceinline__ unsigned xb_ld(unsigned* p)              { return __hip_atomic_load(p, __ATOMIC_RELAXED, __HIP_MEMORY_SCOPE_AGENT); }
__device__ __forceinline__ unsigned xb_add(unsigned* p, unsigned v) { return __hip_atomic_fetch_add(p, v, __ATOMIC_RELAXED, __HIP_MEMORY_SCOPE_AGENT); }
__device__ __forceinline__ unsigned xb_xcc_id() { return (unsigned)__builtin_amdgcn_s_getreg((3 << 11) | 20) & 0xFu; }
#define XB_SPIN(cond, bar) do { unsigned _sp = 0; while (cond) { __builtin_amdgcn_s_sleep(1); \
    if ((++_sp & 255u) == 0u) { if (xb_ld(&(bar)[XB_TMO])) break; if (_sp > XB_SPIN_CAP) { atomicAdd(&(bar)[XB_TMO], 1u); break; } } } } while (0)

struct XcdBarrier {
    unsigned* bar; unsigned x;
    volatile LAS unsigned* st;
};

__device__ __forceinline__ XcdBarrier xcd_barrier_post(unsigned* bar, volatile LAS unsigned* st) {
    XcdBarrier b; b.bar = bar; b.x = xb_xcc_id(); b.st = st;
    if (threadIdx.x == 0) (void)xb_add(&bar[XB_XCNT(b.x)], 1u);
    return b;
}
__device__ __forceinline__ void xcd_barrier_complete(unsigned* bar, unsigned x, unsigned& nloc, unsigned& nx) {
    const unsigned G = gridDim.x * gridDim.y * gridDim.z;
    unsigned sum, cnt, mine, sp = 0u;
    for (;;) {
        sum = 0u; cnt = 0u; mine = 0u;
#pragma unroll
        for (unsigned j = 0; j < 16; ++j) { const unsigned c = xb_ld(&bar[XB_XCNT(j)]); sum += c; cnt += (c > 0u) ? 1u : 0u; mine = (j == x) ? c : mine; }
        if (sum == G) break;
        __builtin_amdgcn_s_sleep(1);
        if ((++sp & 255u) == 0u) { if (xb_ld(&bar[XB_TMO])) break; if (sp > XB_SPIN_CAP) { atomicAdd(&bar[XB_TMO], 1u); break; } }
    }
    nloc = mine > 0u ? mine : 1u; nx = cnt > 0u ? cnt : 1u;
}

__device__ __forceinline__ void xcd_barrier(const XcdBarrier& b) {
    asm volatile("s_waitcnt vmcnt(0)" ::: "memory");
    __syncthreads();
    if (threadIdx.x == 0) {
        unsigned* bar = b.bar;
        __builtin_amdgcn_s_waitcnt(0);
        unsigned nloc = b.st[0], nx = b.st[1];
        if (nloc == 0u) { xcd_barrier_complete(bar, b.x, nloc, nx); b.st[0] = nloc; b.st[1] = nx; }
        const unsigned old = xb_add(&bar[XB_XSUB(b.x)], 1u);
        const unsigned gen = old / nloc;
        if (old + 1u == (gen + 1u) * nloc) {
            __builtin_amdgcn_fence(__ATOMIC_RELEASE, "agent");
            asm volatile("s_waitcnt vmcnt(0)" ::: "memory");
            const unsigned og = xb_add(&bar[XB_TOP], 1u);
            const unsigned tg = og / nx;
            if (og + 1u == (tg + 1u) * nx) xb_add(&bar[XB_TOPGEN], 1u);
            else XB_SPIN(xb_ld(&bar[XB_TOPGEN]) == tg, bar);
            __builtin_amdgcn_fence(__ATOMIC_ACQUIRE, "agent");
            xb_add(&bar[XB_XGEN(b.x)], 1u);
            asm volatile("s_waitcnt vmcnt(0)" ::: "memory");
        } else {
            XB_SPIN(xb_ld(&bar[XB_XGEN(b.x)]) == gen, bar);
            __builtin_amdgcn_fence(__ATOMIC_ACQUIRE, "agent");
            asm volatile("s_waitcnt vmcnt(0)" ::: "memory");
        }
    }
    __syncthreads();
}

#define DI __device__ __forceinline__
#define LDS_WAIT() asm volatile("s_waitcnt lgkmcnt(0)" ::: "memory")
typedef unsigned short bf16;
typedef float f32x4 __attribute__((ext_vector_type(4)));

namespace mk {
constexpr int NB = 8, SEQ = 2048, DM = 1024, NT = NB * SEQ, NL = 2;
constexpr int INW = 3856, ZLD = 4096;
constexpr int ZA = 0, ZRKV = 768, ZWDF = 1920, ZWDB = 1984, ZADF = 2048, ZADB = 2112, ZGD = 2176, ZMQK = 2304, ZMV = 3072, ZMO = 3456, ZMG = 3840;
constexpr int RW = 384, MW = 384, AW = 256;
constexpr int NE = 16, CAP = 256, FF = 2816, NSLOT = NB * NE * CAP;
constexpr int NWAVES = 8, NTHR = 512;
constexpr float RMS_EPS = 1e-6f;

enum { I_X = 0, I_RELB, I_LN1G, I_WIN, I_WOUT, I_MU, I_W0, I_W2, I_A0, I_A2, I_KK, I_KA, I_RK, I_G2, I_RLNG, I_RLNB,
       I_CW, I_CB, I_IB, I_FB, I_MLNG, I_LN2G, I_ROUTER, I_EW1, I_EW3, I_EW2, I_FG, N_IN };

constexpr size_t MiB = 1u << 20;
constexpr size_t WS_CTL = 0, CTL_ZERO_BYTES = 1 * MiB;
constexpr size_t WS_WTIN = 2 * MiB;
constexpr size_t WS_WTOUT = 18 * MiB;
constexpr size_t WS_W13T = 22 * MiB;
constexpr size_t WS_W2T = 374 * MiB;
constexpr size_t WS_X1 = 550 * MiB;
constexpr size_t WS_X2 = 614 * MiB;
constexpr size_t WS_HB = 678 * MiB;
constexpr size_t WS_AFF = 710 * MiB;
constexpr size_t WS_SEL = 711 * MiB;
constexpr size_t WS_GATE = 712 * MiB;
constexpr size_t WS_G2T = 713 * MiB;
constexpr size_t WS_LWT = 713 * MiB + 256 * 1024;
constexpr size_t WS_R = 714 * MiB;
constexpr size_t WS_Z = WS_R;
constexpr size_t WS_ATTO = WS_R + 128 * MiB;
constexpr size_t WS_ATTL = WS_R + 152 * MiB;
constexpr size_t WS_PR = WS_R + 154 * MiB;
constexpr size_t WS_RKY = WS_R + 442 * MiB;
constexpr size_t WS_RKB = WS_R + 490 * MiB;
constexpr size_t WS_MLQK = WS_R + 538 * MiB;
constexpr size_t WS_MLNUM = WS_R + 586 * MiB;
constexpr size_t WS_MLDEN = WS_R + 634 * MiB;
constexpr size_t WS_XG = WS_R;
constexpr size_t WS_ACT = WS_R + 64 * MiB;
constexpr size_t WS_YS = WS_R + 240 * MiB;
constexpr size_t WS_END = WS_R + 636 * MiB;

constexpr int CW_BAR = 4096;
constexpr int LDS_BYTES = 147456;
constexpr int MISC_OFF = LDS_BYTES - 256;

struct Args { const float* in[N_IN]; float* out; unsigned char* ws; int ph_lo, ph_hi; };

DI float bf2f(unsigned v) { return __uint_as_float(v << 16); }
DI unsigned f2bf(float f) { unsigned u = __float_as_uint(f); return (u + 0x7fffu + ((u >> 16) & 1u)) >> 16; }
DI unsigned pk2(float lo, float hi) { return f2bf(lo) | (f2bf(hi) << 16); }
DI float wave_sum(float v) {
#pragma unroll
    for (int o = 1; o < 64; o <<= 1) v += __shfl_xor(v, o);
    return v;
}
DI float sigm(float x) { return 1.f / (1.f + __expf(-x)); }
DI void unpack8(const uint4 w, float (&f)[8]) {
    f[0] = __uint_as_float(w.x << 16); f[1] = __uint_as_float(w.x & 0xffff0000u); f[2] = __uint_as_float(w.y << 16); f[3] = __uint_as_float(w.y & 0xffff0000u);
    f[4] = __uint_as_float(w.z << 16); f[5] = __uint_as_float(w.z & 0xffff0000u); f[6] = __uint_as_float(w.w << 16); f[7] = __uint_as_float(w.w & 0xffff0000u);
}

struct GroupOrder {
    int G, c2, nunits, per_e, nN;
    DI void init(int nN_, int G_, int bid) { nN = nN_; per_e = 8 * nN_; nunits = NE * per_e; G = G_; c2 = (G_ % 8 == 0) ? (bid % 8) * (G_ / 8) + bid / 8 : bid; }
    DI bool next(int i, pg8::Unit& u) const {
        const long L = (long)i * G + c2; if (L >= nunits) return false;
        const int e = (int)L / per_e, r = (int)L % per_e; u.pm = e * 8 + (r & 7); u.pn = e * nN + (r >> 3); return true;
    }
    DI void a_ready(const pg8::Unit&) const {}
    DI void done(const pg8::Unit&) const {}
};
DI unsigned pkbf(float lo, float hi) { typedef __bf16 b2 __attribute__((ext_vector_type(2))); typedef float f2 __attribute__((ext_vector_type(2))); const f2 v = {lo, hi}; return __builtin_bit_cast(unsigned, __builtin_convertvector(v, b2)); }
template <bool BASE_BF16>
struct EpiResT {
    static constexpr bool PERM = false, AFTER_DRAIN = false;
    const void* base; bf16* out; int ldc;
    DI void operator()(const pg8::f32x4 (&acc)[2][2][4][2], const pg8::Unit& u, int wr, int wc, int fr, int fq) const {
        const int row0 = u.pm * 256 + wr * 64 + fr, col0 = u.pn * 256 + wc * 32 + 4 * fq;
#pragma unroll
        for (int ai = 0; ai < 2; ++ai)
#pragma unroll
            for (int m = 0; m < 4; ++m) { const size_t off = (size_t)(row0 + ai * 128 + m * 16) * ldc + col0;
#pragma unroll
                for (int bj = 0; bj < 2; ++bj)
#pragma unroll
                    for (int n = 0; n < 2; ++n) { pg8::f32x4 b;
                        if constexpr (BASE_BF16) { const uint2 w = *(const uint2*)((const bf16*)base + off + bj * 128 + n * 16);
                            b[0] = __uint_as_float(w.x << 16); b[1] = __uint_as_float(w.x & 0xffff0000u); b[2] = __uint_as_float(w.y << 16); b[3] = __uint_as_float(w.y & 0xffff0000u); }
                        else b = *(const pg8::f32x4*)((const float*)base + off + bj * 128 + n * 16);
                        b += acc[ai][bj][m][n]; uint2 o; o.x = pkbf(b[0], b[1]); o.y = pkbf(b[2], b[3]); *(uint2*)(out + off + bj * 128 + n * 16) = o; } }
    }
};
DI float silu_f(float x) { return x * __builtin_amdgcn_rcpf(1.f + __expf(-x)); }
DI float f8clamp(float x) { return __builtin_amdgcn_fmed3f(x, -448.f, 448.f); }
DI unsigned pk4_fp8(float a, float b, float c, float d) { unsigned p = 0u; p = __builtin_amdgcn_cvt_pk_fp8_f32(f8clamp(a), f8clamp(b), p, false); p = __builtin_amdgcn_cvt_pk_fp8_f32(f8clamp(c), f8clamp(d), p, true); return p; }
constexpr float F8_WSC = 64.f, F8_HSC = 8.f, F8_ASC = 16.f;
struct EpiSwiGLU {
    static constexpr bool PERM = true, AFTER_DRAIN = false;
    unsigned char* act; int nN;
    DI void operator()(const pg8::f32x4 (&acc)[2][2][4][2], const pg8::Unit& u, int wr, int wc, int fr, int fq) const {
        const int lpn = u.pn % nN; const int row0 = u.pm * 256 + wr * 64 + fr, col0 = lpn * 128 + wc * 32 + 8 * fq; constexpr float is = 1.f / (F8_HSC * F8_WSC);
#pragma unroll
        for (int ai = 0; ai < 2; ++ai)
#pragma unroll
            for (int m = 0; m < 4; ++m) { unsigned char* p = act + (size_t)(row0 + ai * 128 + m * 16) * FF + col0;
                const pg8::f32x4 a0 = acc[ai][0][m][0] * is, a1 = acc[ai][0][m][1] * is, g0 = acc[ai][1][m][0] * (is * F8_ASC), g1 = acc[ai][1][m][1] * (is * F8_ASC);
                uint2 w; w.x = pk4_fp8(silu_f(a0[0]) * g0[0], silu_f(a0[1]) * g0[1], silu_f(a0[2]) * g0[2], silu_f(a0[3]) * g0[3]);
                w.y = pk4_fp8(silu_f(a1[0]) * g1[0], silu_f(a1[1]) * g1[1], silu_f(a1[2]) * g1[2], silu_f(a1[3]) * g1[3]);
                *(uint2*)p = w; }
    }
};
struct EpiGate {
    static constexpr bool PERM = true, AFTER_DRAIN = false;
    bf16* ys; const float* gate;
    DI void operator()(const pg8::f32x4 (&acc)[2][2][4][2], const pg8::Unit& u, int wr, int wc, int fr, int fq) const {
        const int row0 = u.pm * 256 + wr * 64 + fr, col0 = (u.pn & 3) * 256 + wc * 32 + 8 * fq;
#pragma unroll
        for (int ai = 0; ai < 2; ++ai)
#pragma unroll
            for (int m = 0; m < 4; ++m) { const int row = row0 + ai * 128 + m * 16; const float g = gate[row] * (1.f / (F8_ASC * F8_WSC)); bf16* p = ys + (size_t)row * DM + col0;
#pragma unroll
                for (int bj = 0; bj < 2; ++bj) { const pg8::f32x4 v0 = acc[ai][bj][m][0] * g, v1 = acc[ai][bj][m][1] * g; pg8::u32x4 w;
                    w.x = pg8::cvt_pk_bf16(v0[0], v0[1]); w.y = pg8::cvt_pk_bf16(v0[2], v0[3]); w.z = pg8::cvt_pk_bf16(v1[0], v1[1]); w.w = pg8::cvt_pk_bf16(v1[2], v1[3]);
                    *(pg8::u32x4*)(p + bj * 128) = w; } }
    }
};

DI void cvt_tile(const float* W, int N, int nvalid, int k0, int n0, bf16* dst, int Kd, size_t drow0, LAS float* scr, int lane) {
    const int c4 = (lane & 15) * 4, kr = lane >> 4;
#pragma unroll
    for (int it = 0; it < 16; ++it) { const int k = it * 4 + kr; float4 v = make_float4(0.f, 0.f, 0.f, 0.f);
        if (n0 + c4 < nvalid) v = *(const float4*)(W + (size_t)(k0 + k) * N + n0 + c4);
        LAS float* s = scr + k * 65 + c4; s[0] = v.x; s[1] = v.y; s[2] = v.z; s[3] = v.w; }
    LDS_WAIT(); asm volatile("" ::: "memory");
    const int c = lane & 7;
#pragma unroll
    for (int it = 0; it < 8; ++it) { const int n = it * 8 + (lane >> 3); const LAS float* s = scr + (8 * c) * 65 + n;
        uint4 o; o.x = pk2(s[0], s[65]); o.y = pk2(s[130], s[195]); o.z = pk2(s[260], s[325]); o.w = pk2(s[390], s[455]);
        *(uint4*)(dst + (drow0 + n) * (size_t)Kd + k0 + 8 * c) = o; }
    LDS_WAIT(); asm volatile("" ::: "memory");
}
DI void cvt_tile_fp8(const float* W, int N, int k0, int n0, unsigned char* dst, int Kd, size_t drow0, float sc, LAS unsigned char* scr, int lane) {
    const int nq = lane & 15, kq = lane >> 4;
#pragma unroll
    for (int hb = 0; hb < 2; ++hb) {
        f32x4 v[4][4];
#pragma unroll
        for (int it = 0; it < 4; ++it)
#pragma unroll
            for (int j = 0; j < 4; ++j) v[it][j] = __builtin_nontemporal_load((const f32x4*)(W + (size_t)(k0 + hb * 64 + it * 16 + kq * 4 + j) * N + n0 + 4 * nq));
#pragma unroll
        for (int it = 0; it < 4; ++it)
#pragma unroll
            for (int i = 0; i < 4; ++i) *(LAS unsigned*)(scr + (4 * nq + i) * 132 + hb * 64 + it * 16 + kq * 4) = pk4_fp8(v[it][0][i] * sc, v[it][1][i] * sc, v[it][2][i] * sc, v[it][3][i] * sc);
    }
    LDS_WAIT(); asm volatile("" ::: "memory");
    const int c = lane & 7;
#pragma unroll
    for (int it = 0; it < 8; ++it) { const int n = it * 8 + (lane >> 3); const LAS unsigned* s = (const LAS unsigned*)(scr + n * 132 + 16 * c);
        uint4 o; o.x = s[0]; o.y = s[1]; o.z = s[2]; o.w = s[3];
        *(uint4*)(dst + (drow0 + n) * (size_t)Kd + k0 + 16 * c) = o; }
    LDS_WAIT(); asm volatile("" ::: "memory");
}
DI void phase_p0(const Args& A, LAS unsigned char* lds, int it0, int it1, int gw, int ngw, int wave, int lane) {
    LAS float* scr = (LAS float*)(lds + wave * 16896);
    bf16* wtin = (bf16*)(A.ws + WS_WTIN); bf16* wtout = (bf16*)(A.ws + WS_WTOUT); unsigned char* w13 = A.ws + WS_W13T; unsigned char* w2t = A.ws + WS_W2T;
    constexpr int I_IN = NL * 16 * 64, I_OUT = NL * 16 * 16, I_E = 8 * 44, I_MOE = NL * NE * 3 * I_E;
    for (int it = it0 + gw; it < it1; it += ngw) {
        int r = it;
        if (r < I_IN) { const int l = r / 1024, t = r % 1024, kb = t / 64, nb = t % 64;
            cvt_tile(A.in[I_WIN] + (size_t)l * DM * INW, INW, INW, kb * 64, nb * 64, wtin + (size_t)l * ZLD * DM, DM, (size_t)nb * 64, scr, lane); continue; }
        r -= I_IN;
        if (r < I_OUT) { const int l = r / 256, t = r % 256, kb = t / 16, nb = t % 16;
            cvt_tile(A.in[I_WOUT] + (size_t)l * DM * DM, DM, DM, kb * 64, nb * 64, wtout + (size_t)l * DM * DM, DM, (size_t)nb * 64, scr, lane); continue; }
        r -= I_OUT;
        const int le = r / (3 * I_E), q = r % (3 * I_E), which = q / I_E, t = q % I_E;
        if (which < 2) { const int kb = t / 44, nb = t % 44, n0 = nb * 64;
            cvt_tile_fp8(A.in[which == 0 ? I_EW1 : I_EW3] + (size_t)le * DM * FF, FF, kb * 128, n0, w13 + (size_t)le * 5632 * DM, DM, (size_t)((n0 >> 7) * 256 + which * 128 + (n0 & 127)), F8_WSC, (LAS unsigned char*)scr, lane); }
        else { const int kb = t / 16, nb = t % 16;
            cvt_tile_fp8(A.in[I_EW2] + (size_t)le * FF * DM, DM, kb * 128, nb * 64, w2t + (size_t)le * DM * FF, FF, (size_t)nb * 64, F8_WSC, (LAS unsigned char*)scr, lane); }
    }
    if (it0 == 0) { bf16* g2t = (bf16*)(A.ws + WS_G2T);
        for (int idx = gw * 64 + lane; idx < NL * 128 * RW; idx += ngw * 64) { const int col = idx % RW, j = (idx / RW) % 128, l = idx / (128 * RW); g2t[((size_t)l * RW + col) * 128 + j] = (bf16)f2bf(A.in[I_G2][idx]); } }
}

DI void load_row(const float* xrow, int lane, f32x4 (&v)[4]) {
    const f32x4* xr = (const f32x4*)xrow + lane;
#pragma unroll
    for (int j = 0; j < 4; ++j) v[j] = xr[64 * j];
}
DI void load_row_bf(const bf16* xrow, int lane, f32x4 (&v)[4]) {
    const uint2* xr = (const uint2*)xrow + lane;
#pragma unroll
    for (int j = 0; j < 4; ++j) { const uint2 w = xr[64 * j]; v[j][0] = __uint_as_float(w.x << 16); v[j][1] = __uint_as_float(w.x & 0xffff0000u); v[j][2] = __uint_as_float(w.y << 16); v[j][3] = __uint_as_float(w.y & 0xffff0000u); }
}
DI void add_slots(const Args& A, int tok, int lane, f32x4 (&v)[4]) {
    const int* sel = (const int*)(A.ws + WS_SEL); const bf16* ys = (const bf16*)(A.ws + WS_YS);
    const int b = tok / SEQ; const int mys = (lane < NE) ? sel[(size_t)tok * NE + lane] : -1;
    for (int e = 0; e < NE; ++e) { const int r = __shfl(mys, e);
        if (r >= 0) { const uint2* p = (const uint2*)(ys + (size_t)((e * NB + b) * CAP + r) * DM) + lane;
#pragma unroll
            for (int j = 0; j < 4; ++j) { const uint2 w = p[64 * j]; v[j][0] += __uint_as_float(w.x << 16); v[j][1] += __uint_as_float(w.x & 0xffff0000u); v[j][2] += __uint_as_float(w.y << 16); v[j][3] += __uint_as_float(w.y & 0xffff0000u); } } }
}
DI float row_rstd(const f32x4 (&v)[4]) {
    float s = 0.f;
#pragma unroll
    for (int j = 0; j < 4; ++j) s += (v[j][0] * v[j][0] + v[j][1] * v[j][1]) + (v[j][2] * v[j][2] + v[j][3] * v[j][3]);
    return rsqrtf(wave_sum(s) * (1.f / DM) + RMS_EPS);
}
DI void phase_ln1(const Args& A, int l, int gw, int ngw, int lane) {
    const float* xin = A.in[I_X]; const bf16* x1 = (const bf16*)(A.ws + WS_X1); bf16* x2 = (bf16*)(A.ws + WS_X2); bf16* hb = (bf16*)(A.ws + WS_HB);
    f32x4 gg[4];
#pragma unroll
    for (int j = 0; j < 4; ++j) gg[j] = ((const f32x4*)(A.in[I_LN1G] + (size_t)l * DM) + lane)[64 * j];
    for (int tok = gw; tok < NT; tok += 2 * ngw) {
        const int tokb = tok + ngw; const bool hb2 = tokb < NT;
        f32x4 va[4], vb[4];
        if (l == 0) { load_row(xin + (size_t)tok * DM, lane, va); load_row(xin + (size_t)(hb2 ? tokb : tok) * DM, lane, vb); }
        else { load_row_bf(x1 + (size_t)tok * DM, lane, va); load_row_bf(x1 + (size_t)(hb2 ? tokb : tok) * DM, lane, vb);
            add_slots(A, tok, lane, va); add_slots(A, hb2 ? tokb : tok, lane, vb);
            uint2* oa = (uint2*)(x2 + (size_t)tok * DM) + lane; uint2* ob = (uint2*)(x2 + (size_t)tokb * DM) + lane;
#pragma unroll
            for (int j = 0; j < 4; ++j) { uint2 w; w.x = pkbf(va[j][0], va[j][1]); w.y = pkbf(va[j][2], va[j][3]); oa[64 * j] = w;
                if (hb2) { uint2 u; u.x = pkbf(vb[j][0], vb[j][1]); u.y = pkbf(vb[j][2], vb[j][3]); ob[64 * j] = u; } } }
        const float ra = row_rstd(va), rb = row_rstd(vb); uint2* o8a = (uint2*)(hb + (size_t)tok * DM) + lane; uint2* o8b = (uint2*)(hb + (size_t)tokb * DM) + lane;
#pragma unroll
        for (int j = 0; j < 4; ++j) { uint2 w; w.x = pkbf(va[j][0] * ra * gg[j][0], va[j][1] * ra * gg[j][1]); w.y = pkbf(va[j][2] * ra * gg[j][2], va[j][3] * ra * gg[j][3]); o8a[64 * j] = w;
            if (hb2) { uint2 u; u.x = pkbf(vb[j][0] * rb * gg[j][0], vb[j][1] * rb * gg[j][1]); u.y = pkbf(vb[j][2] * rb * gg[j][2], vb[j][3] * rb * gg[j][3]); o8b[64 * j] = u; } }
    }
}
DI void phase_final(const Args& A, int gw, int ngw, int lane) {
    const bf16* xin = (const bf16*)(A.ws + WS_X1);
    f32x4 gg[4];
#pragma unroll
    for (int j = 0; j < 4; ++j) gg[j] = ((const f32x4*)A.in[I_FG] + lane)[64 * j];
    for (int tok = gw; tok < NT; tok += 2 * ngw) {
        const int tokb = tok + ngw; const bool hb2 = tokb < NT;
        f32x4 va[4], vb[4]; load_row_bf(xin + (size_t)tok * DM, lane, va); load_row_bf(xin + (size_t)(hb2 ? tokb : tok) * DM, lane, vb);
        add_slots(A, tok, lane, va); add_slots(A, hb2 ? tokb : tok, lane, vb);
        const float ra = row_rstd(va), rb = row_rstd(vb); f32x4* oa = (f32x4*)(A.out + (size_t)tok * DM) + lane; f32x4* ob = (f32x4*)(A.out + (size_t)tokb * DM) + lane;
#pragma unroll
        for (int j = 0; j < 4; ++j) { oa[64 * j] = va[j] * ra * gg[j]; if (hb2) ob[64 * j] = vb[j] * rb * gg[j]; }
    }
}
DI void phase_topk(const Args& A, LAS unsigned char* lds, int bid, int G, int tid, int wave, int lane) {
    const unsigned* affk = (const unsigned*)(A.ws + WS_AFF); int* sel = (int*)(A.ws + WS_SEL); float* gate = (float*)(A.ws + WS_GATE);
    const unsigned char* hb = A.ws + WS_HB; unsigned char* xg = A.ws + WS_XG;
    LAS unsigned* hist = (LAS unsigned*)lds;
    LAS unsigned* wsum = hist + 32;
    LAS int* list = (LAS int*)(lds + 256);
    for (int u = bid; u < NB * NE * 2; u += G) {
        const int half = u & 1, e = (u >> 1) % NE, b = u / (2 * NE);
        __syncthreads();
        if (tid < 32) hist[tid] = 0u;
        const uint4 kv = *(const uint4*)(affk + (size_t)(b * NE + e) * SEQ + tid * 4);
        const unsigned key[4] = {kv.x, kv.y, kv.z, kv.w};
        __syncthreads();
        unsigned prefix = 0u, krem = CAP;
#pragma unroll 1
        for (int pass = 0; pass < 8; ++pass) { const int shift = 28 - 4 * pass; LAS unsigned* h = hist + (pass & 1) * 16;
            unsigned cnt = 0u;
#pragma unroll
            for (int i = 0; i < 4; ++i) { const bool cand = (pass == 0) || ((key[i] >> (shift + 4)) == prefix); const unsigned bin = (key[i] >> shift) & 15u;
#pragma unroll
                for (int v = 0; v < 16; ++v) { const unsigned long long m = __ballot(cand && bin == (unsigned)v); if (lane == v) cnt += (unsigned)__popcll(m); } }
            if (lane < 16 && cnt) atomicAdd((unsigned*)(h + lane), cnt);
            __syncthreads();
            unsigned acc = 0u, pick = 0u, before = 0u;
#pragma unroll
            for (int v = 15; v >= 0; --v) { const unsigned c = h[v]; if (acc < krem && acc + c >= krem) { pick = (unsigned)v; before = acc; } acc += c; }
            prefix = (prefix << 4) | pick; krem -= before;
            if (tid < 16) hist[((pass + 1) & 1) * 16 + tid] = 0u;
            __syncthreads();
        }
        const unsigned tau = prefix;
        unsigned gt[4], eq[4]; unsigned ngt = 0u, neq = 0u;
#pragma unroll
        for (int i = 0; i < 4; ++i) { gt[i] = key[i] > tau ? 1u : 0u; eq[i] = key[i] == tau ? 1u : 0u; ngt += gt[i]; neq += eq[i]; }
        unsigned sg = ngt, se = neq;
#pragma unroll
        for (int o = 1; o < 64; o <<= 1) { const unsigned tg = __shfl_up(sg, o), te = __shfl_up(se, o); if (lane >= o) { sg += tg; se += te; } }
        if (lane == 63) { wsum[wave] = sg; wsum[8 + wave] = se; }
        __syncthreads();
        unsigned offg = 0u, offe = 0u;
        for (int w = 0; w < wave; ++w) { offg += wsum[w]; offe += wsum[8 + w]; }
        unsigned eqbefore = offe + se - neq;
        unsigned gtbefore = offg + sg - ngt;
        const int slot0 = (e * NB + b) * CAP;
#pragma unroll
        for (int i = 0; i < 4; ++i) { const int s = tid * 4 + i; const bool selq = gt[i] || (eq[i] && eqbefore < krem);
            const unsigned pos = gtbefore + (eqbefore < krem ? eqbefore : krem);
            if ((s >> 10) == half) { sel[(size_t)(b * SEQ + s) * NE + e] = selq ? (int)pos : -1;
                if (selq) { gate[slot0 + pos] = __uint_as_float(key[i]); } }
            if (selq && pos < CAP) list[pos] = s;
            gtbefore += gt[i]; eqbefore += eq[i]; }
        __syncthreads();
        for (int r = wave; r < CAP; r += NWAVES) { const int s = list[r];
            if ((s >> 10) == half) { const uint4* src = (const uint4*)(hb + (size_t)(b * SEQ + s) * DM) + lane; uint4* dstp = (uint4*)(xg + (size_t)(slot0 + r) * DM) + lane; dstp[0] = src[0]; } }
    }
    __syncthreads();
}

DI int t5_bucket(int rel) {
    const int ret = rel > 0 ? 16 : 0; const int n = rel < 0 ? -rel : rel;
    if (n < 8) return ret + n;
    int large = 8 + (int)(logf((float)n / 8.0f) / 4.852030263919617f * 8.0f);
    large = large < 15 ? large : 15;
    return ret + large;
}

typedef short bf16x8_t __attribute__((ext_vector_type(8)));
typedef short bf16x4_t __attribute__((ext_vector_type(4)));
typedef unsigned u32x4_t __attribute__((ext_vector_type(4)));
typedef unsigned u32x2_t __attribute__((ext_vector_type(2)));
typedef __bf16 bf2_t __attribute__((ext_vector_type(2)));
typedef float f2_t __attribute__((ext_vector_type(2)));
DI unsigned cvtpk(float lo, float hi) { const f2_t v = {lo, hi}; return __builtin_bit_cast(unsigned, __builtin_convertvector(v, bf2_t)); }
#define MFMA16(a, b, c) __builtin_amdgcn_mfma_f32_16x16x32_bf16((a), (b), (c), 0, 0, 0)

constexpr int AT_QS = 0, AT_QLD = 72;
constexpr int AT_KS = AT_QS + 128 * AT_QLD * 2;
constexpr int AT_VT = AT_KS + 272 * AT_QLD * 2, AT_VLD = 280;
constexpr int AT_BT = AT_VT + 64 * AT_VLD * 2;
constexpr int AT_END = AT_BT + 132 * 4;
static_assert(AT_END <= MISC_OFF, "attention LDS");

DI void attn_unit(const Args& A, LAS unsigned char* lds, int unit, int tid, int wave, int lane) {
    const bf16* Z = (const bf16*)(A.ws + WS_Z); bf16* ao = (bf16*)(A.ws + WS_ATTO); float* al = (float*)(A.ws + WS_ATTL);
    const int x = unit & 15; int r0 = unit >> 4; const int hh = r0 & 3; r0 >>= 2; const int b = r0 % NB, br = r0 / NB;
    const int dil = br == 0 ? 1 : (br == 1 ? 4 : 16), lsub = SEQ / dil, nblk = lsub / 128;
    const int res = x / nblk, nbk = x % nblk, l0 = nbk * 128, wbase = l0 - 64;
    LAS bf16* Qs = (LAS bf16*)(lds + AT_QS); LAS bf16* Ks = (LAS bf16*)(lds + AT_KS); LAS bf16* Vt = (LAS bf16*)(lds + AT_VT); LAS float* btab = (LAS float*)(lds + AT_BT);
    __syncthreads();
#pragma unroll
    for (int i = 0; i < 2; ++i) { const int id = tid + 512 * i, row = id >> 3, ch = id & 7; const int tok = b * SEQ + (l0 + row) * dil + res;
        *(LAS u32x4_t*)(Qs + row * AT_QLD + ch * 8) = *(const u32x4_t*)(Z + (size_t)tok * ZLD + ZA + hh * 64 + ch * 8); }
    for (int id = tid; id < 272 * 8; id += NTHR) { const int row = id >> 3, ch = id & 7; const int pos = wbase + row; u32x4_t v = (u32x4_t){0u, 0u, 0u, 0u};
        if (row < 256 && pos >= 0 && pos < lsub) v = *(const u32x4_t*)(Z + (size_t)(b * SEQ + pos * dil + res) * ZLD + ZA + 256 + hh * 64 + ch * 8);
        *(LAS u32x4_t*)(Ks + row * AT_QLD + ch * 8) = v; }
    for (int id = tid; id < 272 * 8; id += NTHR) { const int key = id % 272, ch = id / 272; const int pos = wbase + key; u32x4_t v = (u32x4_t){0u, 0u, 0u, 0u};
        if (key < 256 && pos >= 0 && pos < lsub) v = *(const u32x4_t*)(Z + (size_t)(b * SEQ + pos * dil + res) * ZLD + ZA + 512 + hh * 64 + ch * 8);
        LAS bf16* d = Vt + (ch * 8) * AT_VLD + key;
        d[0] = (bf16)(v.x & 0xffffu); d[AT_VLD] = (bf16)(v.x >> 16); d[2 * AT_VLD] = (bf16)(v.y & 0xffffu); d[3 * AT_VLD] = (bf16)(v.y >> 16);
        d[4 * AT_VLD] = (bf16)(v.z & 0xffffu); d[5 * AT_VLD] = (bf16)(v.z >> 16); d[6 * AT_VLD] = (bf16)(v.w & 0xffffu); d[7 * AT_VLD] = (bf16)(v.w >> 16); }
    if (tid < 129) btab[tid] = A.in[I_RELB][t5_bucket((tid - 64) * dil) * 4 + hh];
    __syncthreads();
    const int fr = lane & 15, qd = lane >> 4;
    f32x4 acc[10];
    { bf16x8_t qb[2];
#pragma unroll
      for (int ks = 0; ks < 2; ++ks) qb[ks] = *(const LAS bf16x8_t*)(Qs + (16 * wave + fr) * AT_QLD + ks * 32 + 8 * qd);
#pragma unroll
      for (int j = 0; j < 10; ++j) { acc[j] = (f32x4){0.f, 0.f, 0.f, 0.f};
#pragma unroll
          for (int ks = 0; ks < 2; ++ks) { const bf16x8_t ka = *(const LAS bf16x8_t*)(Ks + (16 * (wave + j) + fr) * AT_QLD + ks * 32 + 8 * qd); acc[j] = MFMA16(ka, qb[ks], acc[j]); } } }
    const int iq = 16 * wave + fr; float mx = -1.0e30f;
#pragma unroll
    for (int j = 0; j < 10; ++j)
#pragma unroll
        for (int r = 0; r < 4; ++r) { const int kw = 16 * (wave + j) + 4 * qd + r; const int m = kw - 64 - iq; const int pos = wbase + kw;
            const bool valid = (m >= -64) && (m <= 64) && (pos >= 0) && (pos < lsub);
            const float s = valid ? acc[j][r] * 0.125f + btab[valid ? m + 64 : 0] : -1.0e30f; acc[j][r] = s; mx = fmaxf(mx, s); }
    mx = fmaxf(mx, __shfl_xor(mx, 16)); mx = fmaxf(mx, __shfl_xor(mx, 32));
    float lsum = 0.f;
#pragma unroll
    for (int j = 0; j < 10; ++j)
#pragma unroll
        for (int r = 0; r < 4; ++r) { const float p = __expf(acc[j][r] - mx); acc[j][r] = p; lsum += p; }
    lsum += __shfl_xor(lsum, 16); lsum += __shfl_xor(lsum, 32);
    f32x4 oacc[4];
#pragma unroll
    for (int d = 0; d < 4; ++d) oacc[d] = (f32x4){0.f, 0.f, 0.f, 0.f};
#pragma unroll
    for (int pp = 0; pp < 5; ++pp) {
        union { unsigned u[4]; bf16x8_t v; } pb;
        pb.u[0] = cvtpk(acc[2 * pp][0], acc[2 * pp][1]); pb.u[1] = cvtpk(acc[2 * pp][2], acc[2 * pp][3]); pb.u[2] = cvtpk(acc[2 * pp + 1][0], acc[2 * pp + 1][1]); pb.u[3] = cvtpk(acc[2 * pp + 1][2], acc[2 * pp + 1][3]);
#pragma unroll
        for (int d = 0; d < 4; ++d) { const LAS bf16* vp = Vt + (16 * d + fr) * AT_VLD + 16 * (wave + 2 * pp) + 4 * qd;
            union { bf16x4_t h[2]; bf16x8_t v; } va; va.h[0] = *(const LAS bf16x4_t*)vp; va.h[1] = *(const LAS bf16x4_t*)(vp + 16);
            oacc[d] = MFMA16(va.v, pb.v, oacc[d]); } }
    const float inv = 1.f / lsum; const int tok = b * SEQ + (l0 + iq) * dil + res;
    bf16* op = ao + ((size_t)br * NT + tok) * AW + hh * 64 + 4 * qd;
#pragma unroll
    for (int d = 0; d < 4; ++d) { uint2 w; w.x = cvtpk(oacc[d][0] * inv, oacc[d][1] * inv); w.y = cvtpk(oacc[d][2] * inv, oacc[d][3] * inv); *(uint2*)(op + 16 * d) = w; }
    if (qd == 0) al[((size_t)br * NT + tok) * 4 + hh] = mx + logf(lsum);
}
DI void phase_attn(const Args& A, LAS unsigned char* lds, int bid, int G, int tid, int wave, int lane) {
    for (int u = bid; u < 3 * NB * 4 * 16; u += G) attn_unit(A, lds, u, tid, wave, lane);
    __syncthreads();
}


constexpr int ML_QLD = 104, ML_SLD = 72;
constexpr int ML_QS = 0;
constexpr int ML_QT = ML_QS + 64 * ML_QLD * 2;
constexpr int ML_KS = ML_QT + 64 * ML_QLD * 2;
constexpr int ML_KT = ML_KS + 64 * ML_QLD * 2;
constexpr int ML_VT = ML_KT + 96 * ML_SLD * 2;
constexpr int ML_WS = ML_VT + 112 * ML_SLD * 2;
constexpr int ML_CT = ML_WS + 64 * ML_SLD * 2;
constexpr int ML_CW = ML_CT + 112 * ML_QLD * 2;
constexpr int ML_END = ML_CW + 6 * 192 * 4;
static_assert(ML_END <= MISC_OFF, "mlstm LDS");

constexpr int MLP_QF = 0, MLP_NI = 12288, MLP_U = 26624, MLP_DEC = 48128, MLP_BYTES = 48384;
constexpr size_t WS_MLPKG = WS_R + 304 * MiB;
static_assert(WS_MLPKG + (size_t)2 * NB * 4 * 32 * MLP_BYTES <= WS_RKY, "mlstm package region");

struct M1Regs { u32x4_t zc[15]; u32x2_t vv[3]; float gi, gf; };
DI void mlstm_m1_fetch(const Args& A, int item, int tid, int lane, M1Regs& R) {
    const bf16* Z = (const bf16*)(A.ws + WS_Z);
    const int c = item & 31, u = item >> 5; const int dir = u / 32, b = (u % 32) / 4, hh = u % 4; const int j = tid >> 3, sub = tid & 7;
    const int tl = dir ? SEQ - 1 - (c * 64 + lane) : c * 64 + lane; const size_t tokl = (size_t)b * SEQ + tl;
    R.gi = bf2f(Z[tokl * ZLD + ZMG + dir * 8 + hh]); R.gf = bf2f(Z[tokl * ZLD + ZMG + dir * 8 + 4 + hh]);
    const int tj = dir ? SEQ - 1 - (c * 64 + j) : c * 64 + j; const size_t tokj = (size_t)b * SEQ + tj;
    const bool isk = sub >= 4; const int zcol = ZMQK + (isk ? 384 : 0) + hh * 96 + (sub & 3) * 24;
#pragma unroll
    for (int tap = 0; tap < 5; ++tap) { const int tt = tj + tap - 2; const bool ok = tt >= 0 && tt < SEQ; const u32x4_t* zp = (const u32x4_t*)(Z + ((size_t)b * SEQ + (ok ? tt : tj)) * ZLD + zcol);
#pragma unroll
        for (int q4 = 0; q4 < 3; ++q4) { const u32x4_t w = zp[q4]; R.zc[tap * 3 + q4] = ok ? w : (u32x4_t){0u, 0u, 0u, 0u}; } }
    const u32x2_t* vp = (const u32x2_t*)(Z + tokj * ZLD + ZMV + hh * 96 + sub * 12);
#pragma unroll
    for (int q2 = 0; q2 < 3; ++q2) R.vv[q2] = vp[q2];
}
DI void mlstm_m1_item(const Args& A, int l, LAS unsigned char* lds, int item, int item_next, M1Regs& R, int& hh_staged, int tid, int wave, int lane) {
    const int c = item & 31, u = item >> 5; const int dir = u / 32, hh = u % 4;
    LAS bf16* Qs = (LAS bf16*)(lds + ML_QS); LAS bf16* Qt = (LAS bf16*)(lds + ML_QT); LAS bf16* Ks = (LAS bf16*)(lds + ML_KS); LAS bf16* KtT = (LAS bf16*)(lds + ML_KT);
    LAS bf16* VtT = (LAS bf16*)(lds + ML_VT); LAS bf16* Ws = (LAS bf16*)(lds + ML_WS); LAS float* cwl = (LAS float*)(lds + ML_CW); LAS float* cbl = cwl + 5 * 192;
    const int fr = lane & 15, qd = lane >> 4;
    unsigned char* pkg = A.ws + WS_MLPKG + (size_t)item * MLP_BYTES;
    __syncthreads();
    if (hh != hh_staged) { hh_staged = hh;
        for (int i = tid; i < 5 * 192; i += NTHR) { const int tap = i / 192, ch = i % 192; cwl[i] = A.in[I_CW][(size_t)(l * 5 + tap) * 768 + (ch < 96 ? 0 : 384) + hh * 96 + (ch % 96)]; }
        for (int i = tid; i < 192; i += NTHR) cbl[i] = A.in[I_CB][(size_t)l * 768 + (i < 96 ? 0 : 384) + hh * 96 + (i % 96)];
        for (int i = tid; i < 16 * ML_SLD; i += NTHR) VtT[96 * ML_SLD + i] = (i < ML_SLD) ? (bf16)0x3F80u : (bf16)0u;
        __syncthreads(); }
    const float ibv = A.in[I_IB][(l * 2 + dir) * 4 + hh], fbv = A.in[I_FB][(l * 2 + dir) * 4 + hh];
    const int j = tid >> 3, sub = tid & 7;
    const float gi = R.gi + ibv, gf = R.gf + fbv;
    float bsum = fminf(gf, 0.f) - __logf(1.f + __expf(-fabsf(gf)));
#pragma unroll
    for (int o = 1; o < 64; o <<= 1) { const float t = __shfl_up(bsum, o); if (lane >= o) bsum += t; }
    const float bend = __shfl(bsum, 63);
    const float bj = __shfl(bsum, j), igj = __shfl(gi, j);
    { const bool isk = sub >= 4; const int c0 = (sub & 3) * 24, cl = (isk ? 96 : 0) + c0;
      float acc[24];
#pragma unroll
      for (int e = 0; e < 24; ++e) acc[e] = cbl[cl + e];
#pragma unroll
      for (int tap = 0; tap < 5; ++tap) {
#pragma unroll
          for (int q4 = 0; q4 < 3; ++q4) { const u32x4_t w = R.zc[tap * 3 + q4]; const LAS float* cwp = cwl + tap * 192 + cl + q4 * 8;
              acc[q4 * 8 + 0] += cwp[0] * __uint_as_float(w.x << 16); acc[q4 * 8 + 1] += cwp[1] * __uint_as_float(w.x & 0xffff0000u);
              acc[q4 * 8 + 2] += cwp[2] * __uint_as_float(w.y << 16); acc[q4 * 8 + 3] += cwp[3] * __uint_as_float(w.y & 0xffff0000u);
              acc[q4 * 8 + 4] += cwp[4] * __uint_as_float(w.z << 16); acc[q4 * 8 + 5] += cwp[5] * __uint_as_float(w.z & 0xffff0000u);
              acc[q4 * 8 + 6] += cwp[6] * __uint_as_float(w.w << 16); acc[q4 * 8 + 7] += cwp[7] * __uint_as_float(w.w & 0xffff0000u); } }
      const float sc1 = isk ? 0.10206207261596575f : 1.f; const float sc2 = isk ? __expf(bend - bj + igj) : __expf(bj);
#pragma unroll
      for (int e = 0; e < 24; ++e) acc[e] = acc[e] * sigm(acc[e]) * sc1;
      if (!isk) { LAS bf16* d1 = Qs + j * ML_QLD + c0; LAS bf16* d2 = Qt + j * ML_QLD + c0;
#pragma unroll
          for (int q4 = 0; q4 < 3; ++q4) { u32x4_t w; w.x = cvtpk(acc[q4 * 8 + 0], acc[q4 * 8 + 1]); w.y = cvtpk(acc[q4 * 8 + 2], acc[q4 * 8 + 3]); w.z = cvtpk(acc[q4 * 8 + 4], acc[q4 * 8 + 5]); w.w = cvtpk(acc[q4 * 8 + 6], acc[q4 * 8 + 7]);
              *(LAS u32x4_t*)(d1 + q4 * 8) = w;
              u32x4_t x; x.x = cvtpk(acc[q4 * 8 + 0] * sc2, acc[q4 * 8 + 1] * sc2); x.y = cvtpk(acc[q4 * 8 + 2] * sc2, acc[q4 * 8 + 3] * sc2); x.z = cvtpk(acc[q4 * 8 + 4] * sc2, acc[q4 * 8 + 5] * sc2); x.w = cvtpk(acc[q4 * 8 + 6] * sc2, acc[q4 * 8 + 7] * sc2);
              *(LAS u32x4_t*)(d2 + q4 * 8) = x; } }
      else { LAS bf16* d1 = Ks + j * ML_QLD + c0;
#pragma unroll
          for (int q4 = 0; q4 < 3; ++q4) { u32x4_t w; w.x = cvtpk(acc[q4 * 8 + 0], acc[q4 * 8 + 1]); w.y = cvtpk(acc[q4 * 8 + 2], acc[q4 * 8 + 3]); w.z = cvtpk(acc[q4 * 8 + 4], acc[q4 * 8 + 5]); w.w = cvtpk(acc[q4 * 8 + 6], acc[q4 * 8 + 7]);
              *(LAS u32x4_t*)(d1 + q4 * 8) = w; }
#pragma unroll
          for (int e = 0; e < 24; ++e) KtT[(c0 + e) * ML_SLD + j] = (bf16)f2bf(acc[e] * sc2); } }
    { const int n0 = sub * 12;
#pragma unroll
      for (int q2 = 0; q2 < 3; ++q2) { const u32x2_t w = R.vv[q2]; LAS bf16* d = VtT + (n0 + q2 * 4) * ML_SLD + j;
          d[0] = (bf16)(w.x & 0xffffu); d[ML_SLD] = (bf16)(w.x >> 16); d[2 * ML_SLD] = (bf16)(w.y & 0xffffu); d[3 * ML_SLD] = (bf16)(w.y >> 16); } }
    if (item_next >= 0) mlstm_m1_fetch(A, item_next, tid, lane, R);
    __syncthreads();
#pragma unroll
    for (int i = 0; i < 2; ++i) { const int tile = 2 * wave + i, jt = tile >> 2, st = tile & 3; const int jq = 16 * jt + fr;
        u32x2_t w = (u32x2_t){0u, 0u};
        if (st <= jt) { f32x4 acc = (f32x4){0.f, 0.f, 0.f, 0.f};
#pragma unroll
            for (int ks = 0; ks < 3; ++ks) { const bf16x8_t a = *(const LAS bf16x8_t*)(Ks + (16 * st + fr) * ML_QLD + 32 * ks + 8 * qd); const bf16x8_t bq = *(const LAS bf16x8_t*)(Qs + jq * ML_QLD + 32 * ks + 8 * qd); acc = MFMA16(a, bq, acc); }
            const float bjq = __shfl(bsum, jq); float wv[4];
#pragma unroll
            for (int r = 0; r < 4; ++r) { const int s = 16 * st + 4 * qd + r; const float bs = __shfl(bsum, s), igs = __shfl(gi, s); wv[r] = (s <= jq) ? acc[r] * __expf(bjq - bs + igs) : 0.f; }
            w.x = cvtpk(wv[0], wv[1]); w.y = cvtpk(wv[2], wv[3]); }
        *(LAS u32x2_t*)(Ws + jq * ML_SLD + 16 * st + 4 * qd) = w; }
    __syncthreads();
    for (int id = wave; id < 12; id += NWAVES) { const int jt = id / 3, i3 = id % 3; const LAS bf16* p = Qt + (16 * jt + fr) * ML_QLD + 32 * i3 + 4 * qd; const u32x2_t lo = *(const LAS u32x2_t*)p, hi = *(const LAS u32x2_t*)(p + 16);
        *(u32x4_t*)(pkg + MLP_QF + (size_t)id * 1024 + lane * 16) = (u32x4_t){lo.x, lo.y, hi.x, hi.y}; }
    for (int id = wave; id < 70; id += NWAVES) { f32x4 acc = (f32x4){0.f, 0.f, 0.f, 0.f}; int nt; const LAS bf16* ap; int ald; unsigned char* dst;
        if (id < 28) { const int jt = id & 3; nt = id >> 2; ap = Ws + (16 * jt + fr) * ML_SLD; ald = 0; dst = pkg + MLP_NI + (size_t)(nt * 4 + jt) * 512; }
        else { const int q = id - 28, kt = q % 6; nt = q / 6; ap = KtT + (16 * kt + fr) * ML_SLD; ald = 0; dst = pkg + MLP_U + (size_t)(nt * 6 + kt) * 512; }
#pragma unroll
        for (int ks = 0; ks < 2; ++ks) { const bf16x8_t a = *(const LAS bf16x8_t*)(ap + 32 * ks + 8 * qd); const bf16x8_t bv = *(const LAS bf16x8_t*)(VtT + (16 * nt + fr) * ML_SLD + 32 * ks + 8 * qd); acc = MFMA16(a, bv, acc); }
        u32x2_t w; w.x = cvtpk(acc[0], acc[1]); w.y = cvtpk(acc[2], acc[3]); *(u32x2_t*)(dst + lane * 8) = w; }
    if (tid < 64) ((float*)(pkg + MLP_DEC))[tid] = __expf(bend);
}
DI void phase_mlstm_m1(const Args& A, int l, LAS unsigned char* lds, int bid, int G, int tid, int wave, int lane) {
    int hh_staged = -1; constexpr int NIT = 2 * NB * 4 * 32;
    if (bid < NIT) { M1Regs R; mlstm_m1_fetch(A, bid, tid, lane, R);
        for (int it = bid; it < NIT; it += G) mlstm_m1_item(A, l, lds, it, (it + G < NIT) ? it + G : -1, R, hh_staged, tid, wave, lane); }
    __syncthreads();
}
constexpr int M2_SLOTS = 8, M2_SLOT_BYTES = 12288, M2_CTL = M2_SLOTS * M2_SLOT_BYTES;
static_assert(M2_CTL + 64 <= MISC_OFF, "mlstm m2 LDS");
DI f32x4 unpk4(const u32x2_t w) { return (f32x4){__uint_as_float(w.x << 16), __uint_as_float(w.x & 0xffff0000u), __uint_as_float(w.y << 16), __uint_as_float(w.y & 0xffff0000u)}; }
struct M2Small { u32x2_t ni[4], uu[6]; float dec; };
DI void m2_load_small(M2Small& o, const unsigned char* pkg, int nt, int lane) {
#pragma unroll
    for (int jt = 0; jt < 4; ++jt) o.ni[jt] = *(const u32x2_t*)(pkg + MLP_NI + (nt * 4 + jt) * 512 + lane * 8);
#pragma unroll
    for (int kt = 0; kt < 6; ++kt) o.uu[kt] = *(const u32x2_t*)(pkg + MLP_U + (nt * 6 + kt) * 512 + lane * 8);
    o.dec = ((const float*)(pkg + MLP_DEC))[lane];
}
DI void m2_step(const M2Small& o, const LAS unsigned char* slot, f32x4 (&C)[6], bf16* num, float* den, int dir, int b, int hh, int nt, int c, int lane, int fr, int qd) {
    union { unsigned u[4]; bf16x8_t v; } sB[3];
#pragma unroll
    for (int i = 0; i < 3; ++i) { sB[i].u[0] = cvtpk(C[2 * i][0], C[2 * i][1]); sB[i].u[1] = cvtpk(C[2 * i][2], C[2 * i][3]); sB[i].u[2] = cvtpk(C[2 * i + 1][0], C[2 * i + 1][1]); sB[i].u[3] = cvtpk(C[2 * i + 1][2], C[2 * i + 1][3]); }
#pragma unroll
    for (int jt = 0; jt < 4; ++jt) { f32x4 acc = unpk4(o.ni[jt]);
#pragma unroll
        for (int i = 0; i < 3; ++i) { const bf16x8_t qf = *(const LAS bf16x8_t*)(slot + (3 * jt + i) * 1024 + lane * 16); acc = MFMA16(qf, sB[i].v, acc); }
#pragma unroll
        for (int r = 0; r < 4; ++r) { const int jj = 16 * jt + 4 * qd + r; const int tt = dir ? SEQ - 1 - (c * 64 + jj) : c * 64 + jj; const size_t tok = (size_t)b * SEQ + tt;
            if (nt < 6) num[((size_t)dir * NT + tok) * MW + hh * 96 + 16 * nt + fr] = (bf16)f2bf(acc[r]); else if (fr == 0) den[((size_t)dir * NT + tok) * 4 + hh] = acc[r]; } }
#pragma unroll
    for (int kt = 0; kt < 6; ++kt) C[kt] = C[kt] * o.dec + unpk4(o.uu[kt]);
}
DI void mlstm_m2_unit(const Args& A, LAS unsigned char* lds, int u, int tid, int wave, int lane) {
    bf16* num = (bf16*)(A.ws + WS_MLNUM); float* den = (float*)(A.ws + WS_MLDEN);
    const int dir = u / 32, b = (u % 32) / 4, hh = u % 4; const int fr = lane & 15, qd = lane >> 4;
    const unsigned char* pkg0 = A.ws + WS_MLPKG + (size_t)u * 32 * MLP_BYTES;
    volatile LAS unsigned* ready = (volatile LAS unsigned*)(lds + M2_CTL); volatile LAS unsigned* consumed = ready + 8;
    __syncthreads();
    if (tid < 16) ready[tid] = 0u;
    __syncthreads();
    if (wave == 7) {
        u32x4_t f0[12], f1[12], f2[12];
#define M2_FETCH(dst, c_) do { _Pragma("unroll") for (int i = 0; i < 12; ++i) dst[i] = *(const u32x4_t*)(pkg0 + (size_t)(c_) * MLP_BYTES + MLP_QF + i * 1024 + lane * 16); } while (0)
#define M2_PUBLISH(src, c_) do { if ((c_) >= M2_SLOTS) { const unsigned need = (unsigned)((c_) - M2_SLOTS + 1); unsigned spins = 0; \
            for (;;) { bool ok = true; _Pragma("unroll") for (int w = 0; w < 7; ++w) ok = ok && (consumed[w] >= need); if (ok) break; if (++spins > (1u << 22)) break; __builtin_amdgcn_s_sleep(1); } } \
        LAS unsigned char* slot_ = lds + ((c_) & (M2_SLOTS - 1)) * M2_SLOT_BYTES; _Pragma("unroll") for (int i = 0; i < 12; ++i) *(LAS u32x4_t*)(slot_ + i * 1024 + lane * 16) = src[i]; \
        asm volatile("s_waitcnt lgkmcnt(0)" ::: "memory"); if (lane == 0) ready[(c_) & (M2_SLOTS - 1)] = (unsigned)((c_) + 1); asm volatile("" ::: "memory"); } while (0)
        M2_FETCH(f0, 0); M2_FETCH(f1, 1);
        for (int c = 0; c < 30; c += 3) { M2_FETCH(f2, c + 2); M2_PUBLISH(f0, c); M2_FETCH(f0, c + 3); M2_PUBLISH(f1, c + 1); M2_FETCH(f1, c + 4); M2_PUBLISH(f2, c + 2); }
        M2_PUBLISH(f0, 30); M2_PUBLISH(f1, 31);
#undef M2_FETCH
#undef M2_PUBLISH
    } else {
        const int nt = wave; f32x4 C[6];
#pragma unroll
        for (int kt = 0; kt < 6; ++kt) C[kt] = (f32x4){0.f, 0.f, 0.f, 0.f};
        M2Small s0, s1, s2, s3;
        m2_load_small(s0, pkg0, nt, lane); m2_load_small(s1, pkg0 + MLP_BYTES, nt, lane); m2_load_small(s2, pkg0 + 2 * (size_t)MLP_BYTES, nt, lane); m2_load_small(s3, pkg0 + 3 * (size_t)MLP_BYTES, nt, lane);
#define M2_CHAIN(sx, c_) do { unsigned spins = 0; while (ready[(c_) & (M2_SLOTS - 1)] != (unsigned)((c_) + 1)) { if (++spins > (1u << 22)) break; __builtin_amdgcn_s_sleep(1); } asm volatile("" ::: "memory"); \
            m2_step(sx, lds + ((c_) & (M2_SLOTS - 1)) * M2_SLOT_BYTES, C, num, den, dir, b, hh, nt, (c_), lane, fr, qd); \
            asm volatile("s_waitcnt lgkmcnt(0)" ::: "memory"); if (lane == 0) consumed[nt] = (unsigned)((c_) + 1); asm volatile("" ::: "memory"); \
            if ((c_) + 4 < 32) m2_load_small(sx, pkg0 + (size_t)((c_) + 4) * MLP_BYTES, nt, lane); } while (0)
        for (int c = 0; c < 32; c += 4) { M2_CHAIN(s0, c); M2_CHAIN(s1, c + 1); M2_CHAIN(s2, c + 2); M2_CHAIN(s3, c + 3); }
#undef M2_CHAIN
    }
    __syncthreads();
}

constexpr int PKG_BYTES = 12544;
constexpr int PK_AH = 0, PK_RH = 2048, PK_KB = 4096, PK_VV = 8192, PK_TM = 10240, PK_MM = 10752, PK_LAK = 11776, PK_GE = 12288;
constexpr size_t WS_PKG = WS_PR;
static_assert((size_t)2 * NB * 6 * 128 * PKG_BYTES <= 288 * MiB, "package region");
constexpr int R1_W2T = 0, R1_A2T = 9216, R1_WV = 18432, R1_WV_BYTES = 12928;
constexpr int R1_IMG = 0, R1_LF = 9216, R1_MT = 10368;
static_assert(R1_WV + 8 * R1_WV_BYTES <= MISC_OFF, "rwkv r1 LDS");

DI bf16x4_t pack4(const f32x4 v) { union { unsigned u[2]; bf16x4_t h; } x; x.u[0] = cvtpk(v[0], v[1]); x.u[1] = cvtpk(v[2], v[3]); return x.h; }

DI void rwkv_r1_item(const Args& A, int l, LAS unsigned char* lds, int item, int& dh_staged, int tid, int wave, int lane) {
    const bf16* Z = (const bf16*)(A.ws + WS_Z);
    const int g = item & 15; int r0 = item >> 4; const int hh = r0 % 6; r0 /= 6; const int b = r0 % NB, dir = r0 / NB;
    const int cc = 8 * g + wave, fr = lane & 15, qd = lane >> 4;
    LAS bf16* W2T = (LAS bf16*)(lds + R1_W2T); LAS bf16* A2T = (LAS bf16*)(lds + R1_A2T);
    LAS unsigned char* wv = lds + R1_WV + wave * R1_WV_BYTES;
    LAS bf16* IMG = (LAS bf16*)(wv + R1_IMG); LAS float* Lf = (LAS float*)(wv + R1_LF); LAS bf16* MT = (LAS bf16*)(wv + R1_MT);
    if (dh_staged != dir * 6 + hh) { dh_staged = dir * 6 + hh;
    __syncthreads();
    { const int ch = tid & 63, i0 = (tid >> 6) * 8; const float* w2 = A.in[I_W2] + ((size_t)(l * 2 + dir) * 64 + i0) * RW + hh * 64 + ch; const float* a2 = A.in[I_A2] + ((size_t)(l * 2 + dir) * 64 + i0) * RW + hh * 64 + ch;
      u32x4_t pw, pa; pw.x = cvtpk(w2[0], w2[RW]); pw.y = cvtpk(w2[2 * RW], w2[3 * RW]); pw.z = cvtpk(w2[4 * RW], w2[5 * RW]); pw.w = cvtpk(w2[6 * RW], w2[7 * RW]);
      pa.x = cvtpk(a2[0], a2[RW]); pa.y = cvtpk(a2[2 * RW], a2[3 * RW]); pa.z = cvtpk(a2[4 * RW], a2[5 * RW]); pa.w = cvtpk(a2[6 * RW], a2[7 * RW]);
      *(LAS u32x4_t*)(W2T + ch * 72 + i0) = pw; *(LAS u32x4_t*)(A2T + ch * 72 + i0) = pa; }
    __syncthreads(); }
    const int sgn = dir ? -1 : 1; const int tok0 = b * SEQ + (dir ? SEQ - 1 - 16 * cc : 16 * cc);
    const float* mu = A.in[I_MU] + (size_t)(l * 2 + dir) * 1280;
    float er[4][4], ek[4][4], ev[4][4], pr4[4], pk4[4], pv4[4];
    { const bool ext = (qd == 0) && (cc > 0); const size_t prow = (size_t)(ext ? tok0 - sgn : tok0 + sgn * (4 * qd)) * ZLD;
#pragma unroll
      for (int nt = 0; nt < 4; ++nt) {
#pragma unroll
          for (int r = 0; r < 4; ++r) { const bf16* zp = Z + (size_t)(tok0 + sgn * (4 * qd + r)) * ZLD + ZRKV + hh * 64 + 16 * nt + fr; er[nt][r] = bf2f(zp[0]); ek[nt][r] = bf2f(zp[RW]); ev[nt][r] = bf2f(zp[2 * RW]); }
          const bf16* zq = Z + prow + ZRKV + hh * 64 + 16 * nt + fr; pr4[nt] = bf2f(zq[0]); pk4[nt] = bf2f(zq[RW]); pv4[nt] = bf2f(zq[2 * RW]); }
      asm volatile("" : "+v"(er[0][0]), "+v"(pr4[3]));
#pragma unroll
      for (int nt = 0; nt < 4; ++nt) {
        float pr = __shfl(er[nt][3], lane - 16), pk = __shfl(ek[nt][3], lane - 16), pv = __shfl(ev[nt][3], lane - 16);
        if (qd == 0) { pr = ext ? pr4[nt] : 0.f; pk = ext ? pk4[nt] : 0.f; pv = ext ? pv4[nt] : 0.f; }
        const float mr = mu[hh * 64 + 16 * nt + fr], mk = mu[RW + hh * 64 + 16 * nt + fr], mv = mu[2 * RW + hh * 64 + 16 * nt + fr];
#pragma unroll
        for (int r = 3; r >= 0; --r) { const float qr = r ? er[nt][r - 1] : pr, qk = r ? ek[nt][r - 1] : pk, qv = r ? ev[nt][r - 1] : pv;
            er[nt][r] += mr * (qr - er[nt][r]); ek[nt][r] += mk * (qk - ek[nt][r]); ev[nt][r] += mv * (qv - ev[nt][r]); }
      } }
    bf16x8_t thA[2], adA[2];
    { const int zwd = dir ? ZWDB : ZWDF, zad = dir ? ZADB : ZADF; const bool hasp = !(cc == 0 && fr == 0);
      const bf16* zc = Z + (size_t)(tok0 + sgn * fr) * ZLD; const bf16* zq = Z + (size_t)(tok0 + sgn * (fr - 1)) * ZLD;
#pragma unroll
      for (int ks = 0; ks < 2; ++ks) { float cw[8], pw[8], ca[8], pa[8];
          unpack8(*(const uint4*)(zc + zwd + 32 * ks + 8 * qd), cw); unpack8(*(const uint4*)(zc + zad + 32 * ks + 8 * qd), ca);
          if (hasp) { unpack8(*(const uint4*)(zq + zwd + 32 * ks + 8 * qd), pw); unpack8(*(const uint4*)(zq + zad + 32 * ks + 8 * qd), pa); }
          else {
#pragma unroll
              for (int e = 0; e < 8; ++e) { pw[e] = 0.f; pa[e] = 0.f; } }
          const float* muw = mu + 1152 + 32 * ks + 8 * qd; const float* mua = mu + 1216 + 32 * ks + 8 * qd;
#pragma unroll
          for (int e = 0; e < 8; ++e) { const float xw = cw[e] + muw[e] * (pw[e] - cw[e]); cw[e] = 1.f - 2.f * __builtin_amdgcn_rcpf(1.f + __expf(2.f * xw)); ca[e] = ca[e] + mua[e] * (pa[e] - ca[e]); }
          union { unsigned u[4]; bf16x8_t v; } x, y;
#pragma unroll
          for (int e = 0; e < 4; ++e) { x.u[e] = cvtpk(cw[2 * e], cw[2 * e + 1]); y.u[e] = cvtpk(ca[2 * e], ca[2 * e + 1]); }
          thA[ks] = x.v; adA[ks] = y.v; } }
    f32x4 wl[4], al[4];
#pragma unroll
    for (int nt = 0; nt < 4; ++nt) { wl[nt] = (f32x4){0.f, 0.f, 0.f, 0.f}; al[nt] = (f32x4){0.f, 0.f, 0.f, 0.f};
#pragma unroll
        for (int ks = 0; ks < 2; ++ks) { const bf16x8_t bw = *(const LAS bf16x8_t*)(W2T + (16 * nt + fr) * 72 + 32 * ks + 8 * qd); const bf16x8_t ba = *(const LAS bf16x8_t*)(A2T + (16 * nt + fr) * 72 + 32 * ks + 8 * qd);
            wl[nt] = MFMA16(thA[ks], bw, wl[nt]); al[nt] = MFMA16(adA[ks], ba, al[nt]); } }
    float lw[4][4], alp[4][4], kap[4][4]; float ssq[4] = {0.f, 0.f, 0.f, 0.f}, bsm[4] = {0.f, 0.f, 0.f, 0.f};
#pragma unroll
    for (int nt = 0; nt < 4; ++nt) { const int ch = hh * 64 + 16 * nt + fr;
        const float w0v = A.in[I_W0][(size_t)(l * 2 + dir) * RW + ch], a0v = A.in[I_A0][(size_t)(l * 2 + dir) * RW + ch], kkw = A.in[I_KK][(size_t)l * RW + ch], kaw = A.in[I_KA][(size_t)l * RW + ch], rkw = A.in[I_RK][(size_t)l * RW + ch];
#pragma unroll
        for (int r = 0; r < 4; ++r) { const float x = w0v + wl[nt][r]; const float nx = -x; const float sp = fmaxf(nx, 0.f) + __logf(1.f + __expf(-fabsf(nx)));
            lw[nt][r] = -__expf(-sp - 0.5f);
            const float a = __builtin_amdgcn_rcpf(1.f + __expf(-(a0v + al[nt][r]))); alp[nt][r] = a;
            const float k0 = ek[nt][r]; kap[nt][r] = k0 * kkw; ek[nt][r] = k0 * (1.f + (a - 1.f) * kaw);
            ssq[r] += kap[nt][r] * kap[nt][r]; bsm[r] += er[nt][r] * ek[nt][r] * rkw; } }
#pragma unroll
    for (int r = 0; r < 4; ++r) {
#pragma unroll
        for (int o = 1; o < 16; o <<= 1) { ssq[r] += __shfl_xor(ssq[r], o); bsm[r] += __shfl_xor(bsm[r], o); }
        ssq[r] = __builtin_amdgcn_rsqf(fmaxf(ssq[r], 1e-24f)); }
    { bf16* bon = (bf16*)(A.ws + WS_RKB);
#pragma unroll
      for (int nt = 0; nt < 4; ++nt)
#pragma unroll
          for (int r = 0; r < 4; ++r) { kap[nt][r] *= ssq[r]; bon[((size_t)dir * NT + tok0 + sgn * (4 * qd + r)) * RW + hh * 64 + 16 * nt + fr] = (bf16)f2bf(bsm[r] * ev[nt][r]); } }
    unsigned char* pkg = A.ws + WS_PKG + ((size_t)((dir * NB + b) * 6 + hh) * 128 + cc) * PKG_BYTES;
    float lend[4];
    u32x2_t btf[4], ktf[4];
#pragma unroll
    for (int nt = 0; nt < 4; ++nt) { float lam[4]; lam[0] = lw[nt][0]; lam[1] = lam[0] + lw[nt][1]; lam[2] = lam[1] + lw[nt][2]; lam[3] = lam[2] + lw[nt][3];
        const float t1 = __shfl(lam[3], lane - 16), t2 = __shfl(lam[3], lane - 32), t3 = __shfl(lam[3], lane - 48);
        const float off = (qd >= 1 ? t1 : 0.f) + (qd >= 2 ? t2 : 0.f) + (qd >= 3 ? t3 : 0.f);
#pragma unroll
        for (int r = 0; r < 4; ++r) lam[r] += off;
        lend[nt] = __shfl(lam[3], 48 + fr);
        float bt4[4], kt4[4];
        float epv[4];
#pragma unroll
        for (int r = 0; r < 4; ++r) epv[r] = __expf(lam[r]);
        float ep_prev = __shfl(epv[3], lane - 16); if (qd == 0) ep_prev = 1.f;
        const float eendall = __expf(lend[nt]);
#pragma unroll
        for (int r = 0; r < 4; ++r) { const float ep = epv[r], epm = r ? epv[r - 1] : ep_prev, einv = __builtin_amdgcn_rcpf(ep), eend = eendall * einv;
            const float bb = kap[nt][r] * alp[nt][r]; const int o = (4 * qd + r) * 72 + 16 * nt + fr;
            IMG[o] = (bf16)f2bf(-kap[nt][r] * epm); IMG[1152 + o] = (bf16)f2bf(er[nt][r] * ep); IMG[2304 + o] = (bf16)f2bf(bb * einv); IMG[3456 + o] = (bf16)f2bf(ek[nt][r] * einv);
            bt4[r] = bb * eend; kt4[r] = ek[nt][r] * eend; }
        btf[nt].x = cvtpk(bt4[0], bt4[1]); btf[nt].y = cvtpk(bt4[2], bt4[3]); ktf[nt].x = cvtpk(kt4[0], kt4[1]); ktf[nt].y = cvtpk(kt4[2], kt4[3]); }
    asm volatile("s_waitcnt lgkmcnt(0)" ::: "memory");
    f32x4 Lab = (f32x4){0.f, 0.f, 0.f, 0.f}, Lak = Lab, Mrb = Lab, Mrk = Lab;
#pragma unroll
    for (int ks = 0; ks < 2; ++ks) { const int o = fr * 72 + 32 * ks + 8 * qd;
        const bf16x8_t aA = *(const LAS bf16x8_t*)(IMG + o), aR = *(const LAS bf16x8_t*)(IMG + 1152 + o), bB = *(const LAS bf16x8_t*)(IMG + 2304 + o), bK = *(const LAS bf16x8_t*)(IMG + 3456 + o);
        Lab = MFMA16(aA, bB, Lab); Lak = MFMA16(aA, bK, Lak); Mrb = MFMA16(aR, bB, Mrb); Mrk = MFMA16(aR, bK, Mrk); }
#pragma unroll
    for (int r = 0; r < 4; ++r) { const int t = 4 * qd + r; if (!(fr < t)) { Lab[r] = 0.f; Lak[r] = 0.f; } if (!(fr <= t)) { Mrb[r] = 0.f; Mrk[r] = 0.f; } Lf[t * 17 + fr] = Lab[r]; }
    asm volatile("s_waitcnt lgkmcnt(0)" ::: "memory");
    float Tc[16];
#pragma unroll
    for (int t = 0; t < 16; ++t) { float acc = (t == fr) ? 1.f : 0.f;
#pragma unroll
        for (int s = 0; s < t; ++s) acc += Lf[t * 17 + s] * Tc[s];
        Tc[t] = acc; }
    f32x4 Tm;
#pragma unroll
    for (int r = 0; r < 4; ++r) Tm[r] = qd == 0 ? Tc[r] : (qd == 1 ? Tc[4 + r] : (qd == 2 ? Tc[8 + r] : Tc[12 + r]));
#pragma unroll
    for (int r = 0; r < 4; ++r) { const int o = (4 * qd + r) * 20 + fr; MT[o] = (bf16)f2bf(Tm[r]); MT[320 + o] = (bf16)f2bf(Mrb[r]); MT[640 + o] = (bf16)f2bf(Lak[r]); MT[960 + o] = (bf16)f2bf(Mrk[r]); }
    asm volatile("s_waitcnt lgkmcnt(0)" ::: "memory");
    { const int o = fr * 20 + 4 * qd;
      const u32x2_t mrb = *(const LAS u32x2_t*)(MT + 320 + o), mrk = *(const LAS u32x2_t*)(MT + 960 + o);
      *(u32x2_t*)(pkg + PK_TM + lane * 8) = *(const LAS u32x2_t*)(MT + o); *(u32x2_t*)(pkg + PK_LAK + lane * 8) = *(const LAS u32x2_t*)(MT + 640 + o);
      *(u32x4_t*)(pkg + PK_MM + lane * 16) = (u32x4_t){mrk.x, mrk.y, mrb.x, mrb.y}; }
#pragma unroll
    for (int ks = 0; ks < 2; ++ks) { const int o = fr * 72 + 32 * ks + 4 * qd;
        const u32x2_t alo = *(const LAS u32x2_t*)(IMG + o), ahi = *(const LAS u32x2_t*)(IMG + o + 16), rlo = *(const LAS u32x2_t*)(IMG + 1152 + o), rhi = *(const LAS u32x2_t*)(IMG + 1152 + o + 16);
        *(u32x4_t*)(pkg + PK_AH + ks * 1024 + lane * 16) = (u32x4_t){alo.x, alo.y, ahi.x, ahi.y}; *(u32x4_t*)(pkg + PK_RH + ks * 1024 + lane * 16) = (u32x4_t){rlo.x, rlo.y, rhi.x, rhi.y}; }
#pragma unroll
    for (int nt = 0; nt < 4; ++nt) { *(u32x4_t*)(pkg + PK_KB + nt * 1024 + lane * 16) = (u32x4_t){ktf[nt].x, ktf[nt].y, btf[nt].x, btf[nt].y};
        u32x2_t vf; vf.x = cvtpk(ev[nt][0], ev[nt][1]); vf.y = cvtpk(ev[nt][2], ev[nt][3]); *(u32x2_t*)(pkg + PK_VV + nt * 512 + lane * 8) = vf;
        if (qd == 0) ((float*)(pkg + PK_GE))[16 * nt + fr] = __expf(lend[nt]); }
    asm volatile("s_waitcnt lgkmcnt(0)" ::: "memory");
}
DI void phase_rwkv_r1(const Args& A, int l, LAS unsigned char* lds, int bid, int G, int tid, int wave, int lane) {
    constexpr int NIT = 2 * NB * 6 * 16; int dh_staged = -1;
    __syncthreads();
    for (int it = bid; it < NIT; it += G) rwkv_r1_item(A, l, lds, it, dh_staged, tid, wave, lane);
    __syncthreads();
}

struct RkOps { bf16x8_t ah[2], rh[2], kb[4], mm; bf16x4_t vv, tm, lak; f32x4 ge[4]; };
DI bf16x8_t widen4(const bf16x4_t a) { return __builtin_shufflevector(a, (bf16x4_t){0, 0, 0, 0}, 0, 1, 2, 3, 4, 5, 6, 7); }
DI void rk_step(const RkOps& c, f32x4 (&sT)[4], bf16* yb, int dir, int b, int hh, int vb, int cc, int fr, int qd) {
    const f32x4 zero4 = (f32x4){0.f, 0.f, 0.f, 0.f};
    union { unsigned u[4]; bf16x8_t v; } s0, s1;
    s0.u[0] = cvtpk(sT[0][0], sT[0][1]); s0.u[1] = cvtpk(sT[0][2], sT[0][3]); s0.u[2] = cvtpk(sT[1][0], sT[1][1]); s0.u[3] = cvtpk(sT[1][2], sT[1][3]);
    s1.u[0] = cvtpk(sT[2][0], sT[2][1]); s1.u[1] = cvtpk(sT[2][2], sT[2][3]); s1.u[2] = cvtpk(sT[3][0], sT[3][1]); s1.u[3] = cvtpk(sT[3][2], sT[3][3]);
    f32x4 ax = MFMA16(widen4(c.lak), widen4(c.vv), zero4); ax = MFMA16(c.ah[0], s0.v, ax); ax = MFMA16(c.ah[1], s1.v, ax);
    f32x4 ay = MFMA16(c.rh[0], s0.v, zero4); ay = MFMA16(c.rh[1], s1.v, ay);
    const f32x4 au = MFMA16(widen4(c.tm), widen4(pack4(ax)), zero4);
    const bf16x8_t vu = __builtin_shufflevector(c.vv, pack4(au), 0, 1, 2, 3, 4, 5, 6, 7);
    ay = MFMA16(c.mm, vu, ay);
#pragma unroll
    for (int kt = 0; kt < 4; ++kt) sT[kt] = MFMA16(c.kb[kt], vu, sT[kt] * c.ge[kt]);
    const int sgn = dir ? -1 : 1; const int tok0 = b * SEQ + (dir ? SEQ - 1 - 16 * cc : 16 * cc);
#pragma unroll
    for (int r = 0; r < 4; ++r) yb[((size_t)dir * NT + tok0 + sgn * (4 * qd + r)) * RW + hh * 64 + 16 * vb + fr] = (bf16)f2bf(ay[r]);
}
constexpr int R2_SLOTS = 8, R2_CTL = R2_SLOTS * PKG_BYTES;
static_assert(R2_CTL + 64 <= MISC_OFF, "rwkv r2 LDS");
DI void rk_load_lds(RkOps& o, const LAS unsigned char* pkg, int vb, int lane, int qd) {
#pragma unroll
    for (int ks = 0; ks < 2; ++ks) { o.ah[ks] = *(const LAS bf16x8_t*)(pkg + PK_AH + ks * 1024 + lane * 16); o.rh[ks] = *(const LAS bf16x8_t*)(pkg + PK_RH + ks * 1024 + lane * 16); }
#pragma unroll
    for (int kt = 0; kt < 4; ++kt) { o.kb[kt] = *(const LAS bf16x8_t*)(pkg + PK_KB + kt * 1024 + lane * 16); o.ge[kt] = *(const LAS f32x4*)(pkg + PK_GE + (16 * kt + 4 * qd) * 4); }
    o.mm = *(const LAS bf16x8_t*)(pkg + PK_MM + lane * 16);
    o.vv = *(const LAS bf16x4_t*)(pkg + PK_VV + vb * 512 + lane * 8); o.tm = *(const LAS bf16x4_t*)(pkg + PK_TM + lane * 8); o.lak = *(const LAS bf16x4_t*)(pkg + PK_LAK + lane * 8);
}
DI void rk_pkg_fetch(u32x4_t (&buf)[13], const unsigned char* pkg, int lane) {
#pragma unroll
    for (int i = 0; i < 12; ++i) buf[i] = *(const u32x4_t*)(pkg + i * 1024 + lane * 16);
    buf[12] = (lane < 16) ? *(const u32x4_t*)(pkg + 12288 + lane * 16) : (u32x4_t){0u, 0u, 0u, 0u};
}
DI void rwkv_r2_unit(const Args& A, LAS unsigned char* lds, int u, int tid, int wave, int lane) {
    bf16* yb = (bf16*)(A.ws + WS_RKY);
    const int dir = u / 48, rem = u % 48, b = rem / 6, hh = rem % 6; const int fr = lane & 15, qd = lane >> 4;
    const unsigned char* pkg0 = A.ws + WS_PKG + ((size_t)((dir * NB + b) * 6 + hh) * 128) * PKG_BYTES;
    volatile LAS unsigned* ready = (volatile LAS unsigned*)(lds + R2_CTL); volatile LAS unsigned* consumed = ready + 8;
    __syncthreads();
    if (tid < 16) ready[tid] = 0u;
    __syncthreads();
    if (wave >= 4) {
        const int j = wave - 4; u32x4_t cur[13], nxt[13];
        rk_pkg_fetch(cur, pkg0 + (size_t)j * PKG_BYTES, lane);
        for (int cc = j; cc < 128; cc += 4) {
            if (cc + 4 < 128) rk_pkg_fetch(nxt, pkg0 + (size_t)(cc + 4) * PKG_BYTES, lane);
            if (cc >= R2_SLOTS) { const unsigned need = (unsigned)(cc - R2_SLOTS + 1); unsigned spins = 0;
                for (;;) { const unsigned c0 = consumed[0], c1 = consumed[1], c2 = consumed[2], c3 = consumed[3];
                    if (c0 >= need && c1 >= need && c2 >= need && c3 >= need) break; if (++spins > (1u << 22)) break; __builtin_amdgcn_s_sleep(1); } }
            LAS unsigned char* slot = lds + (cc & (R2_SLOTS - 1)) * PKG_BYTES;
#pragma unroll
            for (int i = 0; i < 12; ++i) *(LAS u32x4_t*)(slot + i * 1024 + lane * 16) = cur[i];
            if (lane < 16) *(LAS u32x4_t*)(slot + 12288 + lane * 16) = cur[12];
            asm volatile("s_waitcnt lgkmcnt(0)" ::: "memory");
            if (lane == 0) ready[cc & (R2_SLOTS - 1)] = (unsigned)(cc + 1);
            asm volatile("" ::: "memory");
#pragma unroll
            for (int i = 0; i < 13; ++i) cur[i] = nxt[i];
        }
    } else {
        const int vb = wave; f32x4 sT[4];
#pragma unroll
        for (int kt = 0; kt < 4; ++kt) sT[kt] = (f32x4){0.f, 0.f, 0.f, 0.f};
#define RK_WAIT(cc_) do { unsigned spins = 0; while (ready[(cc_) & (R2_SLOTS - 1)] != (unsigned)((cc_) + 1)) { if (++spins > (1u << 22)) break; __builtin_amdgcn_s_sleep(1); } asm volatile("" ::: "memory"); } while (0)
        RkOps pa, pb;
        RK_WAIT(0); rk_load_lds(pa, lds, vb, lane, qd);
        for (int cc = 0; cc < 128; cc += 2) {
            RK_WAIT(cc + 1); rk_load_lds(pb, lds + ((cc + 1) & (R2_SLOTS - 1)) * PKG_BYTES, vb, lane, qd);
            rk_step(pa, sT, yb, dir, b, hh, vb, cc, fr, qd);
            asm volatile("s_waitcnt lgkmcnt(0)" ::: "memory"); if (lane == 0) consumed[vb] = (unsigned)(cc + 2); asm volatile("" ::: "memory");
            if (cc + 2 < 128) { RK_WAIT(cc + 2); rk_load_lds(pa, lds + ((cc + 2) & (R2_SLOTS - 1)) * PKG_BYTES, vb, lane, qd); }
            rk_step(pb, sT, yb, dir, b, hh, vb, cc + 1, fr, qd);
            if (cc + 2 < 128) { asm volatile("s_waitcnt lgkmcnt(0)" ::: "memory"); if (lane == 0) consumed[vb] = (unsigned)(cc + 3); asm volatile("" ::: "memory"); }
        }
#undef RK_WAIT
    }
    __syncthreads();
}


constexpr int YA_G2LD = 136;
static_assert(384 * YA_G2LD * 2 <= MISC_OFF, "yasm LDS");
DI void yasm_token(const bf16* Z, const bf16* ao, const float* al, const bf16* num, const float* den, const float* mlg, bf16* y, int tok, int lane) {
    const bf16* zr = Z + (size_t)tok * ZLD; bf16* yr = y + (size_t)tok * DM;
    const float lsev = al[((size_t)((lane >> 2) % 3) * NT + tok) * 4 + (lane & 3)];
    const float denv = den[((size_t)((lane >> 2) & 1) * NT + tok) * 4 + (lane & 3)];
    float aov[3][4], nmv[2][4], nm2[2][4], zo[4], zo2[4];
#pragma unroll
    for (int hh = 0; hh < 4; ++hh) { const int col = hh * 64 + lane, c0 = hh * 96 + lane, c1 = hh * 96 + 64 + (lane & 31);
#pragma unroll
        for (int br = 0; br < 3; ++br) aov[br][hh] = bf2f(ao[((size_t)br * NT + tok) * AW + col]);
#pragma unroll
        for (int d = 0; d < 2; ++d) { nmv[d][hh] = bf2f(num[((size_t)d * NT + tok) * MW + c0]); nm2[d][hh] = bf2f(num[((size_t)d * NT + tok) * MW + c1]); }
        zo[hh] = bf2f(zr[ZMO + c0]); zo2[hh] = bf2f(zr[ZMO + c1]); }
#pragma unroll
    for (int hh = 0; hh < 4; ++hh) { const int col = hh * 64 + lane;
        const float l0 = __shfl(lsev, hh), l1 = __shfl(lsev, 4 + hh), l2 = __shfl(lsev, 8 + hh);
        const float mx = fmaxf(l0, fmaxf(l1, l2)); const float w0 = __expf(l0 - mx), w1 = __expf(l1 - mx), w2 = __expf(l2 - mx);
        yr[col] = (bf16)f2bf((w0 * aov[0][hh] + w1 * aov[1][hh] + w2 * aov[2][hh]) / (w0 + w1 + w2)); }
#pragma unroll
    for (int hh = 0; hh < 4; ++hh) { const int c0 = hh * 96 + lane, c1 = hh * 96 + 64 + (lane & 31); const bool hi = lane < 32;
        const float df = __shfl(denv, hh), db = __shfl(denv, 4 + hh);
        const float invf = 1.f / fmaxf(fabsf(df), 1.f), invb = 1.f / fmaxf(fabsf(db), 1.f);
        const float a = nmv[0][hh] * invf + nmv[1][hh] * invb; const float bb = hi ? (nm2[0][hh] * invf + nm2[1][hh] * invb) : 0.f;
        const float mean = (wave_sum(a) + wave_sum(bb)) * (1.f / 96.f); const float da = a - mean, dbb = hi ? bb - mean : 0.f;
        const float var = (wave_sum(da * da) + wave_sum(dbb * dbb)) * (1.f / 96.f); const float rs = rsqrtf(var + 1e-6f);
        yr[AW + RW + c0] = (bf16)f2bf(da * rs * mlg[c0] * sigm(zo[hh]));
        if (hi) yr[AW + RW + c1] = (bf16)f2bf(dbb * rs * mlg[c1] * sigm(zo2[hh])); }
}
DI void phase_yasm(const Args& A, int l, LAS unsigned char* lds, int gw, int ngw, int tid, int lane) {
    const bf16* Z = (const bf16*)(A.ws + WS_Z); const bf16* ao = (const bf16*)(A.ws + WS_ATTO); const float* al = (const float*)(A.ws + WS_ATTL);
    const bf16* rky = (const bf16*)(A.ws + WS_RKY); const bf16* rkb = (const bf16*)(A.ws + WS_RKB);
    const bf16* num = (const bf16*)(A.ws + WS_MLNUM); const float* den = (const float*)(A.ws + WS_MLDEN); bf16* y = (bf16*)(A.ws + WS_HB);
    const float* lng = A.in[I_RLNG] + (size_t)l * RW; const float* lnb = A.in[I_RLNB] + (size_t)l * RW; const float* mlg = A.in[I_MLNG] + (size_t)l * MW;
    LAS bf16* G2T = (LAS bf16*)lds;
    __syncthreads();
    { const u32x4_t* src = (const u32x4_t*)(A.ws + WS_G2T + (size_t)l * RW * 128 * 2);
      for (int idx = tid; idx < RW * 16; idx += NTHR) { const int col = idx >> 4, ch = idx & 15; *(LAS u32x4_t*)(G2T + col * YA_G2LD + ch * 8) = src[idx]; } }
    __syncthreads();
    const int fr = lane & 15, qd = lane >> 4;
    for (int item = gw; item < (NT / 16) * 6; item += ngw) {
        const int hh = item % 6, tg = item / 6; const int tokA = tg * 16 + fr;
        f32x4 gacc[4];
#pragma unroll
        for (int nt = 0; nt < 4; ++nt) gacc[nt] = (f32x4){0.f, 0.f, 0.f, 0.f};
#pragma unroll
        for (int ks = 0; ks < 4; ++ks) { float f[8]; unpack8(*(const uint4*)(Z + (size_t)tokA * ZLD + ZGD + 32 * ks + 8 * qd), f);
            union { unsigned u[4]; bf16x8_t v; } a;
#pragma unroll
            for (int e = 0; e < 4; ++e) a.u[e] = cvtpk(sigm(f[2 * e]), sigm(f[2 * e + 1]));
#pragma unroll
            for (int nt = 0; nt < 4; ++nt) { const bf16x8_t bg = *(const LAS bf16x8_t*)(G2T + (hh * 64 + 16 * nt + fr) * YA_G2LD + 32 * ks + 8 * qd); gacc[nt] = MFMA16(a.v, bg, gacc[nt]); } }
        float sv[4][4], bv[4][4]; float sm[4] = {0.f, 0.f, 0.f, 0.f};
#pragma unroll
        for (int nt = 0; nt < 4; ++nt)
#pragma unroll
            for (int r = 0; r < 4; ++r) { const size_t o = (size_t)(tg * 16 + 4 * qd + r) * RW + hh * 64 + 16 * nt + fr;
                sv[nt][r] = bf2f(rky[o]) + bf2f(rky[(size_t)NT * RW + o]); bv[nt][r] = bf2f(rkb[o]) + bf2f(rkb[(size_t)NT * RW + o]); sm[r] += sv[nt][r]; }
        float vr[4] = {0.f, 0.f, 0.f, 0.f};
#pragma unroll
        for (int r = 0; r < 4; ++r) {
#pragma unroll
            for (int o = 1; o < 16; o <<= 1) sm[r] += __shfl_xor(sm[r], o);
            sm[r] *= (1.f / 64.f);
#pragma unroll
            for (int nt = 0; nt < 4; ++nt) { sv[nt][r] -= sm[r]; vr[r] += sv[nt][r] * sv[nt][r]; }
#pragma unroll
            for (int o = 1; o < 16; o <<= 1) vr[r] += __shfl_xor(vr[r], o);
            vr[r] = rsqrtf(vr[r] * (1.f / 64.f) + 64e-5f); }
#pragma unroll
        for (int nt = 0; nt < 4; ++nt) { const int col = hh * 64 + 16 * nt + fr; const float lg_ = lng[col], lb_ = lnb[col];
#pragma unroll
            for (int r = 0; r < 4; ++r) y[(size_t)(tg * 16 + 4 * qd + r) * DM + AW + col] = (bf16)f2bf((sv[nt][r] * vr[r] * lg_ + lb_ + bv[nt][r]) * gacc[nt][r]); }
    }
    for (int tok = gw; tok < NT; tok += 2 * ngw) { yasm_token(Z, ao, al, num, den, mlg, y, tok, lane); if (tok + ngw < NT) yasm_token(Z, ao, al, num, den, mlg, y, tok + ngw, lane); }
    __syncthreads();
}

constexpr int L2_WLD = 1032;
constexpr int L2_WHI = 0, L2_WLO = 16 * L2_WLD * 2, L2_G2 = 2 * L2_WLO, L2_EX = L2_G2 + DM * 4, L2_SS = L2_EX + 8 * 1024, L2_END = L2_SS + 8 * 16 * 4;
static_assert(L2_END <= MISC_OFF, "ln2 LDS");
DI void phase_ln2(const Args& A, int l, LAS unsigned char* lds, int bid, int G, int tid, int wave, int lane) {
    const bf16* x1 = (const bf16*)(A.ws + WS_X1); unsigned char* hb = A.ws + WS_HB; float* aff = (float*)(A.ws + WS_AFF);
    const float* router = A.in[I_ROUTER] + (size_t)l * DM * NE; const float* g2 = A.in[I_LN2G] + (size_t)l * DM;
    LAS bf16* Whi = (LAS bf16*)(lds + L2_WHI); LAS bf16* Wlo = (LAS bf16*)(lds + L2_WLO); LAS float* g2s = (LAS float*)(lds + L2_G2);
    LAS unsigned char* ex = lds + L2_EX; LAS float* ssx = (LAS float*)(lds + L2_SS);
    const int fr = lane & 15, qd = lane >> 4, tg = wave >> 1, kh = wave & 1;
    __syncthreads();
    for (int i = tid; i < DM * NE; i += NTHR) { const int e = i & 15, c = i >> 4; const float v = router[i] * g2[c]; const unsigned h = f2bf(v);
        Whi[e * L2_WLD + c] = (bf16)h; Wlo[e * L2_WLD + c] = (bf16)f2bf(v - bf2f(h)); }
    for (int i = tid; i < DM; i += NTHR) g2s[i] = g2[i];
    for (int grp = bid; grp < NT / 64; grp += G) {
        const int tokb = grp * 64 + tg * 16, tok = tokb + fr;
        const u32x4_t* xp = (const u32x4_t*)(x1 + (size_t)tok * DM + kh * 512 + 16 * qd);
        u32x4_t xa[8][2];
#pragma unroll
        for (int p = 0; p < 8; ++p) { xa[p][0] = xp[8 * p]; xa[p][1] = xp[8 * p + 1]; }
        __syncthreads();
        f32x4 acc = (f32x4){0.f, 0.f, 0.f, 0.f}; float ss = 0.f;
#pragma unroll
        for (int p = 0; p < 8; ++p)
#pragma unroll
            for (int hf = 0; hf < 2; ++hf) { const int c = kh * 512 + 64 * p + 16 * qd + 8 * hf;
                const bf16x8_t a = __builtin_bit_cast(bf16x8_t, xa[p][hf]);
                const bf16x8_t bh = *(const LAS bf16x8_t*)(Whi + fr * L2_WLD + c), bl = *(const LAS bf16x8_t*)(Wlo + fr * L2_WLD + c);
                acc = MFMA16(a, bh, acc); acc = MFMA16(a, bl, acc);
#pragma unroll
                for (int e = 0; e < 4; ++e) { const float lo = __uint_as_float(xa[p][hf][e] << 16), hi = __uint_as_float(xa[p][hf][e] & 0xffff0000u); ss += lo * lo + hi * hi; } }
        ss += __shfl_xor(ss, 16); ss += __shfl_xor(ss, 32);
        *(LAS f32x4*)(ex + wave * 1024 + lane * 16) = acc; if (qd == 0) ssx[wave * 16 + fr] = ss;
        __syncthreads();
        { const f32x4 oth = *(const LAS f32x4*)(ex + (wave ^ 1) * 1024 + lane * 16); acc += oth; ss += ssx[(wave ^ 1) * 16 + fr]; }
        const float rs = rsqrtf(ss * (1.f / DM) + RMS_EPS);
        unsigned char* hrow = hb + (size_t)tok * DM + kh * 512 + 16 * qd; const float rsc = rs * F8_HSC;
#pragma unroll
        for (int p = 0; p < 8; ++p) { const LAS f32x4* gp = (const LAS f32x4*)(g2s + kh * 512 + 64 * p + 16 * qd); u32x4_t o;
#pragma unroll
            for (int q = 0; q < 4; ++q) { const f32x4 g = gp[q]; const unsigned u0 = xa[p][q >> 1][2 * (q & 1)], u1 = xa[p][q >> 1][2 * (q & 1) + 1];
                o[q] = pk4_fp8(__uint_as_float(u0 << 16) * rsc * g[0], __uint_as_float(u0 & 0xffff0000u) * rsc * g[1], __uint_as_float(u1 << 16) * rsc * g[2], __uint_as_float(u1 & 0xffff0000u) * rsc * g[3]); }
            *(u32x4_t*)(hrow + 64 * p) = o; }
        if (kh == 0) { f32x4 af;
#pragma unroll
            for (int r = 0; r < 4; ++r) { const float lg = acc[r] * __shfl(rs, 4 * qd + r); float mx = lg;
#pragma unroll
                for (int o = 1; o < 16; o <<= 1) mx = fmaxf(mx, __shfl_xor(mx, o));
                const float ev = expf(lg - mx); float sm = ev;
#pragma unroll
                for (int o = 1; o < 16; o <<= 1) sm += __shfl_xor(sm, o);
                af[r] = ev / sm; }
            *(f32x4*)(aff + ((size_t)(tokb / SEQ) * NE + fr) * SEQ + (tokb % SEQ) + 4 * qd) = af; }
    }
    __syncthreads();
}

constexpr int PH_PER_LAYER = 10, NPH = 1 + NL * PH_PER_LAYER + 1;
#ifndef MK_ONE_LAUNCH
#define MK_ONE_LAUNCH 1
#endif

#ifndef MK_DUP
#define MK_DUP 0
#endif
constexpr int P0_END = NL * 16 * 64 + NL * 16 * 16 + NL * NE * 3 * 8 * 44, P0_SPLIT = P0_END - 0;
template <int l> DI void run_layer(const Args& A, LAS unsigned char* lds, const XcdBarrier& bar, int lo, int hi, int G, int bid, int tid, int lane, int wave, int gw, int ngw, int gtid, int nthr) {
#define IN(k) (lo <= (k) && (k) < hi)
#define SEAM(k) do { if (IN(k) && IN((k) + 1)) xcd_barrier(bar); } while (0)
#define PH(k, ...) do { if (IN(pb + (k))) { { __VA_ARGS__ } if ((MK_DUP >> (k)) & 1) { xcd_barrier(bar); { __VA_ARGS__ } } } SEAM(pb + (k)); } while (0)
    const int pb = 1 + l * PH_PER_LAYER;
    PH(0, phase_ln1(A, l, gw, ngw, lane););
    PH(1,
        pg8::Gemm g{(const bf16*)(A.ws + WS_HB), (const bf16*)(A.ws + WS_WTIN) + (size_t)l * ZLD * DM, NT, ZLD, DM};
        pg8::StaticOrder S; S.init(NT, ZLD, G, bid);
        pg8::EpiBf16<0> E{(bf16*)(A.ws + WS_Z), ZLD, nullptr, 0, 0, 1.f};
        pg8::gemm_phase<pg8::EpiBf16<0>, pg8::StaticOrder, true, true>(lds, g, S, E););
    PH(2, phase_attn(A, lds, bid, G, tid, wave, lane); phase_rwkv_r1(A, l, lds, bid, G, tid, wave, lane); if ((MK_DUP >> 13) & 1) phase_rwkv_r1(A, l, lds, bid, G, tid, wave, lane);
          phase_mlstm_m1(A, l, lds, bid, G, tid, wave, lane); if ((MK_DUP >> 16) & 1) phase_mlstm_m1(A, l, lds, bid, G, tid, wave, lane););
    PH(3, if (l == 0 && P0_SPLIT < P0_END) { const int nb = G > 160 ? G - 160 : G, b0 = G > 160 ? bid - 160 : bid; if (b0 >= 0) { __syncthreads(); phase_p0(A, lds, P0_SPLIT, P0_END, b0 * NWAVES + wave, nb * NWAVES, wave, lane); __syncthreads(); } }
          for (int rep = 0; rep < 1 + ((MK_DUP >> 14) & 1); ++rep) for (int u = bid; u < 96; u += G) rwkv_r2_unit(A, lds, u, tid, wave, lane);
          for (int rep = 0; rep < 1 + ((MK_DUP >> 15) & 1); ++rep) for (int u = bid; u < 96 + 64; u += G) { if (u >= 96) mlstm_m2_unit(A, lds, u - 96, tid, wave, lane); });
    PH(4, phase_yasm(A, l, lds, gw, ngw, tid, lane););
    PH(5,
        pg8::Gemm g{(const bf16*)(A.ws + WS_HB), (const bf16*)(A.ws + WS_WTOUT) + (size_t)l * DM * DM, NT, DM, DM};
        pg8::StaticOrder S; S.init(NT, DM, G, bid);
        EpiResT<(l > 0)> E{(l == 0) ? (const void*)A.in[I_X] : (const void*)(A.ws + WS_X2), (bf16*)(A.ws + WS_X1), DM};
        pg8::gemm_phase<EpiResT<(l > 0)>, pg8::StaticOrder, true, true>(lds, g, S, E););
    PH(6, phase_ln2(A, l, lds, bid, G, tid, wave, lane););
    PH(7, phase_topk(A, lds, bid, G, tid, wave, lane););
    PH(8,
        pg8::Gemm g{(const bf16*)(A.ws + WS_XG), (const bf16*)(A.ws + WS_W13T + (size_t)l * NE * 5632 * DM), NSLOT, NE * 5632, DM / 2};
        GroupOrder S; S.init(22, G, bid);
        EpiSwiGLU E{A.ws + WS_ACT, 22};
        pg8::gemm_phase<EpiSwiGLU, GroupOrder, true, true, true>(lds, g, S, E););
    PH(9,
        pg8::Gemm g{(const bf16*)(A.ws + WS_ACT), (const bf16*)(A.ws + WS_W2T + (size_t)l * NE * DM * FF), NSLOT, NE * DM, FF / 2};
        GroupOrder S; S.init(4, G, bid);
        EpiGate E{(bf16*)(A.ws + WS_YS), (const float*)(A.ws + WS_GATE)};
        pg8::gemm_phase<EpiGate, GroupOrder, true, true, true>(lds, g, S, E););
#undef PH
#undef IN
#undef SEAM
}

__global__ void __launch_bounds__(NTHR, 2) mk_fwd(Args A) {
    extern __shared__ __attribute__((aligned(16))) unsigned char lds_raw[];
    LAS unsigned char* lds = (LAS unsigned char*)lds_raw;
    const int tid = threadIdx.x, lane = tid & 63, wave = __builtin_amdgcn_readfirstlane(tid >> 6);
    const int G = gridDim.x, bid = blockIdx.x;
    const int gw = bid * NWAVES + wave, ngw = G * NWAVES, gtid = bid * NTHR + tid, nthr = G * NTHR;
    volatile LAS unsigned* MISC = (volatile LAS unsigned*)(lds + MISC_OFF);
    if (tid < 64) MISC[tid] = 0u;
    __syncthreads();
    const int lo = A.ph_lo, hi = A.ph_hi;
    const bool use_bar = (hi - lo) > 1;
    XcdBarrier bar; bar.bar = (unsigned*)(A.ws + WS_CTL) + CW_BAR; bar.x = 0; bar.st = MISC + 8;
    if (use_bar) bar = xcd_barrier_post((unsigned*)(A.ws + WS_CTL) + CW_BAR, MISC + 8);
#define IN(k) (lo <= (k) && (k) < hi)
#define SEAM(k) do { if (IN(k) && IN((k) + 1)) xcd_barrier(bar); } while (0)

    if (IN(0)) { phase_p0(A, lds, 0, P0_SPLIT, gw, ngw, wave, lane); if ((MK_DUP >> 10) & 1) { xcd_barrier(bar); phase_p0(A, lds, 0, P0_SPLIT, gw, ngw, wave, lane); } } SEAM(0);

    run_layer<0>(A, lds, bar, lo, hi, G, bid, tid, lane, wave, gw, ngw, gtid, nthr);
    run_layer<1>(A, lds, bar, lo, hi, G, bid, tid, lane, wave, gw, ngw, gtid, nthr);
    if (IN(NPH - 1)) { phase_final(A, gw, ngw, lane); if ((MK_DUP >> 11) & 1) { xcd_barrier(bar); phase_final(A, gw, ngw, lane); } }
#undef IN
#undef SEAM
}
}

extern "C" void kernel_launch(void* const* d_in, const int* in_sizes, int n_in, void* d_out, int out_size, void* d_ws, size_t ws_size, hipStream_t stream) {
    using namespace mk;
    static int grid = 0;
    if (grid == 0) {
        if (n_in != N_IN || out_size != NT * DM || ws_size < WS_END) { fprintf(stderr, "kernel_launch: unexpected shapes (n_in %d, out %d, ws %zu < %zu)\n", n_in, out_size, ws_size, (size_t)WS_END); grid = -1; return; }
        int dev = 0, cus = 0, per_cu = 0;
        if (hipGetDevice(&dev) != hipSuccess || hipDeviceGetAttribute(&cus, hipDeviceAttributeMultiprocessorCount, dev) != hipSuccess) { grid = -1; return; }
        if (hipFuncSetAttribute((const void*)mk_fwd, hipFuncAttributeMaxDynamicSharedMemorySize, LDS_BYTES) != hipSuccess) { fprintf(stderr, "kernel_launch: hipFuncSetAttribute failed\n"); grid = -1; return; }
        if (hipOccupancyMaxActiveBlocksPerMultiprocessor(&per_cu, (const void*)mk_fwd, NTHR, LDS_BYTES) != hipSuccess || per_cu < 1) fprintf(stderr, "kernel_launch: occupancy query reports %d\n", per_cu);
        (void)hipGetLastError();
        grid = cus;
    }
    if (grid < 0) return;
    hipMemsetAsync((char*)d_ws + WS_CTL, 0, CTL_ZERO_BYTES, stream);
    Args a{};
    for (int i = 0; i < N_IN; ++i) a.in[i] = (const float*)d_in[i];
    a.out = (float*)d_out; a.ws = (unsigned char*)d_ws;
#if MK_ONE_LAUNCH
    a.ph_lo = 0; a.ph_hi = NPH;
    hipLaunchKernelGGL(mk_fwd, dim3(grid), dim3(NTHR), LDS_BYTES, stream, a);
#else
    for (int p = 0; p < NPH; ++p) { a.ph_lo = p; a.ph_hi = p + 1; hipLaunchKernelGGL(mk_fwd, dim3(grid), dim3(NTHR), LDS_BYTES, stream, a); }
#endif
}
```

```cpp
#include <hip/hip_runtime.h>
#include <cstdio>
#include <cstdint>
namespace pg8 {
#define PG8_LAS __attribute__((address_space(3)))
typedef unsigned short bf16_t;
typedef short bf16x8 __attribute__((ext_vector_type(8)));
typedef float f32x4 __attribute__((ext_vector_type(4)));
typedef unsigned u32x4 __attribute__((ext_vector_type(4)));
constexpr int BM = 256, BK = 64, HALF = 128, HTB = HALF * BK * 2  , STAGE_BYTES = 8 * HTB, NXCD = 8, WGM = 8;

__host__ __device__ __forceinline__ int lds_byte(int r, int c) { const int st = (r >> 4) * 2 + (c >> 5), rr = r & 15, cc = c & 31, ob = rr * 64 + cc * 2; return st * 1024 + (ob ^ (((ob >> 9) & 1) << 5)); }
__host__ __device__ __forceinline__ void stage_rc(int b, int& R, int& C) { const int st = b / 1024, sb = b % 1024, swz = sb ^ (((sb >> 9) & 1) << 5); R = (st >> 1) * 16 + swz / 64; C = (st & 1) * 32 + (swz % 64) / 2; }
__host__ __device__ __forceinline__ int perm32(int rho) { const int n = rho >> 4, i = rho & 15; return 8 * (i >> 2) + 4 * n + (i & 3); }

struct Unit { int pm, pn; };
struct Gemm { const bf16_t* A; const bf16_t* Bt; int M, N, K; };

struct StaticOrder {
    int nM, nN, nwg, G, c;
    __host__ __device__ void init(int M, int N, int G_, int c_) { nM = M / BM; nN = N / BM; nwg = nM * nN; G = G_; c = c_; }
    __host__ __device__ bool next(int i, Unit& u) const {
        const long L = (long)i * G + c; if (L >= nwg) return false;
        int wgid = (int)L; { const int q = nwg / NXCD, r = nwg % NXCD, xcd = wgid % NXCD, off = wgid / NXCD; wgid = (xcd < r ? xcd * (q + 1) : r * (q + 1) + (xcd - r) * q) + off; }
        const int nig = WGM * nN, gid = wgid / nig, fm = gid * WGM, gsz = (nM - fm) < WGM ? (nM - fm) : WGM;
        u.pm = fm + ((wgid % nig) % gsz); u.pn = (wgid % nig) / gsz; return true;
    }
    __device__ __forceinline__ void a_ready(const Unit&) const {}
    __device__ __forceinline__ void done(const Unit&) const {}
};

__device__ __forceinline__ unsigned cvt_pk_bf16(float lo, float hi) { unsigned r; asm volatile("v_cvt_pk_bf16_f32 %0, %1, %2" : "=v"(r) : "v"(lo), "v"(hi)); return r; }
typedef float f32x2 __attribute__((ext_vector_type(2)));
__device__ __forceinline__ f32x2 gelu_pk(f32x2 v) {
    const f32x2 av = __builtin_elementwise_abs(v), d = av * 0.2316418882f + 1.0f;
    f32x2 t; t.x = __builtin_amdgcn_rcpf(d.x); t.y = __builtin_amdgcn_rcpf(d.y);
    f32x2 q = t * 0.5307027145f + (-0.7265760135f); q = q * t + 0.7107068705f; q = q * t + (-0.142248368f); q = q * t + 0.127414796f; q = q * t;
    const f32x2 s = (v * v) * (-0.72134752044f);
    f32x2 e; e.x = __builtin_amdgcn_exp2f(s.x); e.y = __builtin_amdgcn_exp2f(s.y);
    const f32x2 m = v * (q * e), r = v - m;
    f32x2 o; o.x = v.x < 0.f ? m.x : r.x; o.y = v.y < 0.f ? m.y : r.y; return o;
}

template <int ACT  > struct EpiBf16 {
    static constexpr bool PERM = true, AFTER_DRAIN = false; static_assert(ACT == 0 || ACT == 1, "EpiBf16: ACT is 0 (none) or 1 (gelu_pk)");
    bf16_t* O; int ldc; const float* bias; int split_cols; size_t split_stride; float scale0;
    __device__ __forceinline__ void operator()(const f32x4 (&acc)[2][2][4][2], const Unit& u, int wr, int wc, int fr, int fq) const {
        const int row0 = u.pm * BM + wr * 64 + fr; int colt = u.pn * BM; bf16_t* base = O;
        float sc = 1.f; if (split_cols) { const int t = colt / split_cols; base += (size_t)t * split_stride; colt -= t * split_cols; if (t == 0) sc = scale0; }
        const int col0 = colt + wc * 32 + 8 * fq, bcol0 = u.pn * BM + wc * 32 + 8 * fq;
        f32x4 bv[2][2];
#pragma unroll
        for (int bj = 0; bj < 2; ++bj)
#pragma unroll
            for (int n = 0; n < 2; ++n) bv[bj][n] = bias ? *(const f32x4*)(bias + bcol0 + bj * HALF + 4 * n) : (f32x4){0.f, 0.f, 0.f, 0.f};
#pragma unroll
        for (int ai = 0; ai < 2; ++ai)
#pragma unroll
            for (int m = 0; m < 4; ++m) { bf16_t* rowp = base + (size_t)(row0 + ai * HALF + m * 16) * ldc + col0;
#pragma unroll
                for (int bj = 0; bj < 2; ++bj) { f32x4 v0 = acc[ai][bj][m][0] + bv[bj][0], v1 = acc[ai][bj][m][1] + bv[bj][1];
                    if (ACT == 1) { f32x2 a = gelu_pk((f32x2){v0[0], v0[1]}), b = gelu_pk((f32x2){v0[2], v0[3]}), c = gelu_pk((f32x2){v1[0], v1[1]}), d = gelu_pk((f32x2){v1[2], v1[3]});
                        v0 = (f32x4){a.x, a.y, b.x, b.y}; v1 = (f32x4){c.x, c.y, d.x, d.y}; }
                    v0 = v0 * sc; v1 = v1 * sc; u32x4 w; w.x = cvt_pk_bf16(v0[0], v0[1]); w.y = cvt_pk_bf16(v0[2], v0[3]); w.z = cvt_pk_bf16(v1[0], v1[1]); w.w = cvt_pk_bf16(v1[2], v1[3]);
                    *(u32x4*)(rowp + bj * HALF) = w; } }
    }
};
template <class Epi, class Sched, bool ALIGN_EPI = false, bool SP2 = false, bool F8 = false>
__device__ __forceinline__ void gemm_phase(PG8_LAS unsigned char* lds, const Gemm g, const Sched& S, const Epi& E) {
    const int tid = threadIdx.x, wid = __builtin_amdgcn_readfirstlane(tid >> 6), lane = tid & 63, wr = wid >> 2, wc = wid & 3, fr = lane & 15, fq = lane >> 4;
    int Kq = g.K; if constexpr (F8) asm volatile("" : "+s"(Kq));
    const int K = Kq, nt = K / BK;
    unsigned voffA[2], voffB[2];
#pragma unroll
    for (int i = 0; i < 2; ++i) { int R, C; stage_rc(tid * 16 + i * 8192, R, C); const int Rb = Epi::PERM ? ((R & ~31) + perm32(R & 31)) : R;
        voffA[i] = (unsigned)(R * K + C) * 2u; voffB[i] = (unsigned)(Rb * K + C) * 2u; }
    const size_t kstep = (size_t)(BK * 2);
    const size_t hstep = (size_t)HALF * K * 2;
    const size_t tstep = 2 * hstep;
    const unsigned ldsw = (unsigned)wid * 1024u;
    const int aoff = lds_byte(wr * 64 + fr, fq * 8), boff = lds_byte(wc * 32 + fr, fq * 8);
#define PG8_SA(b, h) (((b) * 2 + (h)) * HTB)
#define PG8_SB(b, h) ((4 + (b) * 2 + (h)) * HTB)
#define PG8_STAGE(bufoff, gbase, voff) do { _Pragma("unroll") for (int _i = 0; _i < 2; ++_i) \
        __builtin_amdgcn_global_load_lds((const unsigned*)((const char*)(gbase) + (voff)[_i]), (PG8_LAS unsigned*)(lds + (bufoff) + ldsw + _i * 8192), 16, 0, 0); } while (0)
#define PG8_LDA(dst, b, h) do { _Pragma("unroll") for (int m = 0; m < 4; ++m) { if constexpr (F8) { const i32x4_ lo_ = *(const PG8_LAS i32x4_*)(lds + PG8_SA(b, h) + aoff + m * 2048), hi_ = *(const PG8_LAS i32x4_*)(lds + PG8_SA(b, h) + aoff + m * 2048 + 1024); dst##8[m] = __builtin_shufflevector(lo_, hi_, 0, 1, 2, 3, 4, 5, 6, 7); } \
        else { _Pragma("unroll") for (int k = 0; k < 2; ++k) dst[m][k] = *(const PG8_LAS bf16x8*)(lds + PG8_SA(b, h) + aoff + m * 2048 + k * 1024); } } } while (0)
#define PG8_LDB(dst, b, h) do { _Pragma("unroll") for (int n = 0; n < 2; ++n) { if constexpr (F8) { const i32x4_ lo_ = *(const PG8_LAS i32x4_*)(lds + PG8_SB(b, h) + boff + n * 2048), hi_ = *(const PG8_LAS i32x4_*)(lds + PG8_SB(b, h) + boff + n * 2048 + 1024); dst##8[n] = __builtin_shufflevector(lo_, hi_, 0, 1, 2, 3, 4, 5, 6, 7); } \
        else { _Pragma("unroll") for (int k = 0; k < 2; ++k) dst[n][k] = *(const PG8_LAS bf16x8*)(lds + PG8_SB(b, h) + boff + n * 2048 + k * 1024); } } } while (0)
#define PG8_MMA(ai, bj, At, Bt) do { __builtin_amdgcn_s_setprio(1); _Pragma("unroll") for (int m = 0; m < 4; ++m) _Pragma("unroll") for (int n = 0; n < 2; ++n) { \
        if constexpr (F8) asm volatile("v_mfma_scale_f32_16x16x128_f8f6f4 %0, %1, %2, %0, %3, %3 op_sel_hi:[0,0,0]" : "+v"(acc[ai][bj][m][n]) : "v"(Bt##8[n]), "v"(At##8[m]), "v"(f8scale)); \
        else { _Pragma("unroll") for (int k = 0; k < 2; ++k) acc[ai][bj][m][n] = __builtin_amdgcn_mfma_f32_16x16x32_bf16(Bt[n][k], At[m][k], acc[ai][bj][m][n], 0, 0, 0); } } \
        __builtin_amdgcn_s_setprio(0); } while (0)
#define PG8_WAIT_V(n) asm volatile("s_waitcnt vmcnt(" #n ")" ::: "memory")
#define PG8_WAIT_L(n) asm volatile("s_waitcnt lgkmcnt(" #n ")" ::: "memory")
#define PG8_BAR __builtin_amdgcn_s_barrier()
#define PG8_SCHED __builtin_amdgcn_sched_barrier(0)
    Unit cur, nxt; int ui = 0;
    if (!S.next(0, cur)) return;
    f32x4 acc[2][2][4][2];
#pragma unroll
    for (int a = 0; a < 2; ++a)
#pragma unroll
        for (int b = 0; b < 2; ++b)
#pragma unroll
            for (int m = 0; m < 4; ++m)
#pragma unroll
                for (int n = 0; n < 2; ++n) { acc[a][b][m][n] = (f32x4){0.f, 0.f, 0.f, 0.f}; if constexpr (F8) asm volatile("" : "+v"(acc[a][b][m][n])); }
    bf16x8 At[4][2], B0[2][2], B1[2][2];
    typedef int i32x4_ __attribute__((ext_vector_type(4))); typedef int i32x8_ __attribute__((ext_vector_type(8)));
    i32x8_ At8[4], B08[2], B18[2];
    int f8scale = 0x7f7f7f7f; asm volatile("" : "+v"(f8scale));
    const char* cA = (const char*)g.A + (size_t)cur.pm * tstep; const char* cB = (const char*)g.Bt + (size_t)cur.pn * tstep;
    S.a_ready(cur);
    if constexpr (SP2) {
        PG8_STAGE(PG8_SB(0, 0), cB, voffB); PG8_STAGE(PG8_SB(0, 1), cB + hstep, voffB); PG8_STAGE(PG8_SA(0, 0), cA, voffA); PG8_STAGE(PG8_SA(0, 1), cA + hstep, voffA);
        if (wr == 1) PG8_BAR;
        PG8_WAIT_V(2); PG8_BAR;
        PG8_STAGE(PG8_SB(1, 0), cB + kstep, voffB); PG8_STAGE(PG8_SA(1, 0), cA + kstep, voffA); PG8_STAGE(PG8_SB(1, 1), cB + hstep + kstep, voffB);
        PG8_WAIT_V(6); PG8_BAR;
    } else {
        PG8_STAGE(PG8_SB(0, 0), cB, voffB); PG8_STAGE(PG8_SA(0, 0), cA, voffA); PG8_STAGE(PG8_SB(0, 1), cB + hstep, voffB); PG8_STAGE(PG8_SA(0, 1), cA + hstep, voffA);
        if (wr == 1) PG8_BAR;
        PG8_WAIT_V(4); PG8_BAR;
        PG8_STAGE(PG8_SB(1, 0), cB + kstep, voffB); PG8_STAGE(PG8_SA(1, 0), cA + kstep, voffA); PG8_STAGE(PG8_SB(1, 1), cB + hstep + kstep, voffB);
        PG8_WAIT_V(6); PG8_BAR;
    }
    for (;;) {
        const bool has_next = S.next(ui + 1, nxt);
        const char* nA = has_next ? (const char*)g.A + (size_t)nxt.pm * tstep : cA; const char* nB = has_next ? (const char*)g.Bt + (size_t)nxt.pn * tstep : cB;
        for (int t = 0; t < nt; t += 2) {
            const bool last = (t == nt - 2);
            const char* a1 = cA + (size_t)(t + 1) * kstep;
            const char* a2 = last ? nA : cA + (size_t)(t + 2) * kstep; const char* b2 = last ? nB : cB + (size_t)(t + 2) * kstep;
            const char* a3 = a2 + kstep; const char* b3 = b2 + kstep;
            if (last && has_next) S.a_ready(nxt);
            if constexpr (SP2) {
            PG8_LDB(B0, 0, 0); PG8_LDB(B1, 0, 1); PG8_SCHED; PG8_LDA(At, 0, 0); PG8_STAGE(PG8_SA(1, 1), a1 + hstep, voffA);
            PG8_WAIT_V(8); PG8_WAIT_L(0); PG8_BAR; PG8_MMA(0, 0, At, B0); PG8_MMA(0, 1, At, B1); PG8_BAR; PG8_SCHED;
            PG8_LDA(At, 0, 1); PG8_STAGE(PG8_SB(0, 0), b2, voffB); PG8_STAGE(PG8_SB(0, 1), b2 + hstep, voffB); PG8_STAGE(PG8_SA(0, 0), a2, voffA);
            PG8_WAIT_V(8); PG8_WAIT_L(0); PG8_BAR; PG8_MMA(1, 0, At, B0); PG8_MMA(1, 1, At, B1); PG8_BAR; PG8_SCHED;
            PG8_LDB(B0, 1, 0); PG8_LDB(B1, 1, 1); PG8_SCHED; PG8_LDA(At, 1, 0); PG8_STAGE(PG8_SA(0, 1), a2 + hstep, voffA);
            PG8_WAIT_V(8); PG8_WAIT_L(0); PG8_BAR; PG8_MMA(0, 0, At, B0); PG8_MMA(0, 1, At, B1); PG8_BAR; PG8_SCHED;
            PG8_LDA(At, 1, 1); PG8_STAGE(PG8_SB(1, 0), b3, voffB); PG8_STAGE(PG8_SB(1, 1), b3 + hstep, voffB); PG8_STAGE(PG8_SA(1, 0), a3, voffA);
            PG8_WAIT_V(8); PG8_WAIT_L(0); PG8_BAR; PG8_MMA(1, 0, At, B0); PG8_MMA(1, 1, At, B1); PG8_BAR; PG8_SCHED;
            } else {
            PG8_LDB(B0, 0, 0); PG8_SCHED; PG8_LDA(At, 0, 0); PG8_STAGE(PG8_SA(1, 1), a1 + hstep, voffA);
            PG8_WAIT_L(8); PG8_BAR; PG8_WAIT_L(0); PG8_MMA(0, 0, At, B0); PG8_BAR; PG8_SCHED;
            PG8_LDB(B1, 0, 1); PG8_STAGE(PG8_SB(0, 0), b2, voffB);
            PG8_BAR; PG8_WAIT_L(0); PG8_MMA(0, 1, At, B1); PG8_BAR;
            PG8_LDA(At, 0, 1); PG8_STAGE(PG8_SA(0, 0), a2, voffA);
            PG8_BAR; PG8_WAIT_L(0); PG8_MMA(1, 0, At, B0); PG8_BAR; PG8_SCHED;
            PG8_STAGE(PG8_SB(0, 1), b2 + hstep, voffB);
            PG8_WAIT_V(6); PG8_BAR; PG8_MMA(1, 1, At, B1); PG8_BAR;
            PG8_LDB(B0, 1, 0); PG8_SCHED; PG8_LDA(At, 1, 0); PG8_STAGE(PG8_SA(0, 1), a2 + hstep, voffA);
            PG8_WAIT_L(8); PG8_BAR; PG8_WAIT_L(0); PG8_MMA(0, 0, At, B0); PG8_BAR; PG8_SCHED;
            PG8_LDB(B1, 1, 1); PG8_STAGE(PG8_SB(1, 0), b3, voffB);
            PG8_BAR; PG8_WAIT_L(0); PG8_MMA(0, 1, At, B1); PG8_BAR;
            PG8_LDA(At, 1, 1); PG8_STAGE(PG8_SA(1, 0), a3, voffA);
            PG8_BAR; PG8_WAIT_L(0); PG8_MMA(1, 0, At, B0); PG8_BAR; PG8_SCHED;
            PG8_STAGE(PG8_SB(1, 1), b3 + hstep, voffB);
            PG8_WAIT_V(6); PG8_BAR; PG8_MMA(1, 1, At, B1); PG8_BAR;
            }
        }
        if constexpr (F8) asm volatile("s_nop 15\n\ts_nop 15" ::: "memory");
        if constexpr (ALIGN_EPI) { if (wr == 0) PG8_BAR; }
        if constexpr (!Epi::AFTER_DRAIN) { E(acc, cur, wr, wc, fr, fq); S.done(cur); }
        if (!has_next) break;
#pragma unroll
        for (int a = 0; a < 2; ++a)
#pragma unroll
            for (int b = 0; b < 2; ++b)
#pragma unroll
                for (int m = 0; m < 4; ++m)
#pragma unroll
                    for (int n = 0; n < 2; ++n) { acc[a][b][m][n] = (f32x4){0.f, 0.f, 0.f, 0.f}; if constexpr (F8) asm volatile("" : "+v"(acc[a][b][m][n])); }
        cur = nxt; cA = nA; cB = nB; ++ui;
        if constexpr (ALIGN_EPI) { if (wr == 1) PG8_BAR; }
    }
    PG8_WAIT_V(0);
    if constexpr (!ALIGN_EPI) { if (wr == 0) PG8_BAR; }
    PG8_BAR;
    if constexpr (Epi::AFTER_DRAIN) { E.fused(acc, cur, wr, wc, fr, fq, lds, wid, lane); S.done(cur); }
#undef PG8_SA
#undef PG8_SB
#undef PG8_STAGE
#undef PG8_LDA
#undef PG8_LDB
#undef PG8_MMA
#undef PG8_WAIT_V
#undef PG8_WAIT_L
#undef PG8_BAR
#undef PG8_SCHED
}
}
#define LAS __attribute__((address_space(3)))
#define XB_TMO      128
#define XB_XCNT(j)  (256  + 64 * (j))
#define XB_XSUB(j)  (1280 + 64 * (j))
#define XB_XGEN(j)  (2304 + 64 * (j))
#define XB_TOP      3328
#define XB_TOPGEN   3392
#define XCD_BAR_WORDS 3456
#define XB_SPIN_CAP (1u << 18)

__device__ __forceinline__ unsigned xb_ld(unsigned* p)              { return __hip_atomic_load(p, __ATOMIC_RELAXED, __HIP_MEMORY_SCOPE_AGENT); }
__device__ __forceinline__ unsigned xb_add(unsigned* p, unsigned v) { return __hip_atomic_fetch_add(p, v, __ATOMIC_RELAXED, __HIP_MEMORY_SCOPE_AGENT); }
__device__ __forceinline__ unsigned xb_xcc_id() { return (unsigned)__builtin_amdgcn_s_getreg((3 << 11) | 20) & 0xFu; }
#define XB_SPIN(cond, bar) do { unsigned _sp = 0; while (cond) { __builtin_amdgcn_s_sleep(1); \
    if ((++_sp & 255u) == 0u) { if (xb_ld(&(bar)[XB_TMO])) break; if (_sp > XB_SPIN_CAP) { atomicAdd(&(bar)[XB_TMO], 1u); break; } } } } while (0)

struct XcdBarrier {
    unsigned* bar; unsigned x;
    volatile LAS unsigned* st;
};

__device__ __forceinline__ XcdBarrier xcd_barrier_post(unsigned* bar, volatile LAS unsigned* st) {
    XcdBarrier b; b.bar = bar; b.x = xb_xcc_id(); b.st = st;
    if (threadIdx.x == 0) (void)xb_add(&bar[XB_XCNT(b.x)], 1u);
    return b;
}
__device__ __forceinline__ void xcd_barrier_complete(unsigned* bar, unsigned x, unsigned& nloc, unsigned& nx) {
    const unsigned G = gridDim.x * gridDim.y * gridDim.z;
    unsigned sum, cnt, mine, sp = 0u;
    for (;;) {
        sum = 0u; cnt = 0u; mine = 0u;
#pragma unroll
        for (unsigned j = 0; j < 16; ++j) { const unsigned c = xb_ld(&bar[XB_XCNT(j)]); sum += c; cnt += (c > 0u) ? 1u : 0u; mine = (j == x) ? c : mine; }
        if (sum == G) break;
        __builtin_amdgcn_s_sleep(1);
        if ((++sp & 255u) == 0u) { if (xb_ld(&bar[XB_TMO])) break; if (sp > XB_SPIN_CAP) { atomicAdd(&bar[XB_TMO], 1u); break; } }
    }
    nloc = mine > 0u ? mine : 1u; nx = cnt > 0u ? cnt : 1u;
}

__device__ __forceinline__ void xcd_barrier(const XcdBarrier& b) {
    asm volatile("s_waitcnt vmcnt(0)" ::: "memory");
    __syncthreads();
    if (threadIdx.x == 0) {
        unsigned* bar = b.bar;
        __builtin_amdgcn_s_waitcnt(0);
        unsigned nloc = b.st[0], nx = b.st[1];
        if (nloc == 0u) { xcd_barrier_complete(bar, b.x, nloc, nx); b.st[0] = nloc; b.st[1] = nx; }
        const unsigned old = xb_add(&bar[XB_XSUB(b.x)], 1u);
        const unsigned gen = old / nloc;
        if (old + 1u == (gen + 1u) * nloc) {
            __builtin_amdgcn_fence(__ATOMIC_RELEASE, "agent");
            asm volatile("s_waitcnt vmcnt(0)" ::: "memory");
            const unsigned og = xb_add(&bar[XB_TOP], 1u);
            const unsigned tg = og / nx;
            if (og + 1u == (tg + 1u) * nx) xb_add(&bar[XB_TOPGEN], 1u);
            else XB_SPIN(xb_ld(&bar[XB_TOPGEN]) == tg, bar);
            __builtin_amdgcn_fence(__ATOMIC_ACQUIRE, "agent");
            xb_add(&bar[XB_XGEN(b.x)], 1u);
            asm volatile("s_waitcnt vmcnt(0)" ::: "memory");
        } else {
            XB_SPIN(xb_ld(&bar[XB_XGEN(b.x)]) == gen, bar);
            __builtin_amdgcn_fence(__ATOMIC_ACQUIRE, "agent");
            asm volatile("s_waitcnt vmcnt(0)" ::: "memory");
        }
    }
    __syncthreads();
}

#define DI __device__ __forceinline__
#define LDS_WAIT() asm volatile("s_waitcnt lgkmcnt(0)" ::: "memory")
typedef unsigned short bf16;
typedef float f32x4 __attribute__((ext_vector_type(4)));

namespace mk {
constexpr int NB = 8, SEQ = 2048, DM = 1024, NT = NB * SEQ, NL = 2;
constexpr int INW = 3856, ZLD = 4096;
constexpr int ZA = 0, ZRKV = 768, ZWDF = 1920, ZWDB = 1984, ZADF = 2048, ZADB = 2112, ZGD = 2176, ZMQK = 2304, ZMV = 3072, ZMO = 3456, ZMG = 3840;
constexpr int RW = 384, MW = 384, AW = 256;
constexpr int NE = 16, CAP = 256, FF = 2816, NSLOT = NB * NE * CAP;
constexpr int NWAVES = 8, NTHR = 512;
constexpr float RMS_EPS = 1e-6f;

enum { I_X = 0, I_RELB, I_LN1G, I_WIN, I_WOUT, I_MU, I_W0, I_W2, I_A0, I_A2, I_KK, I_KA, I_RK, I_G2, I_RLNG, I_RLNB,
       I_CW, I_CB, I_IB, I_FB, I_MLNG, I_LN2G, I_ROUTER, I_EW1, I_EW3, I_EW2, I_FG, N_IN };

constexpr size_t MiB = 1u << 20;
constexpr size_t WS_CTL = 0, CTL_ZERO_BYTES = 1 * MiB;
constexpr size_t WS_WTIN = 2 * MiB;
constexpr size_t WS_WTOUT = 18 * MiB;
constexpr size_t WS_W13T = 22 * MiB;
constexpr size_t WS_W2T = 374 * MiB;
constexpr size_t WS_X1 = 550 * MiB;
constexpr size_t WS_X2 = 614 * MiB;
constexpr size_t WS_HB = 678 * MiB;
constexpr size_t WS_AFF = 710 * MiB;
constexpr size_t WS_SEL = 711 * MiB;
constexpr size_t WS_GATE = 712 * MiB;
constexpr size_t WS_G2T = 713 * MiB;
constexpr size_t WS_LWT = 713 * MiB + 256 * 1024;
constexpr size_t WS_R = 714 * MiB;
constexpr size_t WS_Z = WS_R;
constexpr size_t WS_ATTO = WS_R + 128 * MiB;
constexpr size_t WS_ATTL = WS_R + 152 * MiB;
constexpr size_t WS_PR = WS_R + 154 * MiB;
constexpr size_t WS_RKY = WS_R + 442 * MiB;
constexpr size_t WS_RKB = WS_R + 490 * MiB;
constexpr size_t WS_MLQK = WS_R + 538 * MiB;
constexpr size_t WS_MLNUM = WS_R + 586 * MiB;
constexpr size_t WS_MLDEN = WS_R + 634 * MiB;
constexpr size_t WS_XG = WS_R;
constexpr size_t WS_ACT = WS_R + 64 * MiB;
constexpr size_t WS_YS = WS_R + 240 * MiB;
constexpr size_t WS_END = WS_R + 636 * MiB;

constexpr int CW_BAR = 4096;
constexpr int LDS_BYTES = 147456;
constexpr int MISC_OFF = LDS_BYTES - 256;

struct Args { const float* in[N_IN]; float* out; unsigned char* ws; int ph_lo, ph_hi; };

DI float bf2f(unsigned v) { return __uint_as_float(v << 16); }
DI unsigned f2bf(float f) { unsigned u = __float_as_uint(f); return (u + 0x7fffu + ((u >> 16) & 1u)) >> 16; }
DI unsigned pk2(float lo, float hi) { return f2bf(lo) | (f2bf(hi) << 16); }
DI float wave_sum(float v) {
#pragma unroll
    for (int o = 1; o < 64; o <<= 1) v += __shfl_xor(v, o);
    return v;
}
DI float sigm(float x) { return 1.f / (1.f + __expf(-x)); }
DI void unpack8(const uint4 w, float (&f)[8]) {
    f[0] = __uint_as_float(w.x << 16); f[1] = __uint_as_float(w.x & 0xffff0000u); f[2] = __uint_as_float(w.y << 16); f[3] = __uint_as_float(w.y & 0xffff0000u);
    f[4] = __uint_as_float(w.z << 16); f[5] = __uint_as_float(w.z & 0xffff0000u); f[6] = __uint_as_float(w.w << 16); f[7] = __uint_as_float(w.w & 0xffff0000u);
}

struct GroupOrder {
    int G, c2, nunits, per_e, nN;
    DI void init(int nN_, int G_, int bid) { nN = nN_; per_e = 8 * nN_; nunits = NE * per_e; G = G_; c2 = (G_ % 8 == 0) ? (bid % 8) * (G_ / 8) + bid / 8 : bid; }
    DI bool next(int i, pg8::Unit& u) const {
        const long L = (long)i * G + c2; if (L >= nunits) return false;
        const int e = (int)L / per_e, r = (int)L % per_e; u.pm = e * 8 + (r & 7); u.pn = e * nN + (r >> 3); return true;
    }
    DI void a_ready(const pg8::Unit&) const {}
    DI void done(const pg8::Unit&) const {}
};
DI unsigned pkbf(float lo, float hi) { typedef __bf16 b2 __attribute__((ext_vector_type(2))); typedef float f2 __attribute__((ext_vector_type(2))); const f2 v = {lo, hi}; return __builtin_bit_cast(unsigned, __builtin_convertvector(v, b2)); }
template <bool BASE_BF16>
struct EpiResT {
    static constexpr bool PERM = false, AFTER_DRAIN = false;
    const void* base; bf16* out; int ldc;
    DI void operator()(const pg8::f32x4 (&acc)[2][2][4][2], const pg8::Unit& u, int wr, int wc, int fr, int fq) const {
        const int row0 = u.pm * 256 + wr * 64 + fr, col0 = u.pn * 256 + wc * 32 + 4 * fq;
#pragma unroll
        for (int ai = 0; ai < 2; ++ai)
#pragma unroll
            for (int m = 0; m < 4; ++m) { const size_t off = (size_t)(row0 + ai * 128 + m * 16) * ldc + col0;
#pragma unroll
                for (int bj = 0; bj < 2; ++bj)
#pragma unroll
                    for (int n = 0; n < 2; ++n) { pg8::f32x4 b;
                        if constexpr (BASE_BF16) { const uint2 w = *(const uint2*)((const bf16*)base + off + bj * 128 + n * 16);
                            b[0] = __uint_as_float(w.x << 16); b[1] = __uint_as_float(w.x & 0xffff0000u); b[2] = __uint_as_float(w.y << 16); b[3] = __uint_as_float(w.y & 0xffff0000u); }
                        else b = *(const pg8::f32x4*)((const float*)base + off + bj * 128 + n * 16);
                        b += acc[ai][bj][m][n]; uint2 o; o.x = pkbf(b[0], b[1]); o.y = pkbf(b[2], b[3]); *(uint2*)(out + off + bj * 128 + n * 16) = o; } }
    }
};
DI float silu_f(float x) { return x * __builtin_amdgcn_rcpf(1.f + __expf(-x)); }
DI float f8clamp(float x) { return __builtin_amdgcn_fmed3f(x, -448.f, 448.f); }
DI unsigned pk4_fp8(float a, float b, float c, float d) { unsigned p = 0u; p = __builtin_amdgcn_cvt_pk_fp8_f32(f8clamp(a), f8clamp(b), p, false); p = __builtin_amdgcn_cvt_pk_fp8_f32(f8clamp(c), f8clamp(d), p, true); return p; }
constexpr float F8_WSC = 64.f, F8_HSC = 8.f, F8_ASC = 16.f;
struct EpiSwiGLU {
    static constexpr bool PERM = true, AFTER_DRAIN = false;
    unsigned char* act; int nN;
    DI void operator()(const pg8::f32x4 (&acc)[2][2][4][2], const pg8::Unit& u, int wr, int wc, int fr, int fq) const {
        const int lpn = u.pn % nN; const int row0 = u.pm * 256 + wr * 64 + fr, col0 = lpn * 128 + wc * 32 + 8 * fq; constexpr float is = 1.f / (F8_HSC * F8_WSC);
#pragma unroll
        for (int ai = 0; ai < 2; ++ai)
#pragma unroll
            for (int m = 0; m < 4; ++m) { unsigned char* p = act + (size_t)(row0 + ai * 128 + m * 16) * FF + col0;
                const pg8::f32x4 a0 = acc[ai][0][m][0] * is, a1 = acc[ai][0][m][1] * is, g0 = acc[ai][1][m][0] * (is * F8_ASC), g1 = acc[ai][1][m][1] * (is * F8_ASC);
                uint2 w; w.x = pk4_fp8(silu_f(a0[0]) * g0[0], silu_f(a0[1]) * g0[1], silu_f(a0[2]) * g0[2], silu_f(a0[3]) * g0[3]);
                w.y = pk4_fp8(silu_f(a1[0]) * g1[0], silu_f(a1[1]) * g1[1], silu_f(a1[2]) * g1[2], silu_f(a1[3]) * g1[3]);
                *(uint2*)p = w; }
    }
};
struct EpiGate {
    static constexpr bool PERM = true, AFTER_DRAIN = false;
    bf16* ys; const float* gate;
    DI void operator()(const pg8::f32x4 (&acc)[2][2][4][2], const pg8::Unit& u, int wr, int wc, int fr, int fq) const {
        const int row0 = u.pm * 256 + wr * 64 + fr, col0 = (u.pn & 3) * 256 + wc * 32 + 8 * fq;
#pragma unroll
        for (int ai = 0; ai < 2; ++ai)
#pragma unroll
            for (int m = 0; m < 4; ++m) { const int row = row0 + ai * 128 + m * 16; const float g = gate[row] * (1.f / (F8_ASC * F8_WSC)); bf16* p = ys + (size_t)row * DM + col0;
#pragma unroll
                for (int bj = 0; bj < 2; ++bj) { const pg8::f32x4 v0 = acc[ai][bj][m][0] * g, v1 = acc[ai][bj][m][1] * g; pg8::u32x4 w;
                    w.x = pg8::cvt_pk_bf16(v0[0], v0[1]); w.y = pg8::cvt_pk_bf16(v0[2], v0[3]); w.z = pg8::cvt_pk_bf16(v1[0], v1[1]); w.w = pg8::cvt_pk_bf16(v1[2], v1[3]);
                    *(pg8::u32x4*)(p + bj * 128) = w; } }
    }
};

DI void cvt_tile(const float* W, int N, int nvalid, int k0, int n0, bf16* dst, int Kd, size_t drow0, LAS float* scr, int lane) {
    const int c4 = (lane & 15) * 4, kr = lane >> 4;
#pragma unroll
    for (int it = 0; it < 16; ++it) { const int k = it * 4 + kr; float4 v = make_float4(0.f, 0.f, 0.f, 0.f);
        if (n0 + c4 < nvalid) v = *(const float4*)(W + (size_t)(k0 + k) * N + n0 + c4);
        LAS float* s = scr + k * 65 + c4; s[0] = v.x; s[1] = v.y; s[2] = v.z; s[3] = v.w; }
    LDS_WAIT(); asm volatile("" ::: "memory");
    const int c = lane & 7;
#pragma unroll
    for (int it = 0; it < 8; ++it) { const int n = it * 8 + (lane >> 3); const LAS float* s = scr + (8 * c) * 65 + n;
        uint4 o; o.x = pk2(s[0], s[65]); o.y = pk2(s[130], s[195]); o.z = pk2(s[260], s[325]); o.w = pk2(s[390], s[455]);
        *(uint4*)(dst + (drow0 + n) * (size_t)Kd + k0 + 8 * c) = o; }
    LDS_WAIT(); asm volatile("" ::: "memory");
}
DI void cvt_tile_fp8(const float* W, int N, int k0, int n0, unsigned char* dst, int Kd, size_t drow0, float sc, LAS unsigned char* scr, int lane) {
    const int nq = lane & 15, kq = lane >> 4;
#pragma unroll
    for (int hb = 0; hb < 2; ++hb) {
        f32x4 v[4][4];
#pragma unroll
        for (int it = 0; it < 4; ++it)
#pragma unroll
            for (int j = 0; j < 4; ++j) v[it][j] = __builtin_nontemporal_load((const f32x4*)(W + (size_t)(k0 + hb * 64 + it * 16 + kq * 4 + j) * N + n0 + 4 * nq));
#pragma unroll
        for (int it = 0; it < 4; ++it)
#pragma unroll
            for (int i = 0; i < 4; ++i) *(LAS unsigned*)(scr + (4 * nq + i) * 132 + hb * 64 + it * 16 + kq * 4) = pk4_fp8(v[it][0][i] * sc, v[it][1][i] * sc, v[it][2][i] * sc, v[it][3][i] * sc);
    }
    LDS_WAIT(); asm volatile("" ::: "memory");
    const int c = lane & 7;
#pragma unroll
    for (int it = 0; it < 8; ++it) { const int n = it * 8 + (lane >> 3); const LAS unsigned* s = (const LAS unsigned*)(scr + n * 132 + 16 * c);
        uint4 o; o.x = s[0]; o.y = s[1]; o.z = s[2]; o.w = s[3];
        *(uint4*)(dst + (drow0 + n) * (size_t)Kd + k0 + 16 * c) = o; }
    LDS_WAIT(); asm volatile("" ::: "memory");
}
DI void phase_p0(const Args& A, LAS unsigned char* lds, int it0, int it1, int gw, int ngw, int wave, int lane) {
    LAS float* scr = (LAS float*)(lds + wave * 16896);
    bf16* wtin = (bf16*)(A.ws + WS_WTIN); bf16* wtout = (bf16*)(A.ws + WS_WTOUT); unsigned char* w13 = A.ws + WS_W13T; unsigned char* w2t = A.ws + WS_W2T;
    constexpr int I_IN = NL * 16 * 64, I_OUT = NL * 16 * 16, I_E = 8 * 44, I_MOE = NL * NE * 3 * I_E;
    for (int it = it0 + gw; it < it1; it += ngw) {
        int r = it;
        if (r < I_IN) { const int l = r / 1024, t = r % 1024, kb = t / 64, nb = t % 64;
            cvt_tile(A.in[I_WIN] + (size_t)l * DM * INW, INW, INW, kb * 64, nb * 64, wtin + (size_t)l * ZLD * DM, DM, (size_t)nb * 64, scr, lane); continue; }
        r -= I_IN;
        if (r < I_OUT) { const int l = r / 256, t = r % 256, kb = t / 16, nb = t % 16;
            cvt_tile(A.in[I_WOUT] + (size_t)l * DM * DM, DM, DM, kb * 64, nb * 64, wtout + (size_t)l * DM * DM, DM, (size_t)nb * 64, scr, lane); continue; }
        r -= I_OUT;
        const int le = r / (3 * I_E), q = r % (3 * I_E), which = q / I_E, t = q % I_E;
        if (which < 2) { const int kb = t / 44, nb = t % 44, n0 = nb * 64;
            cvt_tile_fp8(A.in[which == 0 ? I_EW1 : I_EW3] + (size_t)le * DM * FF, FF, kb * 128, n0, w13 + (size_t)le * 5632 * DM, DM, (size_t)((n0 >> 7) * 256 + which * 128 + (n0 & 127)), F8_WSC, (LAS unsigned char*)scr, lane); }
        else { const int kb = t / 16, nb = t % 16;
            cvt_tile_fp8(A.in[I_EW2] + (size_t)le * FF * DM, DM, kb * 128, nb * 64, w2t + (size_t)le * DM * FF, FF, (size_t)nb * 64, F8_WSC, (LAS unsigned char*)scr, lane); }
    }
    if (it0 == 0) { bf16* g2t = (bf16*)(A.ws + WS_G2T);
        for (int idx = gw * 64 + lane; idx < NL * 128 * RW; idx += ngw * 64) { const int col = idx % RW, j = (idx / RW) % 128, l = idx / (128 * RW); g2t[((size_t)l * RW + col) * 128 + j] = (bf16)f2bf(A.in[I_G2][idx]); } }
}

DI void load_row(const float* xrow, int lane, f32x4 (&v)[4]) {
    const f32x4* xr = (const f32x4*)xrow + lane;
#pragma unroll
    for (int j = 0; j < 4; ++j) v[j] = xr[64 * j];
}
DI void load_row_bf(const bf16* xrow, int lane, f32x4 (&v)[4]) {
    const uint2* xr = (const uint2*)xrow + lane;
#pragma unroll
    for (int j = 0; j < 4; ++j) { const uint2 w = xr[64 * j]; v[j][0] = __uint_as_float(w.x << 16); v[j][1] = __uint_as_float(w.x & 0xffff0000u); v[j][2] = __uint_as_float(w.y << 16); v[j][3] = __uint_as_float(w.y & 0xffff0000u); }
}
DI void add_slots(const Args& A, int tok, int lane, f32x4 (&v)[4]) {
    const int* sel = (const int*)(A.ws + WS_SEL); const bf16* ys = (const bf16*)(A.ws + WS_YS);
    const int b = tok / SEQ; const int mys = (lane < NE) ? sel[(size_t)tok * NE + lane] : -1;
    for (int e = 0; e < NE; ++e) { const int r = __shfl(mys, e);
        if (r >= 0) { const uint2* p = (const uint2*)(ys + (size_t)((e * NB + b) * CAP + r) * DM) + lane;
#pragma unroll
            for (int j = 0; j < 4; ++j) { const uint2 w = p[64 * j]; v[j][0] += __uint_as_float(w.x << 16); v[j][1] += __uint_as_float(w.x & 0xffff0000u); v[j][2] += __uint_as_float(w.y << 16); v[j][3] += __uint_as_float(w.y & 0xffff0000u); } } }
}
DI float row_rstd(const f32x4 (&v)[4]) {
    float s = 0.f;
#pragma unroll
    for (int j = 0; j < 4; ++j) s += (v[j][0] * v[j][0] + v[j][1] * v[j][1]) + (v[j][2] * v[j][2] + v[j][3] * v[j][3]);
    return rsqrtf(wave_sum(s) * (1.f / DM) + RMS_EPS);
}
DI void phase_ln1(const Args& A, int l, int gw, int ngw, int lane) {
    const float* xin = A.in[I_X]; const bf16* x1 = (const bf16*)(A.ws + WS_X1); bf16* x2 = (bf16*)(A.ws + WS_X2); bf16* hb = (bf16*)(A.ws + WS_HB);
    f32x4 gg[4];
#pragma unroll
    for (int j = 0; j < 4; ++j) gg[j] = ((const f32x4*)(A.in[I_LN1G] + (size_t)l * DM) + lane)[64 * j];
    for (int tok = gw; tok < NT; tok += 2 * ngw) {
        const int tokb = tok + ngw; const bool hb2 = tokb < NT;
        f32x4 va[4], vb[4];
        if (l == 0) { load_row(xin + (size_t)tok * DM, lane, va); load_row(xin + (size_t)(hb2 ? tokb : tok) * DM, lane, vb); }
        else { load_row_bf(x1 + (size_t)tok * DM, lane, va); load_row_bf(x1 + (size_t)(hb2 ? tokb : tok) * DM, lane, vb);
            add_slots(A, tok, lane, va); add_slots(A, hb2 ? tokb : tok, lane, vb);
            uint2* oa = (uint2*)(x2 + (size_t)tok * DM) + lane; uint2* ob = (uint2*)(x2 + (size_t)tokb * DM) + lane;
#pragma unroll
            for (int j = 0; j < 4; ++j) { uint2 w; w.x = pkbf(va[j][0], va[j][1]); w.y = pkbf(va[j][2], va[j][3]); oa[64 * j] = w;
                if (hb2) { uint2 u; u.x = pkbf(vb[j][0], vb[j][1]); u.y = pkbf(vb[j][2], vb[j][3]); ob[64 * j] = u; } } }
        const float ra = row_rstd(va), rb = row_rstd(vb); uint2* o8a = (uint2*)(hb + (size_t)tok * DM) + lane; uint2* o8b = (uint2*)(hb + (size_t)tokb * DM) + lane;
#pragma unroll
        for (int j = 0; j < 4; ++j) { uint2 w; w.x = pkbf(va[j][0] * ra * gg[j][0], va[j][1] * ra * gg[j][1]); w.y = pkbf(va[j][2] * ra * gg[j][2], va[j][3] * ra * gg[j][3]); o8a[64 * j] = w;
            if (hb2) { uint2 u; u.x = pkbf(vb[j][0] * rb * gg[j][0], vb[j][1] * rb * gg[j][1]); u.y = pkbf(vb[j][2] * rb * gg[j][2], vb[j][3] * rb * gg[j][3]); o8b[64 * j] = u; } }
    }
}
DI void phase_final(const Args& A, int gw, int ngw, int lane) {
    const bf16* xin = (const bf16*)(A.ws + WS_X1);
    f32x4 gg[4];
#pragma unroll
    for (int j = 0; j < 4; ++j) gg[j] = ((const f32x4*)A.in[I_FG] + lane)[64 * j];
    for (int tok = gw; tok < NT; tok += 2 * ngw) {
        const int tokb = tok + ngw; const bool hb2 = tokb < NT;
        f32x4 va[4], vb[4]; load_row_bf(xin + (size_t)tok * DM, lane, va); load_row_bf(xin + (size_t)(hb2 ? tokb : tok) * DM, lane, vb);
        add_slots(A, tok, lane, va); add_slots(A, hb2 ? tokb : tok, lane, vb);
        const float ra = row_rstd(va), rb = row_rstd(vb); f32x4* oa = (f32x4*)(A.out + (size_t)tok * DM) + lane; f32x4* ob = (f32x4*)(A.out + (size_t)tokb * DM) + lane;
#pragma unroll
        for (int j = 0; j < 4; ++j) { oa[64 * j] = va[j] * ra * gg[j]; if (hb2) ob[64 * j] = vb[j] * rb * gg[j]; }
    }
}
DI void phase_topk(const Args& A, LAS unsigned char* lds, int bid, int G, int tid, int wave, int lane) {
    const unsigned* affk = (const unsigned*)(A.ws + WS_AFF); int* sel = (int*)(A.ws + WS_SEL); float* gate = (float*)(A.ws + WS_GATE);
    const unsigned char* hb = A.ws + WS_HB; unsigned char* xg = A.ws + WS_XG;
    LAS unsigned* hist = (LAS unsigned*)lds;
    LAS unsigned* wsum = hist + 32;
    LAS int* list = (LAS int*)(lds + 256);
    for (int u = bid; u < NB * NE * 2; u += G) {
        const int half = u & 1, e = (u >> 1) % NE, b = u / (2 * NE);
        __syncthreads();
        if (tid < 32) hist[tid] = 0u;
        const uint4 kv = *(const uint4*)(affk + (size_t)(b * NE + e) * SEQ + tid * 4);
        const unsigned key[4] = {kv.x, kv.y, kv.z, kv.w};
        __syncthreads();
        unsigned prefix = 0u, krem = CAP;
#pragma unroll 1
        for (int pass = 0; pass < 8; ++pass) { const int shift = 28 - 4 * pass; LAS unsigned* h = hist + (pass & 1) * 16;
            unsigned cnt = 0u;
#pragma unroll
            for (int i = 0; i < 4; ++i) { const bool cand = (pass == 0) || ((key[i] >> (shift + 4)) == prefix); const unsigned bin = (key[i] >> shift) & 15u;
#pragma unroll
                for (int v = 0; v < 16; ++v) { const unsigned long long m = __ballot(cand && bin == (unsigned)v); if (lane == v) cnt += (unsigned)__popcll(m); } }
            if (lane < 16 && cnt) atomicAdd((unsigned*)(h + lane), cnt);
            __syncthreads();
            unsigned acc = 0u, pick = 0u, before = 0u;
#pragma unroll
            for (int v = 15; v >= 0; --v) { const unsigned c = h[v]; if (acc < krem && acc + c >= krem) { pick = (unsigned)v; before = acc; } acc += c; }
            prefix = (prefix << 4) | pick; krem -= before;
            if (tid < 16) hist[((pass + 1) & 1) * 16 + tid] = 0u;
            __syncthreads();
        }
        const unsigned tau = prefix;
        unsigned gt[4], eq[4]; unsigned ngt = 0u, neq = 0u;
#pragma unroll
        for (int i = 0; i < 4; ++i) { gt[i] = key[i] > tau ? 1u : 0u; eq[i] = key[i] == tau ? 1u : 0u; ngt += gt[i]; neq += eq[i]; }
        unsigned sg = ngt, se = neq;
#pragma unroll
        for (int o = 1; o < 64; o <<= 1) { const unsigned tg = __shfl_up(sg, o), te = __shfl_up(se, o); if (lane >= o) { sg += tg; se += te; } }
        if (lane == 63) { wsum[wave] = sg; wsum[8 + wave] = se; }
        __syncthreads();
        unsigned offg = 0u, offe = 0u;
        for (int w = 0; w < wave; ++w) { offg += wsum[w]; offe += wsum[8 + w]; }
        unsigned eqbefore = offe + se - neq;
        unsigned gtbefore = offg + sg - ngt;
        const int slot0 = (e * NB + b) * CAP;
#pragma unroll
        for (int i = 0; i < 4; ++i) { const int s = tid * 4 + i; const bool selq = gt[i] || (eq[i] && eqbefore < krem);
            const unsigned pos = gtbefore + (eqbefore < krem ? eqbefore : krem);
            if ((s >> 10) == half) { sel[(size_t)(b * SEQ + s) * NE + e] = selq ? (int)pos : -1;
                if (selq) { gate[slot0 + pos] = __uint_as_float(key[i]); } }
            if (selq && pos < CAP) list[pos] = s;
            gtbefore += gt[i]; eqbefore += eq[i]; }
        __syncthreads();
        for (int r = wave; r < CAP; r += NWAVES) { const int s = list[r];
            if ((s >> 10) == half) { const uint4* src = (const uint4*)(hb + (size_t)(b * SEQ + s) * DM) + lane; uint4* dstp = (uint4*)(xg + (size_t)(slot0 + r) * DM) + lane; dstp[0] = src[0]; } }
    }
    __syncthreads();
}

DI int t5_bucket(int rel) {
    const int ret = rel > 0 ? 16 : 0; const int n = rel < 0 ? -rel : rel;
    if (n < 8) return ret + n;
    int large = 8 + (int)(logf((float)n / 8.0f) / 4.852030263919617f * 8.0f);
    large = large < 15 ? large : 15;
    return ret + large;
}

typedef short bf16x8_t __attribute__((ext_vector_type(8)));
typedef short bf16x4_t __attribute__((ext_vector_type(4)));
typedef unsigned u32x4_t __attribute__((ext_vector_type(4)));
typedef unsigned u32x2_t __attribute__((ext_vector_type(2)));
typedef __bf16 bf2_t __attribute__((ext_vector_type(2)));
typedef float f2_t __attribute__((ext_vector_type(2)));
DI unsigned cvtpk(float lo, float hi) { const f2_t v = {lo, hi}; return __builtin_bit_cast(unsigned, __builtin_convertvector(v, bf2_t)); }
#define MFMA16(a, b, c) __builtin_amdgcn_mfma_f32_16x16x32_bf16((a), (b), (c), 0, 0, 0)

constexpr int AT_QS = 0, AT_QLD = 72;
constexpr int AT_KS = AT_QS + 128 * AT_QLD * 2;
constexpr int AT_VT = AT_KS + 272 * AT_QLD * 2, AT_VLD = 280;
constexpr int AT_BT = AT_VT + 64 * AT_VLD * 2;
constexpr int AT_END = AT_BT + 132 * 4;
static_assert(AT_END <= MISC_OFF, "attention LDS");

DI void attn_unit(const Args& A, LAS unsigned char* lds, int unit, int tid, int wave, int lane) {
    const bf16* Z = (const bf16*)(A.ws + WS_Z); bf16* ao = (bf16*)(A.ws + WS_ATTO); float* al = (float*)(A.ws + WS_ATTL);
    const int x = unit & 15; int r0 = unit >> 4; const int hh = r0 & 3; r0 >>= 2; const int b = r0 % NB, br = r0 / NB;
    const int dil = br == 0 ? 1 : (br == 1 ? 4 : 16), lsub = SEQ / dil, nblk = lsub / 128;
    const int res = x / nblk, nbk = x % nblk, l0 = nbk * 128, wbase = l0 - 64;
    LAS bf16* Qs = (LAS bf16*)(lds + AT_QS); LAS bf16* Ks = (LAS bf16*)(lds + AT_KS); LAS bf16* Vt = (LAS bf16*)(lds + AT_VT); LAS float* btab = (LAS float*)(lds + AT_BT);
    __syncthreads();
#pragma unroll
    for (int i = 0; i < 2; ++i) { const int id = tid + 512 * i, row = id >> 3, ch = id & 7; const int tok = b * SEQ + (l0 + row) * dil + res;
        *(LAS u32x4_t*)(Qs + row * AT_QLD + ch * 8) = *(const u32x4_t*)(Z + (size_t)tok * ZLD + ZA + hh * 64 + ch * 8); }
    for (int id = tid; id < 272 * 8; id += NTHR) { const int row = id >> 3, ch = id & 7; const int pos = wbase + row; u32x4_t v = (u32x4_t){0u, 0u, 0u, 0u};
        if (row < 256 && pos >= 0 && pos < lsub) v = *(const u32x4_t*)(Z + (size_t)(b * SEQ + pos * dil + res) * ZLD + ZA + 256 + hh * 64 + ch * 8);
        *(LAS u32x4_t*)(Ks + row * AT_QLD + ch * 8) = v; }
    for (int id = tid; id < 272 * 8; id += NTHR) { const int key = id % 272, ch = id / 272; const int pos = wbase + key; u32x4_t v = (u32x4_t){0u, 0u, 0u, 0u};
        if (key < 256 && pos >= 0 && pos < lsub) v = *(const u32x4_t*)(Z + (size_t)(b * SEQ + pos * dil + res) * ZLD + ZA + 512 + hh * 64 + ch * 8);
        LAS bf16* d = Vt + (ch * 8) * AT_VLD + key;
        d[0] = (bf16)(v.x & 0xffffu); d[AT_VLD] = (bf16)(v.x >> 16); d[2 * AT_VLD] = (bf16)(v.y & 0xffffu); d[3 * AT_VLD] = (bf16)(v.y >> 16);
        d[4 * AT_VLD] = (bf16)(v.z & 0xffffu); d[5 * AT_VLD] = (bf16)(v.z >> 16); d[6 * AT_VLD] = (bf16)(v.w & 0xffffu); d[7 * AT_VLD] = (bf16)(v.w >> 16); }
    if (tid < 129) btab[tid] = A.in[I_RELB][t5_bucket((tid - 64) * dil) * 4 + hh];
    __syncthreads();
    const int fr = lane & 15, qd = lane >> 4;
    f32x4 acc[10];
    { bf16x8_t qb[2];
#pragma unroll
      for (int ks = 0; ks < 2; ++ks) qb[ks] = *(const LAS bf16x8_t*)(Qs + (16 * wave + fr) * AT_QLD + ks * 32 + 8 * qd);
#pragma unroll
      for (int j = 0; j < 10; ++j) { acc[j] = (f32x4){0.f, 0.f, 0.f, 0.f};
#pragma unroll
          for (int ks = 0; ks < 2; ++ks) { const bf16x8_t ka = *(const LAS bf16x8_t*)(Ks + (16 * (wave + j) + fr) * AT_QLD + ks * 32 + 8 * qd); acc[j] = MFMA16(ka, qb[ks], acc[j]); } } }
    const int iq = 16 * wave + fr; float mx = -1.0e30f;
#pragma unroll
    for (int j = 0; j < 10; ++j)
#pragma unroll
        for (int r = 0; r < 4; ++r) { const int kw = 16 * (wave + j) + 4 * qd + r; const int m = kw - 64 - iq; const int pos = wbase + kw;
            const bool valid = (m >= -64) && (m <= 64) && (pos >= 0) && (pos < lsub);
            const float s = valid ? acc[j][r] * 0.125f + btab[valid ? m + 64 : 0] : -1.0e30f; acc[j][r] = s; mx = fmaxf(mx, s); }
    mx = fmaxf(mx, __shfl_xor(mx, 16)); mx = fmaxf(mx, __shfl_xor(mx, 32));
    float lsum = 0.f;
#pragma unroll
    for (int j = 0; j < 10; ++j)
#pragma unroll
        for (int r = 0; r < 4; ++r) { const float p = __expf(acc[j][r] - mx); acc[j][r] = p; lsum += p; }
    lsum += __shfl_xor(lsum, 16); lsum += __shfl_xor(lsum, 32);
    f32x4 oacc[4];
#pragma unroll
    for (int d = 0; d < 4; ++d) oacc[d] = (f32x4){0.f, 0.f, 0.f, 0.f};
#pragma unroll
    for (int pp = 0; pp < 5; ++pp) {
        union { unsigned u[4]; bf16x8_t v; } pb;
        pb.u[0] = cvtpk(acc[2 * pp][0], acc[2 * pp][1]); pb.u[1] = cvtpk(acc[2 * pp][2], acc[2 * pp][3]); pb.u[2] = cvtpk(acc[2 * pp + 1][0], acc[2 * pp + 1][1]); pb.u[3] = cvtpk(acc[2 * pp + 1][2], acc[2 * pp + 1][3]);
#pragma unroll
        for (int d = 0; d < 4; ++d) { const LAS bf16* vp = Vt + (16 * d + fr) * AT_VLD + 16 * (wave + 2 * pp) + 4 * qd;
            union { bf16x4_t h[2]; bf16x8_t v; } va; va.h[0] = *(const LAS bf16x4_t*)vp; va.h[1] = *(const LAS bf16x4_t*)(vp + 16);
            oacc[d] = MFMA16(va.v, pb.v, oacc[d]); } }
    const float inv = 1.f / lsum; const int tok = b * SEQ + (l0 + iq) * dil + res;
    bf16* op = ao + ((size_t)br * NT + tok) * AW + hh * 64 + 4 * qd;
#pragma unroll
    for (int d = 0; d < 4; ++d) { uint2 w; w.x = cvtpk(oacc[d][0] * inv, oacc[d][1] * inv); w.y = cvtpk(oacc[d][2] * inv, oacc[d][3] * inv); *(uint2*)(op + 16 * d) = w; }
    if (qd == 0) al[((size_t)br * NT + tok) * 4 + hh] = mx + logf(lsum);
}
constexpr int ATT_UNITS = 3 * NB * 4 * 16, ATT_SCAN_BLK0 = 160, ATT_SPLIT = ATT_UNITS / 2;
DI void phase_attn(const Args& A, LAS unsigned char* lds, int u0, int u1, int b0, int nb, int tid, int wave, int lane) {
    for (int u = u0 + b0; u < u1; u += nb) attn_unit(A, lds, u, tid, wave, lane);
    __syncthreads();
}


constexpr int ML_QLD = 104, ML_SLD = 72;
constexpr int ML_QS = 0;
constexpr int ML_QT = ML_QS + 64 * ML_QLD * 2;
constexpr int ML_KS = ML_QT + 64 * ML_QLD * 2;
constexpr int ML_KT = ML_KS + 64 * ML_QLD * 2;
constexpr int ML_VT = ML_KT + 96 * ML_SLD * 2;
constexpr int ML_WS = ML_VT + 112 * ML_SLD * 2;
constexpr int ML_CT = ML_WS + 64 * ML_SLD * 2;
constexpr int ML_CW = ML_CT + 112 * ML_QLD * 2;
constexpr int ML_END = ML_CW + 6 * 192 * 4;
static_assert(ML_END <= MISC_OFF, "mlstm LDS");

constexpr int MLP_QF = 0, MLP_NI = 12288, MLP_U = 26624, MLP_DEC = 48128, MLP_BYTES = 48384;
constexpr size_t WS_MLPKG = WS_R + 304 * MiB;
static_assert(WS_MLPKG + (size_t)2 * NB * 4 * 32 * MLP_BYTES <= WS_RKY, "mlstm package region");

struct M1Regs { u32x4_t zc[15]; u32x2_t vv[3]; float gi, gf; };
DI void mlstm_m1_fetch(const Args& A, int item, int tid, int lane, M1Regs& R) {
    const bf16* Z = (const bf16*)(A.ws + WS_Z);
    const int c = item & 31, u = item >> 5; const int dir = u / 32, b = (u % 32) / 4, hh = u % 4; const int j = tid >> 3, sub = tid & 7;
    const int tl = dir ? SEQ - 1 - (c * 64 + lane) : c * 64 + lane; const size_t tokl = (size_t)b * SEQ + tl;
    R.gi = bf2f(Z[tokl * ZLD + ZMG + dir * 8 + hh]); R.gf = bf2f(Z[tokl * ZLD + ZMG + dir * 8 + 4 + hh]);
    const int tj = dir ? SEQ - 1 - (c * 64 + j) : c * 64 + j; const size_t tokj = (size_t)b * SEQ + tj;
    const bool isk = sub >= 4; const int zcol = ZMQK + (isk ? 384 : 0) + hh * 96 + (sub & 3) * 24;
#pragma unroll
    for (int tap = 0; tap < 5; ++tap) { const int tt = tj + tap - 2; const bool ok = tt >= 0 && tt < SEQ; const u32x4_t* zp = (const u32x4_t*)(Z + ((size_t)b * SEQ + (ok ? tt : tj)) * ZLD + zcol);
#pragma unroll
        for (int q4 = 0; q4 < 3; ++q4) { const u32x4_t w = zp[q4]; R.zc[tap * 3 + q4] = ok ? w : (u32x4_t){0u, 0u, 0u, 0u}; } }
    const u32x2_t* vp = (const u32x2_t*)(Z + tokj * ZLD + ZMV + hh * 96 + sub * 12);
#pragma unroll
    for (int q2 = 0; q2 < 3; ++q2) R.vv[q2] = vp[q2];
}
DI void mlstm_m1_item(const Args& A, int l, LAS unsigned char* lds, int item, int item_next, M1Regs& R, int& hh_staged, int tid, int wave, int lane) {
    const int c = item & 31, u = item >> 5; const int dir = u / 32, hh = u % 4;
    LAS bf16* Qs = (LAS bf16*)(lds + ML_QS); LAS bf16* Qt = (LAS bf16*)(lds + ML_QT); LAS bf16* Ks = (LAS bf16*)(lds + ML_KS); LAS bf16* KtT = (LAS bf16*)(lds + ML_KT);
    LAS bf16* VtT = (LAS bf16*)(lds + ML_VT); LAS bf16* Ws = (LAS bf16*)(lds + ML_WS); LAS float* cwl = (LAS float*)(lds + ML_CW); LAS float* cbl = cwl + 5 * 192;
    const int fr = lane & 15, qd = lane >> 4;
    unsigned char* pkg = A.ws + WS_MLPKG + (size_t)item * MLP_BYTES;
    __syncthreads();
    if (hh != hh_staged) { hh_staged = hh;
        for (int i = tid; i < 5 * 192; i += NTHR) { const int tap = i / 192, ch = i % 192; cwl[i] = A.in[I_CW][(size_t)(l * 5 + tap) * 768 + (ch < 96 ? 0 : 384) + hh * 96 + (ch % 96)]; }
        for (int i = tid; i < 192; i += NTHR) cbl[i] = A.in[I_CB][(size_t)l * 768 + (i < 96 ? 0 : 384) + hh * 96 + (i % 96)];
        for (int i = tid; i < 16 * ML_SLD; i += NTHR) VtT[96 * ML_SLD + i] = (i < ML_SLD) ? (bf16)0x3F80u : (bf16)0u;
        __syncthreads(); }
    const float ibv = A.in[I_IB][(l * 2 + dir) * 4 + hh], fbv = A.in[I_FB][(l * 2 + dir) * 4 + hh];
    const int j = tid >> 3, sub = tid & 7;
    const float gi = R.gi + ibv, gf = R.gf + fbv;
    float bsum = fminf(gf, 0.f) - __logf(1.f + __expf(-fabsf(gf)));
#pragma unroll
    for (int o = 1; o < 64; o <<= 1) { const float t = __shfl_up(bsum, o); if (lane >= o) bsum += t; }
    const float bend = __shfl(bsum, 63);
    const float bj = __shfl(bsum, j), igj = __shfl(gi, j);
    { const bool isk = sub >= 4; const int c0 = (sub & 3) * 24, cl = (isk ? 96 : 0) + c0;
      float acc[24];
#pragma unroll
      for (int e = 0; e < 24; ++e) acc[e] = cbl[cl + e];
#pragma unroll
      for (int tap = 0; tap < 5; ++tap) {
#pragma unroll
          for (int q4 = 0; q4 < 3; ++q4) { const u32x4_t w = R.zc[tap * 3 + q4]; const LAS float* cwp = cwl + tap * 192 + cl + q4 * 8;
              acc[q4 * 8 + 0] += cwp[0] * __uint_as_float(w.x << 16); acc[q4 * 8 + 1] += cwp[1] * __uint_as_float(w.x & 0xffff0000u);
              acc[q4 * 8 + 2] += cwp[2] * __uint_as_float(w.y << 16); acc[q4 * 8 + 3] += cwp[3] * __uint_as_float(w.y & 0xffff0000u);
              acc[q4 * 8 + 4] += cwp[4] * __uint_as_float(w.z << 16); acc[q4 * 8 + 5] += cwp[5] * __uint_as_float(w.z & 0xffff0000u);
              acc[q4 * 8 + 6] += cwp[6] * __uint_as_float(w.w << 16); acc[q4 * 8 + 7] += cwp[7] * __uint_as_float(w.w & 0xffff0000u); } }
      const float sc1 = isk ? 0.10206207261596575f : 1.f; const float sc2 = isk ? __expf(bend - bj + igj) : __expf(bj);
#pragma unroll
      for (int e = 0; e < 24; ++e) acc[e] = acc[e] * sigm(acc[e]) * sc1;
      if (!isk) { LAS bf16* d1 = Qs + j * ML_QLD + c0; LAS bf16* d2 = Qt + j * ML_QLD + c0;
#pragma unroll
          for (int q4 = 0; q4 < 3; ++q4) { u32x4_t w; w.x = cvtpk(acc[q4 * 8 + 0], acc[q4 * 8 + 1]); w.y = cvtpk(acc[q4 * 8 + 2], acc[q4 * 8 + 3]); w.z = cvtpk(acc[q4 * 8 + 4], acc[q4 * 8 + 5]); w.w = cvtpk(acc[q4 * 8 + 6], acc[q4 * 8 + 7]);
              *(LAS u32x4_t*)(d1 + q4 * 8) = w;
              u32x4_t x; x.x = cvtpk(acc[q4 * 8 + 0] * sc2, acc[q4 * 8 + 1] * sc2); x.y = cvtpk(acc[q4 * 8 + 2] * sc2, acc[q4 * 8 + 3] * sc2); x.z = cvtpk(acc[q4 * 8 + 4] * sc2, acc[q4 * 8 + 5] * sc2); x.w = cvtpk(acc[q4 * 8 + 6] * sc2, acc[q4 * 8 + 7] * sc2);
              *(LAS u32x4_t*)(d2 + q4 * 8) = x; } }
      else { LAS bf16* d1 = Ks + j * ML_QLD + c0;
#pragma unroll
          for (int q4 = 0; q4 < 3; ++q4) { u32x4_t w; w.x = cvtpk(acc[q4 * 8 + 0], acc[q4 * 8 + 1]); w.y = cvtpk(acc[q4 * 8 + 2], acc[q4 * 8 + 3]); w.z = cvtpk(acc[q4 * 8 + 4], acc[q4 * 8 + 5]); w.w = cvtpk(acc[q4 * 8 + 6], acc[q4 * 8 + 7]);
              *(LAS u32x4_t*)(d1 + q4 * 8) = w; }
#pragma unroll
          for (int e = 0; e < 24; ++e) KtT[(c0 + e) * ML_SLD + j] = (bf16)f2bf(acc[e] * sc2); } }
    { const int n0 = sub * 12;
#pragma unroll
      for (int q2 = 0; q2 < 3; ++q2) { const u32x2_t w = R.vv[q2]; LAS bf16* d = VtT + (n0 + q2 * 4) * ML_SLD + j;
          d[0] = (bf16)(w.x & 0xffffu); d[ML_SLD] = (bf16)(w.x >> 16); d[2 * ML_SLD] = (bf16)(w.y & 0xffffu); d[3 * ML_SLD] = (bf16)(w.y >> 16); } }
    if (item_next >= 0) mlstm_m1_fetch(A, item_next, tid, lane, R);
    __syncthreads();
#pragma unroll
    for (int i = 0; i < 2; ++i) { const int tile = 2 * wave + i, jt = tile >> 2, st = tile & 3; const int jq = 16 * jt + fr;
        u32x2_t w = (u32x2_t){0u, 0u};
        if (st <= jt) { f32x4 acc = (f32x4){0.f, 0.f, 0.f, 0.f};
#pragma unroll
            for (int ks = 0; ks < 3; ++ks) { const bf16x8_t a = *(const LAS bf16x8_t*)(Ks + (16 * st + fr) * ML_QLD + 32 * ks + 8 * qd); const bf16x8_t bq = *(const LAS bf16x8_t*)(Qs + jq * ML_QLD + 32 * ks + 8 * qd); acc = MFMA16(a, bq, acc); }
            const float bjq = __shfl(bsum, jq); float wv[4];
#pragma unroll
            for (int r = 0; r < 4; ++r) { const int s = 16 * st + 4 * qd + r; const float bs = __shfl(bsum, s), igs = __shfl(gi, s); wv[r] = (s <= jq) ? acc[r] * __expf(bjq - bs + igs) : 0.f; }
            w.x = cvtpk(wv[0], wv[1]); w.y = cvtpk(wv[2], wv[3]); }
        *(LAS u32x2_t*)(Ws + jq * ML_SLD + 16 * st + 4 * qd) = w; }
    __syncthreads();
    for (int id = wave; id < 12; id += NWAVES) { const int jt = id / 3, i3 = id % 3; const LAS bf16* p = Qt + (16 * jt + fr) * ML_QLD + 32 * i3 + 4 * qd; const u32x2_t lo = *(const LAS u32x2_t*)p, hi = *(const LAS u32x2_t*)(p + 16);
        *(u32x4_t*)(pkg + MLP_QF + (size_t)id * 1024 + lane * 16) = (u32x4_t){lo.x, lo.y, hi.x, hi.y}; }
    for (int id = wave; id < 70; id += NWAVES) { f32x4 acc = (f32x4){0.f, 0.f, 0.f, 0.f}; int nt; const LAS bf16* ap; int ald; unsigned char* dst;
        if (id < 28) { const int jt = id & 3; nt = id >> 2; ap = Ws + (16 * jt + fr) * ML_SLD; ald = 0; dst = pkg + MLP_NI + (size_t)(nt * 4 + jt) * 512; }
        else { const int q = id - 28, kt = q % 6; nt = q / 6; ap = KtT + (16 * kt + fr) * ML_SLD; ald = 0; dst = pkg + MLP_U + (size_t)(nt * 6 + kt) * 512; }
#pragma unroll
        for (int ks = 0; ks < 2; ++ks) { const bf16x8_t a = *(const LAS bf16x8_t*)(ap + 32 * ks + 8 * qd); const bf16x8_t bv = *(const LAS bf16x8_t*)(VtT + (16 * nt + fr) * ML_SLD + 32 * ks + 8 * qd); acc = MFMA16(a, bv, acc); }
        u32x2_t w; w.x = cvtpk(acc[0], acc[1]); w.y = cvtpk(acc[2], acc[3]); *(u32x2_t*)(dst + lane * 8) = w; }
    if (tid < 64) ((float*)(pkg + MLP_DEC))[tid] = __expf(bend);
}
DI void phase_mlstm_m1(const Args& A, int l, LAS unsigned char* lds, int bid, int G, int tid, int wave, int lane) {
    int hh_staged = -1; constexpr int NIT = 2 * NB * 4 * 32;
    if (bid < NIT) { M1Regs R; mlstm_m1_fetch(A, bid, tid, lane, R);
        for (int it = bid; it < NIT; it += G) mlstm_m1_item(A, l, lds, it, (it + G < NIT) ? it + G : -1, R, hh_staged, tid, wave, lane); }
    __syncthreads();
}
constexpr int M2_SLOTS = 8, M2_SLOT_BYTES = 12288, M2_CTL = M2_SLOTS * M2_SLOT_BYTES;
static_assert(M2_CTL + 64 <= MISC_OFF, "mlstm m2 LDS");
DI f32x4 unpk4(const u32x2_t w) { return (f32x4){__uint_as_float(w.x << 16), __uint_as_float(w.x & 0xffff0000u), __uint_as_float(w.y << 16), __uint_as_float(w.y & 0xffff0000u)}; }
struct M2Small { u32x2_t ni[4], uu[6]; float dec; };
DI void m2_load_small(M2Small& o, const unsigned char* pkg, int nt, int lane) {
#pragma unroll
    for (int jt = 0; jt < 4; ++jt) o.ni[jt] = *(const u32x2_t*)(pkg + MLP_NI + (nt * 4 + jt) * 512 + lane * 8);
#pragma unroll
    for (int kt = 0; kt < 6; ++kt) o.uu[kt] = *(const u32x2_t*)(pkg + MLP_U + (nt * 6 + kt) * 512 + lane * 8);
    o.dec = ((const float*)(pkg + MLP_DEC))[lane];
}
DI void m2_step(const M2Small& o, const LAS unsigned char* slot, f32x4 (&C)[6], bf16* num, float* den, int dir, int b, int hh, int nt, int c, int lane, int fr, int qd) {
    union { unsigned u[4]; bf16x8_t v; } sB[3];
#pragma unroll
    for (int i = 0; i < 3; ++i) { sB[i].u[0] = cvtpk(C[2 * i][0], C[2 * i][1]); sB[i].u[1] = cvtpk(C[2 * i][2], C[2 * i][3]); sB[i].u[2] = cvtpk(C[2 * i + 1][0], C[2 * i + 1][1]); sB[i].u[3] = cvtpk(C[2 * i + 1][2], C[2 * i + 1][3]); }
#pragma unroll
    for (int jt = 0; jt < 4; ++jt) { f32x4 acc = unpk4(o.ni[jt]);
#pragma unroll
        for (int i = 0; i < 3; ++i) { const bf16x8_t qf = *(const LAS bf16x8_t*)(slot + (3 * jt + i) * 1024 + lane * 16); acc = MFMA16(qf, sB[i].v, acc); }
#pragma unroll
        for (int r = 0; r < 4; ++r) { const int jj = 16 * jt + 4 * qd + r; const int tt = dir ? SEQ - 1 - (c * 64 + jj) : c * 64 + jj; const size_t tok = (size_t)b * SEQ + tt;
            if (nt < 6) num[((size_t)dir * NT + tok) * MW + hh * 96 + 16 * nt + fr] = (bf16)f2bf(acc[r]); else if (fr == 0) den[((size_t)dir * NT + tok) * 4 + hh] = acc[r]; } }
#pragma unroll
    for (int kt = 0; kt < 6; ++kt) C[kt] = C[kt] * o.dec + unpk4(o.uu[kt]);
}
DI void mlstm_m2_unit(const Args& A, LAS unsigned char* lds, int u, int tid, int wave, int lane) {
    bf16* num = (bf16*)(A.ws + WS_MLNUM); float* den = (float*)(A.ws + WS_MLDEN);
    const int dir = u / 32, b = (u % 32) / 4, hh = u % 4; const int fr = lane & 15, qd = lane >> 4;
    const unsigned char* pkg0 = A.ws + WS_MLPKG + (size_t)u * 32 * MLP_BYTES;
    volatile LAS unsigned* ready = (volatile LAS unsigned*)(lds + M2_CTL); volatile LAS unsigned* consumed = ready + 8;
    __syncthreads();
    if (tid < 16) ready[tid] = 0u;
    __syncthreads();
    if (wave == 7) {
        u32x4_t f0[12], f1[12], f2[12];
#define M2_FETCH(dst, c_) do { _Pragma("unroll") for (int i = 0; i < 12; ++i) dst[i] = *(const u32x4_t*)(pkg0 + (size_t)(c_) * MLP_BYTES + MLP_QF + i * 1024 + lane * 16); } while (0)
#define M2_PUBLISH(src, c_) do { if ((c_) >= M2_SLOTS) { const unsigned need = (unsigned)((c_) - M2_SLOTS + 1); unsigned spins = 0; \
            for (;;) { bool ok = true; _Pragma("unroll") for (int w = 0; w < 7; ++w) ok = ok && (consumed[w] >= need); if (ok) break; if (++spins > (1u << 22)) break; __builtin_amdgcn_s_sleep(1); } } \
        LAS unsigned char* slot_ = lds + ((c_) & (M2_SLOTS - 1)) * M2_SLOT_BYTES; _Pragma("unroll") for (int i = 0; i < 12; ++i) *(LAS u32x4_t*)(slot_ + i * 1024 + lane * 16) = src[i]; \
        asm volatile("s_waitcnt lgkmcnt(0)" ::: "memory"); if (lane == 0) ready[(c_) & (M2_SLOTS - 1)] = (unsigned)((c_) + 1); asm volatile("" ::: "memory"); } while (0)
        M2_FETCH(f0, 0); M2_FETCH(f1, 1);
        for (int c = 0; c < 30; c += 3) { M2_FETCH(f2, c + 2); M2_PUBLISH(f0, c); M2_FETCH(f0, c + 3); M2_PUBLISH(f1, c + 1); M2_FETCH(f1, c + 4); M2_PUBLISH(f2, c + 2); }
        M2_PUBLISH(f0, 30); M2_PUBLISH(f1, 31);
#undef M2_FETCH
#undef M2_PUBLISH
    } else {
        const int nt = wave; f32x4 C[6];
#pragma unroll
        for (int kt = 0; kt < 6; ++kt) C[kt] = (f32x4){0.f, 0.f, 0.f, 0.f};
        M2Small s0, s1, s2, s3;
        m2_load_small(s0, pkg0, nt, lane); m2_load_small(s1, pkg0 + MLP_BYTES, nt, lane); m2_load_small(s2, pkg0 + 2 * (size_t)MLP_BYTES, nt, lane); m2_load_small(s3, pkg0 + 3 * (size_t)MLP_BYTES, nt, lane);
#define M2_CHAIN(sx, c_) do { unsigned spins = 0; while (ready[(c_) & (M2_SLOTS - 1)] != (unsigned)((c_) + 1)) { if (++spins > (1u << 22)) break; __builtin_amdgcn_s_sleep(1); } asm volatile("" ::: "memory"); \
            m2_step(sx, lds + ((c_) & (M2_SLOTS - 1)) * M2_SLOT_BYTES, C, num, den, dir, b, hh, nt, (c_), lane, fr, qd); \
            asm volatile("s_waitcnt lgkmcnt(0)" ::: "memory"); if (lane == 0) consumed[nt] = (unsigned)((c_) + 1); asm volatile("" ::: "memory"); \
            if ((c_) + 4 < 32) m2_load_small(sx, pkg0 + (size_t)((c_) + 4) * MLP_BYTES, nt, lane); } while (0)
        for (int c = 0; c < 32; c += 4) { M2_CHAIN(s0, c); M2_CHAIN(s1, c + 1); M2_CHAIN(s2, c + 2); M2_CHAIN(s3, c + 3); }
#undef M2_CHAIN
    }
    __syncthreads();
}

constexpr int PKG_BYTES = 12544;
constexpr int PK_AH = 0, PK_RH = 2048, PK_KB = 4096, PK_VV = 8192, PK_TM = 10240, PK_MM = 10752, PK_LAK = 11776, PK_GE = 12288;
constexpr size_t WS_PKG = WS_PR;
static_assert((size_t)2 * NB * 6 * 128 * PKG_BYTES <= 288 * MiB, "package region");
constexpr int R1_W2T = 0, R1_A2T = 9216, R1_WV = 18432, R1_WV_BYTES = 12928;
constexpr int R1_IMG = 0, R1_LF = 9216, R1_MT = 10368;
static_assert(R1_WV + 8 * R1_WV_BYTES <= MISC_OFF, "rwkv r1 LDS");

DI bf16x4_t pack4(const f32x4 v) { union { unsigned u[2]; bf16x4_t h; } x; x.u[0] = cvtpk(v[0], v[1]); x.u[1] = cvtpk(v[2], v[3]); return x.h; }

DI void rwkv_r1_item(const Args& A, int l, LAS unsigned char* lds, int item, int& dh_staged, int tid, int wave, int lane) {
    const bf16* Z = (const bf16*)(A.ws + WS_Z);
    const int g = item & 15; int r0 = item >> 4; const int hh = r0 % 6; r0 /= 6; const int b = r0 % NB, dir = r0 / NB;
    const int cc = 8 * g + wave, fr = lane & 15, qd = lane >> 4;
    LAS bf16* W2T = (LAS bf16*)(lds + R1_W2T); LAS bf16* A2T = (LAS bf16*)(lds + R1_A2T);
    LAS unsigned char* wv = lds + R1_WV + wave * R1_WV_BYTES;
    LAS bf16* IMG = (LAS bf16*)(wv + R1_IMG); LAS float* Lf = (LAS float*)(wv + R1_LF); LAS bf16* MT = (LAS bf16*)(wv + R1_MT);
    if (dh_staged != dir * 6 + hh) { dh_staged = dir * 6 + hh;
    __syncthreads();
    { const int ch = tid & 63, i0 = (tid >> 6) * 8; const float* w2 = A.in[I_W2] + ((size_t)(l * 2 + dir) * 64 + i0) * RW + hh * 64 + ch; const float* a2 = A.in[I_A2] + ((size_t)(l * 2 + dir) * 64 + i0) * RW + hh * 64 + ch;
      u32x4_t pw, pa; pw.x = cvtpk(w2[0], w2[RW]); pw.y = cvtpk(w2[2 * RW], w2[3 * RW]); pw.z = cvtpk(w2[4 * RW], w2[5 * RW]); pw.w = cvtpk(w2[6 * RW], w2[7 * RW]);
      pa.x = cvtpk(a2[0], a2[RW]); pa.y = cvtpk(a2[2 * RW], a2[3 * RW]); pa.z = cvtpk(a2[4 * RW], a2[5 * RW]); pa.w = cvtpk(a2[6 * RW], a2[7 * RW]);
      *(LAS u32x4_t*)(W2T + ch * 72 + i0) = pw; *(LAS u32x4_t*)(A2T + ch * 72 + i0) = pa; }
    __syncthreads(); }
    const int sgn = dir ? -1 : 1; const int tok0 = b * SEQ + (dir ? SEQ - 1 - 16 * cc : 16 * cc);
    const float* mu = A.in[I_MU] + (size_t)(l * 2 + dir) * 1280;
    float er[4][4], ek[4][4], ev[4][4], pr4[4], pk4[4], pv4[4];
    { const bool ext = (qd == 0) && (cc > 0); const size_t prow = (size_t)(ext ? tok0 - sgn : tok0 + sgn * (4 * qd)) * ZLD;
#pragma unroll
      for (int nt = 0; nt < 4; ++nt) {
#pragma unroll
          for (int r = 0; r < 4; ++r) { const bf16* zp = Z + (size_t)(tok0 + sgn * (4 * qd + r)) * ZLD + ZRKV + hh * 64 + 16 * nt + fr; er[nt][r] = bf2f(zp[0]); ek[nt][r] = bf2f(zp[RW]); ev[nt][r] = bf2f(zp[2 * RW]); }
          const bf16* zq = Z + prow + ZRKV + hh * 64 + 16 * nt + fr; pr4[nt] = bf2f(zq[0]); pk4[nt] = bf2f(zq[RW]); pv4[nt] = bf2f(zq[2 * RW]); }
      asm volatile("" : "+v"(er[0][0]), "+v"(pr4[3]));
#pragma unroll
      for (int nt = 0; nt < 4; ++nt) {
        float pr = __shfl(er[nt][3], lane - 16), pk = __shfl(ek[nt][3], lane - 16), pv = __shfl(ev[nt][3], lane - 16);
        if (qd == 0) { pr = ext ? pr4[nt] : 0.f; pk = ext ? pk4[nt] : 0.f; pv = ext ? pv4[nt] : 0.f; }
        const float mr = mu[hh * 64 + 16 * nt + fr], mk = mu[RW + hh * 64 + 16 * nt + fr], mv = mu[2 * RW + hh * 64 + 16 * nt + fr];
#pragma unroll
        for (int r = 3; r >= 0; --r) { const float qr = r ? er[nt][r - 1] : pr, qk = r ? ek[nt][r - 1] : pk, qv = r ? ev[nt][r - 1] : pv;
            er[nt][r] += mr * (qr - er[nt][r]); ek[nt][r] += mk * (qk - ek[nt][r]); ev[nt][r] += mv * (qv - ev[nt][r]); }
      } }
    bf16x8_t thA[2], adA[2];
    { const int zwd = dir ? ZWDB : ZWDF, zad = dir ? ZADB : ZADF; const bool hasp = !(cc == 0 && fr == 0);
      const bf16* zc = Z + (size_t)(tok0 + sgn * fr) * ZLD; const bf16* zq = Z + (size_t)(tok0 + sgn * (fr - 1)) * ZLD;
#pragma unroll
      for (int ks = 0; ks < 2; ++ks) { float cw[8], pw[8], ca[8], pa[8];
          unpack8(*(const uint4*)(zc + zwd + 32 * ks + 8 * qd), cw); unpack8(*(const uint4*)(zc + zad + 32 * ks + 8 * qd), ca);
          if (hasp) { unpack8(*(const uint4*)(zq + zwd + 32 * ks + 8 * qd), pw); unpack8(*(const uint4*)(zq + zad + 32 * ks + 8 * qd), pa); }
          else {
#pragma unroll
              for (int e = 0; e < 8; ++e) { pw[e] = 0.f; pa[e] = 0.f; } }
          const float* muw = mu + 1152 + 32 * ks + 8 * qd; const float* mua = mu + 1216 + 32 * ks + 8 * qd;
#pragma unroll
          for (int e = 0; e < 8; ++e) { const float xw = cw[e] + muw[e] * (pw[e] - cw[e]); cw[e] = 1.f - 2.f * __builtin_amdgcn_rcpf(1.f + __expf(2.f * xw)); ca[e] = ca[e] + mua[e] * (pa[e] - ca[e]); }
          union { unsigned u[4]; bf16x8_t v; } x, y;
#pragma unroll
          for (int e = 0; e < 4; ++e) { x.u[e] = cvtpk(cw[2 * e], cw[2 * e + 1]); y.u[e] = cvtpk(ca[2 * e], ca[2 * e + 1]); }
          thA[ks] = x.v; adA[ks] = y.v; } }
    f32x4 wl[4], al[4];
#pragma unroll
    for (int nt = 0; nt < 4; ++nt) { wl[nt] = (f32x4){0.f, 0.f, 0.f, 0.f}; al[nt] = (f32x4){0.f, 0.f, 0.f, 0.f};
#pragma unroll
        for (int ks = 0; ks < 2; ++ks) { const bf16x8_t bw = *(const LAS bf16x8_t*)(W2T + (16 * nt + fr) * 72 + 32 * ks + 8 * qd); const bf16x8_t ba = *(const LAS bf16x8_t*)(A2T + (16 * nt + fr) * 72 + 32 * ks + 8 * qd);
            wl[nt] = MFMA16(thA[ks], bw, wl[nt]); al[nt] = MFMA16(adA[ks], ba, al[nt]); } }
    float lw[4][4], alp[4][4], kap[4][4]; float ssq[4] = {0.f, 0.f, 0.f, 0.f}, bsm[4] = {0.f, 0.f, 0.f, 0.f};
#pragma unroll
    for (int nt = 0; nt < 4; ++nt) { const int ch = hh * 64 + 16 * nt + fr;
        const float w0v = A.in[I_W0][(size_t)(l * 2 + dir) * RW + ch], a0v = A.in[I_A0][(size_t)(l * 2 + dir) * RW + ch], kkw = A.in[I_KK][(size_t)l * RW + ch], kaw = A.in[I_KA][(size_t)l * RW + ch], rkw = A.in[I_RK][(size_t)l * RW + ch];
#pragma unroll
        for (int r = 0; r < 4; ++r) { const float x = w0v + wl[nt][r]; const float nx = -x; const float sp = fmaxf(nx, 0.f) + __logf(1.f + __expf(-fabsf(nx)));
            lw[nt][r] = -__expf(-sp - 0.5f);
            const float a = __builtin_amdgcn_rcpf(1.f + __expf(-(a0v + al[nt][r]))); alp[nt][r] = a;
            const float k0 = ek[nt][r]; kap[nt][r] = k0 * kkw; ek[nt][r] = k0 * (1.f + (a - 1.f) * kaw);
            ssq[r] += kap[nt][r] * kap[nt][r]; bsm[r] += er[nt][r] * ek[nt][r] * rkw; } }
#pragma unroll
    for (int r = 0; r < 4; ++r) {
#pragma unroll
        for (int o = 1; o < 16; o <<= 1) { ssq[r] += __shfl_xor(ssq[r], o); bsm[r] += __shfl_xor(bsm[r], o); }
        ssq[r] = __builtin_amdgcn_rsqf(fmaxf(ssq[r], 1e-24f)); }
    { bf16* bon = (bf16*)(A.ws + WS_RKB);
#pragma unroll
      for (int nt = 0; nt < 4; ++nt)
#pragma unroll
          for (int r = 0; r < 4; ++r) { kap[nt][r] *= ssq[r]; bon[((size_t)dir * NT + tok0 + sgn * (4 * qd + r)) * RW + hh * 64 + 16 * nt + fr] = (bf16)f2bf(bsm[r] * ev[nt][r]); } }
    unsigned char* pkg = A.ws + WS_PKG + ((size_t)((dir * NB + b) * 6 + hh) * 128 + cc) * PKG_BYTES;
    float lend[4];
    u32x2_t btf[4], ktf[4];
#pragma unroll
    for (int nt = 0; nt < 4; ++nt) { float lam[4]; lam[0] = lw[nt][0]; lam[1] = lam[0] + lw[nt][1]; lam[2] = lam[1] + lw[nt][2]; lam[3] = lam[2] + lw[nt][3];
        const float t1 = __shfl(lam[3], lane - 16), t2 = __shfl(lam[3], lane - 32), t3 = __shfl(lam[3], lane - 48);
        const float off = (qd >= 1 ? t1 : 0.f) + (qd >= 2 ? t2 : 0.f) + (qd >= 3 ? t3 : 0.f);
#pragma unroll
        for (int r = 0; r < 4; ++r) lam[r] += off;
        lend[nt] = __shfl(lam[3], 48 + fr);
        float bt4[4], kt4[4];
        float epv[4];
#pragma unroll
        for (int r = 0; r < 4; ++r) epv[r] = __expf(lam[r]);
        float ep_prev = __shfl(epv[3], lane - 16); if (qd == 0) ep_prev = 1.f;
        const float eendall = __expf(lend[nt]);
#pragma unroll
        for (int r = 0; r < 4; ++r) { const float ep = epv[r], epm = r ? epv[r - 1] : ep_prev, einv = __builtin_amdgcn_rcpf(ep), eend = eendall * einv;
            const float bb = kap[nt][r] * alp[nt][r]; const int o = (4 * qd + r) * 72 + 16 * nt + fr;
            IMG[o] = (bf16)f2bf(-kap[nt][r] * epm); IMG[1152 + o] = (bf16)f2bf(er[nt][r] * ep); IMG[2304 + o] = (bf16)f2bf(bb * einv); IMG[3456 + o] = (bf16)f2bf(ek[nt][r] * einv);
            bt4[r] = bb * eend; kt4[r] = ek[nt][r] * eend; }
        btf[nt].x = cvtpk(bt4[0], bt4[1]); btf[nt].y = cvtpk(bt4[2], bt4[3]); ktf[nt].x = cvtpk(kt4[0], kt4[1]); ktf[nt].y = cvtpk(kt4[2], kt4[3]); }
    asm volatile("s_waitcnt lgkmcnt(0)" ::: "memory");
    f32x4 Lab = (f32x4){0.f, 0.f, 0.f, 0.f}, Lak = Lab, Mrb = Lab, Mrk = Lab;
#pragma unroll
    for (int ks = 0; ks < 2; ++ks) { const int o = fr * 72 + 32 * ks + 8 * qd;
        const bf16x8_t aA = *(const LAS bf16x8_t*)(IMG + o), aR = *(const LAS bf16x8_t*)(IMG + 1152 + o), bB = *(const LAS bf16x8_t*)(IMG + 2304 + o), bK = *(const LAS bf16x8_t*)(IMG + 3456 + o);
        Lab = MFMA16(aA, bB, Lab); Lak = MFMA16(aA, bK, Lak); Mrb = MFMA16(aR, bB, Mrb); Mrk = MFMA16(aR, bK, Mrk); }
#pragma unroll
    for (int r = 0; r < 4; ++r) { const int t = 4 * qd + r; if (!(fr < t)) { Lab[r] = 0.f; Lak[r] = 0.f; } if (!(fr <= t)) { Mrb[r] = 0.f; Mrk[r] = 0.f; } Lf[t * 17 + fr] = Lab[r]; }
    asm volatile("s_waitcnt lgkmcnt(0)" ::: "memory");
    float Tc[16];
#pragma unroll
    for (int t = 0; t < 16; ++t) { float acc = (t == fr) ? 1.f : 0.f;
#pragma unroll
        for (int s = 0; s < t; ++s) acc += Lf[t * 17 + s] * Tc[s];
        Tc[t] = acc; }
    f32x4 Tm;
#pragma unroll
    for (int r = 0; r < 4; ++r) Tm[r] = qd == 0 ? Tc[r] : (qd == 1 ? Tc[4 + r] : (qd == 2 ? Tc[8 + r] : Tc[12 + r]));
#pragma unroll
    for (int r = 0; r < 4; ++r) { const int o = (4 * qd + r) * 20 + fr; MT[o] = (bf16)f2bf(Tm[r]); MT[320 + o] = (bf16)f2bf(Mrb[r]); MT[640 + o] = (bf16)f2bf(Lak[r]); MT[960 + o] = (bf16)f2bf(Mrk[r]); }
    asm volatile("s_waitcnt lgkmcnt(0)" ::: "memory");
    { const int o = fr * 20 + 4 * qd;
      const u32x2_t mrb = *(const LAS u32x2_t*)(MT + 320 + o), mrk = *(const LAS u32x2_t*)(MT + 960 + o);
      *(u32x2_t*)(pkg + PK_TM + lane * 8) = *(const LAS u32x2_t*)(MT + o); *(u32x2_t*)(pkg + PK_LAK + lane * 8) = *(const LAS u32x2_t*)(MT + 640 + o);
      *(u32x4_t*)(pkg + PK_MM + lane * 16) = (u32x4_t){mrk.x, mrk.y, mrb.x, mrb.y}; }
#pragma unroll
    for (int ks = 0; ks < 2; ++ks) { const int o = fr * 72 + 32 * ks + 4 * qd;
        const u32x2_t alo = *(const LAS u32x2_t*)(IMG + o), ahi = *(const LAS u32x2_t*)(IMG + o + 16), rlo = *(const LAS u32x2_t*)(IMG + 1152 + o), rhi = *(const LAS u32x2_t*)(IMG + 1152 + o + 16);
        *(u32x4_t*)(pkg + PK_AH + ks * 1024 + lane * 16) = (u32x4_t){alo.x, alo.y, ahi.x, ahi.y}; *(u32x4_t*)(pkg + PK_RH + ks * 1024 + lane * 16) = (u32x4_t){rlo.x, rlo.y, rhi.x, rhi.y}; }
#pragma unroll
    for (int nt = 0; nt < 4; ++nt) { *(u32x4_t*)(pkg + PK_KB + nt * 1024 + lane * 16) = (u32x4_t){ktf[nt].x, ktf[nt].y, btf[nt].x, btf[nt].y};
        u32x2_t vf; vf.x = cvtpk(ev[nt][0], ev[nt][1]); vf.y = cvtpk(ev[nt][2], ev[nt][3]); *(u32x2_t*)(pkg + PK_VV + nt * 512 + lane * 8) = vf;
        if (qd == 0) ((float*)(pkg + PK_GE))[16 * nt + fr] = __expf(lend[nt]); }
    asm volatile("s_waitcnt lgkmcnt(0)" ::: "memory");
}
DI void phase_rwkv_r1(const Args& A, int l, LAS unsigned char* lds, int bid, int G, int tid, int wave, int lane) {
    constexpr int NIT = 2 * NB * 6 * 16; int dh_staged = -1;
    __syncthreads();
    for (int it = bid; it < NIT; it += G) rwkv_r1_item(A, l, lds, it, dh_staged, tid, wave, lane);
    __syncthreads();
}

struct RkOps { bf16x8_t ah[2], rh[2], kb[4], mm; bf16x4_t vv, tm, lak; f32x4 ge[4]; };
DI bf16x8_t widen4(const bf16x4_t a) { return __builtin_shufflevector(a, (bf16x4_t){0, 0, 0, 0}, 0, 1, 2, 3, 4, 5, 6, 7); }
DI void rk_step(const RkOps& c, f32x4 (&sT)[4], bf16* yb, int dir, int b, int hh, int vb, int cc, int fr, int qd) {
    const f32x4 zero4 = (f32x4){0.f, 0.f, 0.f, 0.f};
    union { unsigned u[4]; bf16x8_t v; } s0, s1;
    s0.u[0] = cvtpk(sT[0][0], sT[0][1]); s0.u[1] = cvtpk(sT[0][2], sT[0][3]); s0.u[2] = cvtpk(sT[1][0], sT[1][1]); s0.u[3] = cvtpk(sT[1][2], sT[1][3]);
    s1.u[0] = cvtpk(sT[2][0], sT[2][1]); s1.u[1] = cvtpk(sT[2][2], sT[2][3]); s1.u[2] = cvtpk(sT[3][0], sT[3][1]); s1.u[3] = cvtpk(sT[3][2], sT[3][3]);
    f32x4 ax = MFMA16(widen4(c.lak), widen4(c.vv), zero4); ax = MFMA16(c.ah[0], s0.v, ax); ax = MFMA16(c.ah[1], s1.v, ax);
    f32x4 ay = MFMA16(c.rh[0], s0.v, zero4); ay = MFMA16(c.rh[1], s1.v, ay);
    const f32x4 au = MFMA16(widen4(c.tm), widen4(pack4(ax)), zero4);
    const bf16x8_t vu = __builtin_shufflevector(c.vv, pack4(au), 0, 1, 2, 3, 4, 5, 6, 7);
    ay = MFMA16(c.mm, vu, ay);
#pragma unroll
    for (int kt = 0; kt < 4; ++kt) sT[kt] = MFMA16(c.kb[kt], vu, sT[kt] * c.ge[kt]);
    const int sgn = dir ? -1 : 1; const int tok0 = b * SEQ + (dir ? SEQ - 1 - 16 * cc : 16 * cc);
#pragma unroll
    for (int r = 0; r < 4; ++r) yb[((size_t)dir * NT + tok0 + sgn * (4 * qd + r)) * RW + hh * 64 + 16 * vb + fr] = (bf16)f2bf(ay[r]);
}
constexpr int R2_SLOTS = 8, R2_CTL = R2_SLOTS * PKG_BYTES;
static_assert(R2_CTL + 64 <= MISC_OFF, "rwkv r2 LDS");
DI void rk_load_lds(RkOps& o, const LAS unsigned char* pkg, int vb, int lane, int qd) {
#pragma unroll
    for (int ks = 0; ks < 2; ++ks) { o.ah[ks] = *(const LAS bf16x8_t*)(pkg + PK_AH + ks * 1024 + lane * 16); o.rh[ks] = *(const LAS bf16x8_t*)(pkg + PK_RH + ks * 1024 + lane * 16); }
#pragma unroll
    for (int kt = 0; kt < 4; ++kt) { o.kb[kt] = *(const LAS bf16x8_t*)(pkg + PK_KB + kt * 1024 + lane * 16); o.ge[kt] = *(const LAS f32x4*)(pkg + PK_GE + (16 * kt + 4 * qd) * 4); }
    o.mm = *(const LAS bf16x8_t*)(pkg + PK_MM + lane * 16);
    o.vv = *(const LAS bf16x4_t*)(pkg + PK_VV + vb * 512 + lane * 8); o.tm = *(const LAS bf16x4_t*)(pkg + PK_TM + lane * 8); o.lak = *(const LAS bf16x4_t*)(pkg + PK_LAK + lane * 8);
}
DI void rk_pkg_fetch(u32x4_t (&buf)[13], const unsigned char* pkg, int lane) {
#pragma unroll
    for (int i = 0; i < 12; ++i) buf[i] = *(const u32x4_t*)(pkg + i * 1024 + lane * 16);
    buf[12] = (lane < 16) ? *(const u32x4_t*)(pkg + 12288 + lane * 16) : (u32x4_t){0u, 0u, 0u, 0u};
}
DI void rwkv_r2_unit(const Args& A, LAS unsigned char* lds, int u, int tid, int wave, int lane) {
    bf16* yb = (bf16*)(A.ws + WS_RKY);
    const int dir = u / 48, rem = u % 48, b = rem / 6, hh = rem % 6; const int fr = lane & 15, qd = lane >> 4;
    const unsigned char* pkg0 = A.ws + WS_PKG + ((size_t)((dir * NB + b) * 6 + hh) * 128) * PKG_BYTES;
    volatile LAS unsigned* ready = (volatile LAS unsigned*)(lds + R2_CTL); volatile LAS unsigned* consumed = ready + 8;
    __syncthreads();
    if (tid < 16) ready[tid] = 0u;
    __syncthreads();
    if (wave >= 4) {
        const int j = wave - 4; u32x4_t cur[13], nxt[13];
        rk_pkg_fetch(cur, pkg0 + (size_t)j * PKG_BYTES, lane);
        for (int cc = j; cc < 128; cc += 4) {
            if (cc + 4 < 128) rk_pkg_fetch(nxt, pkg0 + (size_t)(cc + 4) * PKG_BYTES, lane);
            if (cc >= R2_SLOTS) { const unsigned need = (unsigned)(cc - R2_SLOTS + 1); unsigned spins = 0;
                for (;;) { const unsigned c0 = consumed[0], c1 = consumed[1], c2 = consumed[2], c3 = consumed[3];
                    if (c0 >= need && c1 >= need && c2 >= need && c3 >= need) break; if (++spins > (1u << 22)) break; __builtin_amdgcn_s_sleep(1); } }
            LAS unsigned char* slot = lds + (cc & (R2_SLOTS - 1)) * PKG_BYTES;
#pragma unroll
            for (int i = 0; i < 12; ++i) *(LAS u32x4_t*)(slot + i * 1024 + lane * 16) = cur[i];
            if (lane < 16) *(LAS u32x4_t*)(slot + 12288 + lane * 16) = cur[12];
            asm volatile("s_waitcnt lgkmcnt(0)" ::: "memory");
            if (lane == 0) ready[cc & (R2_SLOTS - 1)] = (unsigned)(cc + 1);
            asm volatile("" ::: "memory");
#pragma unroll
            for (int i = 0; i < 13; ++i) cur[i] = nxt[i];
        }
    } else {
        const int vb = wave; f32x4 sT[4];
#pragma unroll
        for (int kt = 0; kt < 4; ++kt) sT[kt] = (f32x4){0.f, 0.f, 0.f, 0.f};
#define RK_WAIT(cc_) do { unsigned spins = 0; while (ready[(cc_) & (R2_SLOTS - 1)] != (unsigned)((cc_) + 1)) { if (++spins > (1u << 22)) break; __builtin_amdgcn_s_sleep(1); } asm volatile("" ::: "memory"); } while (0)
        RkOps pa, pb;
        RK_WAIT(0); rk_load_lds(pa, lds, vb, lane, qd);
        for (int cc = 0; cc < 128; cc += 2) {
            RK_WAIT(cc + 1); rk_load_lds(pb, lds + ((cc + 1) & (R2_SLOTS - 1)) * PKG_BYTES, vb, lane, qd);
            rk_step(pa, sT, yb, dir, b, hh, vb, cc, fr, qd);
            asm volatile("s_waitcnt lgkmcnt(0)" ::: "memory"); if (lane == 0) consumed[vb] = (unsigned)(cc + 2); asm volatile("" ::: "memory");
            if (cc + 2 < 128) { RK_WAIT(cc + 2); rk_load_lds(pa, lds + ((cc + 2) & (R2_SLOTS - 1)) * PKG_BYTES, vb, lane, qd); }
            rk_step(pb, sT, yb, dir, b, hh, vb, cc + 1, fr, qd);
            if (cc + 2 < 128) { asm volatile("s_waitcnt lgkmcnt(0)" ::: "memory"); if (lane == 0) consumed[vb] = (unsigned)(cc + 3); asm volatile("" ::: "memory"); }
        }
#undef RK_WAIT
    }
    __syncthreads();
}


constexpr int YA_G2LD = 136;
static_assert(384 * YA_G2LD * 2 <= MISC_OFF, "yasm LDS");
DI void yasm_token(const bf16* Z, const bf16* ao, const float* al, const bf16* num, const float* den, const float* mlg, bf16* y, int tok, int lane) {
    const bf16* zr = Z + (size_t)tok * ZLD; bf16* yr = y + (size_t)tok * DM;
    const float lsev = al[((size_t)((lane >> 2) % 3) * NT + tok) * 4 + (lane & 3)];
    const float denv = den[((size_t)((lane >> 2) & 1) * NT + tok) * 4 + (lane & 3)];
    float aov[3][4], nmv[2][4], nm2[2][4], zo[4], zo2[4];
#pragma unroll
    for (int hh = 0; hh < 4; ++hh) { const int col = hh * 64 + lane, c0 = hh * 96 + lane, c1 = hh * 96 + 64 + (lane & 31);
#pragma unroll
        for (int br = 0; br < 3; ++br) aov[br][hh] = bf2f(ao[((size_t)br * NT + tok) * AW + col]);
#pragma unroll
        for (int d = 0; d < 2; ++d) { nmv[d][hh] = bf2f(num[((size_t)d * NT + tok) * MW + c0]); nm2[d][hh] = bf2f(num[((size_t)d * NT + tok) * MW + c1]); }
        zo[hh] = bf2f(zr[ZMO + c0]); zo2[hh] = bf2f(zr[ZMO + c1]); }
#pragma unroll
    for (int hh = 0; hh < 4; ++hh) { const int col = hh * 64 + lane;
        const float l0 = __shfl(lsev, hh), l1 = __shfl(lsev, 4 + hh), l2 = __shfl(lsev, 8 + hh);
        const float mx = fmaxf(l0, fmaxf(l1, l2)); const float w0 = __expf(l0 - mx), w1 = __expf(l1 - mx), w2 = __expf(l2 - mx);
        yr[col] = (bf16)f2bf((w0 * aov[0][hh] + w1 * aov[1][hh] + w2 * aov[2][hh]) / (w0 + w1 + w2)); }
#pragma unroll
    for (int hh = 0; hh < 4; ++hh) { const int c0 = hh * 96 + lane, c1 = hh * 96 + 64 + (lane & 31); const bool hi = lane < 32;
        const float df = __shfl(denv, hh), db = __shfl(denv, 4 + hh);
        const float invf = 1.f / fmaxf(fabsf(df), 1.f), invb = 1.f / fmaxf(fabsf(db), 1.f);
        const float a = nmv[0][hh] * invf + nmv[1][hh] * invb; const float bb = hi ? (nm2[0][hh] * invf + nm2[1][hh] * invb) : 0.f;
        const float mean = (wave_sum(a) + wave_sum(bb)) * (1.f / 96.f); const float da = a - mean, dbb = hi ? bb - mean : 0.f;
        const float var = (wave_sum(da * da) + wave_sum(dbb * dbb)) * (1.f / 96.f); const float rs = rsqrtf(var + 1e-6f);
        yr[AW + RW + c0] = (bf16)f2bf(da * rs * mlg[c0] * sigm(zo[hh]));
        if (hi) yr[AW + RW + c1] = (bf16)f2bf(dbb * rs * mlg[c1] * sigm(zo2[hh])); }
}
DI void phase_yasm(const Args& A, int l, LAS unsigned char* lds, int gw, int ngw, int tid, int lane) {
    const bf16* Z = (const bf16*)(A.ws + WS_Z); const bf16* ao = (const bf16*)(A.ws + WS_ATTO); const float* al = (const float*)(A.ws + WS_ATTL);
    const bf16* rky = (const bf16*)(A.ws + WS_RKY); const bf16* rkb = (const bf16*)(A.ws + WS_RKB);
    const bf16* num = (const bf16*)(A.ws + WS_MLNUM); const float* den = (const float*)(A.ws + WS_MLDEN); bf16* y = (bf16*)(A.ws + WS_HB);
    const float* lng = A.in[I_RLNG] + (size_t)l * RW; const float* lnb = A.in[I_RLNB] + (size_t)l * RW; const float* mlg = A.in[I_MLNG] + (size_t)l * MW;
    LAS bf16* G2T = (LAS bf16*)lds;
    __syncthreads();
    { const u32x4_t* src = (const u32x4_t*)(A.ws + WS_G2T + (size_t)l * RW * 128 * 2);
      for (int idx = tid; idx < RW * 16; idx += NTHR) { const int col = idx >> 4, ch = idx & 15; *(LAS u32x4_t*)(G2T + col * YA_G2LD + ch * 8) = src[idx]; } }
    __syncthreads();
    const int fr = lane & 15, qd = lane >> 4;
    for (int item = gw; item < (NT / 16) * 6; item += ngw) {
        const int hh = item % 6, tg = item / 6; const int tokA = tg * 16 + fr;
        f32x4 gacc[4];
#pragma unroll
        for (int nt = 0; nt < 4; ++nt) gacc[nt] = (f32x4){0.f, 0.f, 0.f, 0.f};
#pragma unroll
        for (int ks = 0; ks < 4; ++ks) { float f[8]; unpack8(*(const uint4*)(Z + (size_t)tokA * ZLD + ZGD + 32 * ks + 8 * qd), f);
            union { unsigned u[4]; bf16x8_t v; } a;
#pragma unroll
            for (int e = 0; e < 4; ++e) a.u[e] = cvtpk(sigm(f[2 * e]), sigm(f[2 * e + 1]));
#pragma unroll
            for (int nt = 0; nt < 4; ++nt) { const bf16x8_t bg = *(const LAS bf16x8_t*)(G2T + (hh * 64 + 16 * nt + fr) * YA_G2LD + 32 * ks + 8 * qd); gacc[nt] = MFMA16(a.v, bg, gacc[nt]); } }
        float sv[4][4], bv[4][4]; float sm[4] = {0.f, 0.f, 0.f, 0.f};
#pragma unroll
        for (int nt = 0; nt < 4; ++nt)
#pragma unroll
            for (int r = 0; r < 4; ++r) { const size_t o = (size_t)(tg * 16 + 4 * qd + r) * RW + hh * 64 + 16 * nt + fr;
                sv[nt][r] = bf2f(rky[o]) + bf2f(rky[(size_t)NT * RW + o]); bv[nt][r] = bf2f(rkb[o]) + bf2f(rkb[(size_t)NT * RW + o]); sm[r] += sv[nt][r]; }
        float vr[4] = {0.f, 0.f, 0.f, 0.f};
#pragma unroll
        for (int r = 0; r < 4; ++r) {
#pragma unroll
            for (int o = 1; o < 16; o <<= 1) sm[r] += __shfl_xor(sm[r], o);
            sm[r] *= (1.f / 64.f);
#pragma unroll
            for (int nt = 0; nt < 4; ++nt) { sv[nt][r] -= sm[r]; vr[r] += sv[nt][r] * sv[nt][r]; }
#pragma unroll
            for (int o = 1; o < 16; o <<= 1) vr[r] += __shfl_xor(vr[r], o);
            vr[r] = rsqrtf(vr[r] * (1.f / 64.f) + 64e-5f); }
#pragma unroll
        for (int nt = 0; nt < 4; ++nt) { const int col = hh * 64 + 16 * nt + fr; const float lg_ = lng[col], lb_ = lnb[col];
#pragma unroll
            for (int r = 0; r < 4; ++r) y[(size_t)(tg * 16 + 4 * qd + r) * DM + AW + col] = (bf16)f2bf((sv[nt][r] * vr[r] * lg_ + lb_ + bv[nt][r]) * gacc[nt][r]); }
    }
    for (int tok = gw; tok < NT; tok += 2 * ngw) { yasm_token(Z, ao, al, num, den, mlg, y, tok, lane); if (tok + ngw < NT) yasm_token(Z, ao, al, num, den, mlg, y, tok + ngw, lane); }
    __syncthreads();
}

constexpr int L2_WLD = 1032;
constexpr int L2_WHI = 0, L2_WLO = 16 * L2_WLD * 2, L2_G2 = 2 * L2_WLO, L2_EX = L2_G2 + DM * 4, L2_SS = L2_EX + 8 * 1024, L2_END = L2_SS + 8 * 16 * 4;
static_assert(L2_END <= MISC_OFF, "ln2 LDS");
DI void phase_ln2(const Args& A, int l, LAS unsigned char* lds, int bid, int G, int tid, int wave, int lane) {
    const bf16* x1 = (const bf16*)(A.ws + WS_X1); unsigned char* hb = A.ws + WS_HB; float* aff = (float*)(A.ws + WS_AFF);
    const float* router = A.in[I_ROUTER] + (size_t)l * DM * NE; const float* g2 = A.in[I_LN2G] + (size_t)l * DM;
    LAS bf16* Whi = (LAS bf16*)(lds + L2_WHI); LAS bf16* Wlo = (LAS bf16*)(lds + L2_WLO); LAS float* g2s = (LAS float*)(lds + L2_G2);
    LAS unsigned char* ex = lds + L2_EX; LAS float* ssx = (LAS float*)(lds + L2_SS);
    const int fr = lane & 15, qd = lane >> 4, tg = wave >> 1, kh = wave & 1;
    __syncthreads();
    for (int i = tid; i < DM * NE; i += NTHR) { const int e = i & 15, c = i >> 4; const float v = router[i] * g2[c]; const unsigned h = f2bf(v);
        Whi[e * L2_WLD + c] = (bf16)h; Wlo[e * L2_WLD + c] = (bf16)f2bf(v - bf2f(h)); }
    for (int i = tid; i < DM; i += NTHR) g2s[i] = g2[i];
    for (int grp = bid; grp < NT / 64; grp += G) {
        const int tokb = grp * 64 + tg * 16, tok = tokb + fr;
        const u32x4_t* xp = (const u32x4_t*)(x1 + (size_t)tok * DM + kh * 512 + 16 * qd);
        u32x4_t xa[8][2];
#pragma unroll
        for (int p = 0; p < 8; ++p) { xa[p][0] = xp[8 * p]; xa[p][1] = xp[8 * p + 1]; }
        __syncthreads();
        f32x4 acc = (f32x4){0.f, 0.f, 0.f, 0.f}; float ss = 0.f;
#pragma unroll
        for (int p = 0; p < 8; ++p)
#pragma unroll
            for (int hf = 0; hf < 2; ++hf) { const int c = kh * 512 + 64 * p + 16 * qd + 8 * hf;
                const bf16x8_t a = __builtin_bit_cast(bf16x8_t, xa[p][hf]);
                const bf16x8_t bh = *(const LAS bf16x8_t*)(Whi + fr * L2_WLD + c), bl = *(const LAS bf16x8_t*)(Wlo + fr * L2_WLD + c);
                acc = MFMA16(a, bh, acc); acc = MFMA16(a, bl, acc);
#pragma unroll
                for (int e = 0; e < 4; ++e) { const float lo = __uint_as_float(xa[p][hf][e] << 16), hi = __uint_as_float(xa[p][hf][e] & 0xffff0000u); ss += lo * lo + hi * hi; } }
        ss += __shfl_xor(ss, 16); ss += __shfl_xor(ss, 32);
        *(LAS f32x4*)(ex + wave * 1024 + lane * 16) = acc; if (qd == 0) ssx[wave * 16 + fr] = ss;
        __syncthreads();
        { const f32x4 oth = *(const LAS f32x4*)(ex + (wave ^ 1) * 1024 + lane * 16); acc += oth; ss += ssx[(wave ^ 1) * 16 + fr]; }
        const float rs = rsqrtf(ss * (1.f / DM) + RMS_EPS);
        unsigned char* hrow = hb + (size_t)tok * DM + kh * 512 + 16 * qd; const float rsc = rs * F8_HSC;
#pragma unroll
        for (int p = 0; p < 8; ++p) { const LAS f32x4* gp = (const LAS f32x4*)(g2s + kh * 512 + 64 * p + 16 * qd); u32x4_t o;
#pragma unroll
            for (int q = 0; q < 4; ++q) { const f32x4 g = gp[q]; const unsigned u0 = xa[p][q >> 1][2 * (q & 1)], u1 = xa[p][q >> 1][2 * (q & 1) + 1];
                o[q] = pk4_fp8(__uint_as_float(u0 << 16) * rsc * g[0], __uint_as_float(u0 & 0xffff0000u) * rsc * g[1], __uint_as_float(u1 << 16) * rsc * g[2], __uint_as_float(u1 & 0xffff0000u) * rsc * g[3]); }
            *(u32x4_t*)(hrow + 64 * p) = o; }
        if (kh == 0) { f32x4 af;
#pragma unroll
            for (int r = 0; r < 4; ++r) { const float lg = acc[r] * __shfl(rs, 4 * qd + r); float mx = lg;
#pragma unroll
                for (int o = 1; o < 16; o <<= 1) mx = fmaxf(mx, __shfl_xor(mx, o));
                const float ev = expf(lg - mx); float sm = ev;
#pragma unroll
                for (int o = 1; o < 16; o <<= 1) sm += __shfl_xor(sm, o);
                af[r] = ev / sm; }
            *(f32x4*)(aff + ((size_t)(tokb / SEQ) * NE + fr) * SEQ + (tokb % SEQ) + 4 * qd) = af; }
    }
    __syncthreads();
}

constexpr int PH_PER_LAYER = 10, NPH = 1 + NL * PH_PER_LAYER + 1;
#ifndef MK_ONE_LAUNCH
#define MK_ONE_LAUNCH 1
#endif

#ifndef MK_DUP
#define MK_DUP 0
#endif
constexpr int P0_END = NL * 16 * 64 + NL * 16 * 16 + NL * NE * 3 * 8 * 44, P0_SPLIT = P0_END - 0;
template <int l> DI void run_layer(const Args& A, LAS unsigned char* lds, const XcdBarrier& bar, int lo, int hi, int G, int bid, int tid, int lane, int wave, int gw, int ngw, int gtid, int nthr) {
#define IN(k) (lo <= (k) && (k) < hi)
#define SEAM(k) do { if (IN(k) && IN((k) + 1)) xcd_barrier(bar); } while (0)
#define PH(k, ...) do { if (IN(pb + (k))) { { __VA_ARGS__ } if ((MK_DUP >> (k)) & 1) { xcd_barrier(bar); { __VA_ARGS__ } } } SEAM(pb + (k)); } while (0)
    const int pb = 1 + l * PH_PER_LAYER;
    PH(0, phase_ln1(A, l, gw, ngw, lane););
    PH(1,
        pg8::Gemm g{(const bf16*)(A.ws + WS_HB), (const bf16*)(A.ws + WS_WTIN) + (size_t)l * ZLD * DM, NT, ZLD, DM};
        pg8::StaticOrder S; S.init(NT, ZLD, G, bid);
        pg8::EpiBf16<0> E{(bf16*)(A.ws + WS_Z), ZLD, nullptr, 0, 0, 1.f};
        pg8::gemm_phase<pg8::EpiBf16<0>, pg8::StaticOrder, true, true>(lds, g, S, E););
    PH(2, phase_attn(A, lds, 0, G > ATT_SCAN_BLK0 ? ATT_SPLIT : ATT_UNITS, bid, G, tid, wave, lane); phase_rwkv_r1(A, l, lds, bid, G, tid, wave, lane); if ((MK_DUP >> 13) & 1) phase_rwkv_r1(A, l, lds, bid, G, tid, wave, lane);
          phase_mlstm_m1(A, l, lds, bid, G, tid, wave, lane); if ((MK_DUP >> 16) & 1) phase_mlstm_m1(A, l, lds, bid, G, tid, wave, lane););
    PH(3, if (l == 0 && P0_SPLIT < P0_END) { const int nb = G > 160 ? G - 160 : G, b0 = G > 160 ? bid - 160 : bid; if (b0 >= 0) { __syncthreads(); phase_p0(A, lds, P0_SPLIT, P0_END, b0 * NWAVES + wave, nb * NWAVES, wave, lane); __syncthreads(); } }
          if (G > ATT_SCAN_BLK0 && bid >= ATT_SCAN_BLK0) phase_attn(A, lds, ATT_SPLIT, ATT_UNITS, bid - ATT_SCAN_BLK0, G - ATT_SCAN_BLK0, tid, wave, lane);
          for (int rep = 0; rep < 1 + ((MK_DUP >> 14) & 1); ++rep) for (int u = bid; u < 96; u += G) rwkv_r2_unit(A, lds, u, tid, wave, lane);
          for (int rep = 0; rep < 1 + ((MK_DUP >> 15) & 1); ++rep) for (int u = bid; u < 96 + 64; u += G) { if (u >= 96) mlstm_m2_unit(A, lds, u - 96, tid, wave, lane); });
    PH(4, phase_yasm(A, l, lds, gw, ngw, tid, lane););
    PH(5,
        pg8::Gemm g{(const bf16*)(A.ws + WS_HB), (const bf16*)(A.ws + WS_WTOUT) + (size_t)l * DM * DM, NT, DM, DM};
        pg8::StaticOrder S; S.init(NT, DM, G, bid);
        EpiResT<(l > 0)> E{(l == 0) ? (const void*)A.in[I_X] : (const void*)(A.ws + WS_X2), (bf16*)(A.ws + WS_X1), DM};
        pg8::gemm_phase<EpiResT<(l > 0)>, pg8::StaticOrder, true, true>(lds, g, S, E););
    PH(6, phase_ln2(A, l, lds, bid, G, tid, wave, lane););
    PH(7, phase_topk(A, lds, bid, G, tid, wave, lane););
    PH(8,
        pg8::Gemm g{(const bf16*)(A.ws + WS_XG), (const bf16*)(A.ws + WS_W13T + (size_t)l * NE * 5632 * DM), NSLOT, NE * 5632, DM / 2};
        GroupOrder S; S.init(22, G, bid);
        EpiSwiGLU E{A.ws + WS_ACT, 22};
        pg8::gemm_phase<EpiSwiGLU, GroupOrder, true, true, true>(lds, g, S, E););
    PH(9,
        pg8::Gemm g{(const bf16*)(A.ws + WS_ACT), (const bf16*)(A.ws + WS_W2T + (size_t)l * NE * DM * FF), NSLOT, NE * DM, FF / 2};
        GroupOrder S; S.init(4, G, bid);
        EpiGate E{(bf16*)(A.ws + WS_YS), (const float*)(A.ws + WS_GATE)};
        pg8::gemm_phase<EpiGate, GroupOrder, true, true, true>(lds, g, S, E););
#undef PH
#undef IN
#undef SEAM
}

__global__ void __launch_bounds__(NTHR, 2) mk_fwd(Args A) {
    extern __shared__ __attribute__((aligned(16))) unsigned char lds_raw[];
    LAS unsigned char* lds = (LAS unsigned char*)lds_raw;
    const int tid = threadIdx.x, lane = tid & 63, wave = __builtin_amdgcn_readfirstlane(tid >> 6);
    const int G = gridDim.x, bid = blockIdx.x;
    const int gw = bid * NWAVES + wave, ngw = G * NWAVES, gtid = bid * NTHR + tid, nthr = G * NTHR;
    volatile LAS unsigned* MISC = (volatile LAS unsigned*)(lds + MISC_OFF);
    if (tid < 64) MISC[tid] = 0u;
    __syncthreads();
    const int lo = A.ph_lo, hi = A.ph_hi;
    const bool use_bar = (hi - lo) > 1;
    XcdBarrier bar; bar.bar = (unsigned*)(A.ws + WS_CTL) + CW_BAR; bar.x = 0; bar.st = MISC + 8;
    if (use_bar) bar = xcd_barrier_post((unsigned*)(A.ws + WS_CTL) + CW_BAR, MISC + 8);
#define IN(k) (lo <= (k) && (k) < hi)
#define SEAM(k) do { if (IN(k) && IN((k) + 1)) xcd_barrier(bar); } while (0)

    if (IN(0)) { phase_p0(A, lds, 0, P0_SPLIT, gw, ngw, wave, lane); if ((MK_DUP >> 10) & 1) { xcd_barrier(bar); phase_p0(A, lds, 0, P0_SPLIT, gw, ngw, wave, lane); } } SEAM(0);

    run_layer<0>(A, lds, bar, lo, hi, G, bid, tid, lane, wave, gw, ngw, gtid, nthr);
    run_layer<1>(A, lds, bar, lo, hi, G, bid, tid, lane, wave, gw, ngw, gtid, nthr);
    if (IN(NPH - 1)) { phase_final(A, gw, ngw, lane); if ((MK_DUP >> 11) & 1) { xcd_barrier(bar); phase_final(A, gw, ngw, lane); } }
#undef IN
#undef SEAM
}
}

extern "C" void kernel_launch(void* const* d_in, const int* in_sizes, int n_in, void* d_out, int out_size, void* d_ws, size_t ws_size, hipStream_t stream) {
    using namespace mk;
    static int grid = 0;
    if (grid == 0) {
        if (n_in != N_IN || out_size != NT * DM || ws_size < WS_END) { fprintf(stderr, "kernel_launch: unexpected shapes (n_in %d, out %d, ws %zu < %zu)\n", n_in, out_size, ws_size, (size_t)WS_END); grid = -1; return; }
        int dev = 0, cus = 0, per_cu = 0;
        if (hipGetDevice(&dev) != hipSuccess || hipDeviceGetAttribute(&cus, hipDeviceAttributeMultiprocessorCount, dev) != hipSuccess) { grid = -1; return; }
        if (hipFuncSetAttribute((const void*)mk_fwd, hipFuncAttributeMaxDynamicSharedMemorySize, LDS_BYTES) != hipSuccess) { fprintf(stderr, "kernel_launch: hipFuncSetAttribute failed\n"); grid = -1; return; }
        if (hipOccupancyMaxActiveBlocksPerMultiprocessor(&per_cu, (const void*)mk_fwd, NTHR, LDS_BYTES) != hipSuccess || per_cu < 1) fprintf(stderr, "kernel_launch: occupancy query reports %d\n", per_cu);
        (void)hipGetLastError();
        grid = cus;
    }
    if (grid < 0) return;
    hipMemsetAsync((char*)d_ws + WS_CTL, 0, CTL_ZERO_BYTES, stream);
    Args a{};
    for (int i = 0; i < N_IN; ++i) a.in[i] = (const float*)d_in[i];
    a.out = (float*)d_out; a.ws = (unsigned char*)d_ws;
#if MK_ONE_LAUNCH
    a.ph_lo = 0; a.ph_hi = NPH;
    hipLaunchKernelGGL(mk_fwd, dim3(grid), dim3(NTHR), LDS_BYTES, stream, a);
#else
    for (int p = 0; p < NPH; ++p) { a.ph_lo = p; a.ph_hi = p + 1; hipLaunchKernelGGL(mk_fwd, dim3(grid), dim3(NTHR), LDS_BYTES, stream, a); }
#endif
}
```

```cpp
#include <hip/hip_runtime.h>
#include <cstdio>
#include <cstdint>
namespace pg8 {
#define PG8_LAS __attribute__((address_space(3)))
typedef unsigned short bf16_t;
typedef short bf16x8 __attribute__((ext_vector_type(8)));
typedef float f32x4 __attribute__((ext_vector_type(4)));
typedef unsigned u32x4 __attribute__((ext_vector_type(4)));
constexpr int BM = 256, BK = 64, HALF = 128, HTB = HALF * BK * 2  , STAGE_BYTES = 8 * HTB, NXCD = 8, WGM = 8;

__host__ __device__ __forceinline__ int lds_byte(int r, int c) { const int st = (r >> 4) * 2 + (c >> 5), rr = r & 15, cc = c & 31, ob = rr * 64 + cc * 2; return st * 1024 + (ob ^ (((ob >> 9) & 1) << 5)); }
__host__ __device__ __forceinline__ void stage_rc(int b, int& R, int& C) { const int st = b / 1024, sb = b % 1024, swz = sb ^ (((sb >> 9) & 1) << 5); R = (st >> 1) * 16 + swz / 64; C = (st & 1) * 32 + (swz % 64) / 2; }
__host__ __device__ __forceinline__ int perm32(int rho) { const int n = rho >> 4, i = rho & 15; return 8 * (i >> 2) + 4 * n + (i & 3); }

struct Unit { int pm, pn; };
struct Gemm { const bf16_t* A; const bf16_t* Bt; int M, N, K; };

struct StaticOrder {
    int nM, nN, nwg, G, c;
    __host__ __device__ void init(int M, int N, int G_, int c_) { nM = M / BM; nN = N / BM; nwg = nM * nN; G = G_; c = c_; }
    __host__ __device__ bool next(int i, Unit& u) const {
        const long L = (long)i * G + c; if (L >= nwg) return false;
        int wgid = (int)L; { const int q = nwg / NXCD, r = nwg % NXCD, xcd = wgid % NXCD, off = wgid / NXCD; wgid = (xcd < r ? xcd * (q + 1) : r * (q + 1) + (xcd - r) * q) + off; }
        const int nig = WGM * nN, gid = wgid / nig, fm = gid * WGM, gsz = (nM - fm) < WGM ? (nM - fm) : WGM;
        u.pm = fm + ((wgid % nig) % gsz); u.pn = (wgid % nig) / gsz; return true;
    }
    __device__ __forceinline__ void a_ready(const Unit&) const {}
    __device__ __forceinline__ void done(const Unit&) const {}
};

__device__ __forceinline__ unsigned cvt_pk_bf16(float lo, float hi) { unsigned r; asm volatile("v_cvt_pk_bf16_f32 %0, %1, %2" : "=v"(r) : "v"(lo), "v"(hi)); return r; }
typedef float f32x2 __attribute__((ext_vector_type(2)));
__device__ __forceinline__ f32x2 gelu_pk(f32x2 v) {
    const f32x2 av = __builtin_elementwise_abs(v), d = av * 0.2316418882f + 1.0f;
    f32x2 t; t.x = __builtin_amdgcn_rcpf(d.x); t.y = __builtin_amdgcn_rcpf(d.y);
    f32x2 q = t * 0.5307027145f + (-0.7265760135f); q = q * t + 0.7107068705f; q = q * t + (-0.142248368f); q = q * t + 0.127414796f; q = q * t;
    const f32x2 s = (v * v) * (-0.72134752044f);
    f32x2 e; e.x = __builtin_amdgcn_exp2f(s.x); e.y = __builtin_amdgcn_exp2f(s.y);
    const f32x2 m = v * (q * e), r = v - m;
    f32x2 o; o.x = v.x < 0.f ? m.x : r.x; o.y = v.y < 0.f ? m.y : r.y; return o;
}

template <int ACT  > struct EpiBf16 {
    static constexpr bool PERM = true, AFTER_DRAIN = false; static_assert(ACT == 0 || ACT == 1, "EpiBf16: ACT is 0 (none) or 1 (gelu_pk)");
    bf16_t* O; int ldc; const float* bias; int split_cols; size_t split_stride; float scale0;
    __device__ __forceinline__ void operator()(const f32x4 (&acc)[2][2][4][2], const Unit& u, int wr, int wc, int fr, int fq) const {
        const int row0 = u.pm * BM + wr * 64 + fr; int colt = u.pn * BM; bf16_t* base = O;
        float sc = 1.f; if (split_cols) { const int t = colt / split_cols; base += (size_t)t * split_stride; colt -= t * split_cols; if (t == 0) sc = scale0; }
        const int col0 = colt + wc * 32 + 8 * fq, bcol0 = u.pn * BM + wc * 32 + 8 * fq;
        f32x4 bv[2][2];
#pragma unroll
        for (int bj = 0; bj < 2; ++bj)
#pragma unroll
            for (int n = 0; n < 2; ++n) bv[bj][n] = bias ? *(const f32x4*)(bias + bcol0 + bj * HALF + 4 * n) : (f32x4){0.f, 0.f, 0.f, 0.f};
#pragma unroll
        for (int ai = 0; ai < 2; ++ai)
#pragma unroll
            for (int m = 0; m < 4; ++m) { bf16_t* rowp = base + (size_t)(row0 + ai * HALF + m * 16) * ldc + col0;
#pragma unroll
                for (int bj = 0; bj < 2; ++bj) { f32x4 v0 = acc[ai][bj][m][0] + bv[bj][0], v1 = acc[ai][bj][m][1] + bv[bj][1];
                    if (ACT == 1) { f32x2 a = gelu_pk((f32x2){v0[0], v0[1]}), b = gelu_pk((f32x2){v0[2], v0[3]}), c = gelu_pk((f32x2){v1[0], v1[1]}), d = gelu_pk((f32x2){v1[2], v1[3]});
                        v0 = (f32x4){a.x, a.y, b.x, b.y}; v1 = (f32x4){c.x, c.y, d.x, d.y}; }
                    v0 = v0 * sc; v1 = v1 * sc; u32x4 w; w.x = cvt_pk_bf16(v0[0], v0[1]); w.y = cvt_pk_bf16(v0[2], v0[3]); w.z = cvt_pk_bf16(v1[0], v1[1]); w.w = cvt_pk_bf16(v1[2], v1[3]);
                    *(u32x4*)(rowp + bj * HALF) = w; } }
    }
};
template <class Epi, class Sched, bool ALIGN_EPI = false, bool SP2 = false, bool F8 = false>
__device__ __forceinline__ void gemm_phase(PG8_LAS unsigned char* lds, const Gemm g, const Sched& S, const Epi& E) {
    const int tid = threadIdx.x, wid = __builtin_amdgcn_readfirstlane(tid >> 6), lane = tid & 63, wr = wid >> 2, wc = wid & 3, fr = lane & 15, fq = lane >> 4;
    int Kq = g.K; if constexpr (F8) asm volatile("" : "+s"(Kq));
    const int K = Kq, nt = K / BK;
    unsigned voffA[2], voffB[2];
#pragma unroll
    for (int i = 0; i < 2; ++i) { int R, C; stage_rc(tid * 16 + i * 8192, R, C); const int Rb = Epi::PERM ? ((R & ~31) + perm32(R & 31)) : R;
        voffA[i] = (unsigned)(R * K + C) * 2u; voffB[i] = (unsigned)(Rb * K + C) * 2u; }
    const size_t kstep = (size_t)(BK * 2);
    const size_t hstep = (size_t)HALF * K * 2;
    const size_t tstep = 2 * hstep;
    const unsigned ldsw = (unsigned)wid * 1024u;
    const int aoff = lds_byte(wr * 64 + fr, fq * 8), boff = lds_byte(wc * 32 + fr, fq * 8);
#define PG8_SA(b, h) (((b) * 2 + (h)) * HTB)
#define PG8_SB(b, h) ((4 + (b) * 2 + (h)) * HTB)
#define PG8_STAGE(bufoff, gbase, voff) do { _Pragma("unroll") for (int _i = 0; _i < 2; ++_i) \
        __builtin_amdgcn_global_load_lds((const unsigned*)((const char*)(gbase) + (voff)[_i]), (PG8_LAS unsigned*)(lds + (bufoff) + ldsw + _i * 8192), 16, 0, 0); } while (0)
#define PG8_LDA(dst, b, h) do { _Pragma("unroll") for (int m = 0; m < 4; ++m) { if constexpr (F8) { const i32x4_ lo_ = *(const PG8_LAS i32x4_*)(lds + PG8_SA(b, h) + aoff + m * 2048), hi_ = *(const PG8_LAS i32x4_*)(lds + PG8_SA(b, h) + aoff + m * 2048 + 1024); dst##8[m] = __builtin_shufflevector(lo_, hi_, 0, 1, 2, 3, 4, 5, 6, 7); } \
        else { _Pragma("unroll") for (int k = 0; k < 2; ++k) dst[m][k] = *(const PG8_LAS bf16x8*)(lds + PG8_SA(b, h) + aoff + m * 2048 + k * 1024); } } } while (0)
#define PG8_LDB(dst, b, h) do { _Pragma("unroll") for (int n = 0; n < 2; ++n) { if constexpr (F8) { const i32x4_ lo_ = *(const PG8_LAS i32x4_*)(lds + PG8_SB(b, h) + boff + n * 2048), hi_ = *(const PG8_LAS i32x4_*)(lds + PG8_SB(b, h) + boff + n * 2048 + 1024); dst##8[n] = __builtin_shufflevector(lo_, hi_, 0, 1, 2, 3, 4, 5, 6, 7); } \
        else { _Pragma("unroll") for (int k = 0; k < 2; ++k) dst[n][k] = *(const PG8_LAS bf16x8*)(lds + PG8_SB(b, h) + boff + n * 2048 + k * 1024); } } } while (0)
#define PG8_MMA(ai, bj, At, Bt) do { __builtin_amdgcn_s_setprio(1); _Pragma("unroll") for (int m = 0; m < 4; ++m) _Pragma("unroll") for (int n = 0; n < 2; ++n) { \
        if constexpr (F8) asm volatile("v_mfma_scale_f32_16x16x128_f8f6f4 %0, %1, %2, %0, %3, %3 op_sel_hi:[0,0,0]" : "+v"(acc[ai][bj][m][n]) : "v"(Bt##8[n]), "v"(At##8[m]), "v"(f8scale)); \
        else { _Pragma("unroll") for (int k = 0; k < 2; ++k) acc[ai][bj][m][n] = __builtin_amdgcn_mfma_f32_16x16x32_bf16(Bt[n][k], At[m][k], acc[ai][bj][m][n], 0, 0, 0); } } \
        __builtin_amdgcn_s_setprio(0); } while (0)
#define PG8_WAIT_V(n) asm volatile("s_waitcnt vmcnt(" #n ")" ::: "memory")
#define PG8_WAIT_L(n) asm volatile("s_waitcnt lgkmcnt(" #n ")" ::: "memory")
#define PG8_BAR __builtin_amdgcn_s_barrier()
#define PG8_SCHED __builtin_amdgcn_sched_barrier(0)
    Unit cur, nxt; int ui = 0;
    if (!S.next(0, cur)) return;
    f32x4 acc[2][2][4][2];
#pragma unroll
    for (int a = 0; a < 2; ++a)
#pragma unroll
        for (int b = 0; b < 2; ++b)
#pragma unroll
            for (int m = 0; m < 4; ++m)
#pragma unroll
                for (int n = 0; n < 2; ++n) { acc[a][b][m][n] = (f32x4){0.f, 0.f, 0.f, 0.f}; if constexpr (F8) asm volatile("" : "+v"(acc[a][b][m][n])); }
    bf16x8 At[4][2], B0[2][2], B1[2][2];
    typedef int i32x4_ __attribute__((ext_vector_type(4))); typedef int i32x8_ __attribute__((ext_vector_type(8)));
    i32x8_ At8[4], B08[2], B18[2];
    int f8scale = 0x7f7f7f7f; asm volatile("" : "+v"(f8scale));
    const char* cA = (const char*)g.A + (size_t)cur.pm * tstep; const char* cB = (const char*)g.Bt + (size_t)cur.pn * tstep;
    S.a_ready(cur);
    if constexpr (SP2) {
        PG8_STAGE(PG8_SB(0, 0), cB, voffB); PG8_STAGE(PG8_SB(0, 1), cB + hstep, voffB); PG8_STAGE(PG8_SA(0, 0), cA, voffA); PG8_STAGE(PG8_SA(0, 1), cA + hstep, voffA);
        if (wr == 1) PG8_BAR;
        PG8_WAIT_V(2); PG8_BAR;
        PG8_STAGE(PG8_SB(1, 0), cB + kstep, voffB); PG8_STAGE(PG8_SA(1, 0), cA + kstep, voffA); PG8_STAGE(PG8_SB(1, 1), cB + hstep + kstep, voffB);
        PG8_WAIT_V(6); PG8_BAR;
    } else {
        PG8_STAGE(PG8_SB(0, 0), cB, voffB); PG8_STAGE(PG8_SA(0, 0), cA, voffA); PG8_STAGE(PG8_SB(0, 1), cB + hstep, voffB); PG8_STAGE(PG8_SA(0, 1), cA + hstep, voffA);
        if (wr == 1) PG8_BAR;
        PG8_WAIT_V(4); PG8_BAR;
        PG8_STAGE(PG8_SB(1, 0), cB + kstep, voffB); PG8_STAGE(PG8_SA(1, 0), cA + kstep, voffA); PG8_STAGE(PG8_SB(1, 1), cB + hstep + kstep, voffB);
        PG8_WAIT_V(6); PG8_BAR;
    }
    for (;;) {
        const bool has_next = S.next(ui + 1, nxt);
        const char* nA = has_next ? (const char*)g.A + (size_t)nxt.pm * tstep : cA; const char* nB = has_next ? (const char*)g.Bt + (size_t)nxt.pn * tstep : cB;
        for (int t = 0; t < nt; t += 2) {
            const bool last = (t == nt - 2);
            const char* a1 = cA + (size_t)(t + 1) * kstep;
            const char* a2 = last ? nA : cA + (size_t)(t + 2) * kstep; const char* b2 = last ? nB : cB + (size_t)(t + 2) * kstep;
            const char* a3 = a2 + kstep; const char* b3 = b2 + kstep;
            if (last && has_next) S.a_ready(nxt);
            if constexpr (SP2) {
            PG8_LDB(B0, 0, 0); PG8_LDB(B1, 0, 1); PG8_SCHED; PG8_LDA(At, 0, 0); PG8_STAGE(PG8_SA(1, 1), a1 + hstep, voffA);
            PG8_WAIT_V(8); PG8_WAIT_L(0); PG8_BAR; PG8_MMA(0, 0, At, B0); PG8_MMA(0, 1, At, B1); PG8_BAR; PG8_SCHED;
            PG8_LDA(At, 0, 1); PG8_STAGE(PG8_SB(0, 0), b2, voffB); PG8_STAGE(PG8_SB(0, 1), b2 + hstep, voffB); PG8_STAGE(PG8_SA(0, 0), a2, voffA);
            PG8_WAIT_V(8); PG8_WAIT_L(0); PG8_BAR; PG8_MMA(1, 0, At, B0); PG8_MMA(1, 1, At, B1); PG8_BAR; PG8_SCHED;
            PG8_LDB(B0, 1, 0); PG8_LDB(B1, 1, 1); PG8_SCHED; PG8_LDA(At, 1, 0); PG8_STAGE(PG8_SA(0, 1), a2 + hstep, voffA);
            PG8_WAIT_V(8); PG8_WAIT_L(0); PG8_BAR; PG8_MMA(0, 0, At, B0); PG8_MMA(0, 1, At, B1); PG8_BAR; PG8_SCHED;
            PG8_LDA(At, 1, 1); PG8_STAGE(PG8_SB(1, 0), b3, voffB); PG8_STAGE(PG8_SB(1, 1), b3 + hstep, voffB); PG8_STAGE(PG8_SA(1, 0), a3, voffA);
            PG8_WAIT_V(8); PG8_WAIT_L(0); PG8_BAR; PG8_MMA(1, 0, At, B0); PG8_MMA(1, 1, At, B1); PG8_BAR; PG8_SCHED;
            } else {
            PG8_LDB(B0, 0, 0); PG8_SCHED; PG8_LDA(At, 0, 0); PG8_STAGE(PG8_SA(1, 1), a1 + hstep, voffA);
            PG8_WAIT_L(8); PG8_BAR; PG8_WAIT_L(0); PG8_MMA(0, 0, At, B0); PG8_BAR; PG8_SCHED;
            PG8_LDB(B1, 0, 1); PG8_STAGE(PG8_SB(0, 0), b2, voffB);
            PG8_BAR; PG8_WAIT_L(0); PG8_MMA(0, 1, At, B1); PG8_BAR;
            PG8_LDA(At, 0, 1); PG8_STAGE(PG8_SA(0, 0), a2, voffA);
            PG8_BAR; PG8_WAIT_L(0); PG8_MMA(1, 0, At, B0); PG8_BAR; PG8_SCHED;
            PG8_STAGE(PG8_SB(0, 1), b2 + hstep, voffB);
            PG8_WAIT_V(6); PG8_BAR; PG8_MMA(1, 1, At, B1); PG8_BAR;
            PG8_LDB(B0, 1, 0); PG8_SCHED; PG8_LDA(At, 1, 0); PG8_STAGE(PG8_SA(0, 1), a2 + hstep, voffA);
            PG8_WAIT_L(8); PG8_BAR; PG8_WAIT_L(0); PG8_MMA(0, 0, At, B0); PG8_BAR; PG8_SCHED;
            PG8_LDB(B1, 1, 1); PG8_STAGE(PG8_SB(1, 0), b3, voffB);
            PG8_BAR; PG8_WAIT_L(0); PG8_MMA(0, 1, At, B1); PG8_BAR;
            PG8_LDA(At, 1, 1); PG8_STAGE(PG8_SA(1, 0), a3, voffA);
            PG8_BAR; PG8_WAIT_L(0); PG8_MMA(1, 0, At, B0); PG8_BAR; PG8_SCHED;
            PG8_STAGE(PG8_SB(1, 1), b3 + hstep, voffB);
            PG8_WAIT_V(6); PG8_BAR; PG8_MMA(1, 1, At, B1); PG8_BAR;
            }
        }
        if constexpr (F8) asm volatile("s_nop 15\n\ts_nop 15" ::: "memory");
        if constexpr (ALIGN_EPI) { if (wr == 0) PG8_BAR; }
        if constexpr (!Epi::AFTER_DRAIN) { E(acc, cur, wr, wc, fr, fq); S.done(cur); }
        if (!has_next) break;
#pragma unroll
        for (int a = 0; a < 2; ++a)
#pragma unroll
            for (int b = 0; b < 2; ++b)
#pragma unroll
                for (int m = 0; m < 4; ++m)
#pragma unroll
                    for (int n = 0; n < 2; ++n) { acc[a][b][m][n] = (f32x4){0.f, 0.f, 0.f, 0.f}; if constexpr (F8) asm volatile("" : "+v"(acc[a][b][m][n])); }
        cur = nxt; cA = nA; cB = nB; ++ui;
        if constexpr (ALIGN_EPI) { if (wr == 1) PG8_BAR; }
    }
    PG8_WAIT_V(0);
    if constexpr (!ALIGN_EPI) { if (wr == 0) PG8_BAR; }
    PG8_BAR;
    if constexpr (Epi::AFTER_DRAIN) { E.fused(acc, cur, wr, wc, fr, fq, lds, wid, lane); S.done(cur); }
#undef PG8_SA
#undef PG8_SB
#undef PG8_STAGE
#undef PG8_LDA
#undef PG8_LDB
#undef PG8_MMA
#undef PG8_WAIT_V
#undef PG8_WAIT_L
#undef PG8_BAR
#undef PG8_SCHED
}
}
#define LAS __attribute__((address_space(3)))
#define XB_TMO      128
#define XB_XCNT(j)  (256  + 64 * (j))
#define XB_XSUB(j)  (1280 + 64 * (j))
#define XB_XGEN(j)  (2304 + 64 * (j))
#define XB_TOP      3328
#define XB_TOPGEN   3392
#define XCD_BAR_WORDS 3456
#define XB_SPIN_CAP (1u << 18)

__device__ __forceinline__ unsigned xb_ld(unsigned* p)              { return __hip_atomic_load(p, __ATOMIC_RELAXED, __HIP_MEMORY_SCOPE_AGENT); }
__device__ __forceinline__ unsigned xb_add(unsigned* p, unsigned v) { return __hip_atomic_fetch_add(p, v, __ATOMIC_RELAXED, __HIP_MEMORY_SCOPE_AGENT); }
__device__ __forceinline__ unsigned xb_xcc_id() { return (unsigned)__builtin_amdgcn_s_getreg((3 << 11) | 20) & 0xFu; }
#define XB_SPIN(cond, bar) do { unsigned _sp = 0; while (cond) { __builtin_amdgcn_s_sleep(1); \
    if ((++_sp & 255u) == 0u) { if (xb_ld(&(bar)[XB_TMO])) break; if (_sp > XB_SPIN_CAP) { atomicAdd(&(bar)[XB_TMO], 1u); break; } } } } while (0)

struct XcdBarrier {
    unsigned* bar; unsigned x;
    volatile LAS unsigned* st;
};

__device__ __forceinline__ XcdBarrier xcd_barrier_post(unsigned* bar, volatile LAS unsigned* st) {
    XcdBarrier b; b.bar = bar; b.x = xb_xcc_id(); b.st = st;
    if (threadIdx.x == 0) (void)xb_add(&bar[XB_XCNT(b.x)], 1u);
    return b;
}
__device__ __forceinline__ void xcd_barrier_complete(unsigned* bar, unsigned x, unsigned& nloc, unsigned& nx) {
    const unsigned G = gridDim.x * gridDim.y * gridDim.z;
    unsigned sum, cnt, mine, sp = 0u;
    for (;;) {
        sum = 0u; cnt = 0u; mine = 0u;
#pragma unroll
        for (unsigned j = 0; j < 16; ++j) { const unsigned c = xb_ld(&bar[XB_XCNT(j)]); sum += c; cnt += (c > 0u) ? 1u : 0u; mine = (j == x) ? c : mine; }
        if (sum == G) break;
        __builtin_amdgcn_s_sleep(1);
        if ((++sp & 255u) == 0u) { if (xb_ld(&bar[XB_TMO])) break; if (sp > XB_SPIN_CAP) { atomicAdd(&bar[XB_TMO], 1u); break; } }
    }
    nloc = mine > 0u ? mine : 1u; nx = cnt > 0u ? cnt : 1u;
}

__device__ __forceinline__ void xcd_barrier(const XcdBarrier& b) {
    asm volatile("s_waitcnt vmcnt(0)" ::: "memory");
    __syncthreads();
    if (threadIdx.x == 0) {
        unsigned* bar = b.bar;
        __builtin_amdgcn_s_waitcnt(0);
        unsigned nloc = b.st[0], nx = b.st[1];
        if (nloc == 0u) { xcd_barrier_complete(bar, b.x, nloc, nx); b.st[0] = nloc; b.st[1] = nx; }
        const unsigned old = xb_add(&bar[XB_XSUB(b.x)], 1u);
        const unsigned gen = old / nloc;
        if (old + 1u == (gen + 1u) * nloc) {
            __builtin_amdgcn_fence(__ATOMIC_RELEASE, "agent");
            asm volatile("s_waitcnt vmcnt(0)" ::: "memory");
            const unsigned og = xb_add(&bar[XB_TOP], 1u);
            const unsigned tg = og / nx;
            if (og + 1u == (tg + 1u) * nx) xb_add(&bar[XB_TOPGEN], 1u);
            else XB_SPIN(xb_ld(&bar[XB_TOPGEN]) == tg, bar);
            __builtin_amdgcn_fence(__ATOMIC_ACQUIRE, "agent");
            xb_add(&bar[XB_XGEN(b.x)], 1u);
            asm volatile("s_waitcnt vmcnt(0)" ::: "memory");
        } else {
            XB_SPIN(xb_ld(&bar[XB_XGEN(b.x)]) == gen, bar);
            __builtin_amdgcn_fence(__ATOMIC_ACQUIRE, "agent");
            asm volatile("s_waitcnt vmcnt(0)" ::: "memory");
        }
    }
    __syncthreads();
}

#define DI __device__ __forceinline__
#define LDS_WAIT() asm volatile("s_waitcnt lgkmcnt(0)" ::: "memory")
typedef unsigned short bf16;
typedef float f32x4 __attribute__((ext_vector_type(4)));

namespace mk {
constexpr int NB = 8, SEQ = 2048, DM = 1024, NT = NB * SEQ, NL = 2;
constexpr int INW = 3856, ZLD = 4096;
constexpr int ZA = 0, ZRKV = 768, ZWDF = 1920, ZWDB = 1984, ZADF = 2048, ZADB = 2112, ZGD = 2176, ZMQK = 2304, ZMV = 3072, ZMO = 3456, ZMG = 3840;
constexpr int RW = 384, MW = 384, AW = 256;
constexpr int NE = 16, CAP = 256, FF = 2816, NSLOT = NB * NE * CAP;
constexpr int NWAVES = 8, NTHR = 512;
constexpr float RMS_EPS = 1e-6f;

enum { I_X = 0, I_RELB, I_LN1G, I_WIN, I_WOUT, I_MU, I_W0, I_W2, I_A0, I_A2, I_KK, I_KA, I_RK, I_G2, I_RLNG, I_RLNB,
       I_CW, I_CB, I_IB, I_FB, I_MLNG, I_LN2G, I_ROUTER, I_EW1, I_EW3, I_EW2, I_FG, N_IN };

constexpr size_t MiB = 1u << 20;
constexpr size_t WS_CTL = 0, CTL_ZERO_BYTES = 1 * MiB;
constexpr size_t WS_WTIN = 2 * MiB;
constexpr size_t WS_WTOUT = 18 * MiB;
constexpr size_t WS_W13T = 22 * MiB;
constexpr size_t WS_W2T = 374 * MiB;
constexpr size_t WS_X1 = 550 * MiB;
constexpr size_t WS_X2 = 614 * MiB;
constexpr size_t WS_HB = 678 * MiB;
constexpr size_t WS_AFF = 710 * MiB;
constexpr size_t WS_SEL = 711 * MiB;
constexpr size_t WS_GATE = 712 * MiB;
constexpr size_t WS_G2T = 713 * MiB;
constexpr size_t WS_LWT = 713 * MiB + 256 * 1024;
constexpr size_t WS_R = 714 * MiB;
constexpr size_t WS_Z = WS_R;
constexpr size_t WS_ATTO = WS_R + 128 * MiB;
constexpr size_t WS_ATTL = WS_R + 152 * MiB;
constexpr size_t WS_PR = WS_R + 154 * MiB;
constexpr size_t WS_RKY = WS_R + 442 * MiB;
constexpr size_t WS_RKB = WS_R + 490 * MiB;
constexpr size_t WS_MLQK = WS_R + 538 * MiB;
constexpr size_t WS_MLNUM = WS_R + 586 * MiB;
constexpr size_t WS_MLDEN = WS_R + 634 * MiB;
constexpr size_t WS_XG = WS_R;
constexpr size_t WS_ACT = WS_R + 64 * MiB;
constexpr size_t WS_YS = WS_R + 240 * MiB;
constexpr size_t WS_END = WS_R + 636 * MiB;

constexpr int CW_BAR = 4096;
constexpr int LDS_BYTES = 147456;
constexpr int MISC_OFF = LDS_BYTES - 256;

struct Args { const float* in[N_IN]; float* out; unsigned char* ws; int ph_lo, ph_hi; };

DI float bf2f(unsigned v) { return __uint_as_float(v << 16); }
DI unsigned f2bf(float f) { unsigned u = __float_as_uint(f); return (u + 0x7fffu + ((u >> 16) & 1u)) >> 16; }
DI unsigned pk2(float lo, float hi) { return f2bf(lo) | (f2bf(hi) << 16); }
DI float wave_sum(float v) {
#pragma unroll
    for (int o = 1; o < 64; o <<= 1) v += __shfl_xor(v, o);
    return v;
}
DI float sigm(float x) { return 1.f / (1.f + __expf(-x)); }
DI void unpack8(const uint4 w, float (&f)[8]) {
    f[0] = __uint_as_float(w.x << 16); f[1] = __uint_as_float(w.x & 0xffff0000u); f[2] = __uint_as_float(w.y << 16); f[3] = __uint_as_float(w.y & 0xffff0000u);
    f[4] = __uint_as_float(w.z << 16); f[5] = __uint_as_float(w.z & 0xffff0000u); f[6] = __uint_as_float(w.w << 16); f[7] = __uint_as_float(w.w & 0xffff0000u);
}

struct GroupOrder {
    int G, c2, nunits, per_e, nN;
    DI void init(int nN_, int G_, int bid) { nN = nN_; per_e = 8 * nN_; nunits = NE * per_e; G = G_; c2 = (G_ % 8 == 0) ? (bid % 8) * (G_ / 8) + bid / 8 : bid; }
    DI bool next(int i, pg8::Unit& u) const {
        const long L = (long)i * G + c2; if (L >= nunits) return false;
        const int e = (int)L / per_e, r = (int)L % per_e; u.pm = e * 8 + (r & 7); u.pn = e * nN + (r >> 3); return true;
    }
    DI void a_ready(const pg8::Unit&) const {}
    DI void done(const pg8::Unit&) const {}
};
DI unsigned pkbf(float lo, float hi) { typedef __bf16 b2 __attribute__((ext_vector_type(2))); typedef float f2 __attribute__((ext_vector_type(2))); const f2 v = {lo, hi}; return __builtin_bit_cast(unsigned, __builtin_convertvector(v, b2)); }
template <bool BASE_BF16>
struct EpiResT {
    static constexpr bool PERM = false, AFTER_DRAIN = false;
    const void* base; bf16* out; int ldc;
    DI void operator()(const pg8::f32x4 (&acc)[2][2][4][2], const pg8::Unit& u, int wr, int wc, int fr, int fq) const {
        const int row0 = u.pm * 256 + wr * 64 + fr, col0 = u.pn * 256 + wc * 32 + 4 * fq;
#pragma unroll
        for (int ai = 0; ai < 2; ++ai)
#pragma unroll
            for (int m = 0; m < 4; ++m) { const size_t off = (size_t)(row0 + ai * 128 + m * 16) * ldc + col0;
#pragma unroll
                for (int bj = 0; bj < 2; ++bj)
#pragma unroll
                    for (int n = 0; n < 2; ++n) { pg8::f32x4 b;
                        if constexpr (BASE_BF16) { const uint2 w = *(const uint2*)((const bf16*)base + off + bj * 128 + n * 16);
                            b[0] = __uint_as_float(w.x << 16); b[1] = __uint_as_float(w.x & 0xffff0000u); b[2] = __uint_as_float(w.y << 16); b[3] = __uint_as_float(w.y & 0xffff0000u); }
                        else b = *(const pg8::f32x4*)((const float*)base + off + bj * 128 + n * 16);
                        b += acc[ai][bj][m][n]; uint2 o; o.x = pkbf(b[0], b[1]); o.y = pkbf(b[2], b[3]); *(uint2*)(out + off + bj * 128 + n * 16) = o; } }
    }
};
DI float silu_f(float x) { return x * __builtin_amdgcn_rcpf(1.f + __expf(-x)); }
DI float f8clamp(float x) { return __builtin_amdgcn_fmed3f(x, -448.f, 448.f); }
DI unsigned pk4_fp8(float a, float b, float c, float d) { unsigned p = 0u; p = __builtin_amdgcn_cvt_pk_fp8_f32(f8clamp(a), f8clamp(b), p, false); p = __builtin_amdgcn_cvt_pk_fp8_f32(f8clamp(c), f8clamp(d), p, true); return p; }
constexpr float F8_WSC = 64.f, F8_HSC = 8.f, F8_ASC = 16.f;
struct EpiSwiGLU {
    static constexpr bool PERM = true, AFTER_DRAIN = false;
    unsigned char* act; int nN;
    DI void operator()(const pg8::f32x4 (&acc)[2][2][4][2], const pg8::Unit& u, int wr, int wc, int fr, int fq) const {
        const int lpn = u.pn % nN; const int row0 = u.pm * 256 + wr * 64 + fr, col0 = lpn * 128 + wc * 32 + 8 * fq; constexpr float is = 1.f / (F8_HSC * F8_WSC);
#pragma unroll
        for (int ai = 0; ai < 2; ++ai)
#pragma unroll
            for (int m = 0; m < 4; ++m) { unsigned char* p = act + (size_t)(row0 + ai * 128 + m * 16) * FF + col0;
                const pg8::f32x4 a0 = acc[ai][0][m][0] * is, a1 = acc[ai][0][m][1] * is, g0 = acc[ai][1][m][0] * (is * F8_ASC), g1 = acc[ai][1][m][1] * (is * F8_ASC);
                uint2 w; w.x = pk4_fp8(silu_f(a0[0]) * g0[0], silu_f(a0[1]) * g0[1], silu_f(a0[2]) * g0[2], silu_f(a0[3]) * g0[3]);
                w.y = pk4_fp8(silu_f(a1[0]) * g1[0], silu_f(a1[1]) * g1[1], silu_f(a1[2]) * g1[2], silu_f(a1[3]) * g1[3]);
                *(uint2*)p = w; }
    }
};
struct EpiGate {
    static constexpr bool PERM = true, AFTER_DRAIN = false;
    bf16* ys; const float* gate;
    DI void operator()(const pg8::f32x4 (&acc)[2][2][4][2], const pg8::Unit& u, int wr, int wc, int fr, int fq) const {
        const int row0 = u.pm * 256 + wr * 64 + fr, col0 = (u.pn & 3) * 256 + wc * 32 + 8 * fq;
#pragma unroll
        for (int ai = 0; ai < 2; ++ai)
#pragma unroll
            for (int m = 0; m < 4; ++m) { const int row = row0 + ai * 128 + m * 16; const float g = gate[row] * (1.f / (F8_ASC * F8_WSC)); bf16* p = ys + (size_t)row * DM + col0;
#pragma unroll
                for (int bj = 0; bj < 2; ++bj) { const pg8::f32x4 v0 = acc[ai][bj][m][0] * g, v1 = acc[ai][bj][m][1] * g; pg8::u32x4 w;
                    w.x = pg8::cvt_pk_bf16(v0[0], v0[1]); w.y = pg8::cvt_pk_bf16(v0[2], v0[3]); w.z = pg8::cvt_pk_bf16(v1[0], v1[1]); w.w = pg8::cvt_pk_bf16(v1[2], v1[3]);
                    *(pg8::u32x4*)(p + bj * 128) = w; } }
    }
};

DI void cvt_tile(const float* W, int N, int nvalid, int k0, int n0, bf16* dst, int Kd, size_t drow0, LAS float* scr, int lane) {
    const int c4 = (lane & 15) * 4, kr = lane >> 4;
#pragma unroll
    for (int it = 0; it < 16; ++it) { const int k = it * 4 + kr; float4 v = make_float4(0.f, 0.f, 0.f, 0.f);
        if (n0 + c4 < nvalid) v = *(const float4*)(W + (size_t)(k0 + k) * N + n0 + c4);
        LAS float* s = scr + k * 65 + c4; s[0] = v.x; s[1] = v.y; s[2] = v.z; s[3] = v.w; }
    LDS_WAIT(); asm volatile("" ::: "memory");
    const int c = lane & 7;
#pragma unroll
    for (int it = 0; it < 8; ++it) { const int n = it * 8 + (lane >> 3); const LAS float* s = scr + (8 * c) * 65 + n;
        uint4 o; o.x = pk2(s[0], s[65]); o.y = pk2(s[130], s[195]); o.z = pk2(s[260], s[325]); o.w = pk2(s[390], s[455]);
        *(uint4*)(dst + (drow0 + n) * (size_t)Kd + k0 + 8 * c) = o; }
    LDS_WAIT(); asm volatile("" ::: "memory");
}
DI void cvt_tile_fp8(const float* W, int N, int k0, int n0, unsigned char* dst, int Kd, size_t drow0, float sc, LAS unsigned char* scr, int lane) {
    const int nq = lane & 15, kq = lane >> 4;
#pragma unroll
    for (int hb = 0; hb < 2; ++hb) {
        f32x4 v[4][4];
#pragma unroll
        for (int it = 0; it < 4; ++it)
#pragma unroll
            for (int j = 0; j < 4; ++j) v[it][j] = __builtin_nontemporal_load((const f32x4*)(W + (size_t)(k0 + hb * 64 + it * 16 + kq * 4 + j) * N + n0 + 4 * nq));
#pragma unroll
        for (int it = 0; it < 4; ++it)
#pragma unroll
            for (int i = 0; i < 4; ++i) *(LAS unsigned*)(scr + (4 * nq + i) * 132 + hb * 64 + it * 16 + kq * 4) = pk4_fp8(v[it][0][i] * sc, v[it][1][i] * sc, v[it][2][i] * sc, v[it][3][i] * sc);
    }
    LDS_WAIT(); asm volatile("" ::: "memory");
    const int c = lane & 7;
#pragma unroll
    for (int it = 0; it < 8; ++it) { const int n = it * 8 + (lane >> 3); const LAS unsigned* s = (const LAS unsigned*)(scr + n * 132 + 16 * c);
        uint4 o; o.x = s[0]; o.y = s[1]; o.z = s[2]; o.w = s[3];
        *(uint4*)(dst + (drow0 + n) * (size_t)Kd + k0 + 16 * c) = o; }
    LDS_WAIT(); asm volatile("" ::: "memory");
}
DI void phase_p0(const Args& A, LAS unsigned char* lds, int it0, int it1, int gw, int ngw, int wave, int lane) {
    LAS float* scr = (LAS float*)(lds + wave * 16896);
    bf16* wtin = (bf16*)(A.ws + WS_WTIN); bf16* wtout = (bf16*)(A.ws + WS_WTOUT); unsigned char* w13 = A.ws + WS_W13T; unsigned char* w2t = A.ws + WS_W2T;
    constexpr int I_IN = NL * 16 * 64, I_OUT = NL * 16 * 16, I_E = 8 * 44, I_MOE = NL * NE * 3 * I_E;
    for (int it = it0 + gw; it < it1; it += ngw) {
        int r = it;
        if (r < I_IN) { const int l = r / 1024, t = r % 1024, kb = t / 64, nb = t % 64;
            cvt_tile(A.in[I_WIN] + (size_t)l * DM * INW, INW, INW, kb * 64, nb * 64, wtin + (size_t)l * ZLD * DM, DM, (size_t)nb * 64, scr, lane); continue; }
        r -= I_IN;
        if (r < I_OUT) { const int l = r / 256, t = r % 256, kb = t / 16, nb = t % 16;
            cvt_tile(A.in[I_WOUT] + (size_t)l * DM * DM, DM, DM, kb * 64, nb * 64, wtout + (size_t)l * DM * DM, DM, (size_t)nb * 64, scr, lane); continue; }
        r -= I_OUT;
        const int le = r / (3 * I_E), q = r % (3 * I_E), which = q / I_E, t = q % I_E;
        if (which < 2) { const int kb = t / 44, nb = t % 44, n0 = nb * 64;
            cvt_tile_fp8(A.in[which == 0 ? I_EW1 : I_EW3] + (size_t)le * DM * FF, FF, kb * 128, n0, w13 + (size_t)le * 5632 * DM, DM, (size_t)((n0 >> 7) * 256 + which * 128 + (n0 & 127)), F8_WSC, (LAS unsigned char*)scr, lane); }
        else { const int kb = t / 16, nb = t % 16;
            cvt_tile_fp8(A.in[I_EW2] + (size_t)le * FF * DM, DM, kb * 128, nb * 64, w2t + (size_t)le * DM * FF, FF, (size_t)nb * 64, F8_WSC, (LAS unsigned char*)scr, lane); }
    }
    if (it0 == 0) { bf16* g2t = (bf16*)(A.ws + WS_G2T);
        for (int idx = gw * 64 + lane; idx < NL * 128 * RW; idx += ngw * 64) { const int col = idx % RW, j = (idx / RW) % 128, l = idx / (128 * RW); g2t[((size_t)l * RW + col) * 128 + j] = (bf16)f2bf(A.in[I_G2][idx]); } }
}

DI void load_row(const float* xrow, int lane, f32x4 (&v)[4]) {
    const f32x4* xr = (const f32x4*)xrow + lane;
#pragma unroll
    for (int j = 0; j < 4; ++j) v[j] = xr[64 * j];
}
DI void load_row_bf(const bf16* xrow, int lane, f32x4 (&v)[4]) {
    const uint2* xr = (const uint2*)xrow + lane;
#pragma unroll
    for (int j = 0; j < 4; ++j) { const uint2 w = xr[64 * j]; v[j][0] = __uint_as_float(w.x << 16); v[j][1] = __uint_as_float(w.x & 0xffff0000u); v[j][2] = __uint_as_float(w.y << 16); v[j][3] = __uint_as_float(w.y & 0xffff0000u); }
}
DI void add_slots(const Args& A, int tok, int lane, f32x4 (&v)[4]) {
    const int* sel = (const int*)(A.ws + WS_SEL); const bf16* ys = (const bf16*)(A.ws + WS_YS);
    const int b = tok / SEQ; const int mys = (lane < NE) ? sel[(size_t)tok * NE + lane] : -1;
    for (int e = 0; e < NE; ++e) { const int r = __shfl(mys, e);
        if (r >= 0) { const uint2* p = (const uint2*)(ys + (size_t)((e * NB + b) * CAP + r) * DM) + lane;
#pragma unroll
            for (int j = 0; j < 4; ++j) { const uint2 w = p[64 * j]; v[j][0] += __uint_as_float(w.x << 16); v[j][1] += __uint_as_float(w.x & 0xffff0000u); v[j][2] += __uint_as_float(w.y << 16); v[j][3] += __uint_as_float(w.y & 0xffff0000u); } } }
}
DI float row_rstd(const f32x4 (&v)[4]) {
    float s = 0.f;
#pragma unroll
    for (int j = 0; j < 4; ++j) s += (v[j][0] * v[j][0] + v[j][1] * v[j][1]) + (v[j][2] * v[j][2] + v[j][3] * v[j][3]);
    return rsqrtf(wave_sum(s) * (1.f / DM) + RMS_EPS);
}
DI void phase_ln1(const Args& A, int l, int gw, int ngw, int lane) {
    const float* xin = A.in[I_X]; const bf16* x1 = (const bf16*)(A.ws + WS_X1); bf16* x2 = (bf16*)(A.ws + WS_X2); bf16* hb = (bf16*)(A.ws + WS_HB);
    f32x4 gg[4];
#pragma unroll
    for (int j = 0; j < 4; ++j) gg[j] = ((const f32x4*)(A.in[I_LN1G] + (size_t)l * DM) + lane)[64 * j];
    for (int tok = gw; tok < NT; tok += 2 * ngw) {
        const int tokb = tok + ngw; const bool hb2 = tokb < NT;
        f32x4 va[4], vb[4];
        if (l == 0) { load_row(xin + (size_t)tok * DM, lane, va); load_row(xin + (size_t)(hb2 ? tokb : tok) * DM, lane, vb); }
        else { load_row_bf(x1 + (size_t)tok * DM, lane, va); load_row_bf(x1 + (size_t)(hb2 ? tokb : tok) * DM, lane, vb);
            add_slots(A, tok, lane, va); add_slots(A, hb2 ? tokb : tok, lane, vb);
            uint2* oa = (uint2*)(x2 + (size_t)tok * DM) + lane; uint2* ob = (uint2*)(x2 + (size_t)tokb * DM) + lane;
#pragma unroll
            for (int j = 0; j < 4; ++j) { uint2 w; w.x = pkbf(va[j][0], va[j][1]); w.y = pkbf(va[j][2], va[j][3]); oa[64 * j] = w;
                if (hb2) { uint2 u; u.x = pkbf(vb[j][0], vb[j][1]); u.y = pkbf(vb[j][2], vb[j][3]); ob[64 * j] = u; } } }
        const float ra = row_rstd(va), rb = row_rstd(vb); uint2* o8a = (uint2*)(hb + (size_t)tok * DM) + lane; uint2* o8b = (uint2*)(hb + (size_t)tokb * DM) + lane;
#pragma unroll
        for (int j = 0; j < 4; ++j) { uint2 w; w.x = pkbf(va[j][0] * ra * gg[j][0], va[j][1] * ra * gg[j][1]); w.y = pkbf(va[j][2] * ra * gg[j][2], va[j][3] * ra * gg[j][3]); o8a[64 * j] = w;
            if (hb2) { uint2 u; u.x = pkbf(vb[j][0] * rb * gg[j][0], vb[j][1] * rb * gg[j][1]); u.y = pkbf(vb[j][2] * rb * gg[j][2], vb[j][3] * rb * gg[j][3]); o8b[64 * j] = u; } }
    }
}
DI void phase_final(const Args& A, int gw, int ngw, int lane) {
    const bf16* xin = (const bf16*)(A.ws + WS_X1);
    f32x4 gg[4];
#pragma unroll
    for (int j = 0; j < 4; ++j) gg[j] = ((const f32x4*)A.in[I_FG] + lane)[64 * j];
    for (int tok = gw; tok < NT; tok += 2 * ngw) {
        const int tokb = tok + ngw; const bool hb2 = tokb < NT;
        f32x4 va[4], vb[4]; load_row_bf(xin + (size_t)tok * DM, lane, va); load_row_bf(xin + (size_t)(hb2 ? tokb : tok) * DM, lane, vb);
        add_slots(A, tok, lane, va); add_slots(A, hb2 ? tokb : tok, lane, vb);
        const float ra = row_rstd(va), rb = row_rstd(vb); f32x4* oa = (f32x4*)(A.out + (size_t)tok * DM) + lane; f32x4* ob = (f32x4*)(A.out + (size_t)tokb * DM) + lane;
#pragma unroll
        for (int j = 0; j < 4; ++j) { oa[64 * j] = va[j] * ra * gg[j]; if (hb2) ob[64 * j] = vb[j] * rb * gg[j]; }
    }
}
DI void phase_topk(const Args& A, LAS unsigned char* lds, int bid, int G, int tid, int wave, int lane) {
    const unsigned* affk = (const unsigned*)(A.ws + WS_AFF); int* sel = (int*)(A.ws + WS_SEL); float* gate = (float*)(A.ws + WS_GATE);
    const unsigned char* hb = A.ws + WS_HB; unsigned char* xg = A.ws + WS_XG;
    LAS unsigned* hist = (LAS unsigned*)lds;
    LAS unsigned* wsum = hist + 32;
    LAS int* list = (LAS int*)(lds + 256);
    for (int u = bid; u < NB * NE * 2; u += G) {
        const int half = u & 1, e = (u >> 1) % NE, b = u / (2 * NE);
        __syncthreads();
        if (tid < 32) hist[tid] = 0u;
        const uint4 kv = *(const uint4*)(affk + (size_t)(b * NE + e) * SEQ + tid * 4);
        const unsigned key[4] = {kv.x, kv.y, kv.z, kv.w};
        __syncthreads();
        unsigned prefix = 0u, krem = CAP;
#pragma unroll 1
        for (int pass = 0; pass < 8; ++pass) { const int shift = 28 - 4 * pass; LAS unsigned* h = hist + (pass & 1) * 16;
            unsigned cnt = 0u;
#pragma unroll
            for (int i = 0; i < 4; ++i) { const bool cand = (pass == 0) || ((key[i] >> (shift + 4)) == prefix); const unsigned bin = (key[i] >> shift) & 15u;
#pragma unroll
                for (int v = 0; v < 16; ++v) { const unsigned long long m = __ballot(cand && bin == (unsigned)v); if (lane == v) cnt += (unsigned)__popcll(m); } }
            if (lane < 16 && cnt) atomicAdd((unsigned*)(h + lane), cnt);
            __syncthreads();
            unsigned acc = 0u, pick = 0u, before = 0u;
#pragma unroll
            for (int v = 15; v >= 0; --v) { const unsigned c = h[v]; if (acc < krem && acc + c >= krem) { pick = (unsigned)v; before = acc; } acc += c; }
            prefix = (prefix << 4) | pick; krem -= before;
            if (tid < 16) hist[((pass + 1) & 1) * 16 + tid] = 0u;
            __syncthreads();
        }
        const unsigned tau = prefix;
        unsigned gt[4], eq[4]; unsigned ngt = 0u, neq = 0u;
#pragma unroll
        for (int i = 0; i < 4; ++i) { gt[i] = key[i] > tau ? 1u : 0u; eq[i] = key[i] == tau ? 1u : 0u; ngt += gt[i]; neq += eq[i]; }
        unsigned sg = ngt, se = neq;
#pragma unroll
        for (int o = 1; o < 64; o <<= 1) { const unsigned tg = __shfl_up(sg, o), te = __shfl_up(se, o); if (lane >= o) { sg += tg; se += te; } }
        if (lane == 63) { wsum[wave] = sg; wsum[8 + wave] = se; }
        __syncthreads();
        unsigned offg = 0u, offe = 0u;
        for (int w = 0; w < wave; ++w) { offg += wsum[w]; offe += wsum[8 + w]; }
        unsigned eqbefore = offe + se - neq;
        unsigned gtbefore = offg + sg - ngt;
        const int slot0 = (e * NB + b) * CAP;
#pragma unroll
        for (int i = 0; i < 4; ++i) { const int s = tid * 4 + i; const bool selq = gt[i] || (eq[i] && eqbefore < krem);
            const unsigned pos = gtbefore + (eqbefore < krem ? eqbefore : krem);
            if ((s >> 10) == half) { sel[(size_t)(b * SEQ + s) * NE + e] = selq ? (int)pos : -1;
                if (selq) { gate[slot0 + pos] = __uint_as_float(key[i]); } }
            if (selq && pos < CAP) list[pos] = s;
            gtbefore += gt[i]; eqbefore += eq[i]; }
        __syncthreads();
        for (int r = wave; r < CAP; r += NWAVES) { const int s = list[r];
            if ((s >> 10) == half) { const uint4* src = (const uint4*)(hb + (size_t)(b * SEQ + s) * DM) + lane; uint4* dstp = (uint4*)(xg + (size_t)(slot0 + r) * DM) + lane; dstp[0] = src[0]; } }
    }
    __syncthreads();
}

DI int t5_bucket(int rel) {
    const int ret = rel > 0 ? 16 : 0; const int n = rel < 0 ? -rel : rel;
    if (n < 8) return ret + n;
    int large = 8 + (int)(logf((float)n / 8.0f) / 4.852030263919617f * 8.0f);
    large = large < 15 ? large : 15;
    return ret + large;
}

typedef short bf16x8_t __attribute__((ext_vector_type(8)));
typedef short bf16x4_t __attribute__((ext_vector_type(4)));
typedef unsigned u32x4_t __attribute__((ext_vector_type(4)));
typedef unsigned u32x2_t __attribute__((ext_vector_type(2)));
typedef __bf16 bf2_t __attribute__((ext_vector_type(2)));
typedef float f2_t __attribute__((ext_vector_type(2)));
DI unsigned cvtpk(float lo, float hi) { const f2_t v = {lo, hi}; return __builtin_bit_cast(unsigned, __builtin_convertvector(v, bf2_t)); }
#define MFMA16(a, b, c) __builtin_amdgcn_mfma_f32_16x16x32_bf16((a), (b), (c), 0, 0, 0)

constexpr int AT_QS = 0, AT_QLD = 72;
constexpr int AT_KS = AT_QS + 128 * AT_QLD * 2;
constexpr int AT_VT = AT_KS + 272 * AT_QLD * 2, AT_VLD = 280;
constexpr int AT_BT = AT_VT + 64 * AT_VLD * 2;
constexpr int AT_END = AT_BT + 132 * 4;
static_assert(AT_END <= MISC_OFF, "attention LDS");

DI void attn_unit(const Args& A, LAS unsigned char* lds, int unit, int tid, int wave, int lane) {
    const bf16* Z = (const bf16*)(A.ws + WS_Z); bf16* ao = (bf16*)(A.ws + WS_ATTO); float* al = (float*)(A.ws + WS_ATTL);
    const int x = unit & 15; int r0 = unit >> 4; const int hh = r0 & 3; r0 >>= 2; const int b = r0 % NB, br = r0 / NB;
    const int dil = br == 0 ? 1 : (br == 1 ? 4 : 16), lsub = SEQ / dil, nblk = lsub / 128;
    const int res = x / nblk, nbk = x % nblk, l0 = nbk * 128, wbase = l0 - 64;
    LAS bf16* Qs = (LAS bf16*)(lds + AT_QS); LAS bf16* Ks = (LAS bf16*)(lds + AT_KS); LAS bf16* Vt = (LAS bf16*)(lds + AT_VT); LAS float* btab = (LAS float*)(lds + AT_BT);
    __syncthreads();
#pragma unroll
    for (int i = 0; i < 2; ++i) { const int id = tid + 512 * i, row = id >> 3, ch = id & 7; const int tok = b * SEQ + (l0 + row) * dil + res;
        *(LAS u32x4_t*)(Qs + row * AT_QLD + ch * 8) = *(const u32x4_t*)(Z + (size_t)tok * ZLD + ZA + hh * 64 + ch * 8); }
    for (int id = tid; id < 272 * 8; id += NTHR) { const int row = id >> 3, ch = id & 7; const int pos = wbase + row; u32x4_t v = (u32x4_t){0u, 0u, 0u, 0u};
        if (row < 256 && pos >= 0 && pos < lsub) v = *(const u32x4_t*)(Z + (size_t)(b * SEQ + pos * dil + res) * ZLD + ZA + 256 + hh * 64 + ch * 8);
        *(LAS u32x4_t*)(Ks + row * AT_QLD + ch * 8) = v; }
    for (int id = tid; id < 272 * 8; id += NTHR) { const int key = id % 272, ch = id / 272; const int pos = wbase + key; u32x4_t v = (u32x4_t){0u, 0u, 0u, 0u};
        if (key < 256 && pos >= 0 && pos < lsub) v = *(const u32x4_t*)(Z + (size_t)(b * SEQ + pos * dil + res) * ZLD + ZA + 512 + hh * 64 + ch * 8);
        LAS bf16* d = Vt + (ch * 8) * AT_VLD + key;
        d[0] = (bf16)(v.x & 0xffffu); d[AT_VLD] = (bf16)(v.x >> 16); d[2 * AT_VLD] = (bf16)(v.y & 0xffffu); d[3 * AT_VLD] = (bf16)(v.y >> 16);
        d[4 * AT_VLD] = (bf16)(v.z & 0xffffu); d[5 * AT_VLD] = (bf16)(v.z >> 16); d[6 * AT_VLD] = (bf16)(v.w & 0xffffu); d[7 * AT_VLD] = (bf16)(v.w >> 16); }
    if (tid < 129) btab[tid] = A.in[I_RELB][t5_bucket((tid - 64) * dil) * 4 + hh];
    __syncthreads();
    const int fr = lane & 15, qd = lane >> 4;
    f32x4 acc[10];
    { bf16x8_t qb[2];
#pragma unroll
      for (int ks = 0; ks < 2; ++ks) qb[ks] = *(const LAS bf16x8_t*)(Qs + (16 * wave + fr) * AT_QLD + ks * 32 + 8 * qd);
#pragma unroll
      for (int j = 0; j < 10; ++j) { acc[j] = (f32x4){0.f, 0.f, 0.f, 0.f};
#pragma unroll
          for (int ks = 0; ks < 2; ++ks) { const bf16x8_t ka = *(const LAS bf16x8_t*)(Ks + (16 * (wave + j) + fr) * AT_QLD + ks * 32 + 8 * qd); acc[j] = MFMA16(ka, qb[ks], acc[j]); } } }
    const int iq = 16 * wave + fr; float mx = -1.0e30f;
#pragma unroll
    for (int j = 0; j < 10; ++j)
#pragma unroll
        for (int r = 0; r < 4; ++r) { const int kw = 16 * (wave + j) + 4 * qd + r; const int m = kw - 64 - iq; const int pos = wbase + kw;
            const bool valid = (m >= -64) && (m <= 64) && (pos >= 0) && (pos < lsub);
            const float s = valid ? acc[j][r] * 0.125f + btab[valid ? m + 64 : 0] : -1.0e30f; acc[j][r] = s; mx = fmaxf(mx, s); }
    mx = fmaxf(mx, __shfl_xor(mx, 16)); mx = fmaxf(mx, __shfl_xor(mx, 32));
    float lsum = 0.f;
#pragma unroll
    for (int j = 0; j < 10; ++j)
#pragma unroll
        for (int r = 0; r < 4; ++r) { const float p = __expf(acc[j][r] - mx); acc[j][r] = p; lsum += p; }
    lsum += __shfl_xor(lsum, 16); lsum += __shfl_xor(lsum, 32);
    f32x4 oacc[4];
#pragma unroll
    for (int d = 0; d < 4; ++d) oacc[d] = (f32x4){0.f, 0.f, 0.f, 0.f};
#pragma unroll
    for (int pp = 0; pp < 5; ++pp) {
        union { unsigned u[4]; bf16x8_t v; } pb;
        pb.u[0] = cvtpk(acc[2 * pp][0], acc[2 * pp][1]); pb.u[1] = cvtpk(acc[2 * pp][2], acc[2 * pp][3]); pb.u[2] = cvtpk(acc[2 * pp + 1][0], acc[2 * pp + 1][1]); pb.u[3] = cvtpk(acc[2 * pp + 1][2], acc[2 * pp + 1][3]);
#pragma unroll
        for (int d = 0; d < 4; ++d) { const LAS bf16* vp = Vt + (16 * d + fr) * AT_VLD + 16 * (wave + 2 * pp) + 4 * qd;
            union { bf16x4_t h[2]; bf16x8_t v; } va; va.h[0] = *(const LAS bf16x4_t*)vp; va.h[1] = *(const LAS bf16x4_t*)(vp + 16);
            oacc[d] = MFMA16(va.v, pb.v, oacc[d]); } }
    const float inv = 1.f / lsum; const int tok = b * SEQ + (l0 + iq) * dil + res;
    bf16* op = ao + ((size_t)br * NT + tok) * AW + hh * 64 + 4 * qd;
#pragma unroll
    for (int d = 0; d < 4; ++d) { uint2 w; w.x = cvtpk(oacc[d][0] * inv, oacc[d][1] * inv); w.y = cvtpk(oacc[d][2] * inv, oacc[d][3] * inv); *(uint2*)(op + 16 * d) = w; }
    if (qd == 0) al[((size_t)br * NT + tok) * 4 + hh] = mx + logf(lsum);
}
constexpr int ATT_UNITS = 3 * NB * 4 * 16, ATT_SCAN_BLK0 = 160, ATT_SPLIT = ATT_UNITS / 2;
DI void phase_attn(const Args& A, LAS unsigned char* lds, int u0, int u1, int b0, int nb, int tid, int wave, int lane) {
    for (int u = u0 + b0; u < u1; u += nb) attn_unit(A, lds, u, tid, wave, lane);
    __syncthreads();
}


constexpr int ML_QLD = 104, ML_SLD = 72;
constexpr int ML_QS = 0;
constexpr int ML_QT = ML_QS + 64 * ML_QLD * 2;
constexpr int ML_KS = ML_QT + 64 * ML_QLD * 2;
constexpr int ML_KT = ML_KS + 64 * ML_QLD * 2;
constexpr int ML_VT = ML_KT + 96 * ML_SLD * 2;
constexpr int ML_WS = ML_VT + 112 * ML_SLD * 2;
constexpr int ML_CT = ML_WS + 64 * ML_SLD * 2;
constexpr int ML_CW = ML_CT + 112 * ML_QLD * 2;
constexpr int ML_END = ML_CW + 6 * 192 * 4;
static_assert(ML_END <= MISC_OFF, "mlstm LDS");

constexpr int MLP_QF = 0, MLP_NI = 12288, MLP_U = 26624, MLP_DEC = 48128, MLP_BYTES = 48384;
constexpr size_t WS_MLPKG = WS_R + 304 * MiB;
static_assert(WS_MLPKG + (size_t)2 * NB * 4 * 32 * MLP_BYTES <= WS_RKY, "mlstm package region");

struct M1Regs { u32x4_t zc[15]; u32x2_t vv[3]; float gi, gf; };
DI void mlstm_m1_fetch(const Args& A, int item, int tid, int lane, M1Regs& R) {
    const bf16* Z = (const bf16*)(A.ws + WS_Z);
    const int c = item & 31, u = item >> 5; const int dir = u / 32, b = (u % 32) / 4, hh = u % 4; const int j = tid >> 3, sub = tid & 7;
    const int tl = dir ? SEQ - 1 - (c * 64 + lane) : c * 64 + lane; const size_t tokl = (size_t)b * SEQ + tl;
    R.gi = bf2f(Z[tokl * ZLD + ZMG + dir * 8 + hh]); R.gf = bf2f(Z[tokl * ZLD + ZMG + dir * 8 + 4 + hh]);
    const int tj = dir ? SEQ - 1 - (c * 64 + j) : c * 64 + j; const size_t tokj = (size_t)b * SEQ + tj;
    const bool isk = sub >= 4; const int zcol = ZMQK + (isk ? 384 : 0) + hh * 96 + (sub & 3) * 24;
#pragma unroll
    for (int tap = 0; tap < 5; ++tap) { const int tt = tj + tap - 2; const bool ok = tt >= 0 && tt < SEQ; const u32x4_t* zp = (const u32x4_t*)(Z + ((size_t)b * SEQ + (ok ? tt : tj)) * ZLD + zcol);
#pragma unroll
        for (int q4 = 0; q4 < 3; ++q4) { const u32x4_t w = zp[q4]; R.zc[tap * 3 + q4] = ok ? w : (u32x4_t){0u, 0u, 0u, 0u}; } }
    const u32x2_t* vp = (const u32x2_t*)(Z + tokj * ZLD + ZMV + hh * 96 + sub * 12);
#pragma unroll
    for (int q2 = 0; q2 < 3; ++q2) R.vv[q2] = vp[q2];
}
DI void mlstm_m1_item(const Args& A, int l, LAS unsigned char* lds, int item, int item_next, M1Regs& R, int& hh_staged, int tid, int wave, int lane) {
    const int c = item & 31, u = item >> 5; const int dir = u / 32, hh = u % 4;
    LAS bf16* Qs = (LAS bf16*)(lds + ML_QS); LAS bf16* Qt = (LAS bf16*)(lds + ML_QT); LAS bf16* Ks = (LAS bf16*)(lds + ML_KS); LAS bf16* KtT = (LAS bf16*)(lds + ML_KT);
    LAS bf16* VtT = (LAS bf16*)(lds + ML_VT); LAS bf16* Ws = (LAS bf16*)(lds + ML_WS); LAS float* cwl = (LAS float*)(lds + ML_CW); LAS float* cbl = cwl + 5 * 192;
    const int fr = lane & 15, qd = lane >> 4;
    unsigned char* pkg = A.ws + WS_MLPKG + (size_t)item * MLP_BYTES;
    __syncthreads();
    if (hh != hh_staged) { hh_staged = hh;
        for (int i = tid; i < 5 * 192; i += NTHR) { const int tap = i / 192, ch = i % 192; cwl[i] = A.in[I_CW][(size_t)(l * 5 + tap) * 768 + (ch < 96 ? 0 : 384) + hh * 96 + (ch % 96)]; }
        for (int i = tid; i < 192; i += NTHR) cbl[i] = A.in[I_CB][(size_t)l * 768 + (i < 96 ? 0 : 384) + hh * 96 + (i % 96)];
        for (int i = tid; i < 16 * ML_SLD; i += NTHR) VtT[96 * ML_SLD + i] = (i < ML_SLD) ? (bf16)0x3F80u : (bf16)0u;
        __syncthreads(); }
    const float ibv = A.in[I_IB][(l * 2 + dir) * 4 + hh], fbv = A.in[I_FB][(l * 2 + dir) * 4 + hh];
    const int j = tid >> 3, sub = tid & 7;
    const float gi = R.gi + ibv, gf = R.gf + fbv;
    float bsum = fminf(gf, 0.f) - __logf(1.f + __expf(-fabsf(gf)));
#pragma unroll
    for (int o = 1; o < 64; o <<= 1) { const float t = __shfl_up(bsum, o); if (lane >= o) bsum += t; }
    const float bend = __shfl(bsum, 63);
    const float bj = __shfl(bsum, j), igj = __shfl(gi, j);
    { const bool isk = sub >= 4; const int c0 = (sub & 3) * 24, cl = (isk ? 96 : 0) + c0;
      float acc[24];
#pragma unroll
      for (int e = 0; e < 24; ++e) acc[e] = cbl[cl + e];
#pragma unroll
      for (int tap = 0; tap < 5; ++tap) {
#pragma unroll
          for (int q4 = 0; q4 < 3; ++q4) { const u32x4_t w = R.zc[tap * 3 + q4]; const LAS float* cwp = cwl + tap * 192 + cl + q4 * 8;
              acc[q4 * 8 + 0] += cwp[0] * __uint_as_float(w.x << 16); acc[q4 * 8 + 1] += cwp[1] * __uint_as_float(w.x & 0xffff0000u);
              acc[q4 * 8 + 2] += cwp[2] * __uint_as_float(w.y << 16); acc[q4 * 8 + 3] += cwp[3] * __uint_as_float(w.y & 0xffff0000u);
              acc[q4 * 8 + 4] += cwp[4] * __uint_as_float(w.z << 16); acc[q4 * 8 + 5] += cwp[5] * __uint_as_float(w.z & 0xffff0000u);
              acc[q4 * 8 + 6] += cwp[6] * __uint_as_float(w.w << 16); acc[q4 * 8 + 7] += cwp[7] * __uint_as_float(w.w & 0xffff0000u); } }
      const float sc1 = isk ? 0.10206207261596575f : 1.f; const float sc2 = isk ? __expf(bend - bj + igj) : __expf(bj);
#pragma unroll
      for (int e = 0; e < 24; ++e) acc[e] = acc[e] * sigm(acc[e]) * sc1;
      if (!isk) { LAS bf16* d1 = Qs + j * ML_QLD + c0; LAS bf16* d2 = Qt + j * ML_QLD + c0;
#pragma unroll
          for (int q4 = 0; q4 < 3; ++q4) { u32x4_t w; w.x = cvtpk(acc[q4 * 8 + 0], acc[q4 * 8 + 1]); w.y = cvtpk(acc[q4 * 8 + 2], acc[q4 * 8 + 3]); w.z = cvtpk(acc[q4 * 8 + 4], acc[q4 * 8 + 5]); w.w = cvtpk(acc[q4 * 8 + 6], acc[q4 * 8 + 7]);
              *(LAS u32x4_t*)(d1 + q4 * 8) = w;
              u32x4_t x; x.x = cvtpk(acc[q4 * 8 + 0] * sc2, acc[q4 * 8 + 1] * sc2); x.y = cvtpk(acc[q4 * 8 + 2] * sc2, acc[q4 * 8 + 3] * sc2); x.z = cvtpk(acc[q4 * 8 + 4] * sc2, acc[q4 * 8 + 5] * sc2); x.w = cvtpk(acc[q4 * 8 + 6] * sc2, acc[q4 * 8 + 7] * sc2);
              *(LAS u32x4_t*)(d2 + q4 * 8) = x; } }
      else { LAS bf16* d1 = Ks + j * ML_QLD + c0;
#pragma unroll
          for (int q4 = 0; q4 < 3; ++q4) { u32x4_t w; w.x = cvtpk(acc[q4 * 8 + 0], acc[q4 * 8 + 1]); w.y = cvtpk(acc[q4 * 8 + 2], acc[q4 * 8 + 3]); w.z = cvtpk(acc[q4 * 8 + 4], acc[q4 * 8 + 5]); w.w = cvtpk(acc[q4 * 8 + 6], acc[q4 * 8 + 7]);
              *(LAS u32x4_t*)(d1 + q4 * 8) = w; }
#pragma unroll
          for (int e = 0; e < 24; ++e) KtT[(c0 + e) * ML_SLD + j] = (bf16)f2bf(acc[e] * sc2); } }
    { const int n0 = sub * 12;
#pragma unroll
      for (int q2 = 0; q2 < 3; ++q2) { const u32x2_t w = R.vv[q2]; LAS bf16* d = VtT + (n0 + q2 * 4) * ML_SLD + j;
          d[0] = (bf16)(w.x & 0xffffu); d[ML_SLD] = (bf16)(w.x >> 16); d[2 * ML_SLD] = (bf16)(w.y & 0xffffu); d[3 * ML_SLD] = (bf16)(w.y >> 16); } }
    if (item_next >= 0) mlstm_m1_fetch(A, item_next, tid, lane, R);
    __syncthreads();
#pragma unroll
    for (int i = 0; i < 2; ++i) { const int tile = 2 * wave + i, jt = tile >> 2, st = tile & 3; const int jq = 16 * jt + fr;
        u32x2_t w = (u32x2_t){0u, 0u};
        if (st <= jt) { f32x4 acc = (f32x4){0.f, 0.f, 0.f, 0.f};
#pragma unroll
            for (int ks = 0; ks < 3; ++ks) { const bf16x8_t a = *(const LAS bf16x8_t*)(Ks + (16 * st + fr) * ML_QLD + 32 * ks + 8 * qd); const bf16x8_t bq = *(const LAS bf16x8_t*)(Qs + jq * ML_QLD + 32 * ks + 8 * qd); acc = MFMA16(a, bq, acc); }
            const float bjq = __shfl(bsum, jq); float wv[4];
#pragma unroll
            for (int r = 0; r < 4; ++r) { const int s = 16 * st + 4 * qd + r; const float bs = __shfl(bsum, s), igs = __shfl(gi, s); wv[r] = (s <= jq) ? acc[r] * __expf(bjq - bs + igs) : 0.f; }
            w.x = cvtpk(wv[0], wv[1]); w.y = cvtpk(wv[2], wv[3]); }
        *(LAS u32x2_t*)(Ws + jq * ML_SLD + 16 * st + 4 * qd) = w; }
    __syncthreads();
    for (int id = wave; id < 12; id += NWAVES) { const int jt = id / 3, i3 = id % 3; const LAS bf16* p = Qt + (16 * jt + fr) * ML_QLD + 32 * i3 + 4 * qd; const u32x2_t lo = *(const LAS u32x2_t*)p, hi = *(const LAS u32x2_t*)(p + 16);
        *(u32x4_t*)(pkg + MLP_QF + (size_t)id * 1024 + lane * 16) = (u32x4_t){lo.x, lo.y, hi.x, hi.y}; }
    for (int id = wave; id < 70; id += NWAVES) { f32x4 acc = (f32x4){0.f, 0.f, 0.f, 0.f}; int nt; const LAS bf16* ap; int ald; unsigned char* dst;
        if (id < 28) { const int jt = id & 3; nt = id >> 2; ap = Ws + (16 * jt + fr) * ML_SLD; ald = 0; dst = pkg + MLP_NI + (size_t)(nt * 4 + jt) * 512; }
        else { const int q = id - 28, kt = q % 6; nt = q / 6; ap = KtT + (16 * kt + fr) * ML_SLD; ald = 0; dst = pkg + MLP_U + (size_t)(nt * 6 + kt) * 512; }
#pragma unroll
        for (int ks = 0; ks < 2; ++ks) { const bf16x8_t a = *(const LAS bf16x8_t*)(ap + 32 * ks + 8 * qd); const bf16x8_t bv = *(const LAS bf16x8_t*)(VtT + (16 * nt + fr) * ML_SLD + 32 * ks + 8 * qd); acc = MFMA16(a, bv, acc); }
        u32x2_t w; w.x = cvtpk(acc[0], acc[1]); w.y = cvtpk(acc[2], acc[3]); *(u32x2_t*)(dst + lane * 8) = w; }
    if (tid < 64) ((float*)(pkg + MLP_DEC))[tid] = __expf(bend);
}
DI void phase_mlstm_m1(const Args& A, int l, LAS unsigned char* lds, int bid, int G, int tid, int wave, int lane) {
    int hh_staged = -1; constexpr int NIT = 2 * NB * 4 * 32;
    if (bid < NIT) { M1Regs R; mlstm_m1_fetch(A, bid, tid, lane, R);
        for (int it = bid; it < NIT; it += G) mlstm_m1_item(A, l, lds, it, (it + G < NIT) ? it + G : -1, R, hh_staged, tid, wave, lane); }
    __syncthreads();
}
constexpr int M2_SLOTS = 8, M2_SLOT_BYTES = 12288, M2_CTL = M2_SLOTS * M2_SLOT_BYTES;
static_assert(M2_CTL + 64 <= MISC_OFF, "mlstm m2 LDS");
DI f32x4 unpk4(const u32x2_t w) { return (f32x4){__uint_as_float(w.x << 16), __uint_as_float(w.x & 0xffff0000u), __uint_as_float(w.y << 16), __uint_as_float(w.y & 0xffff0000u)}; }
struct M2Small { u32x2_t ni[4], uu[6]; float dec; };
DI void m2_load_small(M2Small& o, const unsigned char* pkg, int nt, int lane) {
#pragma unroll
    for (int jt = 0; jt < 4; ++jt) o.ni[jt] = *(const u32x2_t*)(pkg + MLP_NI + (nt * 4 + jt) * 512 + lane * 8);
#pragma unroll
    for (int kt = 0; kt < 6; ++kt) o.uu[kt] = *(const u32x2_t*)(pkg + MLP_U + (nt * 6 + kt) * 512 + lane * 8);
    o.dec = ((const float*)(pkg + MLP_DEC))[lane];
}
DI void m2_step(const M2Small& o, const LAS unsigned char* slot, f32x4 (&C)[6], bf16* num, float* den, int dir, int b, int hh, int nt, int c, int lane, int fr, int qd) {
    union { unsigned u[4]; bf16x8_t v; } sB[3];
#pragma unroll
    for (int i = 0; i < 3; ++i) { sB[i].u[0] = cvtpk(C[2 * i][0], C[2 * i][1]); sB[i].u[1] = cvtpk(C[2 * i][2], C[2 * i][3]); sB[i].u[2] = cvtpk(C[2 * i + 1][0], C[2 * i + 1][1]); sB[i].u[3] = cvtpk(C[2 * i + 1][2], C[2 * i + 1][3]); }
#pragma unroll
    for (int jt = 0; jt < 4; ++jt) { f32x4 acc = unpk4(o.ni[jt]);
#pragma unroll
        for (int i = 0; i < 3; ++i) { const bf16x8_t qf = *(const LAS bf16x8_t*)(slot + (3 * jt + i) * 1024 + lane * 16); acc = MFMA16(qf, sB[i].v, acc); }
#pragma unroll
        for (int r = 0; r < 4; ++r) { const int jj = 16 * jt + 4 * qd + r; const int tt = dir ? SEQ - 1 - (c * 64 + jj) : c * 64 + jj; const size_t tok = (size_t)b * SEQ + tt;
            if (nt < 6) num[((size_t)dir * NT + tok) * MW + hh * 96 + 16 * nt + fr] = (bf16)f2bf(acc[r]); else if (fr == 0) den[((size_t)dir * NT + tok) * 4 + hh] = acc[r]; } }
#pragma unroll
    for (int kt = 0; kt < 6; ++kt) C[kt] = C[kt] * o.dec + unpk4(o.uu[kt]);
}
DI void mlstm_m2_unit(const Args& A, LAS unsigned char* lds, int u, int tid, int wave, int lane) {
    bf16* num = (bf16*)(A.ws + WS_MLNUM); float* den = (float*)(A.ws + WS_MLDEN);
    const int dir = u / 32, b = (u % 32) / 4, hh = u % 4; const int fr = lane & 15, qd = lane >> 4;
    const unsigned char* pkg0 = A.ws + WS_MLPKG + (size_t)u * 32 * MLP_BYTES;
    volatile LAS unsigned* ready = (volatile LAS unsigned*)(lds + M2_CTL); volatile LAS unsigned* consumed = ready + 8;
    __syncthreads();
    if (tid < 16) ready[tid] = 0u;
    __syncthreads();
    if (wave == 7) {
        u32x4_t f0[12], f1[12], f2[12];
#define M2_FETCH(dst, c_) do { _Pragma("unroll") for (int i = 0; i < 12; ++i) dst[i] = *(const u32x4_t*)(pkg0 + (size_t)(c_) * MLP_BYTES + MLP_QF + i * 1024 + lane * 16); } while (0)
#define M2_PUBLISH(src, c_) do { if ((c_) >= M2_SLOTS) { const unsigned need = (unsigned)((c_) - M2_SLOTS + 1); unsigned spins = 0; \
            for (;;) { bool ok = true; _Pragma("unroll") for (int w = 0; w < 7; ++w) ok = ok && (consumed[w] >= need); if (ok) break; if (++spins > (1u << 22)) break; __builtin_amdgcn_s_sleep(1); } } \
        LAS unsigned char* slot_ = lds + ((c_) & (M2_SLOTS - 1)) * M2_SLOT_BYTES; _Pragma("unroll") for (int i = 0; i < 12; ++i) *(LAS u32x4_t*)(slot_ + i * 1024 + lane * 16) = src[i]; \
        asm volatile("s_waitcnt lgkmcnt(0)" ::: "memory"); if (lane == 0) ready[(c_) & (M2_SLOTS - 1)] = (unsigned)((c_) + 1); asm volatile("" ::: "memory"); } while (0)
        M2_FETCH(f0, 0); M2_FETCH(f1, 1);
        for (int c = 0; c < 30; c += 3) { M2_FETCH(f2, c + 2); M2_PUBLISH(f0, c); M2_FETCH(f0, c + 3); M2_PUBLISH(f1, c + 1); M2_FETCH(f1, c + 4); M2_PUBLISH(f2, c + 2); }
        M2_PUBLISH(f0, 30); M2_PUBLISH(f1, 31);
#undef M2_FETCH
#undef M2_PUBLISH
    } else {
        const int nt = wave; f32x4 C[6];
#pragma unroll
        for (int kt = 0; kt < 6; ++kt) C[kt] = (f32x4){0.f, 0.f, 0.f, 0.f};
        M2Small s0, s1, s2, s3;
        m2_load_small(s0, pkg0, nt, lane); m2_load_small(s1, pkg0 + MLP_BYTES, nt, lane); m2_load_small(s2, pkg0 + 2 * (size_t)MLP_BYTES, nt, lane); m2_load_small(s3, pkg0 + 3 * (size_t)MLP_BYTES, nt, lane);
#define M2_CHAIN(sx, c_) do { unsigned spins = 0; while (ready[(c_) & (M2_SLOTS - 1)] != (unsigned)((c_) + 1)) { if (++spins > (1u << 22)) break; __builtin_amdgcn_s_sleep(1); } asm volatile("" ::: "memory"); \
            m2_step(sx, lds + ((c_) & (M2_SLOTS - 1)) * M2_SLOT_BYTES, C, num, den, dir, b, hh, nt, (c_), lane, fr, qd); \
            asm volatile("s_waitcnt lgkmcnt(0)" ::: "memory"); if (lane == 0) consumed[nt] = (unsigned)((c_) + 1); asm volatile("" ::: "memory"); \
            if ((c_) + 4 < 32) m2_load_small(sx, pkg0 + (size_t)((c_) + 4) * MLP_BYTES, nt, lane); } while (0)
        for (int c = 0; c < 32; c += 4) { M2_CHAIN(s0, c); M2_CHAIN(s1, c + 1); M2_CHAIN(s2, c + 2); M2_CHAIN(s3, c + 3); }
#undef M2_CHAIN
    }
    __syncthreads();
}

constexpr int PKG_BYTES = 12544;
constexpr int PK_AH = 0, PK_RH = 2048, PK_KB = 4096, PK_VV = 8192, PK_TM = 10240, PK_MM = 10752, PK_LAK = 11776, PK_GE = 12288;
constexpr size_t WS_PKG = WS_PR;
static_assert((size_t)2 * NB * 6 * 128 * PKG_BYTES <= 288 * MiB, "package region");
constexpr int R1_W2T = 0, R1_A2T = 9216, R1_WV = 18432, R1_WV_BYTES = 12928;
constexpr int R1_IMG = 0, R1_LF = 9216, R1_MT = 10368;
static_assert(R1_WV + 8 * R1_WV_BYTES <= MISC_OFF, "rwkv r1 LDS");

DI bf16x4_t pack4(const f32x4 v) { union { unsigned u[2]; bf16x4_t h; } x; x.u[0] = cvtpk(v[0], v[1]); x.u[1] = cvtpk(v[2], v[3]); return x.h; }

DI void rwkv_r1_item(const Args& A, int l, LAS unsigned char* lds, int item, int& dh_staged, int tid, int wave, int lane) {
    const bf16* Z = (const bf16*)(A.ws + WS_Z);
    const int g = item & 15; int r0 = item >> 4; const int hh = r0 % 6; r0 /= 6; const int b = r0 % NB, dir = r0 / NB;
    const int cc = 8 * g + wave, fr = lane & 15, qd = lane >> 4;
    LAS bf16* W2T = (LAS bf16*)(lds + R1_W2T); LAS bf16* A2T = (LAS bf16*)(lds + R1_A2T);
    LAS unsigned char* wv = lds + R1_WV + wave * R1_WV_BYTES;
    LAS bf16* IMG = (LAS bf16*)(wv + R1_IMG); LAS float* Lf = (LAS float*)(wv + R1_LF); LAS bf16* MT = (LAS bf16*)(wv + R1_MT);
    if (dh_staged != dir * 6 + hh) { dh_staged = dir * 6 + hh;
    __syncthreads();
    { const int ch = tid & 63, i0 = (tid >> 6) * 8; const float* w2 = A.in[I_W2] + ((size_t)(l * 2 + dir) * 64 + i0) * RW + hh * 64 + ch; const float* a2 = A.in[I_A2] + ((size_t)(l * 2 + dir) * 64 + i0) * RW + hh * 64 + ch;
      u32x4_t pw, pa; pw.x = cvtpk(w2[0], w2[RW]); pw.y = cvtpk(w2[2 * RW], w2[3 * RW]); pw.z = cvtpk(w2[4 * RW], w2[5 * RW]); pw.w = cvtpk(w2[6 * RW], w2[7 * RW]);
      pa.x = cvtpk(a2[0], a2[RW]); pa.y = cvtpk(a2[2 * RW], a2[3 * RW]); pa.z = cvtpk(a2[4 * RW], a2[5 * RW]); pa.w = cvtpk(a2[6 * RW], a2[7 * RW]);
      *(LAS u32x4_t*)(W2T + ch * 72 + i0) = pw; *(LAS u32x4_t*)(A2T + ch * 72 + i0) = pa; }
    __syncthreads(); }
    const int sgn = dir ? -1 : 1; const int tok0 = b * SEQ + (dir ? SEQ - 1 - 16 * cc : 16 * cc);
    const float* mu = A.in[I_MU] + (size_t)(l * 2 + dir) * 1280;
    float er[4][4], ek[4][4], ev[4][4], pr4[4], pk4[4], pv4[4];
    { const bool ext = (qd == 0) && (cc > 0); const size_t prow = (size_t)(ext ? tok0 - sgn : tok0 + sgn * (4 * qd)) * ZLD;
#pragma unroll
      for (int nt = 0; nt < 4; ++nt) {
#pragma unroll
          for (int r = 0; r < 4; ++r) { const bf16* zp = Z + (size_t)(tok0 + sgn * (4 * qd + r)) * ZLD + ZRKV + hh * 64 + 16 * nt + fr; er[nt][r] = bf2f(zp[0]); ek[nt][r] = bf2f(zp[RW]); ev[nt][r] = bf2f(zp[2 * RW]); }
          const bf16* zq = Z + prow + ZRKV + hh * 64 + 16 * nt + fr; pr4[nt] = bf2f(zq[0]); pk4[nt] = bf2f(zq[RW]); pv4[nt] = bf2f(zq[2 * RW]); }
      asm volatile("" : "+v"(er[0][0]), "+v"(pr4[3]));
#pragma unroll
      for (int nt = 0; nt < 4; ++nt) {
        float pr = __shfl(er[nt][3], lane - 16), pk = __shfl(ek[nt][3], lane - 16), pv = __shfl(ev[nt][3], lane - 16);
        if (qd == 0) { pr = ext ? pr4[nt] : 0.f; pk = ext ? pk4[nt] : 0.f; pv = ext ? pv4[nt] : 0.f; }
        const float mr = mu[hh * 64 + 16 * nt + fr], mk = mu[RW + hh * 64 + 16 * nt + fr], mv = mu[2 * RW + hh * 64 + 16 * nt + fr];
#pragma unroll
        for (int r = 3; r >= 0; --r) { const float qr = r ? er[nt][r - 1] : pr, qk = r ? ek[nt][r - 1] : pk, qv = r ? ev[nt][r - 1] : pv;
            er[nt][r] += mr * (qr - er[nt][r]); ek[nt][r] += mk * (qk - ek[nt][r]); ev[nt][r] += mv * (qv - ev[nt][r]); }
      } }
    bf16x8_t thA[2], adA[2];
    { const int zwd = dir ? ZWDB : ZWDF, zad = dir ? ZADB : ZADF; const bool hasp = !(cc == 0 && fr == 0);
      const bf16* zc = Z + (size_t)(tok0 + sgn * fr) * ZLD; const bf16* zq = Z + (size_t)(tok0 + sgn * (fr - 1)) * ZLD;
#pragma unroll
      for (int ks = 0; ks < 2; ++ks) { float cw[8], pw[8], ca[8], pa[8];
          unpack8(*(const uint4*)(zc + zwd + 32 * ks + 8 * qd), cw); unpack8(*(const uint4*)(zc + zad + 32 * ks + 8 * qd), ca);
          if (hasp) { unpack8(*(const uint4*)(zq + zwd + 32 * ks + 8 * qd), pw); unpack8(*(const uint4*)(zq + zad + 32 * ks + 8 * qd), pa); }
          else {
#pragma unroll
              for (int e = 0; e < 8; ++e) { pw[e] = 0.f; pa[e] = 0.f; } }
          const float* muw = mu + 1152 + 32 * ks + 8 * qd; const float* mua = mu + 1216 + 32 * ks + 8 * qd;
#pragma unroll
          for (int e = 0; e < 8; ++e) { const float xw = cw[e] + muw[e] * (pw[e] - cw[e]); cw[e] = 1.f - 2.f * __builtin_amdgcn_rcpf(1.f + __expf(2.f * xw)); ca[e] = ca[e] + mua[e] * (pa[e] - ca[e]); }
          union { unsigned u[4]; bf16x8_t v; } x, y;
#pragma unroll
          for (int e = 0; e < 4; ++e) { x.u[e] = cvtpk(cw[2 * e], cw[2 * e + 1]); y.u[e] = cvtpk(ca[2 * e], ca[2 * e + 1]); }
          thA[ks] = x.v; adA[ks] = y.v; } }
    f32x4 wl[4], al[4];
#pragma unroll
    for (int nt = 0; nt < 4; ++nt) { wl[nt] = (f32x4){0.f, 0.f, 0.f, 0.f}; al[nt] = (f32x4){0.f, 0.f, 0.f, 0.f};
#pragma unroll
        for (int ks = 0; ks < 2; ++ks) { const bf16x8_t bw = *(const LAS bf16x8_t*)(W2T + (16 * nt + fr) * 72 + 32 * ks + 8 * qd); const bf16x8_t ba = *(const LAS bf16x8_t*)(A2T + (16 * nt + fr) * 72 + 32 * ks + 8 * qd);
            wl[nt] = MFMA16(thA[ks], bw, wl[nt]); al[nt] = MFMA16(adA[ks], ba, al[nt]); } }
    float lw[4][4], alp[4][4], kap[4][4]; float ssq[4] = {0.f, 0.f, 0.f, 0.f}, bsm[4] = {0.f, 0.f, 0.f, 0.f};
#pragma unroll
    for (int nt = 0; nt < 4; ++nt) { const int ch = hh * 64 + 16 * nt + fr;
        const float w0v = A.in[I_W0][(size_t)(l * 2 + dir) * RW + ch], a0v = A.in[I_A0][(size_t)(l * 2 + dir) * RW + ch], kkw = A.in[I_KK][(size_t)l * RW + ch], kaw = A.in[I_KA][(size_t)l * RW + ch], rkw = A.in[I_RK][(size_t)l * RW + ch];
#pragma unroll
        for (int r = 0; r < 4; ++r) { const float x = w0v + wl[nt][r]; const float nx = -x; const float sp = fmaxf(nx, 0.f) + __logf(1.f + __expf(-fabsf(nx)));
            lw[nt][r] = -__expf(-sp - 0.5f);
            const float a = __builtin_amdgcn_rcpf(1.f + __expf(-(a0v + al[nt][r]))); alp[nt][r] = a;
            const float k0 = ek[nt][r]; kap[nt][r] = k0 * kkw; ek[nt][r] = k0 * (1.f + (a - 1.f) * kaw);
            ssq[r] += kap[nt][r] * kap[nt][r]; bsm[r] += er[nt][r] * ek[nt][r] * rkw; } }
#pragma unroll
    for (int r = 0; r < 4; ++r) {
#pragma unroll
        for (int o = 1; o < 16; o <<= 1) { ssq[r] += __shfl_xor(ssq[r], o); bsm[r] += __shfl_xor(bsm[r], o); }
        ssq[r] = __builtin_amdgcn_rsqf(fmaxf(ssq[r], 1e-24f)); }
    { bf16* bon = (bf16*)(A.ws + WS_RKB);
#pragma unroll
      for (int nt = 0; nt < 4; ++nt)
#pragma unroll
          for (int r = 0; r < 4; ++r) { kap[nt][r] *= ssq[r]; bon[((size_t)dir * NT + tok0 + sgn * (4 * qd + r)) * RW + hh * 64 + 16 * nt + fr] = (bf16)f2bf(bsm[r] * ev[nt][r]); } }
    unsigned char* pkg = A.ws + WS_PKG + ((size_t)((dir * NB + b) * 6 + hh) * 128 + cc) * PKG_BYTES;
    float lend[4];
    u32x2_t btf[4], ktf[4];
#pragma unroll
    for (int nt = 0; nt < 4; ++nt) { float lam[4]; lam[0] = lw[nt][0]; lam[1] = lam[0] + lw[nt][1]; lam[2] = lam[1] + lw[nt][2]; lam[3] = lam[2] + lw[nt][3];
        const float t1 = __shfl(lam[3], lane - 16), t2 = __shfl(lam[3], lane - 32), t3 = __shfl(lam[3], lane - 48);
        const float off = (qd >= 1 ? t1 : 0.f) + (qd >= 2 ? t2 : 0.f) + (qd >= 3 ? t3 : 0.f);
#pragma unroll
        for (int r = 0; r < 4; ++r) lam[r] += off;
        lend[nt] = __shfl(lam[3], 48 + fr);
        float bt4[4], kt4[4];
        float epv[4];
#pragma unroll
        for (int r = 0; r < 4; ++r) epv[r] = __expf(lam[r]);
        float ep_prev = __shfl(epv[3], lane - 16); if (qd == 0) ep_prev = 1.f;
        const float eendall = __expf(lend[nt]);
#pragma unroll
        for (int r = 0; r < 4; ++r) { const float ep = epv[r], epm = r ? epv[r - 1] : ep_prev, einv = __builtin_amdgcn_rcpf(ep), eend = eendall * einv;
            const float bb = kap[nt][r] * alp[nt][r]; const int o = (4 * qd + r) * 72 + 16 * nt + fr;
            IMG[o] = (bf16)f2bf(-kap[nt][r] * epm); IMG[1152 + o] = (bf16)f2bf(er[nt][r] * ep); IMG[2304 + o] = (bf16)f2bf(bb * einv); IMG[3456 + o] = (bf16)f2bf(ek[nt][r] * einv);
            bt4[r] = bb * eend; kt4[r] = ek[nt][r] * eend; }
        btf[nt].x = cvtpk(bt4[0], bt4[1]); btf[nt].y = cvtpk(bt4[2], bt4[3]); ktf[nt].x = cvtpk(kt4[0], kt4[1]); ktf[nt].y = cvtpk(kt4[2], kt4[3]); }
    asm volatile("s_waitcnt lgkmcnt(0)" ::: "memory");
    f32x4 Lab = (f32x4){0.f, 0.f, 0.f, 0.f}, Lak = Lab, Mrb = Lab, Mrk = Lab;
#pragma unroll
    for (int ks = 0; ks < 2; ++ks) { const int o = fr * 72 + 32 * ks + 8 * qd;
        const bf16x8_t aA = *(const LAS bf16x8_t*)(IMG + o), aR = *(const LAS bf16x8_t*)(IMG + 1152 + o), bB = *(const LAS bf16x8_t*)(IMG + 2304 + o), bK = *(const LAS bf16x8_t*)(IMG + 3456 + o);
        Lab = MFMA16(aA, bB, Lab); Lak = MFMA16(aA, bK, Lak); Mrb = MFMA16(aR, bB, Mrb); Mrk = MFMA16(aR, bK, Mrk); }
#pragma unroll
    for (int r = 0; r < 4; ++r) { const int t = 4 * qd + r; if (!(fr < t)) { Lab[r] = 0.f; Lak[r] = 0.f; } if (!(fr <= t)) { Mrb[r] = 0.f; Mrk[r] = 0.f; } Lf[t * 17 + fr] = Lab[r]; }
    asm volatile("s_waitcnt lgkmcnt(0)" ::: "memory");
    float Tc[16];
#pragma unroll
    for (int t = 0; t < 16; ++t) { float acc = (t == fr) ? 1.f : 0.f;
#pragma unroll
        for (int s = 0; s < t; ++s) acc += Lf[t * 17 + s] * Tc[s];
        Tc[t] = acc; }
    f32x4 Tm;
#pragma unroll
    for (int r = 0; r < 4; ++r) Tm[r] = qd == 0 ? Tc[r] : (qd == 1 ? Tc[4 + r] : (qd == 2 ? Tc[8 + r] : Tc[12 + r]));
#pragma unroll
    for (int r = 0; r < 4; ++r) { const int o = (4 * qd + r) * 20 + fr; MT[o] = (bf16)f2bf(Tm[r]); MT[320 + o] = (bf16)f2bf(Mrb[r]); MT[640 + o] = (bf16)f2bf(Lak[r]); MT[960 + o] = (bf16)f2bf(Mrk[r]); }
    asm volatile("s_waitcnt lgkmcnt(0)" ::: "memory");
    { const int o = fr * 20 + 4 * qd;
      const u32x2_t mrb = *(const LAS u32x2_t*)(MT + 320 + o), mrk = *(const LAS u32x2_t*)(MT + 960 + o);
      *(u32x2_t*)(pkg + PK_TM + lane * 8) = *(const LAS u32x2_t*)(MT + o); *(u32x2_t*)(pkg + PK_LAK + lane * 8) = *(const LAS u32x2_t*)(MT + 640 + o);
      *(u32x4_t*)(pkg + PK_MM + lane * 16) = (u32x4_t){mrk.x, mrk.y, mrb.x, mrb.y}; }
#pragma unroll
    for (int ks = 0; ks < 2; ++ks) { const int o = fr * 72 + 32 * ks + 4 * qd;
        const u32x2_t alo = *(const LAS u32x2_t*)(IMG + o), ahi = *(const LAS u32x2_t*)(IMG + o + 16), rlo = *(const LAS u32x2_t*)(IMG + 1152 + o), rhi = *(const LAS u32x2_t*)(IMG + 1152 + o + 16);
        *(u32x4_t*)(pkg + PK_AH + ks * 1024 + lane * 16) = (u32x4_t){alo.x, alo.y, ahi.x, ahi.y}; *(u32x4_t*)(pkg + PK_RH + ks * 1024 + lane * 16) = (u32x4_t){rlo.x, rlo.y, rhi.x, rhi.y}; }
#pragma unroll
    for (int nt = 0; nt < 4; ++nt) { *(u32x4_t*)(pkg + PK_KB + nt * 1024 + lane * 16) = (u32x4_t){ktf[nt].x, ktf[nt].y, btf[nt].x, btf[nt].y};
        u32x2_t vf; vf.x = cvtpk(ev[nt][0], ev[nt][1]); vf.y = cvtpk(ev[nt][2], ev[nt][3]); *(u32x2_t*)(pkg + PK_VV + nt * 512 + lane * 8) = vf;
        if (qd == 0) ((float*)(pkg + PK_GE))[16 * nt + fr] = __expf(lend[nt]); }
    asm volatile("s_waitcnt lgkmcnt(0)" ::: "memory");
}
DI void phase_rwkv_r1(const Args& A, int l, LAS unsigned char* lds, int bid, int G, int tid, int wave, int lane) {
    constexpr int NIT = 2 * NB * 6 * 16; int dh_staged = -1;
    __syncthreads();
    for (int it = bid; it < NIT; it += G) rwkv_r1_item(A, l, lds, it, dh_staged, tid, wave, lane);
    __syncthreads();
}

struct RkOps { bf16x8_t ah[2], rh[2], kb[4], mm; bf16x4_t vv, tm, lak; f32x4 ge[4]; };
DI bf16x8_t widen4(const bf16x4_t a) { return __builtin_shufflevector(a, (bf16x4_t){0, 0, 0, 0}, 0, 1, 2, 3, 4, 5, 6, 7); }
DI void rk_step(const RkOps& c, f32x4 (&sT)[4], bf16* yb, int dir, int b, int hh, int vb, int cc, int fr, int qd) {
    const f32x4 zero4 = (f32x4){0.f, 0.f, 0.f, 0.f};
    union { unsigned u[4]; bf16x8_t v; } s0, s1;
    s0.u[0] = cvtpk(sT[0][0], sT[0][1]); s0.u[1] = cvtpk(sT[0][2], sT[0][3]); s0.u[2] = cvtpk(sT[1][0], sT[1][1]); s0.u[3] = cvtpk(sT[1][2], sT[1][3]);
    s1.u[0] = cvtpk(sT[2][0], sT[2][1]); s1.u[1] = cvtpk(sT[2][2], sT[2][3]); s1.u[2] = cvtpk(sT[3][0], sT[3][1]); s1.u[3] = cvtpk(sT[3][2], sT[3][3]);
    f32x4 ax = MFMA16(widen4(c.lak), widen4(c.vv), zero4); ax = MFMA16(c.ah[0], s0.v, ax); ax = MFMA16(c.ah[1], s1.v, ax);
    f32x4 ay = MFMA16(c.rh[0], s0.v, zero4); ay = MFMA16(c.rh[1], s1.v, ay);
    const f32x4 au = MFMA16(widen4(c.tm), widen4(pack4(ax)), zero4);
    const bf16x8_t vu = __builtin_shufflevector(c.vv, pack4(au), 0, 1, 2, 3, 4, 5, 6, 7);
    ay = MFMA16(c.mm, vu, ay);
#pragma unroll
    for (int kt = 0; kt < 4; ++kt) sT[kt] = MFMA16(c.kb[kt], vu, sT[kt] * c.ge[kt]);
    const int sgn = dir ? -1 : 1; const int tok0 = b * SEQ + (dir ? SEQ - 1 - 16 * cc : 16 * cc);
#pragma unroll
    for (int r = 0; r < 4; ++r) yb[((size_t)dir * NT + tok0 + sgn * (4 * qd + r)) * RW + hh * 64 + 16 * vb + fr] = (bf16)f2bf(ay[r]);
}
constexpr int R2_SLOTS = 8, R2_CTL = R2_SLOTS * PKG_BYTES;
static_assert(R2_CTL + 64 <= MISC_OFF, "rwkv r2 LDS");
DI void rk_load_lds(RkOps& o, const LAS unsigned char* pkg, int vb, int lane, int qd) {
#pragma unroll
    for (int ks = 0; ks < 2; ++ks) { o.ah[ks] = *(const LAS bf16x8_t*)(pkg + PK_AH + ks * 1024 + lane * 16); o.rh[ks] = *(const LAS bf16x8_t*)(pkg + PK_RH + ks * 1024 + lane * 16); }
#pragma unroll
    for (int kt = 0; kt < 4; ++kt) { o.kb[kt] = *(const LAS bf16x8_t*)(pkg + PK_KB + kt * 1024 + lane * 16); o.ge[kt] = *(const LAS f32x4*)(pkg + PK_GE + (16 * kt + 4 * qd) * 4); }
    o.mm = *(const LAS bf16x8_t*)(pkg + PK_MM + lane * 16);
    o.vv = *(const LAS bf16x4_t*)(pkg + PK_VV + vb * 512 + lane * 8); o.tm = *(const LAS bf16x4_t*)(pkg + PK_TM + lane * 8); o.lak = *(const LAS bf16x4_t*)(pkg + PK_LAK + lane * 8);
}
DI void rk_pkg_fetch(u32x4_t (&buf)[13], const unsigned char* pkg, int lane) {
#pragma unroll
    for (int i = 0; i < 12; ++i) buf[i] = *(const u32x4_t*)(pkg + i * 1024 + lane * 16);
    buf[12] = (lane < 16) ? *(const u32x4_t*)(pkg + 12288 + lane * 16) : (u32x4_t){0u, 0u, 0u, 0u};
}
DI void rwkv_r2_unit(const Args& A, LAS unsigned char* lds, int u, int tid, int wave, int lane) {
    bf16* yb = (bf16*)(A.ws + WS_RKY);
    const int dir = u / 48, rem = u % 48, b = rem / 6, hh = rem % 6; const int fr = lane & 15, qd = lane >> 4;
    const unsigned char* pkg0 = A.ws + WS_PKG + ((size_t)((dir * NB + b) * 6 + hh) * 128) * PKG_BYTES;
    volatile LAS unsigned* ready = (volatile LAS unsigned*)(lds + R2_CTL); volatile LAS unsigned* consumed = ready + 8;
    __syncthreads();
    if (tid < 16) ready[tid] = 0u;
    __syncthreads();
    if (wave >= 4) {
        const int j = wave - 4; u32x4_t cur[13], nxt[13];
        rk_pkg_fetch(cur, pkg0 + (size_t)j * PKG_BYTES, lane);
        for (int cc = j; cc < 128; cc += 4) {
            if (cc + 4 < 128) rk_pkg_fetch(nxt, pkg0 + (size_t)(cc + 4) * PKG_BYTES, lane);
            if (cc >= R2_SLOTS) { const unsigned need = (unsigned)(cc - R2_SLOTS + 1); unsigned spins = 0;
                for (;;) { const unsigned c0 = consumed[0], c1 = consumed[1], c2 = consumed[2], c3 = consumed[3];
                    if (c0 >= need && c1 >= need && c2 >= need && c3 >= need) break; if (++spins > (1u << 22)) break; __builtin_amdgcn_s_sleep(1); } }
            LAS unsigned char* slot = lds + (cc & (R2_SLOTS - 1)) * PKG_BYTES;
#pragma unroll
            for (int i = 0; i < 12; ++i) *(LAS u32x4_t*)(slot + i * 1024 + lane * 16) = cur[i];
            if (lane < 16) *(LAS u32x4_t*)(slot + 12288 + lane * 16) = cur[12];
            asm volatile("s_waitcnt lgkmcnt(0)" ::: "memory");
            if (lane == 0) ready[cc & (R2_SLOTS - 1)] = (unsigned)(cc + 1);
            asm volatile("" ::: "memory");
#pragma unroll
            for (int i = 0; i < 13; ++i) cur[i] = nxt[i];
        }
    } else {
        const int vb = wave; f32x4 sT[4];
#pragma unroll
        for (int kt = 0; kt < 4; ++kt) sT[kt] = (f32x4){0.f, 0.f, 0.f, 0.f};
#define RK_WAIT(cc_) do { unsigned spins = 0; while (ready[(cc_) & (R2_SLOTS - 1)] != (unsigned)((cc_) + 1)) { if (++spins > (1u << 22)) break; __builtin_amdgcn_s_sleep(1); } asm volatile("" ::: "memory"); } while (0)
        RkOps pa, pb;
        RK_WAIT(0); rk_load_lds(pa, lds, vb, lane, qd);
        for (int cc = 0; cc < 128; cc += 2) {
            RK_WAIT(cc + 1); rk_load_lds(pb, lds + ((cc + 1) & (R2_SLOTS - 1)) * PKG_BYTES, vb, lane, qd);
            rk_step(pa, sT, yb, dir, b, hh, vb, cc, fr, qd);
            asm volatile("s_waitcnt lgkmcnt(0)" ::: "memory"); if (lane == 0) consumed[vb] = (unsigned)(cc + 2); asm volatile("" ::: "memory");
            if (cc + 2 < 128) { RK_WAIT(cc + 2); rk_load_lds(pa, lds + ((cc + 2) & (R2_SLOTS - 1)) * PKG_BYTES, vb, lane, qd); }
            rk_step(pb, sT, yb, dir, b, hh, vb, cc + 1, fr, qd);
            if (cc + 2 < 128) { asm volatile("s_waitcnt lgkmcnt(0)" ::: "memory"); if (lane == 0) consumed[vb] = (unsigned)(cc + 3); asm volatile("" ::: "memory"); }
        }
#undef RK_WAIT
    }
    __syncthreads();
}


constexpr int YA_G2LD = 136;
static_assert(384 * YA_G2LD * 2 <= MISC_OFF, "yasm LDS");
DI void unpack4(const uint2 w, float (&f)[4]) { f[0] = __uint_as_float(w.x << 16); f[1] = __uint_as_float(w.x & 0xffff0000u); f[2] = __uint_as_float(w.y << 16); f[3] = __uint_as_float(w.y & 0xffff0000u); }
DI void yasm_token(const bf16* Z, const bf16* ao, const float* al, const bf16* num, const float* den, const f32x4 mgA, const f32x4 mgB, bf16* y, int tok, int lane) {
    const bf16* zr = Z + (size_t)tok * ZLD; bf16* yr = y + (size_t)tok * DM;
    const float lsev = al[((size_t)((lane >> 2) % 3) * NT + tok) * 4 + (lane & 3)];
    const float denv = den[((size_t)((lane >> 2) & 1) * NT + tok) * 4 + (lane & 3)];
    const bool lo32 = lane < 32; const int lb = lane & 31;
    uint2 av[3], nA[2], nB[2];
#pragma unroll
    for (int br = 0; br < 3; ++br) av[br] = *(const uint2*)(ao + ((size_t)br * NT + tok) * AW + 4 * lane);
#pragma unroll
    for (int d = 0; d < 2; ++d) { nA[d] = *(const uint2*)(num + ((size_t)d * NT + tok) * MW + 4 * lane); nB[d] = *(const uint2*)(num + ((size_t)d * NT + tok) * MW + 256 + 4 * lb); }
    const uint2 zA = *(const uint2*)(zr + ZMO + 4 * lane), zB = *(const uint2*)(zr + ZMO + 256 + 4 * lb);
    { const int hh = lane >> 4; const float l0 = __shfl(lsev, hh), l1 = __shfl(lsev, 4 + hh), l2 = __shfl(lsev, 8 + hh);
      const float mx = fmaxf(l0, fmaxf(l1, l2)); const float w0 = __expf(l0 - mx), w1 = __expf(l1 - mx), w2 = __expf(l2 - mx); const float inv = 1.f / (w0 + w1 + w2);
      float a0[4], a1[4], a2[4]; unpack4(av[0], a0); unpack4(av[1], a1); unpack4(av[2], a2);
      uint2 o; o.x = pkbf((w0 * a0[0] + w1 * a1[0] + w2 * a2[0]) * inv, (w0 * a0[1] + w1 * a1[1] + w2 * a2[1]) * inv); o.y = pkbf((w0 * a0[2] + w1 * a1[2] + w2 * a2[2]) * inv, (w0 * a0[3] + w1 * a1[3] + w2 * a2[3]) * inv);
      *(uint2*)(yr + 4 * lane) = o; }
    { const int hA = lane / 24, hB = lane < 8 ? 2 : 3;
      const float dfA = __shfl(denv, hA), dbA = __shfl(denv, 4 + hA), dfB = __shfl(denv, hB), dbB = __shfl(denv, 4 + hB);
      const float ifA = 1.f / fmaxf(fabsf(dfA), 1.f), ibA = 1.f / fmaxf(fabsf(dbA), 1.f), ifB = 1.f / fmaxf(fabsf(dfB), 1.f), ibB = 1.f / fmaxf(fabsf(dbB), 1.f);
      float f0[4], f1[4], a[4], b[4]; unpack4(nA[0], f0); unpack4(nA[1], f1);
#pragma unroll
      for (int i = 0; i < 4; ++i) a[i] = f0[i] * ifA + f1[i] * ibA;
      unpack4(nB[0], f0); unpack4(nB[1], f1);
#pragma unroll
      for (int i = 0; i < 4; ++i) b[i] = lo32 ? f0[i] * ifB + f1[i] * ibB : 0.f;
      const float sA = (a[0] + a[1]) + (a[2] + a[3]), qA = (a[0] * a[0] + a[1] * a[1]) + (a[2] * a[2] + a[3] * a[3]);
      const float sB = (b[0] + b[1]) + (b[2] + b[3]), qB = (b[0] * b[0] + b[1] * b[1]) + (b[2] * b[2] + b[3] * b[3]);
      float mA = 0.f, rA = 0.f, mB = 0.f, rB = 0.f;
#pragma unroll
      for (int h = 0; h < 4; ++h) { const float ps = (hA == h ? sA : 0.f) + ((lo32 && hB == h) ? sB : 0.f), pq = (hA == h ? qA : 0.f) + ((lo32 && hB == h) ? qB : 0.f);
          const float m = wave_sum(ps) * (1.f / 96.f); const float var = fmaxf(wave_sum(pq) * (1.f / 96.f) - m * m, 0.f); const float rs = rsqrtf(var + 1e-6f);
          if (hA == h) { mA = m; rA = rs; } if (hB == h) { mB = m; rB = rs; } }
      float g[4]; unpack4(zA, g);
      uint2 o; o.x = pkbf((a[0] - mA) * rA * mgA[0] * sigm(g[0]), (a[1] - mA) * rA * mgA[1] * sigm(g[1])); o.y = pkbf((a[2] - mA) * rA * mgA[2] * sigm(g[2]), (a[3] - mA) * rA * mgA[3] * sigm(g[3]));
      *(uint2*)(yr + AW + RW + 4 * lane) = o;
      unpack4(zB, g);
      o.x = pkbf((b[0] - mB) * rB * mgB[0] * sigm(g[0]), (b[1] - mB) * rB * mgB[1] * sigm(g[1])); o.y = pkbf((b[2] - mB) * rB * mgB[2] * sigm(g[2]), (b[3] - mB) * rB * mgB[3] * sigm(g[3]));
      if (lo32) *(uint2*)(yr + AW + RW + 256 + 4 * lane) = o; }
}
DI void phase_yasm(const Args& A, int l, LAS unsigned char* lds, int gw, int ngw, int tid, int lane) {
    const bf16* Z = (const bf16*)(A.ws + WS_Z); const bf16* ao = (const bf16*)(A.ws + WS_ATTO); const float* al = (const float*)(A.ws + WS_ATTL);
    const bf16* rky = (const bf16*)(A.ws + WS_RKY); const bf16* rkb = (const bf16*)(A.ws + WS_RKB);
    const bf16* num = (const bf16*)(A.ws + WS_MLNUM); const float* den = (const float*)(A.ws + WS_MLDEN); bf16* y = (bf16*)(A.ws + WS_HB);
    const float* lng = A.in[I_RLNG] + (size_t)l * RW; const float* lnb = A.in[I_RLNB] + (size_t)l * RW; const float* mlg = A.in[I_MLNG] + (size_t)l * MW;
    LAS bf16* G2T = (LAS bf16*)lds;
    __syncthreads();
    { const u32x4_t* src = (const u32x4_t*)(A.ws + WS_G2T + (size_t)l * RW * 128 * 2);
      for (int idx = tid; idx < RW * 16; idx += NTHR) { const int col = idx >> 4, ch = idx & 15; *(LAS u32x4_t*)(G2T + col * YA_G2LD + ch * 8) = src[idx]; } }
    __syncthreads();
    const int fr = lane & 15, qd = lane >> 4;
    for (int item = gw; item < (NT / 16) * 6; item += ngw) {
        const int hh = item % 6, tg = item / 6; const int tokA = tg * 16 + fr;
        const size_t o = (size_t)tokA * RW + hh * 64 + 16 * qd;
        const uint4 y0a = *(const uint4*)(rky + o), y0b = *(const uint4*)(rky + o + 8), y1a = *(const uint4*)(rky + (size_t)NT * RW + o), y1b = *(const uint4*)(rky + (size_t)NT * RW + o + 8);
        const uint4 b0a = *(const uint4*)(rkb + o), b0b = *(const uint4*)(rkb + o + 8), b1a = *(const uint4*)(rkb + (size_t)NT * RW + o), b1b = *(const uint4*)(rkb + (size_t)NT * RW + o + 8);
        f32x4 gacc[4];
#pragma unroll
        for (int nt = 0; nt < 4; ++nt) gacc[nt] = (f32x4){0.f, 0.f, 0.f, 0.f};
#pragma unroll
        for (int ks = 0; ks < 4; ++ks) { float f[8]; unpack8(*(const uint4*)(Z + (size_t)tokA * ZLD + ZGD + 32 * ks + 8 * qd), f);
            union { unsigned u[4]; bf16x8_t v; } a;
#pragma unroll
            for (int e = 0; e < 4; ++e) a.u[e] = cvtpk(sigm(f[2 * e]), sigm(f[2 * e + 1]));
#pragma unroll
            for (int nt = 0; nt < 4; ++nt) { const bf16x8_t bg = *(const LAS bf16x8_t*)(G2T + (hh * 64 + 16 * (fr >> 2) + 4 * nt + (fr & 3)) * YA_G2LD + 32 * ks + 8 * qd); gacc[nt] = MFMA16(bg, a.v, gacc[nt]); } }
        float sv[16], bv[16], t0[8], t1[8];
        unpack8(y0a, t0); unpack8(y1a, t1);
#pragma unroll
        for (int j = 0; j < 8; ++j) sv[j] = t0[j] + t1[j];
        unpack8(y0b, t0); unpack8(y1b, t1);
#pragma unroll
        for (int j = 0; j < 8; ++j) sv[8 + j] = t0[j] + t1[j];
        unpack8(b0a, t0); unpack8(b1a, t1);
#pragma unroll
        for (int j = 0; j < 8; ++j) bv[j] = t0[j] + t1[j];
        unpack8(b0b, t0); unpack8(b1b, t1);
#pragma unroll
        for (int j = 0; j < 8; ++j) bv[8 + j] = t0[j] + t1[j];
        float sm = 0.f;
#pragma unroll
        for (int j = 0; j < 16; ++j) sm += sv[j];
        sm += __shfl_xor(sm, 16); sm += __shfl_xor(sm, 32); sm *= (1.f / 64.f);
        float vr = 0.f;
#pragma unroll
        for (int j = 0; j < 16; ++j) { sv[j] -= sm; vr += sv[j] * sv[j]; }
        vr += __shfl_xor(vr, 16); vr += __shfl_xor(vr, 32); vr = rsqrtf(vr * (1.f / 64.f) + 64e-5f);
        const f32x4* lgp = (const f32x4*)(lng + hh * 64 + 16 * qd); const f32x4* lbp = (const f32x4*)(lnb + hh * 64 + 16 * qd);
        unsigned ow[8];
#pragma unroll
        for (int q = 0; q < 4; ++q) { const f32x4 lg_ = lgp[q], lb_ = lbp[q];
            ow[2 * q] = pkbf((sv[4 * q] * vr * lg_[0] + lb_[0] + bv[4 * q]) * gacc[q][0], (sv[4 * q + 1] * vr * lg_[1] + lb_[1] + bv[4 * q + 1]) * gacc[q][1]);
            ow[2 * q + 1] = pkbf((sv[4 * q + 2] * vr * lg_[2] + lb_[2] + bv[4 * q + 2]) * gacc[q][2], (sv[4 * q + 3] * vr * lg_[3] + lb_[3] + bv[4 * q + 3]) * gacc[q][3]); }
        bf16* yo = y + (size_t)tokA * DM + AW + hh * 64 + 16 * qd;
        *(uint4*)yo = make_uint4(ow[0], ow[1], ow[2], ow[3]); *(uint4*)(yo + 8) = make_uint4(ow[4], ow[5], ow[6], ow[7]);
    }
    const f32x4 mgA = *(const f32x4*)(mlg + 4 * lane), mgB = *(const f32x4*)(mlg + 256 + 4 * (lane & 31));
    for (int tok = gw; tok < NT; tok += 2 * ngw) { yasm_token(Z, ao, al, num, den, mgA, mgB, y, tok, lane); if (tok + ngw < NT) yasm_token(Z, ao, al, num, den, mgA, mgB, y, tok + ngw, lane); }
    __syncthreads();
}

constexpr int L2_WLD = 1032;
constexpr int L2_WHI = 0, L2_WLO = 16 * L2_WLD * 2, L2_G2 = 2 * L2_WLO, L2_EX = L2_G2 + DM * 4, L2_SS = L2_EX + 8 * 1024, L2_END = L2_SS + 8 * 16 * 4;
static_assert(L2_END <= MISC_OFF, "ln2 LDS");
DI void phase_ln2(const Args& A, int l, LAS unsigned char* lds, int bid, int G, int tid, int wave, int lane) {
    const bf16* x1 = (const bf16*)(A.ws + WS_X1); unsigned char* hb = A.ws + WS_HB; float* aff = (float*)(A.ws + WS_AFF);
    const float* router = A.in[I_ROUTER] + (size_t)l * DM * NE; const float* g2 = A.in[I_LN2G] + (size_t)l * DM;
    LAS bf16* Whi = (LAS bf16*)(lds + L2_WHI); LAS bf16* Wlo = (LAS bf16*)(lds + L2_WLO); LAS float* g2s = (LAS float*)(lds + L2_G2);
    LAS unsigned char* ex = lds + L2_EX; LAS float* ssx = (LAS float*)(lds + L2_SS);
    const int fr = lane & 15, qd = lane >> 4, tg = wave >> 1, kh = wave & 1;
    __syncthreads();
    for (int i = tid; i < DM * NE; i += NTHR) { const int e = i & 15, c = i >> 4; const float v = router[i] * g2[c]; const unsigned h = f2bf(v);
        Whi[e * L2_WLD + c] = (bf16)h; Wlo[e * L2_WLD + c] = (bf16)f2bf(v - bf2f(h)); }
    for (int i = tid; i < DM; i += NTHR) g2s[i] = g2[i];
    for (int grp = bid; grp < NT / 64; grp += G) {
        const int tokb = grp * 64 + tg * 16, tok = tokb + fr;
        const u32x4_t* xp = (const u32x4_t*)(x1 + (size_t)tok * DM + kh * 512 + 16 * qd);
        u32x4_t xa[8][2];
#pragma unroll
        for (int p = 0; p < 8; ++p) { xa[p][0] = xp[8 * p]; xa[p][1] = xp[8 * p + 1]; }
        __syncthreads();
        f32x4 acc = (f32x4){0.f, 0.f, 0.f, 0.f}; float ss = 0.f;
#pragma unroll
        for (int p = 0; p < 8; ++p)
#pragma unroll
            for (int hf = 0; hf < 2; ++hf) { const int c = kh * 512 + 64 * p + 16 * qd + 8 * hf;
                const bf16x8_t a = __builtin_bit_cast(bf16x8_t, xa[p][hf]);
                const bf16x8_t bh = *(const LAS bf16x8_t*)(Whi + fr * L2_WLD + c), bl = *(const LAS bf16x8_t*)(Wlo + fr * L2_WLD + c);
                acc = MFMA16(a, bh, acc); acc = MFMA16(a, bl, acc);
#pragma unroll
                for (int e = 0; e < 4; ++e) { const float lo = __uint_as_float(xa[p][hf][e] << 16), hi = __uint_as_float(xa[p][hf][e] & 0xffff0000u); ss += lo * lo + hi * hi; } }
        ss += __shfl_xor(ss, 16); ss += __shfl_xor(ss, 32);
        *(LAS f32x4*)(ex + wave * 1024 + lane * 16) = acc; if (qd == 0) ssx[wave * 16 + fr] = ss;
        __syncthreads();
        { const f32x4 oth = *(const LAS f32x4*)(ex + (wave ^ 1) * 1024 + lane * 16); acc += oth; ss += ssx[(wave ^ 1) * 16 + fr]; }
        const float rs = rsqrtf(ss * (1.f / DM) + RMS_EPS);
        unsigned char* hrow = hb + (size_t)tok * DM + kh * 512 + 16 * qd; const float rsc = rs * F8_HSC;
#pragma unroll
        for (int p = 0; p < 8; ++p) { const LAS f32x4* gp = (const LAS f32x4*)(g2s + kh * 512 + 64 * p + 16 * qd); u32x4_t o;
#pragma unroll
            for (int q = 0; q < 4; ++q) { const f32x4 g = gp[q]; const unsigned u0 = xa[p][q >> 1][2 * (q & 1)], u1 = xa[p][q >> 1][2 * (q & 1) + 1];
                o[q] = pk4_fp8(__uint_as_float(u0 << 16) * rsc * g[0], __uint_as_float(u0 & 0xffff0000u) * rsc * g[1], __uint_as_float(u1 << 16) * rsc * g[2], __uint_as_float(u1 & 0xffff0000u) * rsc * g[3]); }
            *(u32x4_t*)(hrow + 64 * p) = o; }
        if (kh == 0) { f32x4 af;
#pragma unroll
            for (int r = 0; r < 4; ++r) { const float lg = acc[r] * __shfl(rs, 4 * qd + r); float mx = lg;
#pragma unroll
                for (int o = 1; o < 16; o <<= 1) mx = fmaxf(mx, __shfl_xor(mx, o));
                const float ev = expf(lg - mx); float sm = ev;
#pragma unroll
                for (int o = 1; o < 16; o <<= 1) sm += __shfl_xor(sm, o);
                af[r] = ev / sm; }
            *(f32x4*)(aff + ((size_t)(tokb / SEQ) * NE + fr) * SEQ + (tokb % SEQ) + 4 * qd) = af; }
    }
    __syncthreads();
}

constexpr int PH_PER_LAYER = 10, NPH = 1 + NL * PH_PER_LAYER + 1;
#ifndef MK_ONE_LAUNCH
#define MK_ONE_LAUNCH 1
#endif

#ifndef MK_DUP
#define MK_DUP 0
#endif
constexpr int P0_END = NL * 16 * 64 + NL * 16 * 16 + NL * NE * 3 * 8 * 44, P0_SPLIT = P0_END - 0;
template <int l> DI void run_layer(const Args& A, LAS unsigned char* lds, const XcdBarrier& bar, int lo, int hi, int G, int bid, int tid, int lane, int wave, int gw, int ngw, int gtid, int nthr) {
#define IN(k) (lo <= (k) && (k) < hi)
#define SEAM(k) do { if (IN(k) && IN((k) + 1)) xcd_barrier(bar); } while (0)
#define PH(k, ...) do { if (IN(pb + (k))) { { __VA_ARGS__ } if ((MK_DUP >> (k)) & 1) { xcd_barrier(bar); { __VA_ARGS__ } } } SEAM(pb + (k)); } while (0)
    const int pb = 1 + l * PH_PER_LAYER;
    PH(0, phase_ln1(A, l, gw, ngw, lane););
    PH(1,
        pg8::Gemm g{(const bf16*)(A.ws + WS_HB), (const bf16*)(A.ws + WS_WTIN) + (size_t)l * ZLD * DM, NT, ZLD, DM};
        pg8::StaticOrder S; S.init(NT, ZLD, G, bid);
        pg8::EpiBf16<0> E{(bf16*)(A.ws + WS_Z), ZLD, nullptr, 0, 0, 1.f};
        pg8::gemm_phase<pg8::EpiBf16<0>, pg8::StaticOrder, true, true>(lds, g, S, E););
    PH(2, phase_attn(A, lds, 0, G > ATT_SCAN_BLK0 ? ATT_SPLIT : ATT_UNITS, bid, G, tid, wave, lane); phase_rwkv_r1(A, l, lds, bid, G, tid, wave, lane); if ((MK_DUP >> 13) & 1) phase_rwkv_r1(A, l, lds, bid, G, tid, wave, lane);
          phase_mlstm_m1(A, l, lds, bid, G, tid, wave, lane); if ((MK_DUP >> 16) & 1) phase_mlstm_m1(A, l, lds, bid, G, tid, wave, lane););
    PH(3, if (l == 0 && P0_SPLIT < P0_END) { const int nb = G > 160 ? G - 160 : G, b0 = G > 160 ? bid - 160 : bid; if (b0 >= 0) { __syncthreads(); phase_p0(A, lds, P0_SPLIT, P0_END, b0 * NWAVES + wave, nb * NWAVES, wave, lane); __syncthreads(); } }
          if (G > ATT_SCAN_BLK0 && bid >= ATT_SCAN_BLK0) phase_attn(A, lds, ATT_SPLIT, ATT_UNITS, bid - ATT_SCAN_BLK0, G - ATT_SCAN_BLK0, tid, wave, lane);
          for (int rep = 0; rep < 1 + ((MK_DUP >> 14) & 1); ++rep) for (int u = bid; u < 96; u += G) rwkv_r2_unit(A, lds, u, tid, wave, lane);
          for (int rep = 0; rep < 1 + ((MK_DUP >> 15) & 1); ++rep) for (int u = bid; u < 96 + 64; u += G) { if (u >= 96) mlstm_m2_unit(A, lds, u - 96, tid, wave, lane); });
    PH(4, phase_yasm(A, l, lds, gw, ngw, tid, lane););
    PH(5,
        pg8::Gemm g{(const bf16*)(A.ws + WS_HB), (const bf16*)(A.ws + WS_WTOUT) + (size_t)l * DM * DM, NT, DM, DM};
        pg8::StaticOrder S; S.init(NT, DM, G, bid);
        EpiResT<(l > 0)> E{(l == 0) ? (const void*)A.in[I_X] : (const void*)(A.ws + WS_X2), (bf16*)(A.ws + WS_X1), DM};
        pg8::gemm_phase<EpiResT<(l > 0)>, pg8::StaticOrder, true, true>(lds, g, S, E););
    PH(6, phase_ln2(A, l, lds, bid, G, tid, wave, lane););
    PH(7, phase_topk(A, lds, bid, G, tid, wave, lane););
    PH(8,
        pg8::Gemm g{(const bf16*)(A.ws + WS_XG), (const bf16*)(A.ws + WS_W13T + (size_t)l * NE * 5632 * DM), NSLOT, NE * 5632, DM / 2};
        GroupOrder S; S.init(22, G, bid);
        EpiSwiGLU E{A.ws + WS_ACT, 22};
        pg8::gemm_phase<EpiSwiGLU, GroupOrder, true, true, true>(lds, g, S, E););
    PH(9,
        pg8::Gemm g{(const bf16*)(A.ws + WS_ACT), (const bf16*)(A.ws + WS_W2T + (size_t)l * NE * DM * FF), NSLOT, NE * DM, FF / 2};
        GroupOrder S; S.init(4, G, bid);
        EpiGate E{(bf16*)(A.ws + WS_YS), (const float*)(A.ws + WS_GATE)};
        pg8::gemm_phase<EpiGate, GroupOrder, true, true, true>(lds, g, S, E););
#undef PH
#undef IN
#undef SEAM
}

__global__ void __launch_bounds__(NTHR, 2) mk_fwd(Args A) {
    extern __shared__ __attribute__((aligned(16))) unsigned char lds_raw[];
    LAS unsigned char* lds = (LAS unsigned char*)lds_raw;
    const int tid = threadIdx.x, lane = tid & 63, wave = __builtin_amdgcn_readfirstlane(tid >> 6);
    const int G = gridDim.x, bid = blockIdx.x;
    const int gw = bid * NWAVES + wave, ngw = G * NWAVES, gtid = bid * NTHR + tid, nthr = G * NTHR;
    volatile LAS unsigned* MISC = (volatile LAS unsigned*)(lds + MISC_OFF);
    if (tid < 64) MISC[tid] = 0u;
    __syncthreads();
    const int lo = A.ph_lo, hi = A.ph_hi;
    const bool use_bar = (hi - lo) > 1;
    XcdBarrier bar; bar.bar = (unsigned*)(A.ws + WS_CTL) + CW_BAR; bar.x = 0; bar.st = MISC + 8;
    if (use_bar) bar = xcd_barrier_post((unsigned*)(A.ws + WS_CTL) + CW_BAR, MISC + 8);
#define IN(k) (lo <= (k) && (k) < hi)
#define SEAM(k) do { if (IN(k) && IN((k) + 1)) xcd_barrier(bar); } while (0)

    if (IN(0)) { phase_p0(A, lds, 0, P0_SPLIT, gw, ngw, wave, lane); if ((MK_DUP >> 10) & 1) { xcd_barrier(bar); phase_p0(A, lds, 0, P0_SPLIT, gw, ngw, wave, lane); } } SEAM(0);

    run_layer<0>(A, lds, bar, lo, hi, G, bid, tid, lane, wave, gw, ngw, gtid, nthr);
    run_layer<1>(A, lds, bar, lo, hi, G, bid, tid, lane, wave, gw, ngw, gtid, nthr);
    if (IN(NPH - 1)) { phase_final(A, gw, ngw, lane); if ((MK_DUP >> 11) & 1) { xcd_barrier(bar); phase_final(A, gw, ngw, lane); } }
#undef IN
#undef SEAM
}
}

extern "C" void kernel_launch(void* const* d_in, const int* in_sizes, int n_in, void* d_out, int out_size, void* d_ws, size_t ws_size, hipStream_t stream) {
    using namespace mk;
    static int grid = 0;
    if (grid == 0) {
        if (n_in != N_IN || out_size != NT * DM || ws_size < WS_END) { fprintf(stderr, "kernel_launch: unexpected shapes (n_in %d, out %d, ws %zu < %zu)\n", n_in, out_size, ws_size, (size_t)WS_END); grid = -1; return; }
        int dev = 0, cus = 0, per_cu = 0;
        if (hipGetDevice(&dev) != hipSuccess || hipDeviceGetAttribute(&cus, hipDeviceAttributeMultiprocessorCount, dev) != hipSuccess) { grid = -1; return; }
        if (hipFuncSetAttribute((const void*)mk_fwd, hipFuncAttributeMaxDynamicSharedMemorySize, LDS_BYTES) != hipSuccess) { fprintf(stderr, "kernel_launch: hipFuncSetAttribute failed\n"); grid = -1; return; }
        if (hipOccupancyMaxActiveBlocksPerMultiprocessor(&per_cu, (const void*)mk_fwd, NTHR, LDS_BYTES) != hipSuccess || per_cu < 1) fprintf(stderr, "kernel_launch: occupancy query reports %d\n", per_cu);
        (void)hipGetLastError();
        grid = cus;
    }
    if (grid < 0) return;
    hipMemsetAsync((char*)d_ws + WS_CTL, 0, CTL_ZERO_BYTES, stream);
    Args a{};
    for (int i = 0; i < N_IN; ++i) a.in[i] = (const float*)d_in[i];
    a.out = (float*)d_out; a.ws = (unsigned char*)d_ws;
#if MK_ONE_LAUNCH
    a.ph_lo = 0; a.ph_hi = NPH;
    hipLaunchKernelGGL(mk_fwd, dim3(grid), dim3(NTHR), LDS_BYTES, stream, a);
#else
    for (int p = 0; p < NPH; ++p) { a.ph_lo = p; a.ph_hi = p + 1; hipLaunchKernelGGL(mk_fwd, dim3(grid), dim3(NTHR), LDS_BYTES, stream, a); }
#endif
}
```

```cpp
#include <hip/hip_runtime.h>
#include <cstdio>
#include <cstdint>
namespace pg8 {
#define PG8_LAS __attribute__((address_space(3)))
typedef unsigned short bf16_t;
typedef short bf16x8 __attribute__((ext_vector_type(8)));
typedef float f32x4 __attribute__((ext_vector_type(4)));
typedef unsigned u32x4 __attribute__((ext_vector_type(4)));
constexpr int BM = 256, BK = 64, HALF = 128, HTB = HALF * BK * 2  , STAGE_BYTES = 8 * HTB, NXCD = 8, WGM = 8;

__host__ __device__ __forceinline__ int lds_byte(int r, int c) { const int st = (r >> 4) * 2 + (c >> 5), rr = r & 15, cc = c & 31, ob = rr * 64 + cc * 2; return st * 1024 + (ob ^ (((ob >> 9) & 1) << 5)); }
__host__ __device__ __forceinline__ void stage_rc(int b, int& R, int& C) { const int st = b / 1024, sb = b % 1024, swz = sb ^ (((sb >> 9) & 1) << 5); R = (st >> 1) * 16 + swz / 64; C = (st & 1) * 32 + (swz % 64) / 2; }
__host__ __device__ __forceinline__ int perm32(int rho) { const int n = rho >> 4, i = rho & 15; return 8 * (i >> 2) + 4 * n + (i & 3); }

struct Unit { int pm, pn; };
struct Gemm { const bf16_t* A; const bf16_t* Bt; int M, N, K; };

struct StaticOrder {
    int nM, nN, nwg, G, c;
    __host__ __device__ void init(int M, int N, int G_, int c_) { nM = M / BM; nN = N / BM; nwg = nM * nN; G = G_; c = c_; }
    __host__ __device__ bool next(int i, Unit& u) const {
        const long L = (long)i * G + c; if (L >= nwg) return false;
        int wgid = (int)L; { const int q = nwg / NXCD, r = nwg % NXCD, xcd = wgid % NXCD, off = wgid / NXCD; wgid = (xcd < r ? xcd * (q + 1) : r * (q + 1) + (xcd - r) * q) + off; }
        const int nig = WGM * nN, gid = wgid / nig, fm = gid * WGM, gsz = (nM - fm) < WGM ? (nM - fm) : WGM;
        u.pm = fm + ((wgid % nig) % gsz); u.pn = (wgid % nig) / gsz; return true;
    }
    __device__ __forceinline__ void a_ready(const Unit&) const {}
    __device__ __forceinline__ void done(const Unit&) const {}
};

__device__ __forceinline__ unsigned cvt_pk_bf16(float lo, float hi) { unsigned r; asm volatile("v_cvt_pk_bf16_f32 %0, %1, %2" : "=v"(r) : "v"(lo), "v"(hi)); return r; }
typedef float f32x2 __attribute__((ext_vector_type(2)));
__device__ __forceinline__ f32x2 gelu_pk(f32x2 v) {
    const f32x2 av = __builtin_elementwise_abs(v), d = av * 0.2316418882f + 1.0f;
    f32x2 t; t.x = __builtin_amdgcn_rcpf(d.x); t.y = __builtin_amdgcn_rcpf(d.y);
    f32x2 q = t * 0.5307027145f + (-0.7265760135f); q = q * t + 0.7107068705f; q = q * t + (-0.142248368f); q = q * t + 0.127414796f; q = q * t;
    const f32x2 s = (v * v) * (-0.72134752044f);
    f32x2 e; e.x = __builtin_amdgcn_exp2f(s.x); e.y = __builtin_amdgcn_exp2f(s.y);
    const f32x2 m = v * (q * e), r = v - m;
    f32x2 o; o.x = v.x < 0.f ? m.x : r.x; o.y = v.y < 0.f ? m.y : r.y; return o;
}

template <int ACT  > struct EpiBf16 {
    static constexpr bool PERM = true, AFTER_DRAIN = false; static_assert(ACT == 0 || ACT == 1, "EpiBf16: ACT is 0 (none) or 1 (gelu_pk)");
    bf16_t* O; int ldc; const float* bias; int split_cols; size_t split_stride; float scale0;
    __device__ __forceinline__ void operator()(const f32x4 (&acc)[2][2][4][2], const Unit& u, int wr, int wc, int fr, int fq) const {
        const int row0 = u.pm * BM + wr * 64 + fr; int colt = u.pn * BM; bf16_t* base = O;
        float sc = 1.f; if (split_cols) { const int t = colt / split_cols; base += (size_t)t * split_stride; colt -= t * split_cols; if (t == 0) sc = scale0; }
        const int col0 = colt + wc * 32 + 8 * fq, bcol0 = u.pn * BM + wc * 32 + 8 * fq;
        f32x4 bv[2][2];
#pragma unroll
        for (int bj = 0; bj < 2; ++bj)
#pragma unroll
            for (int n = 0; n < 2; ++n) bv[bj][n] = bias ? *(const f32x4*)(bias + bcol0 + bj * HALF + 4 * n) : (f32x4){0.f, 0.f, 0.f, 0.f};
#pragma unroll
        for (int ai = 0; ai < 2; ++ai)
#pragma unroll
            for (int m = 0; m < 4; ++m) { bf16_t* rowp = base + (size_t)(row0 + ai * HALF + m * 16) * ldc + col0;
#pragma unroll
                for (int bj = 0; bj < 2; ++bj) { f32x4 v0 = acc[ai][bj][m][0] + bv[bj][0], v1 = acc[ai][bj][m][1] + bv[bj][1];
                    if (ACT == 1) { f32x2 a = gelu_pk((f32x2){v0[0], v0[1]}), b = gelu_pk((f32x2){v0[2], v0[3]}), c = gelu_pk((f32x2){v1[0], v1[1]}), d = gelu_pk((f32x2){v1[2], v1[3]});
                        v0 = (f32x4){a.x, a.y, b.x, b.y}; v1 = (f32x4){c.x, c.y, d.x, d.y}; }
                    v0 = v0 * sc; v1 = v1 * sc; u32x4 w; w.x = cvt_pk_bf16(v0[0], v0[1]); w.y = cvt_pk_bf16(v0[2], v0[3]); w.z = cvt_pk_bf16(v1[0], v1[1]); w.w = cvt_pk_bf16(v1[2], v1[3]);
                    *(u32x4*)(rowp + bj * HALF) = w; } }
    }
};
template <class Epi, class Sched, bool ALIGN_EPI = false, bool SP2 = false, bool F8 = false>
__device__ __forceinline__ void gemm_phase(PG8_LAS unsigned char* lds, const Gemm g, const Sched& S, const Epi& E) {
    const int tid = threadIdx.x, wid = __builtin_amdgcn_readfirstlane(tid >> 6), lane = tid & 63, wr = wid >> 2, wc = wid & 3, fr = lane & 15, fq = lane >> 4;
    int Kq = g.K; if constexpr (F8) asm volatile("" : "+s"(Kq));
    const int K = Kq, nt = K / BK;
    unsigned voffA[2], voffB[2];
#pragma unroll
    for (int i = 0; i < 2; ++i) { int R, C; stage_rc(tid * 16 + i * 8192, R, C); const int Rb = Epi::PERM ? ((R & ~31) + perm32(R & 31)) : R;
        voffA[i] = (unsigned)(R * K + C) * 2u; voffB[i] = (unsigned)(Rb * K + C) * 2u; }
    const size_t kstep = (size_t)(BK * 2);
    const size_t hstep = (size_t)HALF * K * 2;
    const size_t tstep = 2 * hstep;
    const unsigned ldsw = (unsigned)wid * 1024u;
    const int aoff = lds_byte(wr * 64 + fr, fq * 8), boff = lds_byte(wc * 32 + fr, fq * 8);
#define PG8_SA(b, h) (((b) * 2 + (h)) * HTB)
#define PG8_SB(b, h) ((4 + (b) * 2 + (h)) * HTB)
#define PG8_STAGE(bufoff, gbase, voff) do { _Pragma("unroll") for (int _i = 0; _i < 2; ++_i) \
        __builtin_amdgcn_global_load_lds((const unsigned*)((const char*)(gbase) + (voff)[_i]), (PG8_LAS unsigned*)(lds + (bufoff) + ldsw + _i * 8192), 16, 0, 0); } while (0)
#define PG8_LDA(dst, b, h) do { _Pragma("unroll") for (int m = 0; m < 4; ++m) { if constexpr (F8) { const i32x4_ lo_ = *(const PG8_LAS i32x4_*)(lds + PG8_SA(b, h) + aoff + m * 2048), hi_ = *(const PG8_LAS i32x4_*)(lds + PG8_SA(b, h) + aoff + m * 2048 + 1024); dst##8[m] = __builtin_shufflevector(lo_, hi_, 0, 1, 2, 3, 4, 5, 6, 7); } \
        else { _Pragma("unroll") for (int k = 0; k < 2; ++k) dst[m][k] = *(const PG8_LAS bf16x8*)(lds + PG8_SA(b, h) + aoff + m * 2048 + k * 1024); } } } while (0)
#define PG8_LDB(dst, b, h) do { _Pragma("unroll") for (int n = 0; n < 2; ++n) { if constexpr (F8) { const i32x4_ lo_ = *(const PG8_LAS i32x4_*)(lds + PG8_SB(b, h) + boff + n * 2048), hi_ = *(const PG8_LAS i32x4_*)(lds + PG8_SB(b, h) + boff + n * 2048 + 1024); dst##8[n] = __builtin_shufflevector(lo_, hi_, 0, 1, 2, 3, 4, 5, 6, 7); } \
        else { _Pragma("unroll") for (int k = 0; k < 2; ++k) dst[n][k] = *(const PG8_LAS bf16x8*)(lds + PG8_SB(b, h) + boff + n * 2048 + k * 1024); } } } while (0)
#define PG8_MMA(ai, bj, At, Bt) do { __builtin_amdgcn_s_setprio(1); _Pragma("unroll") for (int m = 0; m < 4; ++m) _Pragma("unroll") for (int n = 0; n < 2; ++n) { \
        if constexpr (F8) asm volatile("v_mfma_scale_f32_16x16x128_f8f6f4 %0, %1, %2, %0, %3, %3 op_sel_hi:[0,0,0]" : "+v"(acc[ai][bj][m][n]) : "v"(Bt##8[n]), "v"(At##8[m]), "v"(f8scale)); \
        else { _Pragma("unroll") for (int k = 0; k < 2; ++k) acc[ai][bj][m][n] = __builtin_amdgcn_mfma_f32_16x16x32_bf16(Bt[n][k], At[m][k], acc[ai][bj][m][n], 0, 0, 0); } } \
        __builtin_amdgcn_s_setprio(0); } while (0)
#define PG8_WAIT_V(n) asm volatile("s_waitcnt vmcnt(" #n ")" ::: "memory")
#define PG8_WAIT_L(n) asm volatile("s_waitcnt lgkmcnt(" #n ")" ::: "memory")
#define PG8_BAR __builtin_amdgcn_s_barrier()
#define PG8_SCHED __builtin_amdgcn_sched_barrier(0)
    Unit cur, nxt; int ui = 0;
    if (!S.next(0, cur)) return;
    f32x4 acc[2][2][4][2];
#pragma unroll
    for (int a = 0; a < 2; ++a)
#pragma unroll
        for (int b = 0; b < 2; ++b)
#pragma unroll
            for (int m = 0; m < 4; ++m)
#pragma unroll
                for (int n = 0; n < 2; ++n) { acc[a][b][m][n] = (f32x4){0.f, 0.f, 0.f, 0.f}; if constexpr (F8) asm volatile("" : "+v"(acc[a][b][m][n])); }
    bf16x8 At[4][2], B0[2][2], B1[2][2];
    typedef int i32x4_ __attribute__((ext_vector_type(4))); typedef int i32x8_ __attribute__((ext_vector_type(8)));
    i32x8_ At8[4], B08[2], B18[2];
    int f8scale = 0x7f7f7f7f; asm volatile("" : "+v"(f8scale));
    const char* cA = (const char*)g.A + (size_t)cur.pm * tstep; const char* cB = (const char*)g.Bt + (size_t)cur.pn * tstep;
    S.a_ready(cur);
    if constexpr (SP2) {
        PG8_STAGE(PG8_SB(0, 0), cB, voffB); PG8_STAGE(PG8_SB(0, 1), cB + hstep, voffB); PG8_STAGE(PG8_SA(0, 0), cA, voffA); PG8_STAGE(PG8_SA(0, 1), cA + hstep, voffA);
        if (wr == 1) PG8_BAR;
        PG8_WAIT_V(2); PG8_BAR;
        PG8_STAGE(PG8_SB(1, 0), cB + kstep, voffB); PG8_STAGE(PG8_SA(1, 0), cA + kstep, voffA); PG8_STAGE(PG8_SB(1, 1), cB + hstep + kstep, voffB);
        PG8_WAIT_V(6); PG8_BAR;
    } else {
        PG8_STAGE(PG8_SB(0, 0), cB, voffB); PG8_STAGE(PG8_SA(0, 0), cA, voffA); PG8_STAGE(PG8_SB(0, 1), cB + hstep, voffB); PG8_STAGE(PG8_SA(0, 1), cA + hstep, voffA);
        if (wr == 1) PG8_BAR;
        PG8_WAIT_V(4); PG8_BAR;
        PG8_STAGE(PG8_SB(1, 0), cB + kstep, voffB); PG8_STAGE(PG8_SA(1, 0), cA + kstep, voffA); PG8_STAGE(PG8_SB(1, 1), cB + hstep + kstep, voffB);
        PG8_WAIT_V(6); PG8_BAR;
    }
    for (;;) {
        const bool has_next = S.next(ui + 1, nxt);
        const char* nA = has_next ? (const char*)g.A + (size_t)nxt.pm * tstep : cA; const char* nB = has_next ? (const char*)g.Bt + (size_t)nxt.pn * tstep : cB;
        for (int t = 0; t < nt; t += 2) {
            const bool last = (t == nt - 2);
            const char* a1 = cA + (size_t)(t + 1) * kstep;
            const char* a2 = last ? nA : cA + (size_t)(t + 2) * kstep; const char* b2 = last ? nB : cB + (size_t)(t + 2) * kstep;
            const char* a3 = a2 + kstep; const char* b3 = b2 + kstep;
            if (last && has_next) S.a_ready(nxt);
            if constexpr (SP2) {
            PG8_LDB(B0, 0, 0); PG8_LDB(B1, 0, 1); PG8_SCHED; PG8_LDA(At, 0, 0); PG8_STAGE(PG8_SA(1, 1), a1 + hstep, voffA);
            PG8_WAIT_V(8); PG8_WAIT_L(0); PG8_BAR; PG8_MMA(0, 0, At, B0); PG8_MMA(0, 1, At, B1); PG8_BAR; PG8_SCHED;
            PG8_LDA(At, 0, 1); PG8_STAGE(PG8_SB(0, 0), b2, voffB); PG8_STAGE(PG8_SB(0, 1), b2 + hstep, voffB); PG8_STAGE(PG8_SA(0, 0), a2, voffA);
            PG8_WAIT_V(8); PG8_WAIT_L(0); PG8_BAR; PG8_MMA(1, 0, At, B0); PG8_MMA(1, 1, At, B1); PG8_BAR; PG8_SCHED;
            PG8_LDB(B0, 1, 0); PG8_LDB(B1, 1, 1); PG8_SCHED; PG8_LDA(At, 1, 0); PG8_STAGE(PG8_SA(0, 1), a2 + hstep, voffA);
            PG8_WAIT_V(8); PG8_WAIT_L(0); PG8_BAR; PG8_MMA(0, 0, At, B0); PG8_MMA(0, 1, At, B1); PG8_BAR; PG8_SCHED;
            PG8_LDA(At, 1, 1); PG8_STAGE(PG8_SB(1, 0), b3, voffB); PG8_STAGE(PG8_SB(1, 1), b3 + hstep, voffB); PG8_STAGE(PG8_SA(1, 0), a3, voffA);
            PG8_WAIT_V(8); PG8_WAIT_L(0); PG8_BAR; PG8_MMA(1, 0, At, B0); PG8_MMA(1, 1, At, B1); PG8_BAR; PG8_SCHED;
            } else {
            PG8_LDB(B0, 0, 0); PG8_SCHED; PG8_LDA(At, 0, 0); PG8_STAGE(PG8_SA(1, 1), a1 + hstep, voffA);
            PG8_WAIT_L(8); PG8_BAR; PG8_WAIT_L(0); PG8_MMA(0, 0, At, B0); PG8_BAR; PG8_SCHED;
            PG8_LDB(B1, 0, 1); PG8_STAGE(PG8_SB(0, 0), b2, voffB);
            PG8_BAR; PG8_WAIT_L(0); PG8_MMA(0, 1, At, B1); PG8_BAR;
            PG8_LDA(At, 0, 1); PG8_STAGE(PG8_SA(0, 0), a2, voffA);
            PG8_BAR; PG8_WAIT_L(0); PG8_MMA(1, 0, At, B0); PG8_BAR; PG8_SCHED;
            PG8_STAGE(PG8_SB(0, 1), b2 + hstep, voffB);
            PG8_WAIT_V(6); PG8_BAR; PG8_MMA(1, 1, At, B1); PG8_BAR;
            PG8_LDB(B0, 1, 0); PG8_SCHED; PG8_LDA(At, 1, 0); PG8_STAGE(PG8_SA(0, 1), a2 + hstep, voffA);
            PG8_WAIT_L(8); PG8_BAR; PG8_WAIT_L(0); PG8_MMA(0, 0, At, B0); PG8_BAR; PG8_SCHED;
            PG8_LDB(B1, 1, 1); PG8_STAGE(PG8_SB(1, 0), b3, voffB);
            PG8_BAR; PG8_WAIT_L(0); PG8_MMA(0, 1, At, B1); PG8_BAR;
            PG8_LDA(At, 1, 1); PG8_STAGE(PG8_SA(1, 0), a3, voffA);
            PG8_BAR; PG8_WAIT_L(0); PG8_MMA(1, 0, At, B0); PG8_BAR; PG8_SCHED;
            PG8_STAGE(PG8_SB(1, 1), b3 + hstep, voffB);
            PG8_WAIT_V(6); PG8_BAR; PG8_MMA(1, 1, At, B1); PG8_BAR;
            }
        }
        if constexpr (F8) asm volatile("s_nop 15\n\ts_nop 15" ::: "memory");
        if constexpr (ALIGN_EPI) { if (wr == 0) PG8_BAR; }
        if constexpr (!Epi::AFTER_DRAIN) { E(acc, cur, wr, wc, fr, fq); S.done(cur); }
        if (!has_next) break;
#pragma unroll
        for (int a = 0; a < 2; ++a)
#pragma unroll
            for (int b = 0; b < 2; ++b)
#pragma unroll
                for (int m = 0; m < 4; ++m)
#pragma unroll
                    for (int n = 0; n < 2; ++n) { acc[a][b][m][n] = (f32x4){0.f, 0.f, 0.f, 0.f}; if constexpr (F8) asm volatile("" : "+v"(acc[a][b][m][n])); }
        cur = nxt; cA = nA; cB = nB; ++ui;
        if constexpr (ALIGN_EPI) { if (wr == 1) PG8_BAR; }
    }
    PG8_WAIT_V(0);
    if constexpr (!ALIGN_EPI) { if (wr == 0) PG8_BAR; }
    PG8_BAR;
    if constexpr (Epi::AFTER_DRAIN) { E.fused(acc, cur, wr, wc, fr, fq, lds, wid, lane); S.done(cur); }
#undef PG8_SA
#undef PG8_SB
#undef PG8_STAGE
#undef PG8_LDA
#undef PG8_LDB
#undef PG8_MMA
#undef PG8_WAIT_V
#undef PG8_WAIT_L
#undef PG8_BAR
#undef PG8_SCHED
}
}
#define LAS __attribute__((address_space(3)))
#define XB_TMO      128
#define XB_XCNT(j)  (256  + 64 * (j))
#define XB_XSUB(j)  (1280 + 64 * (j))
#define XB_XGEN(j)  (2304 + 64 * (j))
#define XB_TOP      3328
#define XB_TOPGEN   3392
#define XCD_BAR_WORDS 3456
#define XB_SPIN_CAP (1u << 18)

__device__ __forceinline__ unsigned xb_ld(unsigned* p)              { return __hip_atomic_load(p, __ATOMIC_RELAXED, __HIP_MEMORY_SCOPE_AGENT); }
__device__ __forceinline__ unsigned xb_add(unsigned* p, unsigned v) { return __hip_atomic_fetch_add(p, v, __ATOMIC_RELAXED, __HIP_MEMORY_SCOPE_AGENT); }
__device__ __forceinline__ unsigned xb_xcc_id() { return (unsigned)__builtin_amdgcn_s_getreg((3 << 11) | 20) & 0xFu; }
#define XB_SPIN(cond, bar) do { unsigned _sp = 0; while (cond) { __builtin_amdgcn_s_sleep(1); \
    if ((++_sp & 255u) == 0u) { if (xb_ld(&(bar)[XB_TMO])) break; if (_sp > XB_SPIN_CAP) { atomicAdd(&(bar)[XB_TMO], 1u); break; } } } } while (0)

struct XcdBarrier {
    unsigned* bar; unsigned x;
    volatile LAS unsigned* st;
};

__device__ __forceinline__ XcdBarrier xcd_barrier_post(unsigned* bar, volatile LAS unsigned* st) {
    XcdBarrier b; b.bar = bar; b.x = xb_xcc_id(); b.st = st;
    if (threadIdx.x == 0) (void)xb_add(&bar[XB_XCNT(b.x)], 1u);
    return b;
}
__device__ __forceinline__ void xcd_barrier_complete(unsigned* bar, unsigned x, unsigned& nloc, unsigned& nx) {
    const unsigned G = gridDim.x * gridDim.y * gridDim.z;
    unsigned sum, cnt, mine, sp = 0u;
    for (;;) {
        sum = 0u; cnt = 0u; mine = 0u;
#pragma unroll
        for (unsigned j = 0; j < 16; ++j) { const unsigned c = xb_ld(&bar[XB_XCNT(j)]); sum += c; cnt += (c > 0u) ? 1u : 0u; mine = (j == x) ? c : mine; }
        if (sum == G) break;
        __builtin_amdgcn_s_sleep(1);
        if ((++sp & 255u) == 0u) { if (xb_ld(&bar[XB_TMO])) break; if (sp > XB_SPIN_CAP) { atomicAdd(&bar[XB_TMO], 1u); break; } }
    }
    nloc = mine > 0u ? mine : 1u; nx = cnt > 0u ? cnt : 1u;
}

__device__ __forceinline__ void xcd_barrier(const XcdBarrier& b) {
    asm volatile("s_waitcnt vmcnt(0)" ::: "memory");
    __syncthreads();
    if (threadIdx.x == 0) {
        unsigned* bar = b.bar;
        __builtin_amdgcn_s_waitcnt(0);
        unsigned nloc = b.st[0], nx = b.st[1];
        if (nloc == 0u) { xcd_barrier_complete(bar, b.x, nloc, nx); b.st[0] = nloc; b.st[1] = nx; }
        const unsigned old = xb_add(&bar[XB_XSUB(b.x)], 1u);
        const unsigned gen = old / nloc;
        if (old + 1u == (gen + 1u) * nloc) {
            __builtin_amdgcn_fence(__ATOMIC_RELEASE, "agent");
            asm volatile("s_waitcnt vmcnt(0)" ::: "memory");
            const unsigned og = xb_add(&bar[XB_TOP], 1u);
            const unsigned tg = og / nx;
            if (og + 1u == (tg + 1u) * nx) xb_add(&bar[XB_TOPGEN], 1u);
            else XB_SPIN(xb_ld(&bar[XB_TOPGEN]) == tg, bar);
            __builtin_amdgcn_fence(__ATOMIC_ACQUIRE, "agent");
            xb_add(&bar[XB_XGEN(b.x)], 1u);
            asm volatile("s_waitcnt vmcnt(0)" ::: "memory");
        } else {
            XB_SPIN(xb_ld(&bar[XB_XGEN(b.x)]) == gen, bar);
            __builtin_amdgcn_fence(__ATOMIC_ACQUIRE, "agent");
            asm volatile("s_waitcnt vmcnt(0)" ::: "memory");
        }
    }
    __syncthreads();
}

#define DI __device__ __forceinline__
#define LDS_WAIT() asm volatile("s_waitcnt lgkmcnt(0)" ::: "memory")
typedef unsigned short bf16;
typedef float f32x4 __attribute__((ext_vector_type(4)));

namespace mk {
constexpr int NB = 8, SEQ = 2048, DM = 1024, NT = NB * SEQ, NL = 2;
constexpr int INW = 3856, ZLD = 4096;
constexpr int ZA = 0, ZRKV = 768, ZWDF = 1920, ZWDB = 1984, ZADF = 2048, ZADB = 2112, ZGD = 2176, ZMQK = 2304, ZMV = 3072, ZMO = 3456, ZMG = 3840;
constexpr int RW = 384, MW = 384, AW = 256;
constexpr int NE = 16, CAP = 256, FF = 2816, NSLOT = NB * NE * CAP;
constexpr int NWAVES = 8, NTHR = 512;
constexpr float RMS_EPS = 1e-6f;

enum { I_X = 0, I_RELB, I_LN1G, I_WIN, I_WOUT, I_MU, I_W0, I_W2, I_A0, I_A2, I_KK, I_KA, I_RK, I_G2, I_RLNG, I_RLNB,
       I_CW, I_CB, I_IB, I_FB, I_MLNG, I_LN2G, I_ROUTER, I_EW1, I_EW3, I_EW2, I_FG, N_IN };

constexpr size_t MiB = 1u << 20;
constexpr size_t WS_CTL = 0, CTL_ZERO_BYTES = 1 * MiB;
constexpr size_t WS_WTIN = 2 * MiB;
constexpr size_t WS_WTOUT = 18 * MiB;
constexpr size_t WS_W13T = 22 * MiB;
constexpr size_t WS_W2T = 374 * MiB;
constexpr size_t WS_X1 = 550 * MiB;
constexpr size_t WS_X2 = 614 * MiB;
constexpr size_t WS_HB = 678 * MiB;
constexpr size_t WS_AFF = 710 * MiB;
constexpr size_t WS_SEL = 711 * MiB;
constexpr size_t WS_GATE = 712 * MiB;
constexpr size_t WS_G2T = 713 * MiB;
constexpr size_t WS_LWT = 713 * MiB + 256 * 1024;
constexpr size_t WS_R = 714 * MiB;
constexpr size_t WS_Z = WS_R;
constexpr size_t WS_ATTO = WS_R + 128 * MiB;
constexpr size_t WS_ATTL = WS_R + 152 * MiB;
constexpr size_t WS_PR = WS_R + 154 * MiB;
constexpr size_t WS_RKY = WS_R + 442 * MiB;
constexpr size_t WS_RKB = WS_R + 490 * MiB;
constexpr size_t WS_MLQK = WS_R + 538 * MiB;
constexpr size_t WS_MLNUM = WS_R + 586 * MiB;
constexpr size_t WS_MLDEN = WS_R + 634 * MiB;
constexpr size_t WS_XG = WS_R;
constexpr size_t WS_ACT = WS_R + 64 * MiB;
constexpr size_t WS_YS = WS_R + 240 * MiB;
constexpr size_t WS_END = WS_R + 636 * MiB;

constexpr int CW_BAR = 4096;
constexpr int LDS_BYTES = 147456;
constexpr int MISC_OFF = LDS_BYTES - 256;

struct Args { const float* in[N_IN]; float* out; unsigned char* ws; int ph_lo, ph_hi; };

DI float bf2f(unsigned v) { return __uint_as_float(v << 16); }
DI unsigned f2bf(float f) { unsigned u = __float_as_uint(f); return (u + 0x7fffu + ((u >> 16) & 1u)) >> 16; }
DI unsigned pk2(float lo, float hi) { return f2bf(lo) | (f2bf(hi) << 16); }
DI float wave_sum(float v) {
#pragma unroll
    for (int o = 1; o < 64; o <<= 1) v += __shfl_xor(v, o);
    return v;
}
DI float sigm(float x) { return 1.f / (1.f + __expf(-x)); }
DI void unpack8(const uint4 w, float (&f)[8]) {
    f[0] = __uint_as_float(w.x << 16); f[1] = __uint_as_float(w.x & 0xffff0000u); f[2] = __uint_as_float(w.y << 16); f[3] = __uint_as_float(w.y & 0xffff0000u);
    f[4] = __uint_as_float(w.z << 16); f[5] = __uint_as_float(w.z & 0xffff0000u); f[6] = __uint_as_float(w.w << 16); f[7] = __uint_as_float(w.w & 0xffff0000u);
}

struct GroupOrder {
    int G, c2, nunits, per_e, nN;
    DI void init(int nN_, int G_, int bid) { nN = nN_; per_e = 8 * nN_; nunits = NE * per_e; G = G_; c2 = (G_ % 8 == 0) ? (bid % 8) * (G_ / 8) + bid / 8 : bid; }
    DI bool next(int i, pg8::Unit& u) const {
        const long L = (long)i * G + c2; if (L >= nunits) return false;
        const int e = (int)L / per_e, r = (int)L % per_e; u.pm = e * 8 + (r & 7); u.pn = e * nN + (r >> 3); return true;
    }
    DI void a_ready(const pg8::Unit&) const {}
    DI void done(const pg8::Unit&) const {}
};
DI unsigned pkbf(float lo, float hi) { typedef __bf16 b2 __attribute__((ext_vector_type(2))); typedef float f2 __attribute__((ext_vector_type(2))); const f2 v = {lo, hi}; return __builtin_bit_cast(unsigned, __builtin_convertvector(v, b2)); }
template <bool BASE_BF16>
struct EpiResT {
    static constexpr bool PERM = false, AFTER_DRAIN = false;
    const void* base; bf16* out; int ldc;
    DI void operator()(const pg8::f32x4 (&acc)[2][2][4][2], const pg8::Unit& u, int wr, int wc, int fr, int fq) const {
        const int row0 = u.pm * 256 + wr * 64 + fr, col0 = u.pn * 256 + wc * 32 + 4 * fq;
#pragma unroll
        for (int ai = 0; ai < 2; ++ai)
#pragma unroll
            for (int m = 0; m < 4; ++m) { const size_t off = (size_t)(row0 + ai * 128 + m * 16) * ldc + col0;
#pragma unroll
                for (int bj = 0; bj < 2; ++bj)
#pragma unroll
                    for (int n = 0; n < 2; ++n) { pg8::f32x4 b;
                        if constexpr (BASE_BF16) { const uint2 w = *(const uint2*)((const bf16*)base + off + bj * 128 + n * 16);
                            b[0] = __uint_as_float(w.x << 16); b[1] = __uint_as_float(w.x & 0xffff0000u); b[2] = __uint_as_float(w.y << 16); b[3] = __uint_as_float(w.y & 0xffff0000u); }
                        else b = *(const pg8::f32x4*)((const float*)base + off + bj * 128 + n * 16);
                        b += acc[ai][bj][m][n]; uint2 o; o.x = pkbf(b[0], b[1]); o.y = pkbf(b[2], b[3]); *(uint2*)(out + off + bj * 128 + n * 16) = o; } }
    }
};
DI float silu_f(float x) { return x * __builtin_amdgcn_rcpf(1.f + __expf(-x)); }
DI float f8clamp(float x) { return __builtin_amdgcn_fmed3f(x, -448.f, 448.f); }
DI unsigned pk4_fp8(float a, float b, float c, float d) { unsigned p = 0u; p = __builtin_amdgcn_cvt_pk_fp8_f32(f8clamp(a), f8clamp(b), p, false); p = __builtin_amdgcn_cvt_pk_fp8_f32(f8clamp(c), f8clamp(d), p, true); return p; }
constexpr float F8_WSC = 64.f, F8_HSC = 8.f, F8_ASC = 16.f;
struct EpiSwiGLU {
    static constexpr bool PERM = true, AFTER_DRAIN = false;
    unsigned char* act; int nN;
    DI void operator()(const pg8::f32x4 (&acc)[2][2][4][2], const pg8::Unit& u, int wr, int wc, int fr, int fq) const {
        const int lpn = u.pn % nN; const int row0 = u.pm * 256 + wr * 64 + fr, col0 = lpn * 128 + wc * 32 + 8 * fq; constexpr float is = 1.f / (F8_HSC * F8_WSC);
#pragma unroll
        for (int ai = 0; ai < 2; ++ai)
#pragma unroll
            for (int m = 0; m < 4; ++m) { unsigned char* p = act + (size_t)(row0 + ai * 128 + m * 16) * FF + col0;
                const pg8::f32x4 a0 = acc[ai][0][m][0] * is, a1 = acc[ai][0][m][1] * is, g0 = acc[ai][1][m][0] * (is * F8_ASC), g1 = acc[ai][1][m][1] * (is * F8_ASC);
                uint2 w; w.x = pk4_fp8(silu_f(a0[0]) * g0[0], silu_f(a0[1]) * g0[1], silu_f(a0[2]) * g0[2], silu_f(a0[3]) * g0[3]);
                w.y = pk4_fp8(silu_f(a1[0]) * g1[0], silu_f(a1[1]) * g1[1], silu_f(a1[2]) * g1[2], silu_f(a1[3]) * g1[3]);
                *(uint2*)p = w; }
    }
};
struct EpiGate {
    static constexpr bool PERM = true, AFTER_DRAIN = false;
    bf16* ys; const float* gate;
    DI void operator()(const pg8::f32x4 (&acc)[2][2][4][2], const pg8::Unit& u, int wr, int wc, int fr, int fq) const {
        const int row0 = u.pm * 256 + wr * 64 + fr, col0 = (u.pn & 3) * 256 + wc * 32 + 8 * fq;
#pragma unroll
        for (int ai = 0; ai < 2; ++ai)
#pragma unroll
            for (int m = 0; m < 4; ++m) { const int row = row0 + ai * 128 + m * 16; const float g = gate[row] * (1.f / (F8_ASC * F8_WSC)); bf16* p = ys + (size_t)row * DM + col0;
#pragma unroll
                for (int bj = 0; bj < 2; ++bj) { const pg8::f32x4 v0 = acc[ai][bj][m][0] * g, v1 = acc[ai][bj][m][1] * g; pg8::u32x4 w;
                    w.x = pg8::cvt_pk_bf16(v0[0], v0[1]); w.y = pg8::cvt_pk_bf16(v0[2], v0[3]); w.z = pg8::cvt_pk_bf16(v1[0], v1[1]); w.w = pg8::cvt_pk_bf16(v1[2], v1[3]);
                    *(pg8::u32x4*)(p + bj * 128) = w; } }
    }
};

DI void cvt_tile(const float* W, int N, int nvalid, int k0, int n0, bf16* dst, int Kd, size_t drow0, LAS float* scr, int lane) {
    const int c4 = (lane & 15) * 4, kr = lane >> 4;
#pragma unroll
    for (int it = 0; it < 16; ++it) { const int k = it * 4 + kr; float4 v = make_float4(0.f, 0.f, 0.f, 0.f);
        if (n0 + c4 < nvalid) v = *(const float4*)(W + (size_t)(k0 + k) * N + n0 + c4);
        LAS float* s = scr + k * 65 + c4; s[0] = v.x; s[1] = v.y; s[2] = v.z; s[3] = v.w; }
    LDS_WAIT(); asm volatile("" ::: "memory");
    const int c = lane & 7;
#pragma unroll
    for (int it = 0; it < 8; ++it) { const int n = it * 8 + (lane >> 3); const LAS float* s = scr + (8 * c) * 65 + n;
        uint4 o; o.x = pk2(s[0], s[65]); o.y = pk2(s[130], s[195]); o.z = pk2(s[260], s[325]); o.w = pk2(s[390], s[455]);
        *(uint4*)(dst + (drow0 + n) * (size_t)Kd + k0 + 8 * c) = o; }
    LDS_WAIT(); asm volatile("" ::: "memory");
}
DI void cvt_tile_fp8(const float* W, int N, int k0, int n0, unsigned char* dst, int Kd, size_t drow0, float sc, LAS unsigned char* scr, int lane) {
    const int nq = lane & 15, kq = lane >> 4;
#pragma unroll
    for (int hb = 0; hb < 2; ++hb) {
        f32x4 v[4][4];
#pragma unroll
        for (int it = 0; it < 4; ++it)
#pragma unroll
            for (int j = 0; j < 4; ++j) v[it][j] = __builtin_nontemporal_load((const f32x4*)(W + (size_t)(k0 + hb * 64 + it * 16 + kq * 4 + j) * N + n0 + 4 * nq));
#pragma unroll
        for (int it = 0; it < 4; ++it)
#pragma unroll
            for (int i = 0; i < 4; ++i) *(LAS unsigned*)(scr + (4 * nq + i) * 132 + hb * 64 + it * 16 + kq * 4) = pk4_fp8(v[it][0][i] * sc, v[it][1][i] * sc, v[it][2][i] * sc, v[it][3][i] * sc);
    }
    LDS_WAIT(); asm volatile("" ::: "memory");
    const int c = lane & 7;
#pragma unroll
    for (int it = 0; it < 8; ++it) { const int n = it * 8 + (lane >> 3); const LAS unsigned* s = (const LAS unsigned*)(scr + n * 132 + 16 * c);
        uint4 o; o.x = s[0]; o.y = s[1]; o.z = s[2]; o.w = s[3];
        *(uint4*)(dst + (drow0 + n) * (size_t)Kd + k0 + 16 * c) = o; }
    LDS_WAIT(); asm volatile("" ::: "memory");
}
DI void phase_p0(const Args& A, LAS unsigned char* lds, int it0, int it1, int gw, int ngw, int wave, int lane) {
    LAS float* scr = (LAS float*)(lds + wave * 16896);
    bf16* wtin = (bf16*)(A.ws + WS_WTIN); bf16* wtout = (bf16*)(A.ws + WS_WTOUT); unsigned char* w13 = A.ws + WS_W13T; unsigned char* w2t = A.ws + WS_W2T;
    constexpr int I_IN = NL * 16 * 64, I_OUT = NL * 16 * 16, I_E = 8 * 44, I_MOE = NL * NE * 3 * I_E;
    for (int it = it0 + gw; it < it1; it += ngw) {
        int r = it;
        if (r < I_IN) { const int l = r / 1024, t = r % 1024, kb = t / 64, nb = t % 64;
            cvt_tile(A.in[I_WIN] + (size_t)l * DM * INW, INW, INW, kb * 64, nb * 64, wtin + (size_t)l * ZLD * DM, DM, (size_t)nb * 64, scr, lane); continue; }
        r -= I_IN;
        if (r < I_OUT) { const int l = r / 256, t = r % 256, kb = t / 16, nb = t % 16;
            cvt_tile(A.in[I_WOUT] + (size_t)l * DM * DM, DM, DM, kb * 64, nb * 64, wtout + (size_t)l * DM * DM, DM, (size_t)nb * 64, scr, lane); continue; }
        r -= I_OUT;
        const int le = r / (3 * I_E), q = r % (3 * I_E), which = q / I_E, t = q % I_E;
        if (which < 2) { const int kb = t / 44, nb = t % 44, n0 = nb * 64;
            cvt_tile_fp8(A.in[which == 0 ? I_EW1 : I_EW3] + (size_t)le * DM * FF, FF, kb * 128, n0, w13 + (size_t)le * 5632 * DM, DM, (size_t)((n0 >> 7) * 256 + which * 128 + (n0 & 127)), F8_WSC, (LAS unsigned char*)scr, lane); }
        else { const int kb = t / 16, nb = t % 16;
            cvt_tile_fp8(A.in[I_EW2] + (size_t)le * FF * DM, DM, kb * 128, nb * 64, w2t + (size_t)le * DM * FF, FF, (size_t)nb * 64, F8_WSC, (LAS unsigned char*)scr, lane); }
    }
    if (it0 == 0) { bf16* g2t = (bf16*)(A.ws + WS_G2T);
        for (int idx = gw * 64 + lane; idx < NL * 128 * RW; idx += ngw * 64) { const int col = idx % RW, j = (idx / RW) % 128, l = idx / (128 * RW); g2t[((size_t)l * RW + col) * 128 + j] = (bf16)f2bf(A.in[I_G2][idx]); } }
}

DI void load_row(const float* xrow, int lane, f32x4 (&v)[4]) {
    const f32x4* xr = (const f32x4*)xrow + lane;
#pragma unroll
    for (int j = 0; j < 4; ++j) v[j] = xr[64 * j];
}
DI void load_row_bf(const bf16* xrow, int lane, f32x4 (&v)[4]) {
    const uint2* xr = (const uint2*)xrow + lane;
#pragma unroll
    for (int j = 0; j < 4; ++j) { const uint2 w = xr[64 * j]; v[j][0] = __uint_as_float(w.x << 16); v[j][1] = __uint_as_float(w.x & 0xffff0000u); v[j][2] = __uint_as_float(w.y << 16); v[j][3] = __uint_as_float(w.y & 0xffff0000u); }
}
DI void add_slots(const Args& A, int tok, int lane, f32x4 (&v)[4]) {
    const int* sel = (const int*)(A.ws + WS_SEL); const bf16* ys = (const bf16*)(A.ws + WS_YS);
    const int b = tok / SEQ; const int mys = (lane < NE) ? sel[(size_t)tok * NE + lane] : -1;
    for (int e = 0; e < NE; ++e) { const int r = __shfl(mys, e);
        if (r >= 0) { const uint2* p = (const uint2*)(ys + (size_t)((e * NB + b) * CAP + r) * DM) + lane;
#pragma unroll
            for (int j = 0; j < 4; ++j) { const uint2 w = p[64 * j]; v[j][0] += __uint_as_float(w.x << 16); v[j][1] += __uint_as_float(w.x & 0xffff0000u); v[j][2] += __uint_as_float(w.y << 16); v[j][3] += __uint_as_float(w.y & 0xffff0000u); } } }
}
DI float row_rstd(const f32x4 (&v)[4]) {
    float s = 0.f;
#pragma unroll
    for (int j = 0; j < 4; ++j) s += (v[j][0] * v[j][0] + v[j][1] * v[j][1]) + (v[j][2] * v[j][2] + v[j][3] * v[j][3]);
    return rsqrtf(wave_sum(s) * (1.f / DM) + RMS_EPS);
}
DI void phase_ln1(const Args& A, int l, int gw, int ngw, int lane) {
    const float* xin = A.in[I_X]; const bf16* x1 = (const bf16*)(A.ws + WS_X1); bf16* x2 = (bf16*)(A.ws + WS_X2); bf16* hb = (bf16*)(A.ws + WS_HB);
    f32x4 gg[4];
#pragma unroll
    for (int j = 0; j < 4; ++j) gg[j] = ((const f32x4*)(A.in[I_LN1G] + (size_t)l * DM) + lane)[64 * j];
    for (int tok = gw; tok < NT; tok += 2 * ngw) {
        const int tokb = tok + ngw; const bool hb2 = tokb < NT;
        f32x4 va[4], vb[4];
        if (l == 0) { load_row(xin + (size_t)tok * DM, lane, va); load_row(xin + (size_t)(hb2 ? tokb : tok) * DM, lane, vb); }
        else { load_row_bf(x1 + (size_t)tok * DM, lane, va); load_row_bf(x1 + (size_t)(hb2 ? tokb : tok) * DM, lane, vb);
            add_slots(A, tok, lane, va); add_slots(A, hb2 ? tokb : tok, lane, vb);
            uint2* oa = (uint2*)(x2 + (size_t)tok * DM) + lane; uint2* ob = (uint2*)(x2 + (size_t)tokb * DM) + lane;
#pragma unroll
            for (int j = 0; j < 4; ++j) { uint2 w; w.x = pkbf(va[j][0], va[j][1]); w.y = pkbf(va[j][2], va[j][3]); oa[64 * j] = w;
                if (hb2) { uint2 u; u.x = pkbf(vb[j][0], vb[j][1]); u.y = pkbf(vb[j][2], vb[j][3]); ob[64 * j] = u; } } }
        const float ra = row_rstd(va), rb = row_rstd(vb); uint2* o8a = (uint2*)(hb + (size_t)tok * DM) + lane; uint2* o8b = (uint2*)(hb + (size_t)tokb * DM) + lane;
#pragma unroll
        for (int j = 0; j < 4; ++j) { uint2 w; w.x = pkbf(va[j][0] * ra * gg[j][0], va[j][1] * ra * gg[j][1]); w.y = pkbf(va[j][2] * ra * gg[j][2], va[j][3] * ra * gg[j][3]); o8a[64 * j] = w;
            if (hb2) { uint2 u; u.x = pkbf(vb[j][0] * rb * gg[j][0], vb[j][1] * rb * gg[j][1]); u.y = pkbf(vb[j][2] * rb * gg[j][2], vb[j][3] * rb * gg[j][3]); o8b[64 * j] = u; } }
    }
}
DI void phase_final(const Args& A, int gw, int ngw, int lane) {
    const bf16* xin = (const bf16*)(A.ws + WS_X1);
    f32x4 gg[4];
#pragma unroll
    for (int j = 0; j < 4; ++j) gg[j] = ((const f32x4*)A.in[I_FG] + lane)[64 * j];
    for (int tok = gw; tok < NT; tok += 2 * ngw) {
        const int tokb = tok + ngw; const bool hb2 = tokb < NT;
        f32x4 va[4], vb[4]; load_row_bf(xin + (size_t)tok * DM, lane, va); load_row_bf(xin + (size_t)(hb2 ? tokb : tok) * DM, lane, vb);
        add_slots(A, tok, lane, va); add_slots(A, hb2 ? tokb : tok, lane, vb);
        const float ra = row_rstd(va), rb = row_rstd(vb); f32x4* oa = (f32x4*)(A.out + (size_t)tok * DM) + lane; f32x4* ob = (f32x4*)(A.out + (size_t)tokb * DM) + lane;
#pragma unroll
        for (int j = 0; j < 4; ++j) { oa[64 * j] = va[j] * ra * gg[j]; if (hb2) ob[64 * j] = vb[j] * rb * gg[j]; }
    }
}
DI void phase_topk(const Args& A, LAS unsigned char* lds, int bid, int G, int tid, int wave, int lane) {
    const unsigned* affk = (const unsigned*)(A.ws + WS_AFF); int* sel = (int*)(A.ws + WS_SEL); float* gate = (float*)(A.ws + WS_GATE);
    const unsigned char* hb = A.ws + WS_HB; unsigned char* xg = A.ws + WS_XG;
    LAS unsigned* hist = (LAS unsigned*)lds;
    LAS unsigned* wsum = hist + 32;
    LAS int* list = (LAS int*)(lds + 256);
    for (int u = bid; u < NB * NE * 2; u += G) {
        const int half = u & 1, e = (u >> 1) % NE, b = u / (2 * NE);
        __syncthreads();
        if (tid < 32) hist[tid] = 0u;
        const uint4 kv = *(const uint4*)(affk + (size_t)(b * NE + e) * SEQ + tid * 4);
        const unsigned key[4] = {kv.x, kv.y, kv.z, kv.w};
        __syncthreads();
        unsigned prefix = 0u, krem = CAP;
#pragma unroll 1
        for (int pass = 0; pass < 8; ++pass) { const int shift = 28 - 4 * pass; LAS unsigned* h = hist + (pass & 1) * 16;
            unsigned cnt = 0u;
#pragma unroll
            for (int i = 0; i < 4; ++i) { const bool cand = (pass == 0) || ((key[i] >> (shift + 4)) == prefix); const unsigned bin = (key[i] >> shift) & 15u;
#pragma unroll
                for (int v = 0; v < 16; ++v) { const unsigned long long m = __ballot(cand && bin == (unsigned)v); if (lane == v) cnt += (unsigned)__popcll(m); } }
            if (lane < 16 && cnt) atomicAdd((unsigned*)(h + lane), cnt);
            __syncthreads();
            unsigned acc = 0u, pick = 0u, before = 0u;
#pragma unroll
            for (int v = 15; v >= 0; --v) { const unsigned c = h[v]; if (acc < krem && acc + c >= krem) { pick = (unsigned)v; before = acc; } acc += c; }
            prefix = (prefix << 4) | pick; krem -= before;
            if (tid < 16) hist[((pass + 1) & 1) * 16 + tid] = 0u;
            __syncthreads();
        }
        const unsigned tau = prefix;
        unsigned gt[4], eq[4]; unsigned ngt = 0u, neq = 0u;
#pragma unroll
        for (int i = 0; i < 4; ++i) { gt[i] = key[i] > tau ? 1u : 0u; eq[i] = key[i] == tau ? 1u : 0u; ngt += gt[i]; neq += eq[i]; }
        unsigned sg = ngt, se = neq;
#pragma unroll
        for (int o = 1; o < 64; o <<= 1) { const unsigned tg = __shfl_up(sg, o), te = __shfl_up(se, o); if (lane >= o) { sg += tg; se += te; } }
        if (lane == 63) { wsum[wave] = sg; wsum[8 + wave] = se; }
        __syncthreads();
        unsigned offg = 0u, offe = 0u;
        for (int w = 0; w < wave; ++w) { offg += wsum[w]; offe += wsum[8 + w]; }
        unsigned eqbefore = offe + se - neq;
        unsigned gtbefore = offg + sg - ngt;
        const int slot0 = (e * NB + b) * CAP;
#pragma unroll
        for (int i = 0; i < 4; ++i) { const int s = tid * 4 + i; const bool selq = gt[i] || (eq[i] && eqbefore < krem);
            const unsigned pos = gtbefore + (eqbefore < krem ? eqbefore : krem);
            if ((s >> 10) == half) { sel[(size_t)(b * SEQ + s) * NE + e] = selq ? (int)pos : -1;
                if (selq) { gate[slot0 + pos] = __uint_as_float(key[i]); } }
            if (selq && pos < CAP) list[pos] = s;
            gtbefore += gt[i]; eqbefore += eq[i]; }
        __syncthreads();
        for (int r = wave; r < CAP; r += NWAVES) { const int s = list[r];
            if ((s >> 10) == half) { const uint4* src = (const uint4*)(hb + (size_t)(b * SEQ + s) * DM) + lane; uint4* dstp = (uint4*)(xg + (size_t)(slot0 + r) * DM) + lane; dstp[0] = src[0]; } }
    }
    __syncthreads();
}

DI int t5_bucket(int rel) {
    const int ret = rel > 0 ? 16 : 0; const int n = rel < 0 ? -rel : rel;
    if (n < 8) return ret + n;
    int large = 8 + (int)(logf((float)n / 8.0f) / 4.852030263919617f * 8.0f);
    large = large < 15 ? large : 15;
    return ret + large;
}

typedef short bf16x8_t __attribute__((ext_vector_type(8)));
typedef short bf16x4_t __attribute__((ext_vector_type(4)));
typedef unsigned u32x4_t __attribute__((ext_vector_type(4)));
typedef unsigned u32x2_t __attribute__((ext_vector_type(2)));
typedef __bf16 bf2_t __attribute__((ext_vector_type(2)));
typedef float f2_t __attribute__((ext_vector_type(2)));
DI unsigned cvtpk(float lo, float hi) { const f2_t v = {lo, hi}; return __builtin_bit_cast(unsigned, __builtin_convertvector(v, bf2_t)); }
#define MFMA16(a, b, c) __builtin_amdgcn_mfma_f32_16x16x32_bf16((a), (b), (c), 0, 0, 0)

constexpr int AT_QS = 0, AT_QLD = 72;
constexpr int AT_KS = AT_QS + 128 * AT_QLD * 2;
constexpr int AT_VT = AT_KS + 272 * AT_QLD * 2, AT_VLD = 280;
constexpr int AT_BT = AT_VT + 64 * AT_VLD * 2;
constexpr int AT_END = AT_BT + 132 * 4;
static_assert(AT_END <= MISC_OFF, "attention LDS");

DI void attn_unit(const Args& A, LAS unsigned char* lds, int unit, int tid, int wave, int lane) {
    const bf16* Z = (const bf16*)(A.ws + WS_Z); bf16* ao = (bf16*)(A.ws + WS_ATTO); float* al = (float*)(A.ws + WS_ATTL);
    const int x = unit & 15; int r0 = unit >> 4; const int hh = r0 & 3; r0 >>= 2; const int b = r0 % NB, br = r0 / NB;
    const int dil = br == 0 ? 1 : (br == 1 ? 4 : 16), lsub = SEQ / dil, nblk = lsub / 128;
    const int res = x / nblk, nbk = x % nblk, l0 = nbk * 128, wbase = l0 - 64;
    LAS bf16* Qs = (LAS bf16*)(lds + AT_QS); LAS bf16* Ks = (LAS bf16*)(lds + AT_KS); LAS bf16* Vt = (LAS bf16*)(lds + AT_VT); LAS float* btab = (LAS float*)(lds + AT_BT);
    __syncthreads();
#pragma unroll
    for (int i = 0; i < 2; ++i) { const int id = tid + 512 * i, row = id >> 3, ch = id & 7; const int tok = b * SEQ + (l0 + row) * dil + res;
        *(LAS u32x4_t*)(Qs + row * AT_QLD + ch * 8) = *(const u32x4_t*)(Z + (size_t)tok * ZLD + ZA + hh * 64 + ch * 8); }
    for (int id = tid; id < 272 * 8; id += NTHR) { const int row = id >> 3, ch = id & 7; const int pos = wbase + row; u32x4_t v = (u32x4_t){0u, 0u, 0u, 0u};
        if (row < 256 && pos >= 0 && pos < lsub) v = *(const u32x4_t*)(Z + (size_t)(b * SEQ + pos * dil + res) * ZLD + ZA + 256 + hh * 64 + ch * 8);
        *(LAS u32x4_t*)(Ks + row * AT_QLD + ch * 8) = v; }
    for (int id = tid; id < 272 * 8; id += NTHR) { const int key = id % 272, ch = id / 272; const int pos = wbase + key; u32x4_t v = (u32x4_t){0u, 0u, 0u, 0u};
        if (key < 256 && pos >= 0 && pos < lsub) v = *(const u32x4_t*)(Z + (size_t)(b * SEQ + pos * dil + res) * ZLD + ZA + 512 + hh * 64 + ch * 8);
        LAS bf16* d = Vt + (ch * 8) * AT_VLD + key;
        d[0] = (bf16)(v.x & 0xffffu); d[AT_VLD] = (bf16)(v.x >> 16); d[2 * AT_VLD] = (bf16)(v.y & 0xffffu); d[3 * AT_VLD] = (bf16)(v.y >> 16);
        d[4 * AT_VLD] = (bf16)(v.z & 0xffffu); d[5 * AT_VLD] = (bf16)(v.z >> 16); d[6 * AT_VLD] = (bf16)(v.w & 0xffffu); d[7 * AT_VLD] = (bf16)(v.w >> 16); }
    if (tid < 129) btab[tid] = A.in[I_RELB][t5_bucket((tid - 64) * dil) * 4 + hh];
    __syncthreads();
    const int fr = lane & 15, qd = lane >> 4;
    f32x4 acc[10];
    { bf16x8_t qb[2];
#pragma unroll
      for (int ks = 0; ks < 2; ++ks) qb[ks] = *(const LAS bf16x8_t*)(Qs + (16 * wave + fr) * AT_QLD + ks * 32 + 8 * qd);
#pragma unroll
      for (int j = 0; j < 10; ++j) { acc[j] = (f32x4){0.f, 0.f, 0.f, 0.f};
#pragma unroll
          for (int ks = 0; ks < 2; ++ks) { const bf16x8_t ka = *(const LAS bf16x8_t*)(Ks + (16 * (wave + j) + fr) * AT_QLD + ks * 32 + 8 * qd); acc[j] = MFMA16(ka, qb[ks], acc[j]); } } }
    const int iq = 16 * wave + fr; float mx = -1.0e30f;
#pragma unroll
    for (int j = 0; j < 10; ++j)
#pragma unroll
        for (int r = 0; r < 4; ++r) { const int kw = 16 * (wave + j) + 4 * qd + r; const int m = kw - 64 - iq; const int pos = wbase + kw;
            const bool valid = (m >= -64) && (m <= 64) && (pos >= 0) && (pos < lsub);
            const float s = valid ? acc[j][r] * 0.125f + btab[valid ? m + 64 : 0] : -1.0e30f; acc[j][r] = s; mx = fmaxf(mx, s); }
    mx = fmaxf(mx, __shfl_xor(mx, 16)); mx = fmaxf(mx, __shfl_xor(mx, 32));
    float lsum = 0.f;
#pragma unroll
    for (int j = 0; j < 10; ++j)
#pragma unroll
        for (int r = 0; r < 4; ++r) { const float p = __expf(acc[j][r] - mx); acc[j][r] = p; lsum += p; }
    lsum += __shfl_xor(lsum, 16); lsum += __shfl_xor(lsum, 32);
    f32x4 oacc[4];
#pragma unroll
    for (int d = 0; d < 4; ++d) oacc[d] = (f32x4){0.f, 0.f, 0.f, 0.f};
#pragma unroll
    for (int pp = 0; pp < 5; ++pp) {
        union { unsigned u[4]; bf16x8_t v; } pb;
        pb.u[0] = cvtpk(acc[2 * pp][0], acc[2 * pp][1]); pb.u[1] = cvtpk(acc[2 * pp][2], acc[2 * pp][3]); pb.u[2] = cvtpk(acc[2 * pp + 1][0], acc[2 * pp + 1][1]); pb.u[3] = cvtpk(acc[2 * pp + 1][2], acc[2 * pp + 1][3]);
#pragma unroll
        for (int d = 0; d < 4; ++d) { const LAS bf16* vp = Vt + (16 * d + fr) * AT_VLD + 16 * (wave + 2 * pp) + 4 * qd;
            union { bf16x4_t h[2]; bf16x8_t v; } va; va.h[0] = *(const LAS bf16x4_t*)vp; va.h[1] = *(const LAS bf16x4_t*)(vp + 16);
            oacc[d] = MFMA16(va.v, pb.v, oacc[d]); } }
    const float inv = 1.f / lsum; const int tok = b * SEQ + (l0 + iq) * dil + res;
    bf16* op = ao + ((size_t)br * NT + tok) * AW + hh * 64 + 4 * qd;
#pragma unroll
    for (int d = 0; d < 4; ++d) { uint2 w; w.x = cvtpk(oacc[d][0] * inv, oacc[d][1] * inv); w.y = cvtpk(oacc[d][2] * inv, oacc[d][3] * inv); *(uint2*)(op + 16 * d) = w; }
    if (qd == 0) al[((size_t)br * NT + tok) * 4 + hh] = mx + logf(lsum);
}
constexpr int ATT_UNITS = 3 * NB * 4 * 16, ATT_SCAN_BLK0 = 160, ATT_SPLIT = ATT_UNITS - 96 * 6;
DI void phase_attn(const Args& A, LAS unsigned char* lds, int u0, int u1, int b0, int nb, int tid, int wave, int lane) {
    for (int u = u0 + b0; u < u1; u += nb) attn_unit(A, lds, u, tid, wave, lane);
    __syncthreads();
}


constexpr int ML_QLD = 104, ML_SLD = 72;
constexpr int ML_QS = 0;
constexpr int ML_QT = ML_QS + 64 * ML_QLD * 2;
constexpr int ML_KS = ML_QT + 64 * ML_QLD * 2;
constexpr int ML_KT = ML_KS + 64 * ML_QLD * 2;
constexpr int ML_VT = ML_KT + 96 * ML_SLD * 2;
constexpr int ML_WS = ML_VT + 112 * ML_SLD * 2;
constexpr int ML_CT = ML_WS + 64 * ML_SLD * 2;
constexpr int ML_CW = ML_CT + 112 * ML_QLD * 2;
constexpr int ML_END = ML_CW + 6 * 192 * 4;
static_assert(ML_END <= MISC_OFF, "mlstm LDS");

constexpr int MLP_QF = 0, MLP_NI = 12288, MLP_U = 26624, MLP_DEC = 48128, MLP_BYTES = 48384;
constexpr size_t WS_MLPKG = WS_R + 304 * MiB;
static_assert(WS_MLPKG + (size_t)2 * NB * 4 * 32 * MLP_BYTES <= WS_RKY, "mlstm package region");

struct M1Regs { u32x4_t zc[15]; u32x2_t vv[3]; float gi, gf; };
DI void mlstm_m1_fetch(const Args& A, int item, int tid, int lane, M1Regs& R) {
    const bf16* Z = (const bf16*)(A.ws + WS_Z);
    const int c = item & 31, u = item >> 5; const int dir = u / 32, b = (u % 32) / 4, hh = u % 4; const int j = tid >> 3, sub = tid & 7;
    const int tl = dir ? SEQ - 1 - (c * 64 + lane) : c * 64 + lane; const size_t tokl = (size_t)b * SEQ + tl;
    R.gi = bf2f(Z[tokl * ZLD + ZMG + dir * 8 + hh]); R.gf = bf2f(Z[tokl * ZLD + ZMG + dir * 8 + 4 + hh]);
    const int tj = dir ? SEQ - 1 - (c * 64 + j) : c * 64 + j; const size_t tokj = (size_t)b * SEQ + tj;
    const bool isk = sub >= 4; const int zcol = ZMQK + (isk ? 384 : 0) + hh * 96 + (sub & 3) * 24;
#pragma unroll
    for (int tap = 0; tap < 5; ++tap) { const int tt = tj + tap - 2; const bool ok = tt >= 0 && tt < SEQ; const u32x4_t* zp = (const u32x4_t*)(Z + ((size_t)b * SEQ + (ok ? tt : tj)) * ZLD + zcol);
#pragma unroll
        for (int q4 = 0; q4 < 3; ++q4) { const u32x4_t w = zp[q4]; R.zc[tap * 3 + q4] = ok ? w : (u32x4_t){0u, 0u, 0u, 0u}; } }
    const u32x2_t* vp = (const u32x2_t*)(Z + tokj * ZLD + ZMV + hh * 96 + sub * 12);
#pragma unroll
    for (int q2 = 0; q2 < 3; ++q2) R.vv[q2] = vp[q2];
}
DI void mlstm_m1_item(const Args& A, int l, LAS unsigned char* lds, int item, int item_next, M1Regs& R, int& hh_staged, int tid, int wave, int lane) {
    const int c = item & 31, u = item >> 5; const int dir = u / 32, hh = u % 4;
    LAS bf16* Qs = (LAS bf16*)(lds + ML_QS); LAS bf16* Qt = (LAS bf16*)(lds + ML_QT); LAS bf16* Ks = (LAS bf16*)(lds + ML_KS); LAS bf16* KtT = (LAS bf16*)(lds + ML_KT);
    LAS bf16* VtT = (LAS bf16*)(lds + ML_VT); LAS bf16* Ws = (LAS bf16*)(lds + ML_WS); LAS float* cwl = (LAS float*)(lds + ML_CW); LAS float* cbl = cwl + 5 * 192;
    const int fr = lane & 15, qd = lane >> 4;
    unsigned char* pkg = A.ws + WS_MLPKG + (size_t)item * MLP_BYTES;
    __syncthreads();
    if (hh != hh_staged) { hh_staged = hh;
        for (int i = tid; i < 5 * 192; i += NTHR) { const int tap = i / 192, ch = i % 192; cwl[i] = A.in[I_CW][(size_t)(l * 5 + tap) * 768 + (ch < 96 ? 0 : 384) + hh * 96 + (ch % 96)]; }
        for (int i = tid; i < 192; i += NTHR) cbl[i] = A.in[I_CB][(size_t)l * 768 + (i < 96 ? 0 : 384) + hh * 96 + (i % 96)];
        for (int i = tid; i < 16 * ML_SLD; i += NTHR) VtT[96 * ML_SLD + i] = (i < ML_SLD) ? (bf16)0x3F80u : (bf16)0u;
        __syncthreads(); }
    const float ibv = A.in[I_IB][(l * 2 + dir) * 4 + hh], fbv = A.in[I_FB][(l * 2 + dir) * 4 + hh];
    const int j = tid >> 3, sub = tid & 7;
    const float gi = R.gi + ibv, gf = R.gf + fbv;
    float bsum = fminf(gf, 0.f) - __logf(1.f + __expf(-fabsf(gf)));
#pragma unroll
    for (int o = 1; o < 64; o <<= 1) { const float t = __shfl_up(bsum, o); if (lane >= o) bsum += t; }
    const float bend = __shfl(bsum, 63);
    const float bj = __shfl(bsum, j), igj = __shfl(gi, j);
    { const bool isk = sub >= 4; const int c0 = (sub & 3) * 24, cl = (isk ? 96 : 0) + c0;
      float acc[24];
#pragma unroll
      for (int e = 0; e < 24; ++e) acc[e] = cbl[cl + e];
#pragma unroll
      for (int tap = 0; tap < 5; ++tap) {
#pragma unroll
          for (int q4 = 0; q4 < 3; ++q4) { const u32x4_t w = R.zc[tap * 3 + q4]; const LAS float* cwp = cwl + tap * 192 + cl + q4 * 8;
              acc[q4 * 8 + 0] += cwp[0] * __uint_as_float(w.x << 16); acc[q4 * 8 + 1] += cwp[1] * __uint_as_float(w.x & 0xffff0000u);
              acc[q4 * 8 + 2] += cwp[2] * __uint_as_float(w.y << 16); acc[q4 * 8 + 3] += cwp[3] * __uint_as_float(w.y & 0xffff0000u);
              acc[q4 * 8 + 4] += cwp[4] * __uint_as_float(w.z << 16); acc[q4 * 8 + 5] += cwp[5] * __uint_as_float(w.z & 0xffff0000u);
              acc[q4 * 8 + 6] += cwp[6] * __uint_as_float(w.w << 16); acc[q4 * 8 + 7] += cwp[7] * __uint_as_float(w.w & 0xffff0000u); } }
      const float sc1 = isk ? 0.10206207261596575f : 1.f; const float sc2 = isk ? __expf(bend - bj + igj) : __expf(bj);
#pragma unroll
      for (int e = 0; e < 24; ++e) acc[e] = acc[e] * sigm(acc[e]) * sc1;
      if (!isk) { LAS bf16* d1 = Qs + j * ML_QLD + c0; LAS bf16* d2 = Qt + j * ML_QLD + c0;
#pragma unroll
          for (int q4 = 0; q4 < 3; ++q4) { u32x4_t w; w.x = cvtpk(acc[q4 * 8 + 0], acc[q4 * 8 + 1]); w.y = cvtpk(acc[q4 * 8 + 2], acc[q4 * 8 + 3]); w.z = cvtpk(acc[q4 * 8 + 4], acc[q4 * 8 + 5]); w.w = cvtpk(acc[q4 * 8 + 6], acc[q4 * 8 + 7]);
              *(LAS u32x4_t*)(d1 + q4 * 8) = w;
              u32x4_t x; x.x = cvtpk(acc[q4 * 8 + 0] * sc2, acc[q4 * 8 + 1] * sc2); x.y = cvtpk(acc[q4 * 8 + 2] * sc2, acc[q4 * 8 + 3] * sc2); x.z = cvtpk(acc[q4 * 8 + 4] * sc2, acc[q4 * 8 + 5] * sc2); x.w = cvtpk(acc[q4 * 8 + 6] * sc2, acc[q4 * 8 + 7] * sc2);
              *(LAS u32x4_t*)(d2 + q4 * 8) = x; } }
      else { LAS bf16* d1 = Ks + j * ML_QLD + c0;
#pragma unroll
          for (int q4 = 0; q4 < 3; ++q4) { u32x4_t w; w.x = cvtpk(acc[q4 * 8 + 0], acc[q4 * 8 + 1]); w.y = cvtpk(acc[q4 * 8 + 2], acc[q4 * 8 + 3]); w.z = cvtpk(acc[q4 * 8 + 4], acc[q4 * 8 + 5]); w.w = cvtpk(acc[q4 * 8 + 6], acc[q4 * 8 + 7]);
              *(LAS u32x4_t*)(d1 + q4 * 8) = w; }
#pragma unroll
          for (int e = 0; e < 24; ++e) KtT[(c0 + e) * ML_SLD + j] = (bf16)cvtpk(acc[e] * sc2, 0.f); } }
    { const int n0 = sub * 12;
#pragma unroll
      for (int q2 = 0; q2 < 3; ++q2) { const u32x2_t w = R.vv[q2]; LAS bf16* d = VtT + (n0 + q2 * 4) * ML_SLD + j;
          d[0] = (bf16)(w.x & 0xffffu); d[ML_SLD] = (bf16)(w.x >> 16); d[2 * ML_SLD] = (bf16)(w.y & 0xffffu); d[3 * ML_SLD] = (bf16)(w.y >> 16); } }
    if (item_next >= 0) mlstm_m1_fetch(A, item_next, tid, lane, R);
    __syncthreads();
#pragma unroll
    for (int i = 0; i < 2; ++i) { const int tile = 2 * wave + i, jt = tile >> 2, st = tile & 3; const int jq = 16 * jt + fr;
        u32x2_t w = (u32x2_t){0u, 0u};
        if (st <= jt) { f32x4 acc = (f32x4){0.f, 0.f, 0.f, 0.f};
#pragma unroll
            for (int ks = 0; ks < 3; ++ks) { const bf16x8_t a = *(const LAS bf16x8_t*)(Ks + (16 * st + fr) * ML_QLD + 32 * ks + 8 * qd); const bf16x8_t bq = *(const LAS bf16x8_t*)(Qs + jq * ML_QLD + 32 * ks + 8 * qd); acc = MFMA16(a, bq, acc); }
            const float bjq = __shfl(bsum, jq); float wv[4];
#pragma unroll
            for (int r = 0; r < 4; ++r) { const int s = 16 * st + 4 * qd + r; const float bs = __shfl(bsum, s), igs = __shfl(gi, s); wv[r] = (s <= jq) ? acc[r] * __expf(bjq - bs + igs) : 0.f; }
            w.x = cvtpk(wv[0], wv[1]); w.y = cvtpk(wv[2], wv[3]); }
        *(LAS u32x2_t*)(Ws + jq * ML_SLD + 16 * st + 4 * qd) = w; }
    __syncthreads();
    for (int id = wave; id < 12; id += NWAVES) { const int jt = id / 3, i3 = id % 3; const LAS bf16* p = Qt + (16 * jt + fr) * ML_QLD + 32 * i3 + 4 * qd; const u32x2_t lo = *(const LAS u32x2_t*)p, hi = *(const LAS u32x2_t*)(p + 16);
        *(u32x4_t*)(pkg + MLP_QF + (size_t)id * 1024 + lane * 16) = (u32x4_t){lo.x, lo.y, hi.x, hi.y}; }
    for (int id = wave; id < 70; id += NWAVES) { f32x4 acc = (f32x4){0.f, 0.f, 0.f, 0.f}; int nt; const LAS bf16* ap; int ald; unsigned char* dst;
        if (id < 28) { const int jt = id & 3; nt = id >> 2; ap = Ws + (16 * jt + fr) * ML_SLD; ald = 0; dst = pkg + MLP_NI + (size_t)(nt * 4 + jt) * 512; }
        else { const int q = id - 28, kt = q % 6; nt = q / 6; ap = KtT + (16 * kt + fr) * ML_SLD; ald = 0; dst = pkg + MLP_U + (size_t)(nt * 6 + kt) * 512; }
#pragma unroll
        for (int ks = 0; ks < 2; ++ks) { const bf16x8_t a = *(const LAS bf16x8_t*)(ap + 32 * ks + 8 * qd); const bf16x8_t bv = *(const LAS bf16x8_t*)(VtT + (16 * nt + fr) * ML_SLD + 32 * ks + 8 * qd);
            acc = (id < 28) ? MFMA16(bv, a, acc) : MFMA16(a, bv, acc); }
        u32x2_t w; w.x = cvtpk(acc[0], acc[1]); w.y = cvtpk(acc[2], acc[3]); *(u32x2_t*)(dst + lane * 8) = w; }
    if (tid < 64) ((float*)(pkg + MLP_DEC))[tid] = __expf(bend);
}
DI void phase_mlstm_m1(const Args& A, int l, LAS unsigned char* lds, int bid, int G, int tid, int wave, int lane) {
    int hh_staged = -1; constexpr int NIT = 2 * NB * 4 * 32;
    if (bid < NIT) { M1Regs R; mlstm_m1_fetch(A, bid, tid, lane, R);
        for (int it = bid; it < NIT; it += G) mlstm_m1_item(A, l, lds, it, (it + G < NIT) ? it + G : -1, R, hh_staged, tid, wave, lane); }
    __syncthreads();
}
constexpr int M2_SLOTS = 8, M2_SLOT_BYTES = 12288, M2_CTL = M2_SLOTS * M2_SLOT_BYTES;
static_assert(M2_CTL + 64 <= MISC_OFF, "mlstm m2 LDS");
DI f32x4 unpk4(const u32x2_t w) { return (f32x4){__uint_as_float(w.x << 16), __uint_as_float(w.x & 0xffff0000u), __uint_as_float(w.y << 16), __uint_as_float(w.y & 0xffff0000u)}; }
struct M2Small { u32x2_t ni[4], uu[6]; float dec; };
DI void m2_load_small(M2Small& o, const unsigned char* pkg, int nt, int lane) {
#pragma unroll
    for (int jt = 0; jt < 4; ++jt) o.ni[jt] = *(const u32x2_t*)(pkg + MLP_NI + (nt * 4 + jt) * 512 + lane * 8);
#pragma unroll
    for (int kt = 0; kt < 6; ++kt) o.uu[kt] = *(const u32x2_t*)(pkg + MLP_U + (nt * 6 + kt) * 512 + lane * 8);
    o.dec = ((const float*)(pkg + MLP_DEC))[lane];
}
DI void m2_step(const M2Small& o, const LAS unsigned char* slot, f32x4 (&C)[6], bf16* num, float* den, int dir, int b, int hh, int nt, int c, int lane, int fr, int qd) {
    union { unsigned u[4]; bf16x8_t v; } sB[3];
#pragma unroll
    for (int i = 0; i < 3; ++i) { sB[i].u[0] = cvtpk(C[2 * i][0], C[2 * i][1]); sB[i].u[1] = cvtpk(C[2 * i][2], C[2 * i][3]); sB[i].u[2] = cvtpk(C[2 * i + 1][0], C[2 * i + 1][1]); sB[i].u[3] = cvtpk(C[2 * i + 1][2], C[2 * i + 1][3]); }
#pragma unroll
    for (int jt = 0; jt < 4; ++jt) { f32x4 acc = unpk4(o.ni[jt]);
#pragma unroll
        for (int i = 0; i < 3; ++i) { const bf16x8_t qf = *(const LAS bf16x8_t*)(slot + (3 * jt + i) * 1024 + lane * 16); acc = MFMA16(sB[i].v, qf, acc); }
        { const int jj = 16 * jt + fr; const int tt = dir ? SEQ - 1 - (c * 64 + jj) : c * 64 + jj; const size_t tok = (size_t)b * SEQ + tt;
          if (nt < 6) { u32x2_t w; w.x = cvtpk(acc[0], acc[1]); w.y = cvtpk(acc[2], acc[3]); *(u32x2_t*)(num + ((size_t)dir * NT + tok) * MW + hh * 96 + 16 * nt + 4 * qd) = w; }
          else if (qd == 0) den[((size_t)dir * NT + tok) * 4 + hh] = acc[0]; } }
#pragma unroll
    for (int kt = 0; kt < 6; ++kt) C[kt] = C[kt] * o.dec + unpk4(o.uu[kt]);
}
DI void mlstm_m2_unit(const Args& A, LAS unsigned char* lds, int u, int tid, int wave, int lane) {
    bf16* num = (bf16*)(A.ws + WS_MLNUM); float* den = (float*)(A.ws + WS_MLDEN);
    const int dir = u / 32, b = (u % 32) / 4, hh = u % 4; const int fr = lane & 15, qd = lane >> 4;
    const unsigned char* pkg0 = A.ws + WS_MLPKG + (size_t)u * 32 * MLP_BYTES;
    volatile LAS unsigned* ready = (volatile LAS unsigned*)(lds + M2_CTL); volatile LAS unsigned* consumed = ready + 8;
    __syncthreads();
    if (tid < 16) ready[tid] = 0u;
    __syncthreads();
    if (wave == 7) {
        u32x4_t f0[12], f1[12], f2[12];
#define M2_FETCH(dst, c_) do { _Pragma("unroll") for (int i = 0; i < 12; ++i) dst[i] = *(const u32x4_t*)(pkg0 + (size_t)(c_) * MLP_BYTES + MLP_QF + i * 1024 + lane * 16); } while (0)
#define M2_PUBLISH(src, c_) do { if ((c_) >= M2_SLOTS) { const unsigned need = (unsigned)((c_) - M2_SLOTS + 1); unsigned spins = 0; \
            for (;;) { bool ok = true; _Pragma("unroll") for (int w = 0; w < 7; ++w) ok = ok && (consumed[w] >= need); if (ok) break; if (++spins > (1u << 22)) break; __builtin_amdgcn_s_sleep(1); } } \
        LAS unsigned char* slot_ = lds + ((c_) & (M2_SLOTS - 1)) * M2_SLOT_BYTES; _Pragma("unroll") for (int i = 0; i < 12; ++i) *(LAS u32x4_t*)(slot_ + i * 1024 + lane * 16) = src[i]; \
        asm volatile("s_waitcnt lgkmcnt(0)" ::: "memory"); if (lane == 0) ready[(c_) & (M2_SLOTS - 1)] = (unsigned)((c_) + 1); asm volatile("" ::: "memory"); } while (0)
        M2_FETCH(f0, 0); M2_FETCH(f1, 1);
        for (int c = 0; c < 30; c += 3) { M2_FETCH(f2, c + 2); M2_PUBLISH(f0, c); M2_FETCH(f0, c + 3); M2_PUBLISH(f1, c + 1); M2_FETCH(f1, c + 4); M2_PUBLISH(f2, c + 2); }
        M2_PUBLISH(f0, 30); M2_PUBLISH(f1, 31);
#undef M2_FETCH
#undef M2_PUBLISH
    } else {
        const int nt = wave; f32x4 C[6];
#pragma unroll
        for (int kt = 0; kt < 6; ++kt) C[kt] = (f32x4){0.f, 0.f, 0.f, 0.f};
        M2Small s0, s1, s2, s3;
        m2_load_small(s0, pkg0, nt, lane); m2_load_small(s1, pkg0 + MLP_BYTES, nt, lane); m2_load_small(s2, pkg0 + 2 * (size_t)MLP_BYTES, nt, lane); m2_load_small(s3, pkg0 + 3 * (size_t)MLP_BYTES, nt, lane);
#define M2_CHAIN(sx, c_) do { unsigned spins = 0; while (ready[(c_) & (M2_SLOTS - 1)] != (unsigned)((c_) + 1)) { if (++spins > (1u << 22)) break; __builtin_amdgcn_s_sleep(1); } asm volatile("" ::: "memory"); \
            m2_step(sx, lds + ((c_) & (M2_SLOTS - 1)) * M2_SLOT_BYTES, C, num, den, dir, b, hh, nt, (c_), lane, fr, qd); \
            asm volatile("s_waitcnt lgkmcnt(0)" ::: "memory"); if (lane == 0) consumed[nt] = (unsigned)((c_) + 1); asm volatile("" ::: "memory"); \
            if ((c_) + 4 < 32) m2_load_small(sx, pkg0 + (size_t)((c_) + 4) * MLP_BYTES, nt, lane); } while (0)
        for (int c = 0; c < 32; c += 4) { M2_CHAIN(s0, c); M2_CHAIN(s1, c + 1); M2_CHAIN(s2, c + 2); M2_CHAIN(s3, c + 3); }
#undef M2_CHAIN
    }
    __syncthreads();
}

constexpr int PKG_BYTES = 12544;
constexpr int PK_AH = 0, PK_RH = 2048, PK_KB = 4096, PK_VV = 8192, PK_TM = 10240, PK_MM = 10752, PK_LAK = 11776, PK_GE = 12288;
constexpr size_t WS_PKG = WS_PR;
static_assert((size_t)2 * NB * 6 * 128 * PKG_BYTES <= 288 * MiB, "package region");
constexpr int R1_W2T = 0, R1_A2T = 9216, R1_WV = 18432, R1_WV_BYTES = 12928;
constexpr int R1_IMG = 0, R1_LF = 9216, R1_MT = 10368;
static_assert(R1_WV + 8 * R1_WV_BYTES <= MISC_OFF, "rwkv r1 LDS");

DI bf16x4_t pack4(const f32x4 v) { union { unsigned u[2]; bf16x4_t h; } x; x.u[0] = cvtpk(v[0], v[1]); x.u[1] = cvtpk(v[2], v[3]); return x.h; }

DI void rwkv_r1_item(const Args& A, int l, LAS unsigned char* lds, int item, int& dh_staged, int tid, int wave, int lane) {
    const bf16* Z = (const bf16*)(A.ws + WS_Z);
    const int g = item & 15; int r0 = item >> 4; const int hh = r0 % 6; r0 /= 6; const int b = r0 % NB, dir = r0 / NB;
    const int cc = 8 * g + wave, fr = lane & 15, qd = lane >> 4;
    LAS bf16* W2T = (LAS bf16*)(lds + R1_W2T); LAS bf16* A2T = (LAS bf16*)(lds + R1_A2T);
    LAS unsigned char* wv = lds + R1_WV + wave * R1_WV_BYTES;
    LAS bf16* IMG = (LAS bf16*)(wv + R1_IMG); LAS float* Lf = (LAS float*)(wv + R1_LF); LAS bf16* MT = (LAS bf16*)(wv + R1_MT);
    if (dh_staged != dir * 6 + hh) { dh_staged = dir * 6 + hh;
    __syncthreads();
    { const int ch = tid & 63, i0 = (tid >> 6) * 8; const float* w2 = A.in[I_W2] + ((size_t)(l * 2 + dir) * 64 + i0) * RW + hh * 64 + ch; const float* a2 = A.in[I_A2] + ((size_t)(l * 2 + dir) * 64 + i0) * RW + hh * 64 + ch;
      u32x4_t pw, pa; pw.x = cvtpk(w2[0], w2[RW]); pw.y = cvtpk(w2[2 * RW], w2[3 * RW]); pw.z = cvtpk(w2[4 * RW], w2[5 * RW]); pw.w = cvtpk(w2[6 * RW], w2[7 * RW]);
      pa.x = cvtpk(a2[0], a2[RW]); pa.y = cvtpk(a2[2 * RW], a2[3 * RW]); pa.z = cvtpk(a2[4 * RW], a2[5 * RW]); pa.w = cvtpk(a2[6 * RW], a2[7 * RW]);
      *(LAS u32x4_t*)(W2T + ch * 72 + i0) = pw; *(LAS u32x4_t*)(A2T + ch * 72 + i0) = pa; }
    __syncthreads(); }
    const int sgn = dir ? -1 : 1; const int tok0 = b * SEQ + (dir ? SEQ - 1 - 16 * cc : 16 * cc);
    const float* mu = A.in[I_MU] + (size_t)(l * 2 + dir) * 1280;
    float er[4][4], ek[4][4], ev[4][4];
    { LAS bf16* stg = IMG; constexpr int SLD = 200;
      u32x4_t ld[7];
#pragma unroll
      for (int i = 0; i < 7; ++i) { const int idx = lane + 64 * i; const int ri = idx / 24, pc = idx % 24; const bool ok = (idx < 17 * 24) && (ri > 0 || cc > 0);
          ld[i] = (u32x4_t){0u, 0u, 0u, 0u};
          if (ok) ld[i] = *(const u32x4_t*)(Z + (size_t)(tok0 + sgn * (ri - 1)) * ZLD + ZRKV + (pc >> 3) * RW + hh * 64 + (pc & 7) * 8); }
#pragma unroll
      for (int i = 0; i < 7; ++i) { const int idx = lane + 64 * i; const int ri = idx / 24, pc = idx % 24; if (idx < 17 * 24) *(LAS u32x4_t*)(stg + ri * SLD + pc * 8) = ld[i]; }
      asm volatile("s_waitcnt lgkmcnt(0)" ::: "memory");
#pragma unroll
      for (int nt = 0; nt < 4; ++nt) { const LAS bf16* sp = stg + (4 * qd) * SLD + 16 * nt + fr;
          float qr = bf2f(sp[0]), qk = bf2f(sp[64]), qv = bf2f(sp[128]);
          const float mr = mu[hh * 64 + 16 * nt + fr], mk = mu[RW + hh * 64 + 16 * nt + fr], mv = mu[2 * RW + hh * 64 + 16 * nt + fr];
#pragma unroll
          for (int r = 0; r < 4; ++r) { const float cr = bf2f(sp[(r + 1) * SLD]), ck = bf2f(sp[(r + 1) * SLD + 64]), cv = bf2f(sp[(r + 1) * SLD + 128]);
              er[nt][r] = cr + mr * (qr - cr); ek[nt][r] = ck + mk * (qk - ck); ev[nt][r] = cv + mv * (qv - cv); qr = cr; qk = ck; qv = cv; } }
      asm volatile("s_waitcnt lgkmcnt(0)" ::: "memory"); }
    bf16x8_t thA[2], adA[2];
    { const int zwd = dir ? ZWDB : ZWDF, zad = dir ? ZADB : ZADF; const bool hasp = !(cc == 0 && fr == 0);
      const bf16* zc = Z + (size_t)(tok0 + sgn * fr) * ZLD; const bf16* zq = Z + (size_t)(tok0 + sgn * (fr - 1)) * ZLD;
#pragma unroll
      for (int ks = 0; ks < 2; ++ks) { float cw[8], pw[8], ca[8], pa[8];
          unpack8(*(const uint4*)(zc + zwd + 32 * ks + 8 * qd), cw); unpack8(*(const uint4*)(zc + zad + 32 * ks + 8 * qd), ca);
          if (hasp) { unpack8(*(const uint4*)(zq + zwd + 32 * ks + 8 * qd), pw); unpack8(*(const uint4*)(zq + zad + 32 * ks + 8 * qd), pa); }
          else {
#pragma unroll
              for (int e = 0; e < 8; ++e) { pw[e] = 0.f; pa[e] = 0.f; } }
          const float* muw = mu + 1152 + 32 * ks + 8 * qd; const float* mua = mu + 1216 + 32 * ks + 8 * qd;
#pragma unroll
          for (int e = 0; e < 8; ++e) { const float xw = cw[e] + muw[e] * (pw[e] - cw[e]); cw[e] = 1.f - 2.f * __builtin_amdgcn_rcpf(1.f + __expf(2.f * xw)); ca[e] = ca[e] + mua[e] * (pa[e] - ca[e]); }
          union { unsigned u[4]; bf16x8_t v; } x, y;
#pragma unroll
          for (int e = 0; e < 4; ++e) { x.u[e] = cvtpk(cw[2 * e], cw[2 * e + 1]); y.u[e] = cvtpk(ca[2 * e], ca[2 * e + 1]); }
          thA[ks] = x.v; adA[ks] = y.v; } }
    f32x4 wl[4], al[4];
#pragma unroll
    for (int nt = 0; nt < 4; ++nt) { wl[nt] = (f32x4){0.f, 0.f, 0.f, 0.f}; al[nt] = (f32x4){0.f, 0.f, 0.f, 0.f};
#pragma unroll
        for (int ks = 0; ks < 2; ++ks) { const bf16x8_t bw = *(const LAS bf16x8_t*)(W2T + (16 * nt + fr) * 72 + 32 * ks + 8 * qd); const bf16x8_t ba = *(const LAS bf16x8_t*)(A2T + (16 * nt + fr) * 72 + 32 * ks + 8 * qd);
            wl[nt] = MFMA16(thA[ks], bw, wl[nt]); al[nt] = MFMA16(adA[ks], ba, al[nt]); } }
    float lw[4][4], alp[4][4], kap[4][4]; float ssq[4] = {0.f, 0.f, 0.f, 0.f}, bsm[4] = {0.f, 0.f, 0.f, 0.f};
#pragma unroll
    for (int nt = 0; nt < 4; ++nt) { const int ch = hh * 64 + 16 * nt + fr;
        const float w0v = A.in[I_W0][(size_t)(l * 2 + dir) * RW + ch], a0v = A.in[I_A0][(size_t)(l * 2 + dir) * RW + ch], kkw = A.in[I_KK][(size_t)l * RW + ch], kaw = A.in[I_KA][(size_t)l * RW + ch], rkw = A.in[I_RK][(size_t)l * RW + ch];
#pragma unroll
        for (int r = 0; r < 4; ++r) { const float x = w0v + wl[nt][r];
            lw[nt][r] = -0.6065306597126334f * __builtin_amdgcn_rcpf(1.f + __expf(-x));
            const float a = __builtin_amdgcn_rcpf(1.f + __expf(-(a0v + al[nt][r]))); alp[nt][r] = a;
            const float k0 = ek[nt][r]; kap[nt][r] = k0 * kkw; ek[nt][r] = k0 * (1.f + (a - 1.f) * kaw);
            ssq[r] += kap[nt][r] * kap[nt][r]; bsm[r] += er[nt][r] * ek[nt][r] * rkw; } }
#pragma unroll
    for (int r = 0; r < 4; ++r) {
#pragma unroll
        for (int o = 1; o < 16; o <<= 1) { ssq[r] += __shfl_xor(ssq[r], o); bsm[r] += __shfl_xor(bsm[r], o); }
        ssq[r] = __builtin_amdgcn_rsqf(fmaxf(ssq[r], 1e-24f)); }
    { bf16* bon = (bf16*)(A.ws + WS_RKB);
#pragma unroll
      for (int nt = 0; nt < 4; ++nt)
#pragma unroll
          for (int r = 0; r < 4; ++r) { kap[nt][r] *= ssq[r]; MT[(4 * qd + r) * 72 + 16 * nt + fr] = (bf16)cvtpk(bsm[r] * ev[nt][r], 0.f); }
      asm volatile("s_waitcnt lgkmcnt(0)" ::: "memory");
      const int p = lane >> 2, c16 = (lane & 3) * 16; const LAS u32x4_t* sp = (const LAS u32x4_t*)(MT + p * 72 + c16); const u32x4_t w0 = sp[0], w1 = sp[1];
      bf16* dst = bon + ((size_t)dir * NT + tok0 + sgn * p) * RW + hh * 64 + c16;
      *(u32x4_t*)dst = w0; *(u32x4_t*)(dst + 8) = w1;
      asm volatile("s_waitcnt lgkmcnt(0)" ::: "memory"); }
    unsigned char* pkg = A.ws + WS_PKG + ((size_t)((dir * NB + b) * 6 + hh) * 128 + cc) * PKG_BYTES;
    float lend[4];
    u32x2_t btf[4], ktf[4];
#pragma unroll
    for (int nt = 0; nt < 4; ++nt) { float lam[4]; lam[0] = lw[nt][0]; lam[1] = lam[0] + lw[nt][1]; lam[2] = lam[1] + lw[nt][2]; lam[3] = lam[2] + lw[nt][3];
        const float t1 = __shfl(lam[3], lane - 16), t2 = __shfl(lam[3], lane - 32), t3 = __shfl(lam[3], lane - 48);
        const float off = (qd >= 1 ? t1 : 0.f) + (qd >= 2 ? t2 : 0.f) + (qd >= 3 ? t3 : 0.f);
#pragma unroll
        for (int r = 0; r < 4; ++r) lam[r] += off;
        lend[nt] = __shfl(lam[3], 48 + fr);
        float bt4[4], kt4[4];
        float epv[4];
#pragma unroll
        for (int r = 0; r < 4; ++r) epv[r] = __expf(lam[r]);
        float ep_prev = __shfl(epv[3], lane - 16); if (qd == 0) ep_prev = 1.f;
        const float eendall = __expf(lend[nt]);
#pragma unroll
        for (int r = 0; r < 4; ++r) { const float ep = epv[r], epm = r ? epv[r - 1] : ep_prev, einv = __builtin_amdgcn_rcpf(ep), eend = eendall * einv;
            const float bb = kap[nt][r] * alp[nt][r]; const int o = (4 * qd + r) * 72 + 16 * nt + fr;
            IMG[o] = (bf16)cvtpk(-kap[nt][r] * epm, 0.f); IMG[1152 + o] = (bf16)cvtpk(er[nt][r] * ep, 0.f); IMG[2304 + o] = (bf16)cvtpk(bb * einv, 0.f); IMG[3456 + o] = (bf16)cvtpk(ek[nt][r] * einv, 0.f);
            bt4[r] = bb * eend; kt4[r] = ek[nt][r] * eend; }
        btf[nt].x = cvtpk(bt4[0], bt4[1]); btf[nt].y = cvtpk(bt4[2], bt4[3]); ktf[nt].x = cvtpk(kt4[0], kt4[1]); ktf[nt].y = cvtpk(kt4[2], kt4[3]); }
    asm volatile("s_waitcnt lgkmcnt(0)" ::: "memory");
    f32x4 Lab = (f32x4){0.f, 0.f, 0.f, 0.f}, Lak = Lab, Mrb = Lab, Mrk = Lab;
#pragma unroll
    for (int ks = 0; ks < 2; ++ks) { const int o = fr * 72 + 32 * ks + 8 * qd;
        const bf16x8_t aA = *(const LAS bf16x8_t*)(IMG + o), aR = *(const LAS bf16x8_t*)(IMG + 1152 + o), bB = *(const LAS bf16x8_t*)(IMG + 2304 + o), bK = *(const LAS bf16x8_t*)(IMG + 3456 + o);
        Lab = MFMA16(aA, bB, Lab); Lak = MFMA16(aA, bK, Lak); Mrb = MFMA16(aR, bB, Mrb); Mrk = MFMA16(aR, bK, Mrk); }
#pragma unroll
    for (int r = 0; r < 4; ++r) { const int t = 4 * qd + r; if (!(fr < t)) { Lab[r] = 0.f; Lak[r] = 0.f; } if (!(fr <= t)) { Mrb[r] = 0.f; Mrk[r] = 0.f; } Lf[t * 17 + fr] = Lab[r]; }
    asm volatile("s_waitcnt lgkmcnt(0)" ::: "memory");
    float Tc[16];
#pragma unroll
    for (int t = 0; t < 16; ++t) { float acc = (t == fr) ? 1.f : 0.f;
#pragma unroll
        for (int s = 0; s < t; ++s) acc += Lf[t * 17 + s] * Tc[s];
        Tc[t] = acc; }
    f32x4 Tm;
#pragma unroll
    for (int r = 0; r < 4; ++r) Tm[r] = qd == 0 ? Tc[r] : (qd == 1 ? Tc[4 + r] : (qd == 2 ? Tc[8 + r] : Tc[12 + r]));
#pragma unroll
    for (int r = 0; r < 4; ++r) { const int o = (4 * qd + r) * 20 + fr; MT[o] = (bf16)cvtpk(Tm[r], 0.f); MT[320 + o] = (bf16)cvtpk(Mrb[r], 0.f); MT[640 + o] = (bf16)cvtpk(Lak[r], 0.f); MT[960 + o] = (bf16)cvtpk(Mrk[r], 0.f); }
    asm volatile("s_waitcnt lgkmcnt(0)" ::: "memory");
    { const int o = fr * 20 + 4 * qd;
      const u32x2_t mrb = *(const LAS u32x2_t*)(MT + 320 + o), mrk = *(const LAS u32x2_t*)(MT + 960 + o);
      *(u32x2_t*)(pkg + PK_TM + lane * 8) = *(const LAS u32x2_t*)(MT + o); *(u32x2_t*)(pkg + PK_LAK + lane * 8) = *(const LAS u32x2_t*)(MT + 640 + o);
      *(u32x4_t*)(pkg + PK_MM + lane * 16) = (u32x4_t){mrk.x, mrk.y, mrb.x, mrb.y}; }
#pragma unroll
    for (int ks = 0; ks < 2; ++ks) { const int o = fr * 72 + 32 * ks + 4 * qd;
        const u32x2_t alo = *(const LAS u32x2_t*)(IMG + o), ahi = *(const LAS u32x2_t*)(IMG + o + 16), rlo = *(const LAS u32x2_t*)(IMG + 1152 + o), rhi = *(const LAS u32x2_t*)(IMG + 1152 + o + 16);
        *(u32x4_t*)(pkg + PK_AH + ks * 1024 + lane * 16) = (u32x4_t){alo.x, alo.y, ahi.x, ahi.y}; *(u32x4_t*)(pkg + PK_RH + ks * 1024 + lane * 16) = (u32x4_t){rlo.x, rlo.y, rhi.x, rhi.y}; }
#pragma unroll
    for (int nt = 0; nt < 4; ++nt) { *(u32x4_t*)(pkg + PK_KB + nt * 1024 + lane * 16) = (u32x4_t){ktf[nt].x, ktf[nt].y, btf[nt].x, btf[nt].y};
        u32x2_t vf; vf.x = cvtpk(ev[nt][0], ev[nt][1]); vf.y = cvtpk(ev[nt][2], ev[nt][3]); *(u32x2_t*)(pkg + PK_VV + nt * 512 + lane * 8) = vf;
        if (qd == 0) ((float*)(pkg + PK_GE))[16 * nt + fr] = __expf(lend[nt]); }
    asm volatile("s_waitcnt lgkmcnt(0)" ::: "memory");
}
DI void phase_rwkv_r1(const Args& A, int l, LAS unsigned char* lds, int bid, int G, int tid, int wave, int lane) {
    constexpr int NIT = 2 * NB * 6 * 16; int dh_staged = -1;
    __syncthreads();
    for (int it = bid; it < NIT; it += G) rwkv_r1_item(A, l, lds, it, dh_staged, tid, wave, lane);
    __syncthreads();
}

struct RkOps { bf16x8_t ah[2], rh[2], kb[4], mm; bf16x4_t vv, tm, lak; f32x4 ge[4]; };
DI bf16x8_t widen4(const bf16x4_t a) { return __builtin_shufflevector(a, (bf16x4_t){0, 0, 0, 0}, 0, 1, 2, 3, 4, 5, 6, 7); }
DI void rk_step(const RkOps& c, f32x4 (&sT)[4], bf16* yb, int dir, int b, int hh, int vb, int cc, int fr, int qd) {
    const f32x4 zero4 = (f32x4){0.f, 0.f, 0.f, 0.f};
    union { unsigned u[4]; bf16x8_t v; } s0, s1;
    s0.u[0] = cvtpk(sT[0][0], sT[0][1]); s0.u[1] = cvtpk(sT[0][2], sT[0][3]); s0.u[2] = cvtpk(sT[1][0], sT[1][1]); s0.u[3] = cvtpk(sT[1][2], sT[1][3]);
    s1.u[0] = cvtpk(sT[2][0], sT[2][1]); s1.u[1] = cvtpk(sT[2][2], sT[2][3]); s1.u[2] = cvtpk(sT[3][0], sT[3][1]); s1.u[3] = cvtpk(sT[3][2], sT[3][3]);
    f32x4 ax = MFMA16(widen4(c.lak), widen4(c.vv), zero4); ax = MFMA16(c.ah[0], s0.v, ax); ax = MFMA16(c.ah[1], s1.v, ax);
    f32x4 ay = MFMA16(s0.v, c.rh[0], zero4); ay = MFMA16(s1.v, c.rh[1], ay);
    const f32x4 au = MFMA16(widen4(c.tm), widen4(pack4(ax)), zero4);
    const bf16x8_t vu = __builtin_shufflevector(c.vv, pack4(au), 0, 1, 2, 3, 4, 5, 6, 7);
    ay = MFMA16(vu, c.mm, ay);
#pragma unroll
    for (int kt = 0; kt < 4; ++kt) sT[kt] = MFMA16(c.kb[kt], vu, sT[kt] * c.ge[kt]);
    const int sgn = dir ? -1 : 1; const int tok0 = b * SEQ + (dir ? SEQ - 1 - 16 * cc : 16 * cc);
    { u32x2_t w; w.x = cvtpk(ay[0], ay[1]); w.y = cvtpk(ay[2], ay[3]); *(u32x2_t*)(yb + ((size_t)dir * NT + tok0 + sgn * fr) * RW + hh * 64 + 16 * vb + 4 * qd) = w; }
}
constexpr int R2_SLOTS = 8, R2_CTL = R2_SLOTS * PKG_BYTES;
static_assert(R2_CTL + 64 <= MISC_OFF, "rwkv r2 LDS");
DI void rk_load_lds(RkOps& o, const LAS unsigned char* pkg, int vb, int lane, int qd) {
#pragma unroll
    for (int ks = 0; ks < 2; ++ks) { o.ah[ks] = *(const LAS bf16x8_t*)(pkg + PK_AH + ks * 1024 + lane * 16); o.rh[ks] = *(const LAS bf16x8_t*)(pkg + PK_RH + ks * 1024 + lane * 16); }
#pragma unroll
    for (int kt = 0; kt < 4; ++kt) { o.kb[kt] = *(const LAS bf16x8_t*)(pkg + PK_KB + kt * 1024 + lane * 16); o.ge[kt] = *(const LAS f32x4*)(pkg + PK_GE + (16 * kt + 4 * qd) * 4); }
    o.mm = *(const LAS bf16x8_t*)(pkg + PK_MM + lane * 16);
    o.vv = *(const LAS bf16x4_t*)(pkg + PK_VV + vb * 512 + lane * 8); o.tm = *(const LAS bf16x4_t*)(pkg + PK_TM + lane * 8); o.lak = *(const LAS bf16x4_t*)(pkg + PK_LAK + lane * 8);
}
DI void rk_pkg_fetch(u32x4_t (&buf)[13], const unsigned char* pkg, int lane) {
#pragma unroll
    for (int i = 0; i < 12; ++i) buf[i] = *(const u32x4_t*)(pkg + i * 1024 + lane * 16);
    buf[12] = (lane < 16) ? *(const u32x4_t*)(pkg + 12288 + lane * 16) : (u32x4_t){0u, 0u, 0u, 0u};
}
DI void rwkv_r2_unit(const Args& A, LAS unsigned char* lds, int u, int tid, int wave, int lane) {
    bf16* yb = (bf16*)(A.ws + WS_RKY);
    const int dir = u / 48, rem = u % 48, b = rem / 6, hh = rem % 6; const int fr = lane & 15, qd = lane >> 4;
    const unsigned char* pkg0 = A.ws + WS_PKG + ((size_t)((dir * NB + b) * 6 + hh) * 128) * PKG_BYTES;
    volatile LAS unsigned* ready = (volatile LAS unsigned*)(lds + R2_CTL); volatile LAS unsigned* consumed = ready + 8;
    __syncthreads();
    if (tid < 16) ready[tid] = 0u;
    __syncthreads();
    if (wave >= 4) {
        const int j = wave - 4; u32x4_t cur[13], nxt[13];
        rk_pkg_fetch(cur, pkg0 + (size_t)j * PKG_BYTES, lane);
        for (int cc = j; cc < 128; cc += 4) {
            if (cc + 4 < 128) rk_pkg_fetch(nxt, pkg0 + (size_t)(cc + 4) * PKG_BYTES, lane);
            if (cc >= R2_SLOTS) { const unsigned need = (unsigned)(cc - R2_SLOTS + 1); unsigned spins = 0;
                for (;;) { const unsigned c0 = consumed[0], c1 = consumed[1], c2 = consumed[2], c3 = consumed[3];
                    if (c0 >= need && c1 >= need && c2 >= need && c3 >= need) break; if (++spins > (1u << 22)) break; __builtin_amdgcn_s_sleep(1); } }
            LAS unsigned char* slot = lds + (cc & (R2_SLOTS - 1)) * PKG_BYTES;
#pragma unroll
            for (int i = 0; i < 12; ++i) *(LAS u32x4_t*)(slot + i * 1024 + lane * 16) = cur[i];
            if (lane < 16) *(LAS u32x4_t*)(slot + 12288 + lane * 16) = cur[12];
            asm volatile("s_waitcnt lgkmcnt(0)" ::: "memory");
            if (lane == 0) ready[cc & (R2_SLOTS - 1)] = (unsigned)(cc + 1);
            asm volatile("" ::: "memory");
#pragma unroll
            for (int i = 0; i < 13; ++i) cur[i] = nxt[i];
        }
    } else {
        const int vb = wave; f32x4 sT[4];
#pragma unroll
        for (int kt = 0; kt < 4; ++kt) sT[kt] = (f32x4){0.f, 0.f, 0.f, 0.f};
#define RK_WAIT(cc_) do { unsigned spins = 0; while (ready[(cc_) & (R2_SLOTS - 1)] != (unsigned)((cc_) + 1)) { if (++spins > (1u << 22)) break; __builtin_amdgcn_s_sleep(1); } asm volatile("" ::: "memory"); } while (0)
        RkOps pa, pb;
        RK_WAIT(0); rk_load_lds(pa, lds, vb, lane, qd);
        for (int cc = 0; cc < 128; cc += 2) {
            RK_WAIT(cc + 1); rk_load_lds(pb, lds + ((cc + 1) & (R2_SLOTS - 1)) * PKG_BYTES, vb, lane, qd);
            rk_step(pa, sT, yb, dir, b, hh, vb, cc, fr, qd);
            asm volatile("s_waitcnt lgkmcnt(0)" ::: "memory"); if (lane == 0) consumed[vb] = (unsigned)(cc + 2); asm volatile("" ::: "memory");
            if (cc + 2 < 128) { RK_WAIT(cc + 2); rk_load_lds(pa, lds + ((cc + 2) & (R2_SLOTS - 1)) * PKG_BYTES, vb, lane, qd); }
            rk_step(pb, sT, yb, dir, b, hh, vb, cc + 1, fr, qd);
            if (cc + 2 < 128) { asm volatile("s_waitcnt lgkmcnt(0)" ::: "memory"); if (lane == 0) consumed[vb] = (unsigned)(cc + 3); asm volatile("" ::: "memory"); }
        }
#undef RK_WAIT
    }
    __syncthreads();
}


constexpr int YA_G2LD = 136;
static_assert(384 * YA_G2LD * 2 <= MISC_OFF, "yasm LDS");
DI void unpack4(const uint2 w, float (&f)[4]) { f[0] = __uint_as_float(w.x << 16); f[1] = __uint_as_float(w.x & 0xffff0000u); f[2] = __uint_as_float(w.y << 16); f[3] = __uint_as_float(w.y & 0xffff0000u); }
DI void yasm_token(const bf16* Z, const bf16* ao, const float* al, const bf16* num, const float* den, const f32x4 mgA, const f32x4 mgB, bf16* y, int tok, int lane) {
    const bf16* zr = Z + (size_t)tok * ZLD; bf16* yr = y + (size_t)tok * DM;
    const float lsev = al[((size_t)((lane >> 2) % 3) * NT + tok) * 4 + (lane & 3)];
    const float denv = den[((size_t)((lane >> 2) & 1) * NT + tok) * 4 + (lane & 3)];
    const bool lo32 = lane < 32; const int lb = lane & 31;
    uint2 av[3], nA[2], nB[2];
#pragma unroll
    for (int br = 0; br < 3; ++br) av[br] = *(const uint2*)(ao + ((size_t)br * NT + tok) * AW + 4 * lane);
#pragma unroll
    for (int d = 0; d < 2; ++d) { nA[d] = *(const uint2*)(num + ((size_t)d * NT + tok) * MW + 4 * lane); nB[d] = *(const uint2*)(num + ((size_t)d * NT + tok) * MW + 256 + 4 * lb); }
    const uint2 zA = *(const uint2*)(zr + ZMO + 4 * lane), zB = *(const uint2*)(zr + ZMO + 256 + 4 * lb);
    { const int hh = lane >> 4; const float l0 = __shfl(lsev, hh), l1 = __shfl(lsev, 4 + hh), l2 = __shfl(lsev, 8 + hh);
      const float mx = fmaxf(l0, fmaxf(l1, l2)); const float w0 = __expf(l0 - mx), w1 = __expf(l1 - mx), w2 = __expf(l2 - mx); const float inv = 1.f / (w0 + w1 + w2);
      float a0[4], a1[4], a2[4]; unpack4(av[0], a0); unpack4(av[1], a1); unpack4(av[2], a2);
      uint2 o; o.x = pkbf((w0 * a0[0] + w1 * a1[0] + w2 * a2[0]) * inv, (w0 * a0[1] + w1 * a1[1] + w2 * a2[1]) * inv); o.y = pkbf((w0 * a0[2] + w1 * a1[2] + w2 * a2[2]) * inv, (w0 * a0[3] + w1 * a1[3] + w2 * a2[3]) * inv);
      *(uint2*)(yr + 4 * lane) = o; }
    { const int hA = lane / 24, hB = lane < 8 ? 2 : 3;
      const float dfA = __shfl(denv, hA), dbA = __shfl(denv, 4 + hA), dfB = __shfl(denv, hB), dbB = __shfl(denv, 4 + hB);
      const float ifA = 1.f / fmaxf(fabsf(dfA), 1.f), ibA = 1.f / fmaxf(fabsf(dbA), 1.f), ifB = 1.f / fmaxf(fabsf(dfB), 1.f), ibB = 1.f / fmaxf(fabsf(dbB), 1.f);
      float f0[4], f1[4], a[4], b[4]; unpack4(nA[0], f0); unpack4(nA[1], f1);
#pragma unroll
      for (int i = 0; i < 4; ++i) a[i] = f0[i] * ifA + f1[i] * ibA;
      unpack4(nB[0], f0); unpack4(nB[1], f1);
#pragma unroll
      for (int i = 0; i < 4; ++i) b[i] = lo32 ? f0[i] * ifB + f1[i] * ibB : 0.f;
      const float sA = (a[0] + a[1]) + (a[2] + a[3]), qA = (a[0] * a[0] + a[1] * a[1]) + (a[2] * a[2] + a[3] * a[3]);
      const float sB = (b[0] + b[1]) + (b[2] + b[3]), qB = (b[0] * b[0] + b[1] * b[1]) + (b[2] * b[2] + b[3] * b[3]);
      float mA = 0.f, rA = 0.f, mB = 0.f, rB = 0.f;
#pragma unroll
      for (int h = 0; h < 4; ++h) { const float ps = (hA == h ? sA : 0.f) + ((lo32 && hB == h) ? sB : 0.f), pq = (hA == h ? qA : 0.f) + ((lo32 && hB == h) ? qB : 0.f);
          const float m = wave_sum(ps) * (1.f / 96.f); const float var = fmaxf(wave_sum(pq) * (1.f / 96.f) - m * m, 0.f); const float rs = rsqrtf(var + 1e-6f);
          if (hA == h) { mA = m; rA = rs; } if (hB == h) { mB = m; rB = rs; } }
      float g[4]; unpack4(zA, g);
      uint2 o; o.x = pkbf((a[0] - mA) * rA * mgA[0] * sigm(g[0]), (a[1] - mA) * rA * mgA[1] * sigm(g[1])); o.y = pkbf((a[2] - mA) * rA * mgA[2] * sigm(g[2]), (a[3] - mA) * rA * mgA[3] * sigm(g[3]));
      *(uint2*)(yr + AW + RW + 4 * lane) = o;
      unpack4(zB, g);
      o.x = pkbf((b[0] - mB) * rB * mgB[0] * sigm(g[0]), (b[1] - mB) * rB * mgB[1] * sigm(g[1])); o.y = pkbf((b[2] - mB) * rB * mgB[2] * sigm(g[2]), (b[3] - mB) * rB * mgB[3] * sigm(g[3]));
      if (lo32) *(uint2*)(yr + AW + RW + 256 + 4 * lane) = o; }
}
DI void phase_yasm(const Args& A, int l, LAS unsigned char* lds, int gw, int ngw, int tid, int lane) {
    const bf16* Z = (const bf16*)(A.ws + WS_Z); const bf16* ao = (const bf16*)(A.ws + WS_ATTO); const float* al = (const float*)(A.ws + WS_ATTL);
    const bf16* rky = (const bf16*)(A.ws + WS_RKY); const bf16* rkb = (const bf16*)(A.ws + WS_RKB);
    const bf16* num = (const bf16*)(A.ws + WS_MLNUM); const float* den = (const float*)(A.ws + WS_MLDEN); bf16* y = (bf16*)(A.ws + WS_HB);
    const float* lng = A.in[I_RLNG] + (size_t)l * RW; const float* lnb = A.in[I_RLNB] + (size_t)l * RW; const float* mlg = A.in[I_MLNG] + (size_t)l * MW;
    LAS bf16* G2T = (LAS bf16*)lds;
    __syncthreads();
    { const u32x4_t* src = (const u32x4_t*)(A.ws + WS_G2T + (size_t)l * RW * 128 * 2);
      for (int idx = tid; idx < RW * 16; idx += NTHR) { const int col = idx >> 4, ch = idx & 15; *(LAS u32x4_t*)(G2T + col * YA_G2LD + ch * 8) = src[idx]; } }
    __syncthreads();
    const int fr = lane & 15, qd = lane >> 4;
    for (int item = gw; item < (NT / 16) * 6; item += ngw) {
        const int hh = item % 6, tg = item / 6; const int tokA = tg * 16 + fr;
        const size_t o = (size_t)tokA * RW + hh * 64 + 16 * qd;
        const uint4 y0a = *(const uint4*)(rky + o), y0b = *(const uint4*)(rky + o + 8), y1a = *(const uint4*)(rky + (size_t)NT * RW + o), y1b = *(const uint4*)(rky + (size_t)NT * RW + o + 8);
        const uint4 b0a = *(const uint4*)(rkb + o), b0b = *(const uint4*)(rkb + o + 8), b1a = *(const uint4*)(rkb + (size_t)NT * RW + o), b1b = *(const uint4*)(rkb + (size_t)NT * RW + o + 8);
        f32x4 gacc[4];
#pragma unroll
        for (int nt = 0; nt < 4; ++nt) gacc[nt] = (f32x4){0.f, 0.f, 0.f, 0.f};
#pragma unroll
        for (int ks = 0; ks < 4; ++ks) { float f[8]; unpack8(*(const uint4*)(Z + (size_t)tokA * ZLD + ZGD + 32 * ks + 8 * qd), f);
            union { unsigned u[4]; bf16x8_t v; } a;
#pragma unroll
            for (int e = 0; e < 4; ++e) a.u[e] = cvtpk(sigm(f[2 * e]), sigm(f[2 * e + 1]));
#pragma unroll
            for (int nt = 0; nt < 4; ++nt) { const bf16x8_t bg = *(const LAS bf16x8_t*)(G2T + (hh * 64 + 16 * (fr >> 2) + 4 * nt + (fr & 3)) * YA_G2LD + 32 * ks + 8 * qd); gacc[nt] = MFMA16(bg, a.v, gacc[nt]); } }
        float sv[16], bv[16], t0[8], t1[8];
        unpack8(y0a, t0); unpack8(y1a, t1);
#pragma unroll
        for (int j = 0; j < 8; ++j) sv[j] = t0[j] + t1[j];
        unpack8(y0b, t0); unpack8(y1b, t1);
#pragma unroll
        for (int j = 0; j < 8; ++j) sv[8 + j] = t0[j] + t1[j];
        unpack8(b0a, t0); unpack8(b1a, t1);
#pragma unroll
        for (int j = 0; j < 8; ++j) bv[j] = t0[j] + t1[j];
        unpack8(b0b, t0); unpack8(b1b, t1);
#pragma unroll
        for (int j = 0; j < 8; ++j) bv[8 + j] = t0[j] + t1[j];
        float sm = 0.f;
#pragma unroll
        for (int j = 0; j < 16; ++j) sm += sv[j];
        sm += __shfl_xor(sm, 16); sm += __shfl_xor(sm, 32); sm *= (1.f / 64.f);
        float vr = 0.f;
#pragma unroll
        for (int j = 0; j < 16; ++j) { sv[j] -= sm; vr += sv[j] * sv[j]; }
        vr += __shfl_xor(vr, 16); vr += __shfl_xor(vr, 32); vr = rsqrtf(vr * (1.f / 64.f) + 64e-5f);
        const f32x4* lgp = (const f32x4*)(lng + hh * 64 + 16 * qd); const f32x4* lbp = (const f32x4*)(lnb + hh * 64 + 16 * qd);
        unsigned ow[8];
#pragma unroll
        for (int q = 0; q < 4; ++q) { const f32x4 lg_ = lgp[q], lb_ = lbp[q];
            ow[2 * q] = pkbf((sv[4 * q] * vr * lg_[0] + lb_[0] + bv[4 * q]) * gacc[q][0], (sv[4 * q + 1] * vr * lg_[1] + lb_[1] + bv[4 * q + 1]) * gacc[q][1]);
            ow[2 * q + 1] = pkbf((sv[4 * q + 2] * vr * lg_[2] + lb_[2] + bv[4 * q + 2]) * gacc[q][2], (sv[4 * q + 3] * vr * lg_[3] + lb_[3] + bv[4 * q + 3]) * gacc[q][3]); }
        bf16* yo = y + (size_t)tokA * DM + AW + hh * 64 + 16 * qd;
        *(uint4*)yo = make_uint4(ow[0], ow[1], ow[2], ow[3]); *(uint4*)(yo + 8) = make_uint4(ow[4], ow[5], ow[6], ow[7]);
    }
    const f32x4 mgA = *(const f32x4*)(mlg + 4 * lane), mgB = *(const f32x4*)(mlg + 256 + 4 * (lane & 31));
    for (int tok = gw; tok < NT; tok += 2 * ngw) { yasm_token(Z, ao, al, num, den, mgA, mgB, y, tok, lane); if (tok + ngw < NT) yasm_token(Z, ao, al, num, den, mgA, mgB, y, tok + ngw, lane); }
    __syncthreads();
}

constexpr int L2_WLD = 1032;
constexpr int L2_WHI = 0, L2_WLO = 16 * L2_WLD * 2, L2_G2 = 2 * L2_WLO, L2_EX = L2_G2 + DM * 4, L2_SS = L2_EX + 8 * 1024, L2_END = L2_SS + 8 * 16 * 4;
static_assert(L2_END <= MISC_OFF, "ln2 LDS");
DI void phase_ln2(const Args& A, int l, LAS unsigned char* lds, int bid, int G, int tid, int wave, int lane) {
    const bf16* x1 = (const bf16*)(A.ws + WS_X1); unsigned char* hb = A.ws + WS_HB; float* aff = (float*)(A.ws + WS_AFF);
    const float* router = A.in[I_ROUTER] + (size_t)l * DM * NE; const float* g2 = A.in[I_LN2G] + (size_t)l * DM;
    LAS bf16* Whi = (LAS bf16*)(lds + L2_WHI); LAS bf16* Wlo = (LAS bf16*)(lds + L2_WLO); LAS float* g2s = (LAS float*)(lds + L2_G2);
    LAS unsigned char* ex = lds + L2_EX; LAS float* ssx = (LAS float*)(lds + L2_SS);
    const int fr = lane & 15, qd = lane >> 4, tg = wave >> 1, kh = wave & 1;
    __syncthreads();
    for (int i = tid; i < DM * NE; i += NTHR) { const int e = i & 15, c = i >> 4; const float v = router[i] * g2[c]; const unsigned h = f2bf(v);
        Whi[e * L2_WLD + c] = (bf16)h; Wlo[e * L2_WLD + c] = (bf16)f2bf(v - bf2f(h)); }
    for (int i = tid; i < DM; i += NTHR) g2s[i] = g2[i];
    for (int grp = bid; grp < NT / 64; grp += G) {
        const int tokb = grp * 64 + tg * 16, tok = tokb + fr;
        const u32x4_t* xp = (const u32x4_t*)(x1 + (size_t)tok * DM + kh * 512 + 16 * qd);
        u32x4_t xa[8][2];
#pragma unroll
        for (int p = 0; p < 8; ++p) { xa[p][0] = xp[8 * p]; xa[p][1] = xp[8 * p + 1]; }
        __syncthreads();
        f32x4 acc = (f32x4){0.f, 0.f, 0.f, 0.f}; float ss = 0.f;
#pragma unroll
        for (int p = 0; p < 8; ++p)
#pragma unroll
            for (int hf = 0; hf < 2; ++hf) { const int c = kh * 512 + 64 * p + 16 * qd + 8 * hf;
                const bf16x8_t a = __builtin_bit_cast(bf16x8_t, xa[p][hf]);
                const bf16x8_t bh = *(const LAS bf16x8_t*)(Whi + fr * L2_WLD + c), bl = *(const LAS bf16x8_t*)(Wlo + fr * L2_WLD + c);
                acc = MFMA16(a, bh, acc); acc = MFMA16(a, bl, acc);
#pragma unroll
                for (int e = 0; e < 4; ++e) { const float lo = __uint_as_float(xa[p][hf][e] << 16), hi = __uint_as_float(xa[p][hf][e] & 0xffff0000u); ss += lo * lo + hi * hi; } }
        ss += __shfl_xor(ss, 16); ss += __shfl_xor(ss, 32);
        *(LAS f32x4*)(ex + wave * 1024 + lane * 16) = acc; if (qd == 0) ssx[wave * 16 + fr] = ss;
        __syncthreads();
        { const f32x4 oth = *(const LAS f32x4*)(ex + (wave ^ 1) * 1024 + lane * 16); acc += oth; ss += ssx[(wave ^ 1) * 16 + fr]; }
        const float rs = rsqrtf(ss * (1.f / DM) + RMS_EPS);
        unsigned char* hrow = hb + (size_t)tok * DM + kh * 512 + 16 * qd; const float rsc = rs * F8_HSC;
#pragma unroll
        for (int p = 0; p < 8; ++p) { const LAS f32x4* gp = (const LAS f32x4*)(g2s + kh * 512 + 64 * p + 16 * qd); u32x4_t o;
#pragma unroll
            for (int q = 0; q < 4; ++q) { const f32x4 g = gp[q]; const unsigned u0 = xa[p][q >> 1][2 * (q & 1)], u1 = xa[p][q >> 1][2 * (q & 1) + 1];
                o[q] = pk4_fp8(__uint_as_float(u0 << 16) * rsc * g[0], __uint_as_float(u0 & 0xffff0000u) * rsc * g[1], __uint_as_float(u1 << 16) * rsc * g[2], __uint_as_float(u1 & 0xffff0000u) * rsc * g[3]); }
            *(u32x4_t*)(hrow + 64 * p) = o; }
        if (kh == 0) { f32x4 af;
#pragma unroll
            for (int r = 0; r < 4; ++r) { const float lg = acc[r] * __shfl(rs, 4 * qd + r); float mx = lg;
#pragma unroll
                for (int o = 1; o < 16; o <<= 1) mx = fmaxf(mx, __shfl_xor(mx, o));
                const float ev = expf(lg - mx); float sm = ev;
#pragma unroll
                for (int o = 1; o < 16; o <<= 1) sm += __shfl_xor(sm, o);
                af[r] = ev / sm; }
            *(f32x4*)(aff + ((size_t)(tokb / SEQ) * NE + fr) * SEQ + (tokb % SEQ) + 4 * qd) = af; }
    }
    __syncthreads();
}

constexpr int PH_PER_LAYER = 10, NPH = 1 + NL * PH_PER_LAYER + 1;
#ifndef MK_ONE_LAUNCH
#define MK_ONE_LAUNCH 1
#endif

#ifndef MK_DUP
#define MK_DUP 0
#endif
constexpr int P0_END = NL * 16 * 64 + NL * 16 * 16 + NL * NE * 3 * 8 * 44, P0_SPLIT = P0_END - 0;
template <int l> DI void run_layer(const Args& A, LAS unsigned char* lds, const XcdBarrier& bar, int lo, int hi, int G, int bid, int tid, int lane, int wave, int gw, int ngw, int gtid, int nthr) {
#define IN(k) (lo <= (k) && (k) < hi)
#define SEAM(k) do { if (IN(k) && IN((k) + 1)) xcd_barrier(bar); } while (0)
#define PH(k, ...) do { if (IN(pb + (k))) { { __VA_ARGS__ } if ((MK_DUP >> (k)) & 1) { xcd_barrier(bar); { __VA_ARGS__ } } } SEAM(pb + (k)); } while (0)
    const int pb = 1 + l * PH_PER_LAYER;
    PH(0, phase_ln1(A, l, gw, ngw, lane););
    PH(1,
        pg8::Gemm g{(const bf16*)(A.ws + WS_HB), (const bf16*)(A.ws + WS_WTIN) + (size_t)l * ZLD * DM, NT, ZLD, DM};
        pg8::StaticOrder S; S.init(NT, ZLD, G, bid);
        pg8::EpiBf16<0> E{(bf16*)(A.ws + WS_Z), ZLD, nullptr, 0, 0, 1.f};
        pg8::gemm_phase<pg8::EpiBf16<0>, pg8::StaticOrder, true, true>(lds, g, S, E););
    PH(2, phase_attn(A, lds, 0, G > ATT_SCAN_BLK0 ? ATT_SPLIT : ATT_UNITS, bid, G, tid, wave, lane); phase_rwkv_r1(A, l, lds, bid, G, tid, wave, lane); if ((MK_DUP >> 13) & 1) phase_rwkv_r1(A, l, lds, bid, G, tid, wave, lane);
          phase_mlstm_m1(A, l, lds, bid, G, tid, wave, lane); if ((MK_DUP >> 16) & 1) phase_mlstm_m1(A, l, lds, bid, G, tid, wave, lane););
    PH(3, if (l == 0 && P0_SPLIT < P0_END) { const int nb = G > 160 ? G - 160 : G, b0 = G > 160 ? bid - 160 : bid; if (b0 >= 0) { __syncthreads(); phase_p0(A, lds, P0_SPLIT, P0_END, b0 * NWAVES + wave, nb * NWAVES, wave, lane); __syncthreads(); } }
          if (G > ATT_SCAN_BLK0 && bid >= ATT_SCAN_BLK0) phase_attn(A, lds, ATT_SPLIT, ATT_UNITS, bid - ATT_SCAN_BLK0, G - ATT_SCAN_BLK0, tid, wave, lane);
          for (int rep = 0; rep < 1 + ((MK_DUP >> 14) & 1); ++rep) for (int u = bid; u < 96; u += G) rwkv_r2_unit(A, lds, u, tid, wave, lane);
          for (int rep = 0; rep < 1 + ((MK_DUP >> 15) & 1); ++rep) for (int u = bid; u < 96 + 64; u += G) { if (u >= 96) mlstm_m2_unit(A, lds, u - 96, tid, wave, lane); });
    PH(4, phase_yasm(A, l, lds, gw, ngw, tid, lane););
    PH(5,
        pg8::Gemm g{(const bf16*)(A.ws + WS_HB), (const bf16*)(A.ws + WS_WTOUT) + (size_t)l * DM * DM, NT, DM, DM};
        pg8::StaticOrder S; S.init(NT, DM, G, bid);
        EpiResT<(l > 0)> E{(l == 0) ? (const void*)A.in[I_X] : (const void*)(A.ws + WS_X2), (bf16*)(A.ws + WS_X1), DM};
        pg8::gemm_phase<EpiResT<(l > 0)>, pg8::StaticOrder, true, true>(lds, g, S, E););
    PH(6, phase_ln2(A, l, lds, bid, G, tid, wave, lane););
    PH(7, phase_topk(A, lds, bid, G, tid, wave, lane););
    PH(8,
        pg8::Gemm g{(const bf16*)(A.ws + WS_XG), (const bf16*)(A.ws + WS_W13T + (size_t)l * NE * 5632 * DM), NSLOT, NE * 5632, DM / 2};
        GroupOrder S; S.init(22, G, bid);
        EpiSwiGLU E{A.ws + WS_ACT, 22};
        pg8::gemm_phase<EpiSwiGLU, GroupOrder, true, true, true>(lds, g, S, E););
    PH(9,
        pg8::Gemm g{(const bf16*)(A.ws + WS_ACT), (const bf16*)(A.ws + WS_W2T + (size_t)l * NE * DM * FF), NSLOT, NE * DM, FF / 2};
        GroupOrder S; S.init(4, G, bid);
        EpiGate E{(bf16*)(A.ws + WS_YS), (const float*)(A.ws + WS_GATE)};
        pg8::gemm_phase<EpiGate, GroupOrder, true, true, true>(lds, g, S, E););
#undef PH
#undef IN
#undef SEAM
}

__global__ void __launch_bounds__(NTHR, 2) mk_fwd(Args A) {
    extern __shared__ __attribute__((aligned(16))) unsigned char lds_raw[];
    LAS unsigned char* lds = (LAS unsigned char*)lds_raw;
    const int tid = threadIdx.x, lane = tid & 63, wave = __builtin_amdgcn_readfirstlane(tid >> 6);
    const int G = gridDim.x, bid = blockIdx.x;
    const int gw = bid * NWAVES + wave, ngw = G * NWAVES, gtid = bid * NTHR + tid, nthr = G * NTHR;
    volatile LAS unsigned* MISC = (volatile LAS unsigned*)(lds + MISC_OFF);
    if (tid < 64) MISC[tid] = 0u;
    __syncthreads();
    const int lo = A.ph_lo, hi = A.ph_hi;
    const bool use_bar = (hi - lo) > 1;
    XcdBarrier bar; bar.bar = (unsigned*)(A.ws + WS_CTL) + CW_BAR; bar.x = 0; bar.st = MISC + 8;
    if (use_bar) bar = xcd_barrier_post((unsigned*)(A.ws + WS_CTL) + CW_BAR, MISC + 8);
#define IN(k) (lo <= (k) && (k) < hi)
#define SEAM(k) do { if (IN(k) && IN((k) + 1)) xcd_barrier(bar); } while (0)

    if (IN(0)) { phase_p0(A, lds, 0, P0_SPLIT, gw, ngw, wave, lane); if ((MK_DUP >> 10) & 1) { xcd_barrier(bar); phase_p0(A, lds, 0, P0_SPLIT, gw, ngw, wave, lane); } } SEAM(0);

    run_layer<0>(A, lds, bar, lo, hi, G, bid, tid, lane, wave, gw, ngw, gtid, nthr);
    run_layer<1>(A, lds, bar, lo, hi, G, bid, tid, lane, wave, gw, ngw, gtid, nthr);
    if (IN(NPH - 1)) { phase_final(A, gw, ngw, lane); if ((MK_DUP >> 11) & 1) { xcd_barrier(bar); phase_final(A, gw, ngw, lane); } }
#undef IN
#undef SEAM
}
}

extern "C" void kernel_launch(void* const* d_in, const int* in_sizes, int n_in, void* d_out, int out_size, void* d_ws, size_t ws_size, hipStream_t stream) {
    using namespace mk;
    static int grid = 0;
    if (grid == 0) {
        if (n_in != N_IN || out_size != NT * DM || ws_size < WS_END) { fprintf(stderr, "kernel_launch: unexpected shapes (n_in %d, out %d, ws %zu < %zu)\n", n_in, out_size, ws_size, (size_t)WS_END); grid = -1; return; }
        int dev = 0, cus = 0, per_cu = 0;
        if (hipGetDevice(&dev) != hipSuccess || hipDeviceGetAttribute(&cus, hipDeviceAttributeMultiprocessorCount, dev) != hipSuccess) { grid = -1; return; }
        if (hipFuncSetAttribute((const void*)mk_fwd, hipFuncAttributeMaxDynamicSharedMemorySize, LDS_BYTES) != hipSuccess) { fprintf(stderr, "kernel_launch: hipFuncSetAttribute failed\n"); grid = -1; return; }
        if (hipOccupancyMaxActiveBlocksPerMultiprocessor(&per_cu, (const void*)mk_fwd, NTHR, LDS_BYTES) != hipSuccess || per_cu < 1) fprintf(stderr, "kernel_launch: occupancy query reports %d\n", per_cu);
        (void)hipGetLastError();
        grid = cus;
    }
    if (grid < 0) return;
    hipMemsetAsync((char*)d_ws + WS_CTL, 0, CTL_ZERO_BYTES, stream);
    Args a{};
    for (int i = 0; i < N_IN; ++i) a.in[i] = (const float*)d_in[i];
    a.out = (float*)d_out; a.ws = (unsigned char*)d_ws;
#if MK_ONE_LAUNCH
    a.ph_lo = 0; a.ph_hi = NPH;
    hipLaunchKernelGGL(mk_fwd, dim3(grid), dim3(NTHR), LDS_BYTES, stream, a);
#else
    for (int p = 0; p < NPH; ++p) { a.ph_lo = p; a.ph_hi = p + 1; hipLaunchKernelGGL(mk_fwd, dim3(grid), dim3(NTHR), LDS_BYTES, stream, a); }
#endif
}
```

```cpp
#include <hip/hip_runtime.h>
#include <cstdio>
#include <cstdint>
namespace pg8 {
#define PG8_LAS __attribute__((address_space(3)))
typedef unsigned short bf16_t;
typedef short bf16x8 __attribute__((ext_vector_type(8)));
typedef float f32x4 __attribute__((ext_vector_type(4)));
typedef unsigned u32x4 __attribute__((ext_vector_type(4)));
constexpr int BM = 256, BK = 64, HALF = 128, HTB = HALF * BK * 2  , STAGE_BYTES = 8 * HTB, NXCD = 8, WGM = 8;

__host__ __device__ __forceinline__ int lds_byte(int r, int c) { const int st = (r >> 4) * 2 + (c >> 5), rr = r & 15, cc = c & 31, ob = rr * 64 + cc * 2; return st * 1024 + (ob ^ (((ob >> 9) & 1) << 5)); }
__host__ __device__ __forceinline__ void stage_rc(int b, int& R, int& C) { const int st = b / 1024, sb = b % 1024, swz = sb ^ (((sb >> 9) & 1) << 5); R = (st >> 1) * 16 + swz / 64; C = (st & 1) * 32 + (swz % 64) / 2; }
__host__ __device__ __forceinline__ int perm32(int rho) { const int n = rho >> 4, i = rho & 15; return 8 * (i >> 2) + 4 * n + (i & 3); }

struct Unit { int pm, pn; };
struct Gemm { const bf16_t* A; const bf16_t* Bt; int M, N, K; };

struct StaticOrder {
    int nM, nN, nwg, G, c;
    __host__ __device__ void init(int M, int N, int G_, int c_) { nM = M / BM; nN = N / BM; nwg = nM * nN; G = G_; c = c_; }
    __host__ __device__ bool next(int i, Unit& u) const {
        const long L = (long)i * G + c; if (L >= nwg) return false;
        int wgid = (int)L; { const int q = nwg / NXCD, r = nwg % NXCD, xcd = wgid % NXCD, off = wgid / NXCD; wgid = (xcd < r ? xcd * (q + 1) : r * (q + 1) + (xcd - r) * q) + off; }
        const int nig = WGM * nN, gid = wgid / nig, fm = gid * WGM, gsz = (nM - fm) < WGM ? (nM - fm) : WGM;
        u.pm = fm + ((wgid % nig) % gsz); u.pn = (wgid % nig) / gsz; return true;
    }
    __device__ __forceinline__ void a_ready(const Unit&) const {}
    __device__ __forceinline__ void done(const Unit&) const {}
};

__device__ __forceinline__ unsigned cvt_pk_bf16(float lo, float hi) { unsigned r; asm volatile("v_cvt_pk_bf16_f32 %0, %1, %2" : "=v"(r) : "v"(lo), "v"(hi)); return r; }
typedef float f32x2 __attribute__((ext_vector_type(2)));
__device__ __forceinline__ f32x2 gelu_pk(f32x2 v) {
    const f32x2 av = __builtin_elementwise_abs(v), d = av * 0.2316418882f + 1.0f;
    f32x2 t; t.x = __builtin_amdgcn_rcpf(d.x); t.y = __builtin_amdgcn_rcpf(d.y);
    f32x2 q = t * 0.5307027145f + (-0.7265760135f); q = q * t + 0.7107068705f; q = q * t + (-0.142248368f); q = q * t + 0.127414796f; q = q * t;
    const f32x2 s = (v * v) * (-0.72134752044f);
    f32x2 e; e.x = __builtin_amdgcn_exp2f(s.x); e.y = __builtin_amdgcn_exp2f(s.y);
    const f32x2 m = v * (q * e), r = v - m;
    f32x2 o; o.x = v.x < 0.f ? m.x : r.x; o.y = v.y < 0.f ? m.y : r.y; return o;
}

template <int ACT  > struct EpiBf16 {
    static constexpr bool PERM = true, AFTER_DRAIN = false; static_assert(ACT == 0 || ACT == 1, "EpiBf16: ACT is 0 (none) or 1 (gelu_pk)");
    bf16_t* O; int ldc; const float* bias; int split_cols; size_t split_stride; float scale0;
    __device__ __forceinline__ void operator()(const f32x4 (&acc)[2][2][4][2], const Unit& u, int wr, int wc, int fr, int fq) const {
        const int row0 = u.pm * BM + wr * 64 + fr; int colt = u.pn * BM; bf16_t* base = O;
        float sc = 1.f; if (split_cols) { const int t = colt / split_cols; base += (size_t)t * split_stride; colt -= t * split_cols; if (t == 0) sc = scale0; }
        const int col0 = colt + wc * 32 + 8 * fq, bcol0 = u.pn * BM + wc * 32 + 8 * fq;
        f32x4 bv[2][2];
#pragma unroll
        for (int bj = 0; bj < 2; ++bj)
#pragma unroll
            for (int n = 0; n < 2; ++n) bv[bj][n] = bias ? *(const f32x4*)(bias + bcol0 + bj * HALF + 4 * n) : (f32x4){0.f, 0.f, 0.f, 0.f};
#pragma unroll
        for (int ai = 0; ai < 2; ++ai)
#pragma unroll
            for (int m = 0; m < 4; ++m) { bf16_t* rowp = base + (size_t)(row0 + ai * HALF + m * 16) * ldc + col0;
#pragma unroll
                for (int bj = 0; bj < 2; ++bj) { f32x4 v0 = acc[ai][bj][m][0] + bv[bj][0], v1 = acc[ai][bj][m][1] + bv[bj][1];
                    if (ACT == 1) { f32x2 a = gelu_pk((f32x2){v0[0], v0[1]}), b = gelu_pk((f32x2){v0[2], v0[3]}), c = gelu_pk((f32x2){v1[0], v1[1]}), d = gelu_pk((f32x2){v1[2], v1[3]});
                        v0 = (f32x4){a.x, a.y, b.x, b.y}; v1 = (f32x4){c.x, c.y, d.x, d.y}; }
                    v0 = v0 * sc; v1 = v1 * sc; u32x4 w; w.x = cvt_pk_bf16(v0[0], v0[1]); w.y = cvt_pk_bf16(v0[2], v0[3]); w.z = cvt_pk_bf16(v1[0], v1[1]); w.w = cvt_pk_bf16(v1[2], v1[3]);
                    *(u32x4*)(rowp + bj * HALF) = w; } }
    }
};
template <class Epi, class Sched, bool ALIGN_EPI = false, bool SP2 = false, bool F8 = false>
__device__ __forceinline__ void gemm_phase(PG8_LAS unsigned char* lds, const Gemm g, const Sched& S, const Epi& E) {
    const int tid = threadIdx.x, wid = __builtin_amdgcn_readfirstlane(tid >> 6), lane = tid & 63, wr = wid >> 2, wc = wid & 3, fr = lane & 15, fq = lane >> 4;
    int Kq = g.K; if constexpr (F8) asm volatile("" : "+s"(Kq));
    const int K = Kq, nt = K / BK;
    unsigned voffA[2], voffB[2];
#pragma unroll
    for (int i = 0; i < 2; ++i) { int R, C; stage_rc(tid * 16 + i * 8192, R, C); const int Rb = Epi::PERM ? ((R & ~31) + perm32(R & 31)) : R;
        voffA[i] = (unsigned)(R * K + C) * 2u; voffB[i] = (unsigned)(Rb * K + C) * 2u; }
    const size_t kstep = (size_t)(BK * 2);
    const size_t hstep = (size_t)HALF * K * 2;
    const size_t tstep = 2 * hstep;
    const unsigned ldsw = (unsigned)wid * 1024u;
    const int aoff = lds_byte(wr * 64 + fr, fq * 8), boff = lds_byte(wc * 32 + fr, fq * 8);
#define PG8_SA(b, h) (((b) * 2 + (h)) * HTB)
#define PG8_SB(b, h) ((4 + (b) * 2 + (h)) * HTB)
#define PG8_STAGE(bufoff, gbase, voff) do { _Pragma("unroll") for (int _i = 0; _i < 2; ++_i) \
        __builtin_amdgcn_global_load_lds((const unsigned*)((const char*)(gbase) + (voff)[_i]), (PG8_LAS unsigned*)(lds + (bufoff) + ldsw + _i * 8192), 16, 0, 0); } while (0)
#define PG8_LDA(dst, b, h) do { _Pragma("unroll") for (int m = 0; m < 4; ++m) { if constexpr (F8) { const i32x4_ lo_ = *(const PG8_LAS i32x4_*)(lds + PG8_SA(b, h) + aoff + m * 2048), hi_ = *(const PG8_LAS i32x4_*)(lds + PG8_SA(b, h) + aoff + m * 2048 + 1024); dst##8[m] = __builtin_shufflevector(lo_, hi_, 0, 1, 2, 3, 4, 5, 6, 7); } \
        else { _Pragma("unroll") for (int k = 0; k < 2; ++k) dst[m][k] = *(const PG8_LAS bf16x8*)(lds + PG8_SA(b, h) + aoff + m * 2048 + k * 1024); } } } while (0)
#define PG8_LDB(dst, b, h) do { _Pragma("unroll") for (int n = 0; n < 2; ++n) { if constexpr (F8) { const i32x4_ lo_ = *(const PG8_LAS i32x4_*)(lds + PG8_SB(b, h) + boff + n * 2048), hi_ = *(const PG8_LAS i32x4_*)(lds + PG8_SB(b, h) + boff + n * 2048 + 1024); dst##8[n] = __builtin_shufflevector(lo_, hi_, 0, 1, 2, 3, 4, 5, 6, 7); } \
        else { _Pragma("unroll") for (int k = 0; k < 2; ++k) dst[n][k] = *(const PG8_LAS bf16x8*)(lds + PG8_SB(b, h) + boff + n * 2048 + k * 1024); } } } while (0)
#define PG8_MMA(ai, bj, At, Bt) do { __builtin_amdgcn_s_setprio(1); _Pragma("unroll") for (int m = 0; m < 4; ++m) _Pragma("unroll") for (int n = 0; n < 2; ++n) { \
        if constexpr (F8) asm volatile("v_mfma_scale_f32_16x16x128_f8f6f4 %0, %1, %2, %0, %3, %3 op_sel_hi:[0,0,0]" : "+v"(acc[ai][bj][m][n]) : "v"(Bt##8[n]), "v"(At##8[m]), "v"(f8scale)); \
        else { _Pragma("unroll") for (int k = 0; k < 2; ++k) acc[ai][bj][m][n] = __builtin_amdgcn_mfma_f32_16x16x32_bf16(Bt[n][k], At[m][k], acc[ai][bj][m][n], 0, 0, 0); } } \
        __builtin_amdgcn_s_setprio(0); } while (0)
#define PG8_WAIT_V(n) asm volatile("s_waitcnt vmcnt(" #n ")" ::: "memory")
#define PG8_WAIT_L(n) asm volatile("s_waitcnt lgkmcnt(" #n ")" ::: "memory")
#define PG8_BAR __builtin_amdgcn_s_barrier()
#define PG8_SCHED __builtin_amdgcn_sched_barrier(0)
    Unit cur, nxt; int ui = 0;
    if (!S.next(0, cur)) return;
    f32x4 acc[2][2][4][2];
#pragma unroll
    for (int a = 0; a < 2; ++a)
#pragma unroll
        for (int b = 0; b < 2; ++b)
#pragma unroll
            for (int m = 0; m < 4; ++m)
#pragma unroll
                for (int n = 0; n < 2; ++n) { acc[a][b][m][n] = (f32x4){0.f, 0.f, 0.f, 0.f}; if constexpr (F8) asm volatile("" : "+v"(acc[a][b][m][n])); }
    bf16x8 At[4][2], B0[2][2], B1[2][2];
    typedef int i32x4_ __attribute__((ext_vector_type(4))); typedef int i32x8_ __attribute__((ext_vector_type(8)));
    i32x8_ At8[4], B08[2], B18[2];
    int f8scale = 0x7f7f7f7f; asm volatile("" : "+v"(f8scale));
    const char* cA = (const char*)g.A + (size_t)cur.pm * tstep; const char* cB = (const char*)g.Bt + (size_t)cur.pn * tstep;
    S.a_ready(cur);
    if constexpr (SP2) {
        PG8_STAGE(PG8_SB(0, 0), cB, voffB); PG8_STAGE(PG8_SB(0, 1), cB + hstep, voffB); PG8_STAGE(PG8_SA(0, 0), cA, voffA); PG8_STAGE(PG8_SA(0, 1), cA + hstep, voffA);
        if (wr == 1) PG8_BAR;
        PG8_WAIT_V(2); PG8_BAR;
        PG8_STAGE(PG8_SB(1, 0), cB + kstep, voffB); PG8_STAGE(PG8_SA(1, 0), cA + kstep, voffA); PG8_STAGE(PG8_SB(1, 1), cB + hstep + kstep, voffB);
        PG8_WAIT_V(6); PG8_BAR;
    } else {
        PG8_STAGE(PG8_SB(0, 0), cB, voffB); PG8_STAGE(PG8_SA(0, 0), cA, voffA); PG8_STAGE(PG8_SB(0, 1), cB + hstep, voffB); PG8_STAGE(PG8_SA(0, 1), cA + hstep, voffA);
        if (wr == 1) PG8_BAR;
        PG8_WAIT_V(4); PG8_BAR;
        PG8_STAGE(PG8_SB(1, 0), cB + kstep, voffB); PG8_STAGE(PG8_SA(1, 0), cA + kstep, voffA); PG8_STAGE(PG8_SB(1, 1), cB + hstep + kstep, voffB);
        PG8_WAIT_V(6); PG8_BAR;
    }
    for (;;) {
        const bool has_next = S.next(ui + 1, nxt);
        const char* nA = has_next ? (const char*)g.A + (size_t)nxt.pm * tstep : cA; const char* nB = has_next ? (const char*)g.Bt + (size_t)nxt.pn * tstep : cB;
        for (int t = 0; t < nt; t += 2) {
            const bool last = (t == nt - 2);
            const char* a1 = cA + (size_t)(t + 1) * kstep;
            const char* a2 = last ? nA : cA + (size_t)(t + 2) * kstep; const char* b2 = last ? nB : cB + (size_t)(t + 2) * kstep;
            const char* a3 = a2 + kstep; const char* b3 = b2 + kstep;
            if (last && has_next) S.a_ready(nxt);
            if constexpr (SP2) {
            PG8_LDB(B0, 0, 0); PG8_LDB(B1, 0, 1); PG8_SCHED; PG8_LDA(At, 0, 0); PG8_STAGE(PG8_SA(1, 1), a1 + hstep, voffA);
            PG8_WAIT_V(8); PG8_WAIT_L(0); PG8_BAR; PG8_MMA(0, 0, At, B0); PG8_MMA(0, 1, At, B1); PG8_BAR; PG8_SCHED;
            PG8_LDA(At, 0, 1); PG8_STAGE(PG8_SB(0, 0), b2, voffB); PG8_STAGE(PG8_SB(0, 1), b2 + hstep, voffB); PG8_STAGE(PG8_SA(0, 0), a2, voffA);
            PG8_WAIT_V(8); PG8_WAIT_L(0); PG8_BAR; PG8_MMA(1, 0, At, B0); PG8_MMA(1, 1, At, B1); PG8_BAR; PG8_SCHED;
            PG8_LDB(B0, 1, 0); PG8_LDB(B1, 1, 1); PG8_SCHED; PG8_LDA(At, 1, 0); PG8_STAGE(PG8_SA(0, 1), a2 + hstep, voffA);
            PG8_WAIT_V(8); PG8_WAIT_L(0); PG8_BAR; PG8_MMA(0, 0, At, B0); PG8_MMA(0, 1, At, B1); PG8_BAR; PG8_SCHED;
            PG8_LDA(At, 1, 1); PG8_STAGE(PG8_SB(1, 0), b3, voffB); PG8_STAGE(PG8_SB(1, 1), b3 + hstep, voffB); PG8_STAGE(PG8_SA(1, 0), a3, voffA);
            PG8_WAIT_V(8); PG8_WAIT_L(0); PG8_BAR; PG8_MMA(1, 0, At, B0); PG8_MMA(1, 1, At, B1); PG8_BAR; PG8_SCHED;
            } else {
            PG8_LDB(B0, 0, 0); PG8_SCHED; PG8_LDA(At, 0, 0); PG8_STAGE(PG8_SA(1, 1), a1 + hstep, voffA);
            PG8_WAIT_L(8); PG8_BAR; PG8_WAIT_L(0); PG8_MMA(0, 0, At, B0); PG8_BAR; PG8_SCHED;
            PG8_LDB(B1, 0, 1); PG8_STAGE(PG8_SB(0, 0), b2, voffB);
            PG8_BAR; PG8_WAIT_L(0); PG8_MMA(0, 1, At, B1); PG8_BAR;
            PG8_LDA(At, 0, 1); PG8_STAGE(PG8_SA(0, 0), a2, voffA);
            PG8_BAR; PG8_WAIT_L(0); PG8_MMA(1, 0, At, B0); PG8_BAR; PG8_SCHED;
            PG8_STAGE(PG8_SB(0, 1), b2 + hstep, voffB);
            PG8_WAIT_V(6); PG8_BAR; PG8_MMA(1, 1, At, B1); PG8_BAR;
            PG8_LDB(B0, 1, 0); PG8_SCHED; PG8_LDA(At, 1, 0); PG8_STAGE(PG8_SA(0, 1), a2 + hstep, voffA);
            PG8_WAIT_L(8); PG8_BAR; PG8_WAIT_L(0); PG8_MMA(0, 0, At, B0); PG8_BAR; PG8_SCHED;
            PG8_LDB(B1, 1, 1); PG8_STAGE(PG8_SB(1, 0), b3, voffB);
            PG8_BAR; PG8_WAIT_L(0); PG8_MMA(0, 1, At, B1); PG8_BAR;
            PG8_LDA(At, 1, 1); PG8_STAGE(PG8_SA(1, 0), a3, voffA);
            PG8_BAR; PG8_WAIT_L(0); PG8_MMA(1, 0, At, B0); PG8_BAR; PG8_SCHED;
            PG8_STAGE(PG8_SB(1, 1), b3 + hstep, voffB);
            PG8_WAIT_V(6); PG8_BAR; PG8_MMA(1, 1, At, B1); PG8_BAR;
            }
        }
        if constexpr (F8) asm volatile("s_nop 15\n\ts_nop 15" ::: "memory");
        if constexpr (ALIGN_EPI) { if (wr == 0) PG8_BAR; }
        if constexpr (!Epi::AFTER_DRAIN) { E(acc, cur, wr, wc, fr, fq); S.done(cur); }
        if (!has_next) break;
#pragma unroll
        for (int a = 0; a < 2; ++a)
#pragma unroll
            for (int b = 0; b < 2; ++b)
#pragma unroll
                for (int m = 0; m < 4; ++m)
#pragma unroll
                    for (int n = 0; n < 2; ++n) { acc[a][b][m][n] = (f32x4){0.f, 0.f, 0.f, 0.f}; if constexpr (F8) asm volatile("" : "+v"(acc[a][b][m][n])); }
        cur = nxt; cA = nA; cB = nB; ++ui;
        if constexpr (ALIGN_EPI) { if (wr == 1) PG8_BAR; }
    }
    PG8_WAIT_V(0);
    if constexpr (!ALIGN_EPI) { if (wr == 0) PG8_BAR; }
    PG8_BAR;
    if constexpr (Epi::AFTER_DRAIN) { E.fused(acc, cur, wr, wc, fr, fq, lds, wid, lane); S.done(cur); }
#undef PG8_SA
#undef PG8_SB
#undef PG8_STAGE
#undef PG8_LDA
#undef PG8_LDB
#undef PG8_MMA
#undef PG8_WAIT_V
#undef PG8_WAIT_L
#undef PG8_BAR
#undef PG8_SCHED
}
}
#define LAS __attribute__((address_space(3)))
#define XB_TMO      128
#define XB_XCNT(j)  (256  + 64 * (j))
#define XB_XSUB(j)  (1280 + 64 * (j))
#define XB_XGEN(j)  (2304 + 64 * (j))
#define XB_TOP      3328
#define XB_TOPGEN   3392
#define XCD_BAR_WORDS 3456
#define XB_SPIN_CAP (1u << 18)

__device__ __forceinline__ unsigned xb_ld(unsigned* p)              { return __hip_atomic_load(p, __ATOMIC_RELAXED, __HIP_MEMORY_SCOPE_AGENT); }
__device__ __forceinline__ unsigned xb_add(unsigned* p, unsigned v) { return __hip_atomic_fetch_add(p, v, __ATOMIC_RELAXED, __HIP_MEMORY_SCOPE_AGENT); }
__device__ __forceinline__ unsigned xb_xcc_id() { return (unsigned)__builtin_amdgcn_s_getreg((3 << 11) | 20) & 0xFu; }
#define XB_SPIN(cond, bar) do { unsigned _sp = 0; while (cond) { __builtin_amdgcn_s_sleep(1); \
    if ((++_sp & 255u) == 0u) { if (xb_ld(&(bar)[XB_TMO])) break; if (_sp > XB_SPIN_CAP) { atomicAdd(&(bar)[XB_TMO], 1u); break; } } } } while (0)

struct XcdBarrier {
    unsigned* bar; unsigned x;
    volatile LAS unsigned* st;
};

__device__ __forceinline__ XcdBarrier xcd_barrier_post(unsigned* bar, volatile LAS unsigned* st) {
    XcdBarrier b; b.bar = bar; b.x = xb_xcc_id(); b.st = st;
    if (threadIdx.x == 0) (void)xb_add(&bar[XB_XCNT(b.x)], 1u);
    return b;
}
__device__ __forceinline__ void xcd_barrier_complete(unsigned* bar, unsigned x, unsigned& nloc, unsigned& nx) {
    const unsigned G = gridDim.x * gridDim.y * gridDim.z;
    unsigned sum, cnt, mine, sp = 0u;
    for (;;) {
        sum = 0u; cnt = 0u; mine = 0u;
#pragma unroll
        for (unsigned j = 0; j < 16; ++j) { const unsigned c = xb_ld(&bar[XB_XCNT(j)]); sum += c; cnt += (c > 0u) ? 1u : 0u; mine = (j == x) ? c : mine; }
        if (sum == G) break;
        __builtin_amdgcn_s_sleep(1);
        if ((++sp & 255u) == 0u) { if (xb_ld(&bar[XB_TMO])) break; if (sp > XB_SPIN_CAP) { atomicAdd(&bar[XB_TMO], 1u); break; } }
    }
    nloc = mine > 0u ? mine : 1u; nx = cnt > 0u ? cnt : 1u;
}

__device__ __forceinline__ void xcd_barrier(const XcdBarrier& b) {
    asm volatile("s_waitcnt vmcnt(0)" ::: "memory");
    __syncthreads();
    if (threadIdx.x == 0) {
        unsigned* bar = b.bar;
        __builtin_amdgcn_s_waitcnt(0);
        unsigned nloc = b.st[0], nx = b.st[1];
        if (nloc == 0u) { xcd_barrier_complete(bar, b.x, nloc, nx); b.st[0] = nloc; b.st[1] = nx; }
        const unsigned old = xb_add(&bar[XB_XSUB(b.x)], 1u);
        const unsigned gen = old / nloc;
        if (old + 1u == (gen + 1u) * nloc) {
            __builtin_amdgcn_fence(__ATOMIC_RELEASE, "agent");
            asm volatile("s_waitcnt vmcnt(0)" ::: "memory");
            const unsigned og = xb_add(&bar[XB_TOP], 1u);
            const unsigned tg = og / nx;
            if (og + 1u == (tg + 1u) * nx) xb_add(&bar[XB_TOPGEN], 1u);
            else XB_SPIN(xb_ld(&bar[XB_TOPGEN]) == tg, bar);
            __builtin_amdgcn_fence(__ATOMIC_ACQUIRE, "agent");
            xb_add(&bar[XB_XGEN(b.x)], 1u);
            asm volatile("s_waitcnt vmcnt(0)" ::: "memory");
        } else {
            XB_SPIN(xb_ld(&bar[XB_XGEN(b.x)]) == gen, bar);
            __builtin_amdgcn_fence(__ATOMIC_ACQUIRE, "agent");
            asm volatile("s_waitcnt vmcnt(0)" ::: "memory");
        }
    }
    __syncthreads();
}

#define DI __device__ __forceinline__
#define LDS_WAIT() asm volatile("s_waitcnt lgkmcnt(0)" ::: "memory")
typedef unsigned short bf16;
typedef float f32x4 __attribute__((ext_vector_type(4)));

namespace mk {
constexpr int NB = 8, SEQ = 2048, DM = 1024, NT = NB * SEQ, NL = 2;
constexpr int INW = 3856, ZLD = 4096;
constexpr int ZA = 0, ZRKV = 768, ZWDF = 1920, ZWDB = 1984, ZADF = 2048, ZADB = 2112, ZGD = 2176, ZMQK = 2304, ZMV = 3072, ZMO = 3456, ZMG = 3840;
constexpr int RW = 384, MW = 384, AW = 256;
constexpr int NE = 16, CAP = 256, FF = 2816, NSLOT = NB * NE * CAP;
constexpr int NWAVES = 8, NTHR = 512;
constexpr float RMS_EPS = 1e-6f;

enum { I_X = 0, I_RELB, I_LN1G, I_WIN, I_WOUT, I_MU, I_W0, I_W2, I_A0, I_A2, I_KK, I_KA, I_RK, I_G2, I_RLNG, I_RLNB,
       I_CW, I_CB, I_IB, I_FB, I_MLNG, I_LN2G, I_ROUTER, I_EW1, I_EW3, I_EW2, I_FG, N_IN };

constexpr size_t MiB = 1u << 20;
constexpr size_t WS_CTL = 0, CTL_ZERO_BYTES = 1 * MiB;
constexpr size_t WS_WTIN = 2 * MiB;
constexpr size_t WS_WTOUT = 18 * MiB;
constexpr size_t WS_W13T = 22 * MiB;
constexpr size_t WS_W2T = 374 * MiB;
constexpr size_t WS_X1 = 550 * MiB;
constexpr size_t WS_X2 = 614 * MiB;
constexpr size_t WS_HB = 678 * MiB;
constexpr size_t WS_AFF = 710 * MiB;
constexpr size_t WS_SEL = 711 * MiB;
constexpr size_t WS_GATE = 712 * MiB;
constexpr size_t WS_G2T = 713 * MiB;
constexpr size_t WS_LWT = 713 * MiB + 256 * 1024;
constexpr size_t WS_R = 714 * MiB;
constexpr size_t WS_Z = WS_R;
constexpr size_t WS_ATTO = WS_R + 128 * MiB;
constexpr size_t WS_ATTL = WS_R + 152 * MiB;
constexpr size_t WS_PR = WS_R + 154 * MiB;
constexpr size_t WS_RKY = WS_R + 442 * MiB;
constexpr size_t WS_RKB = WS_R + 490 * MiB;
constexpr size_t WS_MLQK = WS_R + 538 * MiB;
constexpr size_t WS_MLNUM = WS_R + 586 * MiB;
constexpr size_t WS_MLDEN = WS_R + 634 * MiB;
constexpr size_t WS_XG = WS_R;
constexpr size_t WS_ACT = WS_R + 64 * MiB;
constexpr size_t WS_YS = WS_R + 240 * MiB;
constexpr size_t WS_END = WS_R + 636 * MiB;

constexpr int CW_BAR = 4096;
constexpr int LDS_BYTES = 147456;
constexpr int MISC_OFF = LDS_BYTES - 256;

struct Args { const float* in[N_IN]; float* out; unsigned char* ws; int ph_lo, ph_hi; };

DI float bf2f(unsigned v) { return __uint_as_float(v << 16); }
DI unsigned f2bf(float f) { unsigned u = __float_as_uint(f); return (u + 0x7fffu + ((u >> 16) & 1u)) >> 16; }
DI unsigned pk2(float lo, float hi) { return f2bf(lo) | (f2bf(hi) << 16); }
DI float wave_sum(float v) {
#pragma unroll
    for (int o = 1; o < 64; o <<= 1) v += __shfl_xor(v, o);
    return v;
}
DI float sigm(float x) { return 1.f / (1.f + __expf(-x)); }
DI void unpack8(const uint4 w, float (&f)[8]) {
    f[0] = __uint_as_float(w.x << 16); f[1] = __uint_as_float(w.x & 0xffff0000u); f[2] = __uint_as_float(w.y << 16); f[3] = __uint_as_float(w.y & 0xffff0000u);
    f[4] = __uint_as_float(w.z << 16); f[5] = __uint_as_float(w.z & 0xffff0000u); f[6] = __uint_as_float(w.w << 16); f[7] = __uint_as_float(w.w & 0xffff0000u);
}

struct GroupOrder {
    int G, c2, nunits, per_e, nN;
    DI void init(int nN_, int G_, int bid) { nN = nN_; per_e = 8 * nN_; nunits = NE * per_e; G = G_; c2 = (G_ % 8 == 0) ? (bid % 8) * (G_ / 8) + bid / 8 : bid; }
    DI bool next(int i, pg8::Unit& u) const {
        const long L = (long)i * G + c2; if (L >= nunits) return false;
        const int e = (int)L / per_e, r = (int)L % per_e; u.pm = e * 8 + (r & 7); u.pn = e * nN + (r >> 3); return true;
    }
    DI void a_ready(const pg8::Unit&) const {}
    DI void done(const pg8::Unit&) const {}
};
DI unsigned pkbf(float lo, float hi) { typedef __bf16 b2 __attribute__((ext_vector_type(2))); typedef float f2 __attribute__((ext_vector_type(2))); const f2 v = {lo, hi}; return __builtin_bit_cast(unsigned, __builtin_convertvector(v, b2)); }
template <bool BASE_BF16>
struct EpiResT {
    static constexpr bool PERM = false, AFTER_DRAIN = false;
    const void* base; bf16* out; int ldc;
    DI void operator()(const pg8::f32x4 (&acc)[2][2][4][2], const pg8::Unit& u, int wr, int wc, int fr, int fq) const {
        const int row0 = u.pm * 256 + wr * 64 + fr, col0 = u.pn * 256 + wc * 32 + 4 * fq;
#pragma unroll
        for (int ai = 0; ai < 2; ++ai)
#pragma unroll
            for (int m = 0; m < 4; ++m) { const size_t off = (size_t)(row0 + ai * 128 + m * 16) * ldc + col0;
#pragma unroll
                for (int bj = 0; bj < 2; ++bj)
#pragma unroll
                    for (int n = 0; n < 2; ++n) { pg8::f32x4 b;
                        if constexpr (BASE_BF16) { const uint2 w = *(const uint2*)((const bf16*)base + off + bj * 128 + n * 16);
                            b[0] = __uint_as_float(w.x << 16); b[1] = __uint_as_float(w.x & 0xffff0000u); b[2] = __uint_as_float(w.y << 16); b[3] = __uint_as_float(w.y & 0xffff0000u); }
                        else b = *(const pg8::f32x4*)((const float*)base + off + bj * 128 + n * 16);
                        b += acc[ai][bj][m][n]; uint2 o; o.x = pkbf(b[0], b[1]); o.y = pkbf(b[2], b[3]); *(uint2*)(out + off + bj * 128 + n * 16) = o; } }
    }
};
DI float silu_f(float x) { return x * __builtin_amdgcn_rcpf(1.f + __expf(-x)); }
DI float f8clamp(float x) { return __builtin_amdgcn_fmed3f(x, -448.f, 448.f); }
DI unsigned pk4_fp8(float a, float b, float c, float d) { unsigned p = 0u; p = __builtin_amdgcn_cvt_pk_fp8_f32(f8clamp(a), f8clamp(b), p, false); p = __builtin_amdgcn_cvt_pk_fp8_f32(f8clamp(c), f8clamp(d), p, true); return p; }
constexpr float F8_WSC = 64.f, F8_HSC = 8.f, F8_ASC = 16.f;
struct EpiSwiGLU {
    static constexpr bool PERM = true, AFTER_DRAIN = false;
    unsigned char* act; int nN;
    DI void operator()(const pg8::f32x4 (&acc)[2][2][4][2], const pg8::Unit& u, int wr, int wc, int fr, int fq) const {
        const int lpn = u.pn % nN; const int row0 = u.pm * 256 + wr * 64 + fr, col0 = lpn * 128 + wc * 32 + 8 * fq; constexpr float is = 1.f / (F8_HSC * F8_WSC);
#pragma unroll
        for (int ai = 0; ai < 2; ++ai)
#pragma unroll
            for (int m = 0; m < 4; ++m) { unsigned char* p = act + (size_t)(row0 + ai * 128 + m * 16) * FF + col0;
                const pg8::f32x4 a0 = acc[ai][0][m][0] * is, a1 = acc[ai][0][m][1] * is, g0 = acc[ai][1][m][0] * (is * F8_ASC), g1 = acc[ai][1][m][1] * (is * F8_ASC);
                uint2 w; w.x = pk4_fp8(silu_f(a0[0]) * g0[0], silu_f(a0[1]) * g0[1], silu_f(a0[2]) * g0[2], silu_f(a0[3]) * g0[3]);
                w.y = pk4_fp8(silu_f(a1[0]) * g1[0], silu_f(a1[1]) * g1[1], silu_f(a1[2]) * g1[2], silu_f(a1[3]) * g1[3]);
                *(uint2*)p = w; }
    }
};
struct EpiGate {
    static constexpr bool PERM = true, AFTER_DRAIN = false;
    bf16* ys; const float* gate;
    DI void operator()(const pg8::f32x4 (&acc)[2][2][4][2], const pg8::Unit& u, int wr, int wc, int fr, int fq) const {
        const int row0 = u.pm * 256 + wr * 64 + fr, col0 = (u.pn & 3) * 256 + wc * 32 + 8 * fq;
#pragma unroll
        for (int ai = 0; ai < 2; ++ai)
#pragma unroll
            for (int m = 0; m < 4; ++m) { const int row = row0 + ai * 128 + m * 16; const float g = gate[row] * (1.f / (F8_ASC * F8_WSC)); bf16* p = ys + (size_t)row * DM + col0;
#pragma unroll
                for (int bj = 0; bj < 2; ++bj) { const pg8::f32x4 v0 = acc[ai][bj][m][0] * g, v1 = acc[ai][bj][m][1] * g; pg8::u32x4 w;
                    w.x = pg8::cvt_pk_bf16(v0[0], v0[1]); w.y = pg8::cvt_pk_bf16(v0[2], v0[3]); w.z = pg8::cvt_pk_bf16(v1[0], v1[1]); w.w = pg8::cvt_pk_bf16(v1[2], v1[3]);
                    *(pg8::u32x4*)(p + bj * 128) = w; } }
    }
};

DI void cvt_tile(const float* W, int N, int nvalid, int k0, int n0, bf16* dst, int Kd, size_t drow0, LAS float* scr, int lane) {
    const int c4 = (lane & 15) * 4, kr = lane >> 4;
#pragma unroll
    for (int it = 0; it < 16; ++it) { const int k = it * 4 + kr; float4 v = make_float4(0.f, 0.f, 0.f, 0.f);
        if (n0 + c4 < nvalid) v = *(const float4*)(W + (size_t)(k0 + k) * N + n0 + c4);
        LAS float* s = scr + k * 65 + c4; s[0] = v.x; s[1] = v.y; s[2] = v.z; s[3] = v.w; }
    LDS_WAIT(); asm volatile("" ::: "memory");
    const int c = lane & 7;
#pragma unroll
    for (int it = 0; it < 8; ++it) { const int n = it * 8 + (lane >> 3); const LAS float* s = scr + (8 * c) * 65 + n;
        uint4 o; o.x = pk2(s[0], s[65]); o.y = pk2(s[130], s[195]); o.z = pk2(s[260], s[325]); o.w = pk2(s[390], s[455]);
        *(uint4*)(dst + (drow0 + n) * (size_t)Kd + k0 + 8 * c) = o; }
    LDS_WAIT(); asm volatile("" ::: "memory");
}
DI void cvt_tile_fp8(const float* W, int N, int k0, int n0, unsigned char* dst, int Kd, size_t drow0, float sc, LAS unsigned char* scr, int lane) {
    const int nq = lane & 15, kq = lane >> 4;
#pragma unroll
    for (int hb = 0; hb < 2; ++hb) {
        f32x4 v[4][4];
#pragma unroll
        for (int it = 0; it < 4; ++it)
#pragma unroll
            for (int j = 0; j < 4; ++j) v[it][j] = __builtin_nontemporal_load((const f32x4*)(W + (size_t)(k0 + hb * 64 + it * 16 + kq * 4 + j) * N + n0 + 4 * nq));
#pragma unroll
        for (int it = 0; it < 4; ++it)
#pragma unroll
            for (int i = 0; i < 4; ++i) *(LAS unsigned*)(scr + (4 * nq + i) * 132 + hb * 64 + it * 16 + kq * 4) = pk4_fp8(v[it][0][i] * sc, v[it][1][i] * sc, v[it][2][i] * sc, v[it][3][i] * sc);
    }
    LDS_WAIT(); asm volatile("" ::: "memory");
    const int c = lane & 7;
#pragma unroll
    for (int it = 0; it < 8; ++it) { const int n = it * 8 + (lane >> 3); const LAS unsigned* s = (const LAS unsigned*)(scr + n * 132 + 16 * c);
        uint4 o; o.x = s[0]; o.y = s[1]; o.z = s[2]; o.w = s[3];
        *(uint4*)(dst + (drow0 + n) * (size_t)Kd + k0 + 16 * c) = o; }
    LDS_WAIT(); asm volatile("" ::: "memory");
}
DI void phase_p0(const Args& A, LAS unsigned char* lds, int it0, int it1, int gw, int ngw, int wave, int lane) {
    LAS float* scr = (LAS float*)(lds + wave * 16896);
    bf16* wtin = (bf16*)(A.ws + WS_WTIN); bf16* wtout = (bf16*)(A.ws + WS_WTOUT); unsigned char* w13 = A.ws + WS_W13T; unsigned char* w2t = A.ws + WS_W2T;
    constexpr int I_IN = NL * 16 * 64, I_OUT = NL * 16 * 16, I_E = 8 * 44, I_MOE = NL * NE * 3 * I_E;
    for (int it = it0 + gw; it < it1; it += ngw) {
        int r = it;
        if (r < I_IN) { const int l = r / 1024, t = r % 1024, kb = t / 64, nb = t % 64;
            cvt_tile(A.in[I_WIN] + (size_t)l * DM * INW, INW, INW, kb * 64, nb * 64, wtin + (size_t)l * ZLD * DM, DM, (size_t)nb * 64, scr, lane); continue; }
        r -= I_IN;
        if (r < I_OUT) { const int l = r / 256, t = r % 256, kb = t / 16, nb = t % 16;
            cvt_tile(A.in[I_WOUT] + (size_t)l * DM * DM, DM, DM, kb * 64, nb * 64, wtout + (size_t)l * DM * DM, DM, (size_t)nb * 64, scr, lane); continue; }
        r -= I_OUT;
        const int le = r / (3 * I_E), q = r % (3 * I_E), which = q / I_E, t = q % I_E;
        if (which < 2) { const int kb = t / 44, nb = t % 44, n0 = nb * 64;
            cvt_tile_fp8(A.in[which == 0 ? I_EW1 : I_EW3] + (size_t)le * DM * FF, FF, kb * 128, n0, w13 + (size_t)le * 5632 * DM, DM, (size_t)((n0 >> 7) * 256 + which * 128 + (n0 & 127)), F8_WSC, (LAS unsigned char*)scr, lane); }
        else { const int kb = t / 16, nb = t % 16;
            cvt_tile_fp8(A.in[I_EW2] + (size_t)le * FF * DM, DM, kb * 128, nb * 64, w2t + (size_t)le * DM * FF, FF, (size_t)nb * 64, F8_WSC, (LAS unsigned char*)scr, lane); }
    }
    if (it0 == 0) { bf16* g2t = (bf16*)(A.ws + WS_G2T);
        for (int idx = gw * 64 + lane; idx < NL * 128 * RW; idx += ngw * 64) { const int col = idx % RW, j = (idx / RW) % 128, l = idx / (128 * RW); g2t[((size_t)l * RW + col) * 128 + j] = (bf16)f2bf(A.in[I_G2][idx]); } }
}

DI void load_row(const float* xrow, int lane, f32x4 (&v)[4]) {
    const f32x4* xr = (const f32x4*)xrow + lane;
#pragma unroll
    for (int j = 0; j < 4; ++j) v[j] = xr[64 * j];
}
DI void load_row_bf(const bf16* xrow, int lane, f32x4 (&v)[4]) {
    const uint2* xr = (const uint2*)xrow + lane;
#pragma unroll
    for (int j = 0; j < 4; ++j) { const uint2 w = xr[64 * j]; v[j][0] = __uint_as_float(w.x << 16); v[j][1] = __uint_as_float(w.x & 0xffff0000u); v[j][2] = __uint_as_float(w.y << 16); v[j][3] = __uint_as_float(w.y & 0xffff0000u); }
}
DI void add_slots(const Args& A, int tok, int lane, f32x4 (&v)[4]) {
    const int* sel = (const int*)(A.ws + WS_SEL); const bf16* ys = (const bf16*)(A.ws + WS_YS);
    const int b = tok / SEQ; const int mys = (lane < NE) ? sel[(size_t)tok * NE + lane] : -1;
    unsigned m = (unsigned)__ballot(mys >= 0);
    while (m) {
        const uint2* p[4]; bool ok[4];
#pragma unroll
        for (int q = 0; q < 4; ++q) { ok[q] = m != 0u; const int e = ok[q] ? __builtin_ctz(m) : 0; m &= m - 1u; const int r = __shfl(mys, e);
            p[q] = (const uint2*)(ys + (size_t)((e * NB + b) * CAP + (ok[q] ? r : 0)) * DM) + lane; }
        uint2 w[4][4];
#pragma unroll
        for (int q = 0; q < 4; ++q) if (ok[q]) {
#pragma unroll
            for (int j = 0; j < 4; ++j) w[q][j] = p[q][64 * j]; }
#pragma unroll
        for (int q = 0; q < 4; ++q) if (ok[q]) {
#pragma unroll
            for (int j = 0; j < 4; ++j) { v[j][0] += __uint_as_float(w[q][j].x << 16); v[j][1] += __uint_as_float(w[q][j].x & 0xffff0000u); v[j][2] += __uint_as_float(w[q][j].y << 16); v[j][3] += __uint_as_float(w[q][j].y & 0xffff0000u); } }
    }
}
DI float row_rstd(const f32x4 (&v)[4]) {
    float s = 0.f;
#pragma unroll
    for (int j = 0; j < 4; ++j) s += (v[j][0] * v[j][0] + v[j][1] * v[j][1]) + (v[j][2] * v[j][2] + v[j][3] * v[j][3]);
    return rsqrtf(wave_sum(s) * (1.f / DM) + RMS_EPS);
}
DI void phase_ln1(const Args& A, int l, int gw, int ngw, int lane) {
    const float* xin = A.in[I_X]; const bf16* x1 = (const bf16*)(A.ws + WS_X1); bf16* x2 = (bf16*)(A.ws + WS_X2); bf16* hb = (bf16*)(A.ws + WS_HB);
    f32x4 gg[4];
#pragma unroll
    for (int j = 0; j < 4; ++j) gg[j] = ((const f32x4*)(A.in[I_LN1G] + (size_t)l * DM) + lane)[64 * j];
    for (int tok = gw; tok < NT; tok += 2 * ngw) {
        const int tokb = tok + ngw; const bool hb2 = tokb < NT;
        f32x4 va[4], vb[4];
        if (l == 0) { load_row(xin + (size_t)tok * DM, lane, va); load_row(xin + (size_t)(hb2 ? tokb : tok) * DM, lane, vb); }
        else { load_row_bf(x1 + (size_t)tok * DM, lane, va); load_row_bf(x1 + (size_t)(hb2 ? tokb : tok) * DM, lane, vb);
            add_slots(A, tok, lane, va); add_slots(A, hb2 ? tokb : tok, lane, vb);
            uint2* oa = (uint2*)(x2 + (size_t)tok * DM) + lane; uint2* ob = (uint2*)(x2 + (size_t)tokb * DM) + lane;
#pragma unroll
            for (int j = 0; j < 4; ++j) { uint2 w; w.x = pkbf(va[j][0], va[j][1]); w.y = pkbf(va[j][2], va[j][3]); oa[64 * j] = w;
                if (hb2) { uint2 u; u.x = pkbf(vb[j][0], vb[j][1]); u.y = pkbf(vb[j][2], vb[j][3]); ob[64 * j] = u; } } }
        const float ra = row_rstd(va), rb = row_rstd(vb); uint2* o8a = (uint2*)(hb + (size_t)tok * DM) + lane; uint2* o8b = (uint2*)(hb + (size_t)tokb * DM) + lane;
#pragma unroll
        for (int j = 0; j < 4; ++j) { uint2 w; w.x = pkbf(va[j][0] * ra * gg[j][0], va[j][1] * ra * gg[j][1]); w.y = pkbf(va[j][2] * ra * gg[j][2], va[j][3] * ra * gg[j][3]); o8a[64 * j] = w;
            if (hb2) { uint2 u; u.x = pkbf(vb[j][0] * rb * gg[j][0], vb[j][1] * rb * gg[j][1]); u.y = pkbf(vb[j][2] * rb * gg[j][2], vb[j][3] * rb * gg[j][3]); o8b[64 * j] = u; } }
    }
}
DI void phase_final(const Args& A, int gw, int ngw, int lane) {
    const bf16* xin = (const bf16*)(A.ws + WS_X1);
    f32x4 gg[4];
#pragma unroll
    for (int j = 0; j < 4; ++j) gg[j] = ((const f32x4*)A.in[I_FG] + lane)[64 * j];
    for (int tok = gw; tok < NT; tok += 2 * ngw) {
        const int tokb = tok + ngw; const bool hb2 = tokb < NT;
        f32x4 va[4], vb[4]; load_row_bf(xin + (size_t)tok * DM, lane, va); load_row_bf(xin + (size_t)(hb2 ? tokb : tok) * DM, lane, vb);
        add_slots(A, tok, lane, va); add_slots(A, hb2 ? tokb : tok, lane, vb);
        const float ra = row_rstd(va), rb = row_rstd(vb); f32x4* oa = (f32x4*)(A.out + (size_t)tok * DM) + lane; f32x4* ob = (f32x4*)(A.out + (size_t)tokb * DM) + lane;
#pragma unroll
        for (int j = 0; j < 4; ++j) { oa[64 * j] = va[j] * ra * gg[j]; if (hb2) ob[64 * j] = vb[j] * rb * gg[j]; }
    }
}
DI void phase_topk(const Args& A, LAS unsigned char* lds, int bid, int G, int tid, int wave, int lane) {
    const unsigned* affk = (const unsigned*)(A.ws + WS_AFF); int* sel = (int*)(A.ws + WS_SEL); float* gate = (float*)(A.ws + WS_GATE);
    const unsigned char* hb = A.ws + WS_HB; unsigned char* xg = A.ws + WS_XG;
    LAS unsigned* hist = (LAS unsigned*)lds;
    LAS unsigned* wsum = hist + 32;
    LAS int* list = (LAS int*)(lds + 256);
    for (int u = bid; u < NB * NE * 2; u += G) {
        const int half = u & 1, e = (u >> 1) % NE, b = u / (2 * NE);
        __syncthreads();
        if (tid < 32) hist[tid] = 0u;
        const uint4 kv = *(const uint4*)(affk + (size_t)(b * NE + e) * SEQ + tid * 4);
        const unsigned key[4] = {kv.x, kv.y, kv.z, kv.w};
        __syncthreads();
        unsigned prefix = 0u, krem = CAP;
#pragma unroll 1
        for (int pass = 0; pass < 8; ++pass) { const int shift = 28 - 4 * pass; LAS unsigned* h = hist + (pass & 1) * 16;
            unsigned cnt = 0u;
#pragma unroll
            for (int i = 0; i < 4; ++i) { const bool cand = (pass == 0) || ((key[i] >> (shift + 4)) == prefix); const unsigned bin = (key[i] >> shift) & 15u;
#pragma unroll
                for (int v = 0; v < 16; ++v) { const unsigned long long m = __ballot(cand && bin == (unsigned)v); if (lane == v) cnt += (unsigned)__popcll(m); } }
            if (lane < 16 && cnt) atomicAdd((unsigned*)(h + lane), cnt);
            __syncthreads();
            unsigned acc = 0u, pick = 0u, before = 0u;
#pragma unroll
            for (int v = 15; v >= 0; --v) { const unsigned c = h[v]; if (acc < krem && acc + c >= krem) { pick = (unsigned)v; before = acc; } acc += c; }
            prefix = (prefix << 4) | pick; krem -= before;
            if (tid < 16) hist[((pass + 1) & 1) * 16 + tid] = 0u;
            __syncthreads();
        }
        const unsigned tau = prefix;
        unsigned gt[4], eq[4]; unsigned ngt = 0u, neq = 0u;
#pragma unroll
        for (int i = 0; i < 4; ++i) { gt[i] = key[i] > tau ? 1u : 0u; eq[i] = key[i] == tau ? 1u : 0u; ngt += gt[i]; neq += eq[i]; }
        unsigned sg = ngt, se = neq;
#pragma unroll
        for (int o = 1; o < 64; o <<= 1) { const unsigned tg = __shfl_up(sg, o), te = __shfl_up(se, o); if (lane >= o) { sg += tg; se += te; } }
        if (lane == 63) { wsum[wave] = sg; wsum[8 + wave] = se; }
        __syncthreads();
        unsigned offg = 0u, offe = 0u;
        for (int w = 0; w < wave; ++w) { offg += wsum[w]; offe += wsum[8 + w]; }
        unsigned eqbefore = offe + se - neq;
        unsigned gtbefore = offg + sg - ngt;
        const int slot0 = (e * NB + b) * CAP;
#pragma unroll
        for (int i = 0; i < 4; ++i) { const int s = tid * 4 + i; const bool selq = gt[i] || (eq[i] && eqbefore < krem);
            const unsigned pos = gtbefore + (eqbefore < krem ? eqbefore : krem);
            if ((s >> 10) == half) { sel[(size_t)(b * SEQ + s) * NE + e] = selq ? (int)pos : -1;
                if (selq) { gate[slot0 + pos] = __uint_as_float(key[i]); } }
            if (selq && pos < CAP) list[pos] = s;
            gtbefore += gt[i]; eqbefore += eq[i]; }
        __syncthreads();
        for (int r = wave; r < CAP; r += NWAVES) { const int s = list[r];
            if ((s >> 10) == half) { const uint4* src = (const uint4*)(hb + (size_t)(b * SEQ + s) * DM) + lane; uint4* dstp = (uint4*)(xg + (size_t)(slot0 + r) * DM) + lane; dstp[0] = src[0]; } }
    }
    __syncthreads();
}

DI int t5_bucket(int rel) {
    const int ret = rel > 0 ? 16 : 0; const int n = rel < 0 ? -rel : rel;
    if (n < 8) return ret + n;
    int large = 8 + (int)(logf((float)n / 8.0f) / 4.852030263919617f * 8.0f);
    large = large < 15 ? large : 15;
    return ret + large;
}

typedef short bf16x8_t __attribute__((ext_vector_type(8)));
typedef short bf16x4_t __attribute__((ext_vector_type(4)));
typedef unsigned u32x4_t __attribute__((ext_vector_type(4)));
typedef unsigned u32x2_t __attribute__((ext_vector_type(2)));
typedef __bf16 bf2_t __attribute__((ext_vector_type(2)));
typedef float f2_t __attribute__((ext_vector_type(2)));
DI unsigned cvtpk(float lo, float hi) { const f2_t v = {lo, hi}; return __builtin_bit_cast(unsigned, __builtin_convertvector(v, bf2_t)); }
#define MFMA16(a, b, c) __builtin_amdgcn_mfma_f32_16x16x32_bf16((a), (b), (c), 0, 0, 0)

constexpr int AT_QS = 0, AT_QLD = 72;
constexpr int AT_KS = AT_QS + 128 * AT_QLD * 2;
constexpr int AT_VT = AT_KS + 272 * AT_QLD * 2, AT_VLD = 280;
constexpr int AT_BT = AT_VT + 64 * AT_VLD * 2;
constexpr int AT_END = AT_BT + 132 * 4;
static_assert(AT_END <= MISC_OFF, "attention LDS");

DI void attn_unit(const Args& A, LAS unsigned char* lds, int unit, int tid, int wave, int lane) {
    const bf16* Z = (const bf16*)(A.ws + WS_Z); bf16* ao = (bf16*)(A.ws + WS_ATTO); float* al = (float*)(A.ws + WS_ATTL);
    const int x = unit & 15; int r0 = unit >> 4; const int hh = r0 & 3; r0 >>= 2; const int b = r0 % NB, br = r0 / NB;
    const int dil = br == 0 ? 1 : (br == 1 ? 4 : 16), lsub = SEQ / dil, nblk = lsub / 128;
    const int res = x / nblk, nbk = x % nblk, l0 = nbk * 128, wbase = l0 - 64;
    LAS bf16* Qs = (LAS bf16*)(lds + AT_QS); LAS bf16* Ks = (LAS bf16*)(lds + AT_KS); LAS bf16* Vt = (LAS bf16*)(lds + AT_VT); LAS float* btab = (LAS float*)(lds + AT_BT);
    __syncthreads();
#pragma unroll
    for (int i = 0; i < 2; ++i) { const int id = tid + 512 * i, row = id >> 3, ch = id & 7; const int tok = b * SEQ + (l0 + row) * dil + res;
        *(LAS u32x4_t*)(Qs + row * AT_QLD + ch * 8) = *(const u32x4_t*)(Z + (size_t)tok * ZLD + ZA + hh * 64 + ch * 8); }
    for (int id = tid; id < 272 * 8; id += NTHR) { const int row = id >> 3, ch = id & 7; const int pos = wbase + row; u32x4_t v = (u32x4_t){0u, 0u, 0u, 0u};
        if (row < 256 && pos >= 0 && pos < lsub) v = *(const u32x4_t*)(Z + (size_t)(b * SEQ + pos * dil + res) * ZLD + ZA + 256 + hh * 64 + ch * 8);
        *(LAS u32x4_t*)(Ks + row * AT_QLD + ch * 8) = v; }
    for (int id = tid; id < 272 * 8; id += NTHR) { const int key = id % 272, ch = id / 272; const int pos = wbase + key; u32x4_t v = (u32x4_t){0u, 0u, 0u, 0u};
        if (key < 256 && pos >= 0 && pos < lsub) v = *(const u32x4_t*)(Z + (size_t)(b * SEQ + pos * dil + res) * ZLD + ZA + 512 + hh * 64 + ch * 8);
        LAS bf16* d = Vt + (ch * 8) * AT_VLD + key;
        d[0] = (bf16)(v.x & 0xffffu); d[AT_VLD] = (bf16)(v.x >> 16); d[2 * AT_VLD] = (bf16)(v.y & 0xffffu); d[3 * AT_VLD] = (bf16)(v.y >> 16);
        d[4 * AT_VLD] = (bf16)(v.z & 0xffffu); d[5 * AT_VLD] = (bf16)(v.z >> 16); d[6 * AT_VLD] = (bf16)(v.w & 0xffffu); d[7 * AT_VLD] = (bf16)(v.w >> 16); }
    if (tid < 129) btab[tid] = A.in[I_RELB][t5_bucket((tid - 64) * dil) * 4 + hh];
    __syncthreads();
    const int fr = lane & 15, qd = lane >> 4;
    f32x4 acc[10];
    { bf16x8_t qb[2];
#pragma unroll
      for (int ks = 0; ks < 2; ++ks) qb[ks] = *(const LAS bf16x8_t*)(Qs + (16 * wave + fr) * AT_QLD + ks * 32 + 8 * qd);
#pragma unroll
      for (int j = 0; j < 10; ++j) { acc[j] = (f32x4){0.f, 0.f, 0.f, 0.f};
#pragma unroll
          for (int ks = 0; ks < 2; ++ks) { const bf16x8_t ka = *(const LAS bf16x8_t*)(Ks + (16 * (wave + j) + fr) * AT_QLD + ks * 32 + 8 * qd); acc[j] = MFMA16(ka, qb[ks], acc[j]); } } }
    const int iq = 16 * wave + fr; float mx = -1.0e30f;
#pragma unroll
    for (int j = 0; j < 10; ++j)
#pragma unroll
        for (int r = 0; r < 4; ++r) { const int kw = 16 * (wave + j) + 4 * qd + r; const int m = kw - 64 - iq; const int pos = wbase + kw;
            const bool valid = (m >= -64) && (m <= 64) && (pos >= 0) && (pos < lsub);
            const float s = valid ? acc[j][r] * 0.125f + btab[valid ? m + 64 : 0] : -1.0e30f; acc[j][r] = s; mx = fmaxf(mx, s); }
    mx = fmaxf(mx, __shfl_xor(mx, 16)); mx = fmaxf(mx, __shfl_xor(mx, 32));
    float lsum = 0.f;
#pragma unroll
    for (int j = 0; j < 10; ++j)
#pragma unroll
        for (int r = 0; r < 4; ++r) { const float p = __expf(acc[j][r] - mx); acc[j][r] = p; lsum += p; }
    lsum += __shfl_xor(lsum, 16); lsum += __shfl_xor(lsum, 32);
    f32x4 oacc[4];
#pragma unroll
    for (int d = 0; d < 4; ++d) oacc[d] = (f32x4){0.f, 0.f, 0.f, 0.f};
#pragma unroll
    for (int pp = 0; pp < 5; ++pp) {
        union { unsigned u[4]; bf16x8_t v; } pb;
        pb.u[0] = cvtpk(acc[2 * pp][0], acc[2 * pp][1]); pb.u[1] = cvtpk(acc[2 * pp][2], acc[2 * pp][3]); pb.u[2] = cvtpk(acc[2 * pp + 1][0], acc[2 * pp + 1][1]); pb.u[3] = cvtpk(acc[2 * pp + 1][2], acc[2 * pp + 1][3]);
#pragma unroll
        for (int d = 0; d < 4; ++d) { const LAS bf16* vp = Vt + (16 * d + fr) * AT_VLD + 16 * (wave + 2 * pp) + 4 * qd;
            union { bf16x4_t h[2]; bf16x8_t v; } va; va.h[0] = *(const LAS bf16x4_t*)vp; va.h[1] = *(const LAS bf16x4_t*)(vp + 16);
            oacc[d] = MFMA16(va.v, pb.v, oacc[d]); } }
    const float inv = 1.f / lsum; const int tok = b * SEQ + (l0 + iq) * dil + res;
    bf16* op = ao + ((size_t)br * NT + tok) * AW + hh * 64 + 4 * qd;
#pragma unroll
    for (int d = 0; d < 4; ++d) { uint2 w; w.x = cvtpk(oacc[d][0] * inv, oacc[d][1] * inv); w.y = cvtpk(oacc[d][2] * inv, oacc[d][3] * inv); *(uint2*)(op + 16 * d) = w; }
    if (qd == 0) al[((size_t)br * NT + tok) * 4 + hh] = mx + logf(lsum);
}
constexpr int ATT_UNITS = 3 * NB * 4 * 16, ATT_SCAN_BLK0 = 160, ATT_SPLIT = ATT_UNITS - 96 * 6;
DI void phase_attn(const Args& A, LAS unsigned char* lds, int u0, int u1, int b0, int nb, int tid, int wave, int lane) {
    for (int u = u0 + b0; u < u1; u += nb) attn_unit(A, lds, u, tid, wave, lane);
    __syncthreads();
}


constexpr int ML_QLD = 104, ML_SLD = 72;
constexpr int ML_QS = 0;
constexpr int ML_QT = ML_QS + 64 * ML_QLD * 2;
constexpr int ML_KS = ML_QT + 64 * ML_QLD * 2;
constexpr int ML_KT = ML_KS + 64 * ML_QLD * 2;
constexpr int ML_VT = ML_KT + 96 * ML_SLD * 2;
constexpr int ML_WS = ML_VT + 112 * ML_SLD * 2;
constexpr int ML_CT = ML_WS + 64 * ML_SLD * 2;
constexpr int ML_CW = ML_CT + 112 * ML_QLD * 2;
constexpr int ML_END = ML_CW + 6 * 192 * 4;
static_assert(ML_END <= MISC_OFF, "mlstm LDS");

constexpr int MLP_QF = 0, MLP_NI = 12288, MLP_U = 26624, MLP_DEC = 48128, MLP_BYTES = 48384;
constexpr size_t WS_MLPKG = WS_R + 304 * MiB;
static_assert(WS_MLPKG + (size_t)2 * NB * 4 * 32 * MLP_BYTES <= WS_RKY, "mlstm package region");

struct M1Regs { u32x4_t zc[15]; u32x2_t vv[3]; float gi, gf; };
DI void mlstm_m1_fetch(const Args& A, int item, int tid, int lane, M1Regs& R) {
    const bf16* Z = (const bf16*)(A.ws + WS_Z);
    const int c = item & 31, u = item >> 5; const int dir = u / 32, b = (u % 32) / 4, hh = u % 4; const int j = tid >> 3, sub = tid & 7;
    const int tl = dir ? SEQ - 1 - (c * 64 + lane) : c * 64 + lane; const size_t tokl = (size_t)b * SEQ + tl;
    R.gi = bf2f(Z[tokl * ZLD + ZMG + dir * 8 + hh]); R.gf = bf2f(Z[tokl * ZLD + ZMG + dir * 8 + 4 + hh]);
    const int tj = dir ? SEQ - 1 - (c * 64 + j) : c * 64 + j; const size_t tokj = (size_t)b * SEQ + tj;
    const bool isk = sub >= 4; const int zcol = ZMQK + (isk ? 384 : 0) + hh * 96 + (sub & 3) * 24;
#pragma unroll
    for (int tap = 0; tap < 5; ++tap) { const int tt = tj + tap - 2; const bool ok = tt >= 0 && tt < SEQ; const u32x4_t* zp = (const u32x4_t*)(Z + ((size_t)b * SEQ + (ok ? tt : tj)) * ZLD + zcol);
#pragma unroll
        for (int q4 = 0; q4 < 3; ++q4) { const u32x4_t w = zp[q4]; R.zc[tap * 3 + q4] = ok ? w : (u32x4_t){0u, 0u, 0u, 0u}; } }
    const u32x2_t* vp = (const u32x2_t*)(Z + tokj * ZLD + ZMV + hh * 96 + sub * 12);
#pragma unroll
    for (int q2 = 0; q2 < 3; ++q2) R.vv[q2] = vp[q2];
}
DI void mlstm_m1_item(const Args& A, int l, LAS unsigned char* lds, int item, int item_next, M1Regs& R, int& hh_staged, int tid, int wave, int lane) {
    const int c = item & 31, u = item >> 5; const int dir = u / 32, hh = u % 4;
    LAS bf16* Qs = (LAS bf16*)(lds + ML_QS); LAS bf16* Qt = (LAS bf16*)(lds + ML_QT); LAS bf16* Ks = (LAS bf16*)(lds + ML_KS); LAS bf16* KtT = (LAS bf16*)(lds + ML_KT);
    LAS bf16* VtT = (LAS bf16*)(lds + ML_VT); LAS bf16* Ws = (LAS bf16*)(lds + ML_WS); LAS float* cwl = (LAS float*)(lds + ML_CW); LAS float* cbl = cwl + 5 * 192;
    const int fr = lane & 15, qd = lane >> 4;
    unsigned char* pkg = A.ws + WS_MLPKG + (size_t)item * MLP_BYTES;
    __syncthreads();
    if (hh != hh_staged) { hh_staged = hh;
        for (int i = tid; i < 5 * 192; i += NTHR) { const int tap = i / 192, ch = i % 192; cwl[i] = A.in[I_CW][(size_t)(l * 5 + tap) * 768 + (ch < 96 ? 0 : 384) + hh * 96 + (ch % 96)]; }
        for (int i = tid; i < 192; i += NTHR) cbl[i] = A.in[I_CB][(size_t)l * 768 + (i < 96 ? 0 : 384) + hh * 96 + (i % 96)];
        for (int i = tid; i < 16 * ML_SLD; i += NTHR) VtT[96 * ML_SLD + i] = (i < ML_SLD) ? (bf16)0x3F80u : (bf16)0u;
        __syncthreads(); }
    const float ibv = A.in[I_IB][(l * 2 + dir) * 4 + hh], fbv = A.in[I_FB][(l * 2 + dir) * 4 + hh];
    const int j = tid >> 3, sub = tid & 7;
    const float gi = R.gi + ibv, gf = R.gf + fbv;
    float bsum = fminf(gf, 0.f) - __logf(1.f + __expf(-fabsf(gf)));
#pragma unroll
    for (int o = 1; o < 64; o <<= 1) { const float t = __shfl_up(bsum, o); if (lane >= o) bsum += t; }
    const float bend = __shfl(bsum, 63);
    const float bj = __shfl(bsum, j), igj = __shfl(gi, j);
    { const bool isk = sub >= 4; const int c0 = (sub & 3) * 24, cl = (isk ? 96 : 0) + c0;
      float acc[24];
#pragma unroll
      for (int e = 0; e < 24; ++e) acc[e] = cbl[cl + e];
#pragma unroll
      for (int tap = 0; tap < 5; ++tap) {
#pragma unroll
          for (int q4 = 0; q4 < 3; ++q4) { const u32x4_t w = R.zc[tap * 3 + q4]; const LAS float* cwp = cwl + tap * 192 + cl + q4 * 8;
              acc[q4 * 8 + 0] += cwp[0] * __uint_as_float(w.x << 16); acc[q4 * 8 + 1] += cwp[1] * __uint_as_float(w.x & 0xffff0000u);
              acc[q4 * 8 + 2] += cwp[2] * __uint_as_float(w.y << 16); acc[q4 * 8 + 3] += cwp[3] * __uint_as_float(w.y & 0xffff0000u);
              acc[q4 * 8 + 4] += cwp[4] * __uint_as_float(w.z << 16); acc[q4 * 8 + 5] += cwp[5] * __uint_as_float(w.z & 0xffff0000u);
              acc[q4 * 8 + 6] += cwp[6] * __uint_as_float(w.w << 16); acc[q4 * 8 + 7] += cwp[7] * __uint_as_float(w.w & 0xffff0000u); } }
      const float sc1 = isk ? 0.10206207261596575f : 1.f; const float sc2 = isk ? __expf(bend - bj + igj) : __expf(bj);
#pragma unroll
      for (int e = 0; e < 24; ++e) acc[e] = acc[e] * sigm(acc[e]) * sc1;
      if (!isk) { LAS bf16* d1 = Qs + j * ML_QLD + c0; LAS bf16* d2 = Qt + j * ML_QLD + c0;
#pragma unroll
          for (int q4 = 0; q4 < 3; ++q4) { u32x4_t w; w.x = cvtpk(acc[q4 * 8 + 0], acc[q4 * 8 + 1]); w.y = cvtpk(acc[q4 * 8 + 2], acc[q4 * 8 + 3]); w.z = cvtpk(acc[q4 * 8 + 4], acc[q4 * 8 + 5]); w.w = cvtpk(acc[q4 * 8 + 6], acc[q4 * 8 + 7]);
              *(LAS u32x4_t*)(d1 + q4 * 8) = w;
              u32x4_t x; x.x = cvtpk(acc[q4 * 8 + 0] * sc2, acc[q4 * 8 + 1] * sc2); x.y = cvtpk(acc[q4 * 8 + 2] * sc2, acc[q4 * 8 + 3] * sc2); x.z = cvtpk(acc[q4 * 8 + 4] * sc2, acc[q4 * 8 + 5] * sc2); x.w = cvtpk(acc[q4 * 8 + 6] * sc2, acc[q4 * 8 + 7] * sc2);
              *(LAS u32x4_t*)(d2 + q4 * 8) = x; } }
      else { LAS bf16* d1 = Ks + j * ML_QLD + c0;
#pragma unroll
          for (int q4 = 0; q4 < 3; ++q4) { u32x4_t w; w.x = cvtpk(acc[q4 * 8 + 0], acc[q4 * 8 + 1]); w.y = cvtpk(acc[q4 * 8 + 2], acc[q4 * 8 + 3]); w.z = cvtpk(acc[q4 * 8 + 4], acc[q4 * 8 + 5]); w.w = cvtpk(acc[q4 * 8 + 6], acc[q4 * 8 + 7]);
              *(LAS u32x4_t*)(d1 + q4 * 8) = w; }
#pragma unroll
          for (int e = 0; e < 24; ++e) KtT[(c0 + e) * ML_SLD + j] = (bf16)cvtpk(acc[e] * sc2, 0.f); } }
    { const int n0 = sub * 12;
#pragma unroll
      for (int q2 = 0; q2 < 3; ++q2) { const u32x2_t w = R.vv[q2]; LAS bf16* d = VtT + (n0 + q2 * 4) * ML_SLD + j;
          d[0] = (bf16)(w.x & 0xffffu); d[ML_SLD] = (bf16)(w.x >> 16); d[2 * ML_SLD] = (bf16)(w.y & 0xffffu); d[3 * ML_SLD] = (bf16)(w.y >> 16); } }
    if (item_next >= 0) mlstm_m1_fetch(A, item_next, tid, lane, R);
    __syncthreads();
#pragma unroll
    for (int i = 0; i < 2; ++i) { const int tile = 2 * wave + i, jt = tile >> 2, st = tile & 3; const int jq = 16 * jt + fr;
        u32x2_t w = (u32x2_t){0u, 0u};
        if (st <= jt) { f32x4 acc = (f32x4){0.f, 0.f, 0.f, 0.f};
#pragma unroll
            for (int ks = 0; ks < 3; ++ks) { const bf16x8_t a = *(const LAS bf16x8_t*)(Ks + (16 * st + fr) * ML_QLD + 32 * ks + 8 * qd); const bf16x8_t bq = *(const LAS bf16x8_t*)(Qs + jq * ML_QLD + 32 * ks + 8 * qd); acc = MFMA16(a, bq, acc); }
            const float bjq = __shfl(bsum, jq); float wv[4];
#pragma unroll
            for (int r = 0; r < 4; ++r) { const int s = 16 * st + 4 * qd + r; const float bs = __shfl(bsum, s), igs = __shfl(gi, s); wv[r] = (s <= jq) ? acc[r] * __expf(bjq - bs + igs) : 0.f; }
            w.x = cvtpk(wv[0], wv[1]); w.y = cvtpk(wv[2], wv[3]); }
        *(LAS u32x2_t*)(Ws + jq * ML_SLD + 16 * st + 4 * qd) = w; }
    __syncthreads();
    for (int id = wave; id < 12; id += NWAVES) { const int jt = id / 3, i3 = id % 3; const LAS bf16* p = Qt + (16 * jt + fr) * ML_QLD + 32 * i3 + 4 * qd; const u32x2_t lo = *(const LAS u32x2_t*)p, hi = *(const LAS u32x2_t*)(p + 16);
        *(u32x4_t*)(pkg + MLP_QF + (size_t)id * 1024 + lane * 16) = (u32x4_t){lo.x, lo.y, hi.x, hi.y}; }
    for (int id = wave; id < 70; id += NWAVES) { f32x4 acc = (f32x4){0.f, 0.f, 0.f, 0.f}; int nt; const LAS bf16* ap; int ald; unsigned char* dst;
        if (id < 28) { const int jt = id & 3; nt = id >> 2; ap = Ws + (16 * jt + fr) * ML_SLD; ald = 0; dst = pkg + MLP_NI + (size_t)(nt * 4 + jt) * 512; }
        else { const int q = id - 28, kt = q % 6; nt = q / 6; ap = KtT + (16 * kt + fr) * ML_SLD; ald = 0; dst = pkg + MLP_U + (size_t)(nt * 6 + kt) * 512; }
#pragma unroll
        for (int ks = 0; ks < 2; ++ks) { const bf16x8_t a = *(const LAS bf16x8_t*)(ap + 32 * ks + 8 * qd); const bf16x8_t bv = *(const LAS bf16x8_t*)(VtT + (16 * nt + fr) * ML_SLD + 32 * ks + 8 * qd);
            acc = (id < 28) ? MFMA16(bv, a, acc) : MFMA16(a, bv, acc); }
        u32x2_t w; w.x = cvtpk(acc[0], acc[1]); w.y = cvtpk(acc[2], acc[3]); *(u32x2_t*)(dst + lane * 8) = w; }
    if (tid < 64) ((float*)(pkg + MLP_DEC))[tid] = __expf(bend);
}
DI void phase_mlstm_m1(const Args& A, int l, LAS unsigned char* lds, int bid, int G, int tid, int wave, int lane) {
    int hh_staged = -1; constexpr int NIT = 2 * NB * 4 * 32;
    if (bid < NIT) { M1Regs R; mlstm_m1_fetch(A, bid, tid, lane, R);
        for (int it = bid; it < NIT; it += G) mlstm_m1_item(A, l, lds, it, (it + G < NIT) ? it + G : -1, R, hh_staged, tid, wave, lane); }
    __syncthreads();
}
constexpr int M2_SLOTS = 8, M2_SLOT_BYTES = 12288, M2_CTL = M2_SLOTS * M2_SLOT_BYTES;
static_assert(M2_CTL + 64 <= MISC_OFF, "mlstm m2 LDS");
DI f32x4 unpk4(const u32x2_t w) { return (f32x4){__uint_as_float(w.x << 16), __uint_as_float(w.x & 0xffff0000u), __uint_as_float(w.y << 16), __uint_as_float(w.y & 0xffff0000u)}; }
struct M2Small { u32x2_t ni[4], uu[6]; float dec; };
DI void m2_load_small(M2Small& o, const unsigned char* pkg, int nt, int lane) {
#pragma unroll
    for (int jt = 0; jt < 4; ++jt) o.ni[jt] = *(const u32x2_t*)(pkg + MLP_NI + (nt * 4 + jt) * 512 + lane * 8);
#pragma unroll
    for (int kt = 0; kt < 6; ++kt) o.uu[kt] = *(const u32x2_t*)(pkg + MLP_U + (nt * 6 + kt) * 512 + lane * 8);
    o.dec = ((const float*)(pkg + MLP_DEC))[lane];
}
DI void m2_step(const M2Small& o, const LAS unsigned char* slot, f32x4 (&C)[6], bf16* num, float* den, int dir, int b, int hh, int nt, int c, int lane, int fr, int qd) {
    union { unsigned u[4]; bf16x8_t v; } sB[3];
#pragma unroll
    for (int i = 0; i < 3; ++i) { sB[i].u[0] = cvtpk(C[2 * i][0], C[2 * i][1]); sB[i].u[1] = cvtpk(C[2 * i][2], C[2 * i][3]); sB[i].u[2] = cvtpk(C[2 * i + 1][0], C[2 * i + 1][1]); sB[i].u[3] = cvtpk(C[2 * i + 1][2], C[2 * i + 1][3]); }
#pragma unroll
    for (int jt = 0; jt < 4; ++jt) { f32x4 acc = unpk4(o.ni[jt]);
#pragma unroll
        for (int i = 0; i < 3; ++i) { const bf16x8_t qf = *(const LAS bf16x8_t*)(slot + (3 * jt + i) * 1024 + lane * 16); acc = MFMA16(sB[i].v, qf, acc); }
        { const int jj = 16 * jt + fr; const int tt = dir ? SEQ - 1 - (c * 64 + jj) : c * 64 + jj; const size_t tok = (size_t)b * SEQ + tt;
          if (nt < 6) { u32x2_t w; w.x = cvtpk(acc[0], acc[1]); w.y = cvtpk(acc[2], acc[3]); *(u32x2_t*)(num + ((size_t)dir * NT + tok) * MW + hh * 96 + 16 * nt + 4 * qd) = w; }
          else if (qd == 0) den[((size_t)dir * NT + tok) * 4 + hh] = acc[0]; } }
#pragma unroll
    for (int kt = 0; kt < 6; ++kt) C[kt] = C[kt] * o.dec + unpk4(o.uu[kt]);
}
DI void mlstm_m2_unit(const Args& A, LAS unsigned char* lds, int u, int tid, int wave, int lane) {
    bf16* num = (bf16*)(A.ws + WS_MLNUM); float* den = (float*)(A.ws + WS_MLDEN);
    const int dir = u / 32, b = (u % 32) / 4, hh = u % 4; const int fr = lane & 15, qd = lane >> 4;
    const unsigned char* pkg0 = A.ws + WS_MLPKG + (size_t)u * 32 * MLP_BYTES;
    volatile LAS unsigned* ready = (volatile LAS unsigned*)(lds + M2_CTL); volatile LAS unsigned* consumed = ready + 8;
    __syncthreads();
    if (tid < 16) ready[tid] = 0u;
    __syncthreads();
    if (wave == 7) {
        u32x4_t f0[12], f1[12], f2[12];
#define M2_FETCH(dst, c_) do { _Pragma("unroll") for (int i = 0; i < 12; ++i) dst[i] = *(const u32x4_t*)(pkg0 + (size_t)(c_) * MLP_BYTES + MLP_QF + i * 1024 + lane * 16); } while (0)
#define M2_PUBLISH(src, c_) do { if ((c_) >= M2_SLOTS) { const unsigned need = (unsigned)((c_) - M2_SLOTS + 1); unsigned spins = 0; \
            for (;;) { bool ok = true; _Pragma("unroll") for (int w = 0; w < 7; ++w) ok = ok && (consumed[w] >= need); if (ok) break; if (++spins > (1u << 22)) break; __builtin_amdgcn_s_sleep(1); } } \
        LAS unsigned char* slot_ = lds + ((c_) & (M2_SLOTS - 1)) * M2_SLOT_BYTES; _Pragma("unroll") for (int i = 0; i < 12; ++i) *(LAS u32x4_t*)(slot_ + i * 1024 + lane * 16) = src[i]; \
        asm volatile("s_waitcnt lgkmcnt(0)" ::: "memory"); if (lane == 0) ready[(c_) & (M2_SLOTS - 1)] = (unsigned)((c_) + 1); asm volatile("" ::: "memory"); } while (0)
        M2_FETCH(f0, 0); M2_FETCH(f1, 1);
        for (int c = 0; c < 30; c += 3) { M2_FETCH(f2, c + 2); M2_PUBLISH(f0, c); M2_FETCH(f0, c + 3); M2_PUBLISH(f1, c + 1); M2_FETCH(f1, c + 4); M2_PUBLISH(f2, c + 2); }
        M2_PUBLISH(f0, 30); M2_PUBLISH(f1, 31);
#undef M2_FETCH
#undef M2_PUBLISH
    } else {
        const int nt = wave; f32x4 C[6];
#pragma unroll
        for (int kt = 0; kt < 6; ++kt) C[kt] = (f32x4){0.f, 0.f, 0.f, 0.f};
        M2Small s0, s1, s2, s3;
        m2_load_small(s0, pkg0, nt, lane); m2_load_small(s1, pkg0 + MLP_BYTES, nt, lane); m2_load_small(s2, pkg0 + 2 * (size_t)MLP_BYTES, nt, lane); m2_load_small(s3, pkg0 + 3 * (size_t)MLP_BYTES, nt, lane);
#define M2_CHAIN(sx, c_) do { unsigned spins = 0; while (ready[(c_) & (M2_SLOTS - 1)] != (unsigned)((c_) + 1)) { if (++spins > (1u << 22)) break; __builtin_amdgcn_s_sleep(1); } asm volatile("" ::: "memory"); \
            m2_step(sx, lds + ((c_) & (M2_SLOTS - 1)) * M2_SLOT_BYTES, C, num, den, dir, b, hh, nt, (c_), lane, fr, qd); \
            asm volatile("s_waitcnt lgkmcnt(0)" ::: "memory"); if (lane == 0) consumed[nt] = (unsigned)((c_) + 1); asm volatile("" ::: "memory"); \
            if ((c_) + 4 < 32) m2_load_small(sx, pkg0 + (size_t)((c_) + 4) * MLP_BYTES, nt, lane); } while (0)
        for (int c = 0; c < 32; c += 4) { M2_CHAIN(s0, c); M2_CHAIN(s1, c + 1); M2_CHAIN(s2, c + 2); M2_CHAIN(s3, c + 3); }
#undef M2_CHAIN
    }
    __syncthreads();
}

constexpr int PKG_BYTES = 12544;
constexpr int PK_AH = 0, PK_RH = 2048, PK_KB = 4096, PK_VV = 8192, PK_TM = 10240, PK_MM = 10752, PK_LAK = 11776, PK_GE = 12288;
constexpr size_t WS_PKG = WS_PR;
static_assert((size_t)2 * NB * 6 * 128 * PKG_BYTES <= 288 * MiB, "package region");
constexpr int R1_W2T = 0, R1_A2T = 9216, R1_WV = 18432, R1_WV_BYTES = 12928;
constexpr int R1_IMG = 0, R1_LF = 9216, R1_MT = 10368;
static_assert(R1_WV + 8 * R1_WV_BYTES <= MISC_OFF, "rwkv r1 LDS");

DI bf16x4_t pack4(const f32x4 v) { union { unsigned u[2]; bf16x4_t h; } x; x.u[0] = cvtpk(v[0], v[1]); x.u[1] = cvtpk(v[2], v[3]); return x.h; }

DI void rwkv_r1_item(const Args& A, int l, LAS unsigned char* lds, int item, int& dh_staged, int tid, int wave, int lane) {
    const bf16* Z = (const bf16*)(A.ws + WS_Z);
    const int g = item & 15; int r0 = item >> 4; const int hh = r0 % 6; r0 /= 6; const int b = r0 % NB, dir = r0 / NB;
    const int cc = 8 * g + wave, fr = lane & 15, qd = lane >> 4;
    LAS bf16* W2T = (LAS bf16*)(lds + R1_W2T); LAS bf16* A2T = (LAS bf16*)(lds + R1_A2T);
    LAS unsigned char* wv = lds + R1_WV + wave * R1_WV_BYTES;
    LAS bf16* IMG = (LAS bf16*)(wv + R1_IMG); LAS float* Lf = (LAS float*)(wv + R1_LF); LAS bf16* MT = (LAS bf16*)(wv + R1_MT);
    const int sgn = dir ? -1 : 1; const int tok0 = b * SEQ + (dir ? SEQ - 1 - 16 * cc : 16 * cc);
    const float* mu = A.in[I_MU] + (size_t)(l * 2 + dir) * 1280;
    float er[4][4], ek[4][4], ev[4][4];
    u32x4_t ld[7];
#pragma unroll
    for (int i = 0; i < 7; ++i) { const int idx = lane + 64 * i; const int ri = idx / 24, pc = idx % 24; const bool ok = (idx < 17 * 24) && (ri > 0 || cc > 0);
        ld[i] = (u32x4_t){0u, 0u, 0u, 0u};
        if (ok) ld[i] = *(const u32x4_t*)(Z + (size_t)(tok0 + sgn * (ri - 1)) * ZLD + ZRKV + (pc >> 3) * RW + hh * 64 + (pc & 7) * 8); }
    uint4 zcw[2], zca[2], zpw[2], zpa[2];
    { const int zwd = dir ? ZWDB : ZWDF, zad = dir ? ZADB : ZADF; const bool hasp = !(cc == 0 && fr == 0);
      const bf16* zc = Z + (size_t)(tok0 + sgn * fr) * ZLD; const bf16* zq = Z + (size_t)(tok0 + sgn * (fr - 1)) * ZLD;
#pragma unroll
      for (int ks = 0; ks < 2; ++ks) { zcw[ks] = *(const uint4*)(zc + zwd + 32 * ks + 8 * qd); zca[ks] = *(const uint4*)(zc + zad + 32 * ks + 8 * qd);
          zpw[ks] = make_uint4(0u, 0u, 0u, 0u); zpa[ks] = make_uint4(0u, 0u, 0u, 0u);
          if (hasp) { zpw[ks] = *(const uint4*)(zq + zwd + 32 * ks + 8 * qd); zpa[ks] = *(const uint4*)(zq + zad + 32 * ks + 8 * qd); } } }
    if (dh_staged != dir * 6 + hh) { dh_staged = dir * 6 + hh;
    const int ch = tid & 63, i0 = (tid >> 6) * 8; const float* w2 = A.in[I_W2] + ((size_t)(l * 2 + dir) * 64 + i0) * RW + hh * 64 + ch; const float* a2 = A.in[I_A2] + ((size_t)(l * 2 + dir) * 64 + i0) * RW + hh * 64 + ch;
    u32x4_t pw, pa; pw.x = cvtpk(w2[0], w2[RW]); pw.y = cvtpk(w2[2 * RW], w2[3 * RW]); pw.z = cvtpk(w2[4 * RW], w2[5 * RW]); pw.w = cvtpk(w2[6 * RW], w2[7 * RW]);
    pa.x = cvtpk(a2[0], a2[RW]); pa.y = cvtpk(a2[2 * RW], a2[3 * RW]); pa.z = cvtpk(a2[4 * RW], a2[5 * RW]); pa.w = cvtpk(a2[6 * RW], a2[7 * RW]);
    __syncthreads();
    *(LAS u32x4_t*)(W2T + ch * 72 + i0) = pw; *(LAS u32x4_t*)(A2T + ch * 72 + i0) = pa;
    __syncthreads(); }
    { LAS bf16* stg = IMG; constexpr int SLD = 200;
#pragma unroll
      for (int i = 0; i < 7; ++i) { const int idx = lane + 64 * i; const int ri = idx / 24, pc = idx % 24; if (idx < 17 * 24) *(LAS u32x4_t*)(stg + ri * SLD + pc * 8) = ld[i]; }
      asm volatile("s_waitcnt lgkmcnt(0)" ::: "memory");
#pragma unroll
      for (int nt = 0; nt < 4; ++nt) { const LAS bf16* sp = stg + (4 * qd) * SLD + 16 * nt + fr;
          float qr = bf2f(sp[0]), qk = bf2f(sp[64]), qv = bf2f(sp[128]);
          const float mr = mu[hh * 64 + 16 * nt + fr], mk = mu[RW + hh * 64 + 16 * nt + fr], mv = mu[2 * RW + hh * 64 + 16 * nt + fr];
#pragma unroll
          for (int r = 0; r < 4; ++r) { const float cr = bf2f(sp[(r + 1) * SLD]), ck = bf2f(sp[(r + 1) * SLD + 64]), cv = bf2f(sp[(r + 1) * SLD + 128]);
              er[nt][r] = cr + mr * (qr - cr); ek[nt][r] = ck + mk * (qk - ck); ev[nt][r] = cv + mv * (qv - cv); qr = cr; qk = ck; qv = cv; } }
      asm volatile("s_waitcnt lgkmcnt(0)" ::: "memory"); }
    bf16x8_t thA[2], adA[2];
    {
#pragma unroll
      for (int ks = 0; ks < 2; ++ks) { float cw[8], pw[8], ca[8], pa[8];
          unpack8(zcw[ks], cw); unpack8(zca[ks], ca); unpack8(zpw[ks], pw); unpack8(zpa[ks], pa);
          const float* muw = mu + 1152 + 32 * ks + 8 * qd; const float* mua = mu + 1216 + 32 * ks + 8 * qd;
#pragma unroll
          for (int e = 0; e < 8; ++e) { const float xw = cw[e] + muw[e] * (pw[e] - cw[e]); cw[e] = 1.f - 2.f * __builtin_amdgcn_rcpf(1.f + __expf(2.f * xw)); ca[e] = ca[e] + mua[e] * (pa[e] - ca[e]); }
          union { unsigned u[4]; bf16x8_t v; } x, y;
#pragma unroll
          for (int e = 0; e < 4; ++e) { x.u[e] = cvtpk(cw[2 * e], cw[2 * e + 1]); y.u[e] = cvtpk(ca[2 * e], ca[2 * e + 1]); }
          thA[ks] = x.v; adA[ks] = y.v; } }
    f32x4 wl[4], al[4];
#pragma unroll
    for (int nt = 0; nt < 4; ++nt) { wl[nt] = (f32x4){0.f, 0.f, 0.f, 0.f}; al[nt] = (f32x4){0.f, 0.f, 0.f, 0.f};
#pragma unroll
        for (int ks = 0; ks < 2; ++ks) { const bf16x8_t bw = *(const LAS bf16x8_t*)(W2T + (16 * nt + fr) * 72 + 32 * ks + 8 * qd); const bf16x8_t ba = *(const LAS bf16x8_t*)(A2T + (16 * nt + fr) * 72 + 32 * ks + 8 * qd);
            wl[nt] = MFMA16(thA[ks], bw, wl[nt]); al[nt] = MFMA16(adA[ks], ba, al[nt]); } }
    float lw[4][4], alp[4][4], kap[4][4]; float ssq[4] = {0.f, 0.f, 0.f, 0.f}, bsm[4] = {0.f, 0.f, 0.f, 0.f};
#pragma unroll
    for (int nt = 0; nt < 4; ++nt) { const int ch = hh * 64 + 16 * nt + fr;
        const float w0v = A.in[I_W0][(size_t)(l * 2 + dir) * RW + ch], a0v = A.in[I_A0][(size_t)(l * 2 + dir) * RW + ch], kkw = A.in[I_KK][(size_t)l * RW + ch], kaw = A.in[I_KA][(size_t)l * RW + ch], rkw = A.in[I_RK][(size_t)l * RW + ch];
#pragma unroll
        for (int r = 0; r < 4; ++r) { const float x = w0v + wl[nt][r];
            lw[nt][r] = -0.6065306597126334f * __builtin_amdgcn_rcpf(1.f + __expf(-x));
            const float a = __builtin_amdgcn_rcpf(1.f + __expf(-(a0v + al[nt][r]))); alp[nt][r] = a;
            const float k0 = ek[nt][r]; kap[nt][r] = k0 * kkw; ek[nt][r] = k0 * (1.f + (a - 1.f) * kaw);
            ssq[r] += kap[nt][r] * kap[nt][r]; bsm[r] += er[nt][r] * ek[nt][r] * rkw; } }
#pragma unroll
    for (int r = 0; r < 4; ++r) {
#pragma unroll
        for (int o = 1; o < 16; o <<= 1) { ssq[r] += __shfl_xor(ssq[r], o); bsm[r] += __shfl_xor(bsm[r], o); }
        ssq[r] = __builtin_amdgcn_rsqf(fmaxf(ssq[r], 1e-24f)); }
    { bf16* bon = (bf16*)(A.ws + WS_RKB);
#pragma unroll
      for (int nt = 0; nt < 4; ++nt)
#pragma unroll
          for (int r = 0; r < 4; ++r) { kap[nt][r] *= ssq[r]; MT[(4 * qd + r) * 72 + 16 * nt + fr] = (bf16)cvtpk(bsm[r] * ev[nt][r], 0.f); }
      asm volatile("s_waitcnt lgkmcnt(0)" ::: "memory");
      const int p = lane >> 2, c16 = (lane & 3) * 16; const LAS u32x4_t* sp = (const LAS u32x4_t*)(MT + p * 72 + c16); const u32x4_t w0 = sp[0], w1 = sp[1];
      bf16* dst = bon + ((size_t)dir * NT + tok0 + sgn * p) * RW + hh * 64 + c16;
      *(u32x4_t*)dst = w0; *(u32x4_t*)(dst + 8) = w1;
      asm volatile("s_waitcnt lgkmcnt(0)" ::: "memory"); }
    unsigned char* pkg = A.ws + WS_PKG + ((size_t)((dir * NB + b) * 6 + hh) * 128 + cc) * PKG_BYTES;
    float lend[4];
    u32x2_t btf[4], ktf[4];
#pragma unroll
    for (int nt = 0; nt < 4; ++nt) { float lam[4]; lam[0] = lw[nt][0]; lam[1] = lam[0] + lw[nt][1]; lam[2] = lam[1] + lw[nt][2]; lam[3] = lam[2] + lw[nt][3];
        const float t1 = __shfl(lam[3], lane - 16), t2 = __shfl(lam[3], lane - 32), t3 = __shfl(lam[3], lane - 48);
        const float off = (qd >= 1 ? t1 : 0.f) + (qd >= 2 ? t2 : 0.f) + (qd >= 3 ? t3 : 0.f);
#pragma unroll
        for (int r = 0; r < 4; ++r) lam[r] += off;
        lend[nt] = __shfl(lam[3], 48 + fr);
        float bt4[4], kt4[4];
        float epv[4];
#pragma unroll
        for (int r = 0; r < 4; ++r) epv[r] = __expf(lam[r]);
        float ep_prev = __shfl(epv[3], lane - 16); if (qd == 0) ep_prev = 1.f;
        const float eendall = __expf(lend[nt]);
#pragma unroll
        for (int r = 0; r < 4; ++r) { const float ep = epv[r], epm = r ? epv[r - 1] : ep_prev, einv = __builtin_amdgcn_rcpf(ep), eend = eendall * einv;
            const float bb = kap[nt][r] * alp[nt][r]; const int o = (4 * qd + r) * 72 + 16 * nt + fr;
            IMG[o] = (bf16)cvtpk(-kap[nt][r] * epm, 0.f); IMG[1152 + o] = (bf16)cvtpk(er[nt][r] * ep, 0.f); IMG[2304 + o] = (bf16)cvtpk(bb * einv, 0.f); IMG[3456 + o] = (bf16)cvtpk(ek[nt][r] * einv, 0.f);
            bt4[r] = bb * eend; kt4[r] = ek[nt][r] * eend; }
        btf[nt].x = cvtpk(bt4[0], bt4[1]); btf[nt].y = cvtpk(bt4[2], bt4[3]); ktf[nt].x = cvtpk(kt4[0], kt4[1]); ktf[nt].y = cvtpk(kt4[2], kt4[3]); }
    asm volatile("s_waitcnt lgkmcnt(0)" ::: "memory");
    f32x4 Lab = (f32x4){0.f, 0.f, 0.f, 0.f}, Lak = Lab, Mrb = Lab, Mrk = Lab;
#pragma unroll
    for (int ks = 0; ks < 2; ++ks) { const int o = fr * 72 + 32 * ks + 8 * qd;
        const bf16x8_t aA = *(const LAS bf16x8_t*)(IMG + o), aR = *(const LAS bf16x8_t*)(IMG + 1152 + o), bB = *(const LAS bf16x8_t*)(IMG + 2304 + o), bK = *(const LAS bf16x8_t*)(IMG + 3456 + o);
        Lab = MFMA16(aA, bB, Lab); Lak = MFMA16(aA, bK, Lak); Mrb = MFMA16(aR, bB, Mrb); Mrk = MFMA16(aR, bK, Mrk); }
#pragma unroll
    for (int r = 0; r < 4; ++r) { const int t = 4 * qd + r; if (!(fr < t)) { Lab[r] = 0.f; Lak[r] = 0.f; } if (!(fr <= t)) { Mrb[r] = 0.f; Mrk[r] = 0.f; } Lf[t * 17 + fr] = Lab[r]; }
    asm volatile("s_waitcnt lgkmcnt(0)" ::: "memory");
    float Tc[16];
#pragma unroll
    for (int t = 0; t < 16; ++t) { float acc = (t == fr) ? 1.f : 0.f;
#pragma unroll
        for (int s = 0; s < t; ++s) acc += Lf[t * 17 + s] * Tc[s];
        Tc[t] = acc; }
    f32x4 Tm;
#pragma unroll
    for (int r = 0; r < 4; ++r) Tm[r] = qd == 0 ? Tc[r] : (qd == 1 ? Tc[4 + r] : (qd == 2 ? Tc[8 + r] : Tc[12 + r]));
#pragma unroll
    for (int r = 0; r < 4; ++r) { const int o = (4 * qd + r) * 20 + fr; MT[o] = (bf16)cvtpk(Tm[r], 0.f); MT[320 + o] = (bf16)cvtpk(Mrb[r], 0.f); MT[640 + o] = (bf16)cvtpk(Lak[r], 0.f); MT[960 + o] = (bf16)cvtpk(Mrk[r], 0.f); }
    asm volatile("s_waitcnt lgkmcnt(0)" ::: "memory");
    { const int o = fr * 20 + 4 * qd;
      const u32x2_t mrb = *(const LAS u32x2_t*)(MT + 320 + o), mrk = *(const LAS u32x2_t*)(MT + 960 + o);
      *(u32x2_t*)(pkg + PK_TM + lane * 8) = *(const LAS u32x2_t*)(MT + o); *(u32x2_t*)(pkg + PK_LAK + lane * 8) = *(const LAS u32x2_t*)(MT + 640 + o);
      *(u32x4_t*)(pkg + PK_MM + lane * 16) = (u32x4_t){mrk.x, mrk.y, mrb.x, mrb.y}; }
#pragma unroll
    for (int ks = 0; ks < 2; ++ks) { const int o = fr * 72 + 32 * ks + 4 * qd;
        const u32x2_t alo = *(const LAS u32x2_t*)(IMG + o), ahi = *(const LAS u32x2_t*)(IMG + o + 16), rlo = *(const LAS u32x2_t*)(IMG + 1152 + o), rhi = *(const LAS u32x2_t*)(IMG + 1152 + o + 16);
        *(u32x4_t*)(pkg + PK_AH + ks * 1024 + lane * 16) = (u32x4_t){alo.x, alo.y, ahi.x, ahi.y}; *(u32x4_t*)(pkg + PK_RH + ks * 1024 + lane * 16) = (u32x4_t){rlo.x, rlo.y, rhi.x, rhi.y}; }
#pragma unroll
    for (int nt = 0; nt < 4; ++nt) { *(u32x4_t*)(pkg + PK_KB + nt * 1024 + lane * 16) = (u32x4_t){ktf[nt].x, ktf[nt].y, btf[nt].x, btf[nt].y};
        u32x2_t vf; vf.x = cvtpk(ev[nt][0], ev[nt][1]); vf.y = cvtpk(ev[nt][2], ev[nt][3]); *(u32x2_t*)(pkg + PK_VV + nt * 512 + lane * 8) = vf;
        if (qd == 0) ((float*)(pkg + PK_GE))[16 * nt + fr] = __expf(lend[nt]); }
    asm volatile("s_waitcnt lgkmcnt(0)" ::: "memory");
}
DI void phase_rwkv_r1(const Args& A, int l, LAS unsigned char* lds, int bid, int G, int tid, int wave, int lane) {
    constexpr int NIT = 2 * NB * 6 * 16; int dh_staged = -1;
    __syncthreads();
    for (int it = bid; it < NIT; it += G) rwkv_r1_item(A, l, lds, it, dh_staged, tid, wave, lane);
    __syncthreads();
}

struct RkOps { bf16x8_t ah[2], rh[2], kb[4], mm; bf16x4_t vv, tm, lak; f32x4 ge[4]; };
DI bf16x8_t widen4(const bf16x4_t a) { return __builtin_shufflevector(a, (bf16x4_t){0, 0, 0, 0}, 0, 1, 2, 3, 4, 5, 6, 7); }
DI void rk_step(const RkOps& c, f32x4 (&sT)[4], bf16* yb, int dir, int b, int hh, int vb, int cc, int fr, int qd) {
    const f32x4 zero4 = (f32x4){0.f, 0.f, 0.f, 0.f};
    union { unsigned u[4]; bf16x8_t v; } s0, s1;
    s0.u[0] = cvtpk(sT[0][0], sT[0][1]); s0.u[1] = cvtpk(sT[0][2], sT[0][3]); s0.u[2] = cvtpk(sT[1][0], sT[1][1]); s0.u[3] = cvtpk(sT[1][2], sT[1][3]);
    s1.u[0] = cvtpk(sT[2][0], sT[2][1]); s1.u[1] = cvtpk(sT[2][2], sT[2][3]); s1.u[2] = cvtpk(sT[3][0], sT[3][1]); s1.u[3] = cvtpk(sT[3][2], sT[3][3]);
    f32x4 ax = MFMA16(widen4(c.lak), widen4(c.vv), zero4); ax = MFMA16(c.ah[0], s0.v, ax); ax = MFMA16(c.ah[1], s1.v, ax);
    f32x4 ay = MFMA16(s0.v, c.rh[0], zero4); ay = MFMA16(s1.v, c.rh[1], ay);
    const f32x4 au = MFMA16(widen4(c.tm), widen4(pack4(ax)), zero4);
    const bf16x8_t vu = __builtin_shufflevector(c.vv, pack4(au), 0, 1, 2, 3, 4, 5, 6, 7);
    ay = MFMA16(vu, c.mm, ay);
#pragma unroll
    for (int kt = 0; kt < 4; ++kt) sT[kt] = MFMA16(c.kb[kt], vu, sT[kt] * c.ge[kt]);
    const int sgn = dir ? -1 : 1; const int tok0 = b * SEQ + (dir ? SEQ - 1 - 16 * cc : 16 * cc);
    { u32x2_t w; w.x = cvtpk(ay[0], ay[1]); w.y = cvtpk(ay[2], ay[3]); *(u32x2_t*)(yb + ((size_t)dir * NT + tok0 + sgn * fr) * RW + hh * 64 + 16 * vb + 4 * qd) = w; }
}
constexpr int R2_SLOTS = 8, R2_CTL = R2_SLOTS * PKG_BYTES;
static_assert(R2_CTL + 64 <= MISC_OFF, "rwkv r2 LDS");
DI void rk_load_lds(RkOps& o, const LAS unsigned char* pkg, int vb, int lane, int qd) {
#pragma unroll
    for (int ks = 0; ks < 2; ++ks) { o.ah[ks] = *(const LAS bf16x8_t*)(pkg + PK_AH + ks * 1024 + lane * 16); o.rh[ks] = *(const LAS bf16x8_t*)(pkg + PK_RH + ks * 1024 + lane * 16); }
#pragma unroll
    for (int kt = 0; kt < 4; ++kt) { o.kb[kt] = *(const LAS bf16x8_t*)(pkg + PK_KB + kt * 1024 + lane * 16); o.ge[kt] = *(const LAS f32x4*)(pkg + PK_GE + (16 * kt + 4 * qd) * 4); }
    o.mm = *(const LAS bf16x8_t*)(pkg + PK_MM + lane * 16);
    o.vv = *(const LAS bf16x4_t*)(pkg + PK_VV + vb * 512 + lane * 8); o.tm = *(const LAS bf16x4_t*)(pkg + PK_TM + lane * 8); o.lak = *(const LAS bf16x4_t*)(pkg + PK_LAK + lane * 8);
}
DI void rk_pkg_fetch(u32x4_t (&buf)[13], const unsigned char* pkg, int lane) {
#pragma unroll
    for (int i = 0; i < 12; ++i) buf[i] = *(const u32x4_t*)(pkg + i * 1024 + lane * 16);
    buf[12] = (lane < 16) ? *(const u32x4_t*)(pkg + 12288 + lane * 16) : (u32x4_t){0u, 0u, 0u, 0u};
}
DI void rwkv_r2_unit(const Args& A, LAS unsigned char* lds, int u, int tid, int wave, int lane) {
    bf16* yb = (bf16*)(A.ws + WS_RKY);
    const int dir = u / 48, rem = u % 48, b = rem / 6, hh = rem % 6; const int fr = lane & 15, qd = lane >> 4;
    const unsigned char* pkg0 = A.ws + WS_PKG + ((size_t)((dir * NB + b) * 6 + hh) * 128) * PKG_BYTES;
    volatile LAS unsigned* ready = (volatile LAS unsigned*)(lds + R2_CTL); volatile LAS unsigned* consumed = ready + 8;
    __syncthreads();
    if (tid < 16) ready[tid] = 0u;
    __syncthreads();
    if (wave >= 4) {
        const int j = wave - 4; u32x4_t cur[13], nxt[13];
        rk_pkg_fetch(cur, pkg0 + (size_t)j * PKG_BYTES, lane);
        for (int cc = j; cc < 128; cc += 4) {
            if (cc + 4 < 128) rk_pkg_fetch(nxt, pkg0 + (size_t)(cc + 4) * PKG_BYTES, lane);
            if (cc >= R2_SLOTS) { const unsigned need = (unsigned)(cc - R2_SLOTS + 1); unsigned spins = 0;
                for (;;) { const unsigned c0 = consumed[0], c1 = consumed[1], c2 = consumed[2], c3 = consumed[3];
                    if (c0 >= need && c1 >= need && c2 >= need && c3 >= need) break; if (++spins > (1u << 22)) break; __builtin_amdgcn_s_sleep(1); } }
            LAS unsigned char* slot = lds + (cc & (R2_SLOTS - 1)) * PKG_BYTES;
#pragma unroll
            for (int i = 0; i < 12; ++i) *(LAS u32x4_t*)(slot + i * 1024 + lane * 16) = cur[i];
            if (lane < 16) *(LAS u32x4_t*)(slot + 12288 + lane * 16) = cur[12];
            asm volatile("s_waitcnt lgkmcnt(0)" ::: "memory");
            if (lane == 0) ready[cc & (R2_SLOTS - 1)] = (unsigned)(cc + 1);
            asm volatile("" ::: "memory");
#pragma unroll
            for (int i = 0; i < 13; ++i) cur[i] = nxt[i];
        }
    } else {
        const int vb = wave; f32x4 sT[4];
#pragma unroll
        for (int kt = 0; kt < 4; ++kt) sT[kt] = (f32x4){0.f, 0.f, 0.f, 0.f};
#define RK_WAIT(cc_) do { unsigned spins = 0; while (ready[(cc_) & (R2_SLOTS - 1)] != (unsigned)((cc_) + 1)) { if (++spins > (1u << 22)) break; __builtin_amdgcn_s_sleep(1); } asm volatile("" ::: "memory"); } while (0)
        RkOps pa, pb;
        RK_WAIT(0); rk_load_lds(pa, lds, vb, lane, qd);
        for (int cc = 0; cc < 128; cc += 2) {
            RK_WAIT(cc + 1); rk_load_lds(pb, lds + ((cc + 1) & (R2_SLOTS - 1)) * PKG_BYTES, vb, lane, qd);
            rk_step(pa, sT, yb, dir, b, hh, vb, cc, fr, qd);
            asm volatile("s_waitcnt lgkmcnt(0)" ::: "memory"); if (lane == 0) consumed[vb] = (unsigned)(cc + 2); asm volatile("" ::: "memory");
            if (cc + 2 < 128) { RK_WAIT(cc + 2); rk_load_lds(pa, lds + ((cc + 2) & (R2_SLOTS - 1)) * PKG_BYTES, vb, lane, qd); }
            rk_step(pb, sT, yb, dir, b, hh, vb, cc + 1, fr, qd);
            if (cc + 2 < 128) { asm volatile("s_waitcnt lgkmcnt(0)" ::: "memory"); if (lane == 0) consumed[vb] = (unsigned)(cc + 3); asm volatile("" ::: "memory"); }
        }
#undef RK_WAIT
    }
    __syncthreads();
}


constexpr int YA_G2LD = 136;
static_assert(384 * YA_G2LD * 2 <= MISC_OFF, "yasm LDS");
DI void unpack4(const uint2 w, float (&f)[4]) { f[0] = __uint_as_float(w.x << 16); f[1] = __uint_as_float(w.x & 0xffff0000u); f[2] = __uint_as_float(w.y << 16); f[3] = __uint_as_float(w.y & 0xffff0000u); }
DI void yasm_token(const bf16* Z, const bf16* ao, const float* al, const bf16* num, const float* den, const f32x4 mgA, const f32x4 mgB, bf16* y, int tok, int lane) {
    const bf16* zr = Z + (size_t)tok * ZLD; bf16* yr = y + (size_t)tok * DM;
    const float lsev = al[((size_t)((lane >> 2) % 3) * NT + tok) * 4 + (lane & 3)];
    const float denv = den[((size_t)((lane >> 2) & 1) * NT + tok) * 4 + (lane & 3)];
    const bool lo32 = lane < 32; const int lb = lane & 31;
    uint2 av[3], nA[2], nB[2];
#pragma unroll
    for (int br = 0; br < 3; ++br) av[br] = *(const uint2*)(ao + ((size_t)br * NT + tok) * AW + 4 * lane);
#pragma unroll
    for (int d = 0; d < 2; ++d) { nA[d] = *(const uint2*)(num + ((size_t)d * NT + tok) * MW + 4 * lane); nB[d] = *(const uint2*)(num + ((size_t)d * NT + tok) * MW + 256 + 4 * lb); }
    const uint2 zA = *(const uint2*)(zr + ZMO + 4 * lane), zB = *(const uint2*)(zr + ZMO + 256 + 4 * lb);
    { const int hh = lane >> 4; const float l0 = __shfl(lsev, hh), l1 = __shfl(lsev, 4 + hh), l2 = __shfl(lsev, 8 + hh);
      const float mx = fmaxf(l0, fmaxf(l1, l2)); const float w0 = __expf(l0 - mx), w1 = __expf(l1 - mx), w2 = __expf(l2 - mx); const float inv = 1.f / (w0 + w1 + w2);
      float a0[4], a1[4], a2[4]; unpack4(av[0], a0); unpack4(av[1], a1); unpack4(av[2], a2);
      uint2 o; o.x = pkbf((w0 * a0[0] + w1 * a1[0] + w2 * a2[0]) * inv, (w0 * a0[1] + w1 * a1[1] + w2 * a2[1]) * inv); o.y = pkbf((w0 * a0[2] + w1 * a1[2] + w2 * a2[2]) * inv, (w0 * a0[3] + w1 * a1[3] + w2 * a2[3]) * inv);
      *(uint2*)(yr + 4 * lane) = o; }
    { const int hA = lane / 24, hB = lane < 8 ? 2 : 3;
      const float dfA = __shfl(denv, hA), dbA = __shfl(denv, 4 + hA), dfB = __shfl(denv, hB), dbB = __shfl(denv, 4 + hB);
      const float ifA = 1.f / fmaxf(fabsf(dfA), 1.f), ibA = 1.f / fmaxf(fabsf(dbA), 1.f), ifB = 1.f / fmaxf(fabsf(dfB), 1.f), ibB = 1.f / fmaxf(fabsf(dbB), 1.f);
      float f0[4], f1[4], a[4], b[4]; unpack4(nA[0], f0); unpack4(nA[1], f1);
#pragma unroll
      for (int i = 0; i < 4; ++i) a[i] = f0[i] * ifA + f1[i] * ibA;
      unpack4(nB[0], f0); unpack4(nB[1], f1);
#pragma unroll
      for (int i = 0; i < 4; ++i) b[i] = lo32 ? f0[i] * ifB + f1[i] * ibB : 0.f;
      const float sA = (a[0] + a[1]) + (a[2] + a[3]), qA = (a[0] * a[0] + a[1] * a[1]) + (a[2] * a[2] + a[3] * a[3]);
      const float sB = (b[0] + b[1]) + (b[2] + b[3]), qB = (b[0] * b[0] + b[1] * b[1]) + (b[2] * b[2] + b[3] * b[3]);
      float mA = 0.f, rA = 0.f, mB = 0.f, rB = 0.f;
#pragma unroll
      for (int h = 0; h < 4; ++h) { const float ps = (hA == h ? sA : 0.f) + ((lo32 && hB == h) ? sB : 0.f), pq = (hA == h ? qA : 0.f) + ((lo32 && hB == h) ? qB : 0.f);
          const float m = wave_sum(ps) * (1.f / 96.f); const float var = fmaxf(wave_sum(pq) * (1.f / 96.f) - m * m, 0.f); const float rs = rsqrtf(var + 1e-6f);
          if (hA == h) { mA = m; rA = rs; } if (hB == h) { mB = m; rB = rs; } }
      float g[4]; unpack4(zA, g);
      uint2 o; o.x = pkbf((a[0] - mA) * rA * mgA[0] * sigm(g[0]), (a[1] - mA) * rA * mgA[1] * sigm(g[1])); o.y = pkbf((a[2] - mA) * rA * mgA[2] * sigm(g[2]), (a[3] - mA) * rA * mgA[3] * sigm(g[3]));
      *(uint2*)(yr + AW + RW + 4 * lane) = o;
      unpack4(zB, g);
      o.x = pkbf((b[0] - mB) * rB * mgB[0] * sigm(g[0]), (b[1] - mB) * rB * mgB[1] * sigm(g[1])); o.y = pkbf((b[2] - mB) * rB * mgB[2] * sigm(g[2]), (b[3] - mB) * rB * mgB[3] * sigm(g[3]));
      if (lo32) *(uint2*)(yr + AW + RW + 256 + 4 * lane) = o; }
}
DI void phase_yasm(const Args& A, int l, LAS unsigned char* lds, int gw, int ngw, int tid, int lane) {
    const bf16* Z = (const bf16*)(A.ws + WS_Z); const bf16* ao = (const bf16*)(A.ws + WS_ATTO); const float* al = (const float*)(A.ws + WS_ATTL);
    const bf16* rky = (const bf16*)(A.ws + WS_RKY); const bf16* rkb = (const bf16*)(A.ws + WS_RKB);
    const bf16* num = (const bf16*)(A.ws + WS_MLNUM); const float* den = (const float*)(A.ws + WS_MLDEN); bf16* y = (bf16*)(A.ws + WS_HB);
    const float* lng = A.in[I_RLNG] + (size_t)l * RW; const float* lnb = A.in[I_RLNB] + (size_t)l * RW; const float* mlg = A.in[I_MLNG] + (size_t)l * MW;
    LAS bf16* G2T = (LAS bf16*)lds;
    __syncthreads();
    { const u32x4_t* src = (const u32x4_t*)(A.ws + WS_G2T + (size_t)l * RW * 128 * 2);
      for (int idx = tid; idx < RW * 16; idx += NTHR) { const int col = idx >> 4, ch = idx & 15; *(LAS u32x4_t*)(G2T + col * YA_G2LD + ch * 8) = src[idx]; } }
    __syncthreads();
    const int fr = lane & 15, qd = lane >> 4;
    for (int item = gw; item < (NT / 16) * 6; item += ngw) {
        const int hh = item % 6, tg = item / 6; const int tokA = tg * 16 + fr;
        const size_t o = (size_t)tokA * RW + hh * 64 + 16 * qd;
        const uint4 y0a = *(const uint4*)(rky + o), y0b = *(const uint4*)(rky + o + 8), y1a = *(const uint4*)(rky + (size_t)NT * RW + o), y1b = *(const uint4*)(rky + (size_t)NT * RW + o + 8);
        const uint4 b0a = *(const uint4*)(rkb + o), b0b = *(const uint4*)(rkb + o + 8), b1a = *(const uint4*)(rkb + (size_t)NT * RW + o), b1b = *(const uint4*)(rkb + (size_t)NT * RW + o + 8);
        f32x4 gacc[4];
#pragma unroll
        for (int nt = 0; nt < 4; ++nt) gacc[nt] = (f32x4){0.f, 0.f, 0.f, 0.f};
#pragma unroll
        for (int ks = 0; ks < 4; ++ks) { float f[8]; unpack8(*(const uint4*)(Z + (size_t)tokA * ZLD + ZGD + 32 * ks + 8 * qd), f);
            union { unsigned u[4]; bf16x8_t v; } a;
#pragma unroll
            for (int e = 0; e < 4; ++e) a.u[e] = cvtpk(sigm(f[2 * e]), sigm(f[2 * e + 1]));
#pragma unroll
            for (int nt = 0; nt < 4; ++nt) { const bf16x8_t bg = *(const LAS bf16x8_t*)(G2T + (hh * 64 + 16 * (fr >> 2) + 4 * nt + (fr & 3)) * YA_G2LD + 32 * ks + 8 * qd); gacc[nt] = MFMA16(bg, a.v, gacc[nt]); } }
        float sv[16], bv[16], t0[8], t1[8];
        unpack8(y0a, t0); unpack8(y1a, t1);
#pragma unroll
        for (int j = 0; j < 8; ++j) sv[j] = t0[j] + t1[j];
        unpack8(y0b, t0); unpack8(y1b, t1);
#pragma unroll
        for (int j = 0; j < 8; ++j) sv[8 + j] = t0[j] + t1[j];
        unpack8(b0a, t0); unpack8(b1a, t1);
#pragma unroll
        for (int j = 0; j < 8; ++j) bv[j] = t0[j] + t1[j];
        unpack8(b0b, t0); unpack8(b1b, t1);
#pragma unroll
        for (int j = 0; j < 8; ++j) bv[8 + j] = t0[j] + t1[j];
        float sm = 0.f;
#pragma unroll
        for (int j = 0; j < 16; ++j) sm += sv[j];
        sm += __shfl_xor(sm, 16); sm += __shfl_xor(sm, 32); sm *= (1.f / 64.f);
        float vr = 0.f;
#pragma unroll
        for (int j = 0; j < 16; ++j) { sv[j] -= sm; vr += sv[j] * sv[j]; }
        vr += __shfl_xor(vr, 16); vr += __shfl_xor(vr, 32); vr = rsqrtf(vr * (1.f / 64.f) + 64e-5f);
        const f32x4* lgp = (const f32x4*)(lng + hh * 64 + 16 * qd); const f32x4* lbp = (const f32x4*)(lnb + hh * 64 + 16 * qd);
        unsigned ow[8];
#pragma unroll
        for (int q = 0; q < 4; ++q) { const f32x4 lg_ = lgp[q], lb_ = lbp[q];
            ow[2 * q] = pkbf((sv[4 * q] * vr * lg_[0] + lb_[0] + bv[4 * q]) * gacc[q][0], (sv[4 * q + 1] * vr * lg_[1] + lb_[1] + bv[4 * q + 1]) * gacc[q][1]);
            ow[2 * q + 1] = pkbf((sv[4 * q + 2] * vr * lg_[2] + lb_[2] + bv[4 * q + 2]) * gacc[q][2], (sv[4 * q + 3] * vr * lg_[3] + lb_[3] + bv[4 * q + 3]) * gacc[q][3]); }
        bf16* yo = y + (size_t)tokA * DM + AW + hh * 64 + 16 * qd;
        *(uint4*)yo = make_uint4(ow[0], ow[1], ow[2], ow[3]); *(uint4*)(yo + 8) = make_uint4(ow[4], ow[5], ow[6], ow[7]);
    }
    const f32x4 mgA = *(const f32x4*)(mlg + 4 * lane), mgB = *(const f32x4*)(mlg + 256 + 4 * (lane & 31));
    for (int tok = gw; tok < NT; tok += 2 * ngw) { yasm_token(Z, ao, al, num, den, mgA, mgB, y, tok, lane); if (tok + ngw < NT) yasm_token(Z, ao, al, num, den, mgA, mgB, y, tok + ngw, lane); }
    __syncthreads();
}

constexpr int L2_WLD = 1032;
constexpr int L2_WHI = 0, L2_WLO = 16 * L2_WLD * 2, L2_G2 = 2 * L2_WLO, L2_EX = L2_G2 + DM * 4, L2_SS = L2_EX + 8 * 1024, L2_END = L2_SS + 8 * 16 * 4;
static_assert(L2_END <= MISC_OFF, "ln2 LDS");
DI void phase_ln2(const Args& A, int l, LAS unsigned char* lds, int bid, int G, int tid, int wave, int lane) {
    const bf16* x1 = (const bf16*)(A.ws + WS_X1); unsigned char* hb = A.ws + WS_HB; float* aff = (float*)(A.ws + WS_AFF);
    const float* router = A.in[I_ROUTER] + (size_t)l * DM * NE; const float* g2 = A.in[I_LN2G] + (size_t)l * DM;
    LAS bf16* Whi = (LAS bf16*)(lds + L2_WHI); LAS bf16* Wlo = (LAS bf16*)(lds + L2_WLO); LAS float* g2s = (LAS float*)(lds + L2_G2);
    LAS unsigned char* ex = lds + L2_EX; LAS float* ssx = (LAS float*)(lds + L2_SS);
    const int fr = lane & 15, qd = lane >> 4, tg = wave >> 1, kh = wave & 1;
    __syncthreads();
    for (int i = tid; i < DM * NE; i += NTHR) { const int e = i & 15, c = i >> 4; const float v = router[i] * g2[c]; const unsigned h = f2bf(v);
        Whi[e * L2_WLD + c] = (bf16)h; Wlo[e * L2_WLD + c] = (bf16)f2bf(v - bf2f(h)); }
    for (int i = tid; i < DM; i += NTHR) g2s[i] = g2[i];
    for (int grp = bid; grp < NT / 64; grp += G) {
        const int tokb = grp * 64 + tg * 16, tok = tokb + fr;
        const u32x4_t* xp = (const u32x4_t*)(x1 + (size_t)tok * DM + kh * 512 + 16 * qd);
        u32x4_t xa[8][2];
#pragma unroll
        for (int p = 0; p < 8; ++p) { xa[p][0] = xp[8 * p]; xa[p][1] = xp[8 * p + 1]; }
        __syncthreads();
        f32x4 acc = (f32x4){0.f, 0.f, 0.f, 0.f}; float ss = 0.f;
#pragma unroll
        for (int p = 0; p < 8; ++p)
#pragma unroll
            for (int hf = 0; hf < 2; ++hf) { const int c = kh * 512 + 64 * p + 16 * qd + 8 * hf;
                const bf16x8_t a = __builtin_bit_cast(bf16x8_t, xa[p][hf]);
                const bf16x8_t bh = *(const LAS bf16x8_t*)(Whi + fr * L2_WLD + c), bl = *(const LAS bf16x8_t*)(Wlo + fr * L2_WLD + c);
                acc = MFMA16(a, bh, acc); acc = MFMA16(a, bl, acc);
#pragma unroll
                for (int e = 0; e < 4; ++e) { const float lo = __uint_as_float(xa[p][hf][e] << 16), hi = __uint_as_float(xa[p][hf][e] & 0xffff0000u); ss += lo * lo + hi * hi; } }
        ss += __shfl_xor(ss, 16); ss += __shfl_xor(ss, 32);
        *(LAS f32x4*)(ex + wave * 1024 + lane * 16) = acc; if (qd == 0) ssx[wave * 16 + fr] = ss;
        __syncthreads();
        { const f32x4 oth = *(const LAS f32x4*)(ex + (wave ^ 1) * 1024 + lane * 16); acc += oth; ss += ssx[(wave ^ 1) * 16 + fr]; }
        const float rs = rsqrtf(ss * (1.f / DM) + RMS_EPS);
        unsigned char* hrow = hb + (size_t)tok * DM + kh * 512 + 16 * qd; const float rsc = rs * F8_HSC;
#pragma unroll
        for (int p = 0; p < 8; ++p) { const LAS f32x4* gp = (const LAS f32x4*)(g2s + kh * 512 + 64 * p + 16 * qd); u32x4_t o;
#pragma unroll
            for (int q = 0; q < 4; ++q) { const f32x4 g = gp[q]; const unsigned u0 = xa[p][q >> 1][2 * (q & 1)], u1 = xa[p][q >> 1][2 * (q & 1) + 1];
                o[q] = pk4_fp8(__uint_as_float(u0 << 16) * rsc * g[0], __uint_as_float(u0 & 0xffff0000u) * rsc * g[1], __uint_as_float(u1 << 16) * rsc * g[2], __uint_as_float(u1 & 0xffff0000u) * rsc * g[3]); }
            *(u32x4_t*)(hrow + 64 * p) = o; }
        if (kh == 0) { f32x4 af;
#pragma unroll
            for (int r = 0; r < 4; ++r) { const float lg = acc[r] * __shfl(rs, 4 * qd + r); float mx = lg;
#pragma unroll
                for (int o = 1; o < 16; o <<= 1) mx = fmaxf(mx, __shfl_xor(mx, o));
                const float ev = expf(lg - mx); float sm = ev;
#pragma unroll
                for (int o = 1; o < 16; o <<= 1) sm += __shfl_xor(sm, o);
                af[r] = ev / sm; }
            *(f32x4*)(aff + ((size_t)(tokb / SEQ) * NE + fr) * SEQ + (tokb % SEQ) + 4 * qd) = af; }
    }
    __syncthreads();
}

constexpr int PH_PER_LAYER = 10, NPH = 1 + NL * PH_PER_LAYER + 1;
#ifndef MK_ONE_LAUNCH
#define MK_ONE_LAUNCH 1
#endif

#ifndef MK_DUP
#define MK_DUP 0
#endif
constexpr int P0_END = NL * 16 * 64 + NL * 16 * 16 + NL * NE * 3 * 8 * 44, P0_SPLIT = P0_END - 0;
template <int l> DI void run_layer(const Args& A, LAS unsigned char* lds, const XcdBarrier& bar, int lo, int hi, int G, int bid, int tid, int lane, int wave, int gw, int ngw, int gtid, int nthr) {
#define IN(k) (lo <= (k) && (k) < hi)
#define SEAM(k) do { if (IN(k) && IN((k) + 1)) xcd_barrier(bar); } while (0)
#define PH(k, ...) do { if (IN(pb + (k))) { { __VA_ARGS__ } if ((MK_DUP >> (k)) & 1) { xcd_barrier(bar); { __VA_ARGS__ } } } SEAM(pb + (k)); } while (0)
    const int pb = 1 + l * PH_PER_LAYER;
    PH(0, phase_ln1(A, l, gw, ngw, lane););
    PH(1,
        pg8::Gemm g{(const bf16*)(A.ws + WS_HB), (const bf16*)(A.ws + WS_WTIN) + (size_t)l * ZLD * DM, NT, ZLD, DM};
        pg8::StaticOrder S; S.init(NT, ZLD, G, bid);
        pg8::EpiBf16<0> E{(bf16*)(A.ws + WS_Z), ZLD, nullptr, 0, 0, 1.f};
        pg8::gemm_phase<pg8::EpiBf16<0>, pg8::StaticOrder, true, true>(lds, g, S, E););
    PH(2, phase_attn(A, lds, 0, G > ATT_SCAN_BLK0 ? ATT_SPLIT : ATT_UNITS, bid, G, tid, wave, lane); phase_rwkv_r1(A, l, lds, bid, G, tid, wave, lane); if ((MK_DUP >> 13) & 1) phase_rwkv_r1(A, l, lds, bid, G, tid, wave, lane);
          phase_mlstm_m1(A, l, lds, bid, G, tid, wave, lane); if ((MK_DUP >> 16) & 1) phase_mlstm_m1(A, l, lds, bid, G, tid, wave, lane););
    PH(3, if (l == 0 && P0_SPLIT < P0_END) { const int nb = G > 160 ? G - 160 : G, b0 = G > 160 ? bid - 160 : bid; if (b0 >= 0) { __syncthreads(); phase_p0(A, lds, P0_SPLIT, P0_END, b0 * NWAVES + wave, nb * NWAVES, wave, lane); __syncthreads(); } }
          if (G > ATT_SCAN_BLK0 && bid >= ATT_SCAN_BLK0) phase_attn(A, lds, ATT_SPLIT, ATT_UNITS, bid - ATT_SCAN_BLK0, G - ATT_SCAN_BLK0, tid, wave, lane);
          for (int rep = 0; rep < 1 + ((MK_DUP >> 14) & 1); ++rep) for (int u = bid; u < 96; u += G) rwkv_r2_unit(A, lds, u, tid, wave, lane);
          for (int rep = 0; rep < 1 + ((MK_DUP >> 15) & 1); ++rep) for (int u = bid; u < 96 + 64; u += G) { if (u >= 96) mlstm_m2_unit(A, lds, u - 96, tid, wave, lane); });
    PH(4, phase_yasm(A, l, lds, gw, ngw, tid, lane););
    PH(5,
        pg8::Gemm g{(const bf16*)(A.ws + WS_HB), (const bf16*)(A.ws + WS_WTOUT) + (size_t)l * DM * DM, NT, DM, DM};
        pg8::StaticOrder S; S.init(NT, DM, G, bid);
        EpiResT<(l > 0)> E{(l == 0) ? (const void*)A.in[I_X] : (const void*)(A.ws + WS_X2), (bf16*)(A.ws + WS_X1), DM};
        pg8::gemm_phase<EpiResT<(l > 0)>, pg8::StaticOrder, true, true>(lds, g, S, E););
    PH(6, phase_ln2(A, l, lds, bid, G, tid, wave, lane););
    PH(7, phase_topk(A, lds, bid, G, tid, wave, lane););
    PH(8,
        pg8::Gemm g{(const bf16*)(A.ws + WS_XG), (const bf16*)(A.ws + WS_W13T + (size_t)l * NE * 5632 * DM), NSLOT, NE * 5632, DM / 2};
        GroupOrder S; S.init(22, G, bid);
        EpiSwiGLU E{A.ws + WS_ACT, 22};
        pg8::gemm_phase<EpiSwiGLU, GroupOrder, true, true, true>(lds, g, S, E););
    PH(9,
        pg8::Gemm g{(const bf16*)(A.ws + WS_ACT), (const bf16*)(A.ws + WS_W2T + (size_t)l * NE * DM * FF), NSLOT, NE * DM, FF / 2};
        GroupOrder S; S.init(4, G, bid);
        EpiGate E{(bf16*)(A.ws + WS_YS), (const float*)(A.ws + WS_GATE)};
        pg8::gemm_phase<EpiGate, GroupOrder, true, true, true>(lds, g, S, E););
#undef PH
#undef IN
#undef SEAM
}

__global__ void __launch_bounds__(NTHR, 2) mk_fwd(Args A) {
    extern __shared__ __attribute__((aligned(16))) unsigned char lds_raw[];
    LAS unsigned char* lds = (LAS unsigned char*)lds_raw;
    const int tid = threadIdx.x, lane = tid & 63, wave = __builtin_amdgcn_readfirstlane(tid >> 6);
    const int G = gridDim.x, bid = blockIdx.x;
    const int gw = bid * NWAVES + wave, ngw = G * NWAVES, gtid = bid * NTHR + tid, nthr = G * NTHR;
    volatile LAS unsigned* MISC = (volatile LAS unsigned*)(lds + MISC_OFF);
    if (tid < 64) MISC[tid] = 0u;
    __syncthreads();
    const int lo = A.ph_lo, hi = A.ph_hi;
    const bool use_bar = (hi - lo) > 1;
    XcdBarrier bar; bar.bar = (unsigned*)(A.ws + WS_CTL) + CW_BAR; bar.x = 0; bar.st = MISC + 8;
    if (use_bar) bar = xcd_barrier_post((unsigned*)(A.ws + WS_CTL) + CW_BAR, MISC + 8);
#define IN(k) (lo <= (k) && (k) < hi)
#define SEAM(k) do { if (IN(k) && IN((k) + 1)) xcd_barrier(bar); } while (0)

    if (IN(0)) { phase_p0(A, lds, 0, P0_SPLIT, gw, ngw, wave, lane); if ((MK_DUP >> 10) & 1) { xcd_barrier(bar); phase_p0(A, lds, 0, P0_SPLIT, gw, ngw, wave, lane); } } SEAM(0);

    run_layer<0>(A, lds, bar, lo, hi, G, bid, tid, lane, wave, gw, ngw, gtid, nthr);
    run_layer<1>(A, lds, bar, lo, hi, G, bid, tid, lane, wave, gw, ngw, gtid, nthr);
    if (IN(NPH - 1)) { phase_final(A, gw, ngw, lane); if ((MK_DUP >> 11) & 1) { xcd_barrier(bar); phase_final(A, gw, ngw, lane); } }
#undef IN
#undef SEAM
}
}

extern "C" void kernel_launch(void* const* d_in, const int* in_sizes, int n_in, void* d_out, int out_size, void* d_ws, size_t ws_size, hipStream_t stream) {
    using namespace mk;
    static int grid = 0;
    if (grid == 0) {
        if (n_in != N_IN || out_size != NT * DM || ws_size < WS_END) { fprintf(stderr, "kernel_launch: unexpected shapes (n_in %d, out %d, ws %zu < %zu)\n", n_in, out_size, ws_size, (size_t)WS_END); grid = -1; return; }
        int dev = 0, cus = 0, per_cu = 0;
        if (hipGetDevice(&dev) != hipSuccess || hipDeviceGetAttribute(&cus, hipDeviceAttributeMultiprocessorCount, dev) != hipSuccess) { grid = -1; return; }
        if (hipFuncSetAttribute((const void*)mk_fwd, hipFuncAttributeMaxDynamicSharedMemorySize, LDS_BYTES) != hipSuccess) { fprintf(stderr, "kernel_launch: hipFuncSetAttribute failed\n"); grid = -1; return; }
        if (hipOccupancyMaxActiveBlocksPerMultiprocessor(&per_cu, (const void*)mk_fwd, NTHR, LDS_BYTES) != hipSuccess || per_cu < 1) fprintf(stderr, "kernel_launch: occupancy query reports %d\n", per_cu);
        (void)hipGetLastError();
        grid = cus;
    }
    if (grid < 0) return;
    hipMemsetAsync((char*)d_ws + WS_CTL, 0, CTL_ZERO_BYTES, stream);
    Args a{};
    for (int i = 0; i < N_IN; ++i) a.in[i] = (const float*)d_in[i];
    a.out = (float*)d_out; a.ws = (unsigned char*)d_ws;
#if MK_ONE_LAUNCH
    a.ph_lo = 0; a.ph_hi = NPH;
    hipLaunchKernelGGL(mk_fwd, dim3(grid), dim3(NTHR), LDS_BYTES, stream, a);
#else
    for (int p = 0; p < NPH; ++p) { a.ph_lo = p; a.ph_hi = p + 1; hipLaunchKernelGGL(mk_fwd, dim3(grid), dim3(NTHR), LDS_BYTES, stream, a); }
#endif
}
```

```cpp
#include <hip/hip_runtime.h>
#include <cstdio>
#include <cstdint>
namespace pg8 {
#define PG8_LAS __attribute__((address_space(3)))
typedef unsigned short bf16_t;
typedef short bf16x8 __attribute__((ext_vector_type(8)));
typedef float f32x4 __attribute__((ext_vector_type(4)));
typedef unsigned u32x4 __attribute__((ext_vector_type(4)));
constexpr int BM = 256, BK = 64, HALF = 128, HTB = HALF * BK * 2  , STAGE_BYTES = 8 * HTB, NXCD = 8, WGM = 8;

__host__ __device__ __forceinline__ int lds_byte(int r, int c) { const int st = (r >> 4) * 2 + (c >> 5), rr = r & 15, cc = c & 31, ob = rr * 64 + cc * 2; return st * 1024 + (ob ^ (((ob >> 9) & 1) << 5)); }
__host__ __device__ __forceinline__ void stage_rc(int b, int& R, int& C) { const int st = b / 1024, sb = b % 1024, swz = sb ^ (((sb >> 9) & 1) << 5); R = (st >> 1) * 16 + swz / 64; C = (st & 1) * 32 + (swz % 64) / 2; }
__host__ __device__ __forceinline__ int perm32(int rho) { const int n = rho >> 4, i = rho & 15; return 8 * (i >> 2) + 4 * n + (i & 3); }

struct Unit { int pm, pn; };
struct Gemm { const bf16_t* A; const bf16_t* Bt; int M, N, K; };

struct StaticOrder {
    int nM, nN, nwg, G, c;
    __host__ __device__ void init(int M, int N, int G_, int c_) { nM = M / BM; nN = N / BM; nwg = nM * nN; G = G_; c = c_; }
    __host__ __device__ bool next(int i, Unit& u) const {
        const long L = (long)i * G + c; if (L >= nwg) return false;
        int wgid = (int)L; { const int q = nwg / NXCD, r = nwg % NXCD, xcd = wgid % NXCD, off = wgid / NXCD; wgid = (xcd < r ? xcd * (q + 1) : r * (q + 1) + (xcd - r) * q) + off; }
        const int nig = WGM * nN, gid = wgid / nig, fm = gid * WGM, gsz = (nM - fm) < WGM ? (nM - fm) : WGM;
        u.pm = fm + ((wgid % nig) % gsz); u.pn = (wgid % nig) / gsz; return true;
    }
    __device__ __forceinline__ void a_ready(const Unit&) const {}
    __device__ __forceinline__ void done(const Unit&) const {}
};

__device__ __forceinline__ unsigned cvt_pk_bf16(float lo, float hi) { unsigned r; asm volatile("v_cvt_pk_bf16_f32 %0, %1, %2" : "=v"(r) : "v"(lo), "v"(hi)); return r; }
typedef float f32x2 __attribute__((ext_vector_type(2)));
__device__ __forceinline__ f32x2 gelu_pk(f32x2 v) {
    const f32x2 av = __builtin_elementwise_abs(v), d = av * 0.2316418882f + 1.0f;
    f32x2 t; t.x = __builtin_amdgcn_rcpf(d.x); t.y = __builtin_amdgcn_rcpf(d.y);
    f32x2 q = t * 0.5307027145f + (-0.7265760135f); q = q * t + 0.7107068705f; q = q * t + (-0.142248368f); q = q * t + 0.127414796f; q = q * t;
    const f32x2 s = (v * v) * (-0.72134752044f);
    f32x2 e; e.x = __builtin_amdgcn_exp2f(s.x); e.y = __builtin_amdgcn_exp2f(s.y);
    const f32x2 m = v * (q * e), r = v - m;
    f32x2 o; o.x = v.x < 0.f ? m.x : r.x; o.y = v.y < 0.f ? m.y : r.y; return o;
}

template <int ACT  > struct EpiBf16 {
    static constexpr bool PERM = true, AFTER_DRAIN = false; static_assert(ACT == 0 || ACT == 1, "EpiBf16: ACT is 0 (none) or 1 (gelu_pk)");
    bf16_t* O; int ldc; const float* bias; int split_cols; size_t split_stride; float scale0;
    __device__ __forceinline__ void operator()(const f32x4 (&acc)[2][2][4][2], const Unit& u, int wr, int wc, int fr, int fq) const {
        const int row0 = u.pm * BM + wr * 64 + fr; int colt = u.pn * BM; bf16_t* base = O;
        float sc = 1.f; if (split_cols) { const int t = colt / split_cols; base += (size_t)t * split_stride; colt -= t * split_cols; if (t == 0) sc = scale0; }
        const int col0 = colt + wc * 32 + 8 * fq, bcol0 = u.pn * BM + wc * 32 + 8 * fq;
        f32x4 bv[2][2];
#pragma unroll
        for (int bj = 0; bj < 2; ++bj)
#pragma unroll
            for (int n = 0; n < 2; ++n) bv[bj][n] = bias ? *(const f32x4*)(bias + bcol0 + bj * HALF + 4 * n) : (f32x4){0.f, 0.f, 0.f, 0.f};
#pragma unroll
        for (int ai = 0; ai < 2; ++ai)
#pragma unroll
            for (int m = 0; m < 4; ++m) { bf16_t* rowp = base + (size_t)(row0 + ai * HALF + m * 16) * ldc + col0;
#pragma unroll
                for (int bj = 0; bj < 2; ++bj) { f32x4 v0 = acc[ai][bj][m][0] + bv[bj][0], v1 = acc[ai][bj][m][1] + bv[bj][1];
                    if (ACT == 1) { f32x2 a = gelu_pk((f32x2){v0[0], v0[1]}), b = gelu_pk((f32x2){v0[2], v0[3]}), c = gelu_pk((f32x2){v1[0], v1[1]}), d = gelu_pk((f32x2){v1[2], v1[3]});
                        v0 = (f32x4){a.x, a.y, b.x, b.y}; v1 = (f32x4){c.x, c.y, d.x, d.y}; }
                    v0 = v0 * sc; v1 = v1 * sc; u32x4 w; w.x = cvt_pk_bf16(v0[0], v0[1]); w.y = cvt_pk_bf16(v0[2], v0[3]); w.z = cvt_pk_bf16(v1[0], v1[1]); w.w = cvt_pk_bf16(v1[2], v1[3]);
                    *(u32x4*)(rowp + bj * HALF) = w; } }
    }
};
template <class Epi, class Sched, bool ALIGN_EPI = false, bool SP2 = false, bool F8 = false>
__device__ __forceinline__ void gemm_phase(PG8_LAS unsigned char* lds, const Gemm g, const Sched& S, const Epi& E) {
    const int tid = threadIdx.x, wid = __builtin_amdgcn_readfirstlane(tid >> 6), lane = tid & 63, wr = wid >> 2, wc = wid & 3, fr = lane & 15, fq = lane >> 4;
    int Kq = g.K; if constexpr (F8) asm volatile("" : "+s"(Kq));
    const int K = Kq, nt = K / BK;
    unsigned voffA[2], voffB[2];
#pragma unroll
    for (int i = 0; i < 2; ++i) { int R, C; stage_rc(tid * 16 + i * 8192, R, C); const int Rb = Epi::PERM ? ((R & ~31) + perm32(R & 31)) : R;
        voffA[i] = (unsigned)(R * K + C) * 2u; voffB[i] = (unsigned)(Rb * K + C) * 2u; }
    const size_t kstep = (size_t)(BK * 2);
    const size_t hstep = (size_t)HALF * K * 2;
    const size_t tstep = 2 * hstep;
    const unsigned ldsw = (unsigned)wid * 1024u;
    const int aoff = lds_byte(wr * 64 + fr, fq * 8), boff = lds_byte(wc * 32 + fr, fq * 8);
#define PG8_SA(b, h) (((b) * 2 + (h)) * HTB)
#define PG8_SB(b, h) ((4 + (b) * 2 + (h)) * HTB)
#define PG8_STAGE(bufoff, gbase, voff) do { _Pragma("unroll") for (int _i = 0; _i < 2; ++_i) \
        __builtin_amdgcn_global_load_lds((const unsigned*)((const char*)(gbase) + (voff)[_i]), (PG8_LAS unsigned*)(lds + (bufoff) + ldsw + _i * 8192), 16, 0, 0); } while (0)
#define PG8_LDA(dst, b, h) do { _Pragma("unroll") for (int m = 0; m < 4; ++m) { if constexpr (F8) { const i32x4_ lo_ = *(const PG8_LAS i32x4_*)(lds + PG8_SA(b, h) + aoff + m * 2048), hi_ = *(const PG8_LAS i32x4_*)(lds + PG8_SA(b, h) + aoff + m * 2048 + 1024); dst##8[m] = __builtin_shufflevector(lo_, hi_, 0, 1, 2, 3, 4, 5, 6, 7); } \
        else { _Pragma("unroll") for (int k = 0; k < 2; ++k) dst[m][k] = *(const PG8_LAS bf16x8*)(lds + PG8_SA(b, h) + aoff + m * 2048 + k * 1024); } } } while (0)
#define PG8_LDB(dst, b, h) do { _Pragma("unroll") for (int n = 0; n < 2; ++n) { if constexpr (F8) { const i32x4_ lo_ = *(const PG8_LAS i32x4_*)(lds + PG8_SB(b, h) + boff + n * 2048), hi_ = *(const PG8_LAS i32x4_*)(lds + PG8_SB(b, h) + boff + n * 2048 + 1024); dst##8[n] = __builtin_shufflevector(lo_, hi_, 0, 1, 2, 3, 4, 5, 6, 7); } \
        else { _Pragma("unroll") for (int k = 0; k < 2; ++k) dst[n][k] = *(const PG8_LAS bf16x8*)(lds + PG8_SB(b, h) + boff + n * 2048 + k * 1024); } } } while (0)
#define PG8_MMA(ai, bj, At, Bt) do { __builtin_amdgcn_s_setprio(1); _Pragma("unroll") for (int m = 0; m < 4; ++m) _Pragma("unroll") for (int n = 0; n < 2; ++n) { \
        if constexpr (F8) asm volatile("v_mfma_scale_f32_16x16x128_f8f6f4 %0, %1, %2, %0, %3, %3 op_sel_hi:[0,0,0]" : "+v"(acc[ai][bj][m][n]) : "v"(Bt##8[n]), "v"(At##8[m]), "v"(f8scale)); \
        else { _Pragma("unroll") for (int k = 0; k < 2; ++k) acc[ai][bj][m][n] = __builtin_amdgcn_mfma_f32_16x16x32_bf16(Bt[n][k], At[m][k], acc[ai][bj][m][n], 0, 0, 0); } } \
        __builtin_amdgcn_s_setprio(0); } while (0)
#define PG8_WAIT_V(n) asm volatile("s_waitcnt vmcnt(" #n ")" ::: "memory")
#define PG8_WAIT_L(n) asm volatile("s_waitcnt lgkmcnt(" #n ")" ::: "memory")
#define PG8_BAR __builtin_amdgcn_s_barrier()
#define PG8_SCHED __builtin_amdgcn_sched_barrier(0)
    Unit cur, nxt; int ui = 0;
    if (!S.next(0, cur)) return;
    f32x4 acc[2][2][4][2];
#pragma unroll
    for (int a = 0; a < 2; ++a)
#pragma unroll
        for (int b = 0; b < 2; ++b)
#pragma unroll
            for (int m = 0; m < 4; ++m)
#pragma unroll
                for (int n = 0; n < 2; ++n) { acc[a][b][m][n] = (f32x4){0.f, 0.f, 0.f, 0.f}; if constexpr (F8) asm volatile("" : "+v"(acc[a][b][m][n])); }
    bf16x8 At[4][2], B0[2][2], B1[2][2];
    typedef int i32x4_ __attribute__((ext_vector_type(4))); typedef int i32x8_ __attribute__((ext_vector_type(8)));
    i32x8_ At8[4], B08[2], B18[2];
    int f8scale = 0x7f7f7f7f; asm volatile("" : "+v"(f8scale));
    const char* cA = (const char*)g.A + (size_t)cur.pm * tstep; const char* cB = (const char*)g.Bt + (size_t)cur.pn * tstep;
    S.a_ready(cur);
    if constexpr (SP2) {
        PG8_STAGE(PG8_SB(0, 0), cB, voffB); PG8_STAGE(PG8_SB(0, 1), cB + hstep, voffB); PG8_STAGE(PG8_SA(0, 0), cA, voffA); PG8_STAGE(PG8_SA(0, 1), cA + hstep, voffA);
        if (wr == 1) PG8_BAR;
        PG8_WAIT_V(2); PG8_BAR;
        PG8_STAGE(PG8_SB(1, 0), cB + kstep, voffB); PG8_STAGE(PG8_SA(1, 0), cA + kstep, voffA); PG8_STAGE(PG8_SB(1, 1), cB + hstep + kstep, voffB);
        PG8_WAIT_V(6); PG8_BAR;
    } else {
        PG8_STAGE(PG8_SB(0, 0), cB, voffB); PG8_STAGE(PG8_SA(0, 0), cA, voffA); PG8_STAGE(PG8_SB(0, 1), cB + hstep, voffB); PG8_STAGE(PG8_SA(0, 1), cA + hstep, voffA);
        if (wr == 1) PG8_BAR;
        PG8_WAIT_V(4); PG8_BAR;
        PG8_STAGE(PG8_SB(1, 0), cB + kstep, voffB); PG8_STAGE(PG8_SA(1, 0), cA + kstep, voffA); PG8_STAGE(PG8_SB(1, 1), cB + hstep + kstep, voffB);
        PG8_WAIT_V(6); PG8_BAR;
    }
    for (;;) {
        const bool has_next = S.next(ui + 1, nxt);
        const char* nA = has_next ? (const char*)g.A + (size_t)nxt.pm * tstep : cA; const char* nB = has_next ? (const char*)g.Bt + (size_t)nxt.pn * tstep : cB;
        for (int t = 0; t < nt; t += 2) {
            const bool last = (t == nt - 2);
            const char* a1 = cA + (size_t)(t + 1) * kstep;
            const char* a2 = last ? nA : cA + (size_t)(t + 2) * kstep; const char* b2 = last ? nB : cB + (size_t)(t + 2) * kstep;
            const char* a3 = a2 + kstep; const char* b3 = b2 + kstep;
            if (last && has_next) S.a_ready(nxt);
            if constexpr (SP2) {
            PG8_LDB(B0, 0, 0); PG8_LDB(B1, 0, 1); PG8_SCHED; PG8_LDA(At, 0, 0); PG8_STAGE(PG8_SA(1, 1), a1 + hstep, voffA);
            PG8_WAIT_V(8); PG8_WAIT_L(0); PG8_BAR; PG8_MMA(0, 0, At, B0); PG8_MMA(0, 1, At, B1); PG8_BAR; PG8_SCHED;
            PG8_LDA(At, 0, 1); PG8_STAGE(PG8_SB(0, 0), b2, voffB); PG8_STAGE(PG8_SB(0, 1), b2 + hstep, voffB); PG8_STAGE(PG8_SA(0, 0), a2, voffA);
            PG8_WAIT_V(8); PG8_WAIT_L(0); PG8_BAR; PG8_MMA(1, 0, At, B0); PG8_MMA(1, 1, At, B1); PG8_BAR; PG8_SCHED;
            PG8_LDB(B0, 1, 0); PG8_LDB(B1, 1, 1); PG8_SCHED; PG8_LDA(At, 1, 0); PG8_STAGE(PG8_SA(0, 1), a2 + hstep, voffA);
            PG8_WAIT_V(8); PG8_WAIT_L(0); PG8_BAR; PG8_MMA(0, 0, At, B0); PG8_MMA(0, 1, At, B1); PG8_BAR; PG8_SCHED;
            PG8_LDA(At, 1, 1); PG8_STAGE(PG8_SB(1, 0), b3, voffB); PG8_STAGE(PG8_SB(1, 1), b3 + hstep, voffB); PG8_STAGE(PG8_SA(1, 0), a3, voffA);
            PG8_WAIT_V(8); PG8_WAIT_L(0); PG8_BAR; PG8_MMA(1, 0, At, B0); PG8_MMA(1, 1, At, B1); PG8_BAR; PG8_SCHED;
            } else {
            PG8_LDB(B0, 0, 0); PG8_SCHED; PG8_LDA(At, 0, 0); PG8_STAGE(PG8_SA(1, 1), a1 + hstep, voffA);
            PG8_WAIT_L(8); PG8_BAR; PG8_WAIT_L(0); PG8_MMA(0, 0, At, B0); PG8_BAR; PG8_SCHED;
            PG8_LDB(B1, 0, 1); PG8_STAGE(PG8_SB(0, 0), b2, voffB);
            PG8_BAR; PG8_WAIT_L(0); PG8_MMA(0, 1, At, B1); PG8_BAR;
            PG8_LDA(At, 0, 1); PG8_STAGE(PG8_SA(0, 0), a2, voffA);
            PG8_BAR; PG8_WAIT_L(0); PG8_MMA(1, 0, At, B0); PG8_BAR; PG8_SCHED;
            PG8_STAGE(PG8_SB(0, 1), b2 + hstep, voffB);
            PG8_WAIT_V(6); PG8_BAR; PG8_MMA(1, 1, At, B1); PG8_BAR;
            PG8_LDB(B0, 1, 0); PG8_SCHED; PG8_LDA(At, 1, 0); PG8_STAGE(PG8_SA(0, 1), a2 + hstep, voffA);
            PG8_WAIT_L(8); PG8_BAR; PG8_WAIT_L(0); PG8_MMA(0, 0, At, B0); PG8_BAR; PG8_SCHED;
            PG8_LDB(B1, 1, 1); PG8_STAGE(PG8_SB(1, 0), b3, voffB);
            PG8_BAR; PG8_WAIT_L(0); PG8_MMA(0, 1, At, B1); PG8_BAR;
            PG8_LDA(At, 1, 1); PG8_STAGE(PG8_SA(1, 0), a3, voffA);
            PG8_BAR; PG8_WAIT_L(0); PG8_MMA(1, 0, At, B0); PG8_BAR; PG8_SCHED;
            PG8_STAGE(PG8_SB(1, 1), b3 + hstep, voffB);
            PG8_WAIT_V(6); PG8_BAR; PG8_MMA(1, 1, At, B1); PG8_BAR;
            }
        }
        if constexpr (F8) asm volatile("s_nop 15\n\ts_nop 15" ::: "memory");
        if constexpr (ALIGN_EPI) { if (wr == 0) PG8_BAR; }
        if constexpr (!Epi::AFTER_DRAIN) { E(acc, cur, wr, wc, fr, fq); S.done(cur); }
        if (!has_next) break;
#pragma unroll
        for (int a = 0; a < 2; ++a)
#pragma unroll
            for (int b = 0; b < 2; ++b)
#pragma unroll
                for (int m = 0; m < 4; ++m)
#pragma unroll
                    for (int n = 0; n < 2; ++n) { acc[a][b][m][n] = (f32x4){0.f, 0.f, 0.f, 0.f}; if constexpr (F8) asm volatile("" : "+v"(acc[a][b][m][n])); }
        cur = nxt; cA = nA; cB = nB; ++ui;
        if constexpr (ALIGN_EPI) { if (wr == 1) PG8_BAR; }
    }
    PG8_WAIT_V(0);
    if constexpr (!ALIGN_EPI) { if (wr == 0) PG8_BAR; }
    PG8_BAR;
    if constexpr (Epi::AFTER_DRAIN) { E.fused(acc, cur, wr, wc, fr, fq, lds, wid, lane); S.done(cur); }
#undef PG8_SA
#undef PG8_SB
#undef PG8_STAGE
#undef PG8_LDA
#undef PG8_LDB
#undef PG8_MMA
#undef PG8_WAIT_V
#undef PG8_WAIT_L
#undef PG8_BAR
#undef PG8_SCHED
}
}
#define LAS __attribute__((address_space(3)))
#define XB_TMO      128
#define XB_XCNT(j)  (256  + 64 * (j))
#define XB_XSUB(j)  (1280 + 64 * (j))
#define XB_XGEN(j)  (2304 + 64 * (j))
#define XB_TOP      3328
#define XB_TOPGEN   3392
#define XCD_BAR_WORDS 3456
#define XB_SPIN_CAP (1u << 18)

__device__ __forceinline__ unsigned xb_ld(unsigned* p)              { return __hip_atomic_load(p, __ATOMIC_RELAXED, __HIP_MEMORY_SCOPE_AGENT); }
__device__ __forceinline__ unsigned xb_add(unsigned* p, unsigned v) { return __hip_atomic_fetch_add(p, v, __ATOMIC_RELAXED, __HIP_MEMORY_SCOPE_AGENT); }
__device__ __forceinline__ unsigned xb_xcc_id() { return (unsigned)__builtin_amdgcn_s_getreg((3 << 11) | 20) & 0xFu; }
#define XB_SPIN(cond, bar) do { unsigned _sp = 0; while (cond) { __builtin_amdgcn_s_sleep(1); \
    if ((++_sp & 255u) == 0u) { if (xb_ld(&(bar)[XB_TMO])) break; if (_sp > XB_SPIN_CAP) { atomicAdd(&(bar)[XB_TMO], 1u); break; } } } } while (0)

struct XcdBarrier {
    unsigned* bar; unsigned x;
    volatile LAS unsigned* st;
};

__device__ __forceinline__ XcdBarrier xcd_barrier_post(unsigned* bar, volatile LAS unsigned* st) {
    XcdBarrier b; b.bar = bar; b.x = xb_xcc_id(); b.st = st;
    if (threadIdx.x == 0) (void)xb_add(&bar[XB_XCNT(b.x)], 1u);
    return b;
}
__device__ __forceinline__ void xcd_barrier_complete(unsigned* bar, unsigned x, unsigned& nloc, unsigned& nx) {
    const unsigned G = gridDim.x * gridDim.y * gridDim.z;
    unsigned sum, cnt, mine, sp = 0u;
    for (;;) {
        sum = 0u; cnt = 0u; mine = 0u;
#pragma unroll
        for (unsigned j = 0; j < 16; ++j) { const unsigned c = xb_ld(&bar[XB_XCNT(j)]); sum += c; cnt += (c > 0u) ? 1u : 0u; mine = (j == x) ? c : mine; }
        if (sum == G) break;
        __builtin_amdgcn_s_sleep(1);
        if ((++sp & 255u) == 0u) { if (xb_ld(&bar[XB_TMO])) break; if (sp > XB_SPIN_CAP) { atomicAdd(&bar[XB_TMO], 1u); break; } }
    }
    nloc = mine > 0u ? mine : 1u; nx = cnt > 0u ? cnt : 1u;
}

__device__ __forceinline__ void xcd_barrier(const XcdBarrier& b) {
    asm volatile("s_waitcnt vmcnt(0)" ::: "memory");
    __syncthreads();
    if (threadIdx.x == 0) {
        unsigned* bar = b.bar;
        __builtin_amdgcn_s_waitcnt(0);
        unsigned nloc = b.st[0], nx = b.st[1];
        if (nloc == 0u) { xcd_barrier_complete(bar, b.x, nloc, nx); b.st[0] = nloc; b.st[1] = nx; }
        const unsigned old = xb_add(&bar[XB_XSUB(b.x)], 1u);
        const unsigned gen = old / nloc;
        if (old + 1u == (gen + 1u) * nloc) {
            __builtin_amdgcn_fence(__ATOMIC_RELEASE, "agent");
            asm volatile("s_waitcnt vmcnt(0)" ::: "memory");
            const unsigned og = xb_add(&bar[XB_TOP], 1u);
            const unsigned tg = og / nx;
            if (og + 1u == (tg + 1u) * nx) xb_add(&bar[XB_TOPGEN], 1u);
            else XB_SPIN(xb_ld(&bar[XB_TOPGEN]) == tg, bar);
            __builtin_amdgcn_fence(__ATOMIC_ACQUIRE, "agent");
            xb_add(&bar[XB_XGEN(b.x)], 1u);
            asm volatile("s_waitcnt vmcnt(0)" ::: "memory");
        } else {
            XB_SPIN(xb_ld(&bar[XB_XGEN(b.x)]) == gen, bar);
            __builtin_amdgcn_fence(__ATOMIC_ACQUIRE, "agent");
            asm volatile("s_waitcnt vmcnt(0)" ::: "memory");
        }
    }
    __syncthreads();
}

#define DI __device__ __forceinline__
#define LDS_WAIT() asm volatile("s_waitcnt lgkmcnt(0)" ::: "memory")
typedef unsigned short bf16;
typedef float f32x4 __attribute__((ext_vector_type(4)));

namespace mk {
constexpr int NB = 8, SEQ = 2048, DM = 1024, NT = NB * SEQ, NL = 2;
constexpr int INW = 3856, ZLD = 4096;
constexpr int ZA = 0, ZRKV = 768, ZWDF = 1920, ZWDB = 1984, ZADF = 2048, ZADB = 2112, ZGD = 2176, ZMQK = 2304, ZMV = 3072, ZMO = 3456, ZMG = 3840;
constexpr int RW = 384, MW = 384, AW = 256;
constexpr int NE = 16, CAP = 256, FF = 2816, NSLOT = NB * NE * CAP;
constexpr int NWAVES = 8, NTHR = 512;
constexpr float RMS_EPS = 1e-6f;

enum { I_X = 0, I_RELB, I_LN1G, I_WIN, I_WOUT, I_MU, I_W0, I_W2, I_A0, I_A2, I_KK, I_KA, I_RK, I_G2, I_RLNG, I_RLNB,
       I_CW, I_CB, I_IB, I_FB, I_MLNG, I_LN2G, I_ROUTER, I_EW1, I_EW3, I_EW2, I_FG, N_IN };

constexpr size_t MiB = 1u << 20;
constexpr size_t WS_CTL = 0, CTL_ZERO_BYTES = 1 * MiB;
constexpr size_t WS_WTIN = 2 * MiB;
constexpr size_t WS_WTOUT = 18 * MiB;
constexpr size_t WS_W13T = 22 * MiB;
constexpr size_t WS_W2T = 374 * MiB;
constexpr size_t WS_X1 = 550 * MiB;
constexpr size_t WS_X2 = 614 * MiB;
constexpr size_t WS_HB = 678 * MiB;
constexpr size_t WS_AFF = 710 * MiB;
constexpr size_t WS_SEL = 711 * MiB;
constexpr size_t WS_GATE = 712 * MiB;
constexpr size_t WS_G2T = 713 * MiB;
constexpr size_t WS_LWT = 713 * MiB + 256 * 1024;
constexpr size_t WS_R = 714 * MiB;
constexpr size_t WS_Z = WS_R;
constexpr size_t WS_ATTO = WS_R + 128 * MiB;
constexpr size_t WS_ATTL = WS_R + 152 * MiB;
constexpr size_t WS_PR = WS_R + 154 * MiB;
constexpr size_t WS_RKY = WS_R + 442 * MiB;
constexpr size_t WS_RKB = WS_R + 490 * MiB;
constexpr size_t WS_MLQK = WS_R + 538 * MiB;
constexpr size_t WS_MLNUM = WS_R + 586 * MiB;
constexpr size_t WS_MLDEN = WS_R + 634 * MiB;
constexpr size_t WS_XG = WS_R;
constexpr size_t WS_ACT = WS_R + 64 * MiB;
constexpr size_t WS_YS = WS_R + 240 * MiB;
constexpr size_t WS_END = WS_R + 636 * MiB;

constexpr int CW_BAR = 4096;
constexpr int LDS_BYTES = 147456;
constexpr int MISC_OFF = LDS_BYTES - 256;

struct Args { const float* in[N_IN]; float* out; unsigned char* ws; int ph_lo, ph_hi; };

DI float bf2f(unsigned v) { return __uint_as_float(v << 16); }
DI unsigned f2bf(float f) { unsigned u = __float_as_uint(f); return (u + 0x7fffu + ((u >> 16) & 1u)) >> 16; }
DI unsigned pk2(float lo, float hi) { return f2bf(lo) | (f2bf(hi) << 16); }
DI float wave_sum(float v) {
#pragma unroll
    for (int o = 1; o < 64; o <<= 1) v += __shfl_xor(v, o);
    return v;
}
DI float sigm(float x) { return __builtin_amdgcn_rcpf(1.f + __expf(-x)); }
DI void unpack8(const uint4 w, float (&f)[8]) {
    f[0] = __uint_as_float(w.x << 16); f[1] = __uint_as_float(w.x & 0xffff0000u); f[2] = __uint_as_float(w.y << 16); f[3] = __uint_as_float(w.y & 0xffff0000u);
    f[4] = __uint_as_float(w.z << 16); f[5] = __uint_as_float(w.z & 0xffff0000u); f[6] = __uint_as_float(w.w << 16); f[7] = __uint_as_float(w.w & 0xffff0000u);
}

struct GroupOrder {
    int G, c2, nunits, per_e, nN;
    DI void init(int nN_, int G_, int bid) { nN = nN_; per_e = 8 * nN_; nunits = NE * per_e; G = G_; c2 = (G_ % 8 == 0) ? (bid % 8) * (G_ / 8) + bid / 8 : bid; }
    DI bool next(int i, pg8::Unit& u) const {
        const long L = (long)i * G + c2; if (L >= nunits) return false;
        const int e = (int)L / per_e, r = (int)L % per_e; u.pm = e * 8 + (r & 7); u.pn = e * nN + (r >> 3); return true;
    }
    DI void a_ready(const pg8::Unit&) const {}
    DI void done(const pg8::Unit&) const {}
};
DI unsigned pkbf(float lo, float hi) { typedef __bf16 b2 __attribute__((ext_vector_type(2))); typedef float f2 __attribute__((ext_vector_type(2))); const f2 v = {lo, hi}; return __builtin_bit_cast(unsigned, __builtin_convertvector(v, b2)); }
template <bool BASE_BF16>
struct EpiResT {
    static constexpr bool PERM = false, AFTER_DRAIN = false;
    const void* base; bf16* out; int ldc;
    DI void operator()(const pg8::f32x4 (&acc)[2][2][4][2], const pg8::Unit& u, int wr, int wc, int fr, int fq) const {
        const int row0 = u.pm * 256 + wr * 64 + fr, col0 = u.pn * 256 + wc * 32 + 4 * fq;
#pragma unroll
        for (int ai = 0; ai < 2; ++ai)
#pragma unroll
            for (int m = 0; m < 4; ++m) { const size_t off = (size_t)(row0 + ai * 128 + m * 16) * ldc + col0;
#pragma unroll
                for (int bj = 0; bj < 2; ++bj)
#pragma unroll
                    for (int n = 0; n < 2; ++n) { pg8::f32x4 b;
                        if constexpr (BASE_BF16) { const uint2 w = *(const uint2*)((const bf16*)base + off + bj * 128 + n * 16);
                            b[0] = __uint_as_float(w.x << 16); b[1] = __uint_as_float(w.x & 0xffff0000u); b[2] = __uint_as_float(w.y << 16); b[3] = __uint_as_float(w.y & 0xffff0000u); }
                        else b = *(const pg8::f32x4*)((const float*)base + off + bj * 128 + n * 16);
                        b += acc[ai][bj][m][n]; uint2 o; o.x = pkbf(b[0], b[1]); o.y = pkbf(b[2], b[3]); *(uint2*)(out + off + bj * 128 + n * 16) = o; } }
    }
};
DI float silu_f(float x) { return x * __builtin_amdgcn_rcpf(1.f + __expf(-x)); }
DI float f8clamp(float x) { return __builtin_amdgcn_fmed3f(x, -448.f, 448.f); }
DI unsigned pk4_fp8(float a, float b, float c, float d) { unsigned p = 0u; p = __builtin_amdgcn_cvt_pk_fp8_f32(f8clamp(a), f8clamp(b), p, false); p = __builtin_amdgcn_cvt_pk_fp8_f32(f8clamp(c), f8clamp(d), p, true); return p; }
constexpr float F8_WSC = 64.f, F8_HSC = 8.f, F8_ASC = 16.f;
DI float swiglu8(float xa, float xg) {
    constexpr float sc = F8_HSC * F8_WSC, K1 = -1.4426950408889634f / sc, IK2 = sc * sc / F8_ASC;
    const float e = __builtin_amdgcn_exp2f(xa * K1);
    return (xa * xg) * __builtin_amdgcn_rcpf(__builtin_fmaf(e, IK2, IK2));
}
struct EpiSwiGLU {
    static constexpr bool PERM = true, AFTER_DRAIN = false;
    unsigned char* act; int nN;
    DI void operator()(const pg8::f32x4 (&acc)[2][2][4][2], const pg8::Unit& u, int wr, int wc, int fr, int fq) const {
        const int lpn = u.pn % nN; const int row0 = u.pm * 256 + wr * 64 + fr, col0 = lpn * 128 + wc * 32 + 8 * fq;
#pragma unroll
        for (int ai = 0; ai < 2; ++ai)
#pragma unroll
            for (int m = 0; m < 4; ++m) { unsigned char* p = act + (size_t)(row0 + ai * 128 + m * 16) * FF + col0;
                const pg8::f32x4 a0 = acc[ai][0][m][0], a1 = acc[ai][0][m][1], g0 = acc[ai][1][m][0], g1 = acc[ai][1][m][1];
                uint2 w; w.x = pk4_fp8(swiglu8(a0[0], g0[0]), swiglu8(a0[1], g0[1]), swiglu8(a0[2], g0[2]), swiglu8(a0[3], g0[3]));
                w.y = pk4_fp8(swiglu8(a1[0], g1[0]), swiglu8(a1[1], g1[1]), swiglu8(a1[2], g1[2]), swiglu8(a1[3], g1[3]));
                *(uint2*)p = w; }
    }
};
struct EpiGate {
    static constexpr bool PERM = true, AFTER_DRAIN = false;
    bf16* ys; const float* gate;
    DI void operator()(const pg8::f32x4 (&acc)[2][2][4][2], const pg8::Unit& u, int wr, int wc, int fr, int fq) const {
        const int row0 = u.pm * 256 + wr * 64 + fr, col0 = (u.pn & 3) * 256 + wc * 32 + 8 * fq;
#pragma unroll
        for (int ai = 0; ai < 2; ++ai)
#pragma unroll
            for (int m = 0; m < 4; ++m) { const int row = row0 + ai * 128 + m * 16; const float g = gate[row] * (1.f / (F8_ASC * F8_WSC)); bf16* p = ys + (size_t)row * DM + col0;
#pragma unroll
                for (int bj = 0; bj < 2; ++bj) { const pg8::f32x4 v0 = acc[ai][bj][m][0] * g, v1 = acc[ai][bj][m][1] * g; pg8::u32x4 w;
                    w.x = pg8::cvt_pk_bf16(v0[0], v0[1]); w.y = pg8::cvt_pk_bf16(v0[2], v0[3]); w.z = pg8::cvt_pk_bf16(v1[0], v1[1]); w.w = pg8::cvt_pk_bf16(v1[2], v1[3]);
                    *(pg8::u32x4*)(p + bj * 128) = w; } }
    }
};

DI void cvt_tile(const float* W, int N, int nvalid, int k0, int n0, bf16* dst, int Kd, size_t drow0, LAS float* scr, int lane) {
    const int c4 = (lane & 15) * 4, kr = lane >> 4;
#pragma unroll
    for (int it = 0; it < 16; ++it) { const int k = it * 4 + kr; float4 v = make_float4(0.f, 0.f, 0.f, 0.f);
        if (n0 + c4 < nvalid) v = *(const float4*)(W + (size_t)(k0 + k) * N + n0 + c4);
        LAS float* s = scr + k * 65 + c4; s[0] = v.x; s[1] = v.y; s[2] = v.z; s[3] = v.w; }
    LDS_WAIT(); asm volatile("" ::: "memory");
    const int c = lane & 7;
#pragma unroll
    for (int it = 0; it < 8; ++it) { const int n = it * 8 + (lane >> 3); const LAS float* s = scr + (8 * c) * 65 + n;
        uint4 o; o.x = pk2(s[0], s[65]); o.y = pk2(s[130], s[195]); o.z = pk2(s[260], s[325]); o.w = pk2(s[390], s[455]);
        *(uint4*)(dst + (drow0 + n) * (size_t)Kd + k0 + 8 * c) = o; }
    LDS_WAIT(); asm volatile("" ::: "memory");
}
DI void cvt_tile_fp8(const float* W, int N, int k0, int n0, unsigned char* dst, int Kd, size_t drow0, float sc, LAS unsigned char* scr, int lane) {
    const int nq = lane & 15, kq = lane >> 4;
#pragma unroll
    for (int hb = 0; hb < 2; ++hb) {
        f32x4 v[4][4];
#pragma unroll
        for (int it = 0; it < 4; ++it)
#pragma unroll
            for (int j = 0; j < 4; ++j) v[it][j] = __builtin_nontemporal_load((const f32x4*)(W + (size_t)(k0 + hb * 64 + it * 16 + kq * 4 + j) * N + n0 + 4 * nq));
#pragma unroll
        for (int it = 0; it < 4; ++it)
#pragma unroll
            for (int i = 0; i < 4; ++i) *(LAS unsigned*)(scr + (4 * nq + i) * 132 + hb * 64 + it * 16 + kq * 4) = pk4_fp8(v[it][0][i] * sc, v[it][1][i] * sc, v[it][2][i] * sc, v[it][3][i] * sc);
    }
    LDS_WAIT(); asm volatile("" ::: "memory");
    const int c = lane & 7;
#pragma unroll
    for (int it = 0; it < 8; ++it) { const int n = it * 8 + (lane >> 3); const LAS unsigned* s = (const LAS unsigned*)(scr + n * 132 + 16 * c);
        uint4 o; o.x = s[0]; o.y = s[1]; o.z = s[2]; o.w = s[3];
        *(uint4*)(dst + (drow0 + n) * (size_t)Kd + k0 + 16 * c) = o; }
    LDS_WAIT(); asm volatile("" ::: "memory");
}
DI void phase_p0(const Args& A, LAS unsigned char* lds, int it0, int it1, int gw, int ngw, int wave, int lane) {
    LAS float* scr = (LAS float*)(lds + wave * 16896);
    bf16* wtin = (bf16*)(A.ws + WS_WTIN); bf16* wtout = (bf16*)(A.ws + WS_WTOUT); unsigned char* w13 = A.ws + WS_W13T; unsigned char* w2t = A.ws + WS_W2T;
    constexpr int I_IN = NL * 16 * 64, I_OUT = NL * 16 * 16, I_E = 8 * 44, I_MOE = NL * NE * 3 * I_E;
    for (int it = it0 + gw; it < it1; it += ngw) {
        int r = it;
        if (r < I_IN) { const int l = r / 1024, t = r % 1024, kb = t / 64, nb = t % 64;
            cvt_tile(A.in[I_WIN] + (size_t)l * DM * INW, INW, INW, kb * 64, nb * 64, wtin + (size_t)l * ZLD * DM, DM, (size_t)nb * 64, scr, lane); continue; }
        r -= I_IN;
        if (r < I_OUT) { const int l = r / 256, t = r % 256, kb = t / 16, nb = t % 16;
            cvt_tile(A.in[I_WOUT] + (size_t)l * DM * DM, DM, DM, kb * 64, nb * 64, wtout + (size_t)l * DM * DM, DM, (size_t)nb * 64, scr, lane); continue; }
        r -= I_OUT;
        const int le = r / (3 * I_E), q = r % (3 * I_E), which = q / I_E, t = q % I_E;
        if (which < 2) { const int kb = t / 44, nb = t % 44, n0 = nb * 64;
            cvt_tile_fp8(A.in[which == 0 ? I_EW1 : I_EW3] + (size_t)le * DM * FF, FF, kb * 128, n0, w13 + (size_t)le * 5632 * DM, DM, (size_t)((n0 >> 7) * 256 + which * 128 + (n0 & 127)), F8_WSC, (LAS unsigned char*)scr, lane); }
        else { const int kb = t / 16, nb = t % 16;
            cvt_tile_fp8(A.in[I_EW2] + (size_t)le * FF * DM, DM, kb * 128, nb * 64, w2t + (size_t)le * DM * FF, FF, (size_t)nb * 64, F8_WSC, (LAS unsigned char*)scr, lane); }
    }
    if (it0 == 0) { bf16* g2t = (bf16*)(A.ws + WS_G2T);
        for (int idx = gw * 64 + lane; idx < NL * 128 * RW; idx += ngw * 64) { const int col = idx % RW, j = (idx / RW) % 128, l = idx / (128 * RW); g2t[((size_t)l * RW + col) * 128 + j] = (bf16)f2bf(A.in[I_G2][idx]); } }
}

DI void load_row(const float* xrow, int lane, f32x4 (&v)[4]) {
    const f32x4* xr = (const f32x4*)xrow + lane;
#pragma unroll
    for (int j = 0; j < 4; ++j) v[j] = xr[64 * j];
}
DI void load_row_bf(const bf16* xrow, int lane, f32x4 (&v)[4]) {
    const uint2* xr = (const uint2*)xrow + lane;
#pragma unroll
    for (int j = 0; j < 4; ++j) { const uint2 w = xr[64 * j]; v[j][0] = __uint_as_float(w.x << 16); v[j][1] = __uint_as_float(w.x & 0xffff0000u); v[j][2] = __uint_as_float(w.y << 16); v[j][3] = __uint_as_float(w.y & 0xffff0000u); }
}
DI void add_slots(const Args& A, int tok, int lane, f32x4 (&v)[4]) {
    const int* sel = (const int*)(A.ws + WS_SEL); const bf16* ys = (const bf16*)(A.ws + WS_YS);
    const int b = tok / SEQ; const int mys = (lane < NE) ? sel[(size_t)tok * NE + lane] : -1;
    unsigned m = (unsigned)__ballot(mys >= 0);
    while (m) {
        const uint2* p[4]; bool ok[4];
#pragma unroll
        for (int q = 0; q < 4; ++q) { ok[q] = m != 0u; const int e = ok[q] ? __builtin_ctz(m) : 0; m &= m - 1u; const int r = __shfl(mys, e);
            p[q] = (const uint2*)(ys + (size_t)((e * NB + b) * CAP + (ok[q] ? r : 0)) * DM) + lane; }
        uint2 w[4][4];
#pragma unroll
        for (int q = 0; q < 4; ++q) if (ok[q]) {
#pragma unroll
            for (int j = 0; j < 4; ++j) w[q][j] = p[q][64 * j]; }
#pragma unroll
        for (int q = 0; q < 4; ++q) if (ok[q]) {
#pragma unroll
            for (int j = 0; j < 4; ++j) { v[j][0] += __uint_as_float(w[q][j].x << 16); v[j][1] += __uint_as_float(w[q][j].x & 0xffff0000u); v[j][2] += __uint_as_float(w[q][j].y << 16); v[j][3] += __uint_as_float(w[q][j].y & 0xffff0000u); } }
    }
}
DI float row_rstd(const f32x4 (&v)[4]) {
    float s = 0.f;
#pragma unroll
    for (int j = 0; j < 4; ++j) s += (v[j][0] * v[j][0] + v[j][1] * v[j][1]) + (v[j][2] * v[j][2] + v[j][3] * v[j][3]);
    return rsqrtf(wave_sum(s) * (1.f / DM) + RMS_EPS);
}
DI void phase_ln1(const Args& A, int l, int gw, int ngw, int lane) {
    const float* xin = A.in[I_X]; const bf16* x1 = (const bf16*)(A.ws + WS_X1); bf16* x2 = (bf16*)(A.ws + WS_X2); bf16* hb = (bf16*)(A.ws + WS_HB);
    f32x4 gg[4];
#pragma unroll
    for (int j = 0; j < 4; ++j) gg[j] = ((const f32x4*)(A.in[I_LN1G] + (size_t)l * DM) + lane)[64 * j];
    for (int tok = gw; tok < NT; tok += 2 * ngw) {
        const int tokb = tok + ngw; const bool hb2 = tokb < NT;
        f32x4 va[4], vb[4];
        if (l == 0) { load_row(xin + (size_t)tok * DM, lane, va); load_row(xin + (size_t)(hb2 ? tokb : tok) * DM, lane, vb); }
        else { load_row_bf(x1 + (size_t)tok * DM, lane, va); load_row_bf(x1 + (size_t)(hb2 ? tokb : tok) * DM, lane, vb);
            add_slots(A, tok, lane, va); add_slots(A, hb2 ? tokb : tok, lane, vb);
            uint2* oa = (uint2*)(x2 + (size_t)tok * DM) + lane; uint2* ob = (uint2*)(x2 + (size_t)tokb * DM) + lane;
#pragma unroll
            for (int j = 0; j < 4; ++j) { uint2 w; w.x = pkbf(va[j][0], va[j][1]); w.y = pkbf(va[j][2], va[j][3]); oa[64 * j] = w;
                if (hb2) { uint2 u; u.x = pkbf(vb[j][0], vb[j][1]); u.y = pkbf(vb[j][2], vb[j][3]); ob[64 * j] = u; } } }
        const float ra = row_rstd(va), rb = row_rstd(vb); uint2* o8a = (uint2*)(hb + (size_t)tok * DM) + lane; uint2* o8b = (uint2*)(hb + (size_t)tokb * DM) + lane;
#pragma unroll
        for (int j = 0; j < 4; ++j) { uint2 w; w.x = pkbf(va[j][0] * ra * gg[j][0], va[j][1] * ra * gg[j][1]); w.y = pkbf(va[j][2] * ra * gg[j][2], va[j][3] * ra * gg[j][3]); o8a[64 * j] = w;
            if (hb2) { uint2 u; u.x = pkbf(vb[j][0] * rb * gg[j][0], vb[j][1] * rb * gg[j][1]); u.y = pkbf(vb[j][2] * rb * gg[j][2], vb[j][3] * rb * gg[j][3]); o8b[64 * j] = u; } }
    }
}
DI void phase_final(const Args& A, int gw, int ngw, int lane) {
    const bf16* xin = (const bf16*)(A.ws + WS_X1);
    f32x4 gg[4];
#pragma unroll
    for (int j = 0; j < 4; ++j) gg[j] = ((const f32x4*)A.in[I_FG] + lane)[64 * j];
    for (int tok = gw; tok < NT; tok += 2 * ngw) {
        const int tokb = tok + ngw; const bool hb2 = tokb < NT;
        f32x4 va[4], vb[4]; load_row_bf(xin + (size_t)tok * DM, lane, va); load_row_bf(xin + (size_t)(hb2 ? tokb : tok) * DM, lane, vb);
        add_slots(A, tok, lane, va); add_slots(A, hb2 ? tokb : tok, lane, vb);
        const float ra = row_rstd(va), rb = row_rstd(vb); f32x4* oa = (f32x4*)(A.out + (size_t)tok * DM) + lane; f32x4* ob = (f32x4*)(A.out + (size_t)tokb * DM) + lane;
#pragma unroll
        for (int j = 0; j < 4; ++j) { oa[64 * j] = va[j] * ra * gg[j]; if (hb2) ob[64 * j] = vb[j] * rb * gg[j]; }
    }
}
DI void phase_topk(const Args& A, LAS unsigned char* lds, int bid, int G, int tid, int wave, int lane) {
    const unsigned* affk = (const unsigned*)(A.ws + WS_AFF); int* sel = (int*)(A.ws + WS_SEL); float* gate = (float*)(A.ws + WS_GATE);
    const unsigned char* hb = A.ws + WS_HB; unsigned char* xg = A.ws + WS_XG;
    LAS unsigned* hist = (LAS unsigned*)lds;
    LAS unsigned* wsum = hist + 32;
    LAS int* list = (LAS int*)(lds + 256);
    for (int u = bid; u < NB * NE * 2; u += G) {
        const int half = u & 1, e = (u >> 1) % NE, b = u / (2 * NE);
        __syncthreads();
        if (tid < 32) hist[tid] = 0u;
        const uint4 kv = *(const uint4*)(affk + (size_t)(b * NE + e) * SEQ + tid * 4);
        const unsigned key[4] = {kv.x, kv.y, kv.z, kv.w};
        __syncthreads();
        unsigned prefix = 0u, krem = CAP;
#pragma unroll 1
        for (int pass = 0; pass < 8; ++pass) { const int shift = 28 - 4 * pass; LAS unsigned* h = hist + (pass & 1) * 16;
            unsigned cnt = 0u;
#pragma unroll
            for (int i = 0; i < 4; ++i) { const bool cand = (pass == 0) || ((key[i] >> (shift + 4)) == prefix); const unsigned bin = (key[i] >> shift) & 15u;
#pragma unroll
                for (int v = 0; v < 16; ++v) { const unsigned long long m = __ballot(cand && bin == (unsigned)v); if (lane == v) cnt += (unsigned)__popcll(m); } }
            if (lane < 16 && cnt) atomicAdd((unsigned*)(h + lane), cnt);
            __syncthreads();
            unsigned acc = 0u, pick = 0u, before = 0u;
#pragma unroll
            for (int v = 15; v >= 0; --v) { const unsigned c = h[v]; if (acc < krem && acc + c >= krem) { pick = (unsigned)v; before = acc; } acc += c; }
            prefix = (prefix << 4) | pick; krem -= before;
            if (tid < 16) hist[((pass + 1) & 1) * 16 + tid] = 0u;
            __syncthreads();
        }
        const unsigned tau = prefix;
        unsigned gt[4], eq[4]; unsigned ngt = 0u, neq = 0u;
#pragma unroll
        for (int i = 0; i < 4; ++i) { gt[i] = key[i] > tau ? 1u : 0u; eq[i] = key[i] == tau ? 1u : 0u; ngt += gt[i]; neq += eq[i]; }
        unsigned sg = ngt, se = neq;
#pragma unroll
        for (int o = 1; o < 64; o <<= 1) { const unsigned tg = __shfl_up(sg, o), te = __shfl_up(se, o); if (lane >= o) { sg += tg; se += te; } }
        if (lane == 63) { wsum[wave] = sg; wsum[8 + wave] = se; }
        __syncthreads();
        unsigned offg = 0u, offe = 0u;
        for (int w = 0; w < wave; ++w) { offg += wsum[w]; offe += wsum[8 + w]; }
        unsigned eqbefore = offe + se - neq;
        unsigned gtbefore = offg + sg - ngt;
        const int slot0 = (e * NB + b) * CAP;
#pragma unroll
        for (int i = 0; i < 4; ++i) { const int s = tid * 4 + i; const bool selq = gt[i] || (eq[i] && eqbefore < krem);
            const unsigned pos = gtbefore + (eqbefore < krem ? eqbefore : krem);
            if ((s >> 10) == half) { sel[(size_t)(b * SEQ + s) * NE + e] = selq ? (int)pos : -1;
                if (selq) { gate[slot0 + pos] = __uint_as_float(key[i]); } }
            if (selq && pos < CAP) list[pos] = s;
            gtbefore += gt[i]; eqbefore += eq[i]; }
        __syncthreads();
        for (int r = wave; r < CAP; r += NWAVES) { const int s = list[r];
            if ((s >> 10) == half) { const uint4* src = (const uint4*)(hb + (size_t)(b * SEQ + s) * DM) + lane; uint4* dstp = (uint4*)(xg + (size_t)(slot0 + r) * DM) + lane; dstp[0] = src[0]; } }
    }
    __syncthreads();
}

DI int t5_bucket(int rel) {
    const int ret = rel > 0 ? 16 : 0; const int n = rel < 0 ? -rel : rel;
    if (n < 8) return ret + n;
    int large = 8 + (int)(logf((float)n / 8.0f) / 4.852030263919617f * 8.0f);
    large = large < 15 ? large : 15;
    return ret + large;
}

typedef short bf16x8_t __attribute__((ext_vector_type(8)));
typedef short bf16x4_t __attribute__((ext_vector_type(4)));
typedef unsigned u32x4_t __attribute__((ext_vector_type(4)));
typedef unsigned u32x2_t __attribute__((ext_vector_type(2)));
typedef __bf16 bf2_t __attribute__((ext_vector_type(2)));
typedef float f2_t __attribute__((ext_vector_type(2)));
DI unsigned cvtpk(float lo, float hi) { const f2_t v = {lo, hi}; return __builtin_bit_cast(unsigned, __builtin_convertvector(v, bf2_t)); }
#define MFMA16(a, b, c) __builtin_amdgcn_mfma_f32_16x16x32_bf16((a), (b), (c), 0, 0, 0)

constexpr int AT_QS = 0, AT_QLD = 72;
constexpr int AT_KS = AT_QS + 128 * AT_QLD * 2;
constexpr int AT_VT = AT_KS + 272 * AT_QLD * 2, AT_VLD = 280;
constexpr int AT_BT = AT_VT + 64 * AT_VLD * 2;
constexpr int AT_END = AT_BT + 132 * 4;
static_assert(AT_END <= MISC_OFF, "attention LDS");

DI void attn_unit(const Args& A, LAS unsigned char* lds, int unit, int tid, int wave, int lane) {
    const bf16* Z = (const bf16*)(A.ws + WS_Z); bf16* ao = (bf16*)(A.ws + WS_ATTO); float* al = (float*)(A.ws + WS_ATTL);
    const int x = unit & 15; int r0 = unit >> 4; const int hh = r0 & 3; r0 >>= 2; const int b = r0 % NB, br = r0 / NB;
    const int dil = br == 0 ? 1 : (br == 1 ? 4 : 16), lsub = SEQ / dil, nblk = lsub / 128;
    const int res = x / nblk, nbk = x % nblk, l0 = nbk * 128, wbase = l0 - 64;
    LAS bf16* Qs = (LAS bf16*)(lds + AT_QS); LAS bf16* Ks = (LAS bf16*)(lds + AT_KS); LAS bf16* Vt = (LAS bf16*)(lds + AT_VT); LAS float* btab = (LAS float*)(lds + AT_BT);
    __syncthreads();
#pragma unroll
    for (int i = 0; i < 2; ++i) { const int id = tid + 512 * i, row = id >> 3, ch = id & 7; const int tok = b * SEQ + (l0 + row) * dil + res;
        *(LAS u32x4_t*)(Qs + row * AT_QLD + ch * 8) = *(const u32x4_t*)(Z + (size_t)tok * ZLD + ZA + hh * 64 + ch * 8); }
    for (int id = tid; id < 272 * 8; id += NTHR) { const int row = id >> 3, ch = id & 7; const int pos = wbase + row; u32x4_t v = (u32x4_t){0u, 0u, 0u, 0u};
        if (row < 256 && pos >= 0 && pos < lsub) v = *(const u32x4_t*)(Z + (size_t)(b * SEQ + pos * dil + res) * ZLD + ZA + 256 + hh * 64 + ch * 8);
        *(LAS u32x4_t*)(Ks + row * AT_QLD + ch * 8) = v; }
    for (int id = tid; id < 272 * 8; id += NTHR) { const int key = id % 272, ch = id / 272; const int pos = wbase + key; u32x4_t v = (u32x4_t){0u, 0u, 0u, 0u};
        if (key < 256 && pos >= 0 && pos < lsub) v = *(const u32x4_t*)(Z + (size_t)(b * SEQ + pos * dil + res) * ZLD + ZA + 512 + hh * 64 + ch * 8);
        LAS bf16* d = Vt + (ch * 8) * AT_VLD + key;
        d[0] = (bf16)(v.x & 0xffffu); d[AT_VLD] = (bf16)(v.x >> 16); d[2 * AT_VLD] = (bf16)(v.y & 0xffffu); d[3 * AT_VLD] = (bf16)(v.y >> 16);
        d[4 * AT_VLD] = (bf16)(v.z & 0xffffu); d[5 * AT_VLD] = (bf16)(v.z >> 16); d[6 * AT_VLD] = (bf16)(v.w & 0xffffu); d[7 * AT_VLD] = (bf16)(v.w >> 16); }
    if (tid < 129) btab[tid] = A.in[I_RELB][t5_bucket((tid - 64) * dil) * 4 + hh];
    __syncthreads();
    const int fr = lane & 15, qd = lane >> 4;
    f32x4 acc[10];
    { bf16x8_t qb[2];
#pragma unroll
      for (int ks = 0; ks < 2; ++ks) qb[ks] = *(const LAS bf16x8_t*)(Qs + (16 * wave + fr) * AT_QLD + ks * 32 + 8 * qd);
#pragma unroll
      for (int j = 0; j < 10; ++j) { acc[j] = (f32x4){0.f, 0.f, 0.f, 0.f};
#pragma unroll
          for (int ks = 0; ks < 2; ++ks) { const bf16x8_t ka = *(const LAS bf16x8_t*)(Ks + (16 * (wave + j) + fr) * AT_QLD + ks * 32 + 8 * qd); acc[j] = MFMA16(ka, qb[ks], acc[j]); } } }
    const int iq = 16 * wave + fr; float mx = -1.0e30f;
#pragma unroll
    for (int j = 0; j < 10; ++j)
#pragma unroll
        for (int r = 0; r < 4; ++r) { const int kw = 16 * (wave + j) + 4 * qd + r; const int m = kw - 64 - iq; const int pos = wbase + kw;
            const bool valid = (m >= -64) && (m <= 64) && (pos >= 0) && (pos < lsub);
            const float s = valid ? acc[j][r] * 0.125f + btab[valid ? m + 64 : 0] : -1.0e30f; acc[j][r] = s; mx = fmaxf(mx, s); }
    mx = fmaxf(mx, __shfl_xor(mx, 16)); mx = fmaxf(mx, __shfl_xor(mx, 32));
    float lsum = 0.f;
#pragma unroll
    for (int j = 0; j < 10; ++j)
#pragma unroll
        for (int r = 0; r < 4; ++r) { const float p = __expf(acc[j][r] - mx); acc[j][r] = p; lsum += p; }
    lsum += __shfl_xor(lsum, 16); lsum += __shfl_xor(lsum, 32);
    f32x4 oacc[4];
#pragma unroll
    for (int d = 0; d < 4; ++d) oacc[d] = (f32x4){0.f, 0.f, 0.f, 0.f};
#pragma unroll
    for (int pp = 0; pp < 5; ++pp) {
        union { unsigned u[4]; bf16x8_t v; } pb;
        pb.u[0] = cvtpk(acc[2 * pp][0], acc[2 * pp][1]); pb.u[1] = cvtpk(acc[2 * pp][2], acc[2 * pp][3]); pb.u[2] = cvtpk(acc[2 * pp + 1][0], acc[2 * pp + 1][1]); pb.u[3] = cvtpk(acc[2 * pp + 1][2], acc[2 * pp + 1][3]);
#pragma unroll
        for (int d = 0; d < 4; ++d) { const LAS bf16* vp = Vt + (16 * d + fr) * AT_VLD + 16 * (wave + 2 * pp) + 4 * qd;
            union { bf16x4_t h[2]; bf16x8_t v; } va; va.h[0] = *(const LAS bf16x4_t*)vp; va.h[1] = *(const LAS bf16x4_t*)(vp + 16);
            oacc[d] = MFMA16(va.v, pb.v, oacc[d]); } }
    const float inv = 1.f / lsum; const int tok = b * SEQ + (l0 + iq) * dil + res;
    bf16* op = ao + ((size_t)br * NT + tok) * AW + hh * 64 + 4 * qd;
#pragma unroll
    for (int d = 0; d < 4; ++d) { uint2 w; w.x = cvtpk(oacc[d][0] * inv, oacc[d][1] * inv); w.y = cvtpk(oacc[d][2] * inv, oacc[d][3] * inv); *(uint2*)(op + 16 * d) = w; }
    if (qd == 0) al[((size_t)br * NT + tok) * 4 + hh] = mx + logf(lsum);
}
constexpr int ATT_UNITS = 3 * NB * 4 * 16, ATT_SCAN_BLK0 = 160, ATT_SPLIT = ATT_UNITS - 96 * 6;
DI void phase_attn(const Args& A, LAS unsigned char* lds, int u0, int u1, int b0, int nb, int tid, int wave, int lane) {
    for (int u = u0 + b0; u < u1; u += nb) attn_unit(A, lds, u, tid, wave, lane);
    __syncthreads();
}


constexpr int ML_QLD = 104, ML_SLD = 72;
constexpr int ML_QS = 0;
constexpr int ML_QT = ML_QS + 64 * ML_QLD * 2;
constexpr int ML_KS = ML_QT + 64 * ML_QLD * 2;
constexpr int ML_KT = ML_KS + 64 * ML_QLD * 2;
constexpr int ML_VT = ML_KT + 96 * ML_SLD * 2;
constexpr int ML_WS = ML_VT + 112 * ML_SLD * 2;
constexpr int ML_CT = ML_WS + 64 * ML_SLD * 2;
constexpr int ML_CW = ML_CT + 112 * ML_QLD * 2;
constexpr int ML_END = ML_CW + 6 * 192 * 4;
static_assert(ML_END <= MISC_OFF, "mlstm LDS");

constexpr int MLP_QF = 0, MLP_NI = 12288, MLP_U = 26624, MLP_DEC = 48128, MLP_BYTES = 48384;
constexpr size_t WS_MLPKG = WS_R + 304 * MiB;
static_assert(WS_MLPKG + (size_t)2 * NB * 4 * 32 * MLP_BYTES <= WS_RKY, "mlstm package region");

struct M1Regs { u32x4_t zc[15]; u32x2_t vv[3]; float gi, gf; };
DI void mlstm_m1_fetch(const Args& A, int item, int tid, int lane, M1Regs& R) {
    const bf16* Z = (const bf16*)(A.ws + WS_Z);
    const int c = item & 31, u = item >> 5; const int dir = u / 32, b = (u % 32) / 4, hh = u % 4; const int j = tid >> 3, sub = tid & 7;
    const int tl = dir ? SEQ - 1 - (c * 64 + lane) : c * 64 + lane; const size_t tokl = (size_t)b * SEQ + tl;
    R.gi = bf2f(Z[tokl * ZLD + ZMG + dir * 8 + hh]); R.gf = bf2f(Z[tokl * ZLD + ZMG + dir * 8 + 4 + hh]);
    const int tj = dir ? SEQ - 1 - (c * 64 + j) : c * 64 + j; const size_t tokj = (size_t)b * SEQ + tj;
    const bool isk = sub >= 4; const int zcol = ZMQK + (isk ? 384 : 0) + hh * 96 + (sub & 3) * 24;
#pragma unroll
    for (int tap = 0; tap < 5; ++tap) { const int tt = tj + tap - 2; const bool ok = tt >= 0 && tt < SEQ; const u32x4_t* zp = (const u32x4_t*)(Z + ((size_t)b * SEQ + (ok ? tt : tj)) * ZLD + zcol);
#pragma unroll
        for (int q4 = 0; q4 < 3; ++q4) { const u32x4_t w = zp[q4]; R.zc[tap * 3 + q4] = ok ? w : (u32x4_t){0u, 0u, 0u, 0u}; } }
    const u32x2_t* vp = (const u32x2_t*)(Z + tokj * ZLD + ZMV + hh * 96 + sub * 12);
#pragma unroll
    for (int q2 = 0; q2 < 3; ++q2) R.vv[q2] = vp[q2];
}
DI void mlstm_m1_item(const Args& A, int l, LAS unsigned char* lds, int item, int item_next, M1Regs& R, int& hh_staged, int tid, int wave, int lane) {
    const int c = item & 31, u = item >> 5; const int dir = u / 32, hh = u % 4;
    LAS bf16* Qs = (LAS bf16*)(lds + ML_QS); LAS bf16* Qt = (LAS bf16*)(lds + ML_QT); LAS bf16* Ks = (LAS bf16*)(lds + ML_KS); LAS bf16* KtT = (LAS bf16*)(lds + ML_KT);
    LAS bf16* VtT = (LAS bf16*)(lds + ML_VT); LAS bf16* Ws = (LAS bf16*)(lds + ML_WS); LAS float* cwl = (LAS float*)(lds + ML_CW); LAS float* cbl = cwl + 5 * 192;
    const int fr = lane & 15, qd = lane >> 4;
    unsigned char* pkg = A.ws + WS_MLPKG + (size_t)item * MLP_BYTES;
    __syncthreads();
    if (hh != hh_staged) { hh_staged = hh;
        for (int i = tid; i < 5 * 192; i += NTHR) { const int tap = i / 192, ch = i % 192; cwl[i] = A.in[I_CW][(size_t)(l * 5 + tap) * 768 + (ch < 96 ? 0 : 384) + hh * 96 + (ch % 96)]; }
        for (int i = tid; i < 192; i += NTHR) cbl[i] = A.in[I_CB][(size_t)l * 768 + (i < 96 ? 0 : 384) + hh * 96 + (i % 96)];
        for (int i = tid; i < 16 * ML_SLD; i += NTHR) VtT[96 * ML_SLD + i] = (i < ML_SLD) ? (bf16)0x3F80u : (bf16)0u;
        __syncthreads(); }
    const float ibv = A.in[I_IB][(l * 2 + dir) * 4 + hh], fbv = A.in[I_FB][(l * 2 + dir) * 4 + hh];
    const int j = tid >> 3, sub = tid & 7;
    const float gi = R.gi + ibv, gf = R.gf + fbv;
    float bsum = fminf(gf, 0.f) - __logf(1.f + __expf(-fabsf(gf)));
#pragma unroll
    for (int o = 1; o < 64; o <<= 1) { const float t = __shfl_up(bsum, o); if (lane >= o) bsum += t; }
    const float bend = __shfl(bsum, 63);
    const float bj = __shfl(bsum, j), igj = __shfl(gi, j);
    { const bool isk = sub >= 4; const int c0 = (sub & 3) * 24, cl = (isk ? 96 : 0) + c0;
      float acc[24];
#pragma unroll
      for (int e = 0; e < 24; ++e) acc[e] = cbl[cl + e];
#pragma unroll
      for (int tap = 0; tap < 5; ++tap) {
#pragma unroll
          for (int q4 = 0; q4 < 3; ++q4) { const u32x4_t w = R.zc[tap * 3 + q4]; const LAS float* cwp = cwl + tap * 192 + cl + q4 * 8;
              acc[q4 * 8 + 0] += cwp[0] * __uint_as_float(w.x << 16); acc[q4 * 8 + 1] += cwp[1] * __uint_as_float(w.x & 0xffff0000u);
              acc[q4 * 8 + 2] += cwp[2] * __uint_as_float(w.y << 16); acc[q4 * 8 + 3] += cwp[3] * __uint_as_float(w.y & 0xffff0000u);
              acc[q4 * 8 + 4] += cwp[4] * __uint_as_float(w.z << 16); acc[q4 * 8 + 5] += cwp[5] * __uint_as_float(w.z & 0xffff0000u);
              acc[q4 * 8 + 6] += cwp[6] * __uint_as_float(w.w << 16); acc[q4 * 8 + 7] += cwp[7] * __uint_as_float(w.w & 0xffff0000u); } }
      const float sc1 = isk ? 0.10206207261596575f : 1.f; const float sc2 = isk ? __expf(bend - bj + igj) : __expf(bj);
#pragma unroll
      for (int e = 0; e < 24; ++e) acc[e] = acc[e] * sigm(acc[e]) * sc1;
      if (!isk) { LAS bf16* d1 = Qs + j * ML_QLD + c0; LAS bf16* d2 = Qt + j * ML_QLD + c0;
#pragma unroll
          for (int q4 = 0; q4 < 3; ++q4) { u32x4_t w; w.x = cvtpk(acc[q4 * 8 + 0], acc[q4 * 8 + 1]); w.y = cvtpk(acc[q4 * 8 + 2], acc[q4 * 8 + 3]); w.z = cvtpk(acc[q4 * 8 + 4], acc[q4 * 8 + 5]); w.w = cvtpk(acc[q4 * 8 + 6], acc[q4 * 8 + 7]);
              *(LAS u32x4_t*)(d1 + q4 * 8) = w;
              u32x4_t x; x.x = cvtpk(acc[q4 * 8 + 0] * sc2, acc[q4 * 8 + 1] * sc2); x.y = cvtpk(acc[q4 * 8 + 2] * sc2, acc[q4 * 8 + 3] * sc2); x.z = cvtpk(acc[q4 * 8 + 4] * sc2, acc[q4 * 8 + 5] * sc2); x.w = cvtpk(acc[q4 * 8 + 6] * sc2, acc[q4 * 8 + 7] * sc2);
              *(LAS u32x4_t*)(d2 + q4 * 8) = x; } }
      else { LAS bf16* d1 = Ks + j * ML_QLD + c0;
#pragma unroll
          for (int q4 = 0; q4 < 3; ++q4) { u32x4_t w; w.x = cvtpk(acc[q4 * 8 + 0], acc[q4 * 8 + 1]); w.y = cvtpk(acc[q4 * 8 + 2], acc[q4 * 8 + 3]); w.z = cvtpk(acc[q4 * 8 + 4], acc[q4 * 8 + 5]); w.w = cvtpk(acc[q4 * 8 + 6], acc[q4 * 8 + 7]);
              *(LAS u32x4_t*)(d1 + q4 * 8) = w; }
#pragma unroll
          for (int e = 0; e < 24; ++e) KtT[(c0 + e) * ML_SLD + j] = (bf16)cvtpk(acc[e] * sc2, 0.f); } }
    { const int n0 = sub * 12;
#pragma unroll
      for (int q2 = 0; q2 < 3; ++q2) { const u32x2_t w = R.vv[q2]; LAS bf16* d = VtT + (n0 + q2 * 4) * ML_SLD + j;
          d[0] = (bf16)(w.x & 0xffffu); d[ML_SLD] = (bf16)(w.x >> 16); d[2 * ML_SLD] = (bf16)(w.y & 0xffffu); d[3 * ML_SLD] = (bf16)(w.y >> 16); } }
    if (item_next >= 0) mlstm_m1_fetch(A, item_next, tid, lane, R);
    __syncthreads();
#pragma unroll
    for (int i = 0; i < 2; ++i) { const int tile = 2 * wave + i, jt = tile >> 2, st = tile & 3; const int jq = 16 * jt + fr;
        u32x2_t w = (u32x2_t){0u, 0u};
        if (st <= jt) { f32x4 acc = (f32x4){0.f, 0.f, 0.f, 0.f};
#pragma unroll
            for (int ks = 0; ks < 3; ++ks) { const bf16x8_t a = *(const LAS bf16x8_t*)(Ks + (16 * st + fr) * ML_QLD + 32 * ks + 8 * qd); const bf16x8_t bq = *(const LAS bf16x8_t*)(Qs + jq * ML_QLD + 32 * ks + 8 * qd); acc = MFMA16(a, bq, acc); }
            const float bjq = __shfl(bsum, jq); float wv[4];
#pragma unroll
            for (int r = 0; r < 4; ++r) { const int s = 16 * st + 4 * qd + r; const float bs = __shfl(bsum, s), igs = __shfl(gi, s); wv[r] = (s <= jq) ? acc[r] * __expf(bjq - bs + igs) : 0.f; }
            w.x = cvtpk(wv[0], wv[1]); w.y = cvtpk(wv[2], wv[3]); }
        *(LAS u32x2_t*)(Ws + jq * ML_SLD + 16 * st + 4 * qd) = w; }
    __syncthreads();
    for (int id = wave; id < 12; id += NWAVES) { const int jt = id / 3, i3 = id % 3; const LAS bf16* p = Qt + (16 * jt + fr) * ML_QLD + 32 * i3 + 4 * qd; const u32x2_t lo = *(const LAS u32x2_t*)p, hi = *(const LAS u32x2_t*)(p + 16);
        *(u32x4_t*)(pkg + MLP_QF + (size_t)id * 1024 + lane * 16) = (u32x4_t){lo.x, lo.y, hi.x, hi.y}; }
    for (int id = wave; id < 70; id += NWAVES) { f32x4 acc = (f32x4){0.f, 0.f, 0.f, 0.f}; int nt; const LAS bf16* ap; int ald; unsigned char* dst;
        if (id < 28) { const int jt = id & 3; nt = id >> 2; ap = Ws + (16 * jt + fr) * ML_SLD; ald = 0; dst = pkg + MLP_NI + (size_t)(nt * 4 + jt) * 512; }
        else { const int q = id - 28, kt = q % 6; nt = q / 6; ap = KtT + (16 * kt + fr) * ML_SLD; ald = 0; dst = pkg + MLP_U + (size_t)(nt * 6 + kt) * 512; }
#pragma unroll
        for (int ks = 0; ks < 2; ++ks) { const bf16x8_t a = *(const LAS bf16x8_t*)(ap + 32 * ks + 8 * qd); const bf16x8_t bv = *(const LAS bf16x8_t*)(VtT + (16 * nt + fr) * ML_SLD + 32 * ks + 8 * qd);
            acc = (id < 28) ? MFMA16(bv, a, acc) : MFMA16(a, bv, acc); }
        u32x2_t w; w.x = cvtpk(acc[0], acc[1]); w.y = cvtpk(acc[2], acc[3]); *(u32x2_t*)(dst + lane * 8) = w; }
    if (tid < 64) ((float*)(pkg + MLP_DEC))[tid] = __expf(bend);
}
DI void phase_mlstm_m1(const Args& A, int l, LAS unsigned char* lds, int bid, int G, int tid, int wave, int lane) {
    int hh_staged = -1; constexpr int NIT = 2 * NB * 4 * 32;
    if (bid < NIT) { M1Regs R; mlstm_m1_fetch(A, bid, tid, lane, R);
        for (int it = bid; it < NIT; it += G) mlstm_m1_item(A, l, lds, it, (it + G < NIT) ? it + G : -1, R, hh_staged, tid, wave, lane); }
    __syncthreads();
}
constexpr int M2_SLOTS = 8, M2_SLOT_BYTES = 12288, M2_CTL = M2_SLOTS * M2_SLOT_BYTES;
static_assert(M2_CTL + 64 <= MISC_OFF, "mlstm m2 LDS");
DI f32x4 unpk4(const u32x2_t w) { return (f32x4){__uint_as_float(w.x << 16), __uint_as_float(w.x & 0xffff0000u), __uint_as_float(w.y << 16), __uint_as_float(w.y & 0xffff0000u)}; }
struct M2Small { u32x2_t ni[4], uu[6]; float dec; };
DI void m2_load_small(M2Small& o, const unsigned char* pkg, int nt, int lane) {
#pragma unroll
    for (int jt = 0; jt < 4; ++jt) o.ni[jt] = *(const u32x2_t*)(pkg + MLP_NI + (nt * 4 + jt) * 512 + lane * 8);
#pragma unroll
    for (int kt = 0; kt < 6; ++kt) o.uu[kt] = *(const u32x2_t*)(pkg + MLP_U + (nt * 6 + kt) * 512 + lane * 8);
    o.dec = ((const float*)(pkg + MLP_DEC))[lane];
}
DI void m2_step(const M2Small& o, const LAS unsigned char* slot, f32x4 (&C)[6], bf16* num, float* den, int dir, int b, int hh, int nt, int c, int lane, int fr, int qd) {
    union { unsigned u[4]; bf16x8_t v; } sB[3];
#pragma unroll
    for (int i = 0; i < 3; ++i) { sB[i].u[0] = cvtpk(C[2 * i][0], C[2 * i][1]); sB[i].u[1] = cvtpk(C[2 * i][2], C[2 * i][3]); sB[i].u[2] = cvtpk(C[2 * i + 1][0], C[2 * i + 1][1]); sB[i].u[3] = cvtpk(C[2 * i + 1][2], C[2 * i + 1][3]); }
#pragma unroll
    for (int jt = 0; jt < 4; ++jt) { f32x4 acc = unpk4(o.ni[jt]);
#pragma unroll
        for (int i = 0; i < 3; ++i) { const bf16x8_t qf = *(const LAS bf16x8_t*)(slot + (3 * jt + i) * 1024 + lane * 16); acc = MFMA16(sB[i].v, qf, acc); }
        { const int jj = 16 * jt + fr; const int tt = dir ? SEQ - 1 - (c * 64 + jj) : c * 64 + jj; const size_t tok = (size_t)b * SEQ + tt;
          if (nt < 6) { u32x2_t w; w.x = cvtpk(acc[0], acc[1]); w.y = cvtpk(acc[2], acc[3]); *(u32x2_t*)(num + ((size_t)dir * NT + tok) * MW + hh * 96 + 16 * nt + 4 * qd) = w; }
          else if (qd == 0) den[((size_t)dir * NT + tok) * 4 + hh] = acc[0]; } }
#pragma unroll
    for (int kt = 0; kt < 6; ++kt) C[kt] = C[kt] * o.dec + unpk4(o.uu[kt]);
}
DI void mlstm_m2_unit(const Args& A, LAS unsigned char* lds, int u, int tid, int wave, int lane) {
    bf16* num = (bf16*)(A.ws + WS_MLNUM); float* den = (float*)(A.ws + WS_MLDEN);
    const int dir = u / 32, b = (u % 32) / 4, hh = u % 4; const int fr = lane & 15, qd = lane >> 4;
    const unsigned char* pkg0 = A.ws + WS_MLPKG + (size_t)u * 32 * MLP_BYTES;
    volatile LAS unsigned* ready = (volatile LAS unsigned*)(lds + M2_CTL); volatile LAS unsigned* consumed = ready + 8;
    __syncthreads();
    if (tid < 16) ready[tid] = 0u;
    __syncthreads();
    if (wave == 7) {
        u32x4_t f0[12], f1[12], f2[12];
#define M2_FETCH(dst, c_) do { _Pragma("unroll") for (int i = 0; i < 12; ++i) dst[i] = *(const u32x4_t*)(pkg0 + (size_t)(c_) * MLP_BYTES + MLP_QF + i * 1024 + lane * 16); } while (0)
#define M2_PUBLISH(src, c_) do { if ((c_) >= M2_SLOTS) { const unsigned need = (unsigned)((c_) - M2_SLOTS + 1); unsigned spins = 0; \
            for (;;) { bool ok = true; _Pragma("unroll") for (int w = 0; w < 7; ++w) ok = ok && (consumed[w] >= need); if (ok) break; if (++spins > (1u << 22)) break; __builtin_amdgcn_s_sleep(1); } } \
        LAS unsigned char* slot_ = lds + ((c_) & (M2_SLOTS - 1)) * M2_SLOT_BYTES; _Pragma("unroll") for (int i = 0; i < 12; ++i) *(LAS u32x4_t*)(slot_ + i * 1024 + lane * 16) = src[i]; \
        asm volatile("s_waitcnt lgkmcnt(0)" ::: "memory"); if (lane == 0) ready[(c_) & (M2_SLOTS - 1)] = (unsigned)((c_) + 1); asm volatile("" ::: "memory"); } while (0)
        M2_FETCH(f0, 0); M2_FETCH(f1, 1);
        for (int c = 0; c < 30; c += 3) { M2_FETCH(f2, c + 2); M2_PUBLISH(f0, c); M2_FETCH(f0, c + 3); M2_PUBLISH(f1, c + 1); M2_FETCH(f1, c + 4); M2_PUBLISH(f2, c + 2); }
        M2_PUBLISH(f0, 30); M2_PUBLISH(f1, 31);
#undef M2_FETCH
#undef M2_PUBLISH
    } else {
        const int nt = wave; f32x4 C[6];
#pragma unroll
        for (int kt = 0; kt < 6; ++kt) C[kt] = (f32x4){0.f, 0.f, 0.f, 0.f};
        M2Small s0, s1, s2, s3;
        m2_load_small(s0, pkg0, nt, lane); m2_load_small(s1, pkg0 + MLP_BYTES, nt, lane); m2_load_small(s2, pkg0 + 2 * (size_t)MLP_BYTES, nt, lane); m2_load_small(s3, pkg0 + 3 * (size_t)MLP_BYTES, nt, lane);
#define M2_CHAIN(sx, c_) do { unsigned spins = 0; while (ready[(c_) & (M2_SLOTS - 1)] != (unsigned)((c_) + 1)) { if (++spins > (1u << 22)) break; __builtin_amdgcn_s_sleep(1); } asm volatile("" ::: "memory"); \
            m2_step(sx, lds + ((c_) & (M2_SLOTS - 1)) * M2_SLOT_BYTES, C, num, den, dir, b, hh, nt, (c_), lane, fr, qd); \
            asm volatile("s_waitcnt lgkmcnt(0)" ::: "memory"); if (lane == 0) consumed[nt] = (unsigned)((c_) + 1); asm volatile("" ::: "memory"); \
            if ((c_) + 4 < 32) m2_load_small(sx, pkg0 + (size_t)((c_) + 4) * MLP_BYTES, nt, lane); } while (0)
        for (int c = 0; c < 32; c += 4) { M2_CHAIN(s0, c); M2_CHAIN(s1, c + 1); M2_CHAIN(s2, c + 2); M2_CHAIN(s3, c + 3); }
#undef M2_CHAIN
    }
    __syncthreads();
}

constexpr int PKG_BYTES = 12544;
constexpr int PK_AH = 0, PK_RH = 2048, PK_KB = 4096, PK_VV = 8192, PK_TM = 10240, PK_MM = 10752, PK_LAK = 11776, PK_GE = 12288;
constexpr size_t WS_PKG = WS_PR;
static_assert((size_t)2 * NB * 6 * 128 * PKG_BYTES <= 288 * MiB, "package region");
constexpr int R1_W2T = 0, R1_A2T = 9216, R1_WV = 18432, R1_WV_BYTES = 12928;
constexpr int R1_IMG = 0, R1_LF = 9216, R1_MT = 10368;
static_assert(R1_WV + 8 * R1_WV_BYTES <= MISC_OFF, "rwkv r1 LDS");

DI bf16x4_t pack4(const f32x4 v) { union { unsigned u[2]; bf16x4_t h; } x; x.u[0] = cvtpk(v[0], v[1]); x.u[1] = cvtpk(v[2], v[3]); return x.h; }

DI void rwkv_r1_item(const Args& A, int l, LAS unsigned char* lds, int item, int& dh_staged, int tid, int wave, int lane) {
    const bf16* Z = (const bf16*)(A.ws + WS_Z);
    const int g = item & 15; int r0 = item >> 4; const int hh = r0 % 6; r0 /= 6; const int b = r0 % NB, dir = r0 / NB;
    const int cc = 8 * g + wave, fr = lane & 15, qd = lane >> 4;
    LAS bf16* W2T = (LAS bf16*)(lds + R1_W2T); LAS bf16* A2T = (LAS bf16*)(lds + R1_A2T);
    LAS unsigned char* wv = lds + R1_WV + wave * R1_WV_BYTES;
    LAS bf16* IMG = (LAS bf16*)(wv + R1_IMG); LAS float* Lf = (LAS float*)(wv + R1_LF); LAS bf16* MT = (LAS bf16*)(wv + R1_MT);
    const int sgn = dir ? -1 : 1; const int tok0 = b * SEQ + (dir ? SEQ - 1 - 16 * cc : 16 * cc);
    const float* mu = A.in[I_MU] + (size_t)(l * 2 + dir) * 1280;
    float er[4][4], ek[4][4], ev[4][4];
    u32x4_t ld[7];
#pragma unroll
    for (int i = 0; i < 7; ++i) { const int idx = lane + 64 * i; const int ri = idx / 24, pc = idx % 24; const bool ok = (idx < 17 * 24) && (ri > 0 || cc > 0);
        ld[i] = (u32x4_t){0u, 0u, 0u, 0u};
        if (ok) ld[i] = *(const u32x4_t*)(Z + (size_t)(tok0 + sgn * (ri - 1)) * ZLD + ZRKV + (pc >> 3) * RW + hh * 64 + (pc & 7) * 8); }
    uint4 zcw[2], zca[2], zpw[2], zpa[2];
    { const int zwd = dir ? ZWDB : ZWDF, zad = dir ? ZADB : ZADF; const bool hasp = !(cc == 0 && fr == 0);
      const bf16* zc = Z + (size_t)(tok0 + sgn * fr) * ZLD; const bf16* zq = Z + (size_t)(tok0 + sgn * (fr - 1)) * ZLD;
#pragma unroll
      for (int ks = 0; ks < 2; ++ks) { zcw[ks] = *(const uint4*)(zc + zwd + 32 * ks + 8 * qd); zca[ks] = *(const uint4*)(zc + zad + 32 * ks + 8 * qd);
          zpw[ks] = make_uint4(0u, 0u, 0u, 0u); zpa[ks] = make_uint4(0u, 0u, 0u, 0u);
          if (hasp) { zpw[ks] = *(const uint4*)(zq + zwd + 32 * ks + 8 * qd); zpa[ks] = *(const uint4*)(zq + zad + 32 * ks + 8 * qd); } } }
    if (dh_staged != dir * 6 + hh) { dh_staged = dir * 6 + hh;
    const int ch = tid & 63, i0 = (tid >> 6) * 8; const float* w2 = A.in[I_W2] + ((size_t)(l * 2 + dir) * 64 + i0) * RW + hh * 64 + ch; const float* a2 = A.in[I_A2] + ((size_t)(l * 2 + dir) * 64 + i0) * RW + hh * 64 + ch;
    u32x4_t pw, pa; pw.x = cvtpk(w2[0], w2[RW]); pw.y = cvtpk(w2[2 * RW], w2[3 * RW]); pw.z = cvtpk(w2[4 * RW], w2[5 * RW]); pw.w = cvtpk(w2[6 * RW], w2[7 * RW]);
    pa.x = cvtpk(a2[0], a2[RW]); pa.y = cvtpk(a2[2 * RW], a2[3 * RW]); pa.z = cvtpk(a2[4 * RW], a2[5 * RW]); pa.w = cvtpk(a2[6 * RW], a2[7 * RW]);
    __syncthreads();
    *(LAS u32x4_t*)(W2T + ch * 72 + i0) = pw; *(LAS u32x4_t*)(A2T + ch * 72 + i0) = pa;
    __syncthreads(); }
    { LAS bf16* stg = IMG; constexpr int SLD = 200;
#pragma unroll
      for (int i = 0; i < 7; ++i) { const int idx = lane + 64 * i; const int ri = idx / 24, pc = idx % 24; if (idx < 17 * 24) *(LAS u32x4_t*)(stg + ri * SLD + pc * 8) = ld[i]; }
      asm volatile("s_waitcnt lgkmcnt(0)" ::: "memory");
#pragma unroll
      for (int nt = 0; nt < 4; ++nt) { const LAS bf16* sp = stg + (4 * qd) * SLD + 16 * nt + fr;
          float qr = bf2f(sp[0]), qk = bf2f(sp[64]), qv = bf2f(sp[128]);
          const float mr = mu[hh * 64 + 16 * nt + fr], mk = mu[RW + hh * 64 + 16 * nt + fr], mv = mu[2 * RW + hh * 64 + 16 * nt + fr];
#pragma unroll
          for (int r = 0; r < 4; ++r) { const float cr = bf2f(sp[(r + 1) * SLD]), ck = bf2f(sp[(r + 1) * SLD + 64]), cv = bf2f(sp[(r + 1) * SLD + 128]);
              er[nt][r] = cr + mr * (qr - cr); ek[nt][r] = ck + mk * (qk - ck); ev[nt][r] = cv + mv * (qv - cv); qr = cr; qk = ck; qv = cv; } }
      asm volatile("s_waitcnt lgkmcnt(0)" ::: "memory"); }
    bf16x8_t thA[2], adA[2];
    {
#pragma unroll
      for (int ks = 0; ks < 2; ++ks) { float cw[8], pw[8], ca[8], pa[8];
          unpack8(zcw[ks], cw); unpack8(zca[ks], ca); unpack8(zpw[ks], pw); unpack8(zpa[ks], pa);
          const float* muw = mu + 1152 + 32 * ks + 8 * qd; const float* mua = mu + 1216 + 32 * ks + 8 * qd;
#pragma unroll
          for (int e = 0; e < 8; ++e) { const float xw = cw[e] + muw[e] * (pw[e] - cw[e]); cw[e] = 1.f - 2.f * __builtin_amdgcn_rcpf(1.f + __expf(2.f * xw)); ca[e] = ca[e] + mua[e] * (pa[e] - ca[e]); }
          union { unsigned u[4]; bf16x8_t v; } x, y;
#pragma unroll
          for (int e = 0; e < 4; ++e) { x.u[e] = cvtpk(cw[2 * e], cw[2 * e + 1]); y.u[e] = cvtpk(ca[2 * e], ca[2 * e + 1]); }
          thA[ks] = x.v; adA[ks] = y.v; } }
    f32x4 wl[4], al[4];
#pragma unroll
    for (int nt = 0; nt < 4; ++nt) { wl[nt] = (f32x4){0.f, 0.f, 0.f, 0.f}; al[nt] = (f32x4){0.f, 0.f, 0.f, 0.f};
#pragma unroll
        for (int ks = 0; ks < 2; ++ks) { const bf16x8_t bw = *(const LAS bf16x8_t*)(W2T + (16 * nt + fr) * 72 + 32 * ks + 8 * qd); const bf16x8_t ba = *(const LAS bf16x8_t*)(A2T + (16 * nt + fr) * 72 + 32 * ks + 8 * qd);
            wl[nt] = MFMA16(thA[ks], bw, wl[nt]); al[nt] = MFMA16(adA[ks], ba, al[nt]); } }
    float lw[4][4], alp[4][4], kap[4][4]; float ssq[4] = {0.f, 0.f, 0.f, 0.f}, bsm[4] = {0.f, 0.f, 0.f, 0.f};
#pragma unroll
    for (int nt = 0; nt < 4; ++nt) { const int ch = hh * 64 + 16 * nt + fr;
        const float w0v = A.in[I_W0][(size_t)(l * 2 + dir) * RW + ch], a0v = A.in[I_A0][(size_t)(l * 2 + dir) * RW + ch], kkw = A.in[I_KK][(size_t)l * RW + ch], kaw = A.in[I_KA][(size_t)l * RW + ch], rkw = A.in[I_RK][(size_t)l * RW + ch];
#pragma unroll
        for (int r = 0; r < 4; ++r) { const float x = w0v + wl[nt][r];
            lw[nt][r] = -0.6065306597126334f * __builtin_amdgcn_rcpf(1.f + __expf(-x));
            const float a = __builtin_amdgcn_rcpf(1.f + __expf(-(a0v + al[nt][r]))); alp[nt][r] = a;
            const float k0 = ek[nt][r]; kap[nt][r] = k0 * kkw; ek[nt][r] = k0 * (1.f + (a - 1.f) * kaw);
            ssq[r] += kap[nt][r] * kap[nt][r]; bsm[r] += er[nt][r] * ek[nt][r] * rkw; } }
#pragma unroll
    for (int r = 0; r < 4; ++r) {
#pragma unroll
        for (int o = 1; o < 16; o <<= 1) { ssq[r] += __shfl_xor(ssq[r], o); bsm[r] += __shfl_xor(bsm[r], o); }
        ssq[r] = __builtin_amdgcn_rsqf(fmaxf(ssq[r], 1e-24f)); }
    { bf16* bon = (bf16*)(A.ws + WS_RKB);
#pragma unroll
      for (int nt = 0; nt < 4; ++nt)
#pragma unroll
          for (int r = 0; r < 4; ++r) { kap[nt][r] *= ssq[r]; MT[(4 * qd + r) * 72 + 16 * nt + fr] = (bf16)cvtpk(bsm[r] * ev[nt][r], 0.f); }
      asm volatile("s_waitcnt lgkmcnt(0)" ::: "memory");
      const int p = lane >> 2, c16 = (lane & 3) * 16; const LAS u32x4_t* sp = (const LAS u32x4_t*)(MT + p * 72 + c16); const u32x4_t w0 = sp[0], w1 = sp[1];
      bf16* dst = bon + ((size_t)dir * NT + tok0 + sgn * p) * RW + hh * 64 + c16;
      *(u32x4_t*)dst = w0; *(u32x4_t*)(dst + 8) = w1;
      asm volatile("s_waitcnt lgkmcnt(0)" ::: "memory"); }
    unsigned char* pkg = A.ws + WS_PKG + ((size_t)((dir * NB + b) * 6 + hh) * 128 + cc) * PKG_BYTES;
    float lend[4];
    u32x2_t btf[4], ktf[4];
#pragma unroll
    for (int nt = 0; nt < 4; ++nt) { float lam[4]; lam[0] = lw[nt][0]; lam[1] = lam[0] + lw[nt][1]; lam[2] = lam[1] + lw[nt][2]; lam[3] = lam[2] + lw[nt][3];
        const float t1 = __shfl(lam[3], lane - 16), t2 = __shfl(lam[3], lane - 32), t3 = __shfl(lam[3], lane - 48);
        const float off = (qd >= 1 ? t1 : 0.f) + (qd >= 2 ? t2 : 0.f) + (qd >= 3 ? t3 : 0.f);
#pragma unroll
        for (int r = 0; r < 4; ++r) lam[r] += off;
        lend[nt] = __shfl(lam[3], 48 + fr);
        float bt4[4], kt4[4];
        float epv[4];
#pragma unroll
        for (int r = 0; r < 4; ++r) epv[r] = __expf(lam[r]);
        float ep_prev = __shfl(epv[3], lane - 16); if (qd == 0) ep_prev = 1.f;
        const float eendall = __expf(lend[nt]);
#pragma unroll
        for (int r = 0; r < 4; ++r) { const float ep = epv[r], epm = r ? epv[r - 1] : ep_prev, einv = __builtin_amdgcn_rcpf(ep), eend = eendall * einv;
            const float bb = kap[nt][r] * alp[nt][r]; const int o = (4 * qd + r) * 72 + 16 * nt + fr;
            IMG[o] = (bf16)cvtpk(-kap[nt][r] * epm, 0.f); IMG[1152 + o] = (bf16)cvtpk(er[nt][r] * ep, 0.f); IMG[2304 + o] = (bf16)cvtpk(bb * einv, 0.f); IMG[3456 + o] = (bf16)cvtpk(ek[nt][r] * einv, 0.f);
            bt4[r] = bb * eend; kt4[r] = ek[nt][r] * eend; }
        btf[nt].x = cvtpk(bt4[0], bt4[1]); btf[nt].y = cvtpk(bt4[2], bt4[3]); ktf[nt].x = cvtpk(kt4[0], kt4[1]); ktf[nt].y = cvtpk(kt4[2], kt4[3]); }
    asm volatile("s_waitcnt lgkmcnt(0)" ::: "memory");
    f32x4 Lab = (f32x4){0.f, 0.f, 0.f, 0.f}, Lak = Lab, Mrb = Lab, Mrk = Lab;
#pragma unroll
    for (int ks = 0; ks < 2; ++ks) { const int o = fr * 72 + 32 * ks + 8 * qd;
        const bf16x8_t aA = *(const LAS bf16x8_t*)(IMG + o), aR = *(const LAS bf16x8_t*)(IMG + 1152 + o), bB = *(const LAS bf16x8_t*)(IMG + 2304 + o), bK = *(const LAS bf16x8_t*)(IMG + 3456 + o);
        Lab = MFMA16(aA, bB, Lab); Lak = MFMA16(aA, bK, Lak); Mrb = MFMA16(aR, bB, Mrb); Mrk = MFMA16(aR, bK, Mrk); }
#pragma unroll
    for (int r = 0; r < 4; ++r) { const int t = 4 * qd + r; if (!(fr < t)) { Lab[r] = 0.f; Lak[r] = 0.f; } if (!(fr <= t)) { Mrb[r] = 0.f; Mrk[r] = 0.f; } Lf[t * 17 + fr] = Lab[r]; }
    asm volatile("s_waitcnt lgkmcnt(0)" ::: "memory");
    float Tc[16];
#pragma unroll
    for (int t = 0; t < 16; ++t) { float acc = (t == fr) ? 1.f : 0.f;
#pragma unroll
        for (int s = 0; s < t; ++s) acc += Lf[t * 17 + s] * Tc[s];
        Tc[t] = acc; }
    f32x4 Tm;
#pragma unroll
    for (int r = 0; r < 4; ++r) Tm[r] = qd == 0 ? Tc[r] : (qd == 1 ? Tc[4 + r] : (qd == 2 ? Tc[8 + r] : Tc[12 + r]));
#pragma unroll
    for (int r = 0; r < 4; ++r) { const int o = (4 * qd + r) * 20 + fr; MT[o] = (bf16)cvtpk(Tm[r], 0.f); MT[320 + o] = (bf16)cvtpk(Mrb[r], 0.f); MT[640 + o] = (bf16)cvtpk(Lak[r], 0.f); MT[960 + o] = (bf16)cvtpk(Mrk[r], 0.f); }
    asm volatile("s_waitcnt lgkmcnt(0)" ::: "memory");
    { const int o = fr * 20 + 4 * qd;
      const u32x2_t mrb = *(const LAS u32x2_t*)(MT + 320 + o), mrk = *(const LAS u32x2_t*)(MT + 960 + o);
      *(u32x2_t*)(pkg + PK_TM + lane * 8) = *(const LAS u32x2_t*)(MT + o); *(u32x2_t*)(pkg + PK_LAK + lane * 8) = *(const LAS u32x2_t*)(MT + 640 + o);
      *(u32x4_t*)(pkg + PK_MM + lane * 16) = (u32x4_t){mrk.x, mrk.y, mrb.x, mrb.y}; }
#pragma unroll
    for (int ks = 0; ks < 2; ++ks) { const int o = fr * 72 + 32 * ks + 4 * qd;
        const u32x2_t alo = *(const LAS u32x2_t*)(IMG + o), ahi = *(const LAS u32x2_t*)(IMG + o + 16), rlo = *(const LAS u32x2_t*)(IMG + 1152 + o), rhi = *(const LAS u32x2_t*)(IMG + 1152 + o + 16);
        *(u32x4_t*)(pkg + PK_AH + ks * 1024 + lane * 16) = (u32x4_t){alo.x, alo.y, ahi.x, ahi.y}; *(u32x4_t*)(pkg + PK_RH + ks * 1024 + lane * 16) = (u32x4_t){rlo.x, rlo.y, rhi.x, rhi.y}; }
#pragma unroll
    for (int nt = 0; nt < 4; ++nt) { *(u32x4_t*)(pkg + PK_KB + nt * 1024 + lane * 16) = (u32x4_t){ktf[nt].x, ktf[nt].y, btf[nt].x, btf[nt].y};
        u32x2_t vf; vf.x = cvtpk(ev[nt][0], ev[nt][1]); vf.y = cvtpk(ev[nt][2], ev[nt][3]); *(u32x2_t*)(pkg + PK_VV + nt * 512 + lane * 8) = vf;
        if (qd == 0) ((float*)(pkg + PK_GE))[16 * nt + fr] = __expf(lend[nt]); }
    asm volatile("s_waitcnt lgkmcnt(0)" ::: "memory");
}
DI void phase_rwkv_r1(const Args& A, int l, LAS unsigned char* lds, int bid, int G, int tid, int wave, int lane) {
    constexpr int NIT = 2 * NB * 6 * 16; int dh_staged = -1;
    __syncthreads();
    for (int it = bid; it < NIT; it += G) rwkv_r1_item(A, l, lds, it, dh_staged, tid, wave, lane);
    __syncthreads();
}

struct RkOps { bf16x8_t ah[2], rh[2], kb[4], mm; bf16x4_t vv, tm, lak; f32x4 ge[4]; };
DI bf16x8_t widen4(const bf16x4_t a) { return __builtin_shufflevector(a, (bf16x4_t){0, 0, 0, 0}, 0, 1, 2, 3, 4, 5, 6, 7); }
DI void rk_step(const RkOps& c, f32x4 (&sT)[4], bf16* yb, int dir, int b, int hh, int vb, int cc, int fr, int qd) {
    const f32x4 zero4 = (f32x4){0.f, 0.f, 0.f, 0.f};
    union { unsigned u[4]; bf16x8_t v; } s0, s1;
    s0.u[0] = cvtpk(sT[0][0], sT[0][1]); s0.u[1] = cvtpk(sT[0][2], sT[0][3]); s0.u[2] = cvtpk(sT[1][0], sT[1][1]); s0.u[3] = cvtpk(sT[1][2], sT[1][3]);
    s1.u[0] = cvtpk(sT[2][0], sT[2][1]); s1.u[1] = cvtpk(sT[2][2], sT[2][3]); s1.u[2] = cvtpk(sT[3][0], sT[3][1]); s1.u[3] = cvtpk(sT[3][2], sT[3][3]);
    f32x4 ax = MFMA16(widen4(c.lak), widen4(c.vv), zero4); ax = MFMA16(c.ah[0], s0.v, ax); ax = MFMA16(c.ah[1], s1.v, ax);
    f32x4 ay = MFMA16(s0.v, c.rh[0], zero4); ay = MFMA16(s1.v, c.rh[1], ay);
    const f32x4 au = MFMA16(widen4(c.tm), widen4(pack4(ax)), zero4);
    const bf16x8_t vu = __builtin_shufflevector(c.vv, pack4(au), 0, 1, 2, 3, 4, 5, 6, 7);
    ay = MFMA16(vu, c.mm, ay);
#pragma unroll
    for (int kt = 0; kt < 4; ++kt) sT[kt] = MFMA16(c.kb[kt], vu, sT[kt] * c.ge[kt]);
    const int sgn = dir ? -1 : 1; const int tok0 = b * SEQ + (dir ? SEQ - 1 - 16 * cc : 16 * cc);
    { u32x2_t w; w.x = cvtpk(ay[0], ay[1]); w.y = cvtpk(ay[2], ay[3]); *(u32x2_t*)(yb + ((size_t)dir * NT + tok0 + sgn * fr) * RW + hh * 64 + 16 * vb + 4 * qd) = w; }
}
constexpr int R2_SLOTS = 8, R2_CTL = R2_SLOTS * PKG_BYTES;
static_assert(R2_CTL + 64 <= MISC_OFF, "rwkv r2 LDS");
DI void rk_load_lds(RkOps& o, const LAS unsigned char* pkg, int vb, int lane, int qd) {
#pragma unroll
    for (int ks = 0; ks < 2; ++ks) { o.ah[ks] = *(const LAS bf16x8_t*)(pkg + PK_AH + ks * 1024 + lane * 16); o.rh[ks] = *(const LAS bf16x8_t*)(pkg + PK_RH + ks * 1024 + lane * 16); }
#pragma unroll
    for (int kt = 0; kt < 4; ++kt) { o.kb[kt] = *(const LAS bf16x8_t*)(pkg + PK_KB + kt * 1024 + lane * 16); o.ge[kt] = *(const LAS f32x4*)(pkg + PK_GE + (16 * kt + 4 * qd) * 4); }
    o.mm = *(const LAS bf16x8_t*)(pkg + PK_MM + lane * 16);
    o.vv = *(const LAS bf16x4_t*)(pkg + PK_VV + vb * 512 + lane * 8); o.tm = *(const LAS bf16x4_t*)(pkg + PK_TM + lane * 8); o.lak = *(const LAS bf16x4_t*)(pkg + PK_LAK + lane * 8);
}
DI void rk_pkg_fetch(u32x4_t (&buf)[13], const unsigned char* pkg, int lane) {
#pragma unroll
    for (int i = 0; i < 12; ++i) buf[i] = *(const u32x4_t*)(pkg + i * 1024 + lane * 16);
    buf[12] = (lane < 16) ? *(const u32x4_t*)(pkg + 12288 + lane * 16) : (u32x4_t){0u, 0u, 0u, 0u};
}
DI void rwkv_r2_unit(const Args& A, LAS unsigned char* lds, int u, int tid, int wave, int lane) {
    bf16* yb = (bf16*)(A.ws + WS_RKY);
    const int dir = u / 48, rem = u % 48, b = rem / 6, hh = rem % 6; const int fr = lane & 15, qd = lane >> 4;
    const unsigned char* pkg0 = A.ws + WS_PKG + ((size_t)((dir * NB + b) * 6 + hh) * 128) * PKG_BYTES;
    volatile LAS unsigned* ready = (volatile LAS unsigned*)(lds + R2_CTL); volatile LAS unsigned* consumed = ready + 8;
    __syncthreads();
    if (tid < 16) ready[tid] = 0u;
    __syncthreads();
    if (wave >= 4) {
        const int j = wave - 4; u32x4_t cur[13], nxt[13];
        rk_pkg_fetch(cur, pkg0 + (size_t)j * PKG_BYTES, lane);
        for (int cc = j; cc < 128; cc += 4) {
            if (cc + 4 < 128) rk_pkg_fetch(nxt, pkg0 + (size_t)(cc + 4) * PKG_BYTES, lane);
            if (cc >= R2_SLOTS) { const unsigned need = (unsigned)(cc - R2_SLOTS + 1); unsigned spins = 0;
                for (;;) { const unsigned c0 = consumed[0], c1 = consumed[1], c2 = consumed[2], c3 = consumed[3];
                    if (c0 >= need && c1 >= need && c2 >= need && c3 >= need) break; if (++spins > (1u << 22)) break; __builtin_amdgcn_s_sleep(1); } }
            LAS unsigned char* slot = lds + (cc & (R2_SLOTS - 1)) * PKG_BYTES;
#pragma unroll
            for (int i = 0; i < 12; ++i) *(LAS u32x4_t*)(slot + i * 1024 + lane * 16) = cur[i];
            if (lane < 16) *(LAS u32x4_t*)(slot + 12288 + lane * 16) = cur[12];
            asm volatile("s_waitcnt lgkmcnt(0)" ::: "memory");
            if (lane == 0) ready[cc & (R2_SLOTS - 1)] = (unsigned)(cc + 1);
            asm volatile("" ::: "memory");
#pragma unroll
            for (int i = 0; i < 13; ++i) cur[i] = nxt[i];
        }
    } else {
        const int vb = wave; f32x4 sT[4];
#pragma unroll
        for (int kt = 0; kt < 4; ++kt) sT[kt] = (f32x4){0.f, 0.f, 0.f, 0.f};
#define RK_WAIT(cc_) do { unsigned spins = 0; while (ready[(cc_) & (R2_SLOTS - 1)] != (unsigned)((cc_) + 1)) { if (++spins > (1u << 22)) break; __builtin_amdgcn_s_sleep(1); } asm volatile("" ::: "memory"); } while (0)
        RkOps pa, pb;
        RK_WAIT(0); rk_load_lds(pa, lds, vb, lane, qd);
        for (int cc = 0; cc < 128; cc += 2) {
            RK_WAIT(cc + 1); rk_load_lds(pb, lds + ((cc + 1) & (R2_SLOTS - 1)) * PKG_BYTES, vb, lane, qd);
            rk_step(pa, sT, yb, dir, b, hh, vb, cc, fr, qd);
            asm volatile("s_waitcnt lgkmcnt(0)" ::: "memory"); if (lane == 0) consumed[vb] = (unsigned)(cc + 2); asm volatile("" ::: "memory");
            if (cc + 2 < 128) { RK_WAIT(cc + 2); rk_load_lds(pa, lds + ((cc + 2) & (R2_SLOTS - 1)) * PKG_BYTES, vb, lane, qd); }
            rk_step(pb, sT, yb, dir, b, hh, vb, cc + 1, fr, qd);
            if (cc + 2 < 128) { asm volatile("s_waitcnt lgkmcnt(0)" ::: "memory"); if (lane == 0) consumed[vb] = (unsigned)(cc + 3); asm volatile("" ::: "memory"); }
        }
#undef RK_WAIT
    }
    __syncthreads();
}


constexpr int YA_G2LD = 136;
static_assert(384 * YA_G2LD * 2 <= MISC_OFF, "yasm LDS");
DI void unpack4(const uint2 w, float (&f)[4]) { f[0] = __uint_as_float(w.x << 16); f[1] = __uint_as_float(w.x & 0xffff0000u); f[2] = __uint_as_float(w.y << 16); f[3] = __uint_as_float(w.y & 0xffff0000u); }
DI void yasm_token(const bf16* Z, const bf16* ao, const float* al, const bf16* num, const float* den, const f32x4 mgA, const f32x4 mgB, bf16* y, int tok, int lane) {
    const bf16* zr = Z + (size_t)tok * ZLD; bf16* yr = y + (size_t)tok * DM;
    const float lsev = al[((size_t)((lane >> 2) % 3) * NT + tok) * 4 + (lane & 3)];
    const float denv = den[((size_t)((lane >> 2) & 1) * NT + tok) * 4 + (lane & 3)];
    const bool lo32 = lane < 32; const int lb = lane & 31;
    uint2 av[3], nA[2], nB[2];
#pragma unroll
    for (int br = 0; br < 3; ++br) av[br] = *(const uint2*)(ao + ((size_t)br * NT + tok) * AW + 4 * lane);
#pragma unroll
    for (int d = 0; d < 2; ++d) { nA[d] = *(const uint2*)(num + ((size_t)d * NT + tok) * MW + 4 * lane); nB[d] = *(const uint2*)(num + ((size_t)d * NT + tok) * MW + 256 + 4 * lb); }
    const uint2 zA = *(const uint2*)(zr + ZMO + 4 * lane), zB = *(const uint2*)(zr + ZMO + 256 + 4 * lb);
    { const int hh = lane >> 4; const float l0 = __shfl(lsev, hh), l1 = __shfl(lsev, 4 + hh), l2 = __shfl(lsev, 8 + hh);
      const float mx = fmaxf(l0, fmaxf(l1, l2)); const float w0 = __expf(l0 - mx), w1 = __expf(l1 - mx), w2 = __expf(l2 - mx); const float inv = 1.f / (w0 + w1 + w2);
      float a0[4], a1[4], a2[4]; unpack4(av[0], a0); unpack4(av[1], a1); unpack4(av[2], a2);
      uint2 o; o.x = pkbf((w0 * a0[0] + w1 * a1[0] + w2 * a2[0]) * inv, (w0 * a0[1] + w1 * a1[1] + w2 * a2[1]) * inv); o.y = pkbf((w0 * a0[2] + w1 * a1[2] + w2 * a2[2]) * inv, (w0 * a0[3] + w1 * a1[3] + w2 * a2[3]) * inv);
      *(uint2*)(yr + 4 * lane) = o; }
    { const int hA = lane / 24, hB = lane < 8 ? 2 : 3;
      const float dfA = __shfl(denv, hA), dbA = __shfl(denv, 4 + hA), dfB = __shfl(denv, hB), dbB = __shfl(denv, 4 + hB);
      const float ifA = 1.f / fmaxf(fabsf(dfA), 1.f), ibA = 1.f / fmaxf(fabsf(dbA), 1.f), ifB = 1.f / fmaxf(fabsf(dfB), 1.f), ibB = 1.f / fmaxf(fabsf(dbB), 1.f);
      float f0[4], f1[4], a[4], b[4]; unpack4(nA[0], f0); unpack4(nA[1], f1);
#pragma unroll
      for (int i = 0; i < 4; ++i) a[i] = f0[i] * ifA + f1[i] * ibA;
      unpack4(nB[0], f0); unpack4(nB[1], f1);
#pragma unroll
      for (int i = 0; i < 4; ++i) b[i] = lo32 ? f0[i] * ifB + f1[i] * ibB : 0.f;
      const float sA = (a[0] + a[1]) + (a[2] + a[3]), qA = (a[0] * a[0] + a[1] * a[1]) + (a[2] * a[2] + a[3] * a[3]);
      const float sB = (b[0] + b[1]) + (b[2] + b[3]), qB = (b[0] * b[0] + b[1] * b[1]) + (b[2] * b[2] + b[3] * b[3]);
      float mA = 0.f, rA = 0.f, mB = 0.f, rB = 0.f;
#pragma unroll
      for (int h = 0; h < 4; ++h) { const float ps = (hA == h ? sA : 0.f) + ((lo32 && hB == h) ? sB : 0.f), pq = (hA == h ? qA : 0.f) + ((lo32 && hB == h) ? qB : 0.f);
          const float m = wave_sum(ps) * (1.f / 96.f); const float var = fmaxf(wave_sum(pq) * (1.f / 96.f) - m * m, 0.f); const float rs = rsqrtf(var + 1e-6f);
          if (hA == h) { mA = m; rA = rs; } if (hB == h) { mB = m; rB = rs; } }
      float g[4]; unpack4(zA, g);
      uint2 o; o.x = pkbf((a[0] - mA) * rA * mgA[0] * sigm(g[0]), (a[1] - mA) * rA * mgA[1] * sigm(g[1])); o.y = pkbf((a[2] - mA) * rA * mgA[2] * sigm(g[2]), (a[3] - mA) * rA * mgA[3] * sigm(g[3]));
      *(uint2*)(yr + AW + RW + 4 * lane) = o;
      unpack4(zB, g);
      o.x = pkbf((b[0] - mB) * rB * mgB[0] * sigm(g[0]), (b[1] - mB) * rB * mgB[1] * sigm(g[1])); o.y = pkbf((b[2] - mB) * rB * mgB[2] * sigm(g[2]), (b[3] - mB) * rB * mgB[3] * sigm(g[3]));
      if (lo32) *(uint2*)(yr + AW + RW + 256 + 4 * lane) = o; }
}
DI void phase_yasm(const Args& A, int l, LAS unsigned char* lds, int gw, int ngw, int tid, int lane) {
    const bf16* Z = (const bf16*)(A.ws + WS_Z); const bf16* ao = (const bf16*)(A.ws + WS_ATTO); const float* al = (const float*)(A.ws + WS_ATTL);
    const bf16* rky = (const bf16*)(A.ws + WS_RKY); const bf16* rkb = (const bf16*)(A.ws + WS_RKB);
    const bf16* num = (const bf16*)(A.ws + WS_MLNUM); const float* den = (const float*)(A.ws + WS_MLDEN); bf16* y = (bf16*)(A.ws + WS_HB);
    const float* lng = A.in[I_RLNG] + (size_t)l * RW; const float* lnb = A.in[I_RLNB] + (size_t)l * RW; const float* mlg = A.in[I_MLNG] + (size_t)l * MW;
    LAS bf16* G2T = (LAS bf16*)lds;
    __syncthreads();
    { const u32x4_t* src = (const u32x4_t*)(A.ws + WS_G2T + (size_t)l * RW * 128 * 2);
      for (int idx = tid; idx < RW * 16; idx += NTHR) { const int col = idx >> 4, ch = idx & 15; *(LAS u32x4_t*)(G2T + col * YA_G2LD + ch * 8) = src[idx]; } }
    __syncthreads();
    const int fr = lane & 15, qd = lane >> 4;
    for (int item = gw; item < (NT / 16) * 6; item += ngw) {
        const int hh = item % 6, tg = item / 6; const int tokA = tg * 16 + fr;
        const size_t o = (size_t)tokA * RW + hh * 64 + 16 * qd;
        const uint4 y0a = *(const uint4*)(rky + o), y0b = *(const uint4*)(rky + o + 8), y1a = *(const uint4*)(rky + (size_t)NT * RW + o), y1b = *(const uint4*)(rky + (size_t)NT * RW + o + 8);
        const uint4 b0a = *(const uint4*)(rkb + o), b0b = *(const uint4*)(rkb + o + 8), b1a = *(const uint4*)(rkb + (size_t)NT * RW + o), b1b = *(const uint4*)(rkb + (size_t)NT * RW + o + 8);
        f32x4 gacc[4];
#pragma unroll
        for (int nt = 0; nt < 4; ++nt) gacc[nt] = (f32x4){0.f, 0.f, 0.f, 0.f};
#pragma unroll
        for (int ks = 0; ks < 4; ++ks) { float f[8]; unpack8(*(const uint4*)(Z + (size_t)tokA * ZLD + ZGD + 32 * ks + 8 * qd), f);
            union { unsigned u[4]; bf16x8_t v; } a;
#pragma unroll
            for (int e = 0; e < 4; ++e) a.u[e] = cvtpk(sigm(f[2 * e]), sigm(f[2 * e + 1]));
#pragma unroll
            for (int nt = 0; nt < 4; ++nt) { const bf16x8_t bg = *(const LAS bf16x8_t*)(G2T + (hh * 64 + 16 * (fr >> 2) + 4 * nt + (fr & 3)) * YA_G2LD + 32 * ks + 8 * qd); gacc[nt] = MFMA16(bg, a.v, gacc[nt]); } }
        float sv[16], bv[16], t0[8], t1[8];
        unpack8(y0a, t0); unpack8(y1a, t1);
#pragma unroll
        for (int j = 0; j < 8; ++j) sv[j] = t0[j] + t1[j];
        unpack8(y0b, t0); unpack8(y1b, t1);
#pragma unroll
        for (int j = 0; j < 8; ++j) sv[8 + j] = t0[j] + t1[j];
        unpack8(b0a, t0); unpack8(b1a, t1);
#pragma unroll
        for (int j = 0; j < 8; ++j) bv[j] = t0[j] + t1[j];
        unpack8(b0b, t0); unpack8(b1b, t1);
#pragma unroll
        for (int j = 0; j < 8; ++j) bv[8 + j] = t0[j] + t1[j];
        float sm = 0.f;
#pragma unroll
        for (int j = 0; j < 16; ++j) sm += sv[j];
        sm += __shfl_xor(sm, 16); sm += __shfl_xor(sm, 32); sm *= (1.f / 64.f);
        float vr = 0.f;
#pragma unroll
        for (int j = 0; j < 16; ++j) { sv[j] -= sm; vr += sv[j] * sv[j]; }
        vr += __shfl_xor(vr, 16); vr += __shfl_xor(vr, 32); vr = rsqrtf(vr * (1.f / 64.f) + 64e-5f);
        const f32x4* lgp = (const f32x4*)(lng + hh * 64 + 16 * qd); const f32x4* lbp = (const f32x4*)(lnb + hh * 64 + 16 * qd);
        unsigned ow[8];
#pragma unroll
        for (int q = 0; q < 4; ++q) { const f32x4 lg_ = lgp[q], lb_ = lbp[q];
            ow[2 * q] = pkbf((sv[4 * q] * vr * lg_[0] + lb_[0] + bv[4 * q]) * gacc[q][0], (sv[4 * q + 1] * vr * lg_[1] + lb_[1] + bv[4 * q + 1]) * gacc[q][1]);
            ow[2 * q + 1] = pkbf((sv[4 * q + 2] * vr * lg_[2] + lb_[2] + bv[4 * q + 2]) * gacc[q][2], (sv[4 * q + 3] * vr * lg_[3] + lb_[3] + bv[4 * q + 3]) * gacc[q][3]); }
        bf16* yo = y + (size_t)tokA * DM + AW + hh * 64 + 16 * qd;
        *(uint4*)yo = make_uint4(ow[0], ow[1], ow[2], ow[3]); *(uint4*)(yo + 8) = make_uint4(ow[4], ow[5], ow[6], ow[7]);
    }
    const f32x4 mgA = *(const f32x4*)(mlg + 4 * lane), mgB = *(const f32x4*)(mlg + 256 + 4 * (lane & 31));
    for (int tok = gw; tok < NT; tok += 2 * ngw) { yasm_token(Z, ao, al, num, den, mgA, mgB, y, tok, lane); if (tok + ngw < NT) yasm_token(Z, ao, al, num, den, mgA, mgB, y, tok + ngw, lane); }
    __syncthreads();
}

constexpr int L2_WLD = 1032;
constexpr int L2_WHI = 0, L2_WLO = 16 * L2_WLD * 2, L2_G2 = 2 * L2_WLO, L2_EX = L2_G2 + DM * 4, L2_SS = L2_EX + 8 * 1024, L2_END = L2_SS + 8 * 16 * 4;
static_assert(L2_END <= MISC_OFF, "ln2 LDS");
DI void phase_ln2(const Args& A, int l, LAS unsigned char* lds, int bid, int G, int tid, int wave, int lane) {
    const bf16* x1 = (const bf16*)(A.ws + WS_X1); unsigned char* hb = A.ws + WS_HB; float* aff = (float*)(A.ws + WS_AFF);
    const float* router = A.in[I_ROUTER] + (size_t)l * DM * NE; const float* g2 = A.in[I_LN2G] + (size_t)l * DM;
    LAS bf16* Whi = (LAS bf16*)(lds + L2_WHI); LAS bf16* Wlo = (LAS bf16*)(lds + L2_WLO); LAS float* g2s = (LAS float*)(lds + L2_G2);
    LAS unsigned char* ex = lds + L2_EX; LAS float* ssx = (LAS float*)(lds + L2_SS);
    const int fr = lane & 15, qd = lane >> 4, tg = wave >> 1, kh = wave & 1;
    __syncthreads();
    for (int i = tid; i < DM * NE; i += NTHR) { const int e = i & 15, c = i >> 4; const float v = router[i] * g2[c]; const unsigned h = f2bf(v);
        Whi[e * L2_WLD + c] = (bf16)h; Wlo[e * L2_WLD + c] = (bf16)f2bf(v - bf2f(h)); }
    for (int i = tid; i < DM; i += NTHR) g2s[i] = g2[i];
    for (int grp = bid; grp < NT / 64; grp += G) {
        const int tokb = grp * 64 + tg * 16, tok = tokb + fr;
        const u32x4_t* xp = (const u32x4_t*)(x1 + (size_t)tok * DM + kh * 512 + 16 * qd);
        u32x4_t xa[8][2];
#pragma unroll
        for (int p = 0; p < 8; ++p) { xa[p][0] = xp[8 * p]; xa[p][1] = xp[8 * p + 1]; }
        __syncthreads();
        f32x4 acc = (f32x4){0.f, 0.f, 0.f, 0.f}; float ss = 0.f;
#pragma unroll
        for (int p = 0; p < 8; ++p)
#pragma unroll
            for (int hf = 0; hf < 2; ++hf) { const int c = kh * 512 + 64 * p + 16 * qd + 8 * hf;
                const bf16x8_t a = __builtin_bit_cast(bf16x8_t, xa[p][hf]);
                const bf16x8_t bh = *(const LAS bf16x8_t*)(Whi + fr * L2_WLD + c), bl = *(const LAS bf16x8_t*)(Wlo + fr * L2_WLD + c);
                acc = MFMA16(a, bh, acc); acc = MFMA16(a, bl, acc);
#pragma unroll
                for (int e = 0; e < 4; ++e) { const float lo = __uint_as_float(xa[p][hf][e] << 16), hi = __uint_as_float(xa[p][hf][e] & 0xffff0000u); ss += lo * lo + hi * hi; } }
        ss += __shfl_xor(ss, 16); ss += __shfl_xor(ss, 32);
        *(LAS f32x4*)(ex + wave * 1024 + lane * 16) = acc; if (qd == 0) ssx[wave * 16 + fr] = ss;
        __syncthreads();
        { const f32x4 oth = *(const LAS f32x4*)(ex + (wave ^ 1) * 1024 + lane * 16); acc += oth; ss += ssx[(wave ^ 1) * 16 + fr]; }
        const float rs = rsqrtf(ss * (1.f / DM) + RMS_EPS);
        unsigned char* hrow = hb + (size_t)tok * DM + kh * 512 + 16 * qd; const float rsc = rs * F8_HSC;
#pragma unroll
        for (int p = 0; p < 8; ++p) { const LAS f32x4* gp = (const LAS f32x4*)(g2s + kh * 512 + 64 * p + 16 * qd); u32x4_t o;
#pragma unroll
            for (int q = 0; q < 4; ++q) { const f32x4 g = gp[q]; const unsigned u0 = xa[p][q >> 1][2 * (q & 1)], u1 = xa[p][q >> 1][2 * (q & 1) + 1];
                o[q] = pk4_fp8(__uint_as_float(u0 << 16) * rsc * g[0], __uint_as_float(u0 & 0xffff0000u) * rsc * g[1], __uint_as_float(u1 << 16) * rsc * g[2], __uint_as_float(u1 & 0xffff0000u) * rsc * g[3]); }
            *(u32x4_t*)(hrow + 64 * p) = o; }
        if (kh == 0) { f32x4 af;
#pragma unroll
            for (int r = 0; r < 4; ++r) { const float lg = acc[r] * __shfl(rs, 4 * qd + r); float mx = lg;
#pragma unroll
                for (int o = 1; o < 16; o <<= 1) mx = fmaxf(mx, __shfl_xor(mx, o));
                const float ev = expf(lg - mx); float sm = ev;
#pragma unroll
                for (int o = 1; o < 16; o <<= 1) sm += __shfl_xor(sm, o);
                af[r] = ev / sm; }
            *(f32x4*)(aff + ((size_t)(tokb / SEQ) * NE + fr) * SEQ + (tokb % SEQ) + 4 * qd) = af; }
    }
    __syncthreads();
}

constexpr int PH_PER_LAYER = 10, NPH = 1 + NL * PH_PER_LAYER + 1;
#ifndef MK_ONE_LAUNCH
#define MK_ONE_LAUNCH 1
#endif

#ifndef MK_DUP
#define MK_DUP 0
#endif
constexpr int P0_END = NL * 16 * 64 + NL * 16 * 16 + NL * NE * 3 * 8 * 44, P0_SPLIT = P0_END - 0;
template <int l> DI void run_layer(const Args& A, LAS unsigned char* lds, const XcdBarrier& bar, int lo, int hi, int G, int bid, int tid, int lane, int wave, int gw, int ngw, int gtid, int nthr) {
#define IN(k) (lo <= (k) && (k) < hi)
#define SEAM(k) do { if (IN(k) && IN((k) + 1)) xcd_barrier(bar); } while (0)
#define PH(k, ...) do { if (IN(pb + (k))) { { __VA_ARGS__ } if ((MK_DUP >> (k)) & 1) { xcd_barrier(bar); { __VA_ARGS__ } } } SEAM(pb + (k)); } while (0)
    const int pb = 1 + l * PH_PER_LAYER;
    PH(0, phase_ln1(A, l, gw, ngw, lane););
    PH(1,
        pg8::Gemm g{(const bf16*)(A.ws + WS_HB), (const bf16*)(A.ws + WS_WTIN) + (size_t)l * ZLD * DM, NT, ZLD, DM};
        pg8::StaticOrder S; S.init(NT, ZLD, G, bid);
        pg8::EpiBf16<0> E{(bf16*)(A.ws + WS_Z), ZLD, nullptr, 0, 0, 1.f};
        pg8::gemm_phase<pg8::EpiBf16<0>, pg8::StaticOrder, true, true>(lds, g, S, E););
    PH(2, phase_attn(A, lds, 0, G > ATT_SCAN_BLK0 ? ATT_SPLIT : ATT_UNITS, bid, G, tid, wave, lane); phase_rwkv_r1(A, l, lds, bid, G, tid, wave, lane); if ((MK_DUP >> 13) & 1) phase_rwkv_r1(A, l, lds, bid, G, tid, wave, lane);
          phase_mlstm_m1(A, l, lds, bid, G, tid, wave, lane); if ((MK_DUP >> 16) & 1) phase_mlstm_m1(A, l, lds, bid, G, tid, wave, lane););
    PH(3, if (l == 0 && P0_SPLIT < P0_END) { const int nb = G > 160 ? G - 160 : G, b0 = G > 160 ? bid - 160 : bid; if (b0 >= 0) { __syncthreads(); phase_p0(A, lds, P0_SPLIT, P0_END, b0 * NWAVES + wave, nb * NWAVES, wave, lane); __syncthreads(); } }
          if (G > ATT_SCAN_BLK0 && bid >= ATT_SCAN_BLK0) phase_attn(A, lds, ATT_SPLIT, ATT_UNITS, bid - ATT_SCAN_BLK0, G - ATT_SCAN_BLK0, tid, wave, lane);
          for (int rep = 0; rep < 1 + ((MK_DUP >> 14) & 1); ++rep) for (int u = bid; u < 96; u += G) rwkv_r2_unit(A, lds, u, tid, wave, lane);
          for (int rep = 0; rep < 1 + ((MK_DUP >> 15) & 1); ++rep) for (int u = bid; u < 96 + 64; u += G) { if (u >= 96) mlstm_m2_unit(A, lds, u - 96, tid, wave, lane); });
    PH(4, phase_yasm(A, l, lds, gw, ngw, tid, lane););
    PH(5,
        pg8::Gemm g{(const bf16*)(A.ws + WS_HB), (const bf16*)(A.ws + WS_WTOUT) + (size_t)l * DM * DM, NT, DM, DM};
        pg8::StaticOrder S; S.init(NT, DM, G, bid);
        EpiResT<(l > 0)> E{(l == 0) ? (const void*)A.in[I_X] : (const void*)(A.ws + WS_X2), (bf16*)(A.ws + WS_X1), DM};
        pg8::gemm_phase<EpiResT<(l > 0)>, pg8::StaticOrder, true, true>(lds, g, S, E););
    PH(6, phase_ln2(A, l, lds, bid, G, tid, wave, lane););
    PH(7, phase_topk(A, lds, bid, G, tid, wave, lane););
    PH(8,
        pg8::Gemm g{(const bf16*)(A.ws + WS_XG), (const bf16*)(A.ws + WS_W13T + (size_t)l * NE * 5632 * DM), NSLOT, NE * 5632, DM / 2};
        GroupOrder S; S.init(22, G, bid);
        EpiSwiGLU E{A.ws + WS_ACT, 22};
        pg8::gemm_phase<EpiSwiGLU, GroupOrder, true, true, true>(lds, g, S, E););
    PH(9,
        pg8::Gemm g{(const bf16*)(A.ws + WS_ACT), (const bf16*)(A.ws + WS_W2T + (size_t)l * NE * DM * FF), NSLOT, NE * DM, FF / 2};
        GroupOrder S; S.init(4, G, bid);
        EpiGate E{(bf16*)(A.ws + WS_YS), (const float*)(A.ws + WS_GATE)};
        pg8::gemm_phase<EpiGate, GroupOrder, true, true, true>(lds, g, S, E););
#undef PH
#undef IN
#undef SEAM
}

__global__ void __launch_bounds__(NTHR, 2) mk_fwd(Args A) {
    extern __shared__ __attribute__((aligned(16))) unsigned char lds_raw[];
    LAS unsigned char* lds = (LAS unsigned char*)lds_raw;
    const int tid = threadIdx.x, lane = tid & 63, wave = __builtin_amdgcn_readfirstlane(tid >> 6);
    const int G = gridDim.x, bid = blockIdx.x;
    const int gw = bid * NWAVES + wave, ngw = G * NWAVES, gtid = bid * NTHR + tid, nthr = G * NTHR;
    volatile LAS unsigned* MISC = (volatile LAS unsigned*)(lds + MISC_OFF);
    if (tid < 64) MISC[tid] = 0u;
    __syncthreads();
    const int lo = A.ph_lo, hi = A.ph_hi;
    const bool use_bar = (hi - lo) > 1;
    XcdBarrier bar; bar.bar = (unsigned*)(A.ws + WS_CTL) + CW_BAR; bar.x = 0; bar.st = MISC + 8;
    if (use_bar) bar = xcd_barrier_post((unsigned*)(A.ws + WS_CTL) + CW_BAR, MISC + 8);
#define IN(k) (lo <= (k) && (k) < hi)
#define SEAM(k) do { if (IN(k) && IN((k) + 1)) xcd_barrier(bar); } while (0)

    if (IN(0)) { phase_p0(A, lds, 0, P0_SPLIT, gw, ngw, wave, lane); if ((MK_DUP >> 10) & 1) { xcd_barrier(bar); phase_p0(A, lds, 0, P0_SPLIT, gw, ngw, wave, lane); } } SEAM(0);

    run_layer<0>(A, lds, bar, lo, hi, G, bid, tid, lane, wave, gw, ngw, gtid, nthr);
    run_layer<1>(A, lds, bar, lo, hi, G, bid, tid, lane, wave, gw, ngw, gtid, nthr);
    if (IN(NPH - 1)) { phase_final(A, gw, ngw, lane); if ((MK_DUP >> 11) & 1) { xcd_barrier(bar); phase_final(A, gw, ngw, lane); } }
#undef IN
#undef SEAM
}
}

extern "C" void kernel_launch(void* const* d_in, const int* in_sizes, int n_in, void* d_out, int out_size, void* d_ws, size_t ws_size, hipStream_t stream) {
    using namespace mk;
    static int grid = 0;
    if (grid == 0) {
        if (n_in != N_IN || out_size != NT * DM || ws_size < WS_END) { fprintf(stderr, "kernel_launch: unexpected shapes (n_in %d, out %d, ws %zu < %zu)\n", n_in, out_size, ws_size, (size_t)WS_END); grid = -1; return; }
        int dev = 0, cus = 0, per_cu = 0;
        if (hipGetDevice(&dev) != hipSuccess || hipDeviceGetAttribute(&cus, hipDeviceAttributeMultiprocessorCount, dev) != hipSuccess) { grid = -1; return; }
        if (hipFuncSetAttribute((const void*)mk_fwd, hipFuncAttributeMaxDynamicSharedMemorySize, LDS_BYTES) != hipSuccess) { fprintf(stderr, "kernel_launch: hipFuncSetAttribute failed\n"); grid = -1; return; }
        if (hipOccupancyMaxActiveBlocksPerMultiprocessor(&per_cu, (const void*)mk_fwd, NTHR, LDS_BYTES) != hipSuccess || per_cu < 1) fprintf(stderr, "kernel_launch: occupancy query reports %d\n", per_cu);
        (void)hipGetLastError();
        grid = cus;
    }
    if (grid < 0) return;
    hipMemsetAsync((char*)d_ws + WS_CTL, 0, CTL_ZERO_BYTES, stream);
    Args a{};
    for (int i = 0; i < N_IN; ++i) a.in[i] = (const float*)d_in[i];
    a.out = (float*)d_out; a.ws = (unsigned char*)d_ws;
#if MK_ONE_LAUNCH
    a.ph_lo = 0; a.ph_hi = NPH;
    hipLaunchKernelGGL(mk_fwd, dim3(grid), dim3(NTHR), LDS_BYTES, stream, a);
#else
    for (int p = 0; p < NPH; ++p) { a.ph_lo = p; a.ph_hi = p + 1; hipLaunchKernelGGL(mk_fwd, dim3(grid), dim3(NTHR), LDS_BYTES, stream, a); }
#endif
}
```

```cpp
#include <hip/hip_runtime.h>
#include <cstdio>
#include <cstdint>
namespace pg8 {
#define PG8_LAS __attribute__((address_space(3)))
typedef unsigned short bf16_t;
typedef short bf16x8 __attribute__((ext_vector_type(8)));
typedef float f32x4 __attribute__((ext_vector_type(4)));
typedef unsigned u32x4 __attribute__((ext_vector_type(4)));
constexpr int BM = 256, BK = 64, HALF = 128, HTB = HALF * BK * 2  , STAGE_BYTES = 8 * HTB, NXCD = 8, WGM = 8;

__host__ __device__ __forceinline__ int lds_byte(int r, int c) { const int st = (r >> 4) * 2 + (c >> 5), rr = r & 15, cc = c & 31, ob = rr * 64 + cc * 2; return st * 1024 + (ob ^ (((ob >> 9) & 1) << 5)); }
__host__ __device__ __forceinline__ void stage_rc(int b, int& R, int& C) { const int st = b / 1024, sb = b % 1024, swz = sb ^ (((sb >> 9) & 1) << 5); R = (st >> 1) * 16 + swz / 64; C = (st & 1) * 32 + (swz % 64) / 2; }
__host__ __device__ __forceinline__ int perm32(int rho) { const int n = rho >> 4, i = rho & 15; return 8 * (i >> 2) + 4 * n + (i & 3); }

struct Unit { int pm, pn; };
struct Gemm { const bf16_t* A; const bf16_t* Bt; int M, N, K; };

struct StaticOrder {
    int nM, nN, nwg, G, c;
    __host__ __device__ void init(int M, int N, int G_, int c_) { nM = M / BM; nN = N / BM; nwg = nM * nN; G = G_; c = c_; }
    __host__ __device__ bool next(int i, Unit& u) const {
        const long L = (long)i * G + c; if (L >= nwg) return false;
        int wgid = (int)L; { const int q = nwg / NXCD, r = nwg % NXCD, xcd = wgid % NXCD, off = wgid / NXCD; wgid = (xcd < r ? xcd * (q + 1) : r * (q + 1) + (xcd - r) * q) + off; }
        const int nig = WGM * nN, gid = wgid / nig, fm = gid * WGM, gsz = (nM - fm) < WGM ? (nM - fm) : WGM;
        u.pm = fm + ((wgid % nig) % gsz); u.pn = (wgid % nig) / gsz; return true;
    }
    __device__ __forceinline__ void a_ready(const Unit&) const {}
    __device__ __forceinline__ void done(const Unit&) const {}
};

__device__ __forceinline__ unsigned cvt_pk_bf16(float lo, float hi) { unsigned r; asm volatile("v_cvt_pk_bf16_f32 %0, %1, %2" : "=v"(r) : "v"(lo), "v"(hi)); return r; }
typedef float f32x2 __attribute__((ext_vector_type(2)));
__device__ __forceinline__ f32x2 gelu_pk(f32x2 v) {
    const f32x2 av = __builtin_elementwise_abs(v), d = av * 0.2316418882f + 1.0f;
    f32x2 t; t.x = __builtin_amdgcn_rcpf(d.x); t.y = __builtin_amdgcn_rcpf(d.y);
    f32x2 q = t * 0.5307027145f + (-0.7265760135f); q = q * t + 0.7107068705f; q = q * t + (-0.142248368f); q = q * t + 0.127414796f; q = q * t;
    const f32x2 s = (v * v) * (-0.72134752044f);
    f32x2 e; e.x = __builtin_amdgcn_exp2f(s.x); e.y = __builtin_amdgcn_exp2f(s.y);
    const f32x2 m = v * (q * e), r = v - m;
    f32x2 o; o.x = v.x < 0.f ? m.x : r.x; o.y = v.y < 0.f ? m.y : r.y; return o;
}

template <int ACT  > struct EpiBf16 {
    static constexpr bool PERM = true, AFTER_DRAIN = false; static_assert(ACT == 0 || ACT == 1, "EpiBf16: ACT is 0 (none) or 1 (gelu_pk)");
    bf16_t* O; int ldc; const float* bias; int split_cols; size_t split_stride; float scale0;
    __device__ __forceinline__ void operator()(const f32x4 (&acc)[2][2][4][2], const Unit& u, int wr, int wc, int fr, int fq) const {
        const int row0 = u.pm * BM + wr * 64 + fr; int colt = u.pn * BM; bf16_t* base = O;
        float sc = 1.f; if (split_cols) { const int t = colt / split_cols; base += (size_t)t * split_stride; colt -= t * split_cols; if (t == 0) sc = scale0; }
        const int col0 = colt + wc * 32 + 8 * fq, bcol0 = u.pn * BM + wc * 32 + 8 * fq;
        f32x4 bv[2][2];
#pragma unroll
        for (int bj = 0; bj < 2; ++bj)
#pragma unroll
            for (int n = 0; n < 2; ++n) bv[bj][n] = bias ? *(const f32x4*)(bias + bcol0 + bj * HALF + 4 * n) : (f32x4){0.f, 0.f, 0.f, 0.f};
#pragma unroll
        for (int ai = 0; ai < 2; ++ai)
#pragma unroll
            for (int m = 0; m < 4; ++m) { bf16_t* rowp = base + (size_t)(row0 + ai * HALF + m * 16) * ldc + col0;
#pragma unroll
                for (int bj = 0; bj < 2; ++bj) { f32x4 v0 = acc[ai][bj][m][0] + bv[bj][0], v1 = acc[ai][bj][m][1] + bv[bj][1];
                    if (ACT == 1) { f32x2 a = gelu_pk((f32x2){v0[0], v0[1]}), b = gelu_pk((f32x2){v0[2], v0[3]}), c = gelu_pk((f32x2){v1[0], v1[1]}), d = gelu_pk((f32x2){v1[2], v1[3]});
                        v0 = (f32x4){a.x, a.y, b.x, b.y}; v1 = (f32x4){c.x, c.y, d.x, d.y}; }
                    v0 = v0 * sc; v1 = v1 * sc; u32x4 w; w.x = cvt_pk_bf16(v0[0], v0[1]); w.y = cvt_pk_bf16(v0[2], v0[3]); w.z = cvt_pk_bf16(v1[0], v1[1]); w.w = cvt_pk_bf16(v1[2], v1[3]);
                    *(u32x4*)(rowp + bj * HALF) = w; } }
    }
};
template <class Epi, class Sched, bool ALIGN_EPI = false, bool SP2 = false, bool F8 = false>
__device__ __forceinline__ void gemm_phase(PG8_LAS unsigned char* lds, const Gemm g, const Sched& S, const Epi& E) {
    const int tid = threadIdx.x, wid = __builtin_amdgcn_readfirstlane(tid >> 6), lane = tid & 63, wr = wid >> 2, wc = wid & 3, fr = lane & 15, fq = lane >> 4;
    int Kq = g.K; if constexpr (F8) asm volatile("" : "+s"(Kq));
    const int K = Kq, nt = K / BK;
    unsigned voffA[2], voffB[2];
#pragma unroll
    for (int i = 0; i < 2; ++i) { int R, C; stage_rc(tid * 16 + i * 8192, R, C); const int Rb = Epi::PERM ? ((R & ~31) + perm32(R & 31)) : R;
        voffA[i] = (unsigned)(R * K + C) * 2u; voffB[i] = (unsigned)(Rb * K + C) * 2u; }
    const size_t kstep = (size_t)(BK * 2);
    const size_t hstep = (size_t)HALF * K * 2;
    const size_t tstep = 2 * hstep;
    const unsigned ldsw = (unsigned)wid * 1024u;
    const int aoff = lds_byte(wr * 64 + fr, fq * 8), boff = lds_byte(wc * 32 + fr, fq * 8);
#define PG8_SA(b, h) (((b) * 2 + (h)) * HTB)
#define PG8_SB(b, h) ((4 + (b) * 2 + (h)) * HTB)
#define PG8_STAGE(bufoff, gbase, voff) do { _Pragma("unroll") for (int _i = 0; _i < 2; ++_i) \
        __builtin_amdgcn_global_load_lds((const unsigned*)((const char*)(gbase) + (voff)[_i]), (PG8_LAS unsigned*)(lds + (bufoff) + ldsw + _i * 8192), 16, 0, 0); } while (0)
#define PG8_LDA(dst, b, h) do { _Pragma("unroll") for (int m = 0; m < 4; ++m) { if constexpr (F8) { const i32x4_ lo_ = *(const PG8_LAS i32x4_*)(lds + PG8_SA(b, h) + aoff + m * 2048), hi_ = *(const PG8_LAS i32x4_*)(lds + PG8_SA(b, h) + aoff + m * 2048 + 1024); dst##8[m] = __builtin_shufflevector(lo_, hi_, 0, 1, 2, 3, 4, 5, 6, 7); } \
        else { _Pragma("unroll") for (int k = 0; k < 2; ++k) dst[m][k] = *(const PG8_LAS bf16x8*)(lds + PG8_SA(b, h) + aoff + m * 2048 + k * 1024); } } } while (0)
#define PG8_LDB(dst, b, h) do { _Pragma("unroll") for (int n = 0; n < 2; ++n) { if constexpr (F8) { const i32x4_ lo_ = *(const PG8_LAS i32x4_*)(lds + PG8_SB(b, h) + boff + n * 2048), hi_ = *(const PG8_LAS i32x4_*)(lds + PG8_SB(b, h) + boff + n * 2048 + 1024); dst##8[n] = __builtin_shufflevector(lo_, hi_, 0, 1, 2, 3, 4, 5, 6, 7); } \
        else { _Pragma("unroll") for (int k = 0; k < 2; ++k) dst[n][k] = *(const PG8_LAS bf16x8*)(lds + PG8_SB(b, h) + boff + n * 2048 + k * 1024); } } } while (0)
#define PG8_MMA(ai, bj, At, Bt) do { __builtin_amdgcn_s_setprio(1); _Pragma("unroll") for (int m = 0; m < 4; ++m) _Pragma("unroll") for (int n = 0; n < 2; ++n) { \
        if constexpr (F8) asm volatile("v_mfma_scale_f32_16x16x128_f8f6f4 %0, %1, %2, %0, %3, %3 op_sel_hi:[0,0,0]" : "+v"(acc[ai][bj][m][n]) : "v"(Bt##8[n]), "v"(At##8[m]), "v"(f8scale)); \
        else { _Pragma("unroll") for (int k = 0; k < 2; ++k) acc[ai][bj][m][n] = __builtin_amdgcn_mfma_f32_16x16x32_bf16(Bt[n][k], At[m][k], acc[ai][bj][m][n], 0, 0, 0); } } \
        __builtin_amdgcn_s_setprio(0); } while (0)
#define PG8_WAIT_V(n) asm volatile("s_waitcnt vmcnt(" #n ")" ::: "memory")
#define PG8_WAIT_L(n) asm volatile("s_waitcnt lgkmcnt(" #n ")" ::: "memory")
#define PG8_BAR __builtin_amdgcn_s_barrier()
#define PG8_SCHED __builtin_amdgcn_sched_barrier(0)
    Unit cur, nxt; int ui = 0;
    if (!S.next(0, cur)) return;
    f32x4 acc[2][2][4][2];
#pragma unroll
    for (int a = 0; a < 2; ++a)
#pragma unroll
        for (int b = 0; b < 2; ++b)
#pragma unroll
            for (int m = 0; m < 4; ++m)
#pragma unroll
                for (int n = 0; n < 2; ++n) { acc[a][b][m][n] = (f32x4){0.f, 0.f, 0.f, 0.f}; if constexpr (F8) asm volatile("" : "+v"(acc[a][b][m][n])); }
    bf16x8 At[4][2], B0[2][2], B1[2][2];
    typedef int i32x4_ __attribute__((ext_vector_type(4))); typedef int i32x8_ __attribute__((ext_vector_type(8)));
    i32x8_ At8[4], B08[2], B18[2];
    int f8scale = 0x7f7f7f7f; asm volatile("" : "+v"(f8scale));
    const char* cA = (const char*)g.A + (size_t)cur.pm * tstep; const char* cB = (const char*)g.Bt + (size_t)cur.pn * tstep;
    S.a_ready(cur);
    if constexpr (SP2) {
        PG8_STAGE(PG8_SB(0, 0), cB, voffB); PG8_STAGE(PG8_SB(0, 1), cB + hstep, voffB); PG8_STAGE(PG8_SA(0, 0), cA, voffA); PG8_STAGE(PG8_SA(0, 1), cA + hstep, voffA);
        if (wr == 1) PG8_BAR;
        PG8_WAIT_V(2); PG8_BAR;
        PG8_STAGE(PG8_SB(1, 0), cB + kstep, voffB); PG8_STAGE(PG8_SA(1, 0), cA + kstep, voffA); PG8_STAGE(PG8_SB(1, 1), cB + hstep + kstep, voffB);
        PG8_WAIT_V(6); PG8_BAR;
    } else {
        PG8_STAGE(PG8_SB(0, 0), cB, voffB); PG8_STAGE(PG8_SA(0, 0), cA, voffA); PG8_STAGE(PG8_SB(0, 1), cB + hstep, voffB); PG8_STAGE(PG8_SA(0, 1), cA + hstep, voffA);
        if (wr == 1) PG8_BAR;
        PG8_WAIT_V(4); PG8_BAR;
        PG8_STAGE(PG8_SB(1, 0), cB + kstep, voffB); PG8_STAGE(PG8_SA(1, 0), cA + kstep, voffA); PG8_STAGE(PG8_SB(1, 1), cB + hstep + kstep, voffB);
        PG8_WAIT_V(6); PG8_BAR;
    }
    for (;;) {
        const bool has_next = S.next(ui + 1, nxt);
        const char* nA = has_next ? (const char*)g.A + (size_t)nxt.pm * tstep : cA; const char* nB = has_next ? (const char*)g.Bt + (size_t)nxt.pn * tstep : cB;
        for (int t = 0; t < nt; t += 2) {
            const bool last = (t == nt - 2);
            const char* a1 = cA + (size_t)(t + 1) * kstep;
            const char* a2 = last ? nA : cA + (size_t)(t + 2) * kstep; const char* b2 = last ? nB : cB + (size_t)(t + 2) * kstep;
            const char* a3 = a2 + kstep; const char* b3 = b2 + kstep;
            if (last && has_next) S.a_ready(nxt);
            if constexpr (SP2) {
            PG8_LDB(B0, 0, 0); PG8_LDB(B1, 0, 1); PG8_SCHED; PG8_LDA(At, 0, 0); PG8_STAGE(PG8_SA(1, 1), a1 + hstep, voffA);
            PG8_WAIT_V(8); PG8_WAIT_L(0); PG8_BAR; PG8_MMA(0, 0, At, B0); PG8_MMA(0, 1, At, B1); PG8_BAR; PG8_SCHED;
            PG8_LDA(At, 0, 1); PG8_STAGE(PG8_SB(0, 0), b2, voffB); PG8_STAGE(PG8_SB(0, 1), b2 + hstep, voffB); PG8_STAGE(PG8_SA(0, 0), a2, voffA);
            PG8_WAIT_V(8); PG8_WAIT_L(0); PG8_BAR; PG8_MMA(1, 0, At, B0); PG8_MMA(1, 1, At, B1); PG8_BAR; PG8_SCHED;
            PG8_LDB(B0, 1, 0); PG8_LDB(B1, 1, 1); PG8_SCHED; PG8_LDA(At, 1, 0); PG8_STAGE(PG8_SA(0, 1), a2 + hstep, voffA);
            PG8_WAIT_V(8); PG8_WAIT_L(0); PG8_BAR; PG8_MMA(0, 0, At, B0); PG8_MMA(0, 1, At, B1); PG8_BAR; PG8_SCHED;
            PG8_LDA(At, 1, 1); PG8_STAGE(PG8_SB(1, 0), b3, voffB); PG8_STAGE(PG8_SB(1, 1), b3 + hstep, voffB); PG8_STAGE(PG8_SA(1, 0), a3, voffA);
            PG8_WAIT_V(8); PG8_WAIT_L(0); PG8_BAR; PG8_MMA(1, 0, At, B0); PG8_MMA(1, 1, At, B1); PG8_BAR; PG8_SCHED;
            } else {
            PG8_LDB(B0, 0, 0); PG8_SCHED; PG8_LDA(At, 0, 0); PG8_STAGE(PG8_SA(1, 1), a1 + hstep, voffA);
            PG8_WAIT_L(8); PG8_BAR; PG8_WAIT_L(0); PG8_MMA(0, 0, At, B0); PG8_BAR; PG8_SCHED;
            PG8_LDB(B1, 0, 1); PG8_STAGE(PG8_SB(0, 0), b2, voffB);
            PG8_BAR; PG8_WAIT_L(0); PG8_MMA(0, 1, At, B1); PG8_BAR;
            PG8_LDA(At, 0, 1); PG8_STAGE(PG8_SA(0, 0), a2, voffA);
            PG8_BAR; PG8_WAIT_L(0); PG8_MMA(1, 0, At, B0); PG8_BAR; PG8_SCHED;
            PG8_STAGE(PG8_SB(0, 1), b2 + hstep, voffB);
            PG8_WAIT_V(6); PG8_BAR; PG8_MMA(1, 1, At, B1); PG8_BAR;
            PG8_LDB(B0, 1, 0); PG8_SCHED; PG8_LDA(At, 1, 0); PG8_STAGE(PG8_SA(0, 1), a2 + hstep, voffA);
            PG8_WAIT_L(8); PG8_BAR; PG8_WAIT_L(0); PG8_MMA(0, 0, At, B0); PG8_BAR; PG8_SCHED;
            PG8_LDB(B1, 1, 1); PG8_STAGE(PG8_SB(1, 0), b3, voffB);
            PG8_BAR; PG8_WAIT_L(0); PG8_MMA(0, 1, At, B1); PG8_BAR;
            PG8_LDA(At, 1, 1); PG8_STAGE(PG8_SA(1, 0), a3, voffA);
            PG8_BAR; PG8_WAIT_L(0); PG8_MMA(1, 0, At, B0); PG8_BAR; PG8_SCHED;
            PG8_STAGE(PG8_SB(1, 1), b3 + hstep, voffB);
            PG8_WAIT_V(6); PG8_BAR; PG8_MMA(1, 1, At, B1); PG8_BAR;
            }
        }
        if constexpr (F8) asm volatile("s_nop 15\n\ts_nop 15" ::: "memory");
        if constexpr (ALIGN_EPI) { if (wr == 0) PG8_BAR; }
        if constexpr (!Epi::AFTER_DRAIN) { E(acc, cur, wr, wc, fr, fq); S.done(cur); }
        if (!has_next) break;
#pragma unroll
        for (int a = 0; a < 2; ++a)
#pragma unroll
            for (int b = 0; b < 2; ++b)
#pragma unroll
                for (int m = 0; m < 4; ++m)
#pragma unroll
                    for (int n = 0; n < 2; ++n) { acc[a][b][m][n] = (f32x4){0.f, 0.f, 0.f, 0.f}; if constexpr (F8) asm volatile("" : "+v"(acc[a][b][m][n])); }
        cur = nxt; cA = nA; cB = nB; ++ui;
        if constexpr (ALIGN_EPI) { if (wr == 1) PG8_BAR; }
    }
    PG8_WAIT_V(0);
    if constexpr (!ALIGN_EPI) { if (wr == 0) PG8_BAR; }
    PG8_BAR;
    if constexpr (Epi::AFTER_DRAIN) { E.fused(acc, cur, wr, wc, fr, fq, lds, wid, lane); S.done(cur); }
#undef PG8_SA
#undef PG8_SB
#undef PG8_STAGE
#undef PG8_LDA
#undef PG8_LDB
#undef PG8_MMA
#undef PG8_WAIT_V
#undef PG8_WAIT_L
#undef PG8_BAR
#undef PG8_SCHED
}
}
#define LAS __attribute__((address_space(3)))
#define XB_TMO      128
#define XB_XCNT(j)  (256  + 64 * (j))
#define XB_XSUB(j)  (1280 + 64 * (j))
#define XB_XGEN(j)  (2304 + 64 * (j))
#define XB_TOP      3328
#define XB_TOPGEN   3392
#define XCD_BAR_WORDS 3456
#define XB_SPIN_CAP (1u << 18)

__device__ __forceinline__ unsigned xb_ld(unsigned* p)              { return __hip_atomic_load(p, __ATOMIC_RELAXED, __HIP_MEMORY_SCOPE_AGENT); }
__device__ __forceinline__ unsigned xb_add(unsigned* p, unsigned v) { return __hip_atomic_fetch_add(p, v, __ATOMIC_RELAXED, __HIP_MEMORY_SCOPE_AGENT); }
__device__ __forceinline__ unsigned xb_xcc_id() { return (unsigned)__builtin_amdgcn_s_getreg((3 << 11) | 20) & 0xFu; }
#define XB_SPIN(cond, bar) do { unsigned _sp = 0; while (cond) { __builtin_amdgcn_s_sleep(1); \
    if ((++_sp & 255u) == 0u) { if (xb_ld(&(bar)[XB_TMO])) break; if (_sp > XB_SPIN_CAP) { atomicAdd(&(bar)[XB_TMO], 1u); break; } } } } while (0)

struct XcdBarrier {
    unsigned* bar; unsigned x;
    volatile LAS unsigned* st;
};

__device__ __forceinline__ XcdBarrier xcd_barrier_post(unsigned* bar, volatile LAS unsigned* st) {
    XcdBarrier b; b.bar = bar; b.x = xb_xcc_id(); b.st = st;
    if (threadIdx.x == 0) (void)xb_add(&bar[XB_XCNT(b.x)], 1u);
    return b;
}
__device__ __forceinline__ void xcd_barrier_complete(unsigned* bar, unsigned x, unsigned& nloc, unsigned& nx) {
    const unsigned G = gridDim.x * gridDim.y * gridDim.z;
    unsigned sum, cnt, mine, sp = 0u;
    for (;;) {
        sum = 0u; cnt = 0u; mine = 0u;
#pragma unroll
        for (unsigned j = 0; j < 16; ++j) { const unsigned c = xb_ld(&bar[XB_XCNT(j)]); sum += c; cnt += (c > 0u) ? 1u : 0u; mine = (j == x) ? c : mine; }
        if (sum == G) break;
        __builtin_amdgcn_s_sleep(1);
        if ((++sp & 255u) == 0u) { if (xb_ld(&bar[XB_TMO])) break; if (sp > XB_SPIN_CAP) { atomicAdd(&bar[XB_TMO], 1u); break; } }
    }
    nloc = mine > 0u ? mine : 1u; nx = cnt > 0u ? cnt : 1u;
}

__device__ __forceinline__ void xcd_barrier(const XcdBarrier& b) {
    asm volatile("s_waitcnt vmcnt(0)" ::: "memory");
    __syncthreads();
    if (threadIdx.x == 0) {
        unsigned* bar = b.bar;
        __builtin_amdgcn_s_waitcnt(0);
        unsigned nloc = b.st[0], nx = b.st[1];
        if (nloc == 0u) { xcd_barrier_complete(bar, b.x, nloc, nx); b.st[0] = nloc; b.st[1] = nx; }
        const unsigned old = xb_add(&bar[XB_XSUB(b.x)], 1u);
        const unsigned gen = old / nloc;
        if (old + 1u == (gen + 1u) * nloc) {
            __builtin_amdgcn_fence(__ATOMIC_RELEASE, "agent");
            asm volatile("s_waitcnt vmcnt(0)" ::: "memory");
            const unsigned og = xb_add(&bar[XB_TOP], 1u);
            const unsigned tg = og / nx;
            if (og + 1u == (tg + 1u) * nx) xb_add(&bar[XB_TOPGEN], 1u);
            else XB_SPIN(xb_ld(&bar[XB_TOPGEN]) == tg, bar);
            __builtin_amdgcn_fence(__ATOMIC_ACQUIRE, "agent");
            xb_add(&bar[XB_XGEN(b.x)], 1u);
            asm volatile("s_waitcnt vmcnt(0)" ::: "memory");
        } else {
            XB_SPIN(xb_ld(&bar[XB_XGEN(b.x)]) == gen, bar);
            __builtin_amdgcn_fence(__ATOMIC_ACQUIRE, "agent");
            asm volatile("s_waitcnt vmcnt(0)" ::: "memory");
        }
    }
    __syncthreads();
}

#define DI __device__ __forceinline__
#define LDS_WAIT() asm volatile("s_waitcnt lgkmcnt(0)" ::: "memory")
typedef unsigned short bf16;
typedef float f32x4 __attribute__((ext_vector_type(4)));

namespace mk {
constexpr int NB = 8, SEQ = 2048, DM = 1024, NT = NB * SEQ, NL = 2;
constexpr int INW = 3856, ZLD = 4096;
constexpr int ZA = 0, ZRKV = 768, ZWDF = 1920, ZWDB = 1984, ZADF = 2048, ZADB = 2112, ZGD = 2176, ZMQK = 2304, ZMV = 3072, ZMO = 3456, ZMG = 3840;
constexpr int RW = 384, MW = 384, AW = 256;
constexpr int NE = 16, CAP = 256, FF = 2816, NSLOT = NB * NE * CAP;
constexpr int NWAVES = 8, NTHR = 512;
constexpr float RMS_EPS = 1e-6f;

enum { I_X = 0, I_RELB, I_LN1G, I_WIN, I_WOUT, I_MU, I_W0, I_W2, I_A0, I_A2, I_KK, I_KA, I_RK, I_G2, I_RLNG, I_RLNB,
       I_CW, I_CB, I_IB, I_FB, I_MLNG, I_LN2G, I_ROUTER, I_EW1, I_EW3, I_EW2, I_FG, N_IN };

constexpr size_t MiB = 1u << 20;
constexpr size_t WS_CTL = 0, CTL_ZERO_BYTES = 1 * MiB;
constexpr size_t WS_WTIN = 2 * MiB;
constexpr size_t WS_WTOUT = 18 * MiB;
constexpr size_t WS_W13T = 22 * MiB;
constexpr size_t WS_W2T = 374 * MiB;
constexpr size_t WS_X1 = 550 * MiB;
constexpr size_t WS_X2 = 614 * MiB;
constexpr size_t WS_HB = 678 * MiB;
constexpr size_t WS_AFF = 710 * MiB;
constexpr size_t WS_SEL = 711 * MiB;
constexpr size_t WS_GATE = 712 * MiB;
constexpr size_t WS_G2T = 713 * MiB;
constexpr size_t WS_LWT = 713 * MiB + 256 * 1024;
constexpr size_t WS_R = 714 * MiB;
constexpr size_t WS_Z = WS_R;
constexpr size_t WS_ATTO = WS_R + 128 * MiB;
constexpr size_t WS_ATTL = WS_R + 152 * MiB;
constexpr size_t WS_PR = WS_R + 154 * MiB;
constexpr size_t WS_RKY = WS_R + 442 * MiB;
constexpr size_t WS_RKB = WS_R + 490 * MiB;
constexpr size_t WS_MLQK = WS_R + 538 * MiB;
constexpr size_t WS_MLNUM = WS_R + 586 * MiB;
constexpr size_t WS_MLDEN = WS_R + 634 * MiB;
constexpr size_t WS_XG = WS_R;
constexpr size_t WS_ACT = WS_R + 64 * MiB;
constexpr size_t WS_YS = WS_R + 240 * MiB;
constexpr size_t WS_END = WS_R + 636 * MiB;

constexpr size_t WS_WP = WS_CTL + 1 * MiB;
constexpr int CW_BAR = 4096;
constexpr int LDS_BYTES = 147456;
constexpr int MISC_OFF = LDS_BYTES - 256;

struct Args { const float* in[N_IN]; float* out; unsigned char* ws; int ph_lo, ph_hi; };

DI float bf2f(unsigned v) { return __uint_as_float(v << 16); }
DI unsigned f2bf(float f) { unsigned u = __float_as_uint(f); return (u + 0x7fffu + ((u >> 16) & 1u)) >> 16; }
DI unsigned pk2(float lo, float hi) { return f2bf(lo) | (f2bf(hi) << 16); }
#define DPPF(v, ctrl) __uint_as_float((unsigned)__builtin_amdgcn_update_dpp(0, (int)__float_as_uint(v), (ctrl), 0xf, 0xf, true))
DI float row16_sum(float v) { v += DPPF(v, 0xB1); v += DPPF(v, 0x4E); v += DPPF(v, 0x141); v += DPPF(v, 0x140); return v; }
DI float wave_sum(float v) { v = row16_sum(v); v += __shfl_xor(v, 16); v += __shfl_xor(v, 32); return v; }
DI float sigm(float x) { return __builtin_amdgcn_rcpf(1.f + __expf(-x)); }
DI void unpack8(const uint4 w, float (&f)[8]) {
    f[0] = __uint_as_float(w.x << 16); f[1] = __uint_as_float(w.x & 0xffff0000u); f[2] = __uint_as_float(w.y << 16); f[3] = __uint_as_float(w.y & 0xffff0000u);
    f[4] = __uint_as_float(w.z << 16); f[5] = __uint_as_float(w.z & 0xffff0000u); f[6] = __uint_as_float(w.w << 16); f[7] = __uint_as_float(w.w & 0xffff0000u);
}

struct GroupOrder {
    int G, c2, nunits, per_e, nN;
    DI void init(int nN_, int G_, int bid) { nN = nN_; per_e = 8 * nN_; nunits = NE * per_e; G = G_; c2 = (G_ % 8 == 0) ? (bid % 8) * (G_ / 8) + bid / 8 : bid; }
    DI bool next(int i, pg8::Unit& u) const {
        const long L = (long)i * G + c2; if (L >= nunits) return false;
        const int e = (int)L / per_e, r = (int)L % per_e; u.pm = e * 8 + (r & 7); u.pn = e * nN + (r >> 3); return true;
    }
    DI void a_ready(const pg8::Unit&) const {}
    DI void done(const pg8::Unit&) const {}
};
DI unsigned pkbf(float lo, float hi) { typedef __bf16 b2 __attribute__((ext_vector_type(2))); typedef float f2 __attribute__((ext_vector_type(2))); const f2 v = {lo, hi}; return __builtin_bit_cast(unsigned, __builtin_convertvector(v, b2)); }
template <bool BASE_BF16>
struct EpiResT {
    static constexpr bool PERM = false, AFTER_DRAIN = false;
    const void* base; bf16* out; int ldc;
    DI void operator()(const pg8::f32x4 (&acc)[2][2][4][2], const pg8::Unit& u, int wr, int wc, int fr, int fq) const {
        const int row0 = u.pm * 256 + wr * 64 + fr, col0 = u.pn * 256 + wc * 32 + 4 * fq;
#pragma unroll
        for (int ai = 0; ai < 2; ++ai)
#pragma unroll
            for (int m = 0; m < 4; ++m) { const size_t off = (size_t)(row0 + ai * 128 + m * 16) * ldc + col0;
#pragma unroll
                for (int bj = 0; bj < 2; ++bj)
#pragma unroll
                    for (int n = 0; n < 2; ++n) { pg8::f32x4 b;
                        if constexpr (BASE_BF16) { const uint2 w = *(const uint2*)((const bf16*)base + off + bj * 128 + n * 16);
                            b[0] = __uint_as_float(w.x << 16); b[1] = __uint_as_float(w.x & 0xffff0000u); b[2] = __uint_as_float(w.y << 16); b[3] = __uint_as_float(w.y & 0xffff0000u); }
                        else b = *(const pg8::f32x4*)((const float*)base + off + bj * 128 + n * 16);
                        b += acc[ai][bj][m][n]; uint2 o; o.x = pkbf(b[0], b[1]); o.y = pkbf(b[2], b[3]); *(uint2*)(out + off + bj * 128 + n * 16) = o; } }
    }
};
DI float silu_f(float x) { return x * __builtin_amdgcn_rcpf(1.f + __expf(-x)); }
DI float f8clamp(float x) { return __builtin_amdgcn_fmed3f(x, -448.f, 448.f); }
DI unsigned pk4_fp8(float a, float b, float c, float d) { unsigned p = 0u; p = __builtin_amdgcn_cvt_pk_fp8_f32(f8clamp(a), f8clamp(b), p, false); p = __builtin_amdgcn_cvt_pk_fp8_f32(f8clamp(c), f8clamp(d), p, true); return p; }
constexpr float F8_WSC = 64.f, F8_HSC = 8.f, F8_ASC = 16.f;
DI float swiglu8(float xa, float xg) {
    constexpr float sc = F8_HSC * F8_WSC, K1 = -1.4426950408889634f / sc, IK2 = sc * sc / F8_ASC;
    const float e = __builtin_amdgcn_exp2f(xa * K1);
    return (xa * xg) * __builtin_amdgcn_rcpf(__builtin_fmaf(e, IK2, IK2));
}
struct EpiSwiGLU {
    static constexpr bool PERM = true, AFTER_DRAIN = false;
    unsigned char* act; int nN;
    DI void operator()(const pg8::f32x4 (&acc)[2][2][4][2], const pg8::Unit& u, int wr, int wc, int fr, int fq) const {
        const int lpn = u.pn % nN; const int row0 = u.pm * 256 + wr * 64 + fr, col0 = lpn * 128 + wc * 32 + 8 * fq;
#pragma unroll
        for (int ai = 0; ai < 2; ++ai)
#pragma unroll
            for (int m = 0; m < 4; ++m) { unsigned char* p = act + (size_t)(row0 + ai * 128 + m * 16) * FF + col0;
                const pg8::f32x4 a0 = acc[ai][0][m][0], a1 = acc[ai][0][m][1], g0 = acc[ai][1][m][0], g1 = acc[ai][1][m][1];
                uint2 w; w.x = pk4_fp8(swiglu8(a0[0], g0[0]), swiglu8(a0[1], g0[1]), swiglu8(a0[2], g0[2]), swiglu8(a0[3], g0[3]));
                w.y = pk4_fp8(swiglu8(a1[0], g1[0]), swiglu8(a1[1], g1[1]), swiglu8(a1[2], g1[2]), swiglu8(a1[3], g1[3]));
                *(uint2*)p = w; }
    }
};
struct EpiGate {
    static constexpr bool PERM = true, AFTER_DRAIN = false;
    bf16* ys; const float* gate;
    DI void operator()(const pg8::f32x4 (&acc)[2][2][4][2], const pg8::Unit& u, int wr, int wc, int fr, int fq) const {
        const int row0 = u.pm * 256 + wr * 64 + fr, col0 = (u.pn & 3) * 256 + wc * 32 + 8 * fq;
#pragma unroll
        for (int ai = 0; ai < 2; ++ai)
#pragma unroll
            for (int m = 0; m < 4; ++m) { const int row = row0 + ai * 128 + m * 16; const float g = gate[row] * (1.f / (F8_ASC * F8_WSC)); bf16* p = ys + (size_t)row * DM + col0;
#pragma unroll
                for (int bj = 0; bj < 2; ++bj) { const pg8::f32x4 v0 = acc[ai][bj][m][0] * g, v1 = acc[ai][bj][m][1] * g; pg8::u32x4 w;
                    w.x = pg8::cvt_pk_bf16(v0[0], v0[1]); w.y = pg8::cvt_pk_bf16(v0[2], v0[3]); w.z = pg8::cvt_pk_bf16(v1[0], v1[1]); w.w = pg8::cvt_pk_bf16(v1[2], v1[3]);
                    *(pg8::u32x4*)(p + bj * 128) = w; } }
    }
};

DI void cvt_tile(const float* W, int N, int nvalid, int k0, int n0, bf16* dst, int Kd, size_t drow0, LAS float* scr, int lane) {
    const int c4 = (lane & 15) * 4, kr = lane >> 4;
#pragma unroll
    for (int it = 0; it < 16; ++it) { const int k = it * 4 + kr; float4 v = make_float4(0.f, 0.f, 0.f, 0.f);
        if (n0 + c4 < nvalid) v = *(const float4*)(W + (size_t)(k0 + k) * N + n0 + c4);
        LAS float* s = scr + k * 65 + c4; s[0] = v.x; s[1] = v.y; s[2] = v.z; s[3] = v.w; }
    LDS_WAIT(); asm volatile("" ::: "memory");
    const int c = lane & 7;
#pragma unroll
    for (int it = 0; it < 8; ++it) { const int n = it * 8 + (lane >> 3); const LAS float* s = scr + (8 * c) * 65 + n;
        uint4 o; o.x = pk2(s[0], s[65]); o.y = pk2(s[130], s[195]); o.z = pk2(s[260], s[325]); o.w = pk2(s[390], s[455]);
        *(uint4*)(dst + (drow0 + n) * (size_t)Kd + k0 + 8 * c) = o; }
    LDS_WAIT(); asm volatile("" ::: "memory");
}
DI void cvt_tile_fp8(const float* W, int N, int k0, int n0, unsigned char* dst, int Kd, size_t drow0, float sc, LAS unsigned char* scr, int lane) {
    const int nq = lane & 15, kq = lane >> 4;
#pragma unroll
    for (int hb = 0; hb < 2; ++hb) {
        f32x4 v[4][4];
#pragma unroll
        for (int it = 0; it < 4; ++it)
#pragma unroll
            for (int j = 0; j < 4; ++j) v[it][j] = __builtin_nontemporal_load((const f32x4*)(W + (size_t)(k0 + hb * 64 + it * 16 + kq * 4 + j) * N + n0 + 4 * nq));
#pragma unroll
        for (int it = 0; it < 4; ++it)
#pragma unroll
            for (int i = 0; i < 4; ++i) *(LAS unsigned*)(scr + (4 * nq + i) * 132 + hb * 64 + it * 16 + kq * 4) = pk4_fp8(v[it][0][i] * sc, v[it][1][i] * sc, v[it][2][i] * sc, v[it][3][i] * sc);
    }
    LDS_WAIT(); asm volatile("" ::: "memory");
    const int c = lane & 7;
#pragma unroll
    for (int it = 0; it < 8; ++it) { const int n = it * 8 + (lane >> 3); const LAS unsigned* s = (const LAS unsigned*)(scr + n * 132 + 16 * c);
        uint4 o; o.x = s[0]; o.y = s[1]; o.z = s[2]; o.w = s[3];
        *(uint4*)(dst + (drow0 + n) * (size_t)Kd + k0 + 16 * c) = o; }
    LDS_WAIT(); asm volatile("" ::: "memory");
}
struct F8Tile { const float* W; int N, k0, n0; unsigned char* dst; int Kd; size_t drow0; };
DI void f8_load(f32x4 (&v)[4][4], const F8Tile& d, int hb, int lane) {
    const int nq = lane & 15, kq = lane >> 4;
#pragma unroll
    for (int it = 0; it < 4; ++it)
#pragma unroll
        for (int j = 0; j < 4; ++j) v[it][j] = __builtin_nontemporal_load((const f32x4*)(d.W + (size_t)(d.k0 + hb * 64 + it * 16 + kq * 4 + j) * d.N + d.n0 + 4 * nq));
}
DI void f8_convert(const f32x4 (&v)[4][4], int hb, float sc, LAS unsigned char* scr, int lane) {
    const int nq = lane & 15, kq = lane >> 4;
#pragma unroll
    for (int it = 0; it < 4; ++it)
#pragma unroll
        for (int i = 0; i < 4; ++i) *(LAS unsigned*)(scr + (4 * nq + i) * 132 + hb * 64 + it * 16 + kq * 4) = pk4_fp8(v[it][0][i] * sc, v[it][1][i] * sc, v[it][2][i] * sc, v[it][3][i] * sc);
}
DI void f8_convert_reload(f32x4 (&v)[4][4], int hb, float sc, LAS unsigned char* scr, bool reload, const F8Tile& dn, int lane) {
    const int nq = lane & 15, kq = lane >> 4;
#pragma unroll
    for (int it = 0; it < 4; ++it) {
#pragma unroll
        for (int i = 0; i < 4; ++i) *(LAS unsigned*)(scr + (4 * nq + i) * 132 + hb * 64 + it * 16 + kq * 4) = pk4_fp8(v[it][0][i] * sc, v[it][1][i] * sc, v[it][2][i] * sc, v[it][3][i] * sc);
        if (reload) {
#pragma unroll
            for (int j = 0; j < 4; ++j) v[it][j] = __builtin_nontemporal_load((const f32x4*)(dn.W + (size_t)(dn.k0 + hb * 64 + it * 16 + kq * 4 + j) * dn.N + dn.n0 + 4 * nq)); } }
}
DI void f8_store(const F8Tile& d, LAS unsigned char* scr, int lane) {
    LDS_WAIT(); asm volatile("" ::: "memory");
    const int c = lane & 7;
#pragma unroll
    for (int it = 0; it < 8; ++it) { const int n = it * 8 + (lane >> 3); const LAS unsigned* s = (const LAS unsigned*)(scr + n * 132 + 16 * c);
        uint4 o; o.x = s[0]; o.y = s[1]; o.z = s[2]; o.w = s[3];
        __builtin_nontemporal_store((pg8::u32x4){o.x, o.y, o.z, o.w}, (pg8::u32x4*)(d.dst + (d.drow0 + n) * (size_t)d.Kd + d.k0 + 16 * c)); }
    LDS_WAIT(); asm volatile("" ::: "memory");
}
DI void phase_p0(const Args& A, LAS unsigned char* lds, int it0, int it1, int gw, int ngw, int wave, int lane) {
    LAS float* scr = (LAS float*)(lds + wave * 16896);
    bf16* wtin = (bf16*)(A.ws + WS_WTIN); bf16* wtout = (bf16*)(A.ws + WS_WTOUT); unsigned char* w13 = A.ws + WS_W13T; unsigned char* w2t = A.ws + WS_W2T;
    constexpr int I_IN = NL * 16 * 64, I_OUT = NL * 16 * 16, I_E = 8 * 44, I_MOE = NL * NE * 3 * I_E;
    int it = it0 + gw;
    for (; it < it1 && it < I_IN + I_OUT; it += ngw) {
        int r = it;
        if (r < I_IN) { const int l = r / 1024, t = r % 1024, kb = t / 64, nb = t % 64;
            cvt_tile(A.in[I_WIN] + (size_t)l * DM * INW, INW, INW, kb * 64, nb * 64, wtin + (size_t)l * ZLD * DM, DM, (size_t)nb * 64, scr, lane); continue; }
        r -= I_IN;
        { const int l = r / 256, t = r % 256, kb = t / 16, nb = t % 16;
            cvt_tile(A.in[I_WOUT] + (size_t)l * DM * DM, DM, DM, kb * 64, nb * 64, wtout + (size_t)l * DM * DM, DM, (size_t)nb * 64, scr, lane); }
    }
    auto desc = [&](int item) { F8Tile d; const int r = item - I_IN - I_OUT; const int le = r / (3 * I_E), q = r % (3 * I_E), which = q / I_E, t = q % I_E;
        if (which < 2) { const int kb = t / 44, nb = t % 44, n0 = nb * 64;
            d.W = A.in[which == 0 ? I_EW1 : I_EW3] + (size_t)le * DM * FF; d.N = FF; d.k0 = kb * 128; d.n0 = n0; d.dst = w13 + (size_t)le * 5632 * DM; d.Kd = DM; d.drow0 = (size_t)((n0 >> 7) * 256 + which * 128 + (n0 & 127)); }
        else { const int kb = t / 16, nb = t % 16;
            d.W = A.in[I_EW2] + (size_t)le * FF * DM; d.N = DM; d.k0 = kb * 128; d.n0 = nb * 64; d.dst = w2t + (size_t)le * DM * FF; d.Kd = FF; d.drow0 = (size_t)nb * 64; }
        return d; };
    if (it < it1) {
        f32x4 ra[4][4], rb[4][4]; LAS unsigned char* sc8 = (LAS unsigned char*)scr;
        F8Tile d = desc(it);
        f8_load(ra, d, 0, lane); f8_load(rb, d, 1, lane);
        for (; it < it1; it += ngw) {
            const bool vn = it + ngw < it1; F8Tile dn = d; if (vn) dn = desc(it + ngw);
            f8_convert_reload(ra, 0, F8_WSC, sc8, vn, dn, lane);
            f8_convert_reload(rb, 1, F8_WSC, sc8, vn, dn, lane);
            f8_store(d, sc8, lane);
            d = dn;
        }
    }
    if (it0 == 0) { bf16* wp = (bf16*)(A.ws + WS_WP);
        for (int idx = gw * 64 + lane; idx < NL * DM * NE; idx += ngw * 64) { const int l = idx / (DM * NE), i = idx % (DM * NE), e = i & 15, c = i >> 4;
            const float v = A.in[I_ROUTER][idx] * A.in[I_LN2G][(size_t)l * DM + c]; const unsigned h = f2bf(v);
            wp[((size_t)(l * 2 + 0) * NE + e) * 1032 + c] = (bf16)h; wp[((size_t)(l * 2 + 1) * NE + e) * 1032 + c] = (bf16)f2bf(v - bf2f(h)); } }
    if (it0 == 0) { bf16* g2t = (bf16*)(A.ws + WS_G2T);
        for (int idx = gw * 64 + lane; idx < NL * 128 * RW; idx += ngw * 64) { const int col = idx % RW, j = (idx / RW) % 128, l = idx / (128 * RW); g2t[((size_t)l * RW + col) * 128 + j] = (bf16)f2bf(A.in[I_G2][idx]); } }
}

DI void load_row(const float* xrow, int lane, f32x4 (&v)[4]) {
    const f32x4* xr = (const f32x4*)xrow + lane;
#pragma unroll
    for (int j = 0; j < 4; ++j) v[j] = xr[64 * j];
}
DI void load_row_bf(const bf16* xrow, int lane, f32x4 (&v)[4]) {
    const uint2* xr = (const uint2*)xrow + lane;
#pragma unroll
    for (int j = 0; j < 4; ++j) { const uint2 w = xr[64 * j]; v[j][0] = __uint_as_float(w.x << 16); v[j][1] = __uint_as_float(w.x & 0xffff0000u); v[j][2] = __uint_as_float(w.y << 16); v[j][3] = __uint_as_float(w.y & 0xffff0000u); }
}
DI void add_slots(const Args& A, int tok, int lane, f32x4 (&v)[4]) {
    const int* sel = (const int*)(A.ws + WS_SEL); const bf16* ys = (const bf16*)(A.ws + WS_YS);
    const int b = tok / SEQ; const int mys = (lane < NE) ? sel[(size_t)tok * NE + lane] : -1;
    unsigned m = (unsigned)__ballot(mys >= 0);
    while (m) {
        const uint2* p[4]; bool ok[4];
#pragma unroll
        for (int q = 0; q < 4; ++q) { ok[q] = m != 0u; const int e = ok[q] ? __builtin_ctz(m) : 0; m &= m - 1u; const int r = __shfl(mys, e);
            p[q] = (const uint2*)(ys + (size_t)((e * NB + b) * CAP + (ok[q] ? r : 0)) * DM) + lane; }
        uint2 w[4][4];
#pragma unroll
        for (int q = 0; q < 4; ++q) if (ok[q]) {
#pragma unroll
            for (int j = 0; j < 4; ++j) w[q][j] = p[q][64 * j]; }
#pragma unroll
        for (int q = 0; q < 4; ++q) if (ok[q]) {
#pragma unroll
            for (int j = 0; j < 4; ++j) { v[j][0] += __uint_as_float(w[q][j].x << 16); v[j][1] += __uint_as_float(w[q][j].x & 0xffff0000u); v[j][2] += __uint_as_float(w[q][j].y << 16); v[j][3] += __uint_as_float(w[q][j].y & 0xffff0000u); } }
    }
}
DI float row_rstd(const f32x4 (&v)[4]) {
    float s = 0.f;
#pragma unroll
    for (int j = 0; j < 4; ++j) s += (v[j][0] * v[j][0] + v[j][1] * v[j][1]) + (v[j][2] * v[j][2] + v[j][3] * v[j][3]);
    return rsqrtf(wave_sum(s) * (1.f / DM) + RMS_EPS);
}
DI void phase_ln1(const Args& A, int l, int gw, int ngw, int lane) {
    const float* xin = A.in[I_X]; const bf16* x1 = (const bf16*)(A.ws + WS_X1); bf16* x2 = (bf16*)(A.ws + WS_X2); bf16* hb = (bf16*)(A.ws + WS_HB);
    f32x4 gg[4];
#pragma unroll
    for (int j = 0; j < 4; ++j) gg[j] = ((const f32x4*)(A.in[I_LN1G] + (size_t)l * DM) + lane)[64 * j];
    for (int tok = gw; tok < NT; tok += 2 * ngw) {
        const int tokb = tok + ngw; const bool hb2 = tokb < NT;
        f32x4 va[4], vb[4];
        if (l == 0) { load_row(xin + (size_t)tok * DM, lane, va); load_row(xin + (size_t)(hb2 ? tokb : tok) * DM, lane, vb); }
        else { load_row_bf(x1 + (size_t)tok * DM, lane, va); load_row_bf(x1 + (size_t)(hb2 ? tokb : tok) * DM, lane, vb);
            add_slots(A, tok, lane, va); add_slots(A, hb2 ? tokb : tok, lane, vb);
            uint2* oa = (uint2*)(x2 + (size_t)tok * DM) + lane; uint2* ob = (uint2*)(x2 + (size_t)tokb * DM) + lane;
#pragma unroll
            for (int j = 0; j < 4; ++j) { uint2 w; w.x = pkbf(va[j][0], va[j][1]); w.y = pkbf(va[j][2], va[j][3]); oa[64 * j] = w;
                if (hb2) { uint2 u; u.x = pkbf(vb[j][0], vb[j][1]); u.y = pkbf(vb[j][2], vb[j][3]); ob[64 * j] = u; } } }
        const float ra = row_rstd(va), rb = row_rstd(vb); uint2* o8a = (uint2*)(hb + (size_t)tok * DM) + lane; uint2* o8b = (uint2*)(hb + (size_t)tokb * DM) + lane;
#pragma unroll
        for (int j = 0; j < 4; ++j) { uint2 w; w.x = pkbf(va[j][0] * ra * gg[j][0], va[j][1] * ra * gg[j][1]); w.y = pkbf(va[j][2] * ra * gg[j][2], va[j][3] * ra * gg[j][3]); o8a[64 * j] = w;
            if (hb2) { uint2 u; u.x = pkbf(vb[j][0] * rb * gg[j][0], vb[j][1] * rb * gg[j][1]); u.y = pkbf(vb[j][2] * rb * gg[j][2], vb[j][3] * rb * gg[j][3]); o8b[64 * j] = u; } }
    }
}
DI void phase_final(const Args& A, int gw, int ngw, int lane) {
    const bf16* xin = (const bf16*)(A.ws + WS_X1);
    f32x4 gg[4];
#pragma unroll
    for (int j = 0; j < 4; ++j) gg[j] = ((const f32x4*)A.in[I_FG] + lane)[64 * j];
    for (int tok = gw; tok < NT; tok += 2 * ngw) {
        const int tokb = tok + ngw; const bool hb2 = tokb < NT;
        f32x4 va[4], vb[4]; load_row_bf(xin + (size_t)tok * DM, lane, va); load_row_bf(xin + (size_t)(hb2 ? tokb : tok) * DM, lane, vb);
        add_slots(A, tok, lane, va); add_slots(A, hb2 ? tokb : tok, lane, vb);
        const float ra = row_rstd(va), rb = row_rstd(vb); f32x4* oa = (f32x4*)(A.out + (size_t)tok * DM) + lane; f32x4* ob = (f32x4*)(A.out + (size_t)tokb * DM) + lane;
#pragma unroll
        for (int j = 0; j < 4; ++j) { oa[64 * j] = va[j] * ra * gg[j]; if (hb2) ob[64 * j] = vb[j] * rb * gg[j]; }
    }
}
DI void phase_topk(const Args& A, LAS unsigned char* lds, int bid, int G, int tid, int wave, int lane) {
    const unsigned* affk = (const unsigned*)(A.ws + WS_AFF); int* sel = (int*)(A.ws + WS_SEL); float* gate = (float*)(A.ws + WS_GATE);
    const unsigned char* hb = A.ws + WS_HB; unsigned char* xg = A.ws + WS_XG;
    LAS unsigned* hist = (LAS unsigned*)lds;
    LAS unsigned* wsum = hist + 32;
    LAS int* list = (LAS int*)(lds + 256);
    for (int u = bid; u < NB * NE * 2; u += G) {
        const int half = u & 1, e = (u >> 1) % NE, b = u / (2 * NE);
        __syncthreads();
        if (tid < 32) hist[tid] = 0u;
        const uint4 kv = *(const uint4*)(affk + (size_t)(b * NE + e) * SEQ + tid * 4);
        const unsigned key[4] = {kv.x, kv.y, kv.z, kv.w};
        __syncthreads();
        unsigned prefix = 0u, krem = CAP;
#pragma unroll 1
        for (int pass = 0; pass < 8; ++pass) { const int shift = 28 - 4 * pass; LAS unsigned* h = hist + (pass & 1) * 16;
#pragma unroll
            for (int i = 0; i < 4; ++i) { const bool cand = (pass == 0) || ((key[i] >> (shift + 4)) == prefix); const unsigned bin = (key[i] >> shift) & 15u;
                if (cand) (void)__hip_atomic_fetch_add(h + bin, 1u, __ATOMIC_RELAXED, __HIP_MEMORY_SCOPE_WORKGROUP); }
            __syncthreads();
            unsigned acc = 0u, pick = 0u, before = 0u;
#pragma unroll
            for (int v = 15; v >= 0; --v) { const unsigned c = h[v]; if (acc < krem && acc + c >= krem) { pick = (unsigned)v; before = acc; } acc += c; }
            prefix = (prefix << 4) | pick; krem -= before;
            if (tid < 16) hist[((pass + 1) & 1) * 16 + tid] = 0u;
            __syncthreads();
        }
        const unsigned tau = prefix;
        unsigned gt[4], eq[4]; unsigned ngt = 0u, neq = 0u;
#pragma unroll
        for (int i = 0; i < 4; ++i) { gt[i] = key[i] > tau ? 1u : 0u; eq[i] = key[i] == tau ? 1u : 0u; ngt += gt[i]; neq += eq[i]; }
        unsigned sg = ngt, se = neq;
#pragma unroll
        for (int o = 1; o < 64; o <<= 1) { const unsigned tg = __shfl_up(sg, o), te = __shfl_up(se, o); if (lane >= o) { sg += tg; se += te; } }
        if (lane == 63) { wsum[wave] = sg; wsum[8 + wave] = se; }
        __syncthreads();
        unsigned offg = 0u, offe = 0u;
        for (int w = 0; w < wave; ++w) { offg += wsum[w]; offe += wsum[8 + w]; }
        unsigned eqbefore = offe + se - neq;
        unsigned gtbefore = offg + sg - ngt;
        const int slot0 = (e * NB + b) * CAP;
#pragma unroll
        for (int i = 0; i < 4; ++i) { const int s = tid * 4 + i; const bool selq = gt[i] || (eq[i] && eqbefore < krem);
            const unsigned pos = gtbefore + (eqbefore < krem ? eqbefore : krem);
            if ((s >> 10) == half) { sel[(size_t)(b * SEQ + s) * NE + e] = selq ? (int)pos : -1;
                if (selq) { gate[slot0 + pos] = __uint_as_float(key[i]); } }
            if (selq && pos < CAP) list[pos] = s;
            gtbefore += gt[i]; eqbefore += eq[i]; }
        __syncthreads();
        for (int r = wave; r < CAP; r += NWAVES) { const int s = list[r];
            if ((s >> 10) == half) { const uint4* src = (const uint4*)(hb + (size_t)(b * SEQ + s) * DM) + lane; uint4* dstp = (uint4*)(xg + (size_t)(slot0 + r) * DM) + lane; dstp[0] = src[0]; } }
    }
    __syncthreads();
}

DI int t5_bucket(int rel) {
    const int ret = rel > 0 ? 16 : 0; const int n = rel < 0 ? -rel : rel;
    if (n < 8) return ret + n;
    int large = 8 + (int)(logf((float)n / 8.0f) / 4.852030263919617f * 8.0f);
    large = large < 15 ? large : 15;
    return ret + large;
}

typedef short bf16x8_t __attribute__((ext_vector_type(8)));
typedef short bf16x4_t __attribute__((ext_vector_type(4)));
typedef unsigned u32x4_t __attribute__((ext_vector_type(4)));
typedef unsigned u32x2_t __attribute__((ext_vector_type(2)));
typedef __bf16 bf2_t __attribute__((ext_vector_type(2)));
typedef float f2_t __attribute__((ext_vector_type(2)));
DI unsigned cvtpk(float lo, float hi) { const f2_t v = {lo, hi}; return __builtin_bit_cast(unsigned, __builtin_convertvector(v, bf2_t)); }
#define MFMA16(a, b, c) __builtin_amdgcn_mfma_f32_16x16x32_bf16((a), (b), (c), 0, 0, 0)

constexpr int AT_QS = 0, AT_QLD = 72;
constexpr int AT_KS = AT_QS + 128 * AT_QLD * 2;
constexpr int AT_VT = AT_KS + 272 * AT_QLD * 2, AT_VLD = 280;
constexpr int AT_BT = AT_VT + 64 * AT_VLD * 2;
constexpr int AT_END = AT_BT + 132 * 4;
static_assert(AT_END <= MISC_OFF, "attention LDS");

DI void attn_unit(const Args& A, LAS unsigned char* lds, int unit, int tid, int wave, int lane) {
    const bf16* Z = (const bf16*)(A.ws + WS_Z); bf16* ao = (bf16*)(A.ws + WS_ATTO); float* al = (float*)(A.ws + WS_ATTL);
    const int x = unit & 15; int r0 = unit >> 4; const int hh = r0 & 3; r0 >>= 2; const int b = r0 % NB, br = r0 / NB;
    const int dil = br == 0 ? 1 : (br == 1 ? 4 : 16), lsub = SEQ / dil, nblk = lsub / 128;
    const int res = x / nblk, nbk = x % nblk, l0 = nbk * 128, wbase = l0 - 64;
    LAS bf16* Qs = (LAS bf16*)(lds + AT_QS); LAS bf16* Ks = (LAS bf16*)(lds + AT_KS); LAS bf16* Vt = (LAS bf16*)(lds + AT_VT); LAS float* btab = (LAS float*)(lds + AT_BT);
    __syncthreads();
#pragma unroll
    for (int i = 0; i < 2; ++i) { const int id = tid + 512 * i, row = id >> 3, ch = id & 7; const int tok = b * SEQ + (l0 + row) * dil + res;
        *(LAS u32x4_t*)(Qs + row * AT_QLD + ch * 8) = *(const u32x4_t*)(Z + (size_t)tok * ZLD + ZA + hh * 64 + ch * 8); }
    for (int id = tid; id < 272 * 8; id += NTHR) { const int row = id >> 3, ch = id & 7; const int pos = wbase + row; u32x4_t v = (u32x4_t){0u, 0u, 0u, 0u};
        if (row < 256 && pos >= 0 && pos < lsub) v = *(const u32x4_t*)(Z + (size_t)(b * SEQ + pos * dil + res) * ZLD + ZA + 256 + hh * 64 + ch * 8);
        *(LAS u32x4_t*)(Ks + row * AT_QLD + ch * 8) = v; }
    for (int id = tid; id < 272 * 8; id += NTHR) { const int key = id % 272, ch = id / 272; const int pos = wbase + key; u32x4_t v = (u32x4_t){0u, 0u, 0u, 0u};
        if (key < 256 && pos >= 0 && pos < lsub) v = *(const u32x4_t*)(Z + (size_t)(b * SEQ + pos * dil + res) * ZLD + ZA + 512 + hh * 64 + ch * 8);
        LAS bf16* d = Vt + (ch * 8) * AT_VLD + key;
        d[0] = (bf16)(v.x & 0xffffu); d[AT_VLD] = (bf16)(v.x >> 16); d[2 * AT_VLD] = (bf16)(v.y & 0xffffu); d[3 * AT_VLD] = (bf16)(v.y >> 16);
        d[4 * AT_VLD] = (bf16)(v.z & 0xffffu); d[5 * AT_VLD] = (bf16)(v.z >> 16); d[6 * AT_VLD] = (bf16)(v.w & 0xffffu); d[7 * AT_VLD] = (bf16)(v.w >> 16); }
    if (tid < 129) btab[tid] = A.in[I_RELB][t5_bucket((tid - 64) * dil) * 4 + hh] * 1.4426950408889634f;
    __syncthreads();
    const int fr = lane & 15, qd = lane >> 4;
    f32x4 acc[10];
    { bf16x8_t qb[2];
#pragma unroll
      for (int ks = 0; ks < 2; ++ks) qb[ks] = *(const LAS bf16x8_t*)(Qs + (16 * wave + fr) * AT_QLD + ks * 32 + 8 * qd);
#pragma unroll
      for (int j = 0; j < 10; ++j) { acc[j] = (f32x4){0.f, 0.f, 0.f, 0.f};
          if (j == 9) continue;
#pragma unroll
          for (int ks = 0; ks < 2; ++ks) { const bf16x8_t ka = *(const LAS bf16x8_t*)(Ks + (16 * (wave + j) + fr) * AT_QLD + ks * 32 + 8 * qd); acc[j] = MFMA16(ka, qb[ks], acc[j]); } } }
    const int iq = 16 * wave + fr; float mx = -1.0e30f;
    int dv[4];
#pragma unroll
    for (int r = 0; r < 4; ++r) dv[r] = 4 * qd + r - fr;
    const int p0 = wbase + 16 * wave + 4 * qd;
#pragma unroll
    for (int j = 0; j < 9; ++j)
#pragma unroll
        for (int r = 0; r < 4; ++r) { const int t = 16 * j + dv[r]; bool valid = (unsigned)(p0 + 16 * j + r) < (unsigned)lsub;
            if (j == 0) valid = valid && (dv[r] >= 0); if (j == 8) valid = valid && (dv[r] <= 0);
            const int ti = (j == 0) ? (t < 0 ? 0 : t) : ((j == 8) ? (t > 128 ? 128 : t) : t);
            const float s = valid ? acc[j][r] * (0.125f * 1.4426950408889634f) + btab[ti] : -1.0e30f; acc[j][r] = s; mx = fmaxf(mx, s); }
    mx = fmaxf(mx, __shfl_xor(mx, 16)); mx = fmaxf(mx, __shfl_xor(mx, 32));
    float lsum = 0.f;
#pragma unroll
    for (int j = 0; j < 9; ++j)
#pragma unroll
        for (int r = 0; r < 4; ++r) { const float p = __builtin_amdgcn_exp2f(acc[j][r] - mx); acc[j][r] = p; lsum += p; }
    lsum += __shfl_xor(lsum, 16); lsum += __shfl_xor(lsum, 32);
    f32x4 oacc[4];
#pragma unroll
    for (int d = 0; d < 4; ++d) oacc[d] = (f32x4){0.f, 0.f, 0.f, 0.f};
#pragma unroll
    for (int pp = 0; pp < 5; ++pp) {
        union { unsigned u[4]; bf16x8_t v; } pb;
        pb.u[0] = cvtpk(acc[2 * pp][0], acc[2 * pp][1]); pb.u[1] = cvtpk(acc[2 * pp][2], acc[2 * pp][3]); pb.u[2] = cvtpk(acc[2 * pp + 1][0], acc[2 * pp + 1][1]); pb.u[3] = cvtpk(acc[2 * pp + 1][2], acc[2 * pp + 1][3]);
#pragma unroll
        for (int d = 0; d < 4; ++d) { const LAS bf16* vp = Vt + (16 * d + fr) * AT_VLD + 16 * (wave + 2 * pp) + 4 * qd;
            union { bf16x4_t h[2]; bf16x8_t v; } va; va.h[0] = *(const LAS bf16x4_t*)vp; va.h[1] = *(const LAS bf16x4_t*)(vp + 16);
            oacc[d] = MFMA16(va.v, pb.v, oacc[d]); } }
    const float inv = 1.f / lsum; const int tok = b * SEQ + (l0 + iq) * dil + res;
    bf16* op = ao + ((size_t)br * NT + tok) * AW + hh * 64 + 4 * qd;
#pragma unroll
    for (int d = 0; d < 4; ++d) { uint2 w; w.x = cvtpk(oacc[d][0] * inv, oacc[d][1] * inv); w.y = cvtpk(oacc[d][2] * inv, oacc[d][3] * inv); *(uint2*)(op + 16 * d) = w; }
    if (qd == 0) al[((size_t)br * NT + tok) * 4 + hh] = mx * 0.6931471805599453f + logf(lsum);
}
constexpr int ATT_UNITS = 3 * NB * 4 * 16, ATT_SCAN_BLK0 = 160, ATT_SPLIT = ATT_UNITS - 96 * 6;
DI void phase_attn(const Args& A, LAS unsigned char* lds, int u0, int u1, int b0, int nb, int tid, int wave, int lane) {
    for (int u = u0 + b0; u < u1; u += nb) attn_unit(A, lds, u, tid, wave, lane);
    __syncthreads();
}


constexpr int ML_QLD = 104, ML_SLD = 72;
constexpr int ML_QS = 0;
constexpr int ML_QT = ML_QS + 64 * ML_QLD * 2;
constexpr int ML_KS = ML_QT + 64 * ML_QLD * 2;
constexpr int ML_KT = ML_KS + 64 * ML_QLD * 2;
constexpr int ML_VT = ML_KT + 96 * ML_SLD * 2;
constexpr int ML_WS = ML_VT + 112 * ML_SLD * 2;
constexpr int ML_CT = ML_WS + 64 * ML_SLD * 2;
constexpr int ML_CW = ML_CT + 112 * ML_QLD * 2;
constexpr int ML_END = ML_CW + 6 * 192 * 4;
static_assert(ML_END <= MISC_OFF, "mlstm LDS");

constexpr int MLP_QF = 0, MLP_NI = 12288, MLP_U = 26624, MLP_DEC = 48128, MLP_BYTES = 48384;
constexpr size_t WS_MLPKG = WS_R + 304 * MiB;
static_assert(WS_MLPKG + (size_t)2 * NB * 4 * 32 * MLP_BYTES <= WS_RKY, "mlstm package region");

struct M1Regs { u32x4_t zc[15]; u32x2_t vv[3]; float gi, gf; };
DI void mlstm_m1_fetch(const Args& A, int item, int tid, int lane, M1Regs& R) {
    const bf16* Z = (const bf16*)(A.ws + WS_Z);
    const int c = item & 31, u = item >> 5; const int dir = u / 32, b = (u % 32) / 4, hh = u % 4; const int j = tid >> 3, sub = tid & 7;
    const int tl = dir ? SEQ - 1 - (c * 64 + lane) : c * 64 + lane; const size_t tokl = (size_t)b * SEQ + tl;
    R.gi = bf2f(Z[tokl * ZLD + ZMG + dir * 8 + hh]); R.gf = bf2f(Z[tokl * ZLD + ZMG + dir * 8 + 4 + hh]);
    const int tj = dir ? SEQ - 1 - (c * 64 + j) : c * 64 + j; const size_t tokj = (size_t)b * SEQ + tj;
    const bool isk = sub >= 4; const int zcol = ZMQK + (isk ? 384 : 0) + hh * 96 + (sub & 3) * 24;
#pragma unroll
    for (int tap = 0; tap < 5; ++tap) { const int tt = tj + tap - 2; const bool ok = tt >= 0 && tt < SEQ; const u32x4_t* zp = (const u32x4_t*)(Z + ((size_t)b * SEQ + (ok ? tt : tj)) * ZLD + zcol);
#pragma unroll
        for (int q4 = 0; q4 < 3; ++q4) { const u32x4_t w = zp[q4]; R.zc[tap * 3 + q4] = ok ? w : (u32x4_t){0u, 0u, 0u, 0u}; } }
    const u32x2_t* vp = (const u32x2_t*)(Z + tokj * ZLD + ZMV + hh * 96 + sub * 12);
#pragma unroll
    for (int q2 = 0; q2 < 3; ++q2) R.vv[q2] = vp[q2];
}
DI void mlstm_m1_item(const Args& A, int l, LAS unsigned char* lds, int item, int item_next, M1Regs& R, int& hh_staged, int tid, int wave, int lane) {
    const int c = item & 31, u = item >> 5; const int dir = u / 32, hh = u % 4;
    LAS bf16* Qs = (LAS bf16*)(lds + ML_QS); LAS bf16* Qt = (LAS bf16*)(lds + ML_QT); LAS bf16* Ks = (LAS bf16*)(lds + ML_KS); LAS bf16* KtT = (LAS bf16*)(lds + ML_KT);
    LAS bf16* VtT = (LAS bf16*)(lds + ML_VT); LAS bf16* Ws = (LAS bf16*)(lds + ML_WS); LAS float* cwl = (LAS float*)(lds + ML_CW); LAS float* cbl = cwl + 5 * 192;
    const int fr = lane & 15, qd = lane >> 4;
    unsigned char* pkg = A.ws + WS_MLPKG + (size_t)item * MLP_BYTES;
    __syncthreads();
    if (hh != hh_staged) { hh_staged = hh;
        for (int i = tid; i < 5 * 192; i += NTHR) { const int tap = i / 192, ch = i % 192; cwl[i] = A.in[I_CW][(size_t)(l * 5 + tap) * 768 + (ch < 96 ? 0 : 384) + hh * 96 + (ch % 96)]; }
        for (int i = tid; i < 192; i += NTHR) cbl[i] = A.in[I_CB][(size_t)l * 768 + (i < 96 ? 0 : 384) + hh * 96 + (i % 96)];
        for (int i = tid; i < 16 * ML_SLD; i += NTHR) VtT[96 * ML_SLD + i] = (i < ML_SLD) ? (bf16)0x3F80u : (bf16)0u;
        __syncthreads(); }
    const float ibv = A.in[I_IB][(l * 2 + dir) * 4 + hh], fbv = A.in[I_FB][(l * 2 + dir) * 4 + hh];
    const int j = tid >> 3, sub = tid & 7;
    const float gi = R.gi + ibv, gf = R.gf + fbv;
    float bsum = fminf(gf, 0.f) - __logf(1.f + __expf(-fabsf(gf)));
#pragma unroll
    for (int o = 1; o < 64; o <<= 1) { const float t = __shfl_up(bsum, o); if (lane >= o) bsum += t; }
    const float bend = __shfl(bsum, 63);
    const float bj = __shfl(bsum, j), igj = __shfl(gi, j);
    { const bool isk = sub >= 4; const int c0 = (sub & 3) * 24, cl = (isk ? 96 : 0) + c0;
      float acc[24];
#pragma unroll
      for (int e = 0; e < 24; ++e) acc[e] = cbl[cl + e];
#pragma unroll
      for (int tap = 0; tap < 5; ++tap) {
#pragma unroll
          for (int q4 = 0; q4 < 3; ++q4) { const u32x4_t w = R.zc[tap * 3 + q4]; const LAS float* cwp = cwl + tap * 192 + cl + q4 * 8;
              acc[q4 * 8 + 0] += cwp[0] * __uint_as_float(w.x << 16); acc[q4 * 8 + 1] += cwp[1] * __uint_as_float(w.x & 0xffff0000u);
              acc[q4 * 8 + 2] += cwp[2] * __uint_as_float(w.y << 16); acc[q4 * 8 + 3] += cwp[3] * __uint_as_float(w.y & 0xffff0000u);
              acc[q4 * 8 + 4] += cwp[4] * __uint_as_float(w.z << 16); acc[q4 * 8 + 5] += cwp[5] * __uint_as_float(w.z & 0xffff0000u);
              acc[q4 * 8 + 6] += cwp[6] * __uint_as_float(w.w << 16); acc[q4 * 8 + 7] += cwp[7] * __uint_as_float(w.w & 0xffff0000u); } }
      const float sc1 = isk ? 0.10206207261596575f : 1.f; const float sc2 = isk ? __expf(bend - bj + igj) : __expf(bj);
#pragma unroll
      for (int e = 0; e < 24; ++e) acc[e] = acc[e] * sigm(acc[e]) * sc1;
      if (!isk) { LAS bf16* d1 = Qs + j * ML_QLD + c0; LAS bf16* d2 = Qt + j * ML_QLD + c0;
#pragma unroll
          for (int q4 = 0; q4 < 3; ++q4) { u32x4_t w; w.x = cvtpk(acc[q4 * 8 + 0], acc[q4 * 8 + 1]); w.y = cvtpk(acc[q4 * 8 + 2], acc[q4 * 8 + 3]); w.z = cvtpk(acc[q4 * 8 + 4], acc[q4 * 8 + 5]); w.w = cvtpk(acc[q4 * 8 + 6], acc[q4 * 8 + 7]);
              *(LAS u32x4_t*)(d1 + q4 * 8) = w;
              u32x4_t x; x.x = cvtpk(acc[q4 * 8 + 0] * sc2, acc[q4 * 8 + 1] * sc2); x.y = cvtpk(acc[q4 * 8 + 2] * sc2, acc[q4 * 8 + 3] * sc2); x.z = cvtpk(acc[q4 * 8 + 4] * sc2, acc[q4 * 8 + 5] * sc2); x.w = cvtpk(acc[q4 * 8 + 6] * sc2, acc[q4 * 8 + 7] * sc2);
              *(LAS u32x4_t*)(d2 + q4 * 8) = x; } }
      else { LAS bf16* d1 = Ks + j * ML_QLD + c0;
#pragma unroll
          for (int q4 = 0; q4 < 3; ++q4) { u32x4_t w; w.x = cvtpk(acc[q4 * 8 + 0], acc[q4 * 8 + 1]); w.y = cvtpk(acc[q4 * 8 + 2], acc[q4 * 8 + 3]); w.z = cvtpk(acc[q4 * 8 + 4], acc[q4 * 8 + 5]); w.w = cvtpk(acc[q4 * 8 + 6], acc[q4 * 8 + 7]);
              *(LAS u32x4_t*)(d1 + q4 * 8) = w; }
#pragma unroll
          for (int e = 0; e < 24; e += 2) { const unsigned pk_ = cvtpk(acc[e] * sc2, acc[e + 1] * sc2); KtT[(c0 + e) * ML_SLD + j] = (bf16)pk_; KtT[(c0 + e + 1) * ML_SLD + j] = (bf16)(pk_ >> 16); } } }
    { const int n0 = sub * 12;
#pragma unroll
      for (int q2 = 0; q2 < 3; ++q2) { const u32x2_t w = R.vv[q2]; LAS bf16* d = VtT + (n0 + q2 * 4) * ML_SLD + j;
          d[0] = (bf16)(w.x & 0xffffu); d[ML_SLD] = (bf16)(w.x >> 16); d[2 * ML_SLD] = (bf16)(w.y & 0xffffu); d[3 * ML_SLD] = (bf16)(w.y >> 16); } }
    if (item_next >= 0) mlstm_m1_fetch(A, item_next, tid, lane, R);
    __syncthreads();
#pragma unroll
    for (int i = 0; i < 2; ++i) { const int tile = 2 * wave + i, jt = tile >> 2, st = tile & 3; const int jq = 16 * jt + fr;
        u32x2_t w = (u32x2_t){0u, 0u};
        if (st <= jt) { f32x4 acc = (f32x4){0.f, 0.f, 0.f, 0.f};
#pragma unroll
            for (int ks = 0; ks < 3; ++ks) { const bf16x8_t a = *(const LAS bf16x8_t*)(Ks + (16 * st + fr) * ML_QLD + 32 * ks + 8 * qd); const bf16x8_t bq = *(const LAS bf16x8_t*)(Qs + jq * ML_QLD + 32 * ks + 8 * qd); acc = MFMA16(a, bq, acc); }
            const float bjq = __shfl(bsum, jq); float wv[4];
#pragma unroll
            for (int r = 0; r < 4; ++r) { const int s = 16 * st + 4 * qd + r; const float bs = __shfl(bsum, s), igs = __shfl(gi, s); wv[r] = (s <= jq) ? acc[r] * __expf(bjq - bs + igs) : 0.f; }
            w.x = cvtpk(wv[0], wv[1]); w.y = cvtpk(wv[2], wv[3]); }
        *(LAS u32x2_t*)(Ws + jq * ML_SLD + 16 * st + 4 * qd) = w; }
    __syncthreads();
    if (wave < 7) { const int nt = wave; bf16x8_t bv[2];
#pragma unroll
        for (int ks = 0; ks < 2; ++ks) bv[ks] = *(const LAS bf16x8_t*)(VtT + (16 * nt + fr) * ML_SLD + 32 * ks + 8 * qd);
#pragma unroll
        for (int jt = 0; jt < 4; ++jt) { const LAS bf16* ap = Ws + (16 * jt + fr) * ML_SLD + 8 * qd;
            f32x4 acc = MFMA16(bv[0], *(const LAS bf16x8_t*)ap, ((f32x4){0.f, 0.f, 0.f, 0.f})); acc = MFMA16(bv[1], *(const LAS bf16x8_t*)(ap + 32), acc);
            u32x2_t w; w.x = cvtpk(acc[0], acc[1]); w.y = cvtpk(acc[2], acc[3]); __builtin_nontemporal_store(w, (u32x2_t*)(pkg + MLP_NI + (size_t)(nt * 4 + jt) * 512 + lane * 8)); }
#pragma unroll
        for (int kt = 0; kt < 6; ++kt) { const LAS bf16* ap = KtT + (16 * kt + fr) * ML_SLD + 8 * qd;
            f32x4 acc = MFMA16(*(const LAS bf16x8_t*)ap, bv[0], ((f32x4){0.f, 0.f, 0.f, 0.f})); acc = MFMA16(*(const LAS bf16x8_t*)(ap + 32), bv[1], acc);
            u32x2_t w; w.x = cvtpk(acc[0], acc[1]); w.y = cvtpk(acc[2], acc[3]); __builtin_nontemporal_store(w, (u32x2_t*)(pkg + MLP_U + (size_t)(nt * 6 + kt) * 512 + lane * 8)); } }
    else {
#pragma unroll
        for (int id = 0; id < 12; ++id) { const int jt = id / 3, i3 = id % 3; const LAS bf16* p = Qt + (16 * jt + fr) * ML_QLD + 32 * i3 + 4 * qd; const u32x2_t lo = *(const LAS u32x2_t*)p, hi = *(const LAS u32x2_t*)(p + 16);
            __builtin_nontemporal_store((u32x4_t){lo.x, lo.y, hi.x, hi.y}, (u32x4_t*)(pkg + MLP_QF + (size_t)id * 1024 + lane * 16)); } }
    if (tid < 64) ((float*)(pkg + MLP_DEC))[tid] = __expf(bend);
}
DI void phase_mlstm_m1(const Args& A, int l, LAS unsigned char* lds, int bid, int G, int tid, int wave, int lane) {
    int hh_staged = -1; constexpr int NIT = 2 * NB * 4 * 32;
    if (bid < NIT) { M1Regs R; mlstm_m1_fetch(A, bid, tid, lane, R);
        for (int it = bid; it < NIT; it += G) mlstm_m1_item(A, l, lds, it, (it + G < NIT) ? it + G : -1, R, hh_staged, tid, wave, lane); }
    __syncthreads();
}
constexpr int M2_SLOTS = 8, M2_SLOT_BYTES = 12288, M2_CTL = M2_SLOTS * M2_SLOT_BYTES;
static_assert(M2_CTL + 64 <= MISC_OFF, "mlstm m2 LDS");
DI f32x4 unpk4(const u32x2_t w) { return (f32x4){__uint_as_float(w.x << 16), __uint_as_float(w.x & 0xffff0000u), __uint_as_float(w.y << 16), __uint_as_float(w.y & 0xffff0000u)}; }
struct M2Small { u32x2_t ni[4], uu[6]; float dec; };
DI void m2_load_small(M2Small& o, const unsigned char* pkg, int nt, int lane) {
#pragma unroll
    for (int jt = 0; jt < 4; ++jt) o.ni[jt] = __builtin_nontemporal_load((const u32x2_t*)(pkg + MLP_NI + (nt * 4 + jt) * 512 + lane * 8));
#pragma unroll
    for (int kt = 0; kt < 6; ++kt) o.uu[kt] = __builtin_nontemporal_load((const u32x2_t*)(pkg + MLP_U + (nt * 6 + kt) * 512 + lane * 8));
    o.dec = ((const float*)(pkg + MLP_DEC))[lane];
}
DI void m2_step(const M2Small& o, const LAS unsigned char* slot, f32x4 (&C)[6], bf16* num, float* den, int dir, int b, int hh, int nt, int c, int lane, int fr, int qd) {
    union { unsigned u[4]; bf16x8_t v; } sB[3];
#pragma unroll
    for (int i = 0; i < 3; ++i) { sB[i].u[0] = cvtpk(C[2 * i][0], C[2 * i][1]); sB[i].u[1] = cvtpk(C[2 * i][2], C[2 * i][3]); sB[i].u[2] = cvtpk(C[2 * i + 1][0], C[2 * i + 1][1]); sB[i].u[3] = cvtpk(C[2 * i + 1][2], C[2 * i + 1][3]); }
#pragma unroll
    for (int jt = 0; jt < 4; ++jt) { f32x4 acc = unpk4(o.ni[jt]);
#pragma unroll
        for (int i = 0; i < 3; ++i) { const bf16x8_t qf = *(const LAS bf16x8_t*)(slot + (3 * jt + i) * 1024 + lane * 16); acc = MFMA16(sB[i].v, qf, acc); }
        { const int jj = 16 * jt + fr; const int tt = dir ? SEQ - 1 - (c * 64 + jj) : c * 64 + jj; const size_t tok = (size_t)b * SEQ + tt;
          if (nt < 6) { u32x2_t w; w.x = cvtpk(acc[0], acc[1]); w.y = cvtpk(acc[2], acc[3]); *(u32x2_t*)(num + ((size_t)dir * NT + tok) * MW + hh * 96 + 16 * nt + 4 * qd) = w; }
          else if (qd == 0) den[((size_t)dir * NT + tok) * 4 + hh] = acc[0]; } }
#pragma unroll
    for (int kt = 0; kt < 6; ++kt) C[kt] = C[kt] * o.dec + unpk4(o.uu[kt]);
}
DI void mlstm_m2_unit(const Args& A, LAS unsigned char* lds, int u, int tid, int wave, int lane) {
    bf16* num = (bf16*)(A.ws + WS_MLNUM); float* den = (float*)(A.ws + WS_MLDEN);
    const int dir = u / 32, b = (u % 32) / 4, hh = u % 4; const int fr = lane & 15, qd = lane >> 4;
    const unsigned char* pkg0 = A.ws + WS_MLPKG + (size_t)u * 32 * MLP_BYTES;
    volatile LAS unsigned* ready = (volatile LAS unsigned*)(lds + M2_CTL); volatile LAS unsigned* consumed = ready + 8;
    __syncthreads();
    if (tid < 16) ready[tid] = 0u;
    __syncthreads();
    if (wave == 7) {
        u32x4_t f0[12], f1[12], f2[12];
#define M2_FETCH(dst, c_) do { _Pragma("unroll") for (int i = 0; i < 12; ++i) dst[i] = __builtin_nontemporal_load((const u32x4_t*)(pkg0 + (size_t)(c_) * MLP_BYTES + MLP_QF + i * 1024 + lane * 16)); } while (0)
#define M2_PUBLISH(src, c_) do { if ((c_) >= M2_SLOTS) { const unsigned need = (unsigned)((c_) - M2_SLOTS + 1); unsigned spins = 0; \
            for (;;) { bool ok = true; _Pragma("unroll") for (int w = 0; w < 7; ++w) ok = ok && (consumed[w] >= need); if (ok) break; if (++spins > (1u << 22)) break; __builtin_amdgcn_s_sleep(1); } } \
        LAS unsigned char* slot_ = lds + ((c_) & (M2_SLOTS - 1)) * M2_SLOT_BYTES; _Pragma("unroll") for (int i = 0; i < 12; ++i) *(LAS u32x4_t*)(slot_ + i * 1024 + lane * 16) = src[i]; \
        asm volatile("s_waitcnt lgkmcnt(0)" ::: "memory"); if (lane == 0) ready[(c_) & (M2_SLOTS - 1)] = (unsigned)((c_) + 1); asm volatile("" ::: "memory"); } while (0)
        M2_FETCH(f0, 0); M2_FETCH(f1, 1);
        for (int c = 0; c < 30; c += 3) { M2_FETCH(f2, c + 2); M2_PUBLISH(f0, c); M2_FETCH(f0, c + 3); M2_PUBLISH(f1, c + 1); M2_FETCH(f1, c + 4); M2_PUBLISH(f2, c + 2); }
        M2_PUBLISH(f0, 30); M2_PUBLISH(f1, 31);
#undef M2_FETCH
#undef M2_PUBLISH
    } else {
        const int nt = wave; f32x4 C[6];
#pragma unroll
        for (int kt = 0; kt < 6; ++kt) C[kt] = (f32x4){0.f, 0.f, 0.f, 0.f};
        M2Small s0, s1, s2, s3;
        m2_load_small(s0, pkg0, nt, lane); m2_load_small(s1, pkg0 + MLP_BYTES, nt, lane); m2_load_small(s2, pkg0 + 2 * (size_t)MLP_BYTES, nt, lane); m2_load_small(s3, pkg0 + 3 * (size_t)MLP_BYTES, nt, lane);
#define M2_CHAIN(sx, c_) do { unsigned spins = 0; while (ready[(c_) & (M2_SLOTS - 1)] != (unsigned)((c_) + 1)) { if (++spins > (1u << 22)) break; __builtin_amdgcn_s_sleep(1); } asm volatile("" ::: "memory"); \
            m2_step(sx, lds + ((c_) & (M2_SLOTS - 1)) * M2_SLOT_BYTES, C, num, den, dir, b, hh, nt, (c_), lane, fr, qd); \
            asm volatile("s_waitcnt lgkmcnt(0)" ::: "memory"); if (lane == 0) consumed[nt] = (unsigned)((c_) + 1); asm volatile("" ::: "memory"); \
            if ((c_) + 4 < 32) m2_load_small(sx, pkg0 + (size_t)((c_) + 4) * MLP_BYTES, nt, lane); } while (0)
        for (int c = 0; c < 32; c += 4) { M2_CHAIN(s0, c); M2_CHAIN(s1, c + 1); M2_CHAIN(s2, c + 2); M2_CHAIN(s3, c + 3); }
#undef M2_CHAIN
    }
    __syncthreads();
}

constexpr int PKG_BYTES = 12544;
constexpr int PK_AH = 0, PK_RH = 2048, PK_KB = 4096, PK_VV = 8192, PK_TM = 10240, PK_MM = 10752, PK_LAK = 11776, PK_GE = 12288;
constexpr size_t WS_PKG = WS_PR;
static_assert((size_t)2 * NB * 6 * 128 * PKG_BYTES <= 288 * MiB, "package region");
constexpr int R1_W2T = 0, R1_A2T = 9216, R1_WV = 18432, R1_WV_BYTES = 12928;
constexpr int R1_IMG = 0, R1_LF = 9216, R1_MT = 10368;
constexpr int R1_PRM = R1_WV + 8 * R1_WV_BYTES;
static_assert(R1_PRM + 8 * 64 * 4 <= MISC_OFF, "rwkv r1 LDS");

DI bf16x4_t pack4(const f32x4 v) { union { unsigned u[2]; bf16x4_t h; } x; x.u[0] = cvtpk(v[0], v[1]); x.u[1] = cvtpk(v[2], v[3]); return x.h; }

DI void rwkv_r1_item(const Args& A, int l, LAS unsigned char* lds, int item, int& dh_staged, int tid, int wave, int lane) {
    const bf16* Z = (const bf16*)(A.ws + WS_Z);
    const int g = item & 15; int r0 = item >> 4; const int hh = r0 % 6; r0 /= 6; const int b = r0 % NB, dir = r0 / NB;
    const int cc = 8 * g + wave, fr = lane & 15, qd = lane >> 4;
    LAS bf16* W2T = (LAS bf16*)(lds + R1_W2T); LAS bf16* A2T = (LAS bf16*)(lds + R1_A2T);
    LAS unsigned char* wv = lds + R1_WV + wave * R1_WV_BYTES;
    const LAS float* prm = (const LAS float*)(lds + R1_PRM);
    LAS bf16* IMG = (LAS bf16*)(wv + R1_IMG); LAS float* Lf = (LAS float*)(wv + R1_LF); LAS bf16* MT = (LAS bf16*)(wv + R1_MT);
    const int sgn = dir ? -1 : 1; const int tok0 = b * SEQ + (dir ? SEQ - 1 - 16 * cc : 16 * cc);
    const float* mu = A.in[I_MU] + (size_t)(l * 2 + dir) * 1280;
    float er[4][4], ek[4][4], ev[4][4];
    u32x4_t ld[7];
#pragma unroll
    for (int i = 0; i < 7; ++i) { const int idx = lane + 64 * i; const int ri = idx / 24, pc = idx % 24; const bool ok = (idx < 17 * 24) && (ri > 0 || cc > 0);
        ld[i] = (u32x4_t){0u, 0u, 0u, 0u};
        if (ok) ld[i] = *(const u32x4_t*)(Z + (size_t)(tok0 + sgn * (ri - 1)) * ZLD + ZRKV + (pc >> 3) * RW + hh * 64 + (pc & 7) * 8); }
    uint4 zcw[2], zca[2], zpw[2], zpa[2];
    { const int zwd = dir ? ZWDB : ZWDF, zad = dir ? ZADB : ZADF; const bool hasp = !(cc == 0 && fr == 0);
      const bf16* zc = Z + (size_t)(tok0 + sgn * fr) * ZLD; const bf16* zq = Z + (size_t)(tok0 + sgn * (fr - 1)) * ZLD;
#pragma unroll
      for (int ks = 0; ks < 2; ++ks) { zcw[ks] = *(const uint4*)(zc + zwd + 32 * ks + 8 * qd); zca[ks] = *(const uint4*)(zc + zad + 32 * ks + 8 * qd);
          zpw[ks] = make_uint4(0u, 0u, 0u, 0u); zpa[ks] = make_uint4(0u, 0u, 0u, 0u);
          if (hasp) { zpw[ks] = *(const uint4*)(zq + zwd + 32 * ks + 8 * qd); zpa[ks] = *(const uint4*)(zq + zad + 32 * ks + 8 * qd); } } }
    if (dh_staged != dir * 6 + hh) { dh_staged = dir * 6 + hh;
    const int ch = tid & 63, i0 = (tid >> 6) * 8; const float* w2 = A.in[I_W2] + ((size_t)(l * 2 + dir) * 64 + i0) * RW + hh * 64 + ch; const float* a2 = A.in[I_A2] + ((size_t)(l * 2 + dir) * 64 + i0) * RW + hh * 64 + ch;
    u32x4_t pw, pa; pw.x = cvtpk(w2[0], w2[RW]); pw.y = cvtpk(w2[2 * RW], w2[3 * RW]); pw.z = cvtpk(w2[4 * RW], w2[5 * RW]); pw.w = cvtpk(w2[6 * RW], w2[7 * RW]);
    pa.x = cvtpk(a2[0], a2[RW]); pa.y = cvtpk(a2[2 * RW], a2[3 * RW]); pa.z = cvtpk(a2[4 * RW], a2[5 * RW]); pa.w = cvtpk(a2[6 * RW], a2[7 * RW]);
    float prmv; { const int pi = tid >> 6, pc = hh * 64 + (tid & 63); const float* mu_ = A.in[I_MU] + (size_t)(l * 2 + dir) * 1280;
      prmv = pi < 3 ? mu_[pi * RW + pc] : (pi == 3 ? A.in[I_W0][(size_t)(l * 2 + dir) * RW + pc] : (pi == 4 ? A.in[I_A0][(size_t)(l * 2 + dir) * RW + pc] : (pi == 5 ? A.in[I_KK][(size_t)l * RW + pc] : (pi == 6 ? A.in[I_KA][(size_t)l * RW + pc] : A.in[I_RK][(size_t)l * RW + pc])))); }
    __syncthreads();
    *(LAS u32x4_t*)(W2T + ch * 72 + i0) = pw; *(LAS u32x4_t*)(A2T + ch * 72 + i0) = pa; ((LAS float*)(lds + R1_PRM))[tid] = prmv;
    __syncthreads(); }
    { LAS bf16* stg = IMG; constexpr int SLD = 200;
#pragma unroll
      for (int i = 0; i < 7; ++i) { const int idx = lane + 64 * i; const int ri = idx / 24, pc = idx % 24; if (idx < 17 * 24) *(LAS u32x4_t*)(stg + ri * SLD + pc * 8) = ld[i]; }
      asm volatile("s_waitcnt lgkmcnt(0)" ::: "memory");
#pragma unroll
      for (int nt = 0; nt < 4; ++nt) { const LAS bf16* sp = stg + (4 * qd) * SLD + 16 * nt + fr;
          float qr = bf2f(sp[0]), qk = bf2f(sp[64]), qv = bf2f(sp[128]);
          const float mr = prm[16 * nt + fr], mk = prm[64 + 16 * nt + fr], mv = prm[128 + 16 * nt + fr];
#pragma unroll
          for (int r = 0; r < 4; ++r) { const float cr = bf2f(sp[(r + 1) * SLD]), ck = bf2f(sp[(r + 1) * SLD + 64]), cv = bf2f(sp[(r + 1) * SLD + 128]);
              er[nt][r] = cr + mr * (qr - cr); ek[nt][r] = ck + mk * (qk - ck); ev[nt][r] = cv + mv * (qv - cv); qr = cr; qk = ck; qv = cv; } }
      asm volatile("s_waitcnt lgkmcnt(0)" ::: "memory"); }
    bf16x8_t thA[2], adA[2];
    {
#pragma unroll
      for (int ks = 0; ks < 2; ++ks) { float cw[8], pw[8], ca[8], pa[8];
          unpack8(zcw[ks], cw); unpack8(zca[ks], ca); unpack8(zpw[ks], pw); unpack8(zpa[ks], pa);
          const float* muw = mu + 1152 + 32 * ks + 8 * qd; const float* mua = mu + 1216 + 32 * ks + 8 * qd;
#pragma unroll
          for (int e = 0; e < 8; ++e) { const float xw = cw[e] + muw[e] * (pw[e] - cw[e]); cw[e] = 1.f - 2.f * __builtin_amdgcn_rcpf(1.f + __expf(2.f * xw)); ca[e] = ca[e] + mua[e] * (pa[e] - ca[e]); }
          union { unsigned u[4]; bf16x8_t v; } x, y;
#pragma unroll
          for (int e = 0; e < 4; ++e) { x.u[e] = cvtpk(cw[2 * e], cw[2 * e + 1]); y.u[e] = cvtpk(ca[2 * e], ca[2 * e + 1]); }
          thA[ks] = x.v; adA[ks] = y.v; } }
    f32x4 wl[4], al[4];
#pragma unroll
    for (int nt = 0; nt < 4; ++nt) { wl[nt] = (f32x4){0.f, 0.f, 0.f, 0.f}; al[nt] = (f32x4){0.f, 0.f, 0.f, 0.f};
#pragma unroll
        for (int ks = 0; ks < 2; ++ks) { const bf16x8_t bw = *(const LAS bf16x8_t*)(W2T + (16 * nt + fr) * 72 + 32 * ks + 8 * qd); const bf16x8_t ba = *(const LAS bf16x8_t*)(A2T + (16 * nt + fr) * 72 + 32 * ks + 8 * qd);
            wl[nt] = MFMA16(thA[ks], bw, wl[nt]); al[nt] = MFMA16(adA[ks], ba, al[nt]); } }
    float lw[4][4], alp[4][4], kap[4][4]; float ssq[4] = {0.f, 0.f, 0.f, 0.f}, bsm[4] = {0.f, 0.f, 0.f, 0.f};
#pragma unroll
    for (int nt = 0; nt < 4; ++nt) { const int ch = hh * 64 + 16 * nt + fr;
        const float w0v = prm[192 + 16 * nt + fr], a0v = prm[256 + 16 * nt + fr], kkw = prm[320 + 16 * nt + fr], kaw = prm[384 + 16 * nt + fr], rkw = prm[448 + 16 * nt + fr];
#pragma unroll
        for (int r = 0; r < 4; ++r) { const float x = w0v + wl[nt][r];
            lw[nt][r] = -0.6065306597126334f * __builtin_amdgcn_rcpf(1.f + __expf(-x));
            const float a = __builtin_amdgcn_rcpf(1.f + __expf(-(a0v + al[nt][r]))); alp[nt][r] = a;
            const float k0 = ek[nt][r]; kap[nt][r] = k0 * kkw; ek[nt][r] = k0 * (1.f + (a - 1.f) * kaw);
            ssq[r] += kap[nt][r] * kap[nt][r]; bsm[r] += er[nt][r] * ek[nt][r] * rkw; } }
#pragma unroll
    for (int r = 0; r < 4; ++r) {
        ssq[r] = row16_sum(ssq[r]); bsm[r] = row16_sum(bsm[r]);
        ssq[r] = __builtin_amdgcn_rsqf(fmaxf(ssq[r], 1e-24f)); }
    { bf16* bon = (bf16*)(A.ws + WS_RKB);
#pragma unroll
      for (int nt = 0; nt < 4; ++nt)
#pragma unroll
          for (int r = 0; r < 4; ++r) { kap[nt][r] *= ssq[r]; MT[(4 * qd + r) * 72 + 16 * nt + fr] = (bf16)cvtpk(bsm[r] * ev[nt][r], 0.f); }
      asm volatile("s_waitcnt lgkmcnt(0)" ::: "memory");
      const int p = lane >> 2, c16 = (lane & 3) * 16; const LAS u32x4_t* sp = (const LAS u32x4_t*)(MT + p * 72 + c16); const u32x4_t w0 = sp[0], w1 = sp[1];
      bf16* dst = bon + ((size_t)dir * NT + tok0 + sgn * p) * RW + hh * 64 + c16;
      *(u32x4_t*)dst = w0; *(u32x4_t*)(dst + 8) = w1;
      asm volatile("s_waitcnt lgkmcnt(0)" ::: "memory"); }
    unsigned char* pkg = A.ws + WS_PKG + ((size_t)((dir * NB + b) * 6 + hh) * 128 + cc) * PKG_BYTES;
    float lend[4];
    u32x2_t btf[4], ktf[4];
#pragma unroll
    for (int nt = 0; nt < 4; ++nt) { float lam[4]; lam[0] = lw[nt][0]; lam[1] = lam[0] + lw[nt][1]; lam[2] = lam[1] + lw[nt][2]; lam[3] = lam[2] + lw[nt][3];
        const float t1 = __shfl(lam[3], lane - 16), t2 = __shfl(lam[3], lane - 32), t3 = __shfl(lam[3], lane - 48);
        const float off = (qd >= 1 ? t1 : 0.f) + (qd >= 2 ? t2 : 0.f) + (qd >= 3 ? t3 : 0.f);
#pragma unroll
        for (int r = 0; r < 4; ++r) lam[r] += off;
        lend[nt] = __shfl(lam[3], 48 + fr);
        float bt4[4], kt4[4];
        float epv[4];
#pragma unroll
        for (int r = 0; r < 4; ++r) epv[r] = __expf(lam[r]);
        float ep_prev = __shfl(epv[3], lane - 16); if (qd == 0) ep_prev = 1.f;
        const float eendall = __expf(lend[nt]);
        float ia[4], ir[4], ib[4], ik[4];
#pragma unroll
        for (int r = 0; r < 4; ++r) { const float ep = epv[r], epm = r ? epv[r - 1] : ep_prev, einv = __builtin_amdgcn_rcpf(ep), eend = eendall * einv;
            const float bb = kap[nt][r] * alp[nt][r];
            ia[r] = -kap[nt][r] * epm; ir[r] = er[nt][r] * ep; ib[r] = bb * einv; ik[r] = ek[nt][r] * einv;
            bt4[r] = bb * eend; kt4[r] = ek[nt][r] * eend; }
#pragma unroll
        for (int r = 0; r < 4; r += 2) { const int o = (4 * qd + r) * 72 + 16 * nt + fr;
            const unsigned pa_ = cvtpk(ia[r], ia[r + 1]), pr_ = cvtpk(ir[r], ir[r + 1]), pb_ = cvtpk(ib[r], ib[r + 1]), pk_ = cvtpk(ik[r], ik[r + 1]);
            IMG[o] = (bf16)pa_; IMG[o + 72] = (bf16)(pa_ >> 16); IMG[1152 + o] = (bf16)pr_; IMG[1152 + o + 72] = (bf16)(pr_ >> 16);
            IMG[2304 + o] = (bf16)pb_; IMG[2304 + o + 72] = (bf16)(pb_ >> 16); IMG[3456 + o] = (bf16)pk_; IMG[3456 + o + 72] = (bf16)(pk_ >> 16); }
        btf[nt].x = cvtpk(bt4[0], bt4[1]); btf[nt].y = cvtpk(bt4[2], bt4[3]); ktf[nt].x = cvtpk(kt4[0], kt4[1]); ktf[nt].y = cvtpk(kt4[2], kt4[3]); }
    asm volatile("s_waitcnt lgkmcnt(0)" ::: "memory");
    f32x4 Lab = (f32x4){0.f, 0.f, 0.f, 0.f}, Lak = Lab, Mrb = Lab, Mrk = Lab;
#pragma unroll
    for (int ks = 0; ks < 2; ++ks) { const int o = fr * 72 + 32 * ks + 8 * qd;
        const bf16x8_t aA = *(const LAS bf16x8_t*)(IMG + o), aR = *(const LAS bf16x8_t*)(IMG + 1152 + o), bB = *(const LAS bf16x8_t*)(IMG + 2304 + o), bK = *(const LAS bf16x8_t*)(IMG + 3456 + o);
        Lab = MFMA16(aA, bB, Lab); Lak = MFMA16(aA, bK, Lak); Mrb = MFMA16(aR, bB, Mrb); Mrk = MFMA16(aR, bK, Mrk); }
#pragma unroll
    for (int r = 0; r < 4; ++r) { const int t = 4 * qd + r; if (!(fr < t)) { Lab[r] = 0.f; Lak[r] = 0.f; } if (!(fr <= t)) { Mrb[r] = 0.f; Mrk[r] = 0.f; } Lf[t * 17 + fr] = Lab[r]; }
    asm volatile("s_waitcnt lgkmcnt(0)" ::: "memory");
    float Tc[16];
#pragma unroll
    for (int t = 0; t < 16; ++t) { float acc = (t == fr) ? 1.f : 0.f;
#pragma unroll
        for (int s = 0; s < t; ++s) acc += Lf[t * 17 + s] * Tc[s];
        Tc[t] = acc; }
    f32x4 Tm;
#pragma unroll
    for (int r = 0; r < 4; ++r) Tm[r] = qd == 0 ? Tc[r] : (qd == 1 ? Tc[4 + r] : (qd == 2 ? Tc[8 + r] : Tc[12 + r]));
#pragma unroll
    for (int r = 0; r < 4; ++r) { const int o = (4 * qd + r) * 20 + fr; MT[o] = (bf16)cvtpk(Tm[r], 0.f); MT[320 + o] = (bf16)cvtpk(Mrb[r], 0.f); MT[640 + o] = (bf16)cvtpk(Lak[r], 0.f); MT[960 + o] = (bf16)cvtpk(Mrk[r], 0.f); }
    asm volatile("s_waitcnt lgkmcnt(0)" ::: "memory");
    { const int o = fr * 20 + 4 * qd;
      const u32x2_t mrb = *(const LAS u32x2_t*)(MT + 320 + o), mrk = *(const LAS u32x2_t*)(MT + 960 + o);
      __builtin_nontemporal_store(*(const LAS u32x2_t*)(MT + o), (u32x2_t*)(pkg + PK_TM + lane * 8)); __builtin_nontemporal_store(*(const LAS u32x2_t*)(MT + 640 + o), (u32x2_t*)(pkg + PK_LAK + lane * 8));
      __builtin_nontemporal_store((u32x4_t){mrk.x, mrk.y, mrb.x, mrb.y}, (u32x4_t*)(pkg + PK_MM + lane * 16)); }
#pragma unroll
    for (int ks = 0; ks < 2; ++ks) { const int o = fr * 72 + 32 * ks + 4 * qd;
        const u32x2_t alo = *(const LAS u32x2_t*)(IMG + o), ahi = *(const LAS u32x2_t*)(IMG + o + 16), rlo = *(const LAS u32x2_t*)(IMG + 1152 + o), rhi = *(const LAS u32x2_t*)(IMG + 1152 + o + 16);
        __builtin_nontemporal_store((u32x4_t){alo.x, alo.y, ahi.x, ahi.y}, (u32x4_t*)(pkg + PK_AH + ks * 1024 + lane * 16)); __builtin_nontemporal_store((u32x4_t){rlo.x, rlo.y, rhi.x, rhi.y}, (u32x4_t*)(pkg + PK_RH + ks * 1024 + lane * 16)); }
#pragma unroll
    for (int nt = 0; nt < 4; ++nt) { __builtin_nontemporal_store((u32x4_t){ktf[nt].x, ktf[nt].y, btf[nt].x, btf[nt].y}, (u32x4_t*)(pkg + PK_KB + nt * 1024 + lane * 16));
        u32x2_t vf; vf.x = cvtpk(ev[nt][0], ev[nt][1]); vf.y = cvtpk(ev[nt][2], ev[nt][3]); __builtin_nontemporal_store(vf, (u32x2_t*)(pkg + PK_VV + nt * 512 + lane * 8));
        if (qd == 0) ((float*)(pkg + PK_GE))[16 * nt + fr] = __expf(lend[nt]); }
    asm volatile("s_waitcnt lgkmcnt(0)" ::: "memory");
}
DI void phase_rwkv_r1(const Args& A, int l, LAS unsigned char* lds, int bid, int G, int tid, int wave, int lane) {
    constexpr int NIT = 2 * NB * 6 * 16; int dh_staged = -1;
    __syncthreads();
    for (int it = bid; it < NIT; it += G) rwkv_r1_item(A, l, lds, it, dh_staged, tid, wave, lane);
    __syncthreads();
}

struct RkOps { bf16x8_t ah[2], rh[2], kb[4], mm; bf16x4_t vv, tm, lak; f32x4 ge[4]; };
DI bf16x8_t widen4(const bf16x4_t a) { return __builtin_shufflevector(a, (bf16x4_t){0, 0, 0, 0}, 0, 1, 2, 3, 4, 5, 6, 7); }
DI void rk_step(const RkOps& c, f32x4 (&sT)[4], bf16* yb, int dir, int b, int hh, int vb, int cc, int fr, int qd) {
    const f32x4 zero4 = (f32x4){0.f, 0.f, 0.f, 0.f};
    union { unsigned u[4]; bf16x8_t v; } s0, s1;
    s0.u[0] = cvtpk(sT[0][0], sT[0][1]); s0.u[1] = cvtpk(sT[0][2], sT[0][3]); s0.u[2] = cvtpk(sT[1][0], sT[1][1]); s0.u[3] = cvtpk(sT[1][2], sT[1][3]);
    s1.u[0] = cvtpk(sT[2][0], sT[2][1]); s1.u[1] = cvtpk(sT[2][2], sT[2][3]); s1.u[2] = cvtpk(sT[3][0], sT[3][1]); s1.u[3] = cvtpk(sT[3][2], sT[3][3]);
    f32x4 ax = MFMA16(widen4(c.lak), widen4(c.vv), zero4); ax = MFMA16(c.ah[0], s0.v, ax); ax = MFMA16(c.ah[1], s1.v, ax);
    f32x4 ay = MFMA16(s0.v, c.rh[0], zero4); ay = MFMA16(s1.v, c.rh[1], ay);
    const f32x4 au = MFMA16(widen4(c.tm), widen4(pack4(ax)), zero4);
    const bf16x8_t vu = __builtin_shufflevector(c.vv, pack4(au), 0, 1, 2, 3, 4, 5, 6, 7);
    ay = MFMA16(vu, c.mm, ay);
#pragma unroll
    for (int kt = 0; kt < 4; ++kt) sT[kt] = MFMA16(c.kb[kt], vu, sT[kt] * c.ge[kt]);
    const int sgn = dir ? -1 : 1; const int tok0 = b * SEQ + (dir ? SEQ - 1 - 16 * cc : 16 * cc);
    { u32x2_t w; w.x = cvtpk(ay[0], ay[1]); w.y = cvtpk(ay[2], ay[3]); *(u32x2_t*)(yb + ((size_t)dir * NT + tok0 + sgn * fr) * RW + hh * 64 + 16 * vb + 4 * qd) = w; }
}
constexpr int R2_SLOTS = 8, R2_CTL = R2_SLOTS * PKG_BYTES;
static_assert(R2_CTL + 64 <= MISC_OFF, "rwkv r2 LDS");
DI void rk_load_lds(RkOps& o, const LAS unsigned char* pkg, int vb, int lane, int qd) {
#pragma unroll
    for (int ks = 0; ks < 2; ++ks) { o.ah[ks] = *(const LAS bf16x8_t*)(pkg + PK_AH + ks * 1024 + lane * 16); o.rh[ks] = *(const LAS bf16x8_t*)(pkg + PK_RH + ks * 1024 + lane * 16); }
#pragma unroll
    for (int kt = 0; kt < 4; ++kt) { o.kb[kt] = *(const LAS bf16x8_t*)(pkg + PK_KB + kt * 1024 + lane * 16); o.ge[kt] = *(const LAS f32x4*)(pkg + PK_GE + (16 * kt + 4 * qd) * 4); }
    o.mm = *(const LAS bf16x8_t*)(pkg + PK_MM + lane * 16);
    o.vv = *(const LAS bf16x4_t*)(pkg + PK_VV + vb * 512 + lane * 8); o.tm = *(const LAS bf16x4_t*)(pkg + PK_TM + lane * 8); o.lak = *(const LAS bf16x4_t*)(pkg + PK_LAK + lane * 8);
}
DI void rk_pkg_fetch(u32x4_t (&buf)[13], const unsigned char* pkg, int lane) {
#pragma unroll
    for (int i = 0; i < 12; ++i) buf[i] = __builtin_nontemporal_load((const u32x4_t*)(pkg + i * 1024 + lane * 16));
    buf[12] = (lane < 16) ? __builtin_nontemporal_load((const u32x4_t*)(pkg + 12288 + lane * 16)) : (u32x4_t){0u, 0u, 0u, 0u};
}
DI void rwkv_r2_unit(const Args& A, LAS unsigned char* lds, int u, int tid, int wave, int lane) {
    bf16* yb = (bf16*)(A.ws + WS_RKY);
    const int dir = u / 48, rem = u % 48, b = rem / 6, hh = rem % 6; const int fr = lane & 15, qd = lane >> 4;
    const unsigned char* pkg0 = A.ws + WS_PKG + ((size_t)((dir * NB + b) * 6 + hh) * 128) * PKG_BYTES;
    volatile LAS unsigned* ready = (volatile LAS unsigned*)(lds + R2_CTL); volatile LAS unsigned* consumed = ready + 8;
    __syncthreads();
    if (tid < 16) ready[tid] = 0u;
    __syncthreads();
    if (wave >= 4) {
        const int j = wave - 4; u32x4_t cur[13], nxt[13];
        rk_pkg_fetch(cur, pkg0 + (size_t)j * PKG_BYTES, lane);
        for (int cc = j; cc < 128; cc += 4) {
            if (cc + 4 < 128) rk_pkg_fetch(nxt, pkg0 + (size_t)(cc + 4) * PKG_BYTES, lane);
            if (cc >= R2_SLOTS) { const unsigned need = (unsigned)(cc - R2_SLOTS + 1); unsigned spins = 0;
                for (;;) { const unsigned c0 = consumed[0], c1 = consumed[1], c2 = consumed[2], c3 = consumed[3];
                    if (c0 >= need && c1 >= need && c2 >= need && c3 >= need) break; if (++spins > (1u << 22)) break; __builtin_amdgcn_s_sleep(1); } }
            LAS unsigned char* slot = lds + (cc & (R2_SLOTS - 1)) * PKG_BYTES;
#pragma unroll
            for (int i = 0; i < 12; ++i) *(LAS u32x4_t*)(slot + i * 1024 + lane * 16) = cur[i];
            if (lane < 16) *(LAS u32x4_t*)(slot + 12288 + lane * 16) = cur[12];
            asm volatile("s_waitcnt lgkmcnt(0)" ::: "memory");
            if (lane == 0) ready[cc & (R2_SLOTS - 1)] = (unsigned)(cc + 1);
            asm volatile("" ::: "memory");
#pragma unroll
            for (int i = 0; i < 13; ++i) cur[i] = nxt[i];
        }
    } else {
        const int vb = wave; f32x4 sT[4];
#pragma unroll
        for (int kt = 0; kt < 4; ++kt) sT[kt] = (f32x4){0.f, 0.f, 0.f, 0.f};
#define RK_WAIT(cc_) do { unsigned spins = 0; while (ready[(cc_) & (R2_SLOTS - 1)] != (unsigned)((cc_) + 1)) { if (++spins > (1u << 22)) break; __builtin_amdgcn_s_sleep(1); } asm volatile("" ::: "memory"); } while (0)
        RkOps pa, pb;
        RK_WAIT(0); rk_load_lds(pa, lds, vb, lane, qd);
        for (int cc = 0; cc < 128; cc += 2) {
            RK_WAIT(cc + 1); rk_load_lds(pb, lds + ((cc + 1) & (R2_SLOTS - 1)) * PKG_BYTES, vb, lane, qd);
            rk_step(pa, sT, yb, dir, b, hh, vb, cc, fr, qd);
            asm volatile("s_waitcnt lgkmcnt(0)" ::: "memory"); if (lane == 0) consumed[vb] = (unsigned)(cc + 2); asm volatile("" ::: "memory");
            if (cc + 2 < 128) { RK_WAIT(cc + 2); rk_load_lds(pa, lds + ((cc + 2) & (R2_SLOTS - 1)) * PKG_BYTES, vb, lane, qd); }
            rk_step(pb, sT, yb, dir, b, hh, vb, cc + 1, fr, qd);
            if (cc + 2 < 128) { asm volatile("s_waitcnt lgkmcnt(0)" ::: "memory"); if (lane == 0) consumed[vb] = (unsigned)(cc + 3); asm volatile("" ::: "memory"); }
        }
#undef RK_WAIT
    }
    __syncthreads();
}


constexpr int YA_G2LD = 136;
static_assert(384 * YA_G2LD * 2 <= MISC_OFF, "yasm LDS");
DI void unpack4(const uint2 w, float (&f)[4]) { f[0] = __uint_as_float(w.x << 16); f[1] = __uint_as_float(w.x & 0xffff0000u); f[2] = __uint_as_float(w.y << 16); f[3] = __uint_as_float(w.y & 0xffff0000u); }
struct YTok { float lsev, denv; uint2 av[3], nA[2], nB[2], zA, zB; };
DI void yasm_token_load(YTok& t, const bf16* Z, const bf16* ao, const float* al, const bf16* num, const float* den, int tok, int lane) {
    const bf16* zr = Z + (size_t)tok * ZLD; const int lb = lane & 31;
    t.lsev = al[((size_t)((lane >> 2) % 3) * NT + tok) * 4 + (lane & 3)];
    t.denv = den[((size_t)((lane >> 2) & 1) * NT + tok) * 4 + (lane & 3)];
#pragma unroll
    for (int br = 0; br < 3; ++br) t.av[br] = *(const uint2*)(ao + ((size_t)br * NT + tok) * AW + 4 * lane);
#pragma unroll
    for (int d = 0; d < 2; ++d) { t.nA[d] = *(const uint2*)(num + ((size_t)d * NT + tok) * MW + 4 * lane); t.nB[d] = *(const uint2*)(num + ((size_t)d * NT + tok) * MW + 256 + 4 * lb); }
    t.zA = *(const uint2*)(zr + ZMO + 4 * lane); t.zB = *(const uint2*)(zr + ZMO + 256 + 4 * lb);
}
DI void yasm_token_finish(const YTok& t, const f32x4 mgA, const f32x4 mgB, bf16* y, int tok, int lane) {
    bf16* yr = y + (size_t)tok * DM; const bool lo32 = lane < 32;
    const float lsev = t.lsev, denv = t.denv;
    { const int hh = lane >> 4; const float l0 = __shfl(lsev, hh), l1 = __shfl(lsev, 4 + hh), l2 = __shfl(lsev, 8 + hh);
      const float mx = fmaxf(l0, fmaxf(l1, l2)); const float w0 = __expf(l0 - mx), w1 = __expf(l1 - mx), w2 = __expf(l2 - mx); const float inv = __builtin_amdgcn_rcpf(w0 + w1 + w2);
      float a0[4], a1[4], a2[4]; unpack4(t.av[0], a0); unpack4(t.av[1], a1); unpack4(t.av[2], a2);
      uint2 o; o.x = pkbf((w0 * a0[0] + w1 * a1[0] + w2 * a2[0]) * inv, (w0 * a0[1] + w1 * a1[1] + w2 * a2[1]) * inv); o.y = pkbf((w0 * a0[2] + w1 * a1[2] + w2 * a2[2]) * inv, (w0 * a0[3] + w1 * a1[3] + w2 * a2[3]) * inv);
      *(uint2*)(yr + 4 * lane) = o; }
    { const int hA = lane / 24, hB = lane < 8 ? 2 : 3;
      const float dfA = __shfl(denv, hA), dbA = __shfl(denv, 4 + hA), dfB = __shfl(denv, hB), dbB = __shfl(denv, 4 + hB);
      const float ifA = __builtin_amdgcn_rcpf(fmaxf(fabsf(dfA), 1.f)), ibA = __builtin_amdgcn_rcpf(fmaxf(fabsf(dbA), 1.f)), ifB = __builtin_amdgcn_rcpf(fmaxf(fabsf(dfB), 1.f)), ibB = __builtin_amdgcn_rcpf(fmaxf(fabsf(dbB), 1.f));
      float f0[4], f1[4], a[4], b[4]; unpack4(t.nA[0], f0); unpack4(t.nA[1], f1);
#pragma unroll
      for (int i = 0; i < 4; ++i) a[i] = f0[i] * ifA + f1[i] * ibA;
      unpack4(t.nB[0], f0); unpack4(t.nB[1], f1);
#pragma unroll
      for (int i = 0; i < 4; ++i) b[i] = lo32 ? f0[i] * ifB + f1[i] * ibB : 0.f;
      const float sA = (a[0] + a[1]) + (a[2] + a[3]), qA = (a[0] * a[0] + a[1] * a[1]) + (a[2] * a[2] + a[3] * a[3]);
      const float sB = (b[0] + b[1]) + (b[2] + b[3]), qB = (b[0] * b[0] + b[1] * b[1]) + (b[2] * b[2] + b[3] * b[3]);
      float mA = 0.f, rA = 0.f, mB = 0.f, rB = 0.f;
#pragma unroll
      for (int h = 0; h < 4; ++h) { const float ps = (hA == h ? sA : 0.f) + ((lo32 && hB == h) ? sB : 0.f), pq = (hA == h ? qA : 0.f) + ((lo32 && hB == h) ? qB : 0.f);
          const float m = wave_sum(ps) * (1.f / 96.f); const float var = fmaxf(wave_sum(pq) * (1.f / 96.f) - m * m, 0.f); const float rs = rsqrtf(var + 1e-6f);
          if (hA == h) { mA = m; rA = rs; } if (hB == h) { mB = m; rB = rs; } }
      float g[4]; unpack4(t.zA, g);
      uint2 o; o.x = pkbf((a[0] - mA) * rA * mgA[0] * sigm(g[0]), (a[1] - mA) * rA * mgA[1] * sigm(g[1])); o.y = pkbf((a[2] - mA) * rA * mgA[2] * sigm(g[2]), (a[3] - mA) * rA * mgA[3] * sigm(g[3]));
      *(uint2*)(yr + AW + RW + 4 * lane) = o;
      unpack4(t.zB, g);
      o.x = pkbf((b[0] - mB) * rB * mgB[0] * sigm(g[0]), (b[1] - mB) * rB * mgB[1] * sigm(g[1])); o.y = pkbf((b[2] - mB) * rB * mgB[2] * sigm(g[2]), (b[3] - mB) * rB * mgB[3] * sigm(g[3]));
      if (lo32) *(uint2*)(yr + AW + RW + 256 + 4 * lane) = o; }
}
DI void phase_yasm(const Args& A, int l, LAS unsigned char* lds, int gw, int ngw, int tid, int lane) {
    const bf16* Z = (const bf16*)(A.ws + WS_Z); const bf16* ao = (const bf16*)(A.ws + WS_ATTO); const float* al = (const float*)(A.ws + WS_ATTL);
    const bf16* rky = (const bf16*)(A.ws + WS_RKY); const bf16* rkb = (const bf16*)(A.ws + WS_RKB);
    const bf16* num = (const bf16*)(A.ws + WS_MLNUM); const float* den = (const float*)(A.ws + WS_MLDEN); bf16* y = (bf16*)(A.ws + WS_HB);
    const float* lng = A.in[I_RLNG] + (size_t)l * RW; const float* lnb = A.in[I_RLNB] + (size_t)l * RW; const float* mlg = A.in[I_MLNG] + (size_t)l * MW;
    LAS bf16* G2T = (LAS bf16*)lds;
    __syncthreads();
    { const u32x4_t* src = (const u32x4_t*)(A.ws + WS_G2T + (size_t)l * RW * 128 * 2);
      for (int idx = tid; idx < RW * 16; idx += NTHR) { const int col = idx >> 4, ch = idx & 15; *(LAS u32x4_t*)(G2T + col * YA_G2LD + ch * 8) = src[idx]; } }
    __syncthreads();
    const int fr = lane & 15, qd = lane >> 4;
    struct YItem { uint4 y0a, y0b, y1a, y1b, b0a, b0b, b1a, b1b, zg[4]; };
    auto item_load = [&](YItem& t, int item) { const int hh = item / (NT / 16), tg = item % (NT / 16); const int tokA = tg * 16 + fr;
        const size_t o = (size_t)tokA * RW + hh * 64 + 16 * qd;
        t.y0a = *(const uint4*)(rky + o); t.y0b = *(const uint4*)(rky + o + 8); t.y1a = *(const uint4*)(rky + (size_t)NT * RW + o); t.y1b = *(const uint4*)(rky + (size_t)NT * RW + o + 8);
        t.b0a = *(const uint4*)(rkb + o); t.b0b = *(const uint4*)(rkb + o + 8); t.b1a = *(const uint4*)(rkb + (size_t)NT * RW + o); t.b1b = *(const uint4*)(rkb + (size_t)NT * RW + o + 8);
#pragma unroll
        for (int ks = 0; ks < 4; ++ks) t.zg[ks] = *(const uint4*)(Z + (size_t)tokA * ZLD + ZGD + 32 * ks + 8 * qd); };
    union { unsigned u[4]; bf16x8_t v; } afr[4]; int tg_prev = -1;
    YItem cur; if (gw < (NT / 16) * 6) item_load(cur, gw);
    for (int item = gw; item < (NT / 16) * 6; item += ngw) {
        const int hh = item / (NT / 16), tg = item % (NT / 16); const int tokA = tg * 16 + fr;
        YItem nxt = cur; if (item + ngw < (NT / 16) * 6) item_load(nxt, item + ngw);
        const uint4 y0a = cur.y0a, y0b = cur.y0b, y1a = cur.y1a, y1b = cur.y1b, b0a = cur.b0a, b0b = cur.b0b, b1a = cur.b1a, b1b = cur.b1b;
        f32x4 gacc[4];
#pragma unroll
        for (int nt = 0; nt < 4; ++nt) gacc[nt] = (f32x4){0.f, 0.f, 0.f, 0.f};
        if (tg != tg_prev) { tg_prev = tg;
#pragma unroll
            for (int ks = 0; ks < 4; ++ks) { float f[8]; unpack8(cur.zg[ks], f);
#pragma unroll
                for (int e = 0; e < 4; ++e) afr[ks].u[e] = cvtpk(sigm(f[2 * e]), sigm(f[2 * e + 1])); } }
#pragma unroll
        for (int ks = 0; ks < 4; ++ks) {
#pragma unroll
            for (int nt = 0; nt < 4; ++nt) { const bf16x8_t bg = *(const LAS bf16x8_t*)(G2T + (hh * 64 + 16 * (fr >> 2) + 4 * nt + (fr & 3)) * YA_G2LD + 32 * ks + 8 * qd); gacc[nt] = MFMA16(bg, afr[ks].v, gacc[nt]); } }
        float sv[16], bv[16], t0[8], t1[8];
        unpack8(y0a, t0); unpack8(y1a, t1);
#pragma unroll
        for (int j = 0; j < 8; ++j) sv[j] = t0[j] + t1[j];
        unpack8(y0b, t0); unpack8(y1b, t1);
#pragma unroll
        for (int j = 0; j < 8; ++j) sv[8 + j] = t0[j] + t1[j];
        unpack8(b0a, t0); unpack8(b1a, t1);
#pragma unroll
        for (int j = 0; j < 8; ++j) bv[j] = t0[j] + t1[j];
        unpack8(b0b, t0); unpack8(b1b, t1);
#pragma unroll
        for (int j = 0; j < 8; ++j) bv[8 + j] = t0[j] + t1[j];
        float sm = 0.f;
#pragma unroll
        for (int j = 0; j < 16; ++j) sm += sv[j];
        sm += __shfl_xor(sm, 16); sm += __shfl_xor(sm, 32); sm *= (1.f / 64.f);
        float vr = 0.f;
#pragma unroll
        for (int j = 0; j < 16; ++j) { sv[j] -= sm; vr += sv[j] * sv[j]; }
        vr += __shfl_xor(vr, 16); vr += __shfl_xor(vr, 32); vr = rsqrtf(vr * (1.f / 64.f) + 64e-5f);
        const f32x4* lgp = (const f32x4*)(lng + hh * 64 + 16 * qd); const f32x4* lbp = (const f32x4*)(lnb + hh * 64 + 16 * qd);
        unsigned ow[8];
#pragma unroll
        for (int q = 0; q < 4; ++q) { const f32x4 lg_ = lgp[q], lb_ = lbp[q];
            ow[2 * q] = pkbf((sv[4 * q] * vr * lg_[0] + lb_[0] + bv[4 * q]) * gacc[q][0], (sv[4 * q + 1] * vr * lg_[1] + lb_[1] + bv[4 * q + 1]) * gacc[q][1]);
            ow[2 * q + 1] = pkbf((sv[4 * q + 2] * vr * lg_[2] + lb_[2] + bv[4 * q + 2]) * gacc[q][2], (sv[4 * q + 3] * vr * lg_[3] + lb_[3] + bv[4 * q + 3]) * gacc[q][3]); }
        bf16* yo = y + (size_t)tokA * DM + AW + hh * 64 + 16 * qd;
        *(uint4*)yo = make_uint4(ow[0], ow[1], ow[2], ow[3]); *(uint4*)(yo + 8) = make_uint4(ow[4], ow[5], ow[6], ow[7]);
        cur = nxt;
    }
    const f32x4 mgA = *(const f32x4*)(mlg + 4 * lane), mgB = *(const f32x4*)(mlg + 256 + 4 * (lane & 31));
    for (int tok0 = gw; tok0 < NT; tok0 += 4 * ngw) {
        YTok t0, t1, t2, t3; const int k1 = tok0 + ngw, k2 = tok0 + 2 * ngw, k3 = tok0 + 3 * ngw;
        yasm_token_load(t0, Z, ao, al, num, den, tok0, lane); yasm_token_load(t1, Z, ao, al, num, den, k1 < NT ? k1 : tok0, lane);
        yasm_token_load(t2, Z, ao, al, num, den, k2 < NT ? k2 : tok0, lane); yasm_token_load(t3, Z, ao, al, num, den, k3 < NT ? k3 : tok0, lane);
        yasm_token_finish(t0, mgA, mgB, y, tok0, lane);
        if (k1 < NT) yasm_token_finish(t1, mgA, mgB, y, k1, lane);
        if (k2 < NT) yasm_token_finish(t2, mgA, mgB, y, k2, lane);
        if (k3 < NT) yasm_token_finish(t3, mgA, mgB, y, k3, lane); }
    __syncthreads();
}

constexpr int L2_WLD = 1032;
constexpr int L2_WHI = 0, L2_WLO = 16 * L2_WLD * 2, L2_G2 = 2 * L2_WLO, L2_EX = L2_G2 + DM * 4, L2_SS = L2_EX + 8 * 1024, L2_END = L2_SS + 8 * 16 * 4;
static_assert(L2_END <= MISC_OFF, "ln2 LDS");
DI void phase_ln2(const Args& A, int l, LAS unsigned char* lds, int bid, int G, int tid, int wave, int lane) {
    const bf16* x1 = (const bf16*)(A.ws + WS_X1); unsigned char* hb = A.ws + WS_HB; float* aff = (float*)(A.ws + WS_AFF);
    const float* router = A.in[I_ROUTER] + (size_t)l * DM * NE; const float* g2 = A.in[I_LN2G] + (size_t)l * DM;
    LAS bf16* Whi = (LAS bf16*)(lds + L2_WHI); LAS bf16* Wlo = (LAS bf16*)(lds + L2_WLO); LAS float* g2s = (LAS float*)(lds + L2_G2);
    LAS unsigned char* ex = lds + L2_EX; LAS float* ssx = (LAS float*)(lds + L2_SS);
    const int fr = lane & 15, qd = lane >> 4, tg = wave >> 1, kh = wave & 1;
    __syncthreads();
    { const u32x4_t* src = (const u32x4_t*)(A.ws + WS_WP + (size_t)l * 2 * NE * L2_WLD * 2);
      for (int i = tid; i < 2 * NE * L2_WLD * 2 / 16; i += NTHR) *(LAS u32x4_t*)(lds + L2_WHI + i * 16) = src[i]; }
    for (int i = tid; i < DM; i += NTHR) g2s[i] = g2[i];
    for (int grp = bid; grp < NT / 64; grp += G) {
        const int tokb = grp * 64 + tg * 16, tok = tokb + fr;
        const u32x4_t* xp = (const u32x4_t*)(x1 + (size_t)tok * DM + kh * 512 + 16 * qd);
        u32x4_t xa[8][2];
#pragma unroll
        for (int p = 0; p < 8; ++p) { xa[p][0] = xp[8 * p]; xa[p][1] = xp[8 * p + 1]; }
        __syncthreads();
        f32x4 acc = (f32x4){0.f, 0.f, 0.f, 0.f}; float ss = 0.f;
#pragma unroll
        for (int p = 0; p < 8; ++p)
#pragma unroll
            for (int hf = 0; hf < 2; ++hf) { const int c = kh * 512 + 64 * p + 16 * qd + 8 * hf;
                const bf16x8_t a = __builtin_bit_cast(bf16x8_t, xa[p][hf]);
                const bf16x8_t bh = *(const LAS bf16x8_t*)(Whi + fr * L2_WLD + c), bl = *(const LAS bf16x8_t*)(Wlo + fr * L2_WLD + c);
                acc = MFMA16(a, bh, acc); acc = MFMA16(a, bl, acc);
#pragma unroll
                for (int e = 0; e < 4; ++e) { const float lo = __uint_as_float(xa[p][hf][e] << 16), hi = __uint_as_float(xa[p][hf][e] & 0xffff0000u); ss += lo * lo + hi * hi; } }
        ss += __shfl_xor(ss, 16); ss += __shfl_xor(ss, 32);
        *(LAS f32x4*)(ex + wave * 1024 + lane * 16) = acc; if (qd == 0) ssx[wave * 16 + fr] = ss;
        __syncthreads();
        { const f32x4 oth = *(const LAS f32x4*)(ex + (wave ^ 1) * 1024 + lane * 16); acc += oth; ss += ssx[(wave ^ 1) * 16 + fr]; }
        const float rs = rsqrtf(ss * (1.f / DM) + RMS_EPS);
        unsigned char* hrow = hb + (size_t)tok * DM + kh * 512 + 16 * qd; const float rsc = rs * F8_HSC;
#pragma unroll
        for (int p = 0; p < 8; ++p) { const LAS f32x4* gp = (const LAS f32x4*)(g2s + kh * 512 + 64 * p + 16 * qd); u32x4_t o;
#pragma unroll
            for (int q = 0; q < 4; ++q) { const f32x4 g = gp[q]; const unsigned u0 = xa[p][q >> 1][2 * (q & 1)], u1 = xa[p][q >> 1][2 * (q & 1) + 1];
                o[q] = pk4_fp8(__uint_as_float(u0 << 16) * rsc * g[0], __uint_as_float(u0 & 0xffff0000u) * rsc * g[1], __uint_as_float(u1 << 16) * rsc * g[2], __uint_as_float(u1 & 0xffff0000u) * rsc * g[3]); }
            *(u32x4_t*)(hrow + 64 * p) = o; }
        if (kh == 0) { f32x4 af;
#pragma unroll
            for (int r = 0; r < 4; ++r) { const float lg = acc[r] * __shfl(rs, 4 * qd + r); float mx = lg;
#pragma unroll
                for (int o = 1; o < 16; o <<= 1) mx = fmaxf(mx, __shfl_xor(mx, o));
                const float ev = expf(lg - mx); float sm = ev;
#pragma unroll
                for (int o = 1; o < 16; o <<= 1) sm += __shfl_xor(sm, o);
                af[r] = ev / sm; }
            *(f32x4*)(aff + ((size_t)(tokb / SEQ) * NE + fr) * SEQ + (tokb % SEQ) + 4 * qd) = af; }
    }
    __syncthreads();
}

constexpr int PH_PER_LAYER = 10, NPH = 1 + NL * PH_PER_LAYER + 1;
#ifndef MK_ONE_LAUNCH
#define MK_ONE_LAUNCH 1
#endif

#ifndef MK_DUP
#define MK_DUP 0
#endif
constexpr int P0_END = NL * 16 * 64 + NL * 16 * 16 + NL * NE * 3 * 8 * 44, P0_SPLIT = P0_END - NE * 3 * 8 * 44, P0_XC = 80, P0_W = NL * 16 * 64 + NL * 16 * 16, P0_XC1 = 104;
template <int l> DI void run_layer(const Args& A, LAS unsigned char* lds, const XcdBarrier& bar, int lo, int hi, int G, int bid, int tid, int lane, int wave, int gw, int ngw, int gtid, int nthr) {
#define IN(k) (lo <= (k) && (k) < hi)
#define SEAM(k) do { if (IN(k) && IN((k) + 1)) xcd_barrier(bar); } while (0)
#define PH(k, ...) do { if (IN(pb + (k))) { { __VA_ARGS__ } if ((MK_DUP >> (k)) & 1) { xcd_barrier(bar); { __VA_ARGS__ } } } SEAM(pb + (k)); } while (0)
    const int pb = 1 + l * PH_PER_LAYER;
    if constexpr (l > 0) PH(0, phase_ln1(A, l, gw, ngw, lane););
    PH(1,
        const bool conv = (l == 0) && (G >= 2 * P0_XC1) && (G % 8 == 0); const int Gg = conv ? G - P0_XC1 : G;
        if (conv && bid >= Gg) { __syncthreads(); phase_p0(A, lds, P0_W, P0_SPLIT, (bid - Gg) * NWAVES + wave, P0_XC1 * NWAVES, wave, lane); __syncthreads(); }
        else {
        pg8::Gemm g{(const bf16*)(A.ws + WS_HB), (const bf16*)(A.ws + WS_WTIN) + (size_t)l * ZLD * DM, NT, ZLD, DM};
        pg8::StaticOrder S; S.init(NT, ZLD, Gg, bid);
        pg8::EpiBf16<0> E{(bf16*)(A.ws + WS_Z), ZLD, nullptr, 0, 0, 1.f};
        pg8::gemm_phase<pg8::EpiBf16<0>, pg8::StaticOrder, true, true>(lds, g, S, E); });
    PH(2, phase_attn(A, lds, G > ATT_SCAN_BLK0 ? ATT_UNITS - ATT_SPLIT : 0, ATT_UNITS, bid, G, tid, wave, lane); phase_rwkv_r1(A, l, lds, bid, G, tid, wave, lane); if ((MK_DUP >> 13) & 1) phase_rwkv_r1(A, l, lds, bid, G, tid, wave, lane);
          phase_mlstm_m1(A, l, lds, bid, G, tid, wave, lane); if ((MK_DUP >> 16) & 1) phase_mlstm_m1(A, l, lds, bid, G, tid, wave, lane););
    PH(3,
          if (G > ATT_SCAN_BLK0 && bid >= ATT_SCAN_BLK0) phase_attn(A, lds, 0, ATT_UNITS - ATT_SPLIT, bid - ATT_SCAN_BLK0, G - ATT_SCAN_BLK0, tid, wave, lane);
          for (int rep = 0; rep < 1 + ((MK_DUP >> 14) & 1); ++rep) for (int u = bid; u < 96; u += G) rwkv_r2_unit(A, lds, u, tid, wave, lane);
          for (int rep = 0; rep < 1 + ((MK_DUP >> 15) & 1); ++rep) for (int u = bid; u < 96 + 64; u += G) { if (u >= 96) mlstm_m2_unit(A, lds, u - 96, tid, wave, lane); });
    PH(4, phase_yasm(A, l, lds, gw, ngw, tid, lane););
    PH(5,
        pg8::Gemm g{(const bf16*)(A.ws + WS_HB), (const bf16*)(A.ws + WS_WTOUT) + (size_t)l * DM * DM, NT, DM, DM};
        pg8::StaticOrder S; S.init(NT, DM, G, bid);
        EpiResT<(l > 0)> E{(l == 0) ? (const void*)A.in[I_X] : (const void*)(A.ws + WS_X2), (bf16*)(A.ws + WS_X1), DM};
        pg8::gemm_phase<EpiResT<(l > 0)>, pg8::StaticOrder, true, true>(lds, g, S, E););
    PH(6, phase_ln2(A, l, lds, bid, G, tid, wave, lane););
    PH(7, phase_topk(A, lds, bid, G, tid, wave, lane););
    PH(8,
        const bool conv = (l == 0) && (P0_SPLIT < P0_END) && (G >= 2 * P0_XC) && (G % 8 == 0); const int Gg = conv ? G - P0_XC : G;
        if (conv && bid >= Gg) { __syncthreads(); phase_p0(A, lds, P0_SPLIT, P0_END, (bid - Gg) * NWAVES + wave, P0_XC * NWAVES, wave, lane); __syncthreads(); }
        else {
        pg8::Gemm g{(const bf16*)(A.ws + WS_XG), (const bf16*)(A.ws + WS_W13T + (size_t)l * NE * 5632 * DM), NSLOT, NE * 5632, DM / 2};
        GroupOrder S; S.init(22, Gg, bid);
        EpiSwiGLU E{A.ws + WS_ACT, 22};
        pg8::gemm_phase<EpiSwiGLU, GroupOrder, true, true, true>(lds, g, S, E); });
    PH(9,
        pg8::Gemm g{(const bf16*)(A.ws + WS_ACT), (const bf16*)(A.ws + WS_W2T + (size_t)l * NE * DM * FF), NSLOT, NE * DM, FF / 2};
        GroupOrder S; S.init(4, G, bid);
        EpiGate E{(bf16*)(A.ws + WS_YS), (const float*)(A.ws + WS_GATE)};
        pg8::gemm_phase<EpiGate, GroupOrder, true, true, true>(lds, g, S, E););
#undef PH
#undef IN
#undef SEAM
}

__global__ void __launch_bounds__(NTHR, 2) mk_fwd(Args A) {
    extern __shared__ __attribute__((aligned(16))) unsigned char lds_raw[];
    LAS unsigned char* lds = (LAS unsigned char*)lds_raw;
    const int tid = threadIdx.x, lane = tid & 63, wave = __builtin_amdgcn_readfirstlane(tid >> 6);
    const int G = gridDim.x, bid = blockIdx.x;
    const int gw = bid * NWAVES + wave, ngw = G * NWAVES, gtid = bid * NTHR + tid, nthr = G * NTHR;
    volatile LAS unsigned* MISC = (volatile LAS unsigned*)(lds + MISC_OFF);
    if (tid < 64) MISC[tid] = 0u;
    __syncthreads();
    const int lo = A.ph_lo, hi = A.ph_hi;
    const bool use_bar = (hi - lo) > 1;
    XcdBarrier bar; bar.bar = (unsigned*)(A.ws + WS_CTL) + CW_BAR; bar.x = 0; bar.st = MISC + 8;
    if (use_bar) bar = xcd_barrier_post((unsigned*)(A.ws + WS_CTL) + CW_BAR, MISC + 8);
#define IN(k) (lo <= (k) && (k) < hi)
#define SEAM(k) do { if (IN(k) && IN((k) + 1)) xcd_barrier(bar); } while (0)

    const int p0_end = ((G >= 2 * P0_XC1) && (G >= 2 * P0_XC) && (G % 8 == 0)) ? P0_W : (((G >= 2 * P0_XC) && (G % 8 == 0)) ? P0_SPLIT : P0_END);
    if (IN(0)) { phase_ln1(A, 0, gw, ngw, lane); phase_p0(A, lds, 0, p0_end, gw, ngw, wave, lane); if ((MK_DUP >> 10) & 1) { xcd_barrier(bar); phase_p0(A, lds, 0, p0_end, gw, ngw, wave, lane); } } SEAM(0);

    run_layer<0>(A, lds, bar, lo, hi, G, bid, tid, lane, wave, gw, ngw, gtid, nthr);
    run_layer<1>(A, lds, bar, lo, hi, G, bid, tid, lane, wave, gw, ngw, gtid, nthr);
    if (IN(NPH - 1)) { phase_final(A, gw, ngw, lane); if ((MK_DUP >> 11) & 1) { xcd_barrier(bar); phase_final(A, gw, ngw, lane); } }
#undef IN
#undef SEAM
}
}

extern "C" void kernel_launch(void* const* d_in, const int* in_sizes, int n_in, void* d_out, int out_size, void* d_ws, size_t ws_size, hipStream_t stream) {
    using namespace mk;
    static int grid = 0;
    if (grid == 0) {
        if (n_in != N_IN || out_size != NT * DM || ws_size < WS_END) { fprintf(stderr, "kernel_launch: unexpected shapes (n_in %d, out %d, ws %zu < %zu)\n", n_in, out_size, ws_size, (size_t)WS_END); grid = -1; return; }
        int dev = 0, cus = 0, per_cu = 0;
        if (hipGetDevice(&dev) != hipSuccess || hipDeviceGetAttribute(&cus, hipDeviceAttributeMultiprocessorCount, dev) != hipSuccess) { grid = -1; return; }
        if (hipFuncSetAttribute((const void*)mk_fwd, hipFuncAttributeMaxDynamicSharedMemorySize, LDS_BYTES) != hipSuccess) { fprintf(stderr, "kernel_launch: hipFuncSetAttribute failed\n"); grid = -1; return; }
        if (hipOccupancyMaxActiveBlocksPerMultiprocessor(&per_cu, (const void*)mk_fwd, NTHR, LDS_BYTES) != hipSuccess || per_cu < 1) fprintf(stderr, "kernel_launch: occupancy query reports %d\n", per_cu);
        (void)hipGetLastError();
        grid = cus;
    }
    if (grid < 0) return;
    hipMemsetAsync((char*)d_ws + WS_CTL, 0, CTL_ZERO_BYTES, stream);
    Args a{};
    for (int i = 0; i < N_IN; ++i) a.in[i] = (const float*)d_in[i];
    a.out = (float*)d_out; a.ws = (unsigned char*)d_ws;
#if MK_ONE_LAUNCH
    a.ph_lo = 0; a.ph_hi = NPH;
    hipLaunchKernelGGL(mk_fwd, dim3(grid), dim3(NTHR), LDS_BYTES, stream, a);
#else
    for (int p = 0; p < NPH; ++p) { a.ph_lo = p; a.ph_hi = p + 1; hipLaunchKernelGGL(mk_fwd, dim3(grid), dim3(NTHR), LDS_BYTES, stream, a); }
#endif
}
```
